# Optimizing an MI355X kernel written in HIP

```python
import math
import jax
import jax.numpy as jnp
from jax import lax
import numpy as np

D_MODEL = 1024
BATCH = 32
SEQ = 256
DEPTH = 2
DEC_BATCH = 8
DEC_SEQ = 1024
PAST_LEN = 256

GRID_W = 64
N_AB = (DEPTH + 1) // 2
N_CD = DEPTH // 2
N_MOD = 9
D_FF = 2816
NORM_EPS = 1e-6
SHORT_CONV = 3
A_HEAD = 64
A_HEADS = 8
A_WIDTH = A_HEADS * A_HEAD
A_DECAY_LORA = 64
A_ICLR_LORA = 64
A_GATE_LORA = 128
A_GN_EPS = 64e-5
A_SPLITS = (A_WIDTH, 2 * A_WIDTH, 3 * A_WIDTH, 3 * A_WIDTH + 2 * A_DECAY_LORA, 3 * A_WIDTH + 2 * A_DECAY_LORA + 2 * A_ICLR_LORA)
A_COLS = A_SPLITS[-1] + A_GATE_LORA
B_HEADS = 4
B_DK = 128
B_DV = 128
B_WIDTH = B_HEADS * B_DV
B_CHUNK = 64
B_COLS = 4 * B_WIDTH + 4 * B_HEADS
AB_COLS = A_COLS + B_COLS
C_HEADS = 8
C_Q_RANK = 384
C_KV_RANK = 256
C_NOPE = 64
C_ROPE = 32
C_V = 64
C_WIDTH = C_HEADS * C_V
C_COLS = C_Q_RANK + C_KV_RANK + C_ROPE
ROPE_BASE = 10000.0
Q_BLOCK = 128
D_WIDTH = 512
D_ORDER = 2
D_BANDS = 16
D_EMB = 1 + 2 * D_BANDS
D_FILTER_HIDDEN = 64
D_DECAY_TARGET = 1e-2
D_FAST_PCT = 0.3
D_SLOW_PCT = 1.5
CD_COLS = C_COLS + 3 * D_WIDTH

kernel_name = 'hybrid_prefix_diffusion_step'


def rmsnorm(x, g):
    xf = x.astype(jnp.float32)
    y = xf * lax.rsqrt(jnp.mean(xf * xf, axis=-1, keepdims=True) + NORM_EPS)
    return (y * g.astype(jnp.float32)).astype(x.dtype)


def l2norm(x):
    xf = x.astype(jnp.float32)
    return (xf * lax.rsqrt(jnp.sum(xf * xf, axis=-1, keepdims=True) + 1e-6)).astype(x.dtype)


def swiglu(x, w_gu, w_down):
    g, u = jnp.split(x @ w_gu, 2, axis=-1)
    return (jax.nn.silu(g) * u) @ w_down


def adaln(cvec, w_mod, b_mod):
    m = jax.nn.silu(cvec) @ w_mod + b_mod
    return m.reshape(m.shape[0], 1, N_MOD, D_MODEL)


def pre(x, g, m, j):
    return rmsnorm(x, g) * (1.0 + m[:, :, 3 * j + 1]) + m[:, :, 3 * j]


def neighbours(p):
    z = jnp.zeros_like(p[:, :1])
    return jnp.concatenate([z, p[:, :-1]], axis=1), jnp.concatenate([p[:, 1:], z], axis=1)


def centred_shift(p):
    prev, nxt = neighbours(p)
    return 0.5 * (prev + nxt)


def conv3(p, w):
    prev, nxt = neighbours(p)
    return w[0] * prev + w[1] * p + w[2] * nxt


def wkv7_scan(r, w, k, v, kk, a, S0):
    def step(S, xs):
        r_t, w_t, k_t, v_t, kk_t, a_t = xs
        sk = jnp.einsum('bhvk,bhk->bhv', S, kk_t)
        S = (S * w_t[:, :, None, :] - sk[..., None] * (kk_t * a_t)[:, :, None, :]
             + v_t[..., None] * k_t[:, :, None, :])
        return S, jnp.einsum('bhvk,bhk->bhv', S, r_t)
    xs = tuple(jnp.swapaxes(t, 0, 1) for t in (r, w, k, v, kk, a))
    S, y = lax.scan(step, S0, xs)
    return jnp.swapaxes(y, 0, 1), S


def rwkv7_mix(p, S0, mu, w0, w_up, a0, a_up, g_up, k_k, k_a, r_k, ln_w, ln_b):
    B, L, _ = p.shape
    f32 = jnp.float32
    p = p + mu * (centred_shift(p) - p)
    r, k, v, wd, ad, gd = jnp.split(p, A_SPLITS, axis=-1)
    wd = wd.reshape(B, L, 2, A_DECAY_LORA)
    ad = ad.reshape(B, L, 2, A_ICLR_LORA)
    w_log = -jax.nn.softplus(-(w0 + jnp.einsum('bldr,drc->bldc', jnp.tanh(wd), w_up))) - 0.5
    decay = jnp.exp(-jnp.exp(w_log.astype(f32)))
    a = jax.nn.sigmoid(a0 + jnp.einsum('bldr,drc->bldc', ad, a_up))
    g = jax.nn.sigmoid(gd) @ g_up
    k_dir = k[:, :, None, :] * (1.0 + (a - 1.0) * k_a)
    hd = lambda t: t.reshape(t.shape[:-1] + (A_HEADS, A_HEAD)).astype(f32)
    fl = lambda t: jnp.flip(t, axis=1)
    kk = l2norm(hd(k * k_k))
    rh, vh = hd(r), hd(v)
    S0 = S0.astype(f32)
    y_f, S_f = wkv7_scan(rh, hd(decay[:, :, 0]), hd(k_dir[:, :, 0]), vh, kk, hd(a[:, :, 0]), S0[:, 0])
    y_b, S_b = wkv7_scan(fl(rh), fl(hd(decay[:, :, 1])), fl(hd(k_dir[:, :, 1])), fl(vh), fl(kk),
                         fl(hd(a[:, :, 1])), S0[:, 1])
    y = y_f + fl(y_b)
    mean = jnp.mean(y, axis=-1, keepdims=True)
    var = jnp.mean(jnp.square(y - mean), axis=-1, keepdims=True)
    y = ((y - mean) * lax.rsqrt(var + A_GN_EPS)).reshape(B, L, A_WIDTH) * ln_w + ln_b
    bonus = jnp.sum(rh * hd(jnp.mean(k_dir, axis=2)) * r_k, axis=-1, keepdims=True) * vh
    out = (y + bonus.reshape(B, L, A_WIDTH)) * g
    return out.astype(p.dtype), jnp.stack([S_f, S_b], axis=1).astype(p.dtype)


def gated_delta_chunked(q, k, v, g, beta, S0):
    B, L, H, DK = q.shape
    DV = v.shape[-1]
    C = math.gcd(L, B_CHUNK)
    N = L // C
    to_chunks = lambda t: jnp.moveaxis(t.reshape(B, N, C, H, -1), (1, 3), (0, 2))
    qc, kc, vc = to_chunks(q), to_chunks(k), to_chunks(v)
    gc = to_chunks(g[..., None])[..., 0]
    bc = to_chunks(beta[..., None])[..., 0]
    G = jnp.cumsum(gc, axis=-1)
    causal = jnp.tril(jnp.ones((C, C), dtype=bool))
    strict = jnp.tril(jnp.ones((C, C), dtype=bool), -1)
    diff = G[..., :, None] - G[..., None, :]
    gamma = jnp.where(causal, jnp.exp(jnp.where(causal, diff, 0.0)), 0.0)
    kb = kc * bc[..., None]
    lower = jnp.where(strict, jnp.einsum('nbhid,nbhjd->nbhij', kb, kc) * gamma, 0.0)
    eye = jnp.eye(C, dtype=q.dtype)
    T = lax.linalg.triangular_solve(eye + lower, jnp.broadcast_to(eye, lower.shape),
                                    left_side=True, lower=True, unit_diagonal=True)
    u = jnp.einsum('nbhij,nbhjv->nbhiv', T, vc * bc[..., None])
    w = jnp.einsum('nbhij,nbhjk->nbhik', T, kb * jnp.exp(G)[..., None])
    qk = jnp.einsum('nbhid,nbhjd->nbhij', qc, kc) * gamma
    q_in = qc * jnp.exp(G)[..., None]
    G_last = G[..., -1]
    k_out = kc * jnp.exp(G_last[..., None] - G)[..., None]

    def step(S, xs):
        u_i, w_i, qk_i, q_i, k_i, gl_i = xs
        v_new = u_i - jnp.einsum('bhck,bhkv->bhcv', w_i, S)
        o = jnp.einsum('bhck,bhkv->bhcv', q_i, S) + jnp.einsum('bhij,bhjv->bhiv', qk_i, v_new)
        S = S * jnp.exp(gl_i)[..., None, None] + jnp.einsum('bhck,bhcv->bhkv', k_i, v_new)
        return S, o
    S, o = lax.scan(step, S0, (u, w, qk, q_in, k_out, G_last))
    o = jnp.moveaxis(o, (0, 2), (1, 3)).reshape(B, L, H, DV)
    return o, S


def gdn_mix(p, S0, conv_w, a_log, dt_bias, norm_w):
    B, L, _ = p.shape
    f32 = jnp.float32
    qkv, z, ab = jnp.split(p, [3 * B_WIDTH, 4 * B_WIDTH], axis=-1)
    q, k, v = jnp.split(jax.nn.silu(conv3(qkv, conv_w)), 3, axis=-1)
    hd = lambda t, d: t.reshape(B, L, B_HEADS, d).astype(f32)
    fl = lambda t: jnp.flip(t, axis=1)
    q = l2norm(hd(q, B_DK)) * (B_DK ** -0.5)
    k = l2norm(hd(k, B_DK))
    v = hd(v, B_DV)
    ab = ab.reshape(B, L, 2, 2, B_HEADS).astype(f32)
    g = -jnp.exp(a_log.astype(f32)) * jax.nn.softplus(ab[:, :, :, 0] + dt_bias.astype(f32))
    beta = jax.nn.sigmoid(ab[:, :, :, 1])
    S0 = S0.astype(f32)
    o_f, S_f = gated_delta_chunked(q, k, v, g[:, :, 0], beta[:, :, 0], S0[:, 0])
    o_b, S_b = gated_delta_chunked(fl(q), fl(k), fl(v), fl(g[:, :, 1]), fl(beta[:, :, 1]), S0[:, 1])
    o = rmsnorm(o_f + fl(o_b), norm_w) * jax.nn.silu(hd(z, B_DV))
    return o.reshape(B, L, B_WIDTH).astype(p.dtype), jnp.stack([S_f, S_b], axis=1).astype(p.dtype)


def axial_rope(L):
    rows = L // GRID_W
    row = jnp.repeat(jnp.arange(rows), GRID_W).astype(jnp.float32)
    col = (jnp.arange(L) % GRID_W).astype(jnp.float32)
    n = C_ROPE // 4
    inv = ROPE_BASE ** (-jnp.arange(n, dtype=jnp.float32) / n)
    ang = jnp.concatenate([row[:, None] * inv, col[:, None] * inv], axis=-1)
    return jnp.cos(ang), jnp.sin(ang)


def apply_rope(x, cos, sin):
    cos = cos.astype(x.dtype)
    sin = sin.astype(x.dtype)
    x1, x2 = x[..., 0::2], x[..., 1::2]
    return jnp.stack([x1 * cos - x2 * sin, x1 * sin + x2 * cos], axis=-1).reshape(x.shape)


def mla_split(p, q_norm, w_uq, kv_norm):
    B, L, _ = p.shape
    pq, pkv, kpe = jnp.split(p, [C_Q_RANK, C_Q_RANK + C_KV_RANK], axis=-1)
    q = (rmsnorm(pq, q_norm) @ w_uq).reshape(B, L, C_HEADS, C_NOPE + C_ROPE)
    return q[..., :C_NOPE], q[..., C_NOPE:], rmsnorm(pkv, kv_norm), kpe


def mla_expand(ckv, w_ukv):
    B, L, _ = ckv.shape
    kv = (ckv @ w_ukv).reshape(B, L, C_HEADS, C_NOPE + C_V)
    return kv[..., :C_NOPE], kv[..., C_NOPE:]


def mla_attend(q_nope, q_pe, k_nope, k_pe, v):
    B, Lq = q_nope.shape[:2]
    qb = math.gcd(Lq, Q_BLOCK)
    nb = Lq // qb
    blocks = lambda t: jnp.swapaxes(t.reshape((B, nb, qb) + t.shape[2:]), 0, 1)
    scale = (C_NOPE + C_ROPE) ** -0.5

    def one_block(qs):
        qn, qp = qs
        s = jnp.einsum('bqhd,bkhd->bhqk', qn, k_nope) + jnp.einsum('bqhr,bkr->bhqk', qp, k_pe)
        prob = jax.nn.softmax(s.astype(jnp.float32) * scale, axis=-1).astype(v.dtype)
        return jnp.einsum('bhqk,bkhd->bqhd', prob, v)
    o = lax.map(one_block, (blocks(q_nope), blocks(q_pe)))
    return jnp.swapaxes(o, 0, 1).reshape(B, Lq, C_WIDTH)


def hyena_filters(L, w1, b1, w2, b2, w3, freq):
    t = jnp.arange(L, dtype=jnp.float32)
    t_norm = t / max(L - 1, 1)
    bands = jnp.linspace(1e-4, D_BANDS - 1, D_BANDS, dtype=jnp.float32)
    ang = (2.0 * math.pi / L) * t[:, None] * bands
    feats = jnp.concatenate([t_norm[:, None], jnp.cos(ang), -jnp.sin(ang)], axis=-1).astype(w1.dtype)
    h = jnp.sin(freq[0] * (feats @ w1 + b1))
    h = jnp.sin(freq[1] * (h @ w2 + b2))
    h = (h @ w3).reshape(L, D_ORDER, 2, D_WIDTH)
    min_decay = math.log(D_DECAY_TARGET) / D_SLOW_PCT
    max_decay = math.log(D_DECAY_TARGET) / D_FAST_PCT
    deltas = jnp.abs(jnp.linspace(min_decay, max_decay, D_WIDTH, dtype=jnp.float32))
    window = jnp.exp(-t_norm[:, None] * deltas)
    return h * window[:, None, None, :].astype(h.dtype)


def bidir_fftconv(z, h_f, h_b):
    B, L, C = z.shape
    filt2 = jnp.concatenate([h_f, jnp.zeros((1, C), h_f.dtype), h_b[:0:-1]], axis=0).astype(jnp.float32)
    zf = jnp.fft.rfft(z.astype(jnp.float32), n=2 * L, axis=1)
    hf = jnp.fft.rfft(filt2, n=2 * L, axis=0)
    return jnp.fft.irfft(zf * hf[None], n=2 * L, axis=1)[:, :L].astype(z.dtype)


def hyena_mix(p, conv_w, w1, b1, w2, b2, w3, freq, bias):
    L = p.shape[1]
    v, x1, x2 = jnp.split(conv3(p, conv_w), 3, axis=-1)
    h = hyena_filters(L, w1, b1, w2, b2, w3, freq)
    z = v
    for n, gate in enumerate((x1, x2)):
        z = gate * (bidir_fftconv(z, h[:, n, 0], h[:, n, 1]) + bias[n] * z)
    return z


def setup_inputs(seed: int = 0) -> dict:
    key = jax.random.key(seed)
    ks = iter(jax.random.split(key, 64))
    f32 = jnp.float32

    def nrm(shape, s):
        return jax.random.normal(next(ks), shape, f32) * s

    def gain(shape, base=1.0):
        return base + nrm(shape, 0.05)

    def unif(shape, lo, hi):
        return jax.random.uniform(next(ks), shape, f32, lo, hi)

    D, F = D_MODEL, D_FF
    dt = jnp.exp(unif((N_AB, 2, B_HEADS), math.log(1e-3), math.log(1e-1)))
    return {
        'x_prompt': nrm((BATCH, SEQ, D), 1.0),
        'x_sample': nrm((DEC_BATCH, DEC_SEQ, D), 1.0),
        'state_rwkv': nrm((DEC_BATCH, N_AB, 2, A_HEADS, A_HEAD, A_HEAD), 1.0),
        'state_gdn': nrm((DEC_BATCH, N_AB, 2, B_HEADS, B_DK, B_DV), 0.3),
        'cache_ckv': nrm((DEC_BATCH, N_CD, PAST_LEN, C_KV_RANK), 1.0),
        'cache_kpe': nrm((DEC_BATCH, N_CD, PAST_LEN, C_ROPE), 1.0),
        'c': nrm((DEC_BATCH, D), 1.0),
        'c_ctx': nrm((D,), 1.0),
        'w_mod': nrm((DEPTH, D, N_MOD * D), 0.02),
        'b_mod': nrm((DEPTH, N_MOD * D), 0.02),
        'norm_ffn1': gain((DEPTH, D)),
        'norm_mix': gain((DEPTH, D)),
        'norm_ffn2': gain((DEPTH, D)),
        'ffn1_w_gu': nrm((DEPTH, D, 2 * F), D ** -0.5),
        'ffn1_w_down': nrm((DEPTH, F, D), F ** -0.5),
        'ffn2_w_gu': nrm((DEPTH, D, 2 * F), D ** -0.5),
        'ffn2_w_down': nrm((DEPTH, F, D), F ** -0.5),
        'w_out': nrm((DEPTH, D, D), D ** -0.5),
        'ab_w_in': nrm((N_AB, D, AB_COLS), D ** -0.5),
        'rwkv_mu': unif((N_AB, A_COLS), 0.0, 1.0),
        'rwkv_w0': unif((N_AB, 2, A_WIDTH), -6.0, 1.0),
        'rwkv_w_up': nrm((N_AB, 2, A_DECAY_LORA, A_WIDTH), A_DECAY_LORA ** -0.5),
        'rwkv_a0': nrm((N_AB, 2, A_WIDTH), 0.5),
        'rwkv_a_up': nrm((N_AB, 2, A_ICLR_LORA, A_WIDTH), A_ICLR_LORA ** -0.5),
        'rwkv_g_up': nrm((N_AB, A_GATE_LORA, A_WIDTH), A_GATE_LORA ** -0.5),
        'rwkv_k_k': gain((N_AB, A_WIDTH), 0.85),
        'rwkv_k_a': gain((N_AB, A_WIDTH)),
        'rwkv_r_k': nrm((N_AB, A_HEADS, A_HEAD), 0.1),
        'rwkv_ln_w': gain((N_AB, A_WIDTH)),
        'rwkv_ln_b': nrm((N_AB, A_WIDTH), 0.02),
        'gdn_conv': nrm((N_AB, SHORT_CONV, 3 * B_WIDTH), SHORT_CONV ** -0.5),
        'gdn_a_log': jnp.log(unif((N_AB, 2, B_HEADS), 1.0, 16.0)),
        'gdn_dt_bias': dt + jnp.log(-jnp.expm1(-dt)),
        'gdn_norm': gain((N_AB, B_DV)),
        'cd_w_in': nrm((N_CD, D, CD_COLS), D ** -0.5),
        'mla_q_norm': gain((N_CD, C_Q_RANK)),
        'mla_w_uq': nrm((N_CD, C_Q_RANK, C_HEADS * (C_NOPE + C_ROPE)), C_Q_RANK ** -0.5),
        'mla_kv_norm': gain((N_CD, C_KV_RANK)),
        'mla_w_ukv': nrm((N_CD, C_KV_RANK, C_HEADS * (C_NOPE + C_V)), C_KV_RANK ** -0.5),
        'hy_conv': nrm((N_CD, SHORT_CONV, 3 * D_WIDTH), SHORT_CONV ** -0.5),
        'hy_w1': nrm((N_CD, D_EMB, D_FILTER_HIDDEN), D_EMB ** -0.5),
        'hy_b1': nrm((N_CD, D_FILTER_HIDDEN), 0.1),
        'hy_w2': nrm((N_CD, D_FILTER_HIDDEN, D_FILTER_HIDDEN), D_FILTER_HIDDEN ** -0.5),
        'hy_b2': nrm((N_CD, D_FILTER_HIDDEN), 0.1),
        'hy_w3': nrm((N_CD, D_FILTER_HIDDEN, D_ORDER * 2 * D_WIDTH), 0.01),
        'hy_freq': gain((N_CD, 2, D_FILTER_HIDDEN)),
        'hy_bias': nrm((N_CD, D_ORDER, D_WIDTH), 0.5),
        'final_norm': gain((D,)),
    }


def reference(x_prompt, x_sample, state_rwkv, state_gdn, cache_ckv, cache_kpe, c, c_ctx,
              w_mod, b_mod, norm_ffn1, norm_mix, norm_ffn2, ffn1_w_gu, ffn1_w_down, ffn2_w_gu, ffn2_w_down, w_out,
              ab_w_in, rwkv_mu, rwkv_w0, rwkv_w_up, rwkv_a0, rwkv_a_up, rwkv_g_up, rwkv_k_k, rwkv_k_a, rwkv_r_k,
              rwkv_ln_w, rwkv_ln_b, gdn_conv, gdn_a_log, gdn_dt_bias, gdn_norm,
              cd_w_in, mla_q_norm, mla_w_uq, mla_kv_norm, mla_w_ukv,
              hy_conv, hy_w1, hy_b1, hy_w2, hy_b2, hy_w3, hy_freq, hy_bias, final_norm):
    xp, xs = x_prompt, x_sample
    Bp = xp.shape[0]
    rwkv_new, gdn_new, ckv_new, kpe_new = [], [], [], []
    for i in range(DEPTH):
        j = i // 2
        mp = adaln(c_ctx[None], w_mod[i], b_mod[i])
        ms = adaln(c, w_mod[i], b_mod[i])
        xp = xp + 0.5 * mp[:, :, 2] * swiglu(pre(xp, norm_ffn1[i], mp, 0), ffn1_w_gu[i], ffn1_w_down[i])
        xs = xs + 0.5 * ms[:, :, 2] * swiglu(pre(xs, norm_ffn1[i], ms, 0), ffn1_w_gu[i], ffn1_w_down[i])
        hp = pre(xp, norm_mix[i], mp, 1)
        hs = pre(xs, norm_mix[i], ms, 1)
        if i % 2 == 0:
            pp = hp @ ab_w_in[j]
            ps = hs @ ab_w_in[j]
            rw = (rwkv_mu[j], rwkv_w0[j], rwkv_w_up[j], rwkv_a0[j], rwkv_a_up[j], rwkv_g_up[j],
                  rwkv_k_k[j], rwkv_k_a[j], rwkv_r_k[j], rwkv_ln_w[j], rwkv_ln_b[j])
            gd = (gdn_conv[j], gdn_a_log[j], gdn_dt_bias[j], gdn_norm[j])
            a_p, s_a = rwkv7_mix(pp[..., :A_COLS], jnp.zeros((Bp, 2, A_HEADS, A_HEAD, A_HEAD), xp.dtype), *rw)
            b_p, s_b = gdn_mix(pp[..., A_COLS:], jnp.zeros((Bp, 2, B_HEADS, B_DK, B_DV), xp.dtype), *gd)
            a_s, _ = rwkv7_mix(ps[..., :A_COLS], state_rwkv[:, j], *rw)
            b_s, _ = gdn_mix(ps[..., A_COLS:], state_gdn[:, j], *gd)
            mix_p = jnp.concatenate([a_p, b_p], axis=-1)
            mix_s = jnp.concatenate([a_s, b_s], axis=-1)
            rwkv_new.append(s_a)
            gdn_new.append(s_b)
        else:
            pp = hp @ cd_w_in[j]
            ps = hs @ cd_w_in[j]
            qn, qp, ckv, kpe = mla_split(pp[..., :C_COLS], mla_q_norm[j], mla_w_uq[j], mla_kv_norm[j])
            kn, vv = mla_expand(ckv, mla_w_ukv[j])
            c_p = mla_attend(qn, qp, kn, kpe, vv)
            cos, sin = axial_rope(xs.shape[1])
            qn_s, qp_s, ckv_s, kpe_s = mla_split(ps[..., :C_COLS], mla_q_norm[j], mla_w_uq[j], mla_kv_norm[j])
            kn_s, v_s = mla_expand(jnp.concatenate([ckv_s, cache_ckv[:, j]], axis=1), mla_w_ukv[j])
            kpe_all = jnp.concatenate([apply_rope(kpe_s, cos, sin), cache_kpe[:, j]], axis=1)
            c_s = mla_attend(qn_s, apply_rope(qp_s, cos[:, None], sin[:, None]), kn_s, kpe_all, v_s)
            hy = (hy_conv[j], hy_w1[j], hy_b1[j], hy_w2[j], hy_b2[j], hy_w3[j], hy_freq[j], hy_bias[j])
            d_p = hyena_mix(pp[..., C_COLS:], *hy)
            d_s = hyena_mix(ps[..., C_COLS:], *hy)
            mix_p = jnp.concatenate([c_p, d_p], axis=-1)
            mix_s = jnp.concatenate([c_s, d_s], axis=-1)
            ckv_new.append(ckv)
            kpe_new.append(kpe)
        xp = xp + mp[:, :, 5] * (mix_p @ w_out[i])
        xs = xs + ms[:, :, 5] * (mix_s @ w_out[i])
        xp = xp + 0.5 * mp[:, :, 8] * swiglu(pre(xp, norm_ffn2[i], mp, 2), ffn2_w_gu[i], ffn2_w_down[i])
        xs = xs + 0.5 * ms[:, :, 8] * swiglu(pre(xs, norm_ffn2[i], ms, 2), ffn2_w_gu[i], ffn2_w_down[i])
    y_prompt = rmsnorm(xp, final_norm)
    y_sample = rmsnorm(xs, final_norm)
    new_state_rwkv = jnp.stack(rwkv_new, axis=1)
    new_state_gdn = jnp.stack(gdn_new, axis=1)
    new_cache_ckv = jnp.stack(ckv_new, axis=1)
    new_cache_kpe = jnp.stack(kpe_new, axis=1)
    return (y_prompt, y_sample, new_state_rwkv, new_state_gdn, new_cache_ckv, new_cache_kpe)
```

```cpp
#include <hip/hip_runtime.h>
#include <hip/hip_cooperative_groups.h>
#include <cstdio>
#include <cstdint>
namespace cg = cooperative_groups;

#define LAS __attribute__((address_space(3)))
typedef unsigned short bf16;
typedef float f32x2 __attribute__((ext_vector_type(2)));
typedef float f32x4 __attribute__((ext_vector_type(4)));
typedef float f32x16 __attribute__((ext_vector_type(16)));
typedef unsigned u32x2 __attribute__((ext_vector_type(2)));
typedef unsigned u32x4 __attribute__((ext_vector_type(4)));
typedef short s16x8 __attribute__((ext_vector_type(8)));

constexpr int M_TOK = 16384, MP = 8192, DM = 1024, DFF = 2816;
constexpr int LDP0 = 3984, LDP1 = 2304;
constexpr int OUT_YS = 8388608, OUT_SRW = 16777216, OUT_SGD = 18874368, OUT_CKV = 23068672, OUT_KPE = 25165824;

constexpr size_t MiB = 1ull << 20;
constexpr size_t WS_CTL = 0;
constexpr size_t WS_ROPE = 512 * 1024;
constexpr size_t WS_MOD = 1 * MiB;
constexpr size_t WS_W = 2 * MiB;
constexpr size_t W_GU = WS_W, W_DOWN = WS_W + 11 * MiB;
constexpr size_t W_IN = WS_W, W_OUT = WS_W + 8 * MiB, W_LORA = WS_W + 10 * MiB, W_UQ = WS_W + 12 * MiB, W_UKV = WS_W + 13 * MiB;
constexpr size_t WS_H = 19 * MiB;
constexpr size_t WS_MIX = 51 * MiB;
constexpr size_t WS_R1 = 83 * MiB;
constexpr size_t R1_BYTES = 130547712;
constexpr size_t WS_HYIN = WS_R1 + 72 * MiB;
constexpr size_t WS_R2 = WS_R1 + R1_BYTES;
constexpr size_t WS_Q = WS_R2, WS_KV = WS_R2 + 24 * MiB, WS_CKVA = WS_R2 + 60 * MiB, WS_KPEA = WS_R2 + 69 * MiB, WS_GFS = WS_R2 + 71 * MiB, WS_GFP = WS_R2 + 75 * MiB;
constexpr size_t WS_END = WS_R2 + 80 * MiB;

constexpr int LDS_BYTES = 147456;
constexpr int NTHREADS = 512;

struct P {
    const float* in[48];
    float* out;
    unsigned char* ws;
    int ph_lo, ph_hi;
};

__device__ __forceinline__ float bf2f(unsigned b) { return __uint_as_float(b << 16); }
__device__ __forceinline__ float bflo(unsigned w) { return __uint_as_float(w << 16); }
__device__ __forceinline__ float bfhi(unsigned w) { return __uint_as_float(w & 0xffff0000u); }
__device__ __forceinline__ unsigned pk2(float lo, float hi) { unsigned r; asm("v_cvt_pk_bf16_f32 %0, %1, %2" : "=v"(r) : "v"(lo), "v"(hi)); return r; }
__device__ __forceinline__ f32x4 unpk4(u32x2 w) { return (f32x4){bflo(w.x), bfhi(w.x), bflo(w.y), bfhi(w.y)}; }
__device__ __forceinline__ u32x2 pk4(f32x4 v) { return (u32x2){pk2(v.x, v.y), pk2(v.z, v.w)}; }
__device__ __forceinline__ float wave_sum(float v) {
#pragma unroll
    for (int o = 1; o < 64; o <<= 1) v += __shfl_xor(v, o);
    return v;
}
__device__ __forceinline__ float dpp_f(float x, int) { return x; }
#define DPPF(x, ctrl) __int_as_float(__builtin_amdgcn_update_dpp(0, __float_as_int(x), (ctrl), 0xF, 0xF, true))
__device__ __forceinline__ float red4(float x) { x += DPPF(x, 0xB1); x += DPPF(x, 0x4E); return x; }
__device__ __forceinline__ float red8(float x) { x = red4(x); x += DPPF(x, 0x141); return x; }
__device__ __forceinline__ float red16(float x) { x = red8(x); x += DPPF(x, 0x140); return x; }
__device__ __forceinline__ float sigmoidf_(float x) { return 1.0f / (1.0f + __expf(-x)); }
__device__ __forceinline__ float siluf_(float x) { return x / (1.0f + __expf(-x)); }
__device__ __forceinline__ int cond_of_row(int row) { return row < MP ? 0 : 1 + ((row - MP) >> 10); }
__device__ __forceinline__ int tid_opaque() { int t = threadIdx.x; asm volatile("" : "+v"(t)); return t; }
#define LDS_WAIT() asm volatile("s_waitcnt lgkmcnt(0)" ::: "memory")

namespace pg8 {
#define PG8_LAS __attribute__((address_space(3)))
typedef unsigned short bf16_t;
typedef short bf16x8 __attribute__((ext_vector_type(8)));
typedef float f32x4 __attribute__((ext_vector_type(4)));
typedef unsigned u32x4 __attribute__((ext_vector_type(4)));
constexpr int BM = 256, BK = 64, HALF = 128, HTB = HALF * BK * 2  , STAGE_BYTES = 8 * HTB, NXCD = 8, WGM = 8;

__host__ __device__ __forceinline__ int lds_byte(int r, int c) { const int st = (r >> 4) * 2 + (c >> 5), rr = r & 15, cc = c & 31, ob = rr * 64 + cc * 2; return st * 1024 + (ob ^ (((ob >> 9) & 1) << 5)); }
__host__ __device__ __forceinline__ void stage_rc(int b, int& R, int& C) { const int st = b / 1024, sb = b % 1024, swz = sb ^ (((sb >> 9) & 1) << 5); R = (st >> 1) * 16 + swz / 64; C = (st & 1) * 32 + (swz % 64) / 2; }
__host__ __device__ __forceinline__ int perm32(int rho) { const int n = rho >> 4, i = rho & 15; return 8 * (i >> 2) + 4 * n + (i & 3); }

struct Unit { int pm, pn; };
struct Gemm { const bf16_t* A; const bf16_t* Bt; int M, N, K; };

struct StaticOrder {
    int nM, nN, nwg, G, c;
    __host__ __device__ void init(int M, int N, int G_, int c_) { nM = M / BM; nN = N / BM; nwg = nM * nN; G = G_; c = c_; }
    __host__ __device__ bool next(int i, Unit& u) const {
        const long L = (long)i * G + c; if (L >= nwg) return false;
        int wgid = (int)L; { const int q = nwg / NXCD, r = nwg % NXCD, xcd = wgid % NXCD, off = wgid / NXCD; wgid = (xcd < r ? xcd * (q + 1) : r * (q + 1) + (xcd - r) * q) + off; }
        const int nig = WGM * nN, gid = wgid / nig, fm = gid * WGM, gsz = (nM - fm) < WGM ? (nM - fm) : WGM;
        u.pm = fm + ((wgid % nig) % gsz); u.pn = (wgid % nig) / gsz; return true;
    }
    __device__ __forceinline__ void a_ready(const Unit&) const {}
    __device__ __forceinline__ void done(const Unit&) const {}
};
__device__ __forceinline__ unsigned cvt_pk_bf16(float lo, float hi) { unsigned r; asm volatile("v_cvt_pk_bf16_f32 %0, %1, %2" : "=v"(r) : "v"(lo), "v"(hi)); return r; }
typedef float f32x2 __attribute__((ext_vector_type(2)));
template <class Epi, class Sched, bool ALIGN_EPI = false, bool SP2 = false>
__device__ __forceinline__ void gemm_phase(PG8_LAS unsigned char* lds, const Gemm g, const Sched& S, const Epi& E) {
    const int tid = tid_opaque(), wid = __builtin_amdgcn_readfirstlane(tid >> 6), lane = tid & 63, wr = wid >> 2, wc = wid & 3, fr = lane & 15, fq = lane >> 4;
    const int K = g.K, nt = K / BK;
    unsigned voffA[2], voffB[2];
#pragma unroll
    for (int i = 0; i < 2; ++i) { int R, C; stage_rc(tid * 16 + i * 8192, R, C); const int Rb = Epi::PERM ? ((R & ~31) + perm32(R & 31)) : R;
        voffA[i] = (unsigned)(R * K + C) * 2u; voffB[i] = (unsigned)(Rb * K + C) * 2u; }
    const size_t kstep = (size_t)(BK * 2);
    const size_t hstep = (size_t)HALF * K * 2;
    const size_t tstep = 2 * hstep;
    const unsigned ldsw = (unsigned)wid * 1024u;
    const int aoff = lds_byte(wr * 64 + fr, fq * 8), boff = lds_byte(wc * 32 + fr, fq * 8);
#define PG8_SA(b, h) (((b) * 2 + (h)) * HTB)
#define PG8_SB(b, h) ((4 + (b) * 2 + (h)) * HTB)
#define PG8_STAGE(bufoff, gbase, voff) do { _Pragma("unroll") for (int _i = 0; _i < 2; ++_i) \
        __builtin_amdgcn_global_load_lds((const unsigned*)((const char*)(gbase) + (voff)[_i]), (PG8_LAS unsigned*)(lds + (bufoff) + ldsw + _i * 8192), 16, 0, 0); } while (0)
#define PG8_LDA(dst, b, h) do { _Pragma("unroll") for (int m = 0; m < 4; ++m) _Pragma("unroll") for (int k = 0; k < 2; ++k) dst[m][k] = *(const PG8_LAS bf16x8*)(lds + PG8_SA(b, h) + aoff + m * 2048 + k * 1024); } while (0)
#define PG8_LDB(dst, b, h) do { _Pragma("unroll") for (int n = 0; n < 2; ++n) _Pragma("unroll") for (int k = 0; k < 2; ++k) dst[n][k] = *(const PG8_LAS bf16x8*)(lds + PG8_SB(b, h) + boff + n * 2048 + k * 1024); } while (0)
#define PG8_MMA(ai, bj, At, Bt) do { __builtin_amdgcn_s_setprio(1); _Pragma("unroll") for (int m = 0; m < 4; ++m) _Pragma("unroll") for (int n = 0; n < 2; ++n) _Pragma("unroll") for (int k = 0; k < 2; ++k) \
        acc[ai][bj][m][n] = __builtin_amdgcn_mfma_f32_16x16x32_bf16(Bt[n][k], At[m][k], acc[ai][bj][m][n], 0, 0, 0); __builtin_amdgcn_s_setprio(0); } while (0)
#define PG8_WAIT_V(n) asm volatile("s_waitcnt vmcnt(" #n ")" ::: "memory")
#define PG8_WAIT_L(n) asm volatile("s_waitcnt lgkmcnt(" #n ")" ::: "memory")
#define PG8_BAR __builtin_amdgcn_s_barrier()
#define PG8_SCHED __builtin_amdgcn_sched_barrier(0)
    Unit cur, nxt; int ui = 0;
    if (!S.next(0, cur)) return;
    f32x4 acc[2][2][4][2];
#pragma unroll
    for (int a = 0; a < 2; ++a)
#pragma unroll
        for (int b = 0; b < 2; ++b)
#pragma unroll
            for (int m = 0; m < 4; ++m)
#pragma unroll
                for (int n = 0; n < 2; ++n) acc[a][b][m][n] = (f32x4){0.f, 0.f, 0.f, 0.f};
    bf16x8 At[4][2], B0[2][2], B1[2][2];
    const char* cA = (const char*)g.A + (size_t)cur.pm * tstep; const char* cB = (const char*)g.Bt + (size_t)cur.pn * tstep;
    S.a_ready(cur);
    if constexpr (SP2) {
        PG8_STAGE(PG8_SB(0, 0), cB, voffB); PG8_STAGE(PG8_SB(0, 1), cB + hstep, voffB); PG8_STAGE(PG8_SA(0, 0), cA, voffA); PG8_STAGE(PG8_SA(0, 1), cA + hstep, voffA);
        if (wr == 1) PG8_BAR;
        PG8_WAIT_V(2); PG8_BAR;
        PG8_STAGE(PG8_SB(1, 0), cB + kstep, voffB); PG8_STAGE(PG8_SA(1, 0), cA + kstep, voffA); PG8_STAGE(PG8_SB(1, 1), cB + hstep + kstep, voffB);
        PG8_WAIT_V(6); PG8_BAR;
    } else {
        PG8_STAGE(PG8_SB(0, 0), cB, voffB); PG8_STAGE(PG8_SA(0, 0), cA, voffA); PG8_STAGE(PG8_SB(0, 1), cB + hstep, voffB); PG8_STAGE(PG8_SA(0, 1), cA + hstep, voffA);
        if (wr == 1) PG8_BAR;
        PG8_WAIT_V(4); PG8_BAR;
        PG8_STAGE(PG8_SB(1, 0), cB + kstep, voffB); PG8_STAGE(PG8_SA(1, 0), cA + kstep, voffA); PG8_STAGE(PG8_SB(1, 1), cB + hstep + kstep, voffB);
        PG8_WAIT_V(6); PG8_BAR;
    }
    for (;;) {
        const bool has_next = S.next(ui + 1, nxt);
        const char* nA = has_next ? (const char*)g.A + (size_t)nxt.pm * tstep : cA; const char* nB = has_next ? (const char*)g.Bt + (size_t)nxt.pn * tstep : cB;
#pragma unroll 1
        for (int t = 0; t < nt; t += 2) {
            const bool last = (t == nt - 2);
            const char* a1 = cA + (size_t)(t + 1) * kstep;
            const char* a2 = last ? nA : cA + (size_t)(t + 2) * kstep; const char* b2 = last ? nB : cB + (size_t)(t + 2) * kstep;
            const char* a3 = a2 + kstep; const char* b3 = b2 + kstep;
            if (last && has_next) S.a_ready(nxt);
            if constexpr (SP2) {
            PG8_LDB(B0, 0, 0); PG8_LDB(B1, 0, 1); PG8_SCHED; PG8_LDA(At, 0, 0); PG8_STAGE(PG8_SA(1, 1), a1 + hstep, voffA);
            PG8_WAIT_V(8); PG8_WAIT_L(0); PG8_BAR; PG8_MMA(0, 0, At, B0); PG8_MMA(0, 1, At, B1); PG8_BAR; PG8_SCHED;
            PG8_LDA(At, 0, 1); PG8_STAGE(PG8_SB(0, 0), b2, voffB); PG8_STAGE(PG8_SB(0, 1), b2 + hstep, voffB); PG8_STAGE(PG8_SA(0, 0), a2, voffA);
            PG8_WAIT_V(8); PG8_WAIT_L(0); PG8_BAR; PG8_MMA(1, 0, At, B0); PG8_MMA(1, 1, At, B1); PG8_BAR; PG8_SCHED;
            PG8_LDB(B0, 1, 0); PG8_LDB(B1, 1, 1); PG8_SCHED; PG8_LDA(At, 1, 0); PG8_STAGE(PG8_SA(0, 1), a2 + hstep, voffA);
            PG8_WAIT_V(8); PG8_WAIT_L(0); PG8_BAR; PG8_MMA(0, 0, At, B0); PG8_MMA(0, 1, At, B1); PG8_BAR; PG8_SCHED;
            PG8_LDA(At, 1, 1); PG8_STAGE(PG8_SB(1, 0), b3, voffB); PG8_STAGE(PG8_SB(1, 1), b3 + hstep, voffB); PG8_STAGE(PG8_SA(1, 0), a3, voffA);
            PG8_WAIT_V(8); PG8_WAIT_L(0); PG8_BAR; PG8_MMA(1, 0, At, B0); PG8_MMA(1, 1, At, B1); PG8_BAR; PG8_SCHED;
            } else {
            PG8_LDB(B0, 0, 0); PG8_SCHED; PG8_LDA(At, 0, 0); PG8_STAGE(PG8_SA(1, 1), a1 + hstep, voffA);
            PG8_WAIT_L(8); PG8_BAR; PG8_WAIT_L(0); PG8_MMA(0, 0, At, B0); PG8_BAR; PG8_SCHED;
            PG8_LDB(B1, 0, 1); PG8_STAGE(PG8_SB(0, 0), b2, voffB);
            PG8_BAR; PG8_WAIT_L(0); PG8_MMA(0, 1, At, B1); PG8_BAR;
            PG8_LDA(At, 0, 1); PG8_STAGE(PG8_SA(0, 0), a2, voffA);
            PG8_BAR; PG8_WAIT_L(0); PG8_MMA(1, 0, At, B0); PG8_BAR; PG8_SCHED;
            PG8_STAGE(PG8_SB(0, 1), b2 + hstep, voffB);
            PG8_WAIT_V(6); PG8_BAR; PG8_MMA(1, 1, At, B1); PG8_BAR;
            PG8_LDB(B0, 1, 0); PG8_SCHED; PG8_LDA(At, 1, 0); PG8_STAGE(PG8_SA(0, 1), a2 + hstep, voffA);
            PG8_WAIT_L(8); PG8_BAR; PG8_WAIT_L(0); PG8_MMA(0, 0, At, B0); PG8_BAR; PG8_SCHED;
            PG8_LDB(B1, 1, 1); PG8_STAGE(PG8_SB(1, 0), b3, voffB);
            PG8_BAR; PG8_WAIT_L(0); PG8_MMA(0, 1, At, B1); PG8_BAR;
            PG8_LDA(At, 1, 1); PG8_STAGE(PG8_SA(1, 0), a3, voffA);
            PG8_BAR; PG8_WAIT_L(0); PG8_MMA(1, 0, At, B0); PG8_BAR; PG8_SCHED;
            PG8_STAGE(PG8_SB(1, 1), b3 + hstep, voffB);
            PG8_WAIT_V(6); PG8_BAR; PG8_MMA(1, 1, At, B1); PG8_BAR;
            }
        }
        if constexpr (ALIGN_EPI) { if (wr == 0) PG8_BAR; }
        if constexpr (!Epi::AFTER_DRAIN) { E(acc, cur, wr, wc, fr, fq); S.done(cur); }
        if (!has_next) break;
#pragma unroll
        for (int a = 0; a < 2; ++a)
#pragma unroll
            for (int b = 0; b < 2; ++b)
#pragma unroll
                for (int m = 0; m < 4; ++m)
#pragma unroll
                    for (int n = 0; n < 2; ++n) acc[a][b][m][n] = (f32x4){0.f, 0.f, 0.f, 0.f};
        cur = nxt; cA = nA; cB = nB; ++ui;
        if constexpr (ALIGN_EPI) { if (wr == 1) PG8_BAR; }
    }
    PG8_WAIT_V(0);
    if constexpr (!ALIGN_EPI) { if (wr == 0) PG8_BAR; }
    PG8_BAR;
    if constexpr (Epi::AFTER_DRAIN) { E.fused(acc, cur, wr, wc, fr, fq, lds, wid, lane); S.done(cur); }
#undef PG8_SA
#undef PG8_SB
#undef PG8_STAGE
#undef PG8_LDA
#undef PG8_LDB
#undef PG8_MMA
#undef PG8_WAIT_V
#undef PG8_WAIT_L
#undef PG8_BAR
#undef PG8_SCHED
}
}

using pg8::Unit;
typedef const f32x4 (&AccRef)[2][2][4][2];

struct EpiSwiglu {
    static constexpr bool PERM = true, AFTER_DRAIN = false;
    bf16* O;
    __device__ __forceinline__ void operator()(AccRef acc, const Unit& u, int wr, int wc, int fr, int fq) const {
        const int row0 = u.pm * 256 + wr * 64 + fr, col0 = u.pn * 128 + wc * 32 + 8 * fq;
#pragma unroll
        for (int ai = 0; ai < 2; ++ai)
#pragma unroll
            for (int m = 0; m < 4; ++m) {
                const f32x4 g0 = acc[ai][0][m][0], g1 = acc[ai][0][m][1], u0 = acc[ai][1][m][0], u1 = acc[ai][1][m][1];
                float v[8];
#pragma unroll
                for (int i = 0; i < 4; ++i) { v[i] = g0[i] * __builtin_amdgcn_rcpf(1.0f + __expf(-g0[i])) * u0[i]; v[4 + i] = g1[i] * __builtin_amdgcn_rcpf(1.0f + __expf(-g1[i])) * u1[i]; }
                u32x4 w; w.x = pk2(v[0], v[1]); w.y = pk2(v[2], v[3]); w.z = pk2(v[4], v[5]); w.w = pk2(v[6], v[7]);
                *(u32x4*)(O + (size_t)(row0 + ai * 128 + m * 16) * DFF + col0) = w;
            }
    }
};
struct EpiResid {
    static constexpr bool PERM = false, AFTER_DRAIN = false;
    const float* xin_p; const float* xin_s; float* xout; const float* gate_base; float coef;
    __device__ __forceinline__ void operator()(AccRef acc, const Unit& u, int wr, int wc, int fr, int fq) const {
        const int cond = u.pm < 32 ? 0 : 1 + ((u.pm - 32) >> 2);
        const float* gate = gate_base + (size_t)cond * 9216;
        const int row0 = u.pm * 256 + wr * 64 + fr, col0 = u.pn * 256 + wc * 32 + 4 * fq;
        f32x4 gv[2][2];
#pragma unroll
        for (int bj = 0; bj < 2; ++bj)
#pragma unroll
            for (int n = 0; n < 2; ++n) gv[bj][n] = *(const f32x4*)(gate + col0 + bj * 128 + n * 16) * coef;
#pragma unroll
        for (int ai = 0; ai < 2; ++ai)
#pragma unroll
            for (int m = 0; m < 4; ++m) {
                const int row = row0 + ai * 128 + m * 16;
                const float* xr = (row < MP ? xin_p + (size_t)row * DM : xin_s + (size_t)(row - MP) * DM) + col0;
                float* xo = xout + (size_t)row * DM + col0;
#pragma unroll
                for (int bj = 0; bj < 2; ++bj)
#pragma unroll
                    for (int n = 0; n < 2; ++n) { const f32x4 xv = *(const f32x4*)(xr + bj * 128 + n * 16); *(f32x4*)(xo + bj * 128 + n * 16) = xv + gv[bj][n] * acc[ai][bj][m][n]; }
            }
    }
};
struct EpiStore {
    static constexpr bool PERM = true, AFTER_DRAIN = false;
    bf16* O; int ldc; int ncols;
    __device__ __forceinline__ void operator()(AccRef acc, const Unit& u, int wr, int wc, int fr, int fq) const {
        const int row0 = u.pm * 256 + wr * 64 + fr, col0 = u.pn * 256 + wc * 32 + 8 * fq;
#pragma unroll
        for (int ai = 0; ai < 2; ++ai)
#pragma unroll
            for (int m = 0; m < 4; ++m) {
                bf16* rowp = O + (size_t)(row0 + ai * 128 + m * 16) * ldc;
#pragma unroll
                for (int bj = 0; bj < 2; ++bj) { const int col = col0 + bj * 128; const f32x4 v0 = acc[ai][bj][m][0], v1 = acc[ai][bj][m][1];
                    u32x4 w; w.x = pk2(v0[0], v0[1]); w.y = pk2(v0[2], v0[3]); w.z = pk2(v1[0], v1[1]); w.w = pk2(v1[2], v1[3]);
                    if (col < ncols) *(u32x4*)(rowp + col) = w; }
            }
    }
};
struct EpiLora {
    static constexpr bool PERM = true, AFTER_DRAIN = false;
    bf16* O; const float* w0; const float* a0;
    __device__ __forceinline__ void operator()(AccRef acc, const Unit& u, int wr, int wc, int fr, int fq) const {
        const int seg = u.pn >> 1;
        const float* bias = seg < 2 ? w0 + seg * 512 : a0 + (seg & 1) * 512;
        const int row0 = u.pm * 256 + wr * 64 + fr, ct0 = wc * 32 + 8 * fq;
#pragma unroll
        for (int bj = 0; bj < 2; ++bj) {
            const int cseg = (u.pn & 1) * 256 + ct0 + bj * 128;
            f32x4 b0 = {0.f, 0.f, 0.f, 0.f}, b1 = {0.f, 0.f, 0.f, 0.f};
            if (seg < 4) { b0 = *(const f32x4*)(bias + cseg); b1 = *(const f32x4*)(bias + cseg + 4); }
#pragma unroll
            for (int ai = 0; ai < 2; ++ai)
#pragma unroll
                for (int m = 0; m < 4; ++m) {
                    f32x4 v0 = acc[ai][bj][m][0] + b0, v1 = acc[ai][bj][m][1] + b1;
                    if (seg < 4) {
                        const float sc = seg < 2 ? 0.60653066f : 1.0f;
#pragma unroll
                        for (int i = 0; i < 4; ++i) { v0[i] = sc * sigmoidf_(v0[i]); v1[i] = sc * sigmoidf_(v1[i]); }
                    }
                    u32x4 w; w.x = pk2(v0[0], v0[1]); w.y = pk2(v0[2], v0[3]); w.z = pk2(v1[0], v1[1]); w.w = pk2(v1[2], v1[3]);
                    *(u32x4*)(O + (size_t)(row0 + ai * 128 + m * 16) * 2560 + u.pn * 256 + ct0 + bj * 128) = w;
                    asm volatile("" ::: "memory");
                }
        }
    }
};
struct EpiQ {
    static constexpr bool PERM = true, AFTER_DRAIN = false;
    bf16* O; const float* rope;
    __device__ __forceinline__ void operator()(AccRef acc, const Unit& u, int wr, int wc, int fr, int fq) const {
        const int row0 = u.pm * 256 + wr * 64 + fr, col0 = u.pn * 256 + wc * 32 + 8 * fq;
        const float qs = 0.10206207261596577f;
#pragma unroll
        for (int bj = 0; bj < 2; ++bj) {
            const int col = col0 + bj * 128, e0 = col % 96;
            const bool is_rope = e0 >= 64;
#pragma unroll
            for (int ai = 0; ai < 2; ++ai)
#pragma unroll
                for (int m = 0; m < 4; ++m) {
                    const int row = row0 + ai * 128 + m * 16;
                    f32x4 v0 = acc[ai][bj][m][0] * qs, v1 = acc[ai][bj][m][1] * qs;
                    if (is_rope && row >= MP) {
                        const int t = (row - MP) & 1023;
                        const float* rt = rope + (size_t)t * 32 + (e0 - 64);
                        const f32x4 c0 = *(const f32x4*)(rt), c1 = *(const f32x4*)(rt + 4);
                        f32x4 r0, r1;
                        r0[0] = v0[0] * c0[0] - v0[1] * c0[1]; r0[1] = v0[0] * c0[1] + v0[1] * c0[0];
                        r0[2] = v0[2] * c0[2] - v0[3] * c0[3]; r0[3] = v0[2] * c0[3] + v0[3] * c0[2];
                        r1[0] = v1[0] * c1[0] - v1[1] * c1[1]; r1[1] = v1[0] * c1[1] + v1[1] * c1[0];
                        r1[2] = v1[2] * c1[2] - v1[3] * c1[3]; r1[3] = v1[2] * c1[3] + v1[3] * c1[2];
                        v0 = r0; v1 = r1;
                    }
                    u32x4 w; w.x = pk2(v0[0], v0[1]); w.y = pk2(v0[2], v0[3]); w.z = pk2(v1[0], v1[1]); w.w = pk2(v1[2], v1[3]);
                    *(u32x4*)(O + (size_t)row * 768 + col) = w;
                    asm volatile("" ::: "memory");
                }
        }
    }
};

__device__ __forceinline__ void ph_adaln(const P& p, LAS unsigned char* lds) {
    LAS float* scv = (LAS float*)lds;
    LAS float* red = scv + 9 * 1024;
    const int tid = tid_opaque(), tx = tid & 15, ty = tid >> 4;
    const float* cc = p.in[6]; const float* cctx = p.in[7];
    float* mod = (float*)(p.ws + WS_MOD);
    for (int i = tid; i < 9 * 1024; i += NTHREADS) { const int c = i >> 10, k = i & 1023; const float v = c == 0 ? cctx[k] : cc[(c - 1) * 1024 + k]; scv[i] = v / (1.0f + expf(-v)); }
    __syncthreads();
    for (int item = blockIdx.x; item < 288; item += gridDim.x) {
        const int l = item / 144, cgp = item % 144, col0 = cgp * 64 + tx * 4;
        const float* W = p.in[8] + (size_t)l * 1024 * 9216;
        f32x4 acc[9];
#pragma unroll
        for (int c = 0; c < 9; ++c) acc[c] = (f32x4){0.f, 0.f, 0.f, 0.f};
        for (int kk = 0; kk < 32; ++kk) {
            const int k = ty * 32 + kk;
            const f32x4 w = *(const f32x4*)(W + (size_t)k * 9216 + col0);
#pragma unroll
            for (int c = 0; c < 9; ++c) acc[c] += w * scv[c * 1024 + k];
        }
#pragma unroll
        for (int c = 0; c < 9; ++c) *(LAS f32x4*)(red + ty * 576 + c * 64 + tx * 4) = acc[c];
        __syncthreads();
        for (int o = tid; o < 576; o += NTHREADS) {
            float s = 0.f;
            for (int y = 0; y < 32; ++y) s += red[y * 576 + o];
            const int c = o >> 6, j = o & 63;
            mod[(size_t)(l * 9 + c) * 9216 + cgp * 64 + j] = s + p.in[9][l * 9216 + cgp * 64 + j];
        }
        __syncthreads();
    }
    float* rope = (float*)(p.ws + WS_ROPE);
    for (int idx = blockIdx.x * NTHREADS + tid; idx < 1024 * 16; idx += gridDim.x * NTHREADS) {
        const int t = idx >> 4, i = idx & 15;
        const float pos = (float)(i < 8 ? (t >> 6) : (t & 63));
        const float inv = powf(10000.0f, -(float)(i & 7) / 8.0f);
        const float ang = pos * inv;
        rope[idx * 2] = cosf(ang); rope[idx * 2 + 1] = sinf(ang);
    }
}

__device__ __forceinline__ void norm_rows(const P& p, int layer, int j, const float* gvec, bool from_input) {
    const int tid = tid_opaque(), lane = tid & 63, wave = tid >> 6;
    const float* mod = (const float*)(p.ws + WS_MOD);
    const float* x = p.out;
    bf16* h = (bf16*)(p.ws + WS_H);
    for (int row = blockIdx.x * 8 + wave; row < M_TOK; row += gridDim.x * 8) {
        const float* xr = from_input ? (row < MP ? p.in[0] + (size_t)row * DM : p.in[1] + (size_t)(row - MP) * DM) : x + (size_t)row * DM;
        const float* mrow = mod + (size_t)(layer * 9 + cond_of_row(row)) * 9216;
        const float* sh = mrow + (3 * j) * 1024; const float* sc = mrow + (3 * j + 1) * 1024;
        f32x4 v[4]; float ss = 0.f;
#pragma unroll
        for (int q = 0; q < 4; ++q) { v[q] = *(const f32x4*)(xr + lane * 4 + 256 * q); ss += v[q].x * v[q].x + v[q].y * v[q].y + v[q].z * v[q].z + v[q].w * v[q].w; }
        const float rstd = 1.0f / sqrtf(wave_sum(ss) * (1.0f / 1024.0f) + 1e-6f);
#pragma unroll
        for (int q = 0; q < 4; ++q) {
            const int col = lane * 4 + 256 * q;
            const f32x4 g = *(const f32x4*)(gvec + col), s1 = *(const f32x4*)(sc + col), s0 = *(const f32x4*)(sh + col);
            const f32x4 y = (v[q] * rstd * g) * (s1 + 1.0f) + s0;
            *(u32x2*)(h + (size_t)row * DM + col) = pk4(y);
        }
    }
}
__device__ __forceinline__ void final_norm_rows(const P& p) {
    const int tid = tid_opaque(), lane = tid & 63, wave = tid >> 6;
    float* x = p.out; const float* gvec = p.in[47];
    for (int row = blockIdx.x * 8 + wave; row < M_TOK; row += gridDim.x * 8) {
        float* xr = x + (size_t)row * DM;
        f32x4 v[4]; float ss = 0.f;
#pragma unroll
        for (int q = 0; q < 4; ++q) { v[q] = *(const f32x4*)(xr + lane * 4 + 256 * q); ss += v[q].x * v[q].x + v[q].y * v[q].y + v[q].z * v[q].z + v[q].w * v[q].w; }
        const float rstd = 1.0f / sqrtf(wave_sum(ss) * (1.0f / 1024.0f) + 1e-6f);
#pragma unroll
        for (int q = 0; q < 4; ++q) { const int col = lane * 4 + 256 * q; *(f32x4*)(xr + col) = v[q] * rstd * *(const f32x4*)(gvec + col); }
    }
}

template <int MODE>
__device__ __forceinline__ void transpose_w(const float* W, int ldw, int ncols_valid, int K, bf16* WT, int Nt, LAS unsigned char* lds) {
    const int tid = tid_opaque(), lane = tid & 63, wave = tid >> 6;
    LAS float* scr = (LAS float*)(lds + wave * 8448);
    const int nblk = Nt / 32, nitems = nblk * (K / 64);
    for (int it = blockIdx.x * 8 + wave; it < nitems; it += gridDim.x * 8) {
        const int kb = it / nblk, nb = it % nblk, k0 = kb * 64;
        const int sc0 = MODE == 1 ? (((nb >> 2) & 1) * DFF + (nb >> 3) * 128 + (nb & 3) * 32) : nb * 32;
        const int n = lane & 31; const bool ok = (sc0 + n) < ncols_valid;
#pragma unroll 8
        for (int i = 0; i < 32; ++i) { const int kk = 2 * i + (lane >> 5); scr[kk * 33 + n] = ok ? W[(size_t)(k0 + kk) * ldw + sc0 + n] : 0.f; }
        LDS_WAIT();
        const int c = lane & 7;
#pragma unroll
        for (int j = 0; j < 4; ++j) {
            const int nn = (lane >> 3) + 8 * j; const LAS float* s = scr + (8 * c) * 33 + nn;
            u32x4 o; o.x = pk2(s[0 * 33], s[1 * 33]); o.y = pk2(s[2 * 33], s[3 * 33]); o.z = pk2(s[4 * 33], s[5 * 33]); o.w = pk2(s[6 * 33], s[7 * 33]);
            *(u32x4*)(WT + (size_t)(nb * 32 + nn) * K + k0 + 8 * c) = o;
        }
        LDS_WAIT();
    }
}
__device__ __forceinline__ void convert_ffn_weights(const P& p, int layer, int which, LAS unsigned char* lds) {
    const float* wgu = p.in[which == 0 ? 13 : 15] + (size_t)layer * 1024 * 5632;
    const float* wdn = p.in[which == 0 ? 14 : 16] + (size_t)layer * 2816 * 1024;
    transpose_w<1>(wgu, 5632, 5632, 1024, (bf16*)(p.ws + W_GU), 5632, lds);
    transpose_w<0>(wdn, 1024, 1024, 2816, (bf16*)(p.ws + W_DOWN), 1024, lds);
}
__device__ __forceinline__ void build_lora_w(const P& p) {
    bf16* WT = (bf16*)(p.ws + W_LORA);
    const float* w_up = p.in[21]; const float* a_up = p.in[23]; const float* g_up = p.in[24];
    for (int idx = blockIdx.x * NTHREADS + tid_opaque(); idx < 2560 * 384; idx += gridDim.x * NTHREADS) {
        const int k = idx / 2560, n = idx % 2560, seg = n >> 9, c = n & 511;
        float v = 0.f;
        if (seg == 0) { if (k < 64) v = w_up[(0 * 64 + k) * 512 + c]; }
        else if (seg == 1) { if (k >= 64 && k < 128) v = w_up[(1 * 64 + k - 64) * 512 + c]; }
        else if (seg == 2) { if (k >= 128 && k < 192) v = a_up[(0 * 64 + k - 128) * 512 + c]; }
        else if (seg == 3) { if (k >= 192 && k < 256) v = a_up[(1 * 64 + k - 192) * 512 + c]; }
        else { if (k >= 256) v = g_up[(k - 256) * 512 + c]; }
        WT[(size_t)n * 384 + k] = (bf16)(pk2(v, 0.f) & 0xffffu);
    }
}

__device__ __forceinline__ void ph_lora_in(const P& p) {
    const int tid = tid_opaque(), lane = tid & 63, wave = tid >> 6;
    const bf16* p0 = (const bf16*)(p.ws + WS_R1); bf16* LA = (bf16*)(p.ws + WS_H);
    const float* mu = p.in[19];
    for (int row = blockIdx.x * 8 + wave; row < M_TOK; row += gridDim.x * 8) {
        const int t = row < MP ? (row & 255) : ((row - MP) & 1023), L = row < MP ? 256 : 1024;
        const bool hp = t > 0, hn = t < L - 1;
#pragma unroll
        for (int ch = 0; ch < 3; ++ch) {
            const int col = 1536 + ch * 128 + lane * 2;
            const bf16* pc = p0 + (size_t)row * LDP0 + col;
            const unsigned cur = *(const unsigned*)pc, prv = hp ? *(const unsigned*)(pc - LDP0) : 0u, nxt = hn ? *(const unsigned*)(pc + LDP0) : 0u;
            float m0 = bflo(cur) + mu[col] * (0.5f * (bflo(prv) + bflo(nxt)) - bflo(cur));
            float m1 = bfhi(cur) + mu[col + 1] * (0.5f * (bfhi(prv) + bfhi(nxt)) - bfhi(cur));
            if (ch == 0) { m0 = tanhf(m0); m1 = tanhf(m1); }
            if (ch == 2) { m0 = 1.0f / (1.0f + expf(-m0)); m1 = 1.0f / (1.0f + expf(-m1)); }
            *(unsigned*)(LA + (size_t)row * 384 + ch * 128 + lane * 2) = pk2(m0, m1);
        }
    }
}

template <int KD, int T, bool GDN>
__device__ __forceinline__ void scan_item(const P& p, LAS unsigned char* lds, int kind, int b, int head, int dir, int half) {
    constexpr int KPL = KD / 8, SLOT = 5 * KD + 64;
    LAS float* opsbuf = (LAS float*)lds;
    LAS float* ybuf = opsbuf + 2 * T * SLOT;
    const int tid = tid_opaque(), lane = tid & 63, wave = tid >> 6, q = lane & 7, vl = lane >> 3, lrow = wave * 8 + vl;
    const int L = kind ? 1024 : 256, rowbase = kind ? MP + b * 1024 : b * 256, nblk = L / T;
    const bf16* p0 = (const bf16*)(p.ws + WS_R1);
    const bf16* lo = (const bf16*)(p.ws + WS_R2);
    bf16* Y = (bf16*)(p.ws + (dir == 0 ? WS_MIX : WS_H));
    const int colbase = GDN ? 512 + head * 128 + half * 64 : head * 64;
    constexpr int TPS = KD / 4;
    const int tt = tid / TPS, cgi = tid % TPS, c4 = cgi * 4;
    f32x4 cA, cB, cC, cD, cE;
    float gA = 0.f, gB = 0.f;
    if (!GDN) {
        const int C = head * 64 + c4;
        cA = *(const f32x4*)(p.in[19] + C); cB = *(const f32x4*)(p.in[19] + 512 + C); cC = *(const f32x4*)(p.in[19] + 1024 + C);
        cD = *(const f32x4*)(p.in[25] + C); cE = *(const f32x4*)(p.in[26] + C);
    } else {
        gA = -expf(p.in[31][dir * 4 + head]); gB = p.in[32][dir * 4 + head];
    }
    float S[KPL];
    if (kind) {
        if (!GDN) { const float* s0 = p.in[2] + ((((size_t)b * 2 + dir) * 8 + head) * 64 + lrow) * 64 + q * 8;
            const f32x4 a = *(const f32x4*)s0, bq = *(const f32x4*)(s0 + 4);
#pragma unroll
            for (int i = 0; i < 4; ++i) { S[i] = a[i]; S[4 + i] = bq[i]; } }
        else { const float* s0 = p.in[3] + (((size_t)b * 2 + dir) * 4 + head) * 16384 + half * 64 + lrow;
#pragma unroll
            for (int i = 0; i < KPL; ++i) S[i] = s0[(size_t)(q * KPL + i) * 128]; }
    } else {
#pragma unroll
        for (int i = 0; i < KPL; ++i) S[i] = 0.f;
    }
    u32x2 ra0, ra1, ra2, rb0, rb1, rb2, rc0, rc1, rc2, rd, re; unsigned rab = 0u, rbb = 0u;
    const u32x2 z2 = {0u, 0u};
#define SCAN_LOAD(blk) do { \
        const int n_ = (blk) * T + tt, t_ = dir ? L - 1 - n_ : n_; const size_t row_ = (size_t)(rowbase + t_); \
        const bool hp_ = t_ > 0, hn_ = t_ < L - 1; \
        if (!GDN) { const bf16* pr_ = p0 + row_ * LDP0 + head * 64 + c4; \
            ra1 = *(const u32x2*)pr_; ra0 = hp_ ? *(const u32x2*)(pr_ - LDP0) : z2; ra2 = hn_ ? *(const u32x2*)(pr_ + LDP0) : z2; \
            rb1 = *(const u32x2*)(pr_ + 512); rb0 = hp_ ? *(const u32x2*)(pr_ + 512 - LDP0) : z2; rb2 = hn_ ? *(const u32x2*)(pr_ + 512 + LDP0) : z2; \
            rc1 = *(const u32x2*)(pr_ + 1024); rc0 = hp_ ? *(const u32x2*)(pr_ + 1024 - LDP0) : z2; rc2 = hn_ ? *(const u32x2*)(pr_ + 1024 + LDP0) : z2; \
            rd = *(const u32x2*)(lo + row_ * 2560 + dir * 512 + head * 64 + c4); re = *(const u32x2*)(lo + row_ * 2560 + 1024 + dir * 512 + head * 64 + c4); \
        } else { const bf16* pr_ = p0 + row_ * LDP0 + 1920 + head * 128 + c4; \
            ra1 = *(const u32x2*)pr_; ra0 = hp_ ? *(const u32x2*)(pr_ - LDP0) : z2; ra2 = hn_ ? *(const u32x2*)(pr_ + LDP0) : z2; \
            rb1 = *(const u32x2*)(pr_ + 512); rb0 = hp_ ? *(const u32x2*)(pr_ + 512 - LDP0) : z2; rb2 = hn_ ? *(const u32x2*)(pr_ + 512 + LDP0) : z2; \
            rc1 = *(const u32x2*)(pr_ + 1024); rc0 = hp_ ? *(const u32x2*)(pr_ + 1024 - LDP0) : z2; rc2 = hn_ ? *(const u32x2*)(pr_ + 1024 + LDP0) : z2; \
            rab = p0[row_ * LDP0 + 3968 + dir * 8 + head]; rbb = p0[row_ * LDP0 + 3968 + dir * 8 + 4 + head]; } \
    } while (0)
#define SCAN_PREP(bi) do { \
        LAS float* slot_ = opsbuf + ((bi) * T + tt) * SLOT; \
        if (!GDN) { \
            const f32x4 r1_ = unpk4(ra1), k1_ = unpk4(rb1), v1_ = unpk4(rc1); \
            const f32x4 r_ = r1_ + cA * ((unpk4(ra0) + unpk4(ra2)) * 0.5f - r1_); \
            const f32x4 k_ = k1_ + cB * ((unpk4(rb0) + unpk4(rb2)) * 0.5f - k1_); \
            const f32x4 v_ = v1_ + cC * ((unpk4(rc0) + unpk4(rc2)) * 0.5f - v1_); \
            f32x4 kk_ = k_ * cD; \
            const float ss_ = red16(kk_.x * kk_.x + kk_.y * kk_.y + kk_.z * kk_.z + kk_.w * kk_.w); \
            kk_ = kk_ * (1.0f / sqrtf(ss_ + 1e-6f)); \
            const f32x4 ew_ = unpk4(rd), a_ = unpk4(re); \
            f32x4 w_; w_.x = __expf(-ew_.x); w_.y = __expf(-ew_.y); w_.z = __expf(-ew_.z); w_.w = __expf(-ew_.w); \
            const f32x4 kd_ = k_ * ((a_ - 1.0f) * cE + 1.0f); \
            *(LAS f32x4*)(slot_ + 0 * KD + c4) = kk_; *(LAS f32x4*)(slot_ + 1 * KD + c4) = w_; *(LAS f32x4*)(slot_ + 2 * KD + c4) = kk_ * a_; \
            *(LAS f32x4*)(slot_ + 3 * KD + c4) = kd_; *(LAS f32x4*)(slot_ + 4 * KD + c4) = r_; *(LAS f32x4*)(slot_ + 5 * KD + c4) = v_; \
        } else { \
            const float* cw_ = p.in[30] + head * 128 + c4; \
            f32x4 q_ = *(const f32x4*)(cw_) * unpk4(ra0) + *(const f32x4*)(cw_ + 1536) * unpk4(ra1) + *(const f32x4*)(cw_ + 3072) * unpk4(ra2); \
            f32x4 k_ = *(const f32x4*)(cw_ + 512) * unpk4(rb0) + *(const f32x4*)(cw_ + 2048) * unpk4(rb1) + *(const f32x4*)(cw_ + 3584) * unpk4(rb2); \
            f32x4 v_ = *(const f32x4*)(cw_ + 1024) * unpk4(rc0) + *(const f32x4*)(cw_ + 2560) * unpk4(rc1) + *(const f32x4*)(cw_ + 4096) * unpk4(rc2); \
            _Pragma("unroll") for (int i_ = 0; i_ < 4; ++i_) { q_[i_] = q_[i_] / (1.0f + __expf(-q_[i_])); k_[i_] = k_[i_] / (1.0f + __expf(-k_[i_])); v_[i_] = v_[i_] / (1.0f + __expf(-v_[i_])); } \
            float sq_ = red16(q_.x * q_.x + q_.y * q_.y + q_.z * q_.z + q_.w * q_.w); sq_ += __shfl_xor(sq_, 16); \
            float sk_ = red16(k_.x * k_.x + k_.y * k_.y + k_.z * k_.z + k_.w * k_.w); sk_ += __shfl_xor(sk_, 16); \
            q_ = q_ * (0.08838834764831845f / sqrtf(sq_ + 1e-6f)); k_ = k_ * (1.0f / sqrtf(sk_ + 1e-6f)); \
            const float xa_ = bf2f(rab) + gB; const float sp_ = xa_ > 20.f ? xa_ : log1pf(expf(xa_)); \
            const float eg_ = expf(gA * sp_), beta_ = 1.0f / (1.0f + expf(-bf2f(rbb))); \
            *(LAS f32x4*)(slot_ + 0 * KD + c4) = k_; *(LAS f32x4*)(slot_ + 1 * KD + c4) = (f32x4){eg_, eg_, eg_, eg_}; *(LAS f32x4*)(slot_ + 2 * KD + c4) = k_ * (beta_ * eg_); \
            *(LAS f32x4*)(slot_ + 3 * KD + c4) = k_ * beta_; *(LAS f32x4*)(slot_ + 4 * KD + c4) = q_; \
            if ((cgi >> 4) == half) *(LAS f32x4*)(slot_ + 5 * KD + (cgi & 15) * 4) = v_; \
        } \
    } while (0)
    __syncthreads();
    SCAN_LOAD(0); SCAN_PREP(0);
    __syncthreads();
#pragma unroll 1
    for (int blk = 0; blk < nblk; ++blk) {
        const int bi = blk & 1;
        if (blk + 1 < nblk) SCAN_LOAD(blk + 1);
        const LAS float* ob = opsbuf + bi * T * SLOT; LAS float* yb = ybuf + bi * T * 64;
#pragma unroll 1
        for (int t = 0; t < T; ++t) {
            const LAS float* o = ob + t * SLOT;
            f32x2 kk[KPL / 2], w[KPL / 2], bb[KPL / 2], kd[KPL / 2], r[KPL / 2];
#pragma unroll
            for (int i = 0; i < KPL / 4; ++i) {
                const f32x4 a0 = *(const LAS f32x4*)(o + 0 * KD + q * KPL + 4 * i); kk[2 * i] = (f32x2){a0.x, a0.y}; kk[2 * i + 1] = (f32x2){a0.z, a0.w};
                const f32x4 a1 = *(const LAS f32x4*)(o + 1 * KD + q * KPL + 4 * i); w[2 * i] = (f32x2){a1.x, a1.y}; w[2 * i + 1] = (f32x2){a1.z, a1.w};
                const f32x4 a2 = *(const LAS f32x4*)(o + 2 * KD + q * KPL + 4 * i); bb[2 * i] = (f32x2){a2.x, a2.y}; bb[2 * i + 1] = (f32x2){a2.z, a2.w};
                const f32x4 a3 = *(const LAS f32x4*)(o + 3 * KD + q * KPL + 4 * i); kd[2 * i] = (f32x2){a3.x, a3.y}; kd[2 * i + 1] = (f32x2){a3.z, a3.w};
                const f32x4 a4 = *(const LAS f32x4*)(o + 4 * KD + q * KPL + 4 * i); r[2 * i] = (f32x2){a4.x, a4.y}; r[2 * i + 1] = (f32x2){a4.z, a4.w};
            }
            const float vv = o[5 * KD + lrow];
            f32x2 acc = {0.f, 0.f};
#pragma unroll
            for (int i = 0; i < KPL / 2; ++i) { const f32x2 s = {S[2 * i], S[2 * i + 1]}; acc = __builtin_elementwise_fma(s, kk[i], acc); }
            const float sk = red8(acc.x + acc.y);
            const f32x2 nsk = {-sk, -sk}, vv2 = {vv, vv};
            f32x2 ya = {0.f, 0.f};
#pragma unroll
            for (int i = 0; i < KPL / 2; ++i) {
                f32x2 s = {S[2 * i], S[2 * i + 1]};
                f32x2 tmp = vv2 * kd[i]; tmp = __builtin_elementwise_fma(nsk, bb[i], tmp); s = __builtin_elementwise_fma(s, w[i], tmp);
                S[2 * i] = s.x; S[2 * i + 1] = s.y; ya = __builtin_elementwise_fma(s, r[i], ya);
            }
            const float y = red8(ya.x + ya.y);
            if (q == 0) yb[t * 64 + lrow] = y;
        }
        if (blk + 1 < nblk) SCAN_PREP(bi ^ 1);
        __syncthreads();
        if (tid < T * 16) {
            const int ft = tid >> 4, r4 = (tid & 15) * 4;
            const int n = blk * T + ft, tk = dir ? L - 1 - n : n;
            const f32x4 yv = *(const LAS f32x4*)(yb + ft * 64 + r4);
            *(u32x2*)(Y + (size_t)(rowbase + tk) * 1024 + colbase + r4) = pk4(yv);
        }
    }
#undef SCAN_LOAD
#undef SCAN_PREP
    if (!kind) {
        if (!GDN) { float* so = p.out + OUT_SRW + ((((size_t)b * 2 + dir) * 8 + head) * 64 + lrow) * 64 + q * 8;
            *(f32x4*)so = (f32x4){S[0], S[1], S[2], S[3]}; *(f32x4*)(so + 4) = (f32x4){S[4], S[5], S[6], S[7]}; }
        else { float* so = p.out + OUT_SGD + (((size_t)b * 2 + dir) * 4 + head) * 16384 + half * 64 + lrow;
#pragma unroll
            for (int i = 0; i < KPL; ++i) so[(size_t)(q * KPL + i) * 128] = S[i]; }
    }
}
__device__ __forceinline__ void scan_dispatch(const P& p, LAS unsigned char* lds, int idx) {
#ifndef T_NO_RWKV
    if (idx < 640) { const int kind = idx < 128 ? 1 : 0, j = idx < 128 ? idx : idx - 128; scan_item<64, 32, false>(p, lds, kind, j >> 4, (j >> 1) & 7, j & 1, 0); }
#endif
#ifndef T_NO_GDN
    if (idx >= 640) { const int kind = idx < 768 ? 1 : 0, j = idx < 768 ? idx - 640 : idx - 768; scan_item<128, 16, true>(p, lds, kind, j >> 4, (j >> 2) & 3, (j >> 1) & 1, j & 1); }
#endif
}
__device__ __forceinline__ void ph_scan(const P& p, LAS unsigned char* lds) {
    const int B = blockIdx.x, G = gridDim.x;
    if (G == 256) {
        if (B < 128) { scan_dispatch(p, lds, 640 + B); scan_dispatch(p, lds, B); }
        else { const int j = B - 128;
            for (int i = 0; i < 4; ++i) scan_dispatch(p, lds, 768 + j * 4 + i);
            for (int i = 0; i < 4; ++i) scan_dispatch(p, lds, 128 + j * 4 + i); }
    } else {
        for (int i = B; i < 1280; i += G) scan_dispatch(p, lds, i);
    }
}

__device__ __forceinline__ void ph_post_ab(const P& p) {
    const int tid = tid_opaque(), lane = tid & 63, wave = tid >> 6;
    const bf16* p0 = (const bf16*)(p.ws + WS_R1); const bf16* lo = (const bf16*)(p.ws + WS_R2);
    bf16* MX = (bf16*)(p.ws + WS_MIX); const bf16* YB = (const bf16*)(p.ws + WS_H);
    const int C = lane * 8;
    float mur[8], muk[8], muv[8], ka[8], rk[8], lw[8], lb[8], gn[8];
#pragma unroll
    for (int i = 0; i < 8; ++i) { mur[i] = p.in[19][C + i]; muk[i] = p.in[19][512 + C + i]; muv[i] = p.in[19][1024 + C + i]; ka[i] = p.in[26][C + i]; rk[i] = p.in[27][C + i];
        lw[i] = p.in[28][C + i]; lb[i] = p.in[29][C + i]; gn[i] = p.in[33][(C + i) & 127]; }
    for (int row = blockIdx.x * 8 + wave; row < M_TOK; row += gridDim.x * 8) {
        const int t = row < MP ? (row & 255) : ((row - MP) & 1023), L = row < MP ? 256 : 1024;
        const bool hp = t > 0, hn = t < L - 1;
        const u32x4 z4 = {0u, 0u, 0u, 0u};
        const bf16* pr = p0 + (size_t)row * LDP0 + C;
        float r[8], k[8], v[8];
        {
            const u32x4 c = *(const u32x4*)pr, a = hp ? *(const u32x4*)(pr - LDP0) : z4, n = hn ? *(const u32x4*)(pr + LDP0) : z4;
#pragma unroll
            for (int i = 0; i < 4; ++i) { float c0 = bflo(c[i]), c1 = bfhi(c[i]); r[2 * i] = c0 + mur[2 * i] * (0.5f * (bflo(a[i]) + bflo(n[i])) - c0); r[2 * i + 1] = c1 + mur[2 * i + 1] * (0.5f * (bfhi(a[i]) + bfhi(n[i])) - c1); }
        }
        {
            const u32x4 c = *(const u32x4*)(pr + 512), a = hp ? *(const u32x4*)(pr + 512 - LDP0) : z4, n = hn ? *(const u32x4*)(pr + 512 + LDP0) : z4;
#pragma unroll
            for (int i = 0; i < 4; ++i) { float c0 = bflo(c[i]), c1 = bfhi(c[i]); k[2 * i] = c0 + muk[2 * i] * (0.5f * (bflo(a[i]) + bflo(n[i])) - c0); k[2 * i + 1] = c1 + muk[2 * i + 1] * (0.5f * (bfhi(a[i]) + bfhi(n[i])) - c1); }
        }
        {
            const u32x4 c = *(const u32x4*)(pr + 1024), a = hp ? *(const u32x4*)(pr + 1024 - LDP0) : z4, n = hn ? *(const u32x4*)(pr + 1024 + LDP0) : z4;
#pragma unroll
            for (int i = 0; i < 4; ++i) { float c0 = bflo(c[i]), c1 = bfhi(c[i]); v[2 * i] = c0 + muv[2 * i] * (0.5f * (bflo(a[i]) + bflo(n[i])) - c0); v[2 * i + 1] = c1 + muv[2 * i + 1] * (0.5f * (bfhi(a[i]) + bfhi(n[i])) - c1); }
        }
        const u32x4 af = *(const u32x4*)(lo + (size_t)row * 2560 + 1024 + C), ab = *(const u32x4*)(lo + (size_t)row * 2560 + 1536 + C), gg = *(const u32x4*)(lo + (size_t)row * 2560 + 2048 + C);
        const u32x4 yf = *(const u32x4*)(MX + (size_t)row * 1024 + C), yb = *(const u32x4*)(YB + (size_t)row * 1024 + C);
        float y[8], s = 0.f, bon = 0.f;
#pragma unroll
        for (int i = 0; i < 4; ++i) {
            y[2 * i] = bflo(yf[i]) + bflo(yb[i]); y[2 * i + 1] = bfhi(yf[i]) + bfhi(yb[i]); s += y[2 * i] + y[2 * i + 1];
            const float am0 = 0.5f * (bflo(af[i]) + bflo(ab[i])), am1 = 0.5f * (bfhi(af[i]) + bfhi(ab[i]));
            bon += r[2 * i] * k[2 * i] * (1.0f + (am0 - 1.0f) * ka[2 * i]) * rk[2 * i] + r[2 * i + 1] * k[2 * i + 1] * (1.0f + (am1 - 1.0f) * ka[2 * i + 1]) * rk[2 * i + 1];
        }
        const float mean = red8(s) * (1.0f / 64.0f); bon = red8(bon);
        float q2 = 0.f;
#pragma unroll
        for (int i = 0; i < 8; ++i) { y[i] -= mean; q2 += y[i] * y[i]; }
        const float rstd = 1.0f / sqrtf(red8(q2) * (1.0f / 64.0f) + 64e-5f);
        u32x4 o;
#pragma unroll
        for (int i = 0; i < 4; ++i) {
            const float o0 = (y[2 * i] * rstd * lw[2 * i] + lb[2 * i] + bon * v[2 * i]) * bflo(gg[i]);
            const float o1 = (y[2 * i + 1] * rstd * lw[2 * i + 1] + lb[2 * i + 1] + bon * v[2 * i + 1]) * bfhi(gg[i]);
            o[i] = pk2(o0, o1);
        }
        *(u32x4*)(MX + (size_t)row * 1024 + C) = o;
        const u32x4 of = *(const u32x4*)(MX + (size_t)row * 1024 + 512 + C), ob = *(const u32x4*)(YB + (size_t)row * 1024 + 512 + C);
        const u32x4 zz = *(const u32x4*)(p0 + (size_t)row * LDP0 + 1920 + 1536 + C);
        float og[8], so = 0.f;
#pragma unroll
        for (int i = 0; i < 4; ++i) { og[2 * i] = bflo(of[i]) + bflo(ob[i]); og[2 * i + 1] = bfhi(of[i]) + bfhi(ob[i]); so += og[2 * i] * og[2 * i] + og[2 * i + 1] * og[2 * i + 1]; }
        const float rs = 1.0f / sqrtf(red16(so) * (1.0f / 128.0f) + 1e-6f);
        u32x4 o2;
#pragma unroll
        for (int i = 0; i < 4; ++i) { const float z0 = bflo(zz[i]), z1 = bfhi(zz[i]);
            o2[i] = pk2(og[2 * i] * rs * gn[2 * i] * siluf_(z0), og[2 * i + 1] * rs * gn[2 * i + 1] * siluf_(z1)); }
        *(u32x4*)(MX + (size_t)row * 1024 + 512 + C) = o2;
    }
}

__device__ __forceinline__ void ph_hyena_filters(const P& p, LAS unsigned char* lds) {
    LAS float* f0 = (LAS float*)lds;
    LAS float* h1 = f0 + 4 * 36;
    LAS float* h2 = h1 + 4 * 64;
    const int tid = tid_opaque();
    const float* w1 = p.in[40]; const float* b1 = p.in[41]; const float* w2 = p.in[42]; const float* b2 = p.in[43]; const float* w3 = p.in[44]; const float* fr = p.in[45];
    for (int item = blockIdx.x; item < 320; item += gridDim.x) {
        const int ls = item < 256 ? 1 : 0;
        const int L = ls ? 1024 : 256, t0 = (ls ? item : item - 256) * 4;
        __syncthreads();
        if (tid < 4 * 33) {
            const int pi = tid / 33, f = tid % 33; const float t = (float)(t0 + pi);
            float v;
            if (f == 0) v = t / (float)(L - 1);
            else { const int bi = (f - 1) & 15; const float band = 1e-4f + (15.0f - 1e-4f) * ((float)bi / 15.0f); const float ang = (6.283185307179586f / (float)L) * t * band; v = f <= 16 ? cosf(ang) : -sinf(ang); }
            f0[pi * 36 + f] = v;
        }
        __syncthreads();
        if (tid < 256) { const int pi = tid >> 6, j = tid & 63; float s = b1[j];
#pragma unroll 3
            for (int f = 0; f < 33; ++f) s += f0[pi * 36 + f] * w1[f * 64 + j];
            h1[pi * 64 + j] = sinf(fr[j] * s); }
        __syncthreads();
        if (tid < 256) { const int pi = tid >> 6, j = tid & 63; float s = b2[j];
#pragma unroll 4
            for (int f = 0; f < 64; ++f) s += h1[pi * 64 + f] * w2[f * 64 + j];
            h2[pi * 64 + j] = sinf(fr[64 + j] * s); }
        __syncthreads();
        bf16* G = (bf16*)(p.ws + (ls ? WS_GFS : WS_GFP));
#pragma unroll 1
        for (int oo = 0; oo < 4; ++oo) {
            const int o = tid + oo * 512;
            const int order = o >> 10, dr = (o >> 9) & 1, c = o & 511;
            float s[4] = {0.f, 0.f, 0.f, 0.f};
#pragma unroll 4
            for (int f = 0; f < 64; ++f) { const float w = w3[f * 2048 + o];
#pragma unroll
                for (int pi = 0; pi < 4; ++pi) s[pi] += h2[pi * 64 + f] * w; }
            const float delta = 3.0701134573253944f + (15.350567286626973f - 3.0701134573253944f) * ((float)c / 511.0f);
#pragma unroll
            for (int pi = 0; pi < 4; ++pi) {
                const int t = t0 + pi; const float tn = (float)t / (float)(L - 1);
                const float val = s[pi] * expf(-tn * delta);
                bf16* g = G + ((size_t)order * 512 + c) * (2 * L);
                if (dr == 0) g[L - t] = (bf16)(pk2(val, 0.f) & 0xffffu);
                else if (t > 0) g[L + t] = (bf16)(pk2(val, 0.f) & 0xffffu);
                if (dr == 0 && t == 0) g[0] = 0;
            }
        }
    }
}

__device__ __forceinline__ void ph_mla_prep(const P& p, LAS unsigned char* lds) {
    const int tid = tid_opaque(), lane = tid & 63, wave = tid >> 6;
    const bf16* p1 = (const bf16*)(p.ws + WS_R1);
    bf16* qn = (bf16*)(p.ws + WS_H); bf16* ckva = (bf16*)(p.ws + WS_CKVA); bf16* kpea = (bf16*)(p.ws + WS_KPEA);
    const float* rope = (const float*)(p.ws + WS_ROPE);
    const float* qg = p.in[35]; const float* kg = p.in[37];
    for (int row = blockIdx.x * 8 + wave; row < M_TOK + 2048; row += gridDim.x * 8) {
        if (row < M_TOK) {
            const bf16* pr = p1 + (size_t)row * LDP1;
            float qv[6]; float ss = 0.f;
#pragma unroll
            for (int j = 0; j < 3; ++j) { const unsigned w = *(const unsigned*)(pr + j * 128 + lane * 2); qv[2 * j] = bflo(w); qv[2 * j + 1] = bfhi(w); ss += qv[2 * j] * qv[2 * j] + qv[2 * j + 1] * qv[2 * j + 1]; }
            const float rq = 1.0f / sqrtf(wave_sum(ss) * (1.0f / 384.0f) + 1e-6f);
#pragma unroll
            for (int j = 0; j < 3; ++j) { const int col = j * 128 + lane * 2; *(unsigned*)(qn + (size_t)row * 384 + col) = pk2(qv[2 * j] * rq * qg[col], qv[2 * j + 1] * rq * qg[col + 1]); }
            const f32x4 kv = unpk4(*(const u32x2*)(pr + 384 + lane * 4));
            const float rk = 1.0f / sqrtf(wave_sum(kv.x * kv.x + kv.y * kv.y + kv.z * kv.z + kv.w * kv.w) * (1.0f / 256.0f) + 1e-6f);
            const f32x4 ck = kv * rk * *(const f32x4*)(kg + lane * 4);
            *(u32x2*)(ckva + (size_t)row * 256 + lane * 4) = pk4(ck);
            if (row < MP) *(f32x4*)(p.out + OUT_CKV + (size_t)row * 256 + lane * 4) = ck;
            if (lane < 16) {
                const unsigned w = *(const unsigned*)(pr + 640 + lane * 2); float x1 = bflo(w), x2 = bfhi(w);
                if (row < MP) { *(f32x2*)(p.out + OUT_KPE + (size_t)row * 32 + lane * 2) = (f32x2){x1, x2}; }
                else { const int t = (row - MP) & 1023; const f32x2 cs = *(const f32x2*)(rope + (size_t)t * 32 + lane * 2); const float a = x1 * cs.x - x2 * cs.y, bq = x1 * cs.y + x2 * cs.x; x1 = a; x2 = bq; }
                *(unsigned*)(kpea + (size_t)row * 32 + lane * 2) = pk2(x1, x2);
            }
        } else {
            const int r2 = row - M_TOK;
            const f32x4 cv = *(const f32x4*)(p.in[4] + (size_t)r2 * 256 + lane * 4);
            *(u32x2*)(ckva + (size_t)row * 256 + lane * 4) = pk4(cv);
            if (lane < 16) { const f32x2 kp = *(const f32x2*)(p.in[5] + (size_t)r2 * 32 + lane * 2); *(unsigned*)(kpea + (size_t)row * 32 + lane * 2) = pk2(kp.x, kp.y); }
        }
    }
    LAS float* tile = (LAS float*)(lds + wave * 8832);
    bf16* HT = (bf16*)(p.ws + WS_HYIN);
    const float* cw = p.in[39];
    for (int it = blockIdx.x * 8 + wave; it < 256 * 48; it += gridDim.x * 8) {
        const int rt = it / 48, cb = it % 48;
        const int r0 = rt * 64, col0 = 672 + cb * 32;
        const int t0 = r0 < MP ? (r0 & 255) : ((r0 - MP) & 1023), L = r0 < MP ? 256 : 1024;
#pragma unroll 1
        for (int i = 0; i < 17; ++i) {
            const int rr = i * 4 + (lane >> 4);
            if (rr < 66) {
                const int tt = t0 - 1 + rr; unsigned w = 0u;
                if (tt >= 0 && tt < L) w = *(const unsigned*)(p1 + (size_t)(r0 - 1 + rr) * LDP1 + col0 + (lane & 15) * 2);
                tile[rr * 33 + (lane & 15) * 2] = bflo(w); tile[rr * 33 + (lane & 15) * 2 + 1] = bfhi(w);
            }
        }
        LDS_WAIT();
#pragma unroll 4
        for (int c = 0; c < 32; ++c) {
            const int ch = cb * 32 + c;
            const float v = cw[ch] * tile[lane * 33 + c] + cw[1536 + ch] * tile[(lane + 1) * 33 + c] + cw[3072 + ch] * tile[(lane + 2) * 33 + c];
            HT[(size_t)ch * M_TOK + r0 + lane] = (bf16)(pk2(v, 0.f) & 0xffffu);
        }
        LDS_WAIT();
    }
}

__device__ __forceinline__ void attn_item(const P& p, LAS unsigned char* lds, int kind, int b, int head, int qt) {
    LAS bf16* Kt = (LAS bf16*)lds;
    LAS bf16* Vt = Kt + 64 * 104;
    const int tid = tid_opaque(), lane = tid & 63, wave = tid >> 6, ln = lane & 15, h = lane >> 4;
    const bf16* Q = (const bf16*)(p.ws + WS_Q); const bf16* KV = (const bf16*)(p.ws + WS_KV); const bf16* KPE = (const bf16*)(p.ws + WS_KPEA);
    bf16* MX = (bf16*)(p.ws + WS_MIX);
    const int nkeys = kind ? 1280 : 256, rowbase = kind ? MP + b * 1024 : b * 256;
    const int qrow = rowbase + qt * 128 + wave * 16 + ln;
    s16x8 qf[3];
#pragma unroll
    for (int s = 0; s < 3; ++s) qf[s] = *(const s16x8*)(Q + (size_t)qrow * 768 + head * 96 + 32 * s + 8 * h);
    f32x4 o[4];
#pragma unroll
    for (int i = 0; i < 4; ++i) o[i] = (f32x4){0.f, 0.f, 0.f, 0.f};
    float mrun = -1e30f, lrun = 0.f;
#pragma unroll 1
    for (int k0 = 0; k0 < nkeys; k0 += 64) {
        __syncthreads();
        for (int c = tid; c < 768; c += NTHREADS) {
            const int key = c / 12, ch = c % 12, j = k0 + key;
            const int krow = kind ? (j < 1024 ? MP + b * 1024 + j : M_TOK + b * 256 + (j - 1024)) : b * 256 + j;
            const bf16* src = ch < 8 ? KV + (size_t)krow * 1024 + head * 128 + ch * 8 : KPE + (size_t)krow * 32 + (ch - 8) * 8;
            *(LAS u32x4*)(Kt + key * 104 + ch * 8) = *(const u32x4*)src;
        }
        {
            const int key = tid >> 3, vc = tid & 7, j = k0 + key;
            const int krow = kind ? (j < 1024 ? MP + b * 1024 + j : M_TOK + b * 256 + (j - 1024)) : b * 256 + j;
            const u32x4 vv = *(const u32x4*)(KV + (size_t)krow * 1024 + head * 128 + 64 + vc * 8);
#pragma unroll
            for (int i = 0; i < 4; ++i) { Vt[(vc * 8 + 2 * i) * 72 + key] = (bf16)(vv[i] & 0xffffu); Vt[(vc * 8 + 2 * i + 1) * 72 + key] = (bf16)(vv[i] >> 16); }
        }
        __syncthreads();
        f32x4 sc[4]; float mx = -1e30f;
#pragma unroll
        for (int kt = 0; kt < 4; ++kt) {
            f32x4 a = {0.f, 0.f, 0.f, 0.f};
#pragma unroll
            for (int s = 0; s < 3; ++s) { const s16x8 kf = *(const LAS s16x8*)(Kt + (kt * 16 + ln) * 104 + 32 * s + 8 * h); a = __builtin_amdgcn_mfma_f32_16x16x32_bf16(kf, qf[s], a, 0, 0, 0); }
            sc[kt] = a; mx = fmaxf(mx, fmaxf(fmaxf(a[0], a[1]), fmaxf(a[2], a[3])));
        }
        mx = fmaxf(mx, __shfl_xor(mx, 16)); mx = fmaxf(mx, __shfl_xor(mx, 32));
        const float mnew = fmaxf(mrun, mx), alpha = __expf(mrun - mnew);
        mrun = mnew;
        float ps = 0.f;
#pragma unroll
        for (int kt = 0; kt < 4; ++kt)
#pragma unroll
            for (int r = 0; r < 4; ++r) { sc[kt][r] = __expf(sc[kt][r] - mnew); ps += sc[kt][r]; }
        lrun = lrun * alpha + ps;
#pragma unroll
        for (int i = 0; i < 4; ++i) o[i] = o[i] * alpha;
#pragma unroll
        for (int s = 0; s < 2; ++s) {
            u32x4 pw; pw.x = pk2(sc[2 * s][0], sc[2 * s][1]); pw.y = pk2(sc[2 * s][2], sc[2 * s][3]); pw.z = pk2(sc[2 * s + 1][0], sc[2 * s + 1][1]); pw.w = pk2(sc[2 * s + 1][2], sc[2 * s + 1][3]);
            const s16x8 pf = __builtin_bit_cast(s16x8, pw);
#pragma unroll
            for (int vt = 0; vt < 4; ++vt) {
                const LAS bf16* vp = Vt + (vt * 16 + ln) * 72 + 32 * s + 4 * h;
                const u32x2 lo2 = *(const LAS u32x2*)vp, hi2 = *(const LAS u32x2*)(vp + 16);
                const u32x4 vw = {lo2.x, lo2.y, hi2.x, hi2.y};
                o[vt] = __builtin_amdgcn_mfma_f32_16x16x32_bf16(__builtin_bit_cast(s16x8, vw), pf, o[vt], 0, 0, 0);
            }
        }
    }
    lrun += __shfl_xor(lrun, 16); lrun += __shfl_xor(lrun, 32);
    const float inv = 1.0f / lrun;
#pragma unroll
    for (int vt = 0; vt < 4; ++vt) *(u32x2*)(MX + (size_t)qrow * 1024 + head * 64 + vt * 16 + 4 * h) = pk4(o[vt] * inv);
}

__device__ __forceinline__ void hyena_item(const P& p, LAS unsigned char* lds, int kind, int cgp) {
    const int tid = tid_opaque(), lane = tid & 63, wave = tid >> 6, ci = wave >> 1, half = wave & 1;
    const int L = kind ? 1024 : 256, NB = kind ? 8 : 32, base = kind ? MP : 0, c = cgp * 4 + ci;
    const int DMAX = kind ? 31 : 7;
    LAS bf16* zb = (LAS bf16*)lds;
    LAS bf16* gb = zb + 4 * 8192;
    const bf16* HT = (const bf16*)(p.ws + WS_HYIN);
    const bf16* G = (const bf16*)(p.ws + (kind ? WS_GFS : WS_GFP));
    bf16* MX = (bf16*)(p.ws + WS_MIX);
    __syncthreads();
    for (int i = tid; i < 4 * 1024; i += NTHREADS) { const int cc = i >> 10, off = (i & 1023) * 8;
        *(LAS u32x4*)(zb + cc * 8192 + off) = *(const u32x4*)(HT + (size_t)(cgp * 4 + cc) * M_TOK + base + off); }
    for (int i = tid; i < 8 * (2 * L / 8); i += NTHREADS) { const int co = i / (2 * L / 8), off = (i % (2 * L / 8)) * 8, cc = co >> 1, od = co & 1;
        *(LAS u32x4*)(gb + (cc * 2 + od) * 2 * L + off) = *(const u32x4*)(G + ((size_t)od * 512 + cgp * 4 + cc) * (2 * L) + off); }
    __syncthreads();
    const int n = lane & 31, h = lane >> 5;
    const int jl = kind ? (n >> 3) : 0, bb = kind ? (n & 7) : n;
    const LAS bf16* zc = zb + ci * 8192 + bb * L;
#pragma unroll 1
    for (int order = 0; order < 2; ++order) {
        const LAS bf16* gr = gb + (ci * 2 + order) * 2 * L;
        f32x16 acc[4];
#pragma unroll
        for (int g = 0; g < 4; ++g)
#pragma unroll
            for (int r = 0; r < 16; ++r) acc[g][r] = 0.f;
#pragma unroll 1
        for (int D = -DMAX; D <= DMAX; ++D) {
#pragma unroll
            for (int ks = 0; ks < 2; ++ks) {
                const int idx = L - 32 * D + 16 * ks + 8 * h - n;
                u32x4 aw;
                aw.x = (unsigned)gr[idx] | ((unsigned)gr[idx + 1] << 16); aw.y = (unsigned)gr[idx + 2] | ((unsigned)gr[idx + 3] << 16);
                aw.z = (unsigned)gr[idx + 4] | ((unsigned)gr[idx + 5] << 16); aw.w = (unsigned)gr[idx + 6] | ((unsigned)gr[idx + 7] << 16);
                const s16x8 af = __builtin_bit_cast(s16x8, aw);
#pragma unroll
                for (int g = 0; g < 4; ++g) {
                    const int og = half * 4 + g;
                    const int Ilo = kind ? 4 * og : og, Ihi = kind ? 4 * og + 3 : og;
                    if (Ihi - D >= 0 && Ilo - D <= (L / 32 - 1)) {
                        const int J = (kind ? 4 * og + jl : og) - D;
                        u32x4 bw = {0u, 0u, 0u, 0u};
                        if (J >= 0 && J < L / 32) bw = *(const LAS u32x4*)(zc + 32 * J + 16 * ks + 8 * h);
                        acc[g] = __builtin_amdgcn_mfma_f32_32x32x16_bf16(af, __builtin_bit_cast(s16x8, bw), acc[g], 0, 0, 0);
                    }
                }
            }
        }
        const float bias = p.in[46][order * 512 + c];
        const bf16* gate = HT + (size_t)((order + 1) * 512 + c) * M_TOK + base + bb * L;
        u32x2 zn[4][4];
#pragma unroll
        for (int g = 0; g < 4; ++g) {
            const int og = half * 4 + g, I = kind ? 4 * og + jl : og;
#pragma unroll
            for (int rq = 0; rq < 4; ++rq) {
                const int t = 32 * I + 8 * rq + 4 * h;
                const f32x4 zo = unpk4(*(const LAS u32x2*)(zc + t)), gt = unpk4(*(const u32x2*)(gate + t));
                f32x4 y; y.x = acc[g][4 * rq]; y.y = acc[g][4 * rq + 1]; y.z = acc[g][4 * rq + 2]; y.w = acc[g][4 * rq + 3];
                zn[g][rq] = pk4(gt * (y + zo * bias));
            }
        }
        if (order == 0) {
            __syncthreads();
#pragma unroll
            for (int g = 0; g < 4; ++g) { const int og = half * 4 + g, I = kind ? 4 * og + jl : og;
#pragma unroll
                for (int rq = 0; rq < 4; ++rq) *(LAS u32x2*)(zb + ci * 8192 + bb * L + 32 * I + 8 * rq + 4 * h) = zn[g][rq]; }
            __syncthreads();
        } else {
#pragma unroll
            for (int g = 0; g < 4; ++g) { const int og = half * 4 + g, I = kind ? 4 * og + jl : og;
#pragma unroll
                for (int rq = 0; rq < 4; ++rq) { const int t = 32 * I + 8 * rq + 4 * h; bf16* dst = MX + (size_t)(base + bb * L + t) * 1024 + 512 + c;
                    dst[0] = (bf16)(zn[g][rq].x & 0xffffu); dst[1024] = (bf16)(zn[g][rq].x >> 16); dst[2048] = (bf16)(zn[g][rq].y & 0xffffu); dst[3072] = (bf16)(zn[g][rq].y >> 16); } }
        }
    }
}
__device__ __forceinline__ void ph_attn_hyena(const P& p, LAS unsigned char* lds) {
    const int B = blockIdx.x, G = gridDim.x;
#ifndef T_NO_ATTN
    for (int i = B; i < 1024; i += G) { if (i < 512) attn_item(p, lds, 1, i >> 6, (i >> 3) & 7, i & 7); else { const int j = i - 512; attn_item(p, lds, 0, j >> 4, (j >> 1) & 7, j & 1); } }
#endif
#ifndef T_NO_HY
    for (int i = B; i < 256; i += G) { hyena_item(p, lds, i < 128 ? 1 : 0, i & 127); }
#endif
}

template <class Epi>
__device__ __forceinline__ void run_gemm(LAS unsigned char* lds, const bf16* A, const bf16* Bt, int M, int N, int K, const Epi& E) {
    asm volatile("" : "+s"(K));
    pg8::Gemm g{A, Bt, M, N, K}; pg8::StaticOrder S; S.init(M, N, (int)gridDim.x, (int)blockIdx.x);
    pg8::gemm_phase<Epi, pg8::StaticOrder, true, true>(lds, g, S, E);
}

__global__ void __launch_bounds__(NTHREADS, 2) hybrid_fwd(P p) {
    extern __shared__ __attribute__((aligned(16))) unsigned char lds_raw[];
    LAS unsigned char* lds = (LAS unsigned char*)lds_raw;
    cg::grid_group grid = cg::this_grid();
    const int lo = p.ph_lo, hi = p.ph_hi;
#define mod ((const float*)(p.ws + WS_MOD))
#define x (p.out)
#define H ((bf16*)(p.ws + WS_H))
#define MX ((bf16*)(p.ws + WS_MIX))
#define R1 ((bf16*)(p.ws + WS_R1))
#define R2 ((bf16*)(p.ws + WS_R2))
#ifndef PH_MASK
#define PH_MASK 0xFFFFFFFFu
#endif
#define KON(b) ((PH_MASK >> (b)) & 1u)
#define IN(k) (lo <= (k) && (k) < hi)
#define SEAM(k) do { if (IN(k) && IN((k) + 1)) grid.sync(); } while (0)

    if (KON(0) && IN(0)) ph_adaln(p, lds);
    SEAM(0);
    for (int layer = 0; layer < 2; ++layer) {
        const int pb = 1 + layer * 13;
        if (KON(1) && IN(pb + 0)) { norm_rows(p, layer, 0, p.in[10] + layer * 1024, layer == 0); convert_ffn_weights(p, layer, 0, lds); }
        SEAM(pb + 0);
        if (KON(2) && IN(pb + 1)) { __syncthreads(); run_gemm(lds, H, (const bf16*)(p.ws + W_GU), M_TOK, 5632, 1024, EpiSwiglu{R1}); }
        SEAM(pb + 1);
        if (KON(3) && IN(pb + 2)) {
            const EpiResid E{layer == 0 ? p.in[0] : x, layer == 0 ? p.in[1] : x + (size_t)MP * DM, x, mod + (size_t)layer * 9 * 9216 + 2 * 1024, 0.5f};
            run_gemm(lds, R1, (const bf16*)(p.ws + W_DOWN), M_TOK, 1024, 2816, E);
        }
        SEAM(pb + 2);
        if (KON(4) && IN(pb + 3)) {
            norm_rows(p, layer, 1, p.in[11] + layer * 1024, false);
            transpose_w<0>(p.in[17] + (size_t)layer * 1024 * 1024, 1024, 1024, 1024, (bf16*)(p.ws + W_OUT), 1024, lds);
            if (layer == 0) { transpose_w<0>(p.in[18], 3984, 3984, 1024, (bf16*)(p.ws + W_IN), 4096, lds); build_lora_w(p); }
            else { transpose_w<0>(p.in[34], 2208, 2208, 1024, (bf16*)(p.ws + W_IN), 2304, lds);
                transpose_w<0>(p.in[36], 768, 768, 384, (bf16*)(p.ws + W_UQ), 768, lds);
                transpose_w<0>(p.in[38], 1024, 1024, 256, (bf16*)(p.ws + W_UKV), 1024, lds);
                ph_hyena_filters(p, lds); }
        }
        SEAM(pb + 3);
        if (KON(5) && IN(pb + 4)) {
            __syncthreads();
            if (layer == 0) run_gemm(lds, H, (const bf16*)(p.ws + W_IN), M_TOK, 4096, 1024, EpiStore{R1, LDP0, LDP0});
            else run_gemm(lds, H, (const bf16*)(p.ws + W_IN), M_TOK, 2304, 1024, EpiStore{R1, LDP1, LDP1});
        }
        SEAM(pb + 4);
        if (KON(6) && IN(pb + 5)) { if (layer == 0) ph_lora_in(p); else ph_mla_prep(p, lds); }
        SEAM(pb + 5);
        if (KON(7) && IN(pb + 6)) {
            __syncthreads();
#ifndef T_NO_LORAG
            if (layer == 0) run_gemm(lds, H, (const bf16*)(p.ws + W_LORA), M_TOK, 2560, 384, EpiLora{R2, p.in[20], p.in[22]});
#endif
            if (layer == 1) {
#ifndef T_NO_QG
                run_gemm(lds, H, (const bf16*)(p.ws + W_UQ), M_TOK, 768, 384, EpiQ{(bf16*)(p.ws + WS_Q), (const float*)(p.ws + WS_ROPE)});
#endif
#ifndef T_NO_KVG
                run_gemm(lds, (const bf16*)(p.ws + WS_CKVA), (const bf16*)(p.ws + W_UKV), M_TOK + 2048, 1024, 256, EpiStore{(bf16*)(p.ws + WS_KV), 1024, 1024});
#endif
            }
        }
        SEAM(pb + 6);
        if (KON(8) && IN(pb + 7)) { if (layer == 0) ph_scan(p, lds); else ph_attn_hyena(p, lds); }
        SEAM(pb + 7);
        if (KON(9) && IN(pb + 8)) { if (layer == 0) ph_post_ab(p); }
        if (layer == 0) SEAM(pb + 8);
        if (KON(10) && IN(pb + 9)) {
            __syncthreads();
            const EpiResid E{x, x + (size_t)MP * DM, x, mod + (size_t)layer * 9 * 9216 + 5 * 1024, 1.0f};
            run_gemm(lds, MX, (const bf16*)(p.ws + W_OUT), M_TOK, 1024, 1024, E);
        }
        SEAM(pb + 9);
        if (KON(1) && IN(pb + 10)) { norm_rows(p, layer, 2, p.in[12] + layer * 1024, false); convert_ffn_weights(p, layer, 1, lds); }
        SEAM(pb + 10);
        if (KON(2) && IN(pb + 11)) { __syncthreads(); run_gemm(lds, H, (const bf16*)(p.ws + W_GU), M_TOK, 5632, 1024, EpiSwiglu{R1}); }
        SEAM(pb + 11);
        if (KON(3) && IN(pb + 12)) {
            const EpiResid E{x, x + (size_t)MP * DM, x, mod + (size_t)layer * 9 * 9216 + 8 * 1024, 0.5f};
            run_gemm(lds, R1, (const bf16*)(p.ws + W_DOWN), M_TOK, 1024, 2816, E);
        }
        SEAM(pb + 12);
    }
    if (KON(11) && IN(27)) final_norm_rows(p);
#undef IN
#undef SEAM
#undef mod
#undef x
#undef H
#undef MX
#undef R1
#undef R2
}

extern "C" void kernel_launch(void* const* d_in, const int* in_sizes, int n_in, void* d_out, int out_size, void* d_ws, size_t ws_size, hipStream_t stream) {
    static int grid = 0;
    if (grid == 0) {
        if (n_in != 48 || out_size != 25427968 || ws_size < WS_END) {
            fprintf(stderr, "kernel_launch: expected 48 inputs, 25427968 outputs, >= %zu B workspace; got %d, %d, %zu\n", (size_t)WS_END, n_in, out_size, ws_size);
            grid = -1; return;
        }
        int dev = 0, cus = 0, per_cu = 0;
        hipGetDevice(&dev);
        hipDeviceGetAttribute(&cus, hipDeviceAttributeMultiprocessorCount, dev);
        hipFuncSetAttribute((const void*)hybrid_fwd, hipFuncAttributeMaxDynamicSharedMemorySize, LDS_BYTES);
        hipOccupancyMaxActiveBlocksPerMultiprocessor(&per_cu, (const void*)hybrid_fwd, NTHREADS, LDS_BYTES);
        if (per_cu < 1) { fprintf(stderr, "kernel_launch: occupancy query says %d blocks/CU\n", per_cu); per_cu = 1; }
        (void)hipGetLastError();
        grid = cus;
    }
    if (grid < 0) return;
    P prm{};
    for (int i = 0; i < 48; ++i) prm.in[i] = (const float*)d_in[i];
    prm.out = (float*)d_out; prm.ws = (unsigned char*)d_ws;
#ifndef N_SPLIT
    prm.ph_lo = 0; prm.ph_hi = 28;
    void* args[] = {&prm};
    hipError_t e = hipLaunchCooperativeKernel((const void*)hybrid_fwd, dim3(grid), dim3(NTHREADS), args, LDS_BYTES, stream);
    if (e != hipSuccess) fprintf(stderr, "cooperative launch failed: %s (grid %d)\n", hipGetErrorString(e), grid);
#else
    for (int k = 0; k < 28; ++k) {
        prm.ph_lo = k; prm.ph_hi = k + 1;
        void* args[] = {&prm};
        hipError_t e = hipLaunchCooperativeKernel((const void*)hybrid_fwd, dim3(grid), dim3(NTHREADS), args, LDS_BYTES, stream);
        if (e != hipSuccess) { fprintf(stderr, "launch %d failed: %s\n", k, hipGetErrorString(e)); break; }
    }
#endif
}
```

```cpp
#include <hip/hip_runtime.h>
#include <hip/hip_cooperative_groups.h>
#include <cstdio>
#include <cstdint>
namespace cg = cooperative_groups;

#define LAS __attribute__((address_space(3)))
typedef unsigned short bf16;
typedef float f32x2 __attribute__((ext_vector_type(2)));
typedef float f32x4 __attribute__((ext_vector_type(4)));
typedef float f32x16 __attribute__((ext_vector_type(16)));
typedef unsigned u32x2 __attribute__((ext_vector_type(2)));
typedef unsigned u32x4 __attribute__((ext_vector_type(4)));
typedef short s16x8 __attribute__((ext_vector_type(8)));

constexpr int M_TOK = 16384, MP = 8192, DM = 1024, DFF = 2816;
constexpr int LDP0 = 3984, LDP1 = 2304;
constexpr int OUT_YS = 8388608, OUT_SRW = 16777216, OUT_SGD = 18874368, OUT_CKV = 23068672, OUT_KPE = 25165824;

constexpr size_t MiB = 1ull << 20;
constexpr size_t WS_CTL = 0;
constexpr size_t WS_ROPE = 512 * 1024;
constexpr size_t WS_MOD = 1 * MiB;
constexpr size_t WS_W = 2 * MiB;
constexpr size_t W_GU = WS_W, W_DOWN = WS_W + 11 * MiB;
constexpr size_t W_IN = WS_W, W_OUT = WS_W + 8 * MiB, W_LORA = WS_W + 10 * MiB, W_UQ = WS_W + 12 * MiB, W_UKV = WS_W + 13 * MiB;
constexpr size_t WS_H = 19 * MiB;
constexpr size_t WS_MIX = 51 * MiB;
constexpr size_t WS_R1 = 83 * MiB;
constexpr size_t R1_BYTES = 130547712;
constexpr size_t WS_HYIN = WS_R1 + 72 * MiB;
constexpr size_t WS_R2 = WS_R1 + R1_BYTES;
constexpr size_t WS_Q = WS_R2, WS_KV = WS_R2 + 24 * MiB, WS_VT = WS_R2 + 42 * MiB, WS_CKVA = WS_R2 + 60 * MiB, WS_KPEA = WS_R2 + 69 * MiB, WS_GFS = WS_R2 + 71 * MiB, WS_GFP = WS_R2 + 75 * MiB;
constexpr size_t WS_END = WS_R2 + 80 * MiB;

constexpr int LDS_BYTES = 147456;
constexpr int NTHREADS = 512;

struct P {
    const float* in[48];
    float* out;
    unsigned char* ws;
    int ph_lo, ph_hi;
};

__device__ __forceinline__ float bf2f(unsigned b) { return __uint_as_float(b << 16); }
__device__ __forceinline__ float bflo(unsigned w) { return __uint_as_float(w << 16); }
__device__ __forceinline__ float bfhi(unsigned w) { return __uint_as_float(w & 0xffff0000u); }
__device__ __forceinline__ unsigned pk2(float lo, float hi) { unsigned r; asm("v_cvt_pk_bf16_f32 %0, %1, %2" : "=v"(r) : "v"(lo), "v"(hi)); return r; }
__device__ __forceinline__ f32x4 unpk4(u32x2 w) { return (f32x4){bflo(w.x), bfhi(w.x), bflo(w.y), bfhi(w.y)}; }
__device__ __forceinline__ u32x2 pk4(f32x4 v) { return (u32x2){pk2(v.x, v.y), pk2(v.z, v.w)}; }
__device__ __forceinline__ float wave_sum(float v) {
#pragma unroll
    for (int o = 1; o < 64; o <<= 1) v += __shfl_xor(v, o);
    return v;
}
__device__ __forceinline__ float dpp_f(float x, int) { return x; }
#define DPPF(x, ctrl) __int_as_float(__builtin_amdgcn_update_dpp(0, __float_as_int(x), (ctrl), 0xF, 0xF, true))
__device__ __forceinline__ float red4(float x) { x += DPPF(x, 0xB1); x += DPPF(x, 0x4E); return x; }
__device__ __forceinline__ float red8(float x) { x = red4(x); x += DPPF(x, 0x141); return x; }
__device__ __forceinline__ float red16(float x) { x = red8(x); x += DPPF(x, 0x140); return x; }
__device__ __forceinline__ float sigmoidf_(float x) { return 1.0f / (1.0f + __expf(-x)); }
__device__ __forceinline__ float siluf_(float x) { return x / (1.0f + __expf(-x)); }
__device__ __forceinline__ int cond_of_row(int row) { return row < MP ? 0 : 1 + ((row - MP) >> 10); }
__device__ __forceinline__ int tid_opaque() { int t = threadIdx.x; asm volatile("" : "+v"(t)); return t; }
#define LDS_WAIT() asm volatile("s_waitcnt lgkmcnt(0)" ::: "memory")

namespace pg8 {
#define PG8_LAS __attribute__((address_space(3)))
typedef unsigned short bf16_t;
typedef short bf16x8 __attribute__((ext_vector_type(8)));
typedef float f32x4 __attribute__((ext_vector_type(4)));
typedef unsigned u32x4 __attribute__((ext_vector_type(4)));
constexpr int BM = 256, BK = 64, HALF = 128, HTB = HALF * BK * 2  , STAGE_BYTES = 8 * HTB, NXCD = 8, WGM = 8;

__host__ __device__ __forceinline__ int lds_byte(int r, int c) { const int st = (r >> 4) * 2 + (c >> 5), rr = r & 15, cc = c & 31, ob = rr * 64 + cc * 2; return st * 1024 + (ob ^ (((ob >> 9) & 1) << 5)); }
__host__ __device__ __forceinline__ void stage_rc(int b, int& R, int& C) { const int st = b / 1024, sb = b % 1024, swz = sb ^ (((sb >> 9) & 1) << 5); R = (st >> 1) * 16 + swz / 64; C = (st & 1) * 32 + (swz % 64) / 2; }
__host__ __device__ __forceinline__ int perm32(int rho) { const int n = rho >> 4, i = rho & 15; return 8 * (i >> 2) + 4 * n + (i & 3); }

struct Unit { int pm, pn; };
struct Gemm { const bf16_t* A; const bf16_t* Bt; int M, N, K; };

struct StaticOrder {
    int nM, nN, nwg, G, c;
    __host__ __device__ void init(int M, int N, int G_, int c_) { nM = M / BM; nN = N / BM; nwg = nM * nN; G = G_; c = c_; }
    __host__ __device__ bool next(int i, Unit& u) const {
        const long L = (long)i * G + c; if (L >= nwg) return false;
        int wgid = (int)L; { const int q = nwg / NXCD, r = nwg % NXCD, xcd = wgid % NXCD, off = wgid / NXCD; wgid = (xcd < r ? xcd * (q + 1) : r * (q + 1) + (xcd - r) * q) + off; }
        const int nig = WGM * nN, gid = wgid / nig, fm = gid * WGM, gsz = (nM - fm) < WGM ? (nM - fm) : WGM;
        u.pm = fm + ((wgid % nig) % gsz); u.pn = (wgid % nig) / gsz; return true;
    }
    __device__ __forceinline__ void a_ready(const Unit&) const {}
    __device__ __forceinline__ void done(const Unit&) const {}
};
__device__ __forceinline__ unsigned cvt_pk_bf16(float lo, float hi) { unsigned r; asm volatile("v_cvt_pk_bf16_f32 %0, %1, %2" : "=v"(r) : "v"(lo), "v"(hi)); return r; }
typedef float f32x2 __attribute__((ext_vector_type(2)));
template <class Epi, class Sched, bool ALIGN_EPI = false, bool SP2 = false>
__device__ __forceinline__ void gemm_phase(PG8_LAS unsigned char* lds, const Gemm g, const Sched& S, const Epi& E) {
    const int tid = tid_opaque(), wid = __builtin_amdgcn_readfirstlane(tid >> 6), lane = tid & 63, wr = wid >> 2, wc = wid & 3, fr = lane & 15, fq = lane >> 4;
    const int K = g.K, nt = K / BK;
    unsigned voffA[2], voffB[2];
#pragma unroll
    for (int i = 0; i < 2; ++i) { int R, C; stage_rc(tid * 16 + i * 8192, R, C); const int Rb = Epi::PERM ? ((R & ~31) + perm32(R & 31)) : R;
        voffA[i] = (unsigned)(R * K + C) * 2u; voffB[i] = (unsigned)(Rb * K + C) * 2u; }
    const size_t kstep = (size_t)(BK * 2);
    const size_t hstep = (size_t)HALF * K * 2;
    const size_t tstep = 2 * hstep;
    const unsigned ldsw = (unsigned)wid * 1024u;
    const int aoff = lds_byte(wr * 64 + fr, fq * 8), boff = lds_byte(wc * 32 + fr, fq * 8);
#define PG8_SA(b, h) (((b) * 2 + (h)) * HTB)
#define PG8_SB(b, h) ((4 + (b) * 2 + (h)) * HTB)
#define PG8_STAGE(bufoff, gbase, voff) do { _Pragma("unroll") for (int _i = 0; _i < 2; ++_i) \
        __builtin_amdgcn_global_load_lds((const unsigned*)((const char*)(gbase) + (voff)[_i]), (PG8_LAS unsigned*)(lds + (bufoff) + ldsw + _i * 8192), 16, 0, 0); } while (0)
#define PG8_LDA(dst, b, h) do { _Pragma("unroll") for (int m = 0; m < 4; ++m) _Pragma("unroll") for (int k = 0; k < 2; ++k) dst[m][k] = *(const PG8_LAS bf16x8*)(lds + PG8_SA(b, h) + aoff + m * 2048 + k * 1024); } while (0)
#define PG8_LDB(dst, b, h) do { _Pragma("unroll") for (int n = 0; n < 2; ++n) _Pragma("unroll") for (int k = 0; k < 2; ++k) dst[n][k] = *(const PG8_LAS bf16x8*)(lds + PG8_SB(b, h) + boff + n * 2048 + k * 1024); } while (0)
#define PG8_MMA(ai, bj, At, Bt) do { __builtin_amdgcn_s_setprio(1); _Pragma("unroll") for (int m = 0; m < 4; ++m) _Pragma("unroll") for (int n = 0; n < 2; ++n) _Pragma("unroll") for (int k = 0; k < 2; ++k) \
        acc[ai][bj][m][n] = __builtin_amdgcn_mfma_f32_16x16x32_bf16(Bt[n][k], At[m][k], acc[ai][bj][m][n], 0, 0, 0); __builtin_amdgcn_s_setprio(0); } while (0)
#define PG8_WAIT_V(n) asm volatile("s_waitcnt vmcnt(" #n ")" ::: "memory")
#define PG8_WAIT_L(n) asm volatile("s_waitcnt lgkmcnt(" #n ")" ::: "memory")
#define PG8_BAR __builtin_amdgcn_s_barrier()
#define PG8_SCHED __builtin_amdgcn_sched_barrier(0)
    Unit cur, nxt; int ui = 0;
    if (!S.next(0, cur)) return;
    f32x4 acc[2][2][4][2];
#pragma unroll
    for (int a = 0; a < 2; ++a)
#pragma unroll
        for (int b = 0; b < 2; ++b)
#pragma unroll
            for (int m = 0; m < 4; ++m)
#pragma unroll
                for (int n = 0; n < 2; ++n) acc[a][b][m][n] = (f32x4){0.f, 0.f, 0.f, 0.f};
    bf16x8 At[4][2], B0[2][2], B1[2][2];
    const char* cA = (const char*)g.A + (size_t)cur.pm * tstep; const char* cB = (const char*)g.Bt + (size_t)cur.pn * tstep;
    S.a_ready(cur);
    if constexpr (SP2) {
        PG8_STAGE(PG8_SB(0, 0), cB, voffB); PG8_STAGE(PG8_SB(0, 1), cB + hstep, voffB); PG8_STAGE(PG8_SA(0, 0), cA, voffA); PG8_STAGE(PG8_SA(0, 1), cA + hstep, voffA);
        if (wr == 1) PG8_BAR;
        PG8_WAIT_V(2); PG8_BAR;
        PG8_STAGE(PG8_SB(1, 0), cB + kstep, voffB); PG8_STAGE(PG8_SA(1, 0), cA + kstep, voffA); PG8_STAGE(PG8_SB(1, 1), cB + hstep + kstep, voffB);
        PG8_WAIT_V(6); PG8_BAR;
    } else {
        PG8_STAGE(PG8_SB(0, 0), cB, voffB); PG8_STAGE(PG8_SA(0, 0), cA, voffA); PG8_STAGE(PG8_SB(0, 1), cB + hstep, voffB); PG8_STAGE(PG8_SA(0, 1), cA + hstep, voffA);
        if (wr == 1) PG8_BAR;
        PG8_WAIT_V(4); PG8_BAR;
        PG8_STAGE(PG8_SB(1, 0), cB + kstep, voffB); PG8_STAGE(PG8_SA(1, 0), cA + kstep, voffA); PG8_STAGE(PG8_SB(1, 1), cB + hstep + kstep, voffB);
        PG8_WAIT_V(6); PG8_BAR;
    }
    for (;;) {
        const bool has_next = S.next(ui + 1, nxt);
        const char* nA = has_next ? (const char*)g.A + (size_t)nxt.pm * tstep : cA; const char* nB = has_next ? (const char*)g.Bt + (size_t)nxt.pn * tstep : cB;
#pragma unroll 1
        for (int t = 0; t < nt; t += 2) {
            const bool last = (t == nt - 2);
            const char* a1 = cA + (size_t)(t + 1) * kstep;
            const char* a2 = last ? nA : cA + (size_t)(t + 2) * kstep; const char* b2 = last ? nB : cB + (size_t)(t + 2) * kstep;
            const char* a3 = a2 + kstep; const char* b3 = b2 + kstep;
            if (last && has_next) S.a_ready(nxt);
            if constexpr (SP2) {
            PG8_LDB(B0, 0, 0); PG8_LDB(B1, 0, 1); PG8_SCHED; PG8_LDA(At, 0, 0); PG8_STAGE(PG8_SA(1, 1), a1 + hstep, voffA);
            PG8_WAIT_V(8); PG8_WAIT_L(0); PG8_BAR; PG8_MMA(0, 0, At, B0); PG8_MMA(0, 1, At, B1); PG8_BAR; PG8_SCHED;
            PG8_LDA(At, 0, 1); PG8_STAGE(PG8_SB(0, 0), b2, voffB); PG8_STAGE(PG8_SB(0, 1), b2 + hstep, voffB); PG8_STAGE(PG8_SA(0, 0), a2, voffA);
            PG8_WAIT_V(8); PG8_WAIT_L(0); PG8_BAR; PG8_MMA(1, 0, At, B0); PG8_MMA(1, 1, At, B1); PG8_BAR; PG8_SCHED;
            PG8_LDB(B0, 1, 0); PG8_LDB(B1, 1, 1); PG8_SCHED; PG8_LDA(At, 1, 0); PG8_STAGE(PG8_SA(0, 1), a2 + hstep, voffA);
            PG8_WAIT_V(8); PG8_WAIT_L(0); PG8_BAR; PG8_MMA(0, 0, At, B0); PG8_MMA(0, 1, At, B1); PG8_BAR; PG8_SCHED;
            PG8_LDA(At, 1, 1); PG8_STAGE(PG8_SB(1, 0), b3, voffB); PG8_STAGE(PG8_SB(1, 1), b3 + hstep, voffB); PG8_STAGE(PG8_SA(1, 0), a3, voffA);
            PG8_WAIT_V(8); PG8_WAIT_L(0); PG8_BAR; PG8_MMA(1, 0, At, B0); PG8_MMA(1, 1, At, B1); PG8_BAR; PG8_SCHED;
            } else {
            PG8_LDB(B0, 0, 0); PG8_SCHED; PG8_LDA(At, 0, 0); PG8_STAGE(PG8_SA(1, 1), a1 + hstep, voffA);
            PG8_WAIT_L(8); PG8_BAR; PG8_WAIT_L(0); PG8_MMA(0, 0, At, B0); PG8_BAR; PG8_SCHED;
            PG8_LDB(B1, 0, 1); PG8_STAGE(PG8_SB(0, 0), b2, voffB);
            PG8_BAR; PG8_WAIT_L(0); PG8_MMA(0, 1, At, B1); PG8_BAR;
            PG8_LDA(At, 0, 1); PG8_STAGE(PG8_SA(0, 0), a2, voffA);
            PG8_BAR; PG8_WAIT_L(0); PG8_MMA(1, 0, At, B0); PG8_BAR; PG8_SCHED;
            PG8_STAGE(PG8_SB(0, 1), b2 + hstep, voffB);
            PG8_WAIT_V(6); PG8_BAR; PG8_MMA(1, 1, At, B1); PG8_BAR;
            PG8_LDB(B0, 1, 0); PG8_SCHED; PG8_LDA(At, 1, 0); PG8_STAGE(PG8_SA(0, 1), a2 + hstep, voffA);
            PG8_WAIT_L(8); PG8_BAR; PG8_WAIT_L(0); PG8_MMA(0, 0, At, B0); PG8_BAR; PG8_SCHED;
            PG8_LDB(B1, 1, 1); PG8_STAGE(PG8_SB(1, 0), b3, voffB);
            PG8_BAR; PG8_WAIT_L(0); PG8_MMA(0, 1, At, B1); PG8_BAR;
            PG8_LDA(At, 1, 1); PG8_STAGE(PG8_SA(1, 0), a3, voffA);
            PG8_BAR; PG8_WAIT_L(0); PG8_MMA(1, 0, At, B0); PG8_BAR; PG8_SCHED;
            PG8_STAGE(PG8_SB(1, 1), b3 + hstep, voffB);
            PG8_WAIT_V(6); PG8_BAR; PG8_MMA(1, 1, At, B1); PG8_BAR;
            }
        }
        if constexpr (ALIGN_EPI) { if (wr == 0) PG8_BAR; }
        if constexpr (!Epi::AFTER_DRAIN) { E(acc, cur, wr, wc, fr, fq); S.done(cur); }
        if (!has_next) break;
#pragma unroll
        for (int a = 0; a < 2; ++a)
#pragma unroll
            for (int b = 0; b < 2; ++b)
#pragma unroll
                for (int m = 0; m < 4; ++m)
#pragma unroll
                    for (int n = 0; n < 2; ++n) acc[a][b][m][n] = (f32x4){0.f, 0.f, 0.f, 0.f};
        cur = nxt; cA = nA; cB = nB; ++ui;
        if constexpr (ALIGN_EPI) { if (wr == 1) PG8_BAR; }
    }
    PG8_WAIT_V(0);
    if constexpr (!ALIGN_EPI) { if (wr == 0) PG8_BAR; }
    PG8_BAR;
    if constexpr (Epi::AFTER_DRAIN) { E.fused(acc, cur, wr, wc, fr, fq, lds, wid, lane); S.done(cur); }
#undef PG8_SA
#undef PG8_SB
#undef PG8_STAGE
#undef PG8_LDA
#undef PG8_LDB
#undef PG8_MMA
#undef PG8_WAIT_V
#undef PG8_WAIT_L
#undef PG8_BAR
#undef PG8_SCHED
}
}

using pg8::Unit;
typedef const f32x4 (&AccRef)[2][2][4][2];

struct EpiSwiglu {
    static constexpr bool PERM = true, AFTER_DRAIN = false;
    bf16* O;
    __device__ __forceinline__ void operator()(AccRef acc, const Unit& u, int wr, int wc, int fr, int fq) const {
        const int row0 = u.pm * 256 + wr * 64 + fr, col0 = u.pn * 128 + wc * 32 + 8 * fq;
#pragma unroll
        for (int ai = 0; ai < 2; ++ai)
#pragma unroll
            for (int m = 0; m < 4; ++m) {
                const f32x4 g0 = acc[ai][0][m][0], g1 = acc[ai][0][m][1], u0 = acc[ai][1][m][0], u1 = acc[ai][1][m][1];
                float v[8];
#pragma unroll
                for (int i = 0; i < 4; ++i) { v[i] = g0[i] * __builtin_amdgcn_rcpf(1.0f + __expf(-g0[i])) * u0[i]; v[4 + i] = g1[i] * __builtin_amdgcn_rcpf(1.0f + __expf(-g1[i])) * u1[i]; }
                u32x4 w; w.x = pk2(v[0], v[1]); w.y = pk2(v[2], v[3]); w.z = pk2(v[4], v[5]); w.w = pk2(v[6], v[7]);
                *(u32x4*)(O + (size_t)(row0 + ai * 128 + m * 16) * DFF + col0) = w;
            }
    }
};
struct EpiResid {
    static constexpr bool PERM = false, AFTER_DRAIN = false;
    const float* xin_p; const float* xin_s; float* xout; const float* gate_base; float coef;
    __device__ __forceinline__ void operator()(AccRef acc, const Unit& u, int wr, int wc, int fr, int fq) const {
        const int cond = u.pm < 32 ? 0 : 1 + ((u.pm - 32) >> 2);
        const float* gate = gate_base + (size_t)cond * 9216;
        const int row0 = u.pm * 256 + wr * 64 + fr, col0 = u.pn * 256 + wc * 32 + 4 * fq;
        f32x4 gv[2][2];
#pragma unroll
        for (int bj = 0; bj < 2; ++bj)
#pragma unroll
            for (int n = 0; n < 2; ++n) gv[bj][n] = *(const f32x4*)(gate + col0 + bj * 128 + n * 16) * coef;
#pragma unroll
        for (int ai = 0; ai < 2; ++ai)
#pragma unroll
            for (int m = 0; m < 4; ++m) {
                const int row = row0 + ai * 128 + m * 16;
                const float* xr = (row < MP ? xin_p + (size_t)row * DM : xin_s + (size_t)(row - MP) * DM) + col0;
                float* xo = xout + (size_t)row * DM + col0;
#pragma unroll
                for (int bj = 0; bj < 2; ++bj)
#pragma unroll
                    for (int n = 0; n < 2; ++n) { const f32x4 xv = *(const f32x4*)(xr + bj * 128 + n * 16); *(f32x4*)(xo + bj * 128 + n * 16) = xv + gv[bj][n] * acc[ai][bj][m][n]; }
            }
    }
};
struct EpiStore {
    static constexpr bool PERM = true, AFTER_DRAIN = false;
    bf16* O; int ldc; int ncols;
    __device__ __forceinline__ void operator()(AccRef acc, const Unit& u, int wr, int wc, int fr, int fq) const {
        const int row0 = u.pm * 256 + wr * 64 + fr, col0 = u.pn * 256 + wc * 32 + 8 * fq;
#pragma unroll
        for (int ai = 0; ai < 2; ++ai)
#pragma unroll
            for (int m = 0; m < 4; ++m) {
                bf16* rowp = O + (size_t)(row0 + ai * 128 + m * 16) * ldc;
#pragma unroll
                for (int bj = 0; bj < 2; ++bj) { const int col = col0 + bj * 128; const f32x4 v0 = acc[ai][bj][m][0], v1 = acc[ai][bj][m][1];
                    u32x4 w; w.x = pk2(v0[0], v0[1]); w.y = pk2(v0[2], v0[3]); w.z = pk2(v1[0], v1[1]); w.w = pk2(v1[2], v1[3]);
                    if (col < ncols) *(u32x4*)(rowp + col) = w; }
            }
    }
};
struct EpiLora {
    static constexpr bool PERM = true, AFTER_DRAIN = false;
    bf16* O; const float* w0; const float* a0;
    __device__ __forceinline__ void operator()(AccRef acc, const Unit& u, int wr, int wc, int fr, int fq) const {
        const int seg = u.pn >> 1;
        const float* bias = seg < 2 ? w0 + seg * 512 : a0 + (seg & 1) * 512;
        const int row0 = u.pm * 256 + wr * 64 + fr, ct0 = wc * 32 + 8 * fq;
#pragma unroll
        for (int bj = 0; bj < 2; ++bj) {
            const int cseg = (u.pn & 1) * 256 + ct0 + bj * 128;
            f32x4 b0 = {0.f, 0.f, 0.f, 0.f}, b1 = {0.f, 0.f, 0.f, 0.f};
            if (seg < 4) { b0 = *(const f32x4*)(bias + cseg); b1 = *(const f32x4*)(bias + cseg + 4); }
#pragma unroll
            for (int ai = 0; ai < 2; ++ai)
#pragma unroll
                for (int m = 0; m < 4; ++m) {
                    f32x4 v0 = acc[ai][bj][m][0] + b0, v1 = acc[ai][bj][m][1] + b1;
                    if (seg < 4) {
                        const float sc = seg < 2 ? 0.60653066f : 1.0f;
#pragma unroll
                        for (int i = 0; i < 4; ++i) { v0[i] = sc * sigmoidf_(v0[i]); v1[i] = sc * sigmoidf_(v1[i]); }
                    }
                    u32x4 w; w.x = pk2(v0[0], v0[1]); w.y = pk2(v0[2], v0[3]); w.z = pk2(v1[0], v1[1]); w.w = pk2(v1[2], v1[3]);
                    *(u32x4*)(O + (size_t)(row0 + ai * 128 + m * 16) * 2560 + u.pn * 256 + ct0 + bj * 128) = w;
                    asm volatile("" ::: "memory");
                }
        }
    }
};
struct EpiQ {
    static constexpr bool PERM = true, AFTER_DRAIN = false;
    bf16* O; const float* rope;
    __device__ __forceinline__ void operator()(AccRef acc, const Unit& u, int wr, int wc, int fr, int fq) const {
        const int row0 = u.pm * 256 + wr * 64 + fr, col0 = u.pn * 256 + wc * 32 + 8 * fq;
        const float qs = 0.10206207261596577f;
#pragma unroll
        for (int bj = 0; bj < 2; ++bj) {
            const int col = col0 + bj * 128, e0 = col % 96;
            const bool is_rope = e0 >= 64;
#pragma unroll
            for (int ai = 0; ai < 2; ++ai)
#pragma unroll
                for (int m = 0; m < 4; ++m) {
                    const int row = row0 + ai * 128 + m * 16;
                    f32x4 v0 = acc[ai][bj][m][0] * qs, v1 = acc[ai][bj][m][1] * qs;
                    if (is_rope && row >= MP) {
                        const int t = (row - MP) & 1023;
                        const float* rt = rope + (size_t)t * 32 + (e0 - 64);
                        const f32x4 c0 = *(const f32x4*)(rt), c1 = *(const f32x4*)(rt + 4);
                        f32x4 r0, r1;
                        r0[0] = v0[0] * c0[0] - v0[1] * c0[1]; r0[1] = v0[0] * c0[1] + v0[1] * c0[0];
                        r0[2] = v0[2] * c0[2] - v0[3] * c0[3]; r0[3] = v0[2] * c0[3] + v0[3] * c0[2];
                        r1[0] = v1[0] * c1[0] - v1[1] * c1[1]; r1[1] = v1[0] * c1[1] + v1[1] * c1[0];
                        r1[2] = v1[2] * c1[2] - v1[3] * c1[3]; r1[3] = v1[2] * c1[3] + v1[3] * c1[2];
                        v0 = r0; v1 = r1;
                    }
                    u32x4 w; w.x = pk2(v0[0], v0[1]); w.y = pk2(v0[2], v0[3]); w.z = pk2(v1[0], v1[1]); w.w = pk2(v1[2], v1[3]);
                    *(u32x4*)(O + (size_t)row * 768 + col) = w;
                    asm volatile("" ::: "memory");
                }
        }
    }
};

struct EpiKV {
    static constexpr bool PERM = true, AFTER_DRAIN = false;
    bf16* KN; bf16* VT; int nrows;
    __device__ __forceinline__ void operator()(AccRef acc, const Unit& u, int wr, int wc, int fr, int fq) const {
        const int row0 = u.pm * 256 + wr * 64 + fr, col0 = u.pn * 256 + wc * 32 + 8 * fq;
#pragma unroll
        for (int bj = 0; bj < 2; ++bj) {
            const int col = col0 + bj * 128, head = col >> 7, e0 = col & 127;
#pragma unroll
            for (int ai = 0; ai < 2; ++ai)
#pragma unroll
                for (int m = 0; m < 4; ++m) {
                    const int row = row0 + ai * 128 + m * 16;
                    const f32x4 v0 = acc[ai][bj][m][0], v1 = acc[ai][bj][m][1];
                    u32x4 w; w.x = pk2(v0[0], v0[1]); w.y = pk2(v0[2], v0[3]); w.z = pk2(v1[0], v1[1]); w.w = pk2(v1[2], v1[3]);
                    if (e0 < 64) *(u32x4*)(KN + (size_t)row * 512 + head * 64 + e0) = w;
                    else { bf16* vp = VT + (size_t)(head * 64 + e0 - 64) * nrows + row;
#pragma unroll
                        for (int i = 0; i < 4; ++i) { vp[(size_t)(2 * i) * nrows] = (bf16)(w[i] & 0xffffu); vp[(size_t)(2 * i + 1) * nrows] = (bf16)(w[i] >> 16); } }
                }
        }
    }
};

__device__ __forceinline__ void ph_adaln(const P& p, LAS unsigned char* lds) {
    LAS float* scv = (LAS float*)lds;
    LAS float* red = scv + 9 * 1024;
    const int tid = tid_opaque(), tx = tid & 15, ty = tid >> 4;
    const float* cc = p.in[6]; const float* cctx = p.in[7];
    float* mod = (float*)(p.ws + WS_MOD);
    for (int i = tid; i < 9 * 1024; i += NTHREADS) { const int c = i >> 10, k = i & 1023; const float v = c == 0 ? cctx[k] : cc[(c - 1) * 1024 + k]; scv[i] = v / (1.0f + expf(-v)); }
    __syncthreads();
    for (int item = blockIdx.x; item < 288; item += gridDim.x) {
        const int l = item / 144, cgp = item % 144, col0 = cgp * 64 + tx * 4;
        const float* W = p.in[8] + (size_t)l * 1024 * 9216;
        f32x4 acc[9];
#pragma unroll
        for (int c = 0; c < 9; ++c) acc[c] = (f32x4){0.f, 0.f, 0.f, 0.f};
        for (int kk = 0; kk < 32; ++kk) {
            const int k = ty * 32 + kk;
            const f32x4 w = *(const f32x4*)(W + (size_t)k * 9216 + col0);
#pragma unroll
            for (int c = 0; c < 9; ++c) acc[c] += w * scv[c * 1024 + k];
        }
#pragma unroll
        for (int c = 0; c < 9; ++c) *(LAS f32x4*)(red + ty * 576 + c * 64 + tx * 4) = acc[c];
        __syncthreads();
        for (int o = tid; o < 576; o += NTHREADS) {
            float s = 0.f;
            for (int y = 0; y < 32; ++y) s += red[y * 576 + o];
            const int c = o >> 6, j = o & 63;
            mod[(size_t)(l * 9 + c) * 9216 + cgp * 64 + j] = s + p.in[9][l * 9216 + cgp * 64 + j];
        }
        __syncthreads();
    }
    float* rope = (float*)(p.ws + WS_ROPE);
    for (int idx = blockIdx.x * NTHREADS + tid; idx < 1024 * 16; idx += gridDim.x * NTHREADS) {
        const int t = idx >> 4, i = idx & 15;
        const float pos = (float)(i < 8 ? (t >> 6) : (t & 63));
        const float inv = powf(10000.0f, -(float)(i & 7) / 8.0f);
        const float ang = pos * inv;
        rope[idx * 2] = cosf(ang); rope[idx * 2 + 1] = sinf(ang);
    }
}

__device__ __forceinline__ void norm_rows(const P& p, int layer, int j, const float* gvec, bool from_input) {
    const int tid = tid_opaque(), lane = tid & 63, wave = tid >> 6;
    const float* mod = (const float*)(p.ws + WS_MOD);
    const float* x = p.out;
    bf16* h = (bf16*)(p.ws + WS_H);
    for (int row = blockIdx.x * 8 + wave; row < M_TOK; row += gridDim.x * 8) {
        const float* xr = from_input ? (row < MP ? p.in[0] + (size_t)row * DM : p.in[1] + (size_t)(row - MP) * DM) : x + (size_t)row * DM;
        const float* mrow = mod + (size_t)(layer * 9 + cond_of_row(row)) * 9216;
        const float* sh = mrow + (3 * j) * 1024; const float* sc = mrow + (3 * j + 1) * 1024;
        f32x4 v[4]; float ss = 0.f;
#pragma unroll
        for (int q = 0; q < 4; ++q) { v[q] = *(const f32x4*)(xr + lane * 4 + 256 * q); ss += v[q].x * v[q].x + v[q].y * v[q].y + v[q].z * v[q].z + v[q].w * v[q].w; }
        const float rstd = 1.0f / sqrtf(wave_sum(ss) * (1.0f / 1024.0f) + 1e-6f);
#pragma unroll
        for (int q = 0; q < 4; ++q) {
            const int col = lane * 4 + 256 * q;
            const f32x4 g = *(const f32x4*)(gvec + col), s1 = *(const f32x4*)(sc + col), s0 = *(const f32x4*)(sh + col);
            const f32x4 y = (v[q] * rstd * g) * (s1 + 1.0f) + s0;
            *(u32x2*)(h + (size_t)row * DM + col) = pk4(y);
        }
    }
}
__device__ __forceinline__ void final_norm_rows(const P& p) {
    const int tid = tid_opaque(), lane = tid & 63, wave = tid >> 6;
    float* x = p.out; const float* gvec = p.in[47];
    for (int row = blockIdx.x * 8 + wave; row < M_TOK; row += gridDim.x * 8) {
        float* xr = x + (size_t)row * DM;
        f32x4 v[4]; float ss = 0.f;
#pragma unroll
        for (int q = 0; q < 4; ++q) { v[q] = *(const f32x4*)(xr + lane * 4 + 256 * q); ss += v[q].x * v[q].x + v[q].y * v[q].y + v[q].z * v[q].z + v[q].w * v[q].w; }
        const float rstd = 1.0f / sqrtf(wave_sum(ss) * (1.0f / 1024.0f) + 1e-6f);
#pragma unroll
        for (int q = 0; q < 4; ++q) { const int col = lane * 4 + 256 * q; *(f32x4*)(xr + col) = v[q] * rstd * *(const f32x4*)(gvec + col); }
    }
}

template <int MODE>
__device__ __forceinline__ void transpose_w(const float* W, int ldw, int ncols_valid, int K, bf16* WT, int Nt, LAS unsigned char* lds) {
    const int tid = tid_opaque(), lane = tid & 63, wave = tid >> 6;
    LAS float* scr = (LAS float*)(lds + wave * 8448);
    const int nblk = Nt / 32, nitems = nblk * (K / 64);
    for (int it = blockIdx.x * 8 + wave; it < nitems; it += gridDim.x * 8) {
        const int kb = it / nblk, nb = it % nblk, k0 = kb * 64;
        const int sc0 = MODE == 1 ? (((nb >> 2) & 1) * DFF + (nb >> 3) * 128 + (nb & 3) * 32) : nb * 32;
        const int n = lane & 31; const bool ok = (sc0 + n) < ncols_valid;
#pragma unroll 8
        for (int i = 0; i < 32; ++i) { const int kk = 2 * i + (lane >> 5); scr[kk * 33 + n] = ok ? W[(size_t)(k0 + kk) * ldw + sc0 + n] : 0.f; }
        LDS_WAIT();
        const int c = lane & 7;
#pragma unroll
        for (int j = 0; j < 4; ++j) {
            const int nn = (lane >> 3) + 8 * j; const LAS float* s = scr + (8 * c) * 33 + nn;
            u32x4 o; o.x = pk2(s[0 * 33], s[1 * 33]); o.y = pk2(s[2 * 33], s[3 * 33]); o.z = pk2(s[4 * 33], s[5 * 33]); o.w = pk2(s[6 * 33], s[7 * 33]);
            *(u32x4*)(WT + (size_t)(nb * 32 + nn) * K + k0 + 8 * c) = o;
        }
        LDS_WAIT();
    }
}
__device__ __forceinline__ void convert_ffn_weights(const P& p, int layer, int which, LAS unsigned char* lds) {
    const float* wgu = p.in[which == 0 ? 13 : 15] + (size_t)layer * 1024 * 5632;
    const float* wdn = p.in[which == 0 ? 14 : 16] + (size_t)layer * 2816 * 1024;
    transpose_w<1>(wgu, 5632, 5632, 1024, (bf16*)(p.ws + W_GU), 5632, lds);
    transpose_w<0>(wdn, 1024, 1024, 2816, (bf16*)(p.ws + W_DOWN), 1024, lds);
}
__device__ __forceinline__ void build_lora_w(const P& p) {
    bf16* WT = (bf16*)(p.ws + W_LORA);
    const float* w_up = p.in[21]; const float* a_up = p.in[23]; const float* g_up = p.in[24];
    for (int idx = blockIdx.x * NTHREADS + tid_opaque(); idx < 2560 * 384; idx += gridDim.x * NTHREADS) {
        const int k = idx / 2560, n = idx % 2560, seg = n >> 9, c = n & 511;
        float v = 0.f;
        if (seg == 0) { if (k < 64) v = w_up[(0 * 64 + k) * 512 + c]; }
        else if (seg == 1) { if (k >= 64 && k < 128) v = w_up[(1 * 64 + k - 64) * 512 + c]; }
        else if (seg == 2) { if (k >= 128 && k < 192) v = a_up[(0 * 64 + k - 128) * 512 + c]; }
        else if (seg == 3) { if (k >= 192 && k < 256) v = a_up[(1 * 64 + k - 192) * 512 + c]; }
        else { if (k >= 256) v = g_up[(k - 256) * 512 + c]; }
        WT[(size_t)n * 384 + k] = (bf16)(pk2(v, 0.f) & 0xffffu);
    }
}

__device__ __forceinline__ void ph_lora_in(const P& p) {
    const int tid = tid_opaque(), lane = tid & 63, wave = tid >> 6;
    const bf16* p0 = (const bf16*)(p.ws + WS_R1); bf16* LA = (bf16*)(p.ws + WS_H);
    const float* mu = p.in[19];
    for (int row = blockIdx.x * 8 + wave; row < M_TOK; row += gridDim.x * 8) {
        const int t = row < MP ? (row & 255) : ((row - MP) & 1023), L = row < MP ? 256 : 1024;
        const bool hp = t > 0, hn = t < L - 1;
#pragma unroll
        for (int ch = 0; ch < 3; ++ch) {
            const int col = 1536 + ch * 128 + lane * 2;
            const bf16* pc = p0 + (size_t)row * LDP0 + col;
            const unsigned cur = *(const unsigned*)pc, prv = hp ? *(const unsigned*)(pc - LDP0) : 0u, nxt = hn ? *(const unsigned*)(pc + LDP0) : 0u;
            float m0 = bflo(cur) + mu[col] * (0.5f * (bflo(prv) + bflo(nxt)) - bflo(cur));
            float m1 = bfhi(cur) + mu[col + 1] * (0.5f * (bfhi(prv) + bfhi(nxt)) - bfhi(cur));
            if (ch == 0) { m0 = tanhf(m0); m1 = tanhf(m1); }
            if (ch == 2) { m0 = 1.0f / (1.0f + expf(-m0)); m1 = 1.0f / (1.0f + expf(-m1)); }
            *(unsigned*)(LA + (size_t)row * 384 + ch * 128 + lane * 2) = pk2(m0, m1);
        }
    }
}

__device__ __forceinline__ void scan_pair(const P& p, LAS unsigned char* lds, int kind, int gb, int ghead, int gdir, int ghalf, int rb, int rhead, int rdir) {
    constexpr int T = 16, SG = 336, SR = 400;
    LAS float* opsG = (LAS float*)lds;
    LAS float* opsR = opsG + 2 * T * SG;
    LAS float* ybG = opsR + 2 * T * SR;
    LAS float* ybR = ybG + 2 * T * 64;
    const int tid = tid_opaque(), lane = tid & 63, wave = tid >> 6, q = lane & 7, vl = lane >> 3;
    const bool isG = wave < 4;
    const int st = tid & 255, sw = wave & 3, r0 = sw * 16 + vl, r1 = r0 + 8;
    const int tt = st >> 4, cgi = st & 15;
    const int L = kind ? 1024 : 256, nblk = L / T;
    const int b = isG ? gb : rb, head = isG ? ghead : rhead, dir = isG ? gdir : rdir;
    const int rowbase = kind ? MP + b * 1024 : b * 256;
    const bf16* p0 = (const bf16*)(p.ws + WS_R1);
    const bf16* lo = (const bf16*)(p.ws + WS_R2);
    bf16* Y = (bf16*)(p.ws + (dir == 0 ? WS_MIX : WS_H));
    const int colbase = isG ? 512 + head * 128 + ghalf * 64 : head * 64;
    float S0[16], S1[16];
#pragma unroll
    for (int i = 0; i < 16; ++i) { S0[i] = 0.f; S1[i] = 0.f; }
    if (kind) {
        if (isG) { const float* s0 = p.in[3] + (((size_t)b * 2 + dir) * 4 + head) * 16384 + ghalf * 64;
#pragma unroll
            for (int i = 0; i < 16; ++i) { S0[i] = s0[(size_t)(q * 16 + i) * 128 + r0]; S1[i] = s0[(size_t)(q * 16 + i) * 128 + r1]; } }
        else { const float* s0 = p.in[2] + (((size_t)b * 2 + dir) * 8 + head) * 4096 + q * 8;
            const f32x4 a0 = *(const f32x4*)(s0 + r0 * 64), a1 = *(const f32x4*)(s0 + r0 * 64 + 4), c0 = *(const f32x4*)(s0 + r1 * 64), c1 = *(const f32x4*)(s0 + r1 * 64 + 4);
#pragma unroll
            for (int i = 0; i < 4; ++i) { S0[i] = a0[i]; S0[4 + i] = a1[i]; S1[i] = c0[i]; S1[4 + i] = c1[i]; } }
    }
    f32x4 cA = {0.f, 0.f, 0.f, 0.f}, cB = cA, cC = cA, cD = cA, cE = cA; float gA = 0.f, gB = 0.f;
    if (isG) { gA = -expf(p.in[31][dir * 4 + head]); gB = p.in[32][dir * 4 + head]; }
    else { const int C = head * 64 + cgi * 4;
        cA = *(const f32x4*)(p.in[19] + C); cB = *(const f32x4*)(p.in[19] + 512 + C); cC = *(const f32x4*)(p.in[19] + 1024 + C);
        cD = *(const f32x4*)(p.in[25] + C); cE = *(const f32x4*)(p.in[26] + C); }
    u32x4 ga0, ga1, ga2, gk0, gk1, gk2, gv0, gv1, gv2; unsigned rab = 0u, rbb = 0u;
    u32x2 ra0, ra1, ra2, rb0, rb1, rb2, rc0, rc1, rc2, rd, re;
    const u32x4 z4 = {0u, 0u, 0u, 0u}; const u32x2 z2 = {0u, 0u};
    ga0 = ga1 = ga2 = gk0 = gk1 = gk2 = gv0 = gv1 = gv2 = z4; ra0 = ra1 = ra2 = rb0 = rb1 = rb2 = rc0 = rc1 = rc2 = rd = re = z2;
#define SCAN_LOAD(blk) do { \
        const int n_ = (blk) * T + tt, t_ = dir ? L - 1 - n_ : n_; const size_t row_ = (size_t)(rowbase + t_); \
        const bool hp_ = t_ > 0, hn_ = t_ < L - 1; \
        if (isG) { const bf16* pr_ = p0 + row_ * LDP0 + 1920 + head * 128 + cgi * 8; \
            ga1 = *(const u32x4*)pr_; ga0 = hp_ ? *(const u32x4*)(pr_ - LDP0) : z4; ga2 = hn_ ? *(const u32x4*)(pr_ + LDP0) : z4; \
            gk1 = *(const u32x4*)(pr_ + 512); gk0 = hp_ ? *(const u32x4*)(pr_ + 512 - LDP0) : z4; gk2 = hn_ ? *(const u32x4*)(pr_ + 512 + LDP0) : z4; \
            gv1 = *(const u32x4*)(pr_ + 1024); gv0 = hp_ ? *(const u32x4*)(pr_ + 1024 - LDP0) : z4; gv2 = hn_ ? *(const u32x4*)(pr_ + 1024 + LDP0) : z4; \
            rab = p0[row_ * LDP0 + 3968 + dir * 8 + head]; rbb = p0[row_ * LDP0 + 3968 + dir * 8 + 4 + head]; \
        } else { const bf16* pr_ = p0 + row_ * LDP0 + head * 64 + cgi * 4; \
            ra1 = *(const u32x2*)pr_; ra0 = hp_ ? *(const u32x2*)(pr_ - LDP0) : z2; ra2 = hn_ ? *(const u32x2*)(pr_ + LDP0) : z2; \
            rb1 = *(const u32x2*)(pr_ + 512); rb0 = hp_ ? *(const u32x2*)(pr_ + 512 - LDP0) : z2; rb2 = hn_ ? *(const u32x2*)(pr_ + 512 + LDP0) : z2; \
            rc1 = *(const u32x2*)(pr_ + 1024); rc0 = hp_ ? *(const u32x2*)(pr_ + 1024 - LDP0) : z2; rc2 = hn_ ? *(const u32x2*)(pr_ + 1024 + LDP0) : z2; \
            rd = *(const u32x2*)(lo + row_ * 2560 + dir * 512 + head * 64 + cgi * 4); re = *(const u32x2*)(lo + row_ * 2560 + 1024 + dir * 512 + head * 64 + cgi * 4); } \
    } while (0)
#define CONV8(dst, w0p, x0, x1, x2) do { \
        const f32x4 wa0_ = *(const f32x4*)(w0p), wa1_ = *(const f32x4*)((w0p) + 4), wb0_ = *(const f32x4*)((w0p) + 1536), wb1_ = *(const f32x4*)((w0p) + 1540), wc0_ = *(const f32x4*)((w0p) + 3072), wc1_ = *(const f32x4*)((w0p) + 3076); \
        _Pragma("unroll") for (int i_ = 0; i_ < 4; ++i_) { \
            float lo_ = (i_ < 2 ? wa0_[2 * i_] : wa1_[2 * i_ - 4]) * bflo(x0[i_]) + (i_ < 2 ? wb0_[2 * i_] : wb1_[2 * i_ - 4]) * bflo(x1[i_]) + (i_ < 2 ? wc0_[2 * i_] : wc1_[2 * i_ - 4]) * bflo(x2[i_]); \
            float hi_ = (i_ < 2 ? wa0_[2 * i_ + 1] : wa1_[2 * i_ - 3]) * bfhi(x0[i_]) + (i_ < 2 ? wb0_[2 * i_ + 1] : wb1_[2 * i_ - 3]) * bfhi(x1[i_]) + (i_ < 2 ? wc0_[2 * i_ + 1] : wc1_[2 * i_ - 3]) * bfhi(x2[i_]); \
            dst[2 * i_] = lo_ / (1.0f + __expf(-lo_)); dst[2 * i_ + 1] = hi_ / (1.0f + __expf(-hi_)); } \
    } while (0)
#define SCAN_PREP(bi) do { \
        if (isG) { LAS float* slot_ = opsG + ((bi) * T + tt) * SG; \
            const float* cw_ = p.in[30] + head * 128 + cgi * 8; \
            float q_[8], k_[8], v_[8]; \
            CONV8(q_, cw_, ga0, ga1, ga2); CONV8(k_, cw_ + 512, gk0, gk1, gk2); CONV8(v_, cw_ + 1024, gv0, gv1, gv2); \
            float sq_ = 0.f, sk_ = 0.f; \
            _Pragma("unroll") for (int i_ = 0; i_ < 8; ++i_) { sq_ += q_[i_] * q_[i_]; sk_ += k_[i_] * k_[i_]; } \
            sq_ = red16(sq_); sk_ = red16(sk_); \
            const float nq_ = 0.08838834764831845f / sqrtf(sq_ + 1e-6f), nk_ = 1.0f / sqrtf(sk_ + 1e-6f); \
            float kq_ = 0.f; \
            _Pragma("unroll") for (int i_ = 0; i_ < 8; ++i_) { q_[i_] *= nq_; k_[i_] *= nk_; kq_ += q_[i_] * k_[i_]; } \
            kq_ = red16(kq_); \
            *(LAS f32x4*)(slot_ + cgi * 8) = (f32x4){k_[0], k_[1], k_[2], k_[3]}; *(LAS f32x4*)(slot_ + cgi * 8 + 4) = (f32x4){k_[4], k_[5], k_[6], k_[7]}; \
            *(LAS f32x4*)(slot_ + 128 + cgi * 8) = (f32x4){q_[0], q_[1], q_[2], q_[3]}; *(LAS f32x4*)(slot_ + 128 + cgi * 8 + 4) = (f32x4){q_[4], q_[5], q_[6], q_[7]}; \
            if ((cgi >> 3) == ghalf) { *(LAS f32x4*)(slot_ + 256 + (cgi & 7) * 8) = (f32x4){v_[0], v_[1], v_[2], v_[3]}; *(LAS f32x4*)(slot_ + 256 + (cgi & 7) * 8 + 4) = (f32x4){v_[4], v_[5], v_[6], v_[7]}; } \
            if (cgi == 0) { const float xa_ = bf2f(rab) + gB; const float sp_ = xa_ > 20.f ? xa_ : log1pf(expf(xa_)); \
                *(LAS f32x4*)(slot_ + 320) = (f32x4){expf(gA * sp_), 1.0f / (1.0f + expf(-bf2f(rbb))), kq_, 0.f}; } \
        } else { LAS float* slot_ = opsR + ((bi) * T + tt) * SR; const int c4_ = cgi * 4; \
            const f32x4 r1_ = unpk4(ra1), k1_ = unpk4(rb1), v1_ = unpk4(rc1); \
            const f32x4 r_ = r1_ + cA * ((unpk4(ra0) + unpk4(ra2)) * 0.5f - r1_); \
            const f32x4 k_ = k1_ + cB * ((unpk4(rb0) + unpk4(rb2)) * 0.5f - k1_); \
            const f32x4 v_ = v1_ + cC * ((unpk4(rc0) + unpk4(rc2)) * 0.5f - v1_); \
            f32x4 kk_ = k_ * cD; \
            const float ss_ = red16(kk_.x * kk_.x + kk_.y * kk_.y + kk_.z * kk_.z + kk_.w * kk_.w); \
            kk_ = kk_ * (1.0f / sqrtf(ss_ + 1e-6f)); \
            const f32x4 ew_ = unpk4(rd), a_ = unpk4(re); \
            f32x4 w_; w_.x = __expf(-ew_.x); w_.y = __expf(-ew_.y); w_.z = __expf(-ew_.z); w_.w = __expf(-ew_.w); \
            const f32x4 kd_ = k_ * ((a_ - 1.0f) * cE + 1.0f), b_ = kk_ * a_; \
            const float br_ = red16(b_.x * r_.x + b_.y * r_.y + b_.z * r_.z + b_.w * r_.w), kr_ = red16(kd_.x * r_.x + kd_.y * r_.y + kd_.z * r_.z + kd_.w * r_.w); \
            *(LAS f32x4*)(slot_ + c4_) = kk_; *(LAS f32x4*)(slot_ + 64 + c4_) = w_; *(LAS f32x4*)(slot_ + 128 + c4_) = b_; \
            *(LAS f32x4*)(slot_ + 192 + c4_) = kd_; *(LAS f32x4*)(slot_ + 256 + c4_) = w_ * r_; *(LAS f32x4*)(slot_ + 320 + c4_) = v_; \
            if (cgi == 0) *(LAS f32x2*)(slot_ + 384) = (f32x2){br_, kr_}; } \
    } while (0)
    __syncthreads();
    SCAN_LOAD(0); SCAN_PREP(0);
    __syncthreads();
#pragma unroll 1
    for (int blk = 0; blk < nblk; ++blk) {
        const int bi = blk & 1;
        if (blk + 1 < nblk) SCAN_LOAD(blk + 1);
        if (isG) {
            const LAS float* ob = opsG + bi * T * SG; LAS float* yb = ybG + bi * T * 64;
#pragma unroll 2
            for (int t = 0; t < T; ++t) {
                const LAS float* o = ob + t * SG;
                f32x2 k2[8], q2[8];
#pragma unroll
                for (int i = 0; i < 4; ++i) {
                    const f32x4 a = *(const LAS f32x4*)(o + q * 16 + 4 * i), c = *(const LAS f32x4*)(o + 128 + q * 16 + 4 * i);
                    k2[2 * i] = (f32x2){a.x, a.y}; k2[2 * i + 1] = (f32x2){a.z, a.w}; q2[2 * i] = (f32x2){c.x, c.y}; q2[2 * i + 1] = (f32x2){c.z, c.w};
                }
                const float vv0 = o[256 + r0], vv1 = o[256 + r1]; const f32x4 sc = *(const LAS f32x4*)(o + 320);
                f32x2 aK0 = {0.f, 0.f}, aQ0 = aK0, aK1 = aK0, aQ1 = aK0;
#pragma unroll
                for (int i = 0; i < 8; ++i) { const f32x2 s0 = {S0[2 * i], S0[2 * i + 1]}, s1 = {S1[2 * i], S1[2 * i + 1]};
                    aK0 = __builtin_elementwise_fma(s0, k2[i], aK0); aQ0 = __builtin_elementwise_fma(s0, q2[i], aQ0);
                    aK1 = __builtin_elementwise_fma(s1, k2[i], aK1); aQ1 = __builtin_elementwise_fma(s1, q2[i], aQ1); }
                const float sk0 = red8(aK0.x + aK0.y), sq0 = red8(aQ0.x + aQ0.y), sk1 = red8(aK1.x + aK1.y), sq1 = red8(aQ1.x + aQ1.y);
                const float d0 = sc.y * (vv0 - sc.x * sk0), d1 = sc.y * (vv1 - sc.x * sk1);
                const float y0 = sc.x * sq0 + d0 * sc.z, y1 = sc.x * sq1 + d1 * sc.z;
                const f32x2 e2 = {sc.x, sc.x}, d02 = {d0, d0}, d12 = {d1, d1};
#pragma unroll
                for (int i = 0; i < 8; ++i) { f32x2 s0 = {S0[2 * i], S0[2 * i + 1]}, s1 = {S1[2 * i], S1[2 * i + 1]};
                    s0 = __builtin_elementwise_fma(s0, e2, k2[i] * d02); s1 = __builtin_elementwise_fma(s1, e2, k2[i] * d12);
                    S0[2 * i] = s0.x; S0[2 * i + 1] = s0.y; S1[2 * i] = s1.x; S1[2 * i + 1] = s1.y; }
                if (q == 0) { yb[t * 64 + r0] = y0; yb[t * 64 + r1] = y1; }
            }
        } else {
            const LAS float* ob = opsR + bi * T * SR; LAS float* yb = ybR + bi * T * 64;
#pragma unroll 2
            for (int t = 0; t < T; ++t) {
                const LAS float* o = ob + t * SR;
                f32x2 kk[4], w[4], bb[4], kd[4], wr[4];
#pragma unroll
                for (int i = 0; i < 2; ++i) {
                    const f32x4 a0 = *(const LAS f32x4*)(o + q * 8 + 4 * i); kk[2 * i] = (f32x2){a0.x, a0.y}; kk[2 * i + 1] = (f32x2){a0.z, a0.w};
                    const f32x4 a1 = *(const LAS f32x4*)(o + 64 + q * 8 + 4 * i); w[2 * i] = (f32x2){a1.x, a1.y}; w[2 * i + 1] = (f32x2){a1.z, a1.w};
                    const f32x4 a2 = *(const LAS f32x4*)(o + 128 + q * 8 + 4 * i); bb[2 * i] = (f32x2){a2.x, a2.y}; bb[2 * i + 1] = (f32x2){a2.z, a2.w};
                    const f32x4 a3 = *(const LAS f32x4*)(o + 192 + q * 8 + 4 * i); kd[2 * i] = (f32x2){a3.x, a3.y}; kd[2 * i + 1] = (f32x2){a3.z, a3.w};
                    const f32x4 a4 = *(const LAS f32x4*)(o + 256 + q * 8 + 4 * i); wr[2 * i] = (f32x2){a4.x, a4.y}; wr[2 * i + 1] = (f32x2){a4.z, a4.w};
                }
                const float vv0 = o[320 + r0], vv1 = o[320 + r1]; const f32x2 sc = *(const LAS f32x2*)(o + 384);
                f32x2 aK0 = {0.f, 0.f}, aY0 = aK0, aK1 = aK0, aY1 = aK0;
#pragma unroll
                for (int i = 0; i < 4; ++i) { const f32x2 s0 = {S0[2 * i], S0[2 * i + 1]}, s1 = {S1[2 * i], S1[2 * i + 1]};
                    aK0 = __builtin_elementwise_fma(s0, kk[i], aK0); aY0 = __builtin_elementwise_fma(s0, wr[i], aY0);
                    aK1 = __builtin_elementwise_fma(s1, kk[i], aK1); aY1 = __builtin_elementwise_fma(s1, wr[i], aY1); }
                const float sk0 = red8(aK0.x + aK0.y), ys0 = red8(aY0.x + aY0.y), sk1 = red8(aK1.x + aK1.y), ys1 = red8(aY1.x + aY1.y);
                const float y0 = ys0 - sk0 * sc.x + vv0 * sc.y, y1 = ys1 - sk1 * sc.x + vv1 * sc.y;
                const f32x2 n0 = {-sk0, -sk0}, n1 = {-sk1, -sk1}, v02 = {vv0, vv0}, v12 = {vv1, vv1};
#pragma unroll
                for (int i = 0; i < 4; ++i) { f32x2 s0 = {S0[2 * i], S0[2 * i + 1]}, s1 = {S1[2 * i], S1[2 * i + 1]};
                    s0 = __builtin_elementwise_fma(s0, w[i], __builtin_elementwise_fma(n0, bb[i], v02 * kd[i]));
                    s1 = __builtin_elementwise_fma(s1, w[i], __builtin_elementwise_fma(n1, bb[i], v12 * kd[i]));
                    S0[2 * i] = s0.x; S0[2 * i + 1] = s0.y; S1[2 * i] = s1.x; S1[2 * i + 1] = s1.y; }
                if (q == 0) { yb[t * 64 + r0] = y0; yb[t * 64 + r1] = y1; }
            }
        }
        if (blk + 1 < nblk) SCAN_PREP(bi ^ 1);
        __syncthreads();
        {
            const LAS float* yb = (isG ? ybG : ybR) + bi * T * 64;
            const int r4 = cgi * 4, n = blk * T + tt, tk = dir ? L - 1 - n : n;
            const f32x4 yv = *(const LAS f32x4*)(yb + tt * 64 + r4);
            *(u32x2*)(Y + (size_t)(rowbase + tk) * 1024 + colbase + r4) = pk4(yv);
        }
    }
#undef SCAN_LOAD
#undef SCAN_PREP
#undef CONV8
    if (!kind) {
        if (isG) { float* so = p.out + OUT_SGD + (((size_t)b * 2 + dir) * 4 + head) * 16384 + ghalf * 64;
#pragma unroll
            for (int i = 0; i < 16; ++i) { so[(size_t)(q * 16 + i) * 128 + r0] = S0[i]; so[(size_t)(q * 16 + i) * 128 + r1] = S1[i]; } }
        else { float* so = p.out + OUT_SRW + (((size_t)b * 2 + dir) * 8 + head) * 4096 + q * 8;
            *(f32x4*)(so + r0 * 64) = (f32x4){S0[0], S0[1], S0[2], S0[3]}; *(f32x4*)(so + r0 * 64 + 4) = (f32x4){S0[4], S0[5], S0[6], S0[7]};
            *(f32x4*)(so + r1 * 64) = (f32x4){S1[0], S1[1], S1[2], S1[3]}; *(f32x4*)(so + r1 * 64 + 4) = (f32x4){S1[4], S1[5], S1[6], S1[7]}; }
    }
}
__device__ __forceinline__ void scan_pair_idx(const P& p, LAS unsigned char* lds, int i) {
    const int kind = i < 128 ? 1 : 0, j = i < 128 ? i : i - 128;
    scan_pair(p, lds, kind, j >> 4, (j >> 2) & 3, (j >> 1) & 1, j & 1, j >> 4, (j >> 1) & 7, j & 1);
}
__device__ __forceinline__ void ph_scan(const P& p, LAS unsigned char* lds) {
    const int B = blockIdx.x, G = gridDim.x;
    if (G == 256) {
        if (B < 128) scan_pair_idx(p, lds, B);
        else { for (int i = 0; i < 4; ++i) scan_pair_idx(p, lds, 128 + (B - 128) * 4 + i); }
    } else {
        for (int i = B; i < 640; i += G) scan_pair_idx(p, lds, i);
    }
}

__device__ __forceinline__ void ph_post_ab(const P& p, bool dummy) {
    const int tid = tid_opaque(), lane = tid & 63, wave = tid >> 6;
    const bf16* p0 = (const bf16*)(p.ws + WS_R1); const bf16* lo = (const bf16*)(p.ws + WS_R2);
    bf16* MX = (bf16*)(p.ws + WS_MIX); const bf16* YB = (const bf16*)(p.ws + WS_H);
    bf16* MO = dummy ? (bf16*)(p.out + OUT_CKV) : MX;
    const int C = lane * 8;
    float mur[8], muk[8], muv[8], ka[8], rk[8], lw[8], lb[8], gn[8];
#pragma unroll
    for (int i = 0; i < 8; ++i) { mur[i] = p.in[19][C + i]; muk[i] = p.in[19][512 + C + i]; muv[i] = p.in[19][1024 + C + i]; ka[i] = p.in[26][C + i]; rk[i] = p.in[27][C + i];
        lw[i] = p.in[28][C + i]; lb[i] = p.in[29][C + i]; gn[i] = p.in[33][(C + i) & 127]; }
    for (int row = blockIdx.x * 8 + wave; row < M_TOK; row += gridDim.x * 8) {
        const int t = row < MP ? (row & 255) : ((row - MP) & 1023), L = row < MP ? 256 : 1024;
        const bool hp = t > 0, hn = t < L - 1;
        const u32x4 z4 = {0u, 0u, 0u, 0u};
        const bf16* pr = p0 + (size_t)row * LDP0 + C;
        float r[8], k[8], v[8];
        {
            const u32x4 c = *(const u32x4*)pr, a = hp ? *(const u32x4*)(pr - LDP0) : z4, n = hn ? *(const u32x4*)(pr + LDP0) : z4;
#pragma unroll
            for (int i = 0; i < 4; ++i) { float c0 = bflo(c[i]), c1 = bfhi(c[i]); r[2 * i] = c0 + mur[2 * i] * (0.5f * (bflo(a[i]) + bflo(n[i])) - c0); r[2 * i + 1] = c1 + mur[2 * i + 1] * (0.5f * (bfhi(a[i]) + bfhi(n[i])) - c1); }
        }
        {
            const u32x4 c = *(const u32x4*)(pr + 512), a = hp ? *(const u32x4*)(pr + 512 - LDP0) : z4, n = hn ? *(const u32x4*)(pr + 512 + LDP0) : z4;
#pragma unroll
            for (int i = 0; i < 4; ++i) { float c0 = bflo(c[i]), c1 = bfhi(c[i]); k[2 * i] = c0 + muk[2 * i] * (0.5f * (bflo(a[i]) + bflo(n[i])) - c0); k[2 * i + 1] = c1 + muk[2 * i + 1] * (0.5f * (bfhi(a[i]) + bfhi(n[i])) - c1); }
        }
        {
            const u32x4 c = *(const u32x4*)(pr + 1024), a = hp ? *(const u32x4*)(pr + 1024 - LDP0) : z4, n = hn ? *(const u32x4*)(pr + 1024 + LDP0) : z4;
#pragma unroll
            for (int i = 0; i < 4; ++i) { float c0 = bflo(c[i]), c1 = bfhi(c[i]); v[2 * i] = c0 + muv[2 * i] * (0.5f * (bflo(a[i]) + bflo(n[i])) - c0); v[2 * i + 1] = c1 + muv[2 * i + 1] * (0.5f * (bfhi(a[i]) + bfhi(n[i])) - c1); }
        }
        const u32x4 af = *(const u32x4*)(lo + (size_t)row * 2560 + 1024 + C), ab = *(const u32x4*)(lo + (size_t)row * 2560 + 1536 + C), gg = *(const u32x4*)(lo + (size_t)row * 2560 + 2048 + C);
        const u32x4 yf = *(const u32x4*)(MX + (size_t)row * 1024 + C), yb = *(const u32x4*)(YB + (size_t)row * 1024 + C);
        float y[8], s = 0.f, bon = 0.f;
#pragma unroll
        for (int i = 0; i < 4; ++i) {
            y[2 * i] = bflo(yf[i]) + bflo(yb[i]); y[2 * i + 1] = bfhi(yf[i]) + bfhi(yb[i]); s += y[2 * i] + y[2 * i + 1];
            const float am0 = 0.5f * (bflo(af[i]) + bflo(ab[i])), am1 = 0.5f * (bfhi(af[i]) + bfhi(ab[i]));
            bon += r[2 * i] * k[2 * i] * (1.0f + (am0 - 1.0f) * ka[2 * i]) * rk[2 * i] + r[2 * i + 1] * k[2 * i + 1] * (1.0f + (am1 - 1.0f) * ka[2 * i + 1]) * rk[2 * i + 1];
        }
        const float mean = red8(s) * (1.0f / 64.0f); bon = red8(bon);
        float q2 = 0.f;
#pragma unroll
        for (int i = 0; i < 8; ++i) { y[i] -= mean; q2 += y[i] * y[i]; }
        const float rstd = 1.0f / sqrtf(red8(q2) * (1.0f / 64.0f) + 64e-5f);
        u32x4 o;
#pragma unroll
        for (int i = 0; i < 4; ++i) {
            const float o0 = (y[2 * i] * rstd * lw[2 * i] + lb[2 * i] + bon * v[2 * i]) * bflo(gg[i]);
            const float o1 = (y[2 * i + 1] * rstd * lw[2 * i + 1] + lb[2 * i + 1] + bon * v[2 * i + 1]) * bfhi(gg[i]);
            o[i] = pk2(o0, o1);
        }
        const size_t orow = dummy ? (size_t)(row & 4095) : (size_t)row;
        *(u32x4*)(MO + orow * 1024 + C) = o;
        const u32x4 of = *(const u32x4*)(MX + (size_t)row * 1024 + 512 + C), ob = *(const u32x4*)(YB + (size_t)row * 1024 + 512 + C);
        const u32x4 zz = *(const u32x4*)(p0 + (size_t)row * LDP0 + 1920 + 1536 + C);
        float og[8], so = 0.f;
#pragma unroll
        for (int i = 0; i < 4; ++i) { og[2 * i] = bflo(of[i]) + bflo(ob[i]); og[2 * i + 1] = bfhi(of[i]) + bfhi(ob[i]); so += og[2 * i] * og[2 * i] + og[2 * i + 1] * og[2 * i + 1]; }
        const float rs = 1.0f / sqrtf(red16(so) * (1.0f / 128.0f) + 1e-6f);
        u32x4 o2;
#pragma unroll
        for (int i = 0; i < 4; ++i) { const float z0 = bflo(zz[i]), z1 = bfhi(zz[i]);
            o2[i] = pk2(og[2 * i] * rs * gn[2 * i] * siluf_(z0), og[2 * i + 1] * rs * gn[2 * i + 1] * siluf_(z1)); }
        *(u32x4*)(MO + orow * 1024 + 512 + C) = o2;
    }
}

__device__ __forceinline__ void ph_hyena_filters(const P& p, LAS unsigned char* lds) {
    LAS float* f0 = (LAS float*)lds;
    LAS float* h1 = f0 + 16 * 36;
    LAS float* h2 = h1 + 16 * 64;
    const int tid = tid_opaque();
    const float* w1 = p.in[40]; const float* b1 = p.in[41]; const float* w2 = p.in[42]; const float* b2 = p.in[43]; const float* w3 = p.in[44]; const float* fr = p.in[45];
    for (int item = blockIdx.x; item < 80; item += gridDim.x) {
        const int ls = item < 64 ? 1 : 0;
        const int L = ls ? 1024 : 256, t0 = (ls ? item : item - 64) * 16;
        __syncthreads();
        for (int e = tid; e < 16 * 33; e += NTHREADS) {
            const int pi = e / 33, f = e % 33; const float t = (float)(t0 + pi);
            float v;
            if (f == 0) v = t / (float)(L - 1);
            else { const int bi = (f - 1) & 15; const float band = 1e-4f + (15.0f - 1e-4f) * ((float)bi / 15.0f); const float ang = (6.283185307179586f / (float)L) * t * band; v = f <= 16 ? cosf(ang) : -sinf(ang); }
            f0[pi * 36 + f] = v;
        }
        __syncthreads();
#pragma unroll 1
        for (int e = tid; e < 1024; e += NTHREADS) { const int pi = e >> 6, j = e & 63; float s = b1[j];
#pragma unroll 3
            for (int f = 0; f < 33; ++f) s += f0[pi * 36 + f] * w1[f * 64 + j];
            h1[pi * 64 + j] = sinf(fr[j] * s); }
        __syncthreads();
#pragma unroll 1
        for (int e = tid; e < 1024; e += NTHREADS) { const int pi = e >> 6, j = e & 63; float s = b2[j];
#pragma unroll 4
            for (int f = 0; f < 64; ++f) s += h1[pi * 64 + f] * w2[f * 64 + j];
            h2[j * 16 + pi] = sinf(fr[64 + j] * s); }
        __syncthreads();
        bf16* G = (bf16*)(p.ws + (ls ? WS_GFS : WS_GFP));
#pragma unroll 1
        for (int oo = 0; oo < 4; ++oo) {
            const int o = tid + oo * 512;
            const int order = o >> 10, dr = (o >> 9) & 1, c = o & 511;
            f32x4 s0 = {0.f, 0.f, 0.f, 0.f}, s1 = s0, s2 = s0, s3 = s0;
#pragma unroll 4
            for (int f = 0; f < 64; ++f) { const float w = w3[f * 2048 + o]; const LAS f32x4* hp = (const LAS f32x4*)(h2 + f * 16);
                s0 += hp[0] * w; s1 += hp[1] * w; s2 += hp[2] * w; s3 += hp[3] * w; }
            const float delta = 3.0701134573253944f + (15.350567286626973f - 3.0701134573253944f) * ((float)c / 511.0f);
            float val[16];
#pragma unroll
            for (int i = 0; i < 4; ++i) { val[i] = s0[i]; val[4 + i] = s1[i]; val[8 + i] = s2[i]; val[12 + i] = s3[i]; }
            bf16* g = G + ((size_t)order * 512 + c) * (2 * L);
#pragma unroll
            for (int pi = 0; pi < 16; ++pi) {
                const int t = t0 + pi; const float tn = (float)t / (float)(L - 1);
                const bf16 hv = (bf16)(pk2(val[pi] * expf(-tn * delta), 0.f) & 0xffffu);
                if (dr == 0) g[L - t] = hv;
                else if (t > 0) g[L + t] = hv;
            }
            if (dr == 0 && t0 == 0) g[0] = 0;
        }
    }
}

__device__ __forceinline__ void ph_mla_prep(const P& p, LAS unsigned char* lds) {
    const int tid = tid_opaque(), lane = tid & 63, wave = tid >> 6;
    const bf16* p1 = (const bf16*)(p.ws + WS_R1);
    bf16* qn = (bf16*)(p.ws + WS_H); bf16* ckva = (bf16*)(p.ws + WS_CKVA); bf16* kpea = (bf16*)(p.ws + WS_KPEA);
    const float* rope = (const float*)(p.ws + WS_ROPE);
    const float* qg = p.in[35]; const float* kg = p.in[37];
    for (int row = blockIdx.x * 8 + wave; row < M_TOK + 2048; row += gridDim.x * 8) {
        if (row < M_TOK) {
            const bf16* pr = p1 + (size_t)row * LDP1;
            float qv[6]; float ss = 0.f;
#pragma unroll
            for (int j = 0; j < 3; ++j) { const unsigned w = *(const unsigned*)(pr + j * 128 + lane * 2); qv[2 * j] = bflo(w); qv[2 * j + 1] = bfhi(w); ss += qv[2 * j] * qv[2 * j] + qv[2 * j + 1] * qv[2 * j + 1]; }
            const float rq = 1.0f / sqrtf(wave_sum(ss) * (1.0f / 384.0f) + 1e-6f);
#pragma unroll
            for (int j = 0; j < 3; ++j) { const int col = j * 128 + lane * 2; *(unsigned*)(qn + (size_t)row * 384 + col) = pk2(qv[2 * j] * rq * qg[col], qv[2 * j + 1] * rq * qg[col + 1]); }
            const f32x4 kv = unpk4(*(const u32x2*)(pr + 384 + lane * 4));
            const float rk = 1.0f / sqrtf(wave_sum(kv.x * kv.x + kv.y * kv.y + kv.z * kv.z + kv.w * kv.w) * (1.0f / 256.0f) + 1e-6f);
            const f32x4 ck = kv * rk * *(const f32x4*)(kg + lane * 4);
            *(u32x2*)(ckva + (size_t)row * 256 + lane * 4) = pk4(ck);
            if (row < MP) *(f32x4*)(p.out + OUT_CKV + (size_t)row * 256 + lane * 4) = ck;
            if (lane < 16) {
                const unsigned w = *(const unsigned*)(pr + 640 + lane * 2); float x1 = bflo(w), x2 = bfhi(w);
                if (row < MP) { *(f32x2*)(p.out + OUT_KPE + (size_t)row * 32 + lane * 2) = (f32x2){x1, x2}; }
                else { const int t = (row - MP) & 1023; const f32x2 cs = *(const f32x2*)(rope + (size_t)t * 32 + lane * 2); const float a = x1 * cs.x - x2 * cs.y, bq = x1 * cs.y + x2 * cs.x; x1 = a; x2 = bq; }
                *(unsigned*)(kpea + (size_t)row * 32 + lane * 2) = pk2(x1, x2);
            }
        } else {
            const int r2 = row - M_TOK;
            const f32x4 cv = *(const f32x4*)(p.in[4] + (size_t)r2 * 256 + lane * 4);
            *(u32x2*)(ckva + (size_t)row * 256 + lane * 4) = pk4(cv);
            if (lane < 16) { const f32x2 kp = *(const f32x2*)(p.in[5] + (size_t)r2 * 32 + lane * 2); *(unsigned*)(kpea + (size_t)row * 32 + lane * 2) = pk2(kp.x, kp.y); }
        }
    }
    LAS float* tile = (LAS float*)(lds + wave * 8832);
    bf16* HT = (bf16*)(p.ws + WS_HYIN);
    const float* cw = p.in[39];
    for (int it = blockIdx.x * 8 + wave; it < 256 * 48; it += gridDim.x * 8) {
        const int rt = it / 48, cb = it % 48;
        const int r0 = rt * 64, col0 = 672 + cb * 32;
        const int t0 = r0 < MP ? (r0 & 255) : ((r0 - MP) & 1023), L = r0 < MP ? 256 : 1024;
#pragma unroll 1
        for (int i = 0; i < 17; ++i) {
            const int rr = i * 4 + (lane >> 4);
            if (rr < 66) {
                const int tt = t0 - 1 + rr; unsigned w = 0u;
                if (tt >= 0 && tt < L) w = *(const unsigned*)(p1 + (size_t)(r0 - 1 + rr) * LDP1 + col0 + (lane & 15) * 2);
                tile[rr * 33 + (lane & 15) * 2] = bflo(w); tile[rr * 33 + (lane & 15) * 2 + 1] = bfhi(w);
            }
        }
        LDS_WAIT();
#pragma unroll 4
        for (int c = 0; c < 32; ++c) {
            const int ch = cb * 32 + c;
            const float v = cw[ch] * tile[lane * 33 + c] + cw[1536 + ch] * tile[(lane + 1) * 33 + c] + cw[3072 + ch] * tile[(lane + 2) * 33 + c];
            HT[(size_t)ch * M_TOK + r0 + lane] = (bf16)(pk2(v, 0.f) & 0xffffu);
        }
        LDS_WAIT();
    }
}

__device__ __forceinline__ void attn_item(const P& p, LAS unsigned char* lds, int kind, int b, int head, int qt) {
    constexpr int TILE_B = 64 * 104 * 2 + 64 * 72 * 2;
    const int tid = tid_opaque(), lane = tid & 63, wave = tid >> 6, ln = lane & 15, h = lane >> 4;
    const bf16* Q = (const bf16*)(p.ws + WS_Q); const bf16* KN = (const bf16*)(p.ws + WS_KV); const bf16* VT = (const bf16*)(p.ws + WS_VT); const bf16* KPE = (const bf16*)(p.ws + WS_KPEA);
    bf16* MX = (bf16*)(p.ws + WS_MIX);
    const int nkeys = kind ? 1280 : 256, rowbase = kind ? MP + b * 1024 : b * 256, ntiles = nkeys / 64;
    const int qrow = rowbase + qt * 128 + wave * 16 + ln;
    s16x8 qf[3];
#pragma unroll
    for (int s = 0; s < 3; ++s) qf[s] = *(const s16x8*)(Q + (size_t)qrow * 768 + head * 96 + 32 * s + 8 * h);
    f32x4 o[4];
#pragma unroll
    for (int i = 0; i < 4; ++i) o[i] = (f32x4){0.f, 0.f, 0.f, 0.f};
    float mrun = -1e30f, lrun = 0.f;
    const int k0key = tid / 12, k0ch = tid % 12, k1key = (tid + 512) / 12, k1ch = (tid + 512) % 12, vv = tid >> 3, vkc = tid & 7;
    u32x4 rk0, rk1 = {0u, 0u, 0u, 0u}, rv;
#define ATT_LOAD(it) do { const int j0_ = (it) * 64; \
        const int kb_ = kind ? (j0_ < 1024 ? MP + b * 1024 + j0_ : M_TOK + b * 256 + (j0_ - 1024)) : b * 256 + j0_; \
        rk0 = *(const u32x4*)(k0ch < 8 ? KN + (size_t)(kb_ + k0key) * 512 + head * 64 + k0ch * 8 : KPE + (size_t)(kb_ + k0key) * 32 + (k0ch - 8) * 8); \
        if (tid < 256) rk1 = *(const u32x4*)(k1ch < 8 ? KN + (size_t)(kb_ + k1key) * 512 + head * 64 + k1ch * 8 : KPE + (size_t)(kb_ + k1key) * 32 + (k1ch - 8) * 8); \
        rv = *(const u32x4*)(VT + (size_t)(head * 64 + vv) * (M_TOK + 2048) + kb_ + vkc * 8); } while (0)
    __syncthreads();
    ATT_LOAD(0);
#pragma unroll 1
    for (int it = 0; it < ntiles; ++it) {
        LAS bf16* Kt = (LAS bf16*)(lds + (it & 1) * TILE_B);
        LAS bf16* Vt = Kt + 64 * 104;
        *(LAS u32x4*)(Kt + k0key * 104 + k0ch * 8) = rk0;
        if (tid < 256) *(LAS u32x4*)(Kt + k1key * 104 + k1ch * 8) = rk1;
        *(LAS u32x4*)(Vt + vv * 72 + vkc * 8) = rv;
        __syncthreads();
        if (it + 1 < ntiles) ATT_LOAD(it + 1);
        f32x4 sc[4]; float mx = -1e30f;
#pragma unroll
        for (int kt = 0; kt < 4; ++kt) {
            f32x4 a = {0.f, 0.f, 0.f, 0.f};
#pragma unroll
            for (int s = 0; s < 3; ++s) { const s16x8 kf = *(const LAS s16x8*)(Kt + (kt * 16 + ln) * 104 + 32 * s + 8 * h); a = __builtin_amdgcn_mfma_f32_16x16x32_bf16(kf, qf[s], a, 0, 0, 0); }
            sc[kt] = a; mx = fmaxf(mx, fmaxf(fmaxf(a[0], a[1]), fmaxf(a[2], a[3])));
        }
        mx = fmaxf(mx, __shfl_xor(mx, 16)); mx = fmaxf(mx, __shfl_xor(mx, 32));
        const float mnew = fmaxf(mrun, mx), alpha = __expf(mrun - mnew);
        mrun = mnew;
        float ps = 0.f;
#pragma unroll
        for (int kt = 0; kt < 4; ++kt)
#pragma unroll
            for (int r = 0; r < 4; ++r) { sc[kt][r] = __expf(sc[kt][r] - mnew); ps += sc[kt][r]; }
        lrun = lrun * alpha + ps;
#pragma unroll
        for (int i = 0; i < 4; ++i) o[i] = o[i] * alpha;
#pragma unroll
        for (int s = 0; s < 2; ++s) {
            u32x4 pw; pw.x = pk2(sc[2 * s][0], sc[2 * s][1]); pw.y = pk2(sc[2 * s][2], sc[2 * s][3]); pw.z = pk2(sc[2 * s + 1][0], sc[2 * s + 1][1]); pw.w = pk2(sc[2 * s + 1][2], sc[2 * s + 1][3]);
            const s16x8 pf = __builtin_bit_cast(s16x8, pw);
#pragma unroll
            for (int vt = 0; vt < 4; ++vt) {
                const LAS bf16* vp = Vt + (vt * 16 + ln) * 72 + 32 * s + 4 * h;
                const u32x2 lo2 = *(const LAS u32x2*)vp, hi2 = *(const LAS u32x2*)(vp + 16);
                const u32x4 vw = {lo2.x, lo2.y, hi2.x, hi2.y};
                o[vt] = __builtin_amdgcn_mfma_f32_16x16x32_bf16(__builtin_bit_cast(s16x8, vw), pf, o[vt], 0, 0, 0);
            }
        }
    }
#undef ATT_LOAD
    lrun += __shfl_xor(lrun, 16); lrun += __shfl_xor(lrun, 32);
    const float inv = 1.0f / lrun;
#pragma unroll
    for (int vt = 0; vt < 4; ++vt) *(u32x2*)(MX + (size_t)qrow * 1024 + head * 64 + vt * 16 + 4 * h) = pk4(o[vt] * inv);
}

__device__ __forceinline__ void hyena_item(const P& p, LAS unsigned char* lds, int kind, int cgp) {
    const int tid = tid_opaque(), lane = tid & 63, wave = tid >> 6, ci = wave >> 2, qtr = wave & 3;
    const int L = kind ? 1024 : 256, NB = kind ? 8 : 32, base = kind ? MP : 0, c = cgp * 2 + ci;
    const int DMAX = kind ? 31 : 7;
    LAS bf16* zb = (LAS bf16*)lds;
    LAS bf16* gb = zb + 2 * 8192;
    const bf16* HT = (const bf16*)(p.ws + WS_HYIN);
    const bf16* G = (const bf16*)(p.ws + (kind ? WS_GFS : WS_GFP));
    bf16* MX = (bf16*)(p.ws + WS_MIX);
    __syncthreads();
    for (int i = tid; i < 2 * 1024; i += NTHREADS) { const int cc = i >> 10, off = (i & 1023) * 8;
        *(LAS u32x4*)(zb + cc * 8192 + off) = *(const u32x4*)(HT + (size_t)(cgp * 2 + cc) * M_TOK + base + off); }
    for (int i = tid; i < 4 * (2 * L / 8); i += NTHREADS) { const int co = i / (2 * L / 8), off = (i % (2 * L / 8)) * 8, cc = co >> 1, od = co & 1;
        *(LAS u32x4*)(gb + (cc * 2 + od) * 2 * L + off) = *(const u32x4*)(G + ((size_t)od * 512 + cgp * 2 + cc) * (2 * L) + off); }
    __syncthreads();
    const int n = lane & 31, h = lane >> 5;
    const int jl = kind ? (n >> 3) : 0, bb = kind ? (n & 7) : n;
    const LAS bf16* zc = zb + ci * 8192 + bb * L;
#pragma unroll 1
    for (int order = 0; order < 2; ++order) {
        const LAS bf16* gr = gb + (ci * 2 + order) * 2 * L;
        f32x16 acc[2];
#pragma unroll
        for (int g = 0; g < 2; ++g)
#pragma unroll
            for (int r = 0; r < 16; ++r) acc[g][r] = 0.f;
        const int Ilo_w = kind ? 8 * qtr : 2 * qtr, Ihi_w = kind ? 8 * qtr + 7 : 2 * qtr + 1;
        int Dlo = Ilo_w - (L / 32 - 1), Dhi = Ihi_w; if (Dlo < -DMAX) Dlo = -DMAX; if (Dhi > DMAX) Dhi = DMAX;
#pragma unroll 1
        for (int D = Dlo; D <= Dhi; ++D) {
#pragma unroll
            for (int ks = 0; ks < 2; ++ks) {
                const int idx = L - 32 * D + 16 * ks + 8 * h - n;
                u32x4 aw;
                aw.x = (unsigned)gr[idx] | ((unsigned)gr[idx + 1] << 16); aw.y = (unsigned)gr[idx + 2] | ((unsigned)gr[idx + 3] << 16);
                aw.z = (unsigned)gr[idx + 4] | ((unsigned)gr[idx + 5] << 16); aw.w = (unsigned)gr[idx + 6] | ((unsigned)gr[idx + 7] << 16);
                const s16x8 af = __builtin_bit_cast(s16x8, aw);
#pragma unroll
                for (int g = 0; g < 2; ++g) {
                    const int og = qtr * 2 + g;
                    const int Ilo = kind ? 4 * og : og, Ihi = kind ? 4 * og + 3 : og;
                    if (Ihi - D >= 0 && Ilo - D <= (L / 32 - 1)) {
                        const int J = (kind ? 4 * og + jl : og) - D;
                        u32x4 bw = {0u, 0u, 0u, 0u};
                        if (J >= 0 && J < L / 32) bw = *(const LAS u32x4*)(zc + 32 * J + 16 * ks + 8 * h);
                        acc[g] = __builtin_amdgcn_mfma_f32_32x32x16_bf16(af, __builtin_bit_cast(s16x8, bw), acc[g], 0, 0, 0);
                    }
                }
            }
        }
        const float bias = p.in[46][order * 512 + c];
        const bf16* gate = HT + (size_t)((order + 1) * 512 + c) * M_TOK + base + bb * L;
        u32x2 zn[2][4];
#pragma unroll
        for (int g = 0; g < 2; ++g) {
            const int og = qtr * 2 + g, I = kind ? 4 * og + jl : og;
#pragma unroll
            for (int rq = 0; rq < 4; ++rq) {
                const int t = 32 * I + 8 * rq + 4 * h;
                const f32x4 zo = unpk4(*(const LAS u32x2*)(zc + t)), gt = unpk4(*(const u32x2*)(gate + t));
                f32x4 y; y.x = acc[g][4 * rq]; y.y = acc[g][4 * rq + 1]; y.z = acc[g][4 * rq + 2]; y.w = acc[g][4 * rq + 3];
                zn[g][rq] = pk4(gt * (y + zo * bias));
            }
        }
        if (order == 0) {
            __syncthreads();
#pragma unroll
            for (int g = 0; g < 2; ++g) { const int og = qtr * 2 + g, I = kind ? 4 * og + jl : og;
#pragma unroll
                for (int rq = 0; rq < 4; ++rq) *(LAS u32x2*)(zb + ci * 8192 + bb * L + 32 * I + 8 * rq + 4 * h) = zn[g][rq]; }
            __syncthreads();
        } else {
#pragma unroll
            for (int g = 0; g < 2; ++g) { const int og = qtr * 2 + g, I = kind ? 4 * og + jl : og;
#pragma unroll
                for (int rq = 0; rq < 4; ++rq) { const int t = 32 * I + 8 * rq + 4 * h; bf16* dst = MX + (size_t)(base + bb * L + t) * 1024 + 512 + c;
                    dst[0] = (bf16)(zn[g][rq].x & 0xffffu); dst[1024] = (bf16)(zn[g][rq].x >> 16); dst[2048] = (bf16)(zn[g][rq].y & 0xffffu); dst[3072] = (bf16)(zn[g][rq].y >> 16); } }
        }
    }
}
__device__ __forceinline__ void ph_attn_hyena(const P& p, LAS unsigned char* lds) {
    const int B = blockIdx.x, G = gridDim.x;
#ifndef T_NO_ATTN
    for (int i = B; i < 1024; i += G) { if (i < 512) attn_item(p, lds, 1, i >> 6, (i >> 3) & 7, i & 7); else { const int j = i - 512; attn_item(p, lds, 0, j >> 4, (j >> 1) & 7, j & 1); } }
#endif
#ifndef T_NO_HY
    for (int i = B; i < 512; i += G) { hyena_item(p, lds, i < 256 ? 1 : 0, i & 255); }
#endif
}

#define XB_TMO      128
#define XB_XCNT(j)  (256  + 64 * (j))
#define XB_XSUB(j)  (1280 + 64 * (j))
#define XB_XGEN(j)  (2304 + 64 * (j))
#define XB_TOP      3328
#define XB_TOPGEN   3392
#define XCD_BAR_WORDS 3456
#define XB_SPIN_CAP (1u << 18)

__device__ __forceinline__ unsigned xb_ld(unsigned* p)              { return __hip_atomic_load(p, __ATOMIC_RELAXED, __HIP_MEMORY_SCOPE_AGENT); }
__device__ __forceinline__ unsigned xb_add(unsigned* p, unsigned v) { return __hip_atomic_fetch_add(p, v, __ATOMIC_RELAXED, __HIP_MEMORY_SCOPE_AGENT); }
__device__ __forceinline__ unsigned xb_xcc_id() { return (unsigned)__builtin_amdgcn_s_getreg((3 << 11) | 20) & 0xFu; }
#define XB_SPIN(cond, bar) do { unsigned _sp = 0; while (cond) { __builtin_amdgcn_s_sleep(1); \
    if ((++_sp & 255u) == 0u) { if (xb_ld(&(bar)[XB_TMO])) break; if (_sp > XB_SPIN_CAP) { atomicAdd(&(bar)[XB_TMO], 1u); break; } } } } while (0)

struct XcdBarrier {
    unsigned* bar; unsigned x;
    volatile LAS unsigned* st;
};

__device__ __forceinline__ XcdBarrier xcd_barrier_post(unsigned* bar, volatile LAS unsigned* st) {
    XcdBarrier b; b.bar = bar; b.x = xb_xcc_id(); b.st = st;
    if (threadIdx.x == 0) (void)xb_add(&bar[XB_XCNT(b.x)], 1u);
    return b;
}
__device__ __forceinline__ void xcd_barrier_complete(unsigned* bar, unsigned x, unsigned& nloc, unsigned& nx) {
    const unsigned G = gridDim.x * gridDim.y * gridDim.z;
    unsigned sum, cnt, mine, sp = 0u;
    for (;;) {
        sum = 0u; cnt = 0u; mine = 0u;
#pragma unroll
        for (unsigned j = 0; j < 16; ++j) { const unsigned c = xb_ld(&bar[XB_XCNT(j)]); sum += c; cnt += (c > 0u) ? 1u : 0u; mine = (j == x) ? c : mine; }
        if (sum == G) break;
        __builtin_amdgcn_s_sleep(1);
        if ((++sp & 255u) == 0u) { if (xb_ld(&bar[XB_TMO])) break; if (sp > XB_SPIN_CAP) { atomicAdd(&bar[XB_TMO], 1u); break; } }
    }
    nloc = mine > 0u ? mine : 1u; nx = cnt > 0u ? cnt : 1u;
}

__device__ __forceinline__ void xcd_barrier(const XcdBarrier& b) {
    asm volatile("s_waitcnt vmcnt(0)" ::: "memory");
    __syncthreads();
    if (threadIdx.x == 0) {
        unsigned* bar = b.bar;
        __builtin_amdgcn_s_waitcnt(0);
        unsigned nloc = b.st[0], nx = b.st[1];
        if (nloc == 0u) { xcd_barrier_complete(bar, b.x, nloc, nx); b.st[0] = nloc; b.st[1] = nx; }
        const unsigned old = xb_add(&bar[XB_XSUB(b.x)], 1u);
        const unsigned gen = old / nloc;
        if (old + 1u == (gen + 1u) * nloc) {
            __builtin_amdgcn_fence(__ATOMIC_RELEASE, "agent");
            asm volatile("s_waitcnt vmcnt(0)" ::: "memory");
            const unsigned og = xb_add(&bar[XB_TOP], 1u);
            const unsigned tg = og / nx;
            if (og + 1u == (tg + 1u) * nx) xb_add(&bar[XB_TOPGEN], 1u);
            else XB_SPIN(xb_ld(&bar[XB_TOPGEN]) == tg, bar);
            __builtin_amdgcn_fence(__ATOMIC_ACQUIRE, "agent");
            xb_add(&bar[XB_XGEN(b.x)], 1u);
            asm volatile("s_waitcnt vmcnt(0)" ::: "memory");
        } else {
            XB_SPIN(xb_ld(&bar[XB_XGEN(b.x)]) == gen, bar);
            __builtin_amdgcn_fence(__ATOMIC_ACQUIRE, "agent");
            asm volatile("s_waitcnt vmcnt(0)" ::: "memory");
        }
    }
    __syncthreads();
}


template <class Epi>
__device__ __forceinline__ void run_gemm(LAS unsigned char* lds, const bf16* A, const bf16* Bt, int M, int N, int K, const Epi& E) {
    asm volatile("" : "+s"(K));
    pg8::Gemm g{A, Bt, M, N, K}; pg8::StaticOrder S; S.init(M, N, (int)gridDim.x, (int)blockIdx.x);
    pg8::gemm_phase<Epi, pg8::StaticOrder, true, true>(lds, g, S, E);
}

#ifndef DUP_PH
#define DUP_PH (-1)
#endif
__device__ __forceinline__ void run_phase(const P& p, LAS unsigned char* lds, int k, bool dummy) {
    if (k == 0) { ph_adaln(p, lds); return; }
    if (k == 27) { final_norm_rows(p); return; }
    const int layer = (k - 1) / 13, sub = (k - 1) % 13;
    float* x = p.out;
    const float* mod = (const float*)(p.ws + WS_MOD);
    bf16* H = (bf16*)(p.ws + WS_H); bf16* R1 = (bf16*)(p.ws + WS_R1);
    switch (sub) {
    case 0: case 10: {
        const int j = sub == 0 ? 0 : 2;
        norm_rows(p, layer, j, p.in[sub == 0 ? 10 : 12] + layer * 1024, layer == 0 && sub == 0);
        convert_ffn_weights(p, layer, sub == 0 ? 0 : 1, lds);
    } break;
    case 1: case 11: run_gemm(lds, H, (const bf16*)(p.ws + W_GU), M_TOK, 5632, 1024, EpiSwiglu{R1}); break;
    case 2: case 12: {
        const bool first = layer == 0 && sub == 2;
        const EpiResid E{first ? p.in[0] : x, first ? p.in[1] : x + (size_t)MP * DM, dummy ? (float*)(p.ws + WS_R2) : x, mod + (size_t)layer * 9 * 9216 + (sub == 2 ? 2 : 8) * 1024, 0.5f};
        run_gemm(lds, R1, (const bf16*)(p.ws + W_DOWN), M_TOK, 1024, 2816, E);
    } break;
    case 3: {
        norm_rows(p, layer, 1, p.in[11] + layer * 1024, false);
        transpose_w<0>(p.in[17] + (size_t)layer * 1024 * 1024, 1024, 1024, 1024, (bf16*)(p.ws + W_OUT), 1024, lds);
        if (layer == 0) { transpose_w<0>(p.in[18], 3984, 3984, 1024, (bf16*)(p.ws + W_IN), 4096, lds); build_lora_w(p); }
        else { transpose_w<0>(p.in[34], 2208, 2208, 1024, (bf16*)(p.ws + W_IN), 2304, lds);
            transpose_w<0>(p.in[36], 768, 768, 384, (bf16*)(p.ws + W_UQ), 768, lds);
            transpose_w<0>(p.in[38], 1024, 1024, 256, (bf16*)(p.ws + W_UKV), 1024, lds);
            ph_hyena_filters(p, lds); }
    } break;
    case 4: {
        const int N = layer == 0 ? 4096 : 2304, ld = layer == 0 ? LDP0 : LDP1;
        run_gemm(lds, H, (const bf16*)(p.ws + W_IN), M_TOK, N, 1024, EpiStore{R1, ld, ld});
    } break;
    case 5: if (layer == 0) ph_lora_in(p); else ph_mla_prep(p, lds); break;
    case 6:
        if (layer == 0) run_gemm(lds, H, (const bf16*)(p.ws + W_LORA), M_TOK, 2560, 384, EpiLora{(bf16*)(p.ws + WS_R2), p.in[20], p.in[22]});
        else { run_gemm(lds, H, (const bf16*)(p.ws + W_UQ), M_TOK, 768, 384, EpiQ{(bf16*)(p.ws + WS_Q), (const float*)(p.ws + WS_ROPE)});
            run_gemm(lds, (const bf16*)(p.ws + WS_CKVA), (const bf16*)(p.ws + W_UKV), M_TOK + 2048, 1024, 256, EpiKV{(bf16*)(p.ws + WS_KV), (bf16*)(p.ws + WS_VT), M_TOK + 2048}); }
        break;
    case 7: if (layer == 0) ph_scan(p, lds); else ph_attn_hyena(p, lds); break;
    case 8: if (layer == 0) ph_post_ab(p, dummy); break;
    case 9: {
        const EpiResid E{x, x + (size_t)MP * DM, dummy ? (float*)(p.ws + WS_R2) : x, mod + (size_t)layer * 9 * 9216 + 5 * 1024, 1.0f};
        run_gemm(lds, (const bf16*)(p.ws + WS_MIX), (const bf16*)(p.ws + W_OUT), M_TOK, 1024, 1024, E);
    } break;
    default: break;
    }
}

__global__ void __launch_bounds__(NTHREADS, 2) hybrid_fwd(P p) {
    extern __shared__ __attribute__((aligned(16))) unsigned char lds_raw[];
    LAS unsigned char* lds = (LAS unsigned char*)lds_raw;
    cg::grid_group grid = cg::this_grid();
    volatile LAS unsigned* bst = (volatile LAS unsigned*)(lds + LDS_BYTES - 64);
    if (threadIdx.x < 16) bst[threadIdx.x] = 0u;
    __syncthreads();
    XcdBarrier bar = xcd_barrier_post((unsigned*)(p.ws + WS_CTL) + 1024, bst);
#pragma unroll 1
    for (int k = p.ph_lo; k < p.ph_hi; ++k) {
        if (k == 22) continue;
        if (DUP_PH >= 0 && k == DUP_PH) { run_phase(p, lds, k, true); __syncthreads(); }
        run_phase(p, lds, k, false);
        if (k + 1 < p.ph_hi) { if (k == 0) grid.sync(); else xcd_barrier(bar); }
    }
}

extern "C" void kernel_launch(void* const* d_in, const int* in_sizes, int n_in, void* d_out, int out_size, void* d_ws, size_t ws_size, hipStream_t stream) {
    static int grid = 0;
    if (grid == 0) {
        if (n_in != 48 || out_size != 25427968 || ws_size < WS_END) {
            fprintf(stderr, "kernel_launch: expected 48 inputs, 25427968 outputs, >= %zu B workspace; got %d, %d, %zu\n", (size_t)WS_END, n_in, out_size, ws_size);
            grid = -1; return;
        }
        int dev = 0, cus = 0, per_cu = 0;
        hipGetDevice(&dev);
        hipDeviceGetAttribute(&cus, hipDeviceAttributeMultiprocessorCount, dev);
        hipFuncSetAttribute((const void*)hybrid_fwd, hipFuncAttributeMaxDynamicSharedMemorySize, LDS_BYTES);
        hipOccupancyMaxActiveBlocksPerMultiprocessor(&per_cu, (const void*)hybrid_fwd, NTHREADS, LDS_BYTES);
        if (per_cu < 1) { fprintf(stderr, "kernel_launch: occupancy query says %d blocks/CU\n", per_cu); per_cu = 1; }
        (void)hipGetLastError();
        grid = cus;
    }
    if (grid < 0) return;
    (void)hipMemsetAsync((char*)d_ws + WS_CTL, 0, 65536, stream);
    P prm{};
    for (int i = 0; i < 48; ++i) prm.in[i] = (const float*)d_in[i];
    prm.out = (float*)d_out; prm.ws = (unsigned char*)d_ws;
#ifndef N_SPLIT
    prm.ph_lo = 0; prm.ph_hi = 28;
    void* args[] = {&prm};
    hipError_t e = hipLaunchCooperativeKernel((const void*)hybrid_fwd, dim3(grid), dim3(NTHREADS), args, LDS_BYTES, stream);
    if (e != hipSuccess) fprintf(stderr, "cooperative launch failed: %s (grid %d)\n", hipGetErrorString(e), grid);
#else
    for (int k = 0; k < 28; ++k) {
        prm.ph_lo = k; prm.ph_hi = k + 1;
        void* args[] = {&prm};
        hipError_t e = hipLaunchCooperativeKernel((const void*)hybrid_fwd, dim3(grid), dim3(NTHREADS), args, LDS_BYTES, stream);
        if (e != hipSuccess) { fprintf(stderr, "launch %d failed: %s\n", k, hipGetErrorString(e)); break; }
    }
#endif
}
```

```cpp
#include <hip/hip_runtime.h>
#include <hip/hip_cooperative_groups.h>
#include <cstdio>
#include <cstdint>
namespace cg = cooperative_groups;

#define LAS __attribute__((address_space(3)))
typedef unsigned short bf16;
typedef float f32x2 __attribute__((ext_vector_type(2)));
typedef float f32x4 __attribute__((ext_vector_type(4)));
typedef float f32x16 __attribute__((ext_vector_type(16)));
typedef unsigned u32x2 __attribute__((ext_vector_type(2)));
typedef unsigned u32x4 __attribute__((ext_vector_type(4)));
typedef short s16x8 __attribute__((ext_vector_type(8)));

constexpr int M_TOK = 16384, MP = 8192, DM = 1024, DFF = 2816;
constexpr int LDP0 = 3984, LDP1 = 2304;
constexpr int OUT_YS = 8388608, OUT_SRW = 16777216, OUT_SGD = 18874368, OUT_CKV = 23068672, OUT_KPE = 25165824;

constexpr size_t MiB = 1ull << 20;
constexpr size_t WS_CTL = 0;
constexpr size_t WS_SS = 64 * 1024;
constexpr size_t WS_ROPE = 512 * 1024;
constexpr size_t WS_CV = 2 * 1048576 + 16 * 1048576 + 524288;
constexpr int CV_STRIDE = 9 * 5632;
constexpr size_t WS_MOD = 1 * MiB;
constexpr size_t WS_W = 2 * MiB;
constexpr size_t W_GU = WS_W, W_DOWN = WS_W + 11 * MiB;
constexpr size_t W_IN = WS_W, W_OUT = WS_W + 8 * MiB, W_LORA = WS_W + 10 * MiB, W_UQ = WS_W + 12 * MiB, W_UKV = WS_W + 13 * MiB;
constexpr size_t WS_H = 19 * MiB;
constexpr size_t WS_MIX = 51 * MiB;
constexpr size_t WS_R1 = 83 * MiB;
constexpr size_t R1_BYTES = 130547712;
constexpr size_t WS_HYIN = WS_R1 + 72 * MiB;
constexpr size_t WS_R2 = WS_R1 + R1_BYTES;
constexpr size_t WS_Q = WS_R2, WS_KV = WS_R2 + 24 * MiB, WS_VT = WS_R2 + 42 * MiB, WS_CKVA = WS_R2 + 60 * MiB, WS_KPEA = WS_R2 + 69 * MiB, WS_GFS = WS_R2 + 71 * MiB, WS_GFP = WS_R2 + 75 * MiB;
constexpr size_t WS_END = WS_R2 + 80 * MiB;

constexpr int LDS_BYTES = 159744;
constexpr int NTHREADS = 512;

struct P {
    const float* in[48];
    float* out;
    unsigned char* ws;
    int ph_lo, ph_hi;
};

__device__ __forceinline__ float bf2f(unsigned b) { return __uint_as_float(b << 16); }
__device__ __forceinline__ float bflo(unsigned w) { return __uint_as_float(w << 16); }
__device__ __forceinline__ float bfhi(unsigned w) { return __uint_as_float(w & 0xffff0000u); }
typedef __bf16 bf16x2_t __attribute__((ext_vector_type(2)));
__device__ __forceinline__ unsigned pk2(float lo, float hi) { const f32x2 v = {lo, hi}; return __builtin_bit_cast(unsigned, __builtin_convertvector(v, bf16x2_t)); }
__device__ __forceinline__ f32x4 unpk4(u32x2 w) { return (f32x4){bflo(w.x), bfhi(w.x), bflo(w.y), bfhi(w.y)}; }
__device__ __forceinline__ u32x2 pk4(f32x4 v) { return (u32x2){pk2(v.x, v.y), pk2(v.z, v.w)}; }
__device__ __forceinline__ float wave_sum(float v) {
#pragma unroll
    for (int o = 1; o < 64; o <<= 1) v += __shfl_xor(v, o);
    return v;
}
__device__ __forceinline__ float dpp_f(float x, int) { return x; }
#define DPPF(x, ctrl) __int_as_float(__builtin_amdgcn_update_dpp(0, __float_as_int(x), (ctrl), 0xF, 0xF, true))
__device__ __forceinline__ float red4(float x) { x += DPPF(x, 0xB1); x += DPPF(x, 0x4E); return x; }
__device__ __forceinline__ float red8(float x) { x = red4(x); x += DPPF(x, 0x141); return x; }
__device__ __forceinline__ float red16(float x) { x = red8(x); x += DPPF(x, 0x140); return x; }
__device__ __forceinline__ float sigmoidf_(float x) { return __builtin_amdgcn_rcpf(1.0f + __expf(-x)); }
__device__ __forceinline__ float siluf_(float x) { return x * __builtin_amdgcn_rcpf(1.0f + __expf(-x)); }
__device__ __forceinline__ float rsqrtf_(float x) { return __builtin_amdgcn_rsqf(x); }
__device__ __forceinline__ int cond_of_row(int row) { return row < MP ? 0 : 1 + ((row - MP) >> 10); }
__device__ __forceinline__ int tid_opaque() { int t = threadIdx.x; asm volatile("" : "+v"(t)); return t; }
#define LDS_WAIT() asm volatile("s_waitcnt lgkmcnt(0)" ::: "memory")

namespace pg8 {
#define PG8_LAS __attribute__((address_space(3)))
typedef unsigned short bf16_t;
typedef short bf16x8 __attribute__((ext_vector_type(8)));
typedef float f32x4 __attribute__((ext_vector_type(4)));
typedef unsigned u32x4 __attribute__((ext_vector_type(4)));
constexpr int BM = 256, BK = 64, HALF = 128, HTB = HALF * BK * 2  , STAGE_BYTES = 8 * HTB, NXCD = 8, WGM = 4;

__host__ __device__ __forceinline__ int lds_byte(int r, int c) { const int st = (r >> 4) * 2 + (c >> 5), rr = r & 15, cc = c & 31, ob = rr * 64 + cc * 2; return st * 1024 + (ob ^ (((ob >> 9) & 1) << 5)); }
__host__ __device__ __forceinline__ void stage_rc(int b, int& R, int& C) { const int st = b / 1024, sb = b % 1024, swz = sb ^ (((sb >> 9) & 1) << 5); R = (st >> 1) * 16 + swz / 64; C = (st & 1) * 32 + (swz % 64) / 2; }
__host__ __device__ __forceinline__ int perm32(int rho) { const int n = rho >> 4, i = rho & 15; return 8 * (i >> 2) + 4 * n + (i & 3); }

struct Unit { int pm, pn; };
struct Gemm { const bf16_t* A; const bf16_t* Bt; int M, N, K; };

struct StaticOrder {
    int nM, nN, nwg, G, c;
    __host__ __device__ void init(int M, int N, int G_, int c_) { nM = M / BM; nN = N / BM; nwg = nM * nN; G = G_; c = c_; }
    __host__ __device__ bool next(int i, Unit& u) const {
        const long L = (long)i * G + c; if (L >= nwg) return false;
        int wgid = (int)L; { const int q = nwg / NXCD, r = nwg % NXCD, xcd = wgid % NXCD, off = wgid / NXCD; wgid = (xcd < r ? xcd * (q + 1) : r * (q + 1) + (xcd - r) * q) + off; }
        const int nig = WGM * nN, gid = wgid / nig, fm = gid * WGM, gsz = (nM - fm) < WGM ? (nM - fm) : WGM;
        u.pm = fm + ((wgid % nig) % gsz); u.pn = (wgid % nig) / gsz; return true;
    }
    __device__ __forceinline__ void a_ready(const Unit&) const {}
    __device__ __forceinline__ void done(const Unit&) const {}
};
__device__ __forceinline__ unsigned cvt_pk_bf16(float lo, float hi) { unsigned r; asm volatile("v_cvt_pk_bf16_f32 %0, %1, %2" : "=v"(r) : "v"(lo), "v"(hi)); return r; }
typedef float f32x2 __attribute__((ext_vector_type(2)));
template <class Epi, class Sched, bool ALIGN_EPI = false, bool SP2 = false>
__device__ __forceinline__ void gemm_phase(PG8_LAS unsigned char* lds, const Gemm g, const Sched& S, const Epi& E) {
    const int tid = tid_opaque(), wid = __builtin_amdgcn_readfirstlane(tid >> 6), lane = tid & 63, wr = wid >> 2, wc = wid & 3, fr = lane & 15, fq = lane >> 4;
    const int K = g.K, nt = K / BK;
    unsigned voffA[2], voffB[2];
#pragma unroll
    for (int i = 0; i < 2; ++i) { int R, C; stage_rc(tid * 16 + i * 8192, R, C); const int Rb = Epi::PERM ? ((R & ~31) + perm32(R & 31)) : R;
        voffA[i] = (unsigned)(R * K + C) * 2u; voffB[i] = (unsigned)(Rb * K + C) * 2u; }
    const size_t kstep = (size_t)(BK * 2);
    const size_t hstep = (size_t)HALF * K * 2;
    const size_t tstep = 2 * hstep;
    const unsigned ldsw = (unsigned)wid * 1024u;
    const int aoff = lds_byte(wr * 64 + fr, fq * 8), boff = lds_byte(wc * 32 + fr, fq * 8);
#define PG8_SA(b, h) (((b) * 2 + (h)) * HTB)
#define PG8_SB(b, h) ((4 + (b) * 2 + (h)) * HTB)
#define PG8_STAGE(bufoff, gbase, voff) do { _Pragma("unroll") for (int _i = 0; _i < 2; ++_i) \
        __builtin_amdgcn_global_load_lds((const unsigned*)((const char*)(gbase) + (voff)[_i]), (PG8_LAS unsigned*)(lds + (bufoff) + ldsw + _i * 8192), 16, 0, 0); } while (0)
#define PG8_LDA(dst, b, h) do { _Pragma("unroll") for (int m = 0; m < 4; ++m) _Pragma("unroll") for (int k = 0; k < 2; ++k) dst[m][k] = *(const PG8_LAS bf16x8*)(lds + PG8_SA(b, h) + aoff + m * 2048 + k * 1024); } while (0)
#define PG8_LDB(dst, b, h) do { _Pragma("unroll") for (int n = 0; n < 2; ++n) _Pragma("unroll") for (int k = 0; k < 2; ++k) dst[n][k] = *(const PG8_LAS bf16x8*)(lds + PG8_SB(b, h) + boff + n * 2048 + k * 1024); } while (0)
#define PG8_MMA(ai, bj, At, Bt) do { __builtin_amdgcn_s_setprio(1); _Pragma("unroll") for (int m = 0; m < 4; ++m) _Pragma("unroll") for (int n = 0; n < 2; ++n) _Pragma("unroll") for (int k = 0; k < 2; ++k) \
        acc[ai][bj][m][n] = __builtin_amdgcn_mfma_f32_16x16x32_bf16(Bt[n][k], At[m][k], acc[ai][bj][m][n], 0, 0, 0); __builtin_amdgcn_s_setprio(0); } while (0)
#define PG8_WAIT_V(n) asm volatile("s_waitcnt vmcnt(" #n ")" ::: "memory")
#define PG8_WAIT_L(n) asm volatile("s_waitcnt lgkmcnt(" #n ")" ::: "memory")
#define PG8_BAR __builtin_amdgcn_s_barrier()
#define PG8_SCHED __builtin_amdgcn_sched_barrier(0)
    Unit cur, nxt; int ui = 0;
    if (!S.next(0, cur)) return;
    f32x4 acc[2][2][4][2];
#pragma unroll
    for (int a = 0; a < 2; ++a)
#pragma unroll
        for (int b = 0; b < 2; ++b)
#pragma unroll
            for (int m = 0; m < 4; ++m)
#pragma unroll
                for (int n = 0; n < 2; ++n) acc[a][b][m][n] = (f32x4){0.f, 0.f, 0.f, 0.f};
    bf16x8 At[4][2], B0[2][2], B1[2][2];
    const char* cA = (const char*)g.A + (size_t)cur.pm * tstep; const char* cB = (const char*)g.Bt + (size_t)cur.pn * tstep;
    S.a_ready(cur);
    if constexpr (SP2) {
        PG8_STAGE(PG8_SB(0, 0), cB, voffB); PG8_STAGE(PG8_SB(0, 1), cB + hstep, voffB); PG8_STAGE(PG8_SA(0, 0), cA, voffA); PG8_STAGE(PG8_SA(0, 1), cA + hstep, voffA);
        if (wr == 1) PG8_BAR;
        PG8_WAIT_V(2); PG8_BAR;
        PG8_STAGE(PG8_SB(1, 0), cB + kstep, voffB); PG8_STAGE(PG8_SA(1, 0), cA + kstep, voffA); PG8_STAGE(PG8_SB(1, 1), cB + hstep + kstep, voffB);
        PG8_WAIT_V(6); PG8_BAR;
    } else {
        PG8_STAGE(PG8_SB(0, 0), cB, voffB); PG8_STAGE(PG8_SA(0, 0), cA, voffA); PG8_STAGE(PG8_SB(0, 1), cB + hstep, voffB); PG8_STAGE(PG8_SA(0, 1), cA + hstep, voffA);
        if (wr == 1) PG8_BAR;
        PG8_WAIT_V(4); PG8_BAR;
        PG8_STAGE(PG8_SB(1, 0), cB + kstep, voffB); PG8_STAGE(PG8_SA(1, 0), cA + kstep, voffA); PG8_STAGE(PG8_SB(1, 1), cB + hstep + kstep, voffB);
        PG8_WAIT_V(6); PG8_BAR;
    }
    for (;;) {
        const bool has_next = S.next(ui + 1, nxt);
        const char* nA = has_next ? (const char*)g.A + (size_t)nxt.pm * tstep : cA; const char* nB = has_next ? (const char*)g.Bt + (size_t)nxt.pn * tstep : cB;
#pragma unroll 1
        for (int t = 0; t < nt; t += 2) {
            const bool last = (t == nt - 2);
            const char* a1 = cA + (size_t)(t + 1) * kstep;
            const char* a2 = last ? nA : cA + (size_t)(t + 2) * kstep; const char* b2 = last ? nB : cB + (size_t)(t + 2) * kstep;
            const char* a3 = a2 + kstep; const char* b3 = b2 + kstep;
            if (last && has_next) S.a_ready(nxt);
            if constexpr (SP2) {
            PG8_LDB(B0, 0, 0); PG8_LDB(B1, 0, 1); PG8_SCHED; PG8_LDA(At, 0, 0); PG8_STAGE(PG8_SA(1, 1), a1 + hstep, voffA);
            PG8_WAIT_V(8); PG8_WAIT_L(0); PG8_BAR; PG8_MMA(0, 0, At, B0); PG8_MMA(0, 1, At, B1); PG8_BAR; PG8_SCHED;
            PG8_LDA(At, 0, 1); PG8_STAGE(PG8_SB(0, 0), b2, voffB); PG8_STAGE(PG8_SB(0, 1), b2 + hstep, voffB); PG8_STAGE(PG8_SA(0, 0), a2, voffA);
            PG8_WAIT_V(8); PG8_WAIT_L(0); PG8_BAR; PG8_MMA(1, 0, At, B0); PG8_MMA(1, 1, At, B1); PG8_BAR; PG8_SCHED;
            PG8_LDB(B0, 1, 0); PG8_LDB(B1, 1, 1); PG8_SCHED; PG8_LDA(At, 1, 0); PG8_STAGE(PG8_SA(0, 1), a2 + hstep, voffA);
            PG8_WAIT_V(8); PG8_WAIT_L(0); PG8_BAR; PG8_MMA(0, 0, At, B0); PG8_MMA(0, 1, At, B1); PG8_BAR; PG8_SCHED;
            PG8_LDA(At, 1, 1); PG8_STAGE(PG8_SB(1, 0), b3, voffB); PG8_STAGE(PG8_SB(1, 1), b3 + hstep, voffB); PG8_STAGE(PG8_SA(1, 0), a3, voffA);
            PG8_WAIT_V(8); PG8_WAIT_L(0); PG8_BAR; PG8_MMA(1, 0, At, B0); PG8_MMA(1, 1, At, B1); PG8_BAR; PG8_SCHED;
            } else {
            PG8_LDB(B0, 0, 0); PG8_SCHED; PG8_LDA(At, 0, 0); PG8_STAGE(PG8_SA(1, 1), a1 + hstep, voffA);
            PG8_WAIT_L(8); PG8_BAR; PG8_WAIT_L(0); PG8_MMA(0, 0, At, B0); PG8_BAR; PG8_SCHED;
            PG8_LDB(B1, 0, 1); PG8_STAGE(PG8_SB(0, 0), b2, voffB);
            PG8_BAR; PG8_WAIT_L(0); PG8_MMA(0, 1, At, B1); PG8_BAR;
            PG8_LDA(At, 0, 1); PG8_STAGE(PG8_SA(0, 0), a2, voffA);
            PG8_BAR; PG8_WAIT_L(0); PG8_MMA(1, 0, At, B0); PG8_BAR; PG8_SCHED;
            PG8_STAGE(PG8_SB(0, 1), b2 + hstep, voffB);
            PG8_WAIT_V(6); PG8_BAR; PG8_MMA(1, 1, At, B1); PG8_BAR;
            PG8_LDB(B0, 1, 0); PG8_SCHED; PG8_LDA(At, 1, 0); PG8_STAGE(PG8_SA(0, 1), a2 + hstep, voffA);
            PG8_WAIT_L(8); PG8_BAR; PG8_WAIT_L(0); PG8_MMA(0, 0, At, B0); PG8_BAR; PG8_SCHED;
            PG8_LDB(B1, 1, 1); PG8_STAGE(PG8_SB(1, 0), b3, voffB);
            PG8_BAR; PG8_WAIT_L(0); PG8_MMA(0, 1, At, B1); PG8_BAR;
            PG8_LDA(At, 1, 1); PG8_STAGE(PG8_SA(1, 0), a3, voffA);
            PG8_BAR; PG8_WAIT_L(0); PG8_MMA(1, 0, At, B0); PG8_BAR; PG8_SCHED;
            PG8_STAGE(PG8_SB(1, 1), b3 + hstep, voffB);
            PG8_WAIT_V(6); PG8_BAR; PG8_MMA(1, 1, At, B1); PG8_BAR;
            }
        }
        if constexpr (ALIGN_EPI) { if (wr == 0) PG8_BAR; }
        if constexpr (!Epi::AFTER_DRAIN) { E(acc, cur, wr, wc, fr, fq); S.done(cur); }
        if (!has_next) break;
#pragma unroll
        for (int a = 0; a < 2; ++a)
#pragma unroll
            for (int b = 0; b < 2; ++b)
#pragma unroll
                for (int m = 0; m < 4; ++m)
#pragma unroll
                    for (int n = 0; n < 2; ++n) acc[a][b][m][n] = (f32x4){0.f, 0.f, 0.f, 0.f};
        cur = nxt; cA = nA; cB = nB; ++ui;
        if constexpr (ALIGN_EPI) { if (wr == 1) PG8_BAR; }
    }
    PG8_WAIT_V(0);
    if constexpr (!ALIGN_EPI) { if (wr == 0) PG8_BAR; }
    PG8_BAR;
    if constexpr (Epi::AFTER_DRAIN) { E.fused(acc, cur, wr, wc, fr, fq, lds, wid, lane); S.done(cur); }
#undef PG8_SA
#undef PG8_SB
#undef PG8_STAGE
#undef PG8_LDA
#undef PG8_LDB
#undef PG8_MMA
#undef PG8_WAIT_V
#undef PG8_WAIT_L
#undef PG8_BAR
#undef PG8_SCHED
}
}

using pg8::Unit;
typedef const f32x4 (&AccRef)[2][2][4][2];

struct EpiSwiglu {
    static constexpr bool PERM = true, AFTER_DRAIN = false;
    bf16* O;
    __device__ __forceinline__ void operator()(AccRef acc, const Unit& u, int wr, int wc, int fr, int fq) const {
        const int row0 = u.pm * 256 + wr * 64 + fr, col0 = u.pn * 128 + wc * 32 + 8 * fq;
#pragma unroll
        for (int ai = 0; ai < 2; ++ai)
#pragma unroll
            for (int m = 0; m < 4; ++m) {
                const f32x4 g0 = acc[ai][0][m][0], g1 = acc[ai][0][m][1], u0 = acc[ai][1][m][0], u1 = acc[ai][1][m][1];
                float v[8];
#pragma unroll
                for (int i = 0; i < 4; ++i) { v[i] = g0[i] * __builtin_amdgcn_rcpf(1.0f + __expf(-g0[i])) * u0[i]; v[4 + i] = g1[i] * __builtin_amdgcn_rcpf(1.0f + __expf(-g1[i])) * u1[i]; }
                u32x4 w; w.x = pk2(v[0], v[1]); w.y = pk2(v[2], v[3]); w.z = pk2(v[4], v[5]); w.w = pk2(v[6], v[7]);
                *(u32x4*)(O + (size_t)(row0 + ai * 128 + m * 16) * DFF + col0) = w;
            }
    }
};
struct EpiSwigluN {
    static constexpr bool PERM = true, AFTER_DRAIN = false;
    bf16* O; const float* ss; const float* cv;
    __device__ __forceinline__ void operator()(AccRef acc, const Unit& u, int wr, int wc, int fr, int fq) const {
        const int cond = u.pm < 32 ? 0 : 1 + ((u.pm - 32) >> 2);
        const int row0 = u.pm * 256 + wr * 64 + fr, col0 = u.pn * 128 + wc * 32 + 8 * fq, gc0 = u.pn * 256 + wc * 32 + 8 * fq;
        const float* cp = cv + (size_t)cond * 5632 + gc0;
        const f32x4 cg0 = *(const f32x4*)cp, cg1 = *(const f32x4*)(cp + 4), cu0 = *(const f32x4*)(cp + 128), cu1 = *(const f32x4*)(cp + 132);
#pragma unroll
        for (int ai = 0; ai < 2; ++ai)
#pragma unroll
            for (int m = 0; m < 4; ++m) {
                const int row = row0 + ai * 128 + m * 16;
                const float rs = ss[row];
                const f32x4 g0 = acc[ai][0][m][0] * rs + cg0, g1 = acc[ai][0][m][1] * rs + cg1, u0 = acc[ai][1][m][0] * rs + cu0, u1 = acc[ai][1][m][1] * rs + cu1;
                float v[8];
#pragma unroll
                for (int i = 0; i < 4; ++i) { v[i] = g0[i] * __builtin_amdgcn_rcpf(1.0f + __expf(-g0[i])) * u0[i]; v[4 + i] = g1[i] * __builtin_amdgcn_rcpf(1.0f + __expf(-g1[i])) * u1[i]; }
                u32x4 w; w.x = pk2(v[0], v[1]); w.y = pk2(v[2], v[3]); w.z = pk2(v[4], v[5]); w.w = pk2(v[6], v[7]);
                *(u32x4*)(O + (size_t)row * DFF + col0) = w;
            }
    }
};
struct EpiStoreN {
    static constexpr bool PERM = true, AFTER_DRAIN = false;
    bf16* O; int ldc; int ncols; const float* ss; const float* cv; int ncv;
    __device__ __forceinline__ void operator()(AccRef acc, const Unit& u, int wr, int wc, int fr, int fq) const {
        const int cond = u.pm < 32 ? 0 : 1 + ((u.pm - 32) >> 2);
        const int row0 = u.pm * 256 + wr * 64 + fr, col0 = u.pn * 256 + wc * 32 + 8 * fq;
        const float* cp = cv + (size_t)cond * ncv + col0;
        const f32x4 c00 = *(const f32x4*)cp, c01 = *(const f32x4*)(cp + 4), c10 = *(const f32x4*)(cp + 128), c11 = *(const f32x4*)(cp + 132);
#pragma unroll
        for (int ai = 0; ai < 2; ++ai)
#pragma unroll
            for (int m = 0; m < 4; ++m) {
                const int row = row0 + ai * 128 + m * 16;
                const float rs = ss[row];
                bf16* rowp = O + (size_t)row * ldc;
#pragma unroll
                for (int bj = 0; bj < 2; ++bj) { const int col = col0 + bj * 128;
                    const f32x4 v0 = acc[ai][bj][m][0] * rs + (bj ? c10 : c00), v1 = acc[ai][bj][m][1] * rs + (bj ? c11 : c01);
                    u32x4 w; w.x = pk2(v0[0], v0[1]); w.y = pk2(v0[2], v0[3]); w.z = pk2(v1[0], v1[1]); w.w = pk2(v1[2], v1[3]);
                    if (col < ncols) *(u32x4*)(rowp + col) = w; }
            }
    }
};
struct EpiResidN {
    static constexpr bool PERM = true, AFTER_DRAIN = false;
    const float* xin_p; const float* xin_s; float* xout; const float* gate_base;
    const float* gnext; const float* scn_base; bf16* xg; float* ss; float coef;
    __device__ __forceinline__ void operator()(AccRef acc, const Unit& u, int wr, int wc, int fr, int fq) const {
        const int cond = u.pm < 32 ? 0 : 1 + ((u.pm - 32) >> 2);
        const float* gate = gate_base + (size_t)cond * 9216; const float* scn = scn_base + (size_t)cond * 9216;
        const int row0 = u.pm * 256 + wr * 64 + fr, col0 = u.pn * 256 + wc * 32 + 8 * fq;
        float sq[2][4];
#pragma unroll
        for (int ai = 0; ai < 2; ++ai)
#pragma unroll
            for (int m = 0; m < 4; ++m) sq[ai][m] = 0.f;
        const float* xb = u.pm < 32 ? xin_p : xin_s - (size_t)MP * DM;
        const unsigned off0 = (unsigned)(row0 * DM + col0);
#pragma unroll
        for (int bj = 0; bj < 2; ++bj) {
            const int col = col0 + bj * 128;
            f32x4 gv[2], G[2];
#pragma unroll
            for (int n = 0; n < 2; ++n) { gv[n] = *(const f32x4*)(gate + col + 4 * n) * coef; G[n] = *(const f32x4*)(gnext + col + 4 * n) * (*(const f32x4*)(scn + col + 4 * n) + 1.0f); }
#pragma unroll
            for (int ai = 0; ai < 2; ++ai) {
                f32x4 xv[4][2];
#pragma unroll
                for (int m = 0; m < 4; ++m)
#pragma unroll
                    for (int n = 0; n < 2; ++n) xv[m][n] = *(const f32x4*)(xb + (off0 + (unsigned)((ai * 128 + m * 16) * DM + bj * 128 + 4 * n)));
                asm volatile("" ::: "memory");
#pragma unroll
                for (int m = 0; m < 4; ++m) {
                    const unsigned off = off0 + (unsigned)((ai * 128 + m * 16) * DM + bj * 128);
                    const f32x4 x0 = xv[m][0] + gv[0] * acc[ai][bj][m][0], x1 = xv[m][1] + gv[1] * acc[ai][bj][m][1];
                    *(f32x4*)(xout + off) = x0; *(f32x4*)(xout + off + 4) = x1;
                    const u32x2 w0 = pk4(x0 * G[0]), w1 = pk4(x1 * G[1]);
                    *(u32x4*)(xg + off) = (u32x4){w0.x, w0.y, w1.x, w1.y};
                    sq[ai][m] += x0.x * x0.x + x0.y * x0.y + x0.z * x0.z + x0.w * x0.w + x1.x * x1.x + x1.y * x1.y + x1.z * x1.z + x1.w * x1.w;
                }
                asm volatile("" ::: "memory");
            }
        }
#pragma unroll
        for (int ai = 0; ai < 2; ++ai)
#pragma unroll
            for (int m = 0; m < 4; ++m) {
                float t = sq[ai][m]; t += __shfl_xor(t, 16); t += __shfl_xor(t, 32);
                if (fq == 0) ss[(u.pn * 4 + wc) * M_TOK + row0 + ai * 128 + m * 16] = t;
            }
    }
};
struct EpiResid {
    static constexpr bool PERM = true, AFTER_DRAIN = false;
    const float* xin_p; const float* xin_s; float* xout; const float* gate_base; float coef;
    __device__ __forceinline__ void operator()(AccRef acc, const Unit& u, int wr, int wc, int fr, int fq) const {
        const int cond = u.pm < 32 ? 0 : 1 + ((u.pm - 32) >> 2);
        const float* gate = gate_base + (size_t)cond * 9216;
        const int row0 = u.pm * 256 + wr * 64 + fr, col0 = u.pn * 256 + wc * 32 + 8 * fq;
        const float* xb = u.pm < 32 ? xin_p : xin_s - (size_t)MP * DM;
        const unsigned off0 = (unsigned)(row0 * DM + col0);
#pragma unroll
        for (int bj = 0; bj < 2; ++bj) {
            const f32x4 gv0 = *(const f32x4*)(gate + col0 + bj * 128) * coef, gv1 = *(const f32x4*)(gate + col0 + bj * 128 + 4) * coef;
#pragma unroll
            for (int ai = 0; ai < 2; ++ai) {
                f32x4 xv[4][2];
#pragma unroll
                for (int m = 0; m < 4; ++m)
#pragma unroll
                    for (int n = 0; n < 2; ++n) xv[m][n] = *(const f32x4*)(xb + (off0 + (unsigned)((ai * 128 + m * 16) * DM + bj * 128 + 4 * n)));
                asm volatile("" ::: "memory");
#pragma unroll
                for (int m = 0; m < 4; ++m) {
                    const unsigned off = off0 + (unsigned)((ai * 128 + m * 16) * DM + bj * 128);
                    *(f32x4*)(xout + off) = xv[m][0] + gv0 * acc[ai][bj][m][0]; *(f32x4*)(xout + off + 4) = xv[m][1] + gv1 * acc[ai][bj][m][1];
                }
                asm volatile("" ::: "memory");
            }
        }
    }
};
struct EpiStore {
    static constexpr bool PERM = true, AFTER_DRAIN = false;
    bf16* O; int ldc; int ncols;
    __device__ __forceinline__ void operator()(AccRef acc, const Unit& u, int wr, int wc, int fr, int fq) const {
        const int row0 = u.pm * 256 + wr * 64 + fr, col0 = u.pn * 256 + wc * 32 + 8 * fq;
#pragma unroll
        for (int ai = 0; ai < 2; ++ai)
#pragma unroll
            for (int m = 0; m < 4; ++m) {
                bf16* rowp = O + (size_t)(row0 + ai * 128 + m * 16) * ldc;
#pragma unroll
                for (int bj = 0; bj < 2; ++bj) { const int col = col0 + bj * 128; const f32x4 v0 = acc[ai][bj][m][0], v1 = acc[ai][bj][m][1];
                    u32x4 w; w.x = pk2(v0[0], v0[1]); w.y = pk2(v0[2], v0[3]); w.z = pk2(v1[0], v1[1]); w.w = pk2(v1[2], v1[3]);
                    if (col < ncols) *(u32x4*)(rowp + col) = w; }
            }
    }
};
struct EpiLora {
    static constexpr bool PERM = true, AFTER_DRAIN = false;
    bf16* O; const float* w0; const float* a0;
    __device__ __forceinline__ void operator()(AccRef acc, const Unit& u, int wr, int wc, int fr, int fq) const {
        const int seg = u.pn >> 1;
        const float* bias = seg < 2 ? w0 + seg * 512 : a0 + (seg & 1) * 512;
        const int row0 = u.pm * 256 + wr * 64 + fr, ct0 = wc * 32 + 8 * fq;
#pragma unroll
        for (int bj = 0; bj < 2; ++bj) {
            const int cseg = (u.pn & 1) * 256 + ct0 + bj * 128;
            f32x4 b0 = {0.f, 0.f, 0.f, 0.f}, b1 = {0.f, 0.f, 0.f, 0.f};
            if (seg < 4) { b0 = *(const f32x4*)(bias + cseg); b1 = *(const f32x4*)(bias + cseg + 4); }
#pragma unroll
            for (int ai = 0; ai < 2; ++ai)
#pragma unroll
                for (int m = 0; m < 4; ++m) {
                    f32x4 v0 = acc[ai][bj][m][0] + b0, v1 = acc[ai][bj][m][1] + b1;
                    if (seg < 4) {
                        const float sc = seg < 2 ? 0.60653066f : 1.0f;
#pragma unroll
                        for (int i = 0; i < 4; ++i) { v0[i] = sc * sigmoidf_(v0[i]); v1[i] = sc * sigmoidf_(v1[i]); }
                    }
                    u32x4 w; w.x = pk2(v0[0], v0[1]); w.y = pk2(v0[2], v0[3]); w.z = pk2(v1[0], v1[1]); w.w = pk2(v1[2], v1[3]);
                    *(u32x4*)(O + (size_t)(row0 + ai * 128 + m * 16) * 2560 + u.pn * 256 + ct0 + bj * 128) = w;
                    asm volatile("" ::: "memory");
                }
        }
    }
};
struct EpiQ {
    static constexpr bool PERM = true, AFTER_DRAIN = false;
    bf16* O; const float* rope;
    __device__ __forceinline__ void operator()(AccRef acc, const Unit& u, int wr, int wc, int fr, int fq) const {
        const int row0 = u.pm * 256 + wr * 64 + fr, col0 = u.pn * 256 + wc * 32 + 8 * fq;
        const float qs = 0.10206207261596577f;
#pragma unroll
        for (int bj = 0; bj < 2; ++bj) {
            const int col = col0 + bj * 128, e0 = col % 96;
            const bool is_rope = e0 >= 64;
#pragma unroll
            for (int ai = 0; ai < 2; ++ai)
#pragma unroll
                for (int m = 0; m < 4; ++m) {
                    const int row = row0 + ai * 128 + m * 16;
                    f32x4 v0 = acc[ai][bj][m][0] * qs, v1 = acc[ai][bj][m][1] * qs;
                    if (is_rope && row >= MP) {
                        const int t = (row - MP) & 1023;
                        const float* rt = rope + (size_t)t * 32 + (e0 - 64);
                        const f32x4 c0 = *(const f32x4*)(rt), c1 = *(const f32x4*)(rt + 4);
                        f32x4 r0, r1;
                        r0[0] = v0[0] * c0[0] - v0[1] * c0[1]; r0[1] = v0[0] * c0[1] + v0[1] * c0[0];
                        r0[2] = v0[2] * c0[2] - v0[3] * c0[3]; r0[3] = v0[2] * c0[3] + v0[3] * c0[2];
                        r1[0] = v1[0] * c1[0] - v1[1] * c1[1]; r1[1] = v1[0] * c1[1] + v1[1] * c1[0];
                        r1[2] = v1[2] * c1[2] - v1[3] * c1[3]; r1[3] = v1[2] * c1[3] + v1[3] * c1[2];
                        v0 = r0; v1 = r1;
                    }
                    u32x4 w; w.x = pk2(v0[0], v0[1]); w.y = pk2(v0[2], v0[3]); w.z = pk2(v1[0], v1[1]); w.w = pk2(v1[2], v1[3]);
                    *(u32x4*)(O + (size_t)row * 768 + col) = w;
                    asm volatile("" ::: "memory");
                }
        }
    }
};

struct EpiKV {
    static constexpr bool PERM = true, AFTER_DRAIN = false;
    bf16* KN; bf16* VT; int nrows;
    __device__ __forceinline__ void operator()(AccRef acc, const Unit& u, int wr, int wc, int fr, int fq) const {
        const int row0 = u.pm * 256 + wr * 64 + fr, col0 = u.pn * 256 + wc * 32 + 8 * fq;
#pragma unroll
        for (int bj = 0; bj < 2; ++bj) {
            const int col = col0 + bj * 128, head = col >> 7, e0 = col & 127;
#pragma unroll
            for (int ai = 0; ai < 2; ++ai)
#pragma unroll
                for (int m = 0; m < 4; ++m) {
                    const int row = row0 + ai * 128 + m * 16;
                    const f32x4 v0 = acc[ai][bj][m][0], v1 = acc[ai][bj][m][1];
                    u32x4 w; w.x = pk2(v0[0], v0[1]); w.y = pk2(v0[2], v0[3]); w.z = pk2(v1[0], v1[1]); w.w = pk2(v1[2], v1[3]);
                    if (e0 < 64) *(u32x4*)(KN + (size_t)row * 512 + head * 64 + e0) = w;
                    else { bf16* vp = VT + (size_t)(head * 64 + e0 - 64) * nrows + row;
#pragma unroll
                        for (int i = 0; i < 4; ++i) { vp[(size_t)(2 * i) * nrows] = (bf16)(w[i] & 0xffffu); vp[(size_t)(2 * i + 1) * nrows] = (bf16)(w[i] >> 16); } }
                }
        }
    }
};

__device__ __forceinline__ void adaln_layer(const P& p, LAS unsigned char* lds, int l, int bfirst) {
    LAS float* scv = (LAS float*)lds;
    LAS float* red = scv + 9 * 1024;
    const int tid = tid_opaque(), tx = tid % 18, ty = tid / 18;
    const float* cc = p.in[6]; const float* cctx = p.in[7];
    float* mod = (float*)(p.ws + WS_MOD);
    if ((int)blockIdx.x < bfirst) return;
    __syncthreads();
    for (int i = tid; i < 9 * 1024; i += NTHREADS) { const int c = i >> 10, k = i & 1023; const float v = c == 0 ? cctx[k] : cc[(c - 1) * 1024 + k]; scv[i] = v / (1.0f + expf(-v)); }
    __syncthreads();
    for (int cgp = blockIdx.x - bfirst; cgp < 128; cgp += gridDim.x - bfirst) {
        const int col0 = cgp * 72 + tx * 4;
        const float* W = p.in[8] + (size_t)l * 1024 * 9216;
        f32x4 acc[9];
#pragma unroll
        for (int c = 0; c < 9; ++c) acc[c] = (f32x4){0.f, 0.f, 0.f, 0.f};
        if (ty < 28) {
#pragma unroll 8
            for (int k = ty; k < 1024; k += 28) {
                const f32x4 w = *(const f32x4*)(W + (size_t)k * 9216 + col0);
#pragma unroll
                for (int c = 0; c < 9; ++c) acc[c] += w * scv[c * 1024 + k];
            }
#pragma unroll
            for (int c = 0; c < 9; ++c) *(LAS f32x4*)(red + ty * 648 + c * 72 + tx * 4) = acc[c];
        }
        __syncthreads();
        for (int o = tid; o < 648; o += NTHREADS) {
            float s = 0.f;
            for (int y = 0; y < 28; ++y) s += red[y * 648 + o];
            const int c = o / 72, j = o % 72;
            mod[(size_t)(l * 9 + c) * 9216 + cgp * 72 + j] = s + p.in[9][l * 9216 + cgp * 72 + j];
        }
        __syncthreads();
    }
}
__device__ __forceinline__ void ph_rope_table(const P& p) {
    const int tid = tid_opaque();
    float* rope = (float*)(p.ws + WS_ROPE);
    for (int idx = blockIdx.x * NTHREADS + tid; idx < 1024 * 16; idx += gridDim.x * NTHREADS) {
        const int t = idx >> 4, i = idx & 15;
        const float pos = (float)(i < 8 ? (t >> 6) : (t & 63));
        const float inv = powf(10000.0f, -(float)(i & 7) / 8.0f);
        const float ang = pos * inv;
        rope[idx * 2] = cosf(ang); rope[idx * 2 + 1] = sinf(ang);
    }
}

__device__ __forceinline__ void norm_rows(const P& p, int layer, int j, const float* gvec, bool from_input) {
    const int tid = tid_opaque(), lane = tid & 63, wave = tid >> 6;
    const float* mod = (const float*)(p.ws + WS_MOD);
    const float* x = p.out;
    bf16* h = (bf16*)(p.ws + WS_H);
    const int nw = gridDim.x * 8;
    for (int row0 = blockIdx.x * 8 + wave; row0 < M_TOK; row0 += 4 * nw) {
        f32x4 v[4][4]; float ss[4];
#pragma unroll
        for (int r = 0; r < 4; ++r) {
            const int row = (row0 + r * nw) < M_TOK ? (row0 + r * nw) : (M_TOK - 1);
            const float* xr = from_input ? (row < MP ? p.in[0] + (size_t)row * DM : p.in[1] + (size_t)(row - MP) * DM) : x + (size_t)row * DM;
#pragma unroll
            for (int q = 0; q < 4; ++q) v[r][q] = *(const f32x4*)(xr + lane * 4 + 256 * q);
        }
#pragma unroll
        for (int r = 0; r < 4; ++r) { float s = 0.f;
#pragma unroll
            for (int q = 0; q < 4; ++q) s += v[r][q].x * v[r][q].x + v[r][q].y * v[r][q].y + v[r][q].z * v[r][q].z + v[r][q].w * v[r][q].w;
            ss[r] = s; }
#pragma unroll
        for (int o = 1; o < 64; o <<= 1) {
#pragma unroll
            for (int r = 0; r < 4; ++r) ss[r] += __shfl_xor(ss[r], o); }
#pragma unroll
        for (int r = 0; r < 4; ++r) {
            const int row = row0 + r * nw; if (row >= M_TOK) break;
            const float rstd = 1.0f / sqrtf(ss[r] * (1.0f / 1024.0f) + 1e-6f);
            const float* mrow = mod + (size_t)(layer * 9 + cond_of_row(row)) * 9216;
            const float* sh = mrow + (3 * j) * 1024; const float* sc = mrow + (3 * j + 1) * 1024;
#pragma unroll
            for (int q = 0; q < 4; ++q) {
                const int col = lane * 4 + 256 * q;
                const f32x4 g = *(const f32x4*)(gvec + col), s1 = *(const f32x4*)(sc + col), s0 = *(const f32x4*)(sh + col);
                const f32x4 y = (v[r][q] * rstd * g) * (s1 + 1.0f) + s0;
                *(u32x2*)(h + (size_t)row * DM + col) = pk4(y);
            }
        }
    }
}
__device__ __forceinline__ void first_rows(const P& p, const float* gvec, float* ss) {
    const int tid = tid_opaque(), lane = tid & 63, wave = tid >> 6;
    const float* mod = (const float*)(p.ws + WS_MOD);
    bf16* h = (bf16*)(p.ws + WS_H);
    const int nw = gridDim.x * 8;
    for (int row0 = blockIdx.x * 8 + wave; row0 < M_TOK; row0 += 4 * nw) {
        f32x4 v[4][4]; float sq[4];
#pragma unroll
        for (int r = 0; r < 4; ++r) {
            const int row = (row0 + r * nw) < M_TOK ? (row0 + r * nw) : (M_TOK - 1);
            const float* xr = row < MP ? p.in[0] + (size_t)row * DM : p.in[1] + (size_t)(row - MP) * DM;
#pragma unroll
            for (int q = 0; q < 4; ++q) v[r][q] = *(const f32x4*)(xr + lane * 4 + 256 * q);
        }
#pragma unroll
        for (int r = 0; r < 4; ++r) { float t = 0.f;
#pragma unroll
            for (int q = 0; q < 4; ++q) t += v[r][q].x * v[r][q].x + v[r][q].y * v[r][q].y + v[r][q].z * v[r][q].z + v[r][q].w * v[r][q].w;
            sq[r] = t; }
#pragma unroll
        for (int o = 1; o < 64; o <<= 1) {
#pragma unroll
            for (int r = 0; r < 4; ++r) sq[r] += __shfl_xor(sq[r], o); }
#pragma unroll
        for (int r = 0; r < 4; ++r) {
            const int row = row0 + r * nw; if (row >= M_TOK) break;
            if (lane == 0) ss[row] = rsqrtf_(sq[r] * (1.0f / 1024.0f) + 1e-6f);
            const float* sc = mod + (size_t)cond_of_row(row) * 9216 + 1024;
#pragma unroll
            for (int q = 0; q < 4; ++q) { const int col = lane * 4 + 256 * q;
                *(u32x2*)(h + (size_t)row * DM + col) = pk4(v[r][q] * (*(const f32x4*)(gvec + col) * (*(const f32x4*)(sc + col) + 1.0f))); }
        }
    }
}
__device__ __forceinline__ void final_norm_rows(const P& p) {
    const int tid = tid_opaque(), lane = tid & 63, wave = tid >> 6;
    float* x = p.out; const float* gvec = p.in[47];
    const int nw = gridDim.x * 8;
    for (int row0 = blockIdx.x * 8 + wave; row0 < M_TOK; row0 += 4 * nw) {
        f32x4 v[4][4]; float ss[4];
#pragma unroll
        for (int r = 0; r < 4; ++r) { const int row = (row0 + r * nw) < M_TOK ? (row0 + r * nw) : (M_TOK - 1);
#pragma unroll
            for (int q = 0; q < 4; ++q) v[r][q] = *(const f32x4*)(x + (size_t)row * DM + lane * 4 + 256 * q); }
#pragma unroll
        for (int r = 0; r < 4; ++r) { float s = 0.f;
#pragma unroll
            for (int q = 0; q < 4; ++q) s += v[r][q].x * v[r][q].x + v[r][q].y * v[r][q].y + v[r][q].z * v[r][q].z + v[r][q].w * v[r][q].w;
            ss[r] = s; }
#pragma unroll
        for (int o = 1; o < 64; o <<= 1) {
#pragma unroll
            for (int r = 0; r < 4; ++r) ss[r] += __shfl_xor(ss[r], o); }
#pragma unroll
        for (int r = 0; r < 4; ++r) { const int row = row0 + r * nw; if (row >= M_TOK) break;
            const float rstd = rsqrtf_(ss[r] * (1.0f / 1024.0f) + 1e-6f);
#pragma unroll
            for (int q = 0; q < 4; ++q) { const int col = lane * 4 + 256 * q; *(f32x4*)(x + (size_t)row * DM + col) = v[r][q] * rstd * *(const f32x4*)(gvec + col); } }
    }
}

template <int MODE>
__device__ __forceinline__ void transpose_w(const float* W, int ldw, int ncols_valid, int K, bf16* WT, int Nt, LAS unsigned char* lds, const float* shift = nullptr, float* cvo = nullptr, int ncv = 0, int rot = 0) {
    const int tid = tid_opaque(), lane = tid & 63, wave = tid >> 6;
    LAS float* scr = (LAS float*)(lds + wave * 16640);
    LAS float* shs = (LAS float*)(lds + 8 * 16640 + wave * 3072);
    const int nblk = Nt / 64, nitems = nblk * (K / 64);
    int vb = ((int)blockIdx.x + (int)gridDim.x - rot % (int)gridDim.x) % (int)gridDim.x;
    for (int it = vb * 8 + wave; it < nitems; it += gridDim.x * 8) {
        const int kb = it / nblk, nb = it % nblk, k0 = kb * 64;
        const int g0 = 2 * nb;
        const int sc0 = MODE == 1 ? (((g0 >> 2) & 1) * DFF + (g0 >> 3) * 128 + (g0 & 3) * 32) : nb * 64;
        const int c4 = (lane & 15) * 4, kr = lane >> 4; const bool ok = (sc0 + c4) < ncols_valid;
        f32x4 t[16];
#pragma unroll
        for (int i = 0; i < 16; ++i) t[i] = ok ? *(const f32x4*)(W + (size_t)(k0 + 4 * i + kr) * ldw + sc0 + c4) : (f32x4){0.f, 0.f, 0.f, 0.f};
#pragma unroll
        for (int i = 0; i < 16; ++i) { LAS float* d = scr + (4 * i + kr) * 65 + c4; d[0] = t[i].x; d[1] = t[i].y; d[2] = t[i].z; d[3] = t[i].w; }
        if (shift) {
#pragma unroll
            for (int cc = 0; cc < 9; ++cc) shs[lane * 12 + cc] = shift[(size_t)cc * 9216 + k0 + lane];
        }
        LDS_WAIT();
        if (shift) {
            float a9[9];
#pragma unroll
            for (int cc = 0; cc < 9; ++cc) a9[cc] = 0.f;
#pragma unroll 4
            for (int k = 0; k < 64; ++k) {
                const float w = scr[k * 65 + lane];
                const f32x4 s0 = *(const LAS f32x4*)(shs + k * 12), s1 = *(const LAS f32x4*)(shs + k * 12 + 4); const float s8 = shs[k * 12 + 8];
                a9[0] += w * s0.x; a9[1] += w * s0.y; a9[2] += w * s0.z; a9[3] += w * s0.w; a9[4] += w * s1.x; a9[5] += w * s1.y; a9[6] += w * s1.z; a9[7] += w * s1.w; a9[8] += w * s8;
            }
#pragma unroll
            for (int cc = 0; cc < 9; ++cc) __hip_atomic_fetch_add(cvo + (size_t)cc * ncv + nb * 64 + lane, a9[cc], __ATOMIC_RELAXED, __HIP_MEMORY_SCOPE_AGENT);
        }
        const int c = lane & 7;
#pragma unroll
        for (int j = 0; j < 8; ++j) {
            const int nn = (lane >> 3) + 8 * j; const LAS float* sp = scr + (8 * c) * 65 + nn;
            u32x4 o; o.x = pk2(sp[0 * 65], sp[1 * 65]); o.y = pk2(sp[2 * 65], sp[3 * 65]); o.z = pk2(sp[4 * 65], sp[5 * 65]); o.w = pk2(sp[6 * 65], sp[7 * 65]);
            *(u32x4*)(WT + (size_t)(nb * 64 + nn) * K + k0 + 8 * c) = o;
        }
        LDS_WAIT();
    }
}
__device__ __forceinline__ void convert_ffn_weights(const P& p, int layer, int which, LAS unsigned char* lds, const float* shift, float* cvo) {
    const float* wgu = p.in[which == 0 ? 13 : 15] + (size_t)layer * 1024 * 5632;
    const float* wdn = p.in[which == 0 ? 14 : 16] + (size_t)layer * 2816 * 1024;
    transpose_w<1>(wgu, 5632, 5632, 1024, (bf16*)(p.ws + W_GU), 5632, lds, shift, cvo, 5632);
    transpose_w<0>(wdn, 1024, 1024, 2816, (bf16*)(p.ws + W_DOWN), 1024, lds, nullptr, nullptr, 0, 176);
}
__device__ __forceinline__ void build_lora_w(const P& p) {
    bf16* WT = (bf16*)(p.ws + W_LORA);
    const float* w_up = p.in[21]; const float* a_up = p.in[23]; const float* g_up = p.in[24];
    for (int idx = blockIdx.x * NTHREADS + tid_opaque(); idx < 2560 * 384; idx += gridDim.x * NTHREADS) {
        const int n = idx / 384, k = idx % 384, seg = n >> 9, c = n & 511;
        float v = 0.f;
        if (seg == 0) { if (k < 64) v = w_up[(0 * 64 + k) * 512 + c]; }
        else if (seg == 1) { if (k >= 64 && k < 128) v = w_up[(1 * 64 + k - 64) * 512 + c]; }
        else if (seg == 2) { if (k >= 128 && k < 192) v = a_up[(0 * 64 + k - 128) * 512 + c]; }
        else if (seg == 3) { if (k >= 192 && k < 256) v = a_up[(1 * 64 + k - 192) * 512 + c]; }
        else { if (k >= 256) v = g_up[(k - 256) * 512 + c]; }
        WT[(size_t)n * 384 + k] = (bf16)(pk2(v, 0.f) & 0xffffu);
    }
}

__device__ __forceinline__ void ph_lora_in(const P& p) {
    const int tid = tid_opaque(), lane = tid & 63, wave = tid >> 6;
    const bf16* p0 = (const bf16*)(p.ws + WS_R1); bf16* LA = (bf16*)(p.ws + WS_H);
    const float* mu = p.in[19];
    const int nw = gridDim.x * 8;
    float m0[3], m1[3];
#pragma unroll
    for (int ch = 0; ch < 3; ++ch) { m0[ch] = mu[1536 + ch * 128 + lane * 2]; m1[ch] = mu[1536 + ch * 128 + lane * 2 + 1]; }
    for (int row0 = blockIdx.x * 8 + wave; row0 < M_TOK; row0 += 4 * nw) {
        unsigned cur[4][3], prv[4][3], nxt[4][3];
#pragma unroll
        for (int r = 0; r < 4; ++r) {
            const int row = (row0 + r * nw) < M_TOK ? (row0 + r * nw) : (M_TOK - 1);
            const int t = row < MP ? (row & 255) : ((row - MP) & 1023), L = row < MP ? 256 : 1024;
            const bool hp = t > 0, hn = t < L - 1;
#pragma unroll
            for (int ch = 0; ch < 3; ++ch) {
                const bf16* pc = p0 + (size_t)row * LDP0 + 1536 + ch * 128 + lane * 2;
                cur[r][ch] = *(const unsigned*)pc; prv[r][ch] = hp ? *(const unsigned*)(pc - LDP0) : 0u; nxt[r][ch] = hn ? *(const unsigned*)(pc + LDP0) : 0u;
            }
        }
#pragma unroll
        for (int r = 0; r < 4; ++r) {
            const int row = row0 + r * nw; if (row >= M_TOK) break;
#pragma unroll
            for (int ch = 0; ch < 3; ++ch) {
                float a0 = bflo(cur[r][ch]) + m0[ch] * (0.5f * (bflo(prv[r][ch]) + bflo(nxt[r][ch])) - bflo(cur[r][ch]));
                float a1 = bfhi(cur[r][ch]) + m1[ch] * (0.5f * (bfhi(prv[r][ch]) + bfhi(nxt[r][ch])) - bfhi(cur[r][ch]));
                if (ch == 0) { a0 = tanhf(a0); a1 = tanhf(a1); }
                if (ch == 2) { a0 = sigmoidf_(a0); a1 = sigmoidf_(a1); }
                *(unsigned*)(LA + (size_t)row * 384 + ch * 128 + lane * 2) = pk2(a0, a1);
            }
        }
    }
}

__device__ __forceinline__ void rwkv_item(const P& p, LAS unsigned char* lds, int kind, int b, int head, int dir) {
    constexpr int T = 32, NG = 8, GS = 1408;
    LAS float* grp = (LAS float*)lds;
    LAS float* raw = grp + 2 * NG * GS;
    LAS float* ybR = raw + T * 320;
    const int tid = tid_opaque(), lane = tid & 63, wave = tid >> 6, q = lane & 7, vl = lane >> 3, r0 = wave * 8 + vl;
    const int tt = tid >> 4, cgi = tid & 15;
    const int L = kind ? 1024 : 256, nblk = L / T;
    const int rowbase = kind ? MP + b * 1024 : b * 256;
    const bf16* p0 = (const bf16*)(p.ws + WS_R1);
    const bf16* lo = (const bf16*)(p.ws + WS_R2);
    bf16* Y = (bf16*)(p.ws + (dir == 0 ? WS_MIX : WS_H));
    const int colbase = head * 64;
    f32x2 S[4];
#pragma unroll
    for (int i = 0; i < 4; ++i) S[i] = (f32x2){0.f, 0.f};
    if (kind) { const float* s0 = p.in[2] + (((size_t)b * 2 + dir) * 8 + head) * 4096 + q * 8;
        const f32x4 a0 = *(const f32x4*)(s0 + r0 * 64), a1 = *(const f32x4*)(s0 + r0 * 64 + 4);
        S[0] = (f32x2){a0.x, a0.y}; S[1] = (f32x2){a0.z, a0.w}; S[2] = (f32x2){a1.x, a1.y}; S[3] = (f32x2){a1.z, a1.w}; }
    const int C = head * 64 + cgi * 4;
    const f32x4 cA = *(const f32x4*)(p.in[19] + C), cB = *(const f32x4*)(p.in[19] + 512 + C), cC = *(const f32x4*)(p.in[19] + 1024 + C);
    const f32x4 cD = *(const f32x4*)(p.in[25] + C), cE = *(const f32x4*)(p.in[26] + C);
    u32x2 ra0, ra1, ra2, rb0, rb1, rb2, rc0, rc1, rc2, rd, re;
    const u32x2 z2 = {0u, 0u};
#define RW_LOAD(blk) do { \
        const int n_ = (blk) * T + tt, t_ = dir ? L - 1 - n_ : n_; const size_t row_ = (size_t)(rowbase + t_); \
        const bool hp_ = t_ > 0, hn_ = t_ < L - 1; \
        const bf16* pr_ = p0 + row_ * LDP0 + head * 64 + cgi * 4; \
        ra1 = *(const u32x2*)pr_; ra0 = hp_ ? *(const u32x2*)(pr_ - LDP0) : z2; ra2 = hn_ ? *(const u32x2*)(pr_ + LDP0) : z2; \
        rb1 = *(const u32x2*)(pr_ + 512); rb0 = hp_ ? *(const u32x2*)(pr_ + 512 - LDP0) : z2; rb2 = hn_ ? *(const u32x2*)(pr_ + 512 + LDP0) : z2; \
        rc1 = *(const u32x2*)(pr_ + 1024); rc0 = hp_ ? *(const u32x2*)(pr_ + 1024 - LDP0) : z2; rc2 = hn_ ? *(const u32x2*)(pr_ + 1024 + LDP0) : z2; \
        rd = *(const u32x2*)(lo + row_ * 2560 + dir * 512 + head * 64 + cgi * 4); re = *(const u32x2*)(lo + row_ * 2560 + 1024 + dir * 512 + head * 64 + cgi * 4); \
    } while (0)
#define RW_PREP1(bi) do { \
        LAS float* rw_ = raw + tt * 320; const int c4_ = cgi * 4; \
        const f32x4 r1_ = unpk4(ra1), k1_ = unpk4(rb1), v1_ = unpk4(rc1); \
        const f32x4 r_ = r1_ + cA * ((unpk4(ra0) + unpk4(ra2)) * 0.5f - r1_); \
        const f32x4 k_ = k1_ + cB * ((unpk4(rb0) + unpk4(rb2)) * 0.5f - k1_); \
        const f32x4 v_ = v1_ + cC * ((unpk4(rc0) + unpk4(rc2)) * 0.5f - v1_); \
        f32x4 kk_ = k_ * cD; \
        const float ss_ = red16(kk_.x * kk_.x + kk_.y * kk_.y + kk_.z * kk_.z + kk_.w * kk_.w); \
        kk_ = kk_ * rsqrtf_(ss_ + 1e-6f); \
        const f32x4 ew_ = unpk4(rd), a_ = unpk4(re); \
        f32x4 w_; w_.x = __expf(-ew_.x); w_.y = __expf(-ew_.y); w_.z = __expf(-ew_.z); w_.w = __expf(-ew_.w); \
        *(LAS f32x4*)(rw_ + c4_) = kk_; *(LAS f32x4*)(rw_ + 64 + c4_) = w_; *(LAS f32x4*)(rw_ + 128 + c4_) = kk_ * a_; \
        *(LAS f32x4*)(rw_ + 192 + c4_) = k_ * ((a_ - 1.0f) * cE + 1.0f); *(LAS f32x4*)(rw_ + 256 + c4_) = r_; \
        *(LAS f32x4*)(grp + ((bi) * NG + (tt >> 2)) * GS + 1088 + (tt & 3) * 64 + c4_) = v_; \
    } while (0)
#define DOT16(aa_, bb_) red16((aa_)[0] * (bb_)[0] + (aa_)[1] * (bb_)[1] + (aa_)[2] * (bb_)[2] + (aa_)[3] * (bb_)[3])
#define RW_PREP2(bi) do { if (tid < 128) { \
        const int gq_ = tid >> 4, c4_ = cgi * 4; const LAS float* r4_ = raw + gq_ * 4 * 320 + c4_; LAS float* gi_ = grp + ((bi) * NG + gq_) * GS; \
        const f32x4 kk1 = *(const LAS f32x4*)(r4_), w1 = *(const LAS f32x4*)(r4_ + 64), b1 = *(const LAS f32x4*)(r4_ + 128), d1 = *(const LAS f32x4*)(r4_ + 192), q1 = *(const LAS f32x4*)(r4_ + 256); \
        const f32x4 kk2 = *(const LAS f32x4*)(r4_ + 320), w2 = *(const LAS f32x4*)(r4_ + 384), b2 = *(const LAS f32x4*)(r4_ + 448), d2 = *(const LAS f32x4*)(r4_ + 512), q2 = *(const LAS f32x4*)(r4_ + 576); \
        const f32x4 kk3 = *(const LAS f32x4*)(r4_ + 640), w3 = *(const LAS f32x4*)(r4_ + 704), b3 = *(const LAS f32x4*)(r4_ + 768), d3 = *(const LAS f32x4*)(r4_ + 832), q3 = *(const LAS f32x4*)(r4_ + 896); \
        const f32x4 kk4 = *(const LAS f32x4*)(r4_ + 960), w4 = *(const LAS f32x4*)(r4_ + 1024), b4 = *(const LAS f32x4*)(r4_ + 1088), d4 = *(const LAS f32x4*)(r4_ + 1152), q4 = *(const LAS f32x4*)(r4_ + 1216); \
        const f32x4 W02 = w1 * w2, W03 = W02 * w3, W04 = W03 * w4, W13 = w2 * w3, W14 = W13 * w4, W24 = w3 * w4; \
        *(LAS f32x4*)(gi_ + c4_) = kk1; *(LAS f32x4*)(gi_ + 64 + c4_) = w1 * kk2; *(LAS f32x4*)(gi_ + 128 + c4_) = W02 * kk3; *(LAS f32x4*)(gi_ + 192 + c4_) = W03 * kk4; \
        *(LAS f32x4*)(gi_ + 256 + c4_) = w1 * q1; *(LAS f32x4*)(gi_ + 320 + c4_) = W02 * q2; *(LAS f32x4*)(gi_ + 384 + c4_) = W03 * q3; *(LAS f32x4*)(gi_ + 448 + c4_) = W04 * q4; \
        *(LAS f32x4*)(gi_ + 512 + c4_) = d1 * W14; *(LAS f32x4*)(gi_ + 576 + c4_) = d2 * W24; *(LAS f32x4*)(gi_ + 640 + c4_) = d3 * w4; *(LAS f32x4*)(gi_ + 704 + c4_) = d4; \
        *(LAS f32x4*)(gi_ + 768 + c4_) = b1 * W14; *(LAS f32x4*)(gi_ + 832 + c4_) = b2 * W24; *(LAS f32x4*)(gi_ + 896 + c4_) = b3 * w4; *(LAS f32x4*)(gi_ + 960 + c4_) = b4; \
        *(LAS f32x4*)(gi_ + 1024 + c4_) = W04; \
        const f32x4 d1w2 = d1 * w2, d1w13 = d1 * W13, d1w14 = d1 * W14, d2w3 = d2 * w3, d2w24 = d2 * W24, d3w4 = d3 * w4; \
        const f32x4 b1w2 = b1 * w2, b1w13 = b1 * W13, b1w14 = b1 * W14, b2w3 = b2 * w3, b2w24 = b2 * W24, b3w4 = b3 * w4; \
        float sc_[32]; \
        sc_[0] = DOT16(d1, kk2); sc_[1] = DOT16(d1w2, kk3); sc_[2] = DOT16(d2, kk3); sc_[3] = DOT16(d1w13, kk4); sc_[4] = DOT16(d2w3, kk4); sc_[5] = DOT16(d3, kk4); \
        sc_[6] = DOT16(b1, kk2); sc_[7] = DOT16(b1w2, kk3); sc_[8] = DOT16(b2, kk3); sc_[9] = DOT16(b1w13, kk4); sc_[10] = DOT16(b2w3, kk4); sc_[11] = DOT16(b3, kk4); \
        sc_[12] = DOT16(d1, q1); sc_[13] = DOT16(d1w2, q2); sc_[14] = DOT16(d2, q2); sc_[15] = DOT16(d1w13, q3); sc_[16] = DOT16(d2w3, q3); sc_[17] = DOT16(d3, q3); \
        sc_[18] = DOT16(d1w14, q4); sc_[19] = DOT16(d2w24, q4); sc_[20] = DOT16(d3w4, q4); sc_[21] = DOT16(d4, q4); \
        sc_[22] = DOT16(b1, q1); sc_[23] = DOT16(b1w2, q2); sc_[24] = DOT16(b2, q2); sc_[25] = DOT16(b1w13, q3); sc_[26] = DOT16(b2w3, q3); sc_[27] = DOT16(b3, q3); \
        sc_[28] = DOT16(b1w14, q4); sc_[29] = DOT16(b2w24, q4); sc_[30] = DOT16(b3w4, q4); sc_[31] = DOT16(b4, q4); \
        if (cgi < 8) { _Pragma("unroll") for (int i_ = 0; i_ < 8; ++i_) if (cgi == i_) *(LAS f32x4*)(gi_ + 1344 + 4 * i_) = (f32x4){sc_[4 * i_], sc_[4 * i_ + 1], sc_[4 * i_ + 2], sc_[4 * i_ + 3]}; } \
    } } while (0)
    __syncthreads();
    RW_LOAD(0); RW_PREP1(0);
    __syncthreads();
    RW_PREP2(0);
    __syncthreads();
#pragma unroll 1
    for (int blk = 0; blk < nblk; ++blk) {
        const int bi = blk & 1;
        if (blk + 1 < nblk) RW_LOAD(blk + 1);
        LAS float* yb = ybR + bi * T * 64;
#pragma unroll 1
        for (int g = 0; g < NG; ++g) {
            const LAS float* gi = grp + (bi * NG + g) * GS;
            float dp[4], du[4];
#pragma unroll
            for (int t = 0; t < 4; ++t) {
                const f32x4 pa = *(const LAS f32x4*)(gi + t * 64 + q * 8), pb = *(const LAS f32x4*)(gi + t * 64 + q * 8 + 4);
                const f32x4 ua = *(const LAS f32x4*)(gi + 256 + t * 64 + q * 8), ub = *(const LAS f32x4*)(gi + 256 + t * 64 + q * 8 + 4);
                const f32x2 a = __builtin_elementwise_fma(S[0], (f32x2){pa.x, pa.y}, S[1] * (f32x2){pa.z, pa.w}) + __builtin_elementwise_fma(S[2], (f32x2){pb.x, pb.y}, S[3] * (f32x2){pb.z, pb.w});
                const f32x2 c = __builtin_elementwise_fma(S[0], (f32x2){ua.x, ua.y}, S[1] * (f32x2){ua.z, ua.w}) + __builtin_elementwise_fma(S[2], (f32x2){ub.x, ub.y}, S[3] * (f32x2){ub.z, ub.w});
                dp[t] = a.x + a.y; du[t] = c.x + c.y;
            }
#pragma unroll
            for (int t = 0; t < 4; ++t) { dp[t] = red8(dp[t]); du[t] = red8(du[t]); }
            const float v1 = gi[1088 + r0], v2 = gi[1152 + r0], v3 = gi[1216 + r0], v4 = gi[1280 + r0];
            const f32x4 A0 = *(const LAS f32x4*)(gi + 1344), A1 = *(const LAS f32x4*)(gi + 1348), B0 = *(const LAS f32x4*)(gi + 1352), E0 = *(const LAS f32x4*)(gi + 1356);
            const f32x4 E1 = *(const LAS f32x4*)(gi + 1360), E2 = *(const LAS f32x4*)(gi + 1364), F0 = *(const LAS f32x4*)(gi + 1368), F1 = *(const LAS f32x4*)(gi + 1372);
            const float g1 = dp[0];
            const float g2 = dp[1] + v1 * A0.x - g1 * A1.z;
            const float g3 = dp[2] + v1 * A0.y + v2 * A0.z - g1 * A1.w - g2 * B0.x;
            const float g4 = dp[3] + v1 * A0.w + v2 * A1.x + v3 * A1.y - g1 * B0.y - g2 * B0.z - g3 * B0.w;
            const float y1 = du[0] + v1 * E0.x - g1 * E2.z;
            const float y2 = du[1] + v1 * E0.y + v2 * E0.z - g1 * E2.w - g2 * F0.x;
            const float y3 = du[2] + v1 * E0.w + v2 * E1.x + v3 * E1.y - g1 * F0.y - g2 * F0.z - g3 * F0.w;
            const float y4 = du[3] + v1 * E1.z + v2 * E1.w + v3 * E2.x + v4 * E2.y - g1 * F1.x - g2 * F1.y - g3 * F1.z - g4 * F1.w;
            if (q == 0) { yb[(4 * g) * 64 + r0] = y1; yb[(4 * g + 1) * 64 + r0] = y2; yb[(4 * g + 2) * 64 + r0] = y3; yb[(4 * g + 3) * 64 + r0] = y4; }
            {
                const f32x4 wa = *(const LAS f32x4*)(gi + 1024 + q * 8), wb = *(const LAS f32x4*)(gi + 1024 + q * 8 + 4);
                f32x2 n0 = S[0] * (f32x2){wa.x, wa.y}, n1 = S[1] * (f32x2){wa.z, wa.w}, n2 = S[2] * (f32x2){wb.x, wb.y}, n3 = S[3] * (f32x2){wb.z, wb.w};
                const float vv[4] = {v1, v2, v3, v4}, gg[4] = {g1, g2, g3, g4};
#pragma unroll
                for (int j = 0; j < 4; ++j) {
                    const f32x4 da = *(const LAS f32x4*)(gi + 512 + j * 64 + q * 8), db = *(const LAS f32x4*)(gi + 512 + j * 64 + q * 8 + 4);
                    const f32x4 ba = *(const LAS f32x4*)(gi + 768 + j * 64 + q * 8), bb = *(const LAS f32x4*)(gi + 768 + j * 64 + q * 8 + 4);
                    const f32x2 vj = {vv[j], vv[j]}, ng = {-gg[j], -gg[j]};
                    n0 = __builtin_elementwise_fma(vj, (f32x2){da.x, da.y}, n0); n1 = __builtin_elementwise_fma(vj, (f32x2){da.z, da.w}, n1);
                    n2 = __builtin_elementwise_fma(vj, (f32x2){db.x, db.y}, n2); n3 = __builtin_elementwise_fma(vj, (f32x2){db.z, db.w}, n3);
                    n0 = __builtin_elementwise_fma(ng, (f32x2){ba.x, ba.y}, n0); n1 = __builtin_elementwise_fma(ng, (f32x2){ba.z, ba.w}, n1);
                    n2 = __builtin_elementwise_fma(ng, (f32x2){bb.x, bb.y}, n2); n3 = __builtin_elementwise_fma(ng, (f32x2){bb.z, bb.w}, n3);
                }
                S[0] = n0; S[1] = n1; S[2] = n2; S[3] = n3;
            }
        }
        if (blk + 1 < nblk) RW_PREP1(bi ^ 1);
        __syncthreads();
        if (blk + 1 < nblk) RW_PREP2(bi ^ 1);
        {
            const int r4 = cgi * 4, n = blk * T + tt, tk = dir ? L - 1 - n : n;
            const f32x4 yv = *(const LAS f32x4*)(yb + tt * 64 + r4);
            *(u32x2*)(Y + (size_t)(rowbase + tk) * 1024 + colbase + r4) = pk4(yv);
        }
        __syncthreads();
    }
#undef RW_LOAD
#undef RW_PREP1
#undef RW_PREP2
#undef DOT16
    if (!kind) { float* so = p.out + OUT_SRW + (((size_t)b * 2 + dir) * 8 + head) * 4096 + q * 8;
        *(f32x4*)(so + r0 * 64) = (f32x4){S[0].x, S[0].y, S[1].x, S[1].y}; *(f32x4*)(so + r0 * 64 + 4) = (f32x4){S[2].x, S[2].y, S[3].x, S[3].y}; }
}

__device__ __forceinline__ void gdn_item(const P& p, LAS unsigned char* lds, int kind, int b, int head, int dir, int half) {
    LAS bf16* Qs = (LAS bf16*)(lds);
    LAS bf16* Ks = (LAS bf16*)(lds + 17408);
    LAS bf16* KT = (LAS bf16*)(lds + 34816);
    LAS bf16* VT = (LAS bf16*)(lds + 53248);
    LAS bf16* ST = (LAS bf16*)(lds + 62464);
    LAS float* Lm = (LAS float*)(lds + 79872);
    LAS bf16* vnT = (LAS bf16*)(lds + 79872);
    LAS bf16* vnsT = (LAS bf16*)(lds + 79872 + 9216);
    LAS float* Tm = (LAS float*)(lds + 98304);
    LAS bf16* Tb = (LAS bf16*)(lds + 115712);
    LAS bf16* QKg = (LAS bf16*)(lds + 124928);
    LAS bf16* rT = (LAS bf16*)(lds + 134144);
    LAS float* gs = (LAS float*)(lds + 143360);
    LAS float* bs = gs + 64;
    LAS float* Gs = gs + 128;
    LAS float* eGs = gs + 192;
    LAS float* eGl = gs + 256;
    LAS float* misc = gs + 320;
    LAS float* CW = (LAS float*)(lds + 144896);
    LAS float* Ysc = (LAS float*)(lds + 148736);
    const int tid = tid_opaque(), lane = tid & 63, wave = tid >> 6, ln = lane & 15, h4 = lane >> 4;
    const int L = kind ? 1024 : 256, nch = L / 64, rowbase = kind ? MP + b * 1024 : b * 256;
    const bf16* p0 = (const bf16*)(p.ws + WS_R1);
    bf16* Y = (bf16*)(p.ws + (dir == 0 ? WS_MIX : WS_H));
    const int colbase = 512 + head * 128 + half * 64;
    const int pi = tid >> 3, c8 = tid & 7;
    const float gA = -expf(p.in[31][dir * 4 + head]), gB = p.in[32][dir * 4 + head];
    __syncthreads();
    for (int e = tid; e < 960; e += NTHREADS) {
        float v;
        if (e < 768) { const int part = e / 384, r = e % 384, tap = r >> 7, d = r & 127; v = p.in[30][tap * 1536 + part * 512 + head * 128 + d]; }
        else { const int r = e - 768, tap = r >> 6, c = r & 63; v = p.in[30][tap * 1536 + 1024 + head * 128 + half * 64 + c]; }
        CW[e] = v;
    }
    for (int e = tid; e < 64 * 72 / 2; e += NTHREADS) { ((LAS unsigned*)Tb)[e] = 0u; ((LAS unsigned*)QKg)[e] = 0u; }
    f32x4 accS[4];
#pragma unroll
    for (int vt = 0; vt < 4; ++vt) {
        accS[vt] = (f32x4){0.f, 0.f, 0.f, 0.f};
        if (kind) { const float* s0 = p.in[3] + (((size_t)b * 2 + dir) * 4 + head) * 16384 + half * 64 + vt * 16 + ln;
#pragma unroll
            for (int r = 0; r < 4; ++r) accS[vt][r] = s0[(size_t)(wave * 16 + h4 * 4 + r) * 128]; }
        *(LAS u32x2*)(ST + (vt * 16 + ln) * 136 + wave * 16 + h4 * 4) = pk4(accS[vt]);
    }
    u32x4 rq[3][2], rk[3][2], rv[3]; unsigned rab = 0u, rbb = 0u;
    const u32x4 z4 = {0u, 0u, 0u, 0u};
#define GD_LOAD(n) do { \
        const int i_ = (n) * 64 + pi, t_ = dir ? L - 1 - i_ : i_; const size_t row_ = (size_t)(rowbase + t_); \
        const bf16* pr_ = p0 + row_ * LDP0 + 1920 + head * 128 + c8 * 16; \
        const bf16* pv_ = p0 + row_ * LDP0 + 1920 + 1024 + head * 128 + half * 64 + c8 * 8; \
        _Pragma("unroll") for (int j_ = 0; j_ < 3; ++j_) { \
            const bool ok_ = (j_ == 1) || (j_ == 0 ? t_ > 0 : t_ < L - 1); const long o_ = (long)(j_ - 1) * LDP0; \
            rq[j_][0] = ok_ ? *(const u32x4*)(pr_ + o_) : z4; rq[j_][1] = ok_ ? *(const u32x4*)(pr_ + o_ + 8) : z4; \
            rk[j_][0] = ok_ ? *(const u32x4*)(pr_ + o_ + 512) : z4; rk[j_][1] = ok_ ? *(const u32x4*)(pr_ + o_ + 520) : z4; \
            rv[j_] = ok_ ? *(const u32x4*)(pv_ + o_) : z4; } \
        rab = p0[row_ * LDP0 + 3968 + dir * 8 + head]; rbb = p0[row_ * LDP0 + 3968 + dir * 8 + 4 + head]; \
    } while (0)
    GD_LOAD(0);
    __syncthreads();
#pragma unroll 1
    for (int n = 0; n < nch; ++n) {
        {
            const int pis = (((pi >> 3) ^ c8) << 3) | (pi & 7);
            {
                float xq[16]; float sq = 0.f;
#pragma unroll
                for (int e = 0; e < 16; ++e) { const int d = c8 * 16 + e; const int wi = e >> 1, hi = e & 1, vi = wi >> 2, ci = wi & 3;
                    const float q0 = hi ? bfhi(rq[0][vi][ci]) : bflo(rq[0][vi][ci]), q1 = hi ? bfhi(rq[1][vi][ci]) : bflo(rq[1][vi][ci]), q2 = hi ? bfhi(rq[2][vi][ci]) : bflo(rq[2][vi][ci]);
                    const float a = CW[d] * q0 + CW[128 + d] * q1 + CW[256 + d] * q2;
                    xq[e] = siluf_(a); sq += xq[e] * xq[e]; }
                sq = red8(sq);
                const float nq = 0.08838834764831845f * rsqrtf_(sq + 1e-6f);
                u32x4 w0, w1;
                w0.x = pk2(xq[0] * nq, xq[1] * nq); w0.y = pk2(xq[2] * nq, xq[3] * nq); w0.z = pk2(xq[4] * nq, xq[5] * nq); w0.w = pk2(xq[6] * nq, xq[7] * nq);
                w1.x = pk2(xq[8] * nq, xq[9] * nq); w1.y = pk2(xq[10] * nq, xq[11] * nq); w1.z = pk2(xq[12] * nq, xq[13] * nq); w1.w = pk2(xq[14] * nq, xq[15] * nq);
                *(LAS u32x4*)(Qs + pi * 136 + c8 * 16) = w0; *(LAS u32x4*)(Qs + pi * 136 + c8 * 16 + 8) = w1;
            }
            {
                float xk[16]; float sk = 0.f;
#pragma unroll
                for (int e = 0; e < 16; ++e) { const int d = c8 * 16 + e; const int wi = e >> 1, hi = e & 1, vi = wi >> 2, ci = wi & 3;
                    const float k0 = hi ? bfhi(rk[0][vi][ci]) : bflo(rk[0][vi][ci]), k1 = hi ? bfhi(rk[1][vi][ci]) : bflo(rk[1][vi][ci]), k2 = hi ? bfhi(rk[2][vi][ci]) : bflo(rk[2][vi][ci]);
                    const float c = CW[384 + d] * k0 + CW[512 + d] * k1 + CW[640 + d] * k2;
                    xk[e] = siluf_(c); sk += xk[e] * xk[e]; }
                sk = red8(sk);
                const float nk = rsqrtf_(sk + 1e-6f);
                u32x4 w0, w1;
                w0.x = pk2(xk[0] * nk, xk[1] * nk); w0.y = pk2(xk[2] * nk, xk[3] * nk); w0.z = pk2(xk[4] * nk, xk[5] * nk); w0.w = pk2(xk[6] * nk, xk[7] * nk);
                w1.x = pk2(xk[8] * nk, xk[9] * nk); w1.y = pk2(xk[10] * nk, xk[11] * nk); w1.z = pk2(xk[12] * nk, xk[13] * nk); w1.w = pk2(xk[14] * nk, xk[15] * nk);
                *(LAS u32x4*)(Ks + pi * 136 + c8 * 16) = w0; *(LAS u32x4*)(Ks + pi * 136 + c8 * 16 + 8) = w1;
#pragma unroll
                for (int e = 0; e < 4; ++e) {
                    KT[(c8 * 16 + 2 * e) * 72 + pis] = (bf16)(w0[e] & 0xffffu); KT[(c8 * 16 + 2 * e + 1) * 72 + pis] = (bf16)(w0[e] >> 16);
                    KT[(c8 * 16 + 8 + 2 * e) * 72 + pis] = (bf16)(w1[e] & 0xffffu); KT[(c8 * 16 + 8 + 2 * e + 1) * 72 + pis] = (bf16)(w1[e] >> 16); }
            }
#pragma unroll
            for (int e = 0; e < 8; ++e) { const int c = c8 * 8 + e; const int wi = e >> 1, hi = e & 1;
                const float v0 = hi ? bfhi(rv[0][wi]) : bflo(rv[0][wi]), v1 = hi ? bfhi(rv[1][wi]) : bflo(rv[1][wi]), v2 = hi ? bfhi(rv[2][wi]) : bflo(rv[2][wi]);
                const float a = CW[768 + c] * v0 + CW[832 + c] * v1 + CW[896 + c] * v2;
                VT[c * 72 + pis] = (bf16)(pk2(siluf_(a), 0.f) & 0xffffu); }
            if (c8 == 0) { const float xa = bf2f(rab) + gB; const float sp = xa > 20.f ? xa : log1pf(expf(xa)); gs[pi] = gA * sp; bs[pi] = 1.0f / (1.0f + expf(-bf2f(rbb))); }
        }
        __syncthreads();
        if (n + 1 < nch) GD_LOAD(n + 1);
        if (wave == 0) {
            float x = gs[lane];
            x += DPPF(x, 0x111); x += DPPF(x, 0x112); x += DPPF(x, 0x114); x += DPPF(x, 0x118);
            const int xi = __float_as_int(x);
            const float t0 = __int_as_float(__builtin_amdgcn_readlane(xi, 15)), t1 = __int_as_float(__builtin_amdgcn_readlane(xi, 31)), t2 = __int_as_float(__builtin_amdgcn_readlane(xi, 47));
            x += (lane >= 48) ? (t0 + t1 + t2) : ((lane >= 32) ? (t0 + t1) : ((lane >= 16) ? t0 : 0.f));
            const float Gl = __int_as_float(__builtin_amdgcn_readlane(__float_as_int(x), 63));
            Gs[lane] = x; eGs[lane] = __expf(x); eGl[lane] = __expf(Gl - x); if (lane == 0) misc[0] = __expf(Gl);
        }
        __syncthreads();
#pragma unroll 1
        for (int tix = wave; tix < 20; tix += 8) {
            const int x = tix < 10 ? tix : tix - 10;
            const int it = x >= 6 ? 3 : (x >= 3 ? 2 : (x >= 1 ? 1 : 0)), jt = x - (it * (it + 1)) / 2;
            f32x4 a = {0.f, 0.f, 0.f, 0.f};
            if (tix < 10) {
#pragma unroll
                for (int s = 0; s < 4; ++s) a = __builtin_amdgcn_mfma_f32_16x16x32_bf16(*(const LAS s16x8*)(Ks + (16 * it + ln) * 136 + 32 * s + 8 * h4), *(const LAS s16x8*)(Ks + (16 * jt + ln) * 136 + 32 * s + 8 * h4), a, 0, 0, 0);
                const int j = 16 * jt + ln; const float Gj = Gs[j];
#pragma unroll
                for (int r = 0; r < 4; ++r) { const int i = 16 * it + 4 * h4 + r; Lm[i * 72 + j] = i > j ? bs[i] * a[r] * __expf(Gs[i] - Gj) : 0.f; }
            } else {
#pragma unroll
                for (int s = 0; s < 4; ++s) a = __builtin_amdgcn_mfma_f32_16x16x32_bf16(*(const LAS s16x8*)(Ks + (16 * jt + ln) * 136 + 32 * s + 8 * h4), *(const LAS s16x8*)(Qs + (16 * it + ln) * 136 + 32 * s + 8 * h4), a, 0, 0, 0);
                const int i = 16 * it + ln; const float Gi = Gs[i]; f32x4 o;
#pragma unroll
                for (int r = 0; r < 4; ++r) { const int j = 16 * jt + 4 * h4 + r; o[r] = i >= j ? a[r] * __expf(Gi - Gs[j]) : 0.f; }
                *(LAS u32x2*)(QKg + i * 72 + 16 * jt + 4 * h4) = pk4(o);
            }
        }
        __syncthreads();
        if (wave == 0) {
            const int a = h4, c = ln; float xr[16];
#pragma unroll
            for (int r = 0; r < 16; ++r) { float s = (r == c) ? 1.0f : 0.0f;
#pragma unroll
                for (int m = 0; m < r; ++m) s -= Lm[(16 * a + r) * 72 + 16 * a + m] * xr[m];
                xr[r] = s; }
#pragma unroll
            for (int r = 0; r < 16; ++r) { Tm[(16 * a + r) * 68 + 16 * a + c] = xr[r]; Tb[(16 * a + r) * 72 + 16 * a + c] = (bf16)(pk2(xr[r], 0.f) & 0xffffu); }
        } else {
#pragma unroll 1
            for (int tk = wave - 1; tk < 16; tk += 7) {
                const int it = tk >> 2, vt = tk & 3; f32x4 a = {0.f, 0.f, 0.f, 0.f};
#pragma unroll
                for (int s = 0; s < 4; ++s) a = __builtin_amdgcn_mfma_f32_16x16x32_bf16(*(const LAS s16x8*)(Ks + (16 * it + ln) * 136 + 32 * s + 8 * h4), *(const LAS s16x8*)(ST + (16 * vt + ln) * 136 + 32 * s + 8 * h4), a, 0, 0, 0);
                const int v = 16 * vt + ln, i0 = 16 * it + 4 * h4;
                const f32x4 vj = unpk4(*(const LAS u32x2*)(VT + v * 72 + ((((i0 >> 3) ^ (v >> 3)) & 7) << 3) + (i0 & 7))), be = *(const LAS f32x4*)(bs + i0), eg = *(const LAS f32x4*)(eGs + i0);
                *(LAS u32x2*)(rT + v * 72 + i0) = pk4(be * (vj - eg * a));
            }
        }
        __syncthreads();
#pragma unroll 1
        for (int dist = 1; dist < 4; ++dist) {
            if (wave < 4 - dist) {
                const int bb = wave, aa = wave + dist; LAS float* ys = Ysc + wave * 272;
                f32x4 y = {0.f, 0.f, 0.f, 0.f};
                float la[3][4], tb[3][4];
#pragma unroll
                for (int mm = 0; mm < 3; ++mm)
#pragma unroll
                    for (int s = 0; s < 4; ++s) { const int m = bb + (mm < dist ? mm : 0);
                        la[mm][s] = Lm[(16 * aa + ln) * 72 + 16 * m + 4 * s + h4]; tb[mm][s] = Tm[(16 * m + 4 * s + h4) * 68 + 16 * bb + ln]; }
#pragma unroll
                for (int mm = 0; mm < 3; ++mm)
                    if (mm < dist) {
#pragma unroll
                        for (int s = 0; s < 4; ++s) y = __builtin_amdgcn_mfma_f32_16x16x4f32(la[mm][s], tb[mm][s], y, 0, 0, 0); }
#pragma unroll
                for (int r = 0; r < 4; ++r) ys[(4 * h4 + r) * 17 + ln] = y[r];
                f32x4 z = {0.f, 0.f, 0.f, 0.f};
#pragma unroll
                for (int s = 0; s < 4; ++s) z = __builtin_amdgcn_mfma_f32_16x16x4f32(Tm[(16 * aa + ln) * 68 + 16 * aa + 4 * s + h4], ys[(4 * s + h4) * 17 + ln], z, 0, 0, 0);
#pragma unroll
                for (int r = 0; r < 4; ++r) { const int i = 16 * aa + 4 * h4 + r, j = 16 * bb + ln; Tm[i * 68 + j] = -z[r]; Tb[i * 72 + j] = (bf16)(pk2(-z[r], 0.f) & 0xffffu); }
            }
            __syncthreads();
        }
#pragma unroll
        for (int u = 0; u < 2; ++u) {
            const int tile = 2 * wave + u, it = tile >> 2, vt = tile & 3; f32x4 a = {0.f, 0.f, 0.f, 0.f};
            a = __builtin_amdgcn_mfma_f32_16x16x32_bf16(*(const LAS s16x8*)(Tb + (16 * it + ln) * 72 + 8 * h4), *(const LAS s16x8*)(rT + (16 * vt + ln) * 72 + 8 * h4), a, 0, 0, 0);
            if (it >= 2) a = __builtin_amdgcn_mfma_f32_16x16x32_bf16(*(const LAS s16x8*)(Tb + (16 * it + ln) * 72 + 32 + 8 * h4), *(const LAS s16x8*)(rT + (16 * vt + ln) * 72 + 32 + 8 * h4), a, 0, 0, 0);
            const int v = 16 * vt + ln, i0 = 16 * it + 4 * h4;
            *(LAS u32x2*)(vnT + v * 72 + i0) = pk4(a); *(LAS u32x2*)(vnsT + v * 72 + i0) = pk4(a * *(const LAS f32x4*)(eGl + i0));
        }
        __syncthreads();
#pragma unroll
        for (int u = 0; u < 2; ++u) {
            const int tile = 2 * wave + u, vt = tile >> 2, it = tile & 3; f32x4 a = {0.f, 0.f, 0.f, 0.f};
#pragma unroll
            for (int s = 0; s < 4; ++s) a = __builtin_amdgcn_mfma_f32_16x16x32_bf16(*(const LAS s16x8*)(ST + (16 * vt + ln) * 136 + 32 * s + 8 * h4), *(const LAS s16x8*)(Qs + (16 * it + ln) * 136 + 32 * s + 8 * h4), a, 0, 0, 0);
            a = a * eGs[16 * it + ln];
            a = __builtin_amdgcn_mfma_f32_16x16x32_bf16(*(const LAS s16x8*)(vnT + (16 * vt + ln) * 72 + 8 * h4), *(const LAS s16x8*)(QKg + (16 * it + ln) * 72 + 8 * h4), a, 0, 0, 0);
            if (it >= 2) a = __builtin_amdgcn_mfma_f32_16x16x32_bf16(*(const LAS s16x8*)(vnT + (16 * vt + ln) * 72 + 32 + 8 * h4), *(const LAS s16x8*)(QKg + (16 * it + ln) * 72 + 32 + 8 * h4), a, 0, 0, 0);
            const int ic = n * 64 + 16 * it + ln, tk = dir ? L - 1 - ic : ic;
            *(u32x2*)(Y + (size_t)(rowbase + tk) * 1024 + colbase + 16 * vt + 4 * h4) = pk4(a);
        }
        {
            const float egl = misc[0];
#pragma unroll
            for (int vt = 0; vt < 4; ++vt) {
                f32x4 a = accS[vt] * egl;
#pragma unroll
                for (int s = 0; s < 2; ++s) a = __builtin_amdgcn_mfma_f32_16x16x32_bf16(*(const LAS s16x8*)(KT + (16 * wave + ln) * 72 + (((4 * s + h4) ^ wave) << 3)), *(const LAS s16x8*)(vnsT + (16 * vt + ln) * 72 + 32 * s + 8 * h4), a, 0, 0, 0);
                accS[vt] = a;
            }
        }
        __syncthreads();
#pragma unroll
        for (int vt = 0; vt < 4; ++vt) *(LAS u32x2*)(ST + (vt * 16 + ln) * 136 + wave * 16 + h4 * 4) = pk4(accS[vt]);
    }
#undef GD_LOAD
    if (!kind) { float* so = p.out + OUT_SGD + (((size_t)b * 2 + dir) * 4 + head) * 16384 + half * 64;
#pragma unroll
        for (int vt = 0; vt < 4; ++vt)
#pragma unroll
            for (int r = 0; r < 4; ++r) so[(size_t)(wave * 16 + h4 * 4 + r) * 128 + vt * 16 + ln] = accS[vt][r]; }
}
__device__ __forceinline__ void rwkv_idx(const P& p, LAS unsigned char* lds, int i) {
    const int kind = i < 128 ? 1 : 0, j = i < 128 ? i : i - 128;
    rwkv_item(p, lds, kind, j >> 4, (j >> 1) & 7, j & 1);
}
__device__ __forceinline__ void gdn_idx(const P& p, LAS unsigned char* lds, int i) {
    const int kind = i < 128 ? 1 : 0, j = i < 128 ? i : i - 128;
    gdn_item(p, lds, kind, j >> 4, (j >> 2) & 3, (j >> 1) & 1, j & 1);
}
__device__ __forceinline__ void ph_scan(const P& p, LAS unsigned char* lds) {
    const int B = blockIdx.x, G = gridDim.x;
    if (G == 256) {
        if (B < 128) { rwkv_idx(p, lds, B); for (int i = 0; i < 4; ++i) gdn_idx(p, lds, 128 + B * 4 + i); }
        else { gdn_idx(p, lds, B - 128); for (int i = 0; i < 4; ++i) rwkv_idx(p, lds, 128 + (B - 128) * 4 + i); }
    } else {
        for (int i = B; i < 640; i += G) { rwkv_idx(p, lds, i); gdn_idx(p, lds, i); }
    }
}

__device__ __forceinline__ void ph_post_ab(const P& p, bool dummy) {
    const int tid = tid_opaque(), lane = tid & 63, wave = tid >> 6;
    const bf16* p0 = (const bf16*)(p.ws + WS_R1); const bf16* lo = (const bf16*)(p.ws + WS_R2);
    bf16* MX = (bf16*)(p.ws + WS_MIX); const bf16* YB = (const bf16*)(p.ws + WS_H);
    bf16* MO = dummy ? (bf16*)(p.out + OUT_CKV) : MX;
    const int C = lane * 8;
    float mur[8], muk[8], muv[8], ka[8], rk[8], lw[8], lb[8], gn[8];
#pragma unroll
    for (int i = 0; i < 8; ++i) { mur[i] = p.in[19][C + i]; muk[i] = p.in[19][512 + C + i]; muv[i] = p.in[19][1024 + C + i]; ka[i] = p.in[26][C + i]; rk[i] = p.in[27][C + i];
        lw[i] = p.in[28][C + i]; lb[i] = p.in[29][C + i]; gn[i] = p.in[33][(C + i) & 127]; }
    for (int row = blockIdx.x * 8 + wave; row < M_TOK; row += gridDim.x * 8) {
        const int t = row < MP ? (row & 255) : ((row - MP) & 1023), L = row < MP ? 256 : 1024;
        const bool hp = t > 0, hn = t < L - 1;
        const u32x4 z4 = {0u, 0u, 0u, 0u};
        const bf16* pr = p0 + (size_t)row * LDP0 + C;
        float r[8], k[8], v[8];
        {
            const u32x4 c = *(const u32x4*)pr, a = hp ? *(const u32x4*)(pr - LDP0) : z4, n = hn ? *(const u32x4*)(pr + LDP0) : z4;
#pragma unroll
            for (int i = 0; i < 4; ++i) { float c0 = bflo(c[i]), c1 = bfhi(c[i]); r[2 * i] = c0 + mur[2 * i] * (0.5f * (bflo(a[i]) + bflo(n[i])) - c0); r[2 * i + 1] = c1 + mur[2 * i + 1] * (0.5f * (bfhi(a[i]) + bfhi(n[i])) - c1); }
        }
        {
            const u32x4 c = *(const u32x4*)(pr + 512), a = hp ? *(const u32x4*)(pr + 512 - LDP0) : z4, n = hn ? *(const u32x4*)(pr + 512 + LDP0) : z4;
#pragma unroll
            for (int i = 0; i < 4; ++i) { float c0 = bflo(c[i]), c1 = bfhi(c[i]); k[2 * i] = c0 + muk[2 * i] * (0.5f * (bflo(a[i]) + bflo(n[i])) - c0); k[2 * i + 1] = c1 + muk[2 * i + 1] * (0.5f * (bfhi(a[i]) + bfhi(n[i])) - c1); }
        }
        {
            const u32x4 c = *(const u32x4*)(pr + 1024), a = hp ? *(const u32x4*)(pr + 1024 - LDP0) : z4, n = hn ? *(const u32x4*)(pr + 1024 + LDP0) : z4;
#pragma unroll
            for (int i = 0; i < 4; ++i) { float c0 = bflo(c[i]), c1 = bfhi(c[i]); v[2 * i] = c0 + muv[2 * i] * (0.5f * (bflo(a[i]) + bflo(n[i])) - c0); v[2 * i + 1] = c1 + muv[2 * i + 1] * (0.5f * (bfhi(a[i]) + bfhi(n[i])) - c1); }
        }
        const u32x4 af = *(const u32x4*)(lo + (size_t)row * 2560 + 1024 + C), ab = *(const u32x4*)(lo + (size_t)row * 2560 + 1536 + C), gg = *(const u32x4*)(lo + (size_t)row * 2560 + 2048 + C);
        const u32x4 yf = *(const u32x4*)(MX + (size_t)row * 1024 + C), yb = *(const u32x4*)(YB + (size_t)row * 1024 + C);
        float y[8], s = 0.f, bon = 0.f;
#pragma unroll
        for (int i = 0; i < 4; ++i) {
            y[2 * i] = bflo(yf[i]) + bflo(yb[i]); y[2 * i + 1] = bfhi(yf[i]) + bfhi(yb[i]); s += y[2 * i] + y[2 * i + 1];
            const float am0 = 0.5f * (bflo(af[i]) + bflo(ab[i])), am1 = 0.5f * (bfhi(af[i]) + bfhi(ab[i]));
            bon += r[2 * i] * k[2 * i] * (1.0f + (am0 - 1.0f) * ka[2 * i]) * rk[2 * i] + r[2 * i + 1] * k[2 * i + 1] * (1.0f + (am1 - 1.0f) * ka[2 * i + 1]) * rk[2 * i + 1];
        }
        const float mean = red8(s) * (1.0f / 64.0f); bon = red8(bon);
        float q2 = 0.f;
#pragma unroll
        for (int i = 0; i < 8; ++i) { y[i] -= mean; q2 += y[i] * y[i]; }
        const float rstd = 1.0f / sqrtf(red8(q2) * (1.0f / 64.0f) + 64e-5f);
        u32x4 o;
#pragma unroll
        for (int i = 0; i < 4; ++i) {
            const float o0 = (y[2 * i] * rstd * lw[2 * i] + lb[2 * i] + bon * v[2 * i]) * bflo(gg[i]);
            const float o1 = (y[2 * i + 1] * rstd * lw[2 * i + 1] + lb[2 * i + 1] + bon * v[2 * i + 1]) * bfhi(gg[i]);
            o[i] = pk2(o0, o1);
        }
        const size_t orow = dummy ? (size_t)(row & 4095) : (size_t)row;
        *(u32x4*)(MO + orow * 1024 + C) = o;
        const u32x4 of = *(const u32x4*)(MX + (size_t)row * 1024 + 512 + C), ob = *(const u32x4*)(YB + (size_t)row * 1024 + 512 + C);
        const u32x4 zz = *(const u32x4*)(p0 + (size_t)row * LDP0 + 1920 + 1536 + C);
        float og[8], so = 0.f;
#pragma unroll
        for (int i = 0; i < 4; ++i) { og[2 * i] = bflo(of[i]) + bflo(ob[i]); og[2 * i + 1] = bfhi(of[i]) + bfhi(ob[i]); so += og[2 * i] * og[2 * i] + og[2 * i + 1] * og[2 * i + 1]; }
        const float rs = 1.0f / sqrtf(red16(so) * (1.0f / 128.0f) + 1e-6f);
        u32x4 o2;
#pragma unroll
        for (int i = 0; i < 4; ++i) { const float z0 = bflo(zz[i]), z1 = bfhi(zz[i]);
            o2[i] = pk2(og[2 * i] * rs * gn[2 * i] * siluf_(z0), og[2 * i + 1] * rs * gn[2 * i + 1] * siluf_(z1)); }
        *(u32x4*)(MO + orow * 1024 + 512 + C) = o2;
    }
}

__device__ __forceinline__ void ph_hyena_filters(const P& p, LAS unsigned char* lds) {
    LAS float* f0 = (LAS float*)lds;
    LAS float* h1 = f0 + 32 * 36;
    LAS float* h2 = h1 + 32 * 64;
    LAS bf16* stg = (LAS bf16*)(h2 + 64 * 32);
    LAS float* w1s = h2 + 64 * 32 + 8192;
    LAS float* w2s = w1s + 33 * 64;
    const int tid = tid_opaque();
    const float* b1 = p.in[41]; const float* b2 = p.in[43]; const float* w3 = p.in[44]; const float* fr = p.in[45];
    __syncthreads();
    if (blockIdx.x < 160) {
        for (int e = tid; e < 33 * 64; e += NTHREADS) w1s[e] = p.in[40][e];
        for (int e = tid; e < 64 * 64; e += NTHREADS) w2s[e] = p.in[42][e];
    }
    for (int item4 = blockIdx.x; item4 < 160; item4 += gridDim.x) {
        const int item = item4 >> 2, oo = item4 & 3;
        const int ls = item < 32 ? 1 : 0;
        const int L = ls ? 1024 : 256, t0 = (ls ? item : item - 32) * 32;
        const int o = tid + oo * 512;
        float wreg[16];
#pragma unroll
        for (int f = 0; f < 16; ++f) wreg[f] = w3[f * 2048 + o];
        __syncthreads();
        for (int e = tid; e < 32 * 33; e += NTHREADS) {
            const int pi = e / 33, f = e % 33; const float t = (float)(t0 + pi);
            float v;
            if (f == 0) v = t / (float)(L - 1);
            else { const int bi = (f - 1) & 15; const float band = 1e-4f + (15.0f - 1e-4f) * ((float)bi / 15.0f); const float ang = (6.283185307179586f / (float)L) * t * band; v = f <= 16 ? __cosf(ang) : -__sinf(ang); }
            f0[pi * 36 + f] = v;
        }
        __syncthreads();
        {
            const int j = tid & 63, pq = tid >> 6; const float bj = b1[j], fj = fr[j];
            float sacc[4] = {bj, bj, bj, bj};
#pragma unroll 3
            for (int f = 0; f < 33; ++f) { const float w = w1s[f * 64 + j];
#pragma unroll
                for (int i = 0; i < 4; ++i) sacc[i] += f0[(pq + 8 * i) * 36 + f] * w; }
#pragma unroll
            for (int i = 0; i < 4; ++i) h1[(pq + 8 * i) * 64 + j] = __sinf(fj * sacc[i]);
        }
        __syncthreads();
        {
            const int j = tid & 63, pq = tid >> 6; const float bj = b2[j], fj = fr[64 + j];
            float sacc[4] = {bj, bj, bj, bj};
#pragma unroll 4
            for (int f = 0; f < 64; ++f) { const float w = w2s[f * 64 + j];
#pragma unroll
                for (int i = 0; i < 4; ++i) sacc[i] += h1[(pq + 8 * i) * 64 + f] * w; }
#pragma unroll
            for (int i = 0; i < 4; ++i) h2[j * 32 + pq + 8 * i] = __sinf(fj * sacc[i]);
        }
        __syncthreads();
        bf16* G = (bf16*)(p.ws + (ls ? WS_GFS : WS_GFP));
        {
            const int c = o & 511;
            f32x4 sv[8];
#pragma unroll
            for (int i = 0; i < 8; ++i) sv[i] = (f32x4){0.f, 0.f, 0.f, 0.f};
#pragma unroll
            for (int fq = 0; fq < 4; ++fq) {
                float wn[16];
                if (fq < 3) {
#pragma unroll
                    for (int f = 0; f < 16; ++f) wn[f] = w3[((fq + 1) * 16 + f) * 2048 + o];
                }
#pragma unroll
                for (int f = 0; f < 16; ++f) { const float w = wreg[f]; const LAS f32x4* hp = (const LAS f32x4*)(h2 + (fq * 16 + f) * 32);
#pragma unroll
                    for (int i = 0; i < 8; ++i) sv[i] += hp[i] * w; }
                if (fq < 3) {
#pragma unroll
                    for (int f = 0; f < 16; ++f) wreg[f] = wn[f];
                }
            }
            const float delta = 3.0701134573253944f + (15.350567286626973f - 3.0701134573253944f) * ((float)c / 511.0f);
            const float inv = 1.0f / (float)(L - 1);
#pragma unroll
            for (int i = 0; i < 8; ++i) {
                const float ta = (float)(t0 + 4 * i) * inv, tb = (float)(t0 + 4 * i + 1) * inv, tc = (float)(t0 + 4 * i + 2) * inv, td = (float)(t0 + 4 * i + 3) * inv;
                *(LAS u32x2*)(stg + tid * 32 + 4 * i) = (u32x2){pk2(sv[i].x * __expf(-ta * delta), sv[i].y * __expf(-tb * delta)), pk2(sv[i].z * __expf(-tc * delta), sv[i].w * __expf(-td * delta))};
            }
            __syncthreads();
            const int lane = tid & 63, wv = tid >> 6, pi = lane & 31;
#pragma unroll 4
            for (int r = 0; r < 32; ++r) {
                const int col = wv * 64 + r * 2 + (lane >> 5);
                const int o2 = col + oo * 512, order2 = o2 >> 10, dr2 = (o2 >> 9) & 1, c2 = o2 & 511, t = t0 + pi;
                const bf16 hv = stg[col * 32 + pi];
                bf16* g = G + ((size_t)order2 * 512 + c2) * (2 * L);
                if (dr2 == 0) g[L - t] = hv;
                else if (t > 0) g[L + t] = hv;
                if (dr2 == 0 && t == 0) g[0] = 0;
            }
        }
    }
}

__device__ __forceinline__ void ph_mla_prep(const P& p, LAS unsigned char* lds) {
    const int tid = tid_opaque(), lane = tid & 63, wave = tid >> 6;
    const bf16* p1 = (const bf16*)(p.ws + WS_R1);
    bf16* qn = (bf16*)(p.ws + WS_H); bf16* ckva = (bf16*)(p.ws + WS_CKVA); bf16* kpea = (bf16*)(p.ws + WS_KPEA);
    const float* rope = (const float*)(p.ws + WS_ROPE);
    const float* qg = p.in[35]; const float* kg = p.in[37];
    const int nw = gridDim.x * 8;
    for (int row0 = blockIdx.x * 8 + wave; row0 < M_TOK; row0 += 4 * nw) {
        unsigned qw[4][3], kw[4]; u32x2 vw[4]; float sq[4], sk[4];
#pragma unroll
        for (int r = 0; r < 4; ++r) {
            const int row = (row0 + r * nw) < M_TOK ? (row0 + r * nw) : (M_TOK - 1);
            const bf16* pr = p1 + (size_t)row * LDP1;
#pragma unroll
            for (int j = 0; j < 3; ++j) qw[r][j] = *(const unsigned*)(pr + j * 128 + lane * 2);
            vw[r] = *(const u32x2*)(pr + 384 + lane * 4);
            kw[r] = lane < 16 ? *(const unsigned*)(pr + 640 + lane * 2) : 0u;
        }
#pragma unroll
        for (int r = 0; r < 4; ++r) {
            float s = 0.f;
#pragma unroll
            for (int j = 0; j < 3; ++j) s += bflo(qw[r][j]) * bflo(qw[r][j]) + bfhi(qw[r][j]) * bfhi(qw[r][j]);
            sq[r] = s;
            const f32x4 kv = unpk4(vw[r]); sk[r] = kv.x * kv.x + kv.y * kv.y + kv.z * kv.z + kv.w * kv.w;
        }
#pragma unroll
        for (int o = 1; o < 64; o <<= 1) {
#pragma unroll
            for (int r = 0; r < 4; ++r) { sq[r] += __shfl_xor(sq[r], o); sk[r] += __shfl_xor(sk[r], o); } }
#pragma unroll
        for (int r = 0; r < 4; ++r) {
            const int row = row0 + r * nw; if (row >= M_TOK) break;
            const float rq = rsqrtf_(sq[r] * (1.0f / 384.0f) + 1e-6f), rk = rsqrtf_(sk[r] * (1.0f / 256.0f) + 1e-6f);
#pragma unroll
            for (int j = 0; j < 3; ++j) { const int col = j * 128 + lane * 2; *(unsigned*)(qn + (size_t)row * 384 + col) = pk2(bflo(qw[r][j]) * rq * qg[col], bfhi(qw[r][j]) * rq * qg[col + 1]); }
            const f32x4 ck = unpk4(vw[r]) * rk * *(const f32x4*)(kg + lane * 4);
            *(u32x2*)(ckva + (size_t)row * 256 + lane * 4) = pk4(ck);
            if (row < MP) *(f32x4*)(p.out + OUT_CKV + (size_t)row * 256 + lane * 4) = ck;
            if (lane < 16) {
                float x1 = bflo(kw[r]), x2 = bfhi(kw[r]);
                if (row < MP) { *(f32x2*)(p.out + OUT_KPE + (size_t)row * 32 + lane * 2) = (f32x2){x1, x2}; }
                else { const int tq = (row - MP) & 1023; const f32x2 cs = *(const f32x2*)(rope + (size_t)tq * 32 + lane * 2); const float a = x1 * cs.x - x2 * cs.y, bq = x1 * cs.y + x2 * cs.x; x1 = a; x2 = bq; }
                *(unsigned*)(kpea + (size_t)row * 32 + lane * 2) = pk2(x1, x2);
            }
        }
    }
    for (int r2 = blockIdx.x * 8 + wave; r2 < 2048; r2 += nw) {
        const int row = M_TOK + r2;
        const f32x4 cv = *(const f32x4*)(p.in[4] + (size_t)r2 * 256 + lane * 4);
        *(u32x2*)(ckva + (size_t)row * 256 + lane * 4) = pk4(cv);
        if (lane < 16) { const f32x2 kp = *(const f32x2*)(p.in[5] + (size_t)r2 * 32 + lane * 2); *(unsigned*)(kpea + (size_t)row * 32 + lane * 2) = pk2(kp.x, kp.y); }
    }
    LAS float* tile = (LAS float*)(lds + wave * 8832);
    bf16* HT = (bf16*)(p.ws + WS_HYIN);
    const float* cw = p.in[39];
    for (int it = blockIdx.x * 8 + wave; it < 256 * 48; it += gridDim.x * 8) {
        const int rt = it / 48, cb = it % 48;
        const int r0 = rt * 64, col0 = 672 + cb * 32;
        const int t0 = r0 < MP ? (r0 & 255) : ((r0 - MP) & 1023), L = r0 < MP ? 256 : 1024;
        unsigned wv[17];
#pragma unroll
        for (int i = 0; i < 17; ++i) {
            const int rr = i * 4 + (lane >> 4), tt = t0 - 1 + rr;
            wv[i] = (rr < 66 && tt >= 0 && tt < L) ? *(const unsigned*)(p1 + (size_t)(r0 - 1 + rr) * LDP1 + col0 + (lane & 15) * 2) : 0u;
        }
#pragma unroll
        for (int i = 0; i < 17; ++i) {
            const int rr = i * 4 + (lane >> 4);
            if (rr < 66) { tile[rr * 33 + (lane & 15) * 2] = bflo(wv[i]); tile[rr * 33 + (lane & 15) * 2 + 1] = bfhi(wv[i]); }
        }
        LDS_WAIT();
#pragma unroll 8
        for (int c = 0; c < 32; ++c) {
            const int ch = cb * 32 + c;
            const float v = cw[ch] * tile[lane * 33 + c] + cw[1536 + ch] * tile[(lane + 1) * 33 + c] + cw[3072 + ch] * tile[(lane + 2) * 33 + c];
            HT[(size_t)ch * M_TOK + r0 + lane] = (bf16)(pk2(v, 0.f) & 0xffffu);
        }
        LDS_WAIT();
    }
}

__device__ __forceinline__ void attn_item(const P& p, LAS unsigned char* lds, int kind, int b, int head, int qt) {
    constexpr int TILE_B = 64 * 104 * 2 + 64 * 72 * 2;
    const int tid = tid_opaque(), lane = tid & 63, wave = tid >> 6, ln = lane & 15, h = lane >> 4;
    const bf16* Q = (const bf16*)(p.ws + WS_Q); const bf16* KN = (const bf16*)(p.ws + WS_KV); const bf16* VT = (const bf16*)(p.ws + WS_VT); const bf16* KPE = (const bf16*)(p.ws + WS_KPEA);
    bf16* MX = (bf16*)(p.ws + WS_MIX);
    const int nkeys = kind ? 1280 : 256, rowbase = kind ? MP + b * 1024 : b * 256, ntiles = nkeys / 64;
    const int qrow = rowbase + qt * 128 + wave * 16 + ln;
    s16x8 qf[3];
#pragma unroll
    for (int s = 0; s < 3; ++s) qf[s] = *(const s16x8*)(Q + (size_t)qrow * 768 + head * 96 + 32 * s + 8 * h);
    f32x4 o[4];
#pragma unroll
    for (int i = 0; i < 4; ++i) o[i] = (f32x4){0.f, 0.f, 0.f, 0.f};
    float mrun = -1e30f, lrun = 0.f;
    const int k0key = tid / 12, k0ch = tid % 12, k1key = (tid + 512) / 12, k1ch = (tid + 512) % 12, vv = tid >> 3, vkc = tid & 7;
    u32x4 Ak0, Ak1 = {0u, 0u, 0u, 0u}, Av, Bk0, Bk1 = {0u, 0u, 0u, 0u}, Bv;
#define ATT_LOAD(X, it) do { const int j0_ = (it) * 64; \
        const int kb_ = kind ? (j0_ < 1024 ? MP + b * 1024 + j0_ : M_TOK + b * 256 + (j0_ - 1024)) : b * 256 + j0_; \
        X##k0 = *(const u32x4*)(k0ch < 8 ? KN + (size_t)(kb_ + k0key) * 512 + head * 64 + k0ch * 8 : KPE + (size_t)(kb_ + k0key) * 32 + (k0ch - 8) * 8); \
        if (tid < 256) X##k1 = *(const u32x4*)(k1ch < 8 ? KN + (size_t)(kb_ + k1key) * 512 + head * 64 + k1ch * 8 : KPE + (size_t)(kb_ + k1key) * 32 + (k1ch - 8) * 8); \
        X##v = *(const u32x4*)(VT + (size_t)(head * 64 + vv) * (M_TOK + 2048) + kb_ + vkc * 8); } while (0)
#define ATT_STORE(X, Kt_, Vt_) do { *(LAS u32x4*)(Kt_ + k0key * 104 + k0ch * 8) = X##k0; \
        if (tid < 256) *(LAS u32x4*)(Kt_ + k1key * 104 + k1ch * 8) = X##k1; \
        *(LAS u32x4*)(Vt_ + vv * 72 + vkc * 8) = X##v; } while (0)
    __syncthreads();
    ATT_LOAD(A, 0);
    if (ntiles > 1) ATT_LOAD(B, 1);
#pragma unroll 1
    for (int it = 0; it < ntiles; ++it) {
        LAS bf16* Kt = (LAS bf16*)(lds + (it & 1) * TILE_B);
        LAS bf16* Vt = Kt + 64 * 104;
        if (it & 1) ATT_STORE(B, Kt, Vt); else ATT_STORE(A, Kt, Vt);
        __syncthreads();
        if (it + 2 < ntiles) { if (it & 1) ATT_LOAD(B, it + 2); else ATT_LOAD(A, it + 2); }
        f32x4 sc[4]; float mx = -1e30f;
#pragma unroll
        for (int kt = 0; kt < 4; ++kt) {
            f32x4 a = {0.f, 0.f, 0.f, 0.f};
#pragma unroll
            for (int s = 0; s < 3; ++s) { const s16x8 kf = *(const LAS s16x8*)(Kt + (kt * 16 + ln) * 104 + 32 * s + 8 * h); a = __builtin_amdgcn_mfma_f32_16x16x32_bf16(kf, qf[s], a, 0, 0, 0); }
            sc[kt] = a; mx = fmaxf(mx, fmaxf(fmaxf(a[0], a[1]), fmaxf(a[2], a[3])));
        }
        mx = fmaxf(mx, __shfl_xor(mx, 16)); mx = fmaxf(mx, __shfl_xor(mx, 32));
        const float mnew = fmaxf(mrun, mx), alpha = __expf(mrun - mnew);
        mrun = mnew;
        float ps = 0.f;
#pragma unroll
        for (int kt = 0; kt < 4; ++kt)
#pragma unroll
            for (int r = 0; r < 4; ++r) { sc[kt][r] = __expf(sc[kt][r] - mnew); ps += sc[kt][r]; }
        lrun = lrun * alpha + ps;
#pragma unroll
        for (int i = 0; i < 4; ++i) o[i] = o[i] * alpha;
#pragma unroll
        for (int s = 0; s < 2; ++s) {
            u32x4 pw; pw.x = pk2(sc[2 * s][0], sc[2 * s][1]); pw.y = pk2(sc[2 * s][2], sc[2 * s][3]); pw.z = pk2(sc[2 * s + 1][0], sc[2 * s + 1][1]); pw.w = pk2(sc[2 * s + 1][2], sc[2 * s + 1][3]);
            const s16x8 pf = __builtin_bit_cast(s16x8, pw);
#pragma unroll
            for (int vt = 0; vt < 4; ++vt) {
                const LAS bf16* vp = Vt + (vt * 16 + ln) * 72 + 32 * s + 4 * h;
                const u32x2 lo2 = *(const LAS u32x2*)vp, hi2 = *(const LAS u32x2*)(vp + 16);
                const u32x4 vw = {lo2.x, lo2.y, hi2.x, hi2.y};
                o[vt] = __builtin_amdgcn_mfma_f32_16x16x32_bf16(__builtin_bit_cast(s16x8, vw), pf, o[vt], 0, 0, 0);
            }
        }
    }
#undef ATT_LOAD
#undef ATT_STORE
    lrun += __shfl_xor(lrun, 16); lrun += __shfl_xor(lrun, 32);
    const float inv = 1.0f / lrun;
#pragma unroll
    for (int vt = 0; vt < 4; ++vt) *(u32x2*)(MX + (size_t)qrow * 1024 + head * 64 + vt * 16 + 4 * h) = pk4(o[vt] * inv);
}

__device__ __forceinline__ void hyena_item(const P& p, LAS unsigned char* lds, int kind, int cgp) {
    const int tid = tid_opaque(), lane = tid & 63, wave = tid >> 6, ci = wave >> 2, qtr = wave & 3;
    const int L = kind ? 1024 : 256, NB = kind ? 8 : 32, base = kind ? MP : 0, c = cgp * 2 + ci;
    const int DMAX = kind ? 31 : 7;
    constexpr int ZCH = 8704;
    LAS bf16* zb = (LAS bf16*)lds;
    LAS bf16* gb = zb + 2 * ZCH;
    const bf16* HT = (const bf16*)(p.ws + WS_HYIN);
    const bf16* G = (const bf16*)(p.ws + (kind ? WS_GFS : WS_GFP));
    bf16* HO = (bf16*)(p.ws + WS_H);
    __syncthreads();
    const int Lp = L + 8;
    for (int i = tid; i < 2 * 1024; i += NTHREADS) { const int cc = i >> 10, off = (i & 1023) * 8;
        *(LAS u32x4*)(zb + cc * ZCH + (off / L) * Lp + (off % L)) = *(const u32x4*)(HT + (size_t)(cgp * 2 + cc) * M_TOK + base + off); }
    for (int i = tid; i < 4 * (2 * L / 8); i += NTHREADS) { const int co = i / (2 * L / 8), off = (i % (2 * L / 8)) * 8, cc = co >> 1, od = co & 1;
        *(LAS u32x4*)(gb + (cc * 2 + od) * 2 * L + off) = *(const u32x4*)(G + ((size_t)od * 512 + cgp * 2 + cc) * (2 * L) + off); }
    __syncthreads();
    const int n = lane & 31, h = lane >> 5;
    const int jl = kind ? (n & 3) : 0, bb = kind ? (n >> 2) : n;
    const LAS bf16* zc = zb + ci * ZCH + bb * Lp;
#pragma unroll 1
    for (int order = 0; order < 2; ++order) {
        const LAS bf16* gr = gb + (ci * 2 + order) * 2 * L;
        f32x16 acc[2];
#pragma unroll
        for (int g = 0; g < 2; ++g)
#pragma unroll
            for (int r = 0; r < 16; ++r) acc[g][r] = 0.f;
        const int Ilo_w = kind ? 8 * qtr : 2 * qtr, Ihi_w = kind ? 8 * qtr + 7 : 2 * qtr + 1;
        int Dlo = Ilo_w - (L / 32 - 1), Dhi = Ihi_w; if (Dlo < -DMAX) Dlo = -DMAX; if (Dhi > DMAX) Dhi = DMAX;
#pragma unroll 1
        for (int D = Dlo; D <= Dhi; ++D) {
#pragma unroll
            for (int ks = 0; ks < 2; ++ks) {
                const int idx = L - 32 * D + 16 * ks + 8 * h - n;
                u32x4 aw;
                aw.x = (unsigned)gr[idx] | ((unsigned)gr[idx + 1] << 16); aw.y = (unsigned)gr[idx + 2] | ((unsigned)gr[idx + 3] << 16);
                aw.z = (unsigned)gr[idx + 4] | ((unsigned)gr[idx + 5] << 16); aw.w = (unsigned)gr[idx + 6] | ((unsigned)gr[idx + 7] << 16);
                const s16x8 af = __builtin_bit_cast(s16x8, aw);
#pragma unroll
                for (int g = 0; g < 2; ++g) {
                    const int og = qtr * 2 + g;
                    const int Ilo = kind ? 4 * og : og, Ihi = kind ? 4 * og + 3 : og;
                    if (Ihi - D >= 0 && Ilo - D <= (L / 32 - 1)) {
                        const int J = (kind ? 4 * og + jl : og) - D;
                        u32x4 bw = {0u, 0u, 0u, 0u};
                        if (J >= 0 && J < L / 32) bw = *(const LAS u32x4*)(zc + 32 * J + 16 * ks + 8 * h);
                        acc[g] = __builtin_amdgcn_mfma_f32_32x32x16_bf16(af, __builtin_bit_cast(s16x8, bw), acc[g], 0, 0, 0);
                    }
                }
            }
        }
        const float bias = p.in[46][order * 512 + c];
        const bf16* gate = HT + (size_t)((order + 1) * 512 + c) * M_TOK + base + bb * L;
        u32x2 zn[2][4];
#pragma unroll
        for (int g = 0; g < 2; ++g) {
            const int og = qtr * 2 + g, I = kind ? 4 * og + jl : og;
#pragma unroll
            for (int rq = 0; rq < 4; ++rq) {
                const int t = 32 * I + 8 * rq + 4 * h;
                const f32x4 zo = unpk4(*(const LAS u32x2*)(zc + t)), gt = unpk4(*(const u32x2*)(gate + t));
                f32x4 y; y.x = acc[g][4 * rq]; y.y = acc[g][4 * rq + 1]; y.z = acc[g][4 * rq + 2]; y.w = acc[g][4 * rq + 3];
                zn[g][rq] = pk4(gt * (y + zo * bias));
            }
        }
        if (order == 0) {
            __syncthreads();
#pragma unroll
            for (int g = 0; g < 2; ++g) { const int og = qtr * 2 + g, I = kind ? 4 * og + jl : og;
#pragma unroll
                for (int rq = 0; rq < 4; ++rq) *(LAS u32x2*)(zb + ci * ZCH + bb * Lp + 32 * I + 8 * rq + 4 * h) = zn[g][rq]; }
            __syncthreads();
        } else {
#pragma unroll
            for (int g = 0; g < 2; ++g) { const int og = qtr * 2 + g, I = kind ? 4 * og + jl : og;
#pragma unroll
                for (int rq = 0; rq < 4; ++rq) { const int t = 32 * I + 8 * rq + 4 * h; *(u32x2*)(HO + (size_t)c * M_TOK + base + bb * L + t) = zn[g][rq]; } }
        }
    }
}
#ifndef DUP_SUB
#define DUP_SUB 3
#endif
__device__ __forceinline__ void ph_attn_hyena(const P& p, LAS unsigned char* lds, bool dummy) {
    const int B = blockIdx.x, G = gridDim.x;
#ifndef T_NO_ATTN
    if (!dummy || (DUP_SUB & 1))
    for (int i = B; i < 1024; i += G) { if (i < 512) attn_item(p, lds, 1, i >> 6, (i >> 3) & 7, i & 7); else { const int j = i - 512; attn_item(p, lds, 0, j >> 4, (j >> 1) & 7, j & 1); } }
#endif
#ifndef T_NO_HY
    if (!dummy || (DUP_SUB & 2))
    for (int i = B; i < 512; i += G) { hyena_item(p, lds, i < 256 ? 1 : 0, i & 255); }
#endif
}

__device__ __forceinline__ void ph_hy_transpose(const P& p, LAS unsigned char* lds) {
    const int tid = tid_opaque(), lane = tid & 63, wave = tid >> 6;
    LAS bf16* tile = (LAS bf16*)(lds + wave * 9216);
    const bf16* HO = (const bf16*)(p.ws + WS_H); bf16* MX = (bf16*)(p.ws + WS_MIX);
    for (int it = blockIdx.x * 8 + wave; it < 2048; it += gridDim.x * 8) {
        const int rt = it >> 3, cb = it & 7, r0 = rt * 64, c0 = cb * 64;
#pragma unroll
        for (int i = 0; i < 8; ++i) { const int id = i * 64 + lane, c = id >> 3, rc = id & 7;
            *(LAS u32x4*)(tile + c * 72 + rc * 8) = *(const u32x4*)(HO + (size_t)(c0 + c) * M_TOK + r0 + rc * 8); }
        LDS_WAIT();
        bf16* dst = MX + (size_t)(r0 + lane) * 1024 + 512 + c0;
#pragma unroll
        for (int j = 0; j < 8; ++j) {
            u32x4 w;
#pragma unroll
            for (int i = 0; i < 4; ++i) { const unsigned a = tile[(j * 8 + 2 * i) * 72 + lane], bq = tile[(j * 8 + 2 * i + 1) * 72 + lane]; w[i] = a | (bq << 16); }
            *(u32x4*)(dst + j * 8) = w;
        }
        LDS_WAIT();
    }
}

#define XB_TMO      128
#define XB_XCNT(j)  (256  + 64 * (j))
#define XB_XSUB(j)  (1280 + 64 * (j))
#define XB_XGEN(j)  (2304 + 64 * (j))
#define XB_TOP      3328
#define XB_TOPGEN   3392
#define XCD_BAR_WORDS 3456
#define XB_SPIN_CAP (1u << 18)

__device__ __forceinline__ unsigned xb_ld(unsigned* p)              { return __hip_atomic_load(p, __ATOMIC_RELAXED, __HIP_MEMORY_SCOPE_AGENT); }
__device__ __forceinline__ unsigned xb_add(unsigned* p, unsigned v) { return __hip_atomic_fetch_add(p, v, __ATOMIC_RELAXED, __HIP_MEMORY_SCOPE_AGENT); }
__device__ __forceinline__ unsigned xb_xcc_id() { return (unsigned)__builtin_amdgcn_s_getreg((3 << 11) | 20) & 0xFu; }
#define XB_SPIN(cond, bar) do { unsigned _sp = 0; while (cond) { __builtin_amdgcn_s_sleep(1); \
    if ((++_sp & 255u) == 0u) { if (xb_ld(&(bar)[XB_TMO])) break; if (_sp > XB_SPIN_CAP) { atomicAdd(&(bar)[XB_TMO], 1u); break; } } } } while (0)

struct XcdBarrier {
    unsigned* bar; unsigned x;
    volatile LAS unsigned* st;
};

__device__ __forceinline__ XcdBarrier xcd_barrier_post(unsigned* bar, volatile LAS unsigned* st) {
    XcdBarrier b; b.bar = bar; b.x = xb_xcc_id(); b.st = st;
    if (threadIdx.x == 0) (void)xb_add(&bar[XB_XCNT(b.x)], 1u);
    return b;
}
__device__ __forceinline__ void xcd_barrier_complete(unsigned* bar, unsigned x, unsigned& nloc, unsigned& nx) {
    const unsigned G = gridDim.x * gridDim.y * gridDim.z;
    unsigned sum, cnt, mine, sp = 0u;
    for (;;) {
        sum = 0u; cnt = 0u; mine = 0u;
#pragma unroll
        for (unsigned j = 0; j < 16; ++j) { const unsigned c = xb_ld(&bar[XB_XCNT(j)]); sum += c; cnt += (c > 0u) ? 1u : 0u; mine = (j == x) ? c : mine; }
        if (sum == G) break;
        __builtin_amdgcn_s_sleep(1);
        if ((++sp & 255u) == 0u) { if (xb_ld(&bar[XB_TMO])) break; if (sp > XB_SPIN_CAP) { atomicAdd(&bar[XB_TMO], 1u); break; } }
    }
    nloc = mine > 0u ? mine : 1u; nx = cnt > 0u ? cnt : 1u;
}

__device__ __forceinline__ void xcd_barrier(const XcdBarrier& b) {
    asm volatile("s_waitcnt vmcnt(0)" ::: "memory");
    __syncthreads();
    if (threadIdx.x == 0) {
        unsigned* bar = b.bar;
        __builtin_amdgcn_s_waitcnt(0);
        unsigned nloc = b.st[0], nx = b.st[1];
        if (nloc == 0u) { xcd_barrier_complete(bar, b.x, nloc, nx); b.st[0] = nloc; b.st[1] = nx; }
        const unsigned old = xb_add(&bar[XB_XSUB(b.x)], 1u);
        const unsigned gen = old / nloc;
        if (old + 1u == (gen + 1u) * nloc) {
            __builtin_amdgcn_fence(__ATOMIC_RELEASE, "agent");
            asm volatile("s_waitcnt vmcnt(0)" ::: "memory");
            const unsigned og = xb_add(&bar[XB_TOP], 1u);
            const unsigned tg = og / nx;
            if (og + 1u == (tg + 1u) * nx) xb_add(&bar[XB_TOPGEN], 1u);
            else XB_SPIN(xb_ld(&bar[XB_TOPGEN]) == tg, bar);
            __builtin_amdgcn_fence(__ATOMIC_ACQUIRE, "agent");
            xb_add(&bar[XB_XGEN(b.x)], 1u);
            asm volatile("s_waitcnt vmcnt(0)" ::: "memory");
        } else {
            XB_SPIN(xb_ld(&bar[XB_XGEN(b.x)]) == gen, bar);
            __builtin_amdgcn_fence(__ATOMIC_ACQUIRE, "agent");
            asm volatile("s_waitcnt vmcnt(0)" ::: "memory");
        }
    }
    __syncthreads();
}


template <class Epi>
__device__ __forceinline__ void run_gemm(LAS unsigned char* lds, const bf16* A, const bf16* Bt, int M, int N, int K, const Epi& E, int rot = 0) {
    asm volatile("" : "+s"(K));
    pg8::Gemm g{A, Bt, M, N, K}; pg8::StaticOrder S; S.init(M, N, (int)gridDim.x, (int)((blockIdx.x + gridDim.x - rot) % gridDim.x));
    pg8::gemm_phase<Epi, pg8::StaticOrder, true, true>(lds, g, S, E);
}

__device__ __forceinline__ void run_phase(const P& p, LAS unsigned char* lds, int k, bool dummy) {
    if (k == 0) {
        { float* cvz0 = (float*)(p.ws + WS_CV); for (int i = blockIdx.x * NTHREADS + tid_opaque(); i < 2 * CV_STRIDE; i += gridDim.x * NTHREADS) cvz0[i] = 0.f; }
        adaln_layer(p, lds, 0, 0); adaln_layer(p, lds, 1, (int)gridDim.x / 2); ph_rope_table(p); return; }
    if (k == 27) { final_norm_rows(p); return; }
    const int layer = (k - 1) / 13, sub = (k - 1) % 13;
    float* x = p.out;
    const float* mod = (const float*)(p.ws + WS_MOD);
    bf16* H = (bf16*)(p.ws + WS_H); bf16* R1 = (bf16*)(p.ws + WS_R1);
    float* ssb = (float*)(p.ws + WS_SS); float* cvb = (float*)(p.ws + WS_CV); float* ssp = (float*)(p.ws + WS_R2);
    switch (sub) {
    case 0: case 3: case 10: {
        const int jn = sub == 0 ? 0 : (sub == 3 ? 1 : 2), uu = 3 * layer + jn;
        float* cvo = cvb + (size_t)(uu & 1) * CV_STRIDE; float* cvz = cvb + (size_t)((uu + 1) & 1) * CV_STRIDE;
        const float* shift = mod + (size_t)layer * 9 * 9216 + (3 * jn) * 1024;
        for (int i = blockIdx.x * NTHREADS + tid_opaque(); i < CV_STRIDE; i += gridDim.x * NTHREADS) cvz[i] = 0.f;
        if (uu == 0) first_rows(p, p.in[10], ssb);
        else { const int t = tid_opaque();
            if (t < 64) for (int row = blockIdx.x * 64 + t; row < M_TOK; row += gridDim.x * 64) { float a = 0.f;
#pragma unroll
                for (int q = 0; q < 16; ++q) a += ssp[q * M_TOK + row];
                ssb[row] = rsqrtf_(a * (1.0f / 1024.0f) + 1e-6f); } }
        if (sub != 3) convert_ffn_weights(p, layer, sub == 0 ? 0 : 1, lds, shift, cvo);
        else {
            transpose_w<0>(p.in[17] + (size_t)layer * 1024 * 1024, 1024, 1024, 1024, (bf16*)(p.ws + W_OUT), 1024, lds, nullptr, nullptr, 0, layer == 0 ? 128 : 232);
            if (layer == 0) { transpose_w<0>(p.in[18], 3984, 3984, 1024, (bf16*)(p.ws + W_IN), 4096, lds, shift, cvo, 4096); build_lora_w(p); }
            else { transpose_w<0>(p.in[34], 2208, 2208, 1024, (bf16*)(p.ws + W_IN), 2304, lds, shift, cvo, 2304, 160);
                transpose_w<0>(p.in[36], 768, 768, 384, (bf16*)(p.ws + W_UQ), 768, lds, nullptr, nullptr, 0, 8);
                transpose_w<0>(p.in[38], 1024, 1024, 256, (bf16*)(p.ws + W_UKV), 1024, lds, nullptr, nullptr, 0, 17);
                ph_hyena_filters(p, lds); }
        }
    } break;
    case 1: case 11: { const int uu = 3 * layer + (sub == 1 ? 0 : 2);
        run_gemm(lds, H, (const bf16*)(p.ws + W_GU), M_TOK, 5632, 1024, EpiSwigluN{R1, ssb, cvb + (size_t)(uu & 1) * CV_STRIDE}); } break;
    case 2: case 12: {
        const bool first = layer == 0 && sub == 2;
        const float* xp = first ? p.in[0] : x; const float* xs = first ? p.in[1] : x + (size_t)MP * DM;
        const float* gate = mod + (size_t)layer * 9 * 9216 + (sub == 2 ? 2 : 8) * 1024;
        if (layer == 1 && sub == 12) { const EpiResid E{xp, xs, x, gate, 0.5f}; run_gemm(lds, R1, (const bf16*)(p.ws + W_DOWN), M_TOK, 1024, 2816, E); }
        else {
            const int ln = sub == 12 ? layer + 1 : layer, jn = sub == 2 ? 1 : 0, uu = 3 * ln + jn;
            const EpiResidN E{xp, xs, x, gate, p.in[jn == 0 ? 10 : 11] + ln * 1024, mod + (size_t)ln * 9 * 9216 + (3 * jn + 1) * 1024, H, ssp, 0.5f};
            run_gemm(lds, R1, (const bf16*)(p.ws + W_DOWN), M_TOK, 1024, 2816, E);
        }
    } break;
    case 9: {
        const int uu = 3 * layer + 2;
        const EpiResidN E{x, x + (size_t)MP * DM, x, mod + (size_t)layer * 9 * 9216 + 5 * 1024, p.in[12] + layer * 1024, mod + (size_t)layer * 9 * 9216 + 7 * 1024, H, ssp, 1.0f};
        run_gemm(lds, (const bf16*)(p.ws + WS_MIX), (const bf16*)(p.ws + W_OUT), M_TOK, 1024, 1024, E);
    } break;
    case 4: {
        const int N = layer == 0 ? 4096 : 2304, ld = layer == 0 ? LDP0 : LDP1, uu = 3 * layer + 1;
        run_gemm(lds, H, (const bf16*)(p.ws + W_IN), M_TOK, N, 1024, EpiStoreN{R1, ld, ld, ssb, cvb + (size_t)(uu & 1) * CV_STRIDE, N});
    } break;
    case 5: if (layer == 0) ph_lora_in(p); else ph_mla_prep(p, lds); break;
    case 6:
        if (layer == 0) run_gemm(lds, H, (const bf16*)(p.ws + W_LORA), M_TOK, 2560, 384, EpiLora{(bf16*)(p.ws + WS_R2), p.in[20], p.in[22]});
        else { run_gemm(lds, (const bf16*)(p.ws + WS_CKVA), (const bf16*)(p.ws + W_UKV), M_TOK + 2048, 1024, 256, EpiKV{(bf16*)(p.ws + WS_KV), (bf16*)(p.ws + WS_VT), M_TOK + 2048});
            run_gemm(lds, H, (const bf16*)(p.ws + W_UQ), M_TOK, 768, 384, EpiQ{(bf16*)(p.ws + WS_Q), (const float*)(p.ws + WS_ROPE)}, 32); }
        break;
    case 7: if (layer == 0) ph_scan(p, lds); else ph_attn_hyena(p, lds, dummy); break;
    case 8: if (layer == 0) ph_post_ab(p, dummy); else ph_hy_transpose(p, lds); break;
    default: break;
    }
}

__global__ void __launch_bounds__(NTHREADS, 2) hybrid_fwd(P p) {
    extern __shared__ __attribute__((aligned(16))) unsigned char lds_raw[];
    LAS unsigned char* lds = (LAS unsigned char*)lds_raw;
    cg::grid_group grid = cg::this_grid();
    volatile LAS unsigned* bst = (volatile LAS unsigned*)(lds + LDS_BYTES - 64);
    if (threadIdx.x < 16) bst[threadIdx.x] = 0u;
    __syncthreads();
    XcdBarrier bar = xcd_barrier_post((unsigned*)(p.ws + WS_CTL) + 1024, bst);
#pragma unroll 1
    for (int k = p.ph_lo; k < p.ph_hi; ++k) {
        run_phase(p, lds, k, false);
        if (k + 1 < p.ph_hi) { if (p.ph_hi < 0) grid.sync(); else xcd_barrier(bar); }
    }
}

extern "C" void kernel_launch(void* const* d_in, const int* in_sizes, int n_in, void* d_out, int out_size, void* d_ws, size_t ws_size, hipStream_t stream) {
    static int grid = 0;
    if (grid == 0) {
        if (n_in != 48 || out_size != 25427968 || ws_size < WS_END) {
            fprintf(stderr, "kernel_launch: expected 48 inputs, 25427968 outputs, >= %zu B workspace; got %d, %d, %zu\n", (size_t)WS_END, n_in, out_size, ws_size);
            grid = -1; return;
        }
        int dev = 0, cus = 0, per_cu = 0;
        hipGetDevice(&dev);
        hipDeviceGetAttribute(&cus, hipDeviceAttributeMultiprocessorCount, dev);
        hipFuncSetAttribute((const void*)hybrid_fwd, hipFuncAttributeMaxDynamicSharedMemorySize, LDS_BYTES);
        hipOccupancyMaxActiveBlocksPerMultiprocessor(&per_cu, (const void*)hybrid_fwd, NTHREADS, LDS_BYTES);
        if (per_cu < 1) { fprintf(stderr, "kernel_launch: occupancy query says %d blocks/CU\n", per_cu); per_cu = 1; }
        (void)hipGetLastError();
        grid = cus;
    }
    if (grid < 0) return;
    (void)hipMemsetAsync((char*)d_ws + WS_CTL, 0, 24 * 1024, stream);
    P prm{};
    for (int i = 0; i < 48; ++i) prm.in[i] = (const float*)d_in[i];
    prm.out = (float*)d_out; prm.ws = (unsigned char*)d_ws;
#ifndef N_SPLIT
    prm.ph_lo = 0; prm.ph_hi = 28;
    void* args[] = {&prm};
    hipError_t e = hipLaunchCooperativeKernel((const void*)hybrid_fwd, dim3(grid), dim3(NTHREADS), args, LDS_BYTES, stream);
    if (e != hipSuccess) fprintf(stderr, "cooperative launch failed: %s (grid %d)\n", hipGetErrorString(e), grid);
#else
    for (int k = 0; k < 28; ++k) {
        prm.ph_lo = k; prm.ph_hi = k + 1;
        void* args[] = {&prm};
        hipError_t e = hipLaunchCooperativeKernel((const void*)hybrid_fwd, dim3(grid), dim3(NTHREADS), args, LDS_BYTES, stream);
        if (e != hipSuccess) { fprintf(stderr, "launch %d failed: %s\n", k, hipGetErrorString(e)); break; }
    }
#endif
}
```

```cpp
#include <hip/hip_runtime.h>
#include <hip/hip_cooperative_groups.h>
#include <cstdio>
#include <cstdint>
namespace cg = cooperative_groups;

#define LAS __attribute__((address_space(3)))
typedef unsigned short bf16;
typedef float f32x2 __attribute__((ext_vector_type(2)));
typedef float f32x4 __attribute__((ext_vector_type(4)));
typedef float f32x16 __attribute__((ext_vector_type(16)));
typedef unsigned u32x2 __attribute__((ext_vector_type(2)));
typedef unsigned u32x4 __attribute__((ext_vector_type(4)));
typedef short s16x8 __attribute__((ext_vector_type(8)));

constexpr int M_TOK = 16384, MP = 8192, DM = 1024, DFF = 2816;
constexpr int LDP0 = 3984, LDP1 = 2304;
constexpr int OUT_YS = 8388608, OUT_SRW = 16777216, OUT_SGD = 18874368, OUT_CKV = 23068672, OUT_KPE = 25165824;

constexpr size_t MiB = 1ull << 20;
constexpr size_t WS_CTL = 0;
constexpr size_t WS_SS = 64 * 1024;
constexpr size_t WS_ROPE = 512 * 1024;
constexpr size_t WS_CV = 2 * 1048576 + 16 * 1048576 + 524288;
constexpr int CV_STRIDE = 9 * 5632;
constexpr size_t WS_MOD = 1 * MiB;
constexpr size_t WS_W = 2 * MiB;
constexpr size_t W_GU = WS_W, W_DOWN = WS_W + 11 * MiB;
constexpr size_t W_IN = WS_W, W_OUT = WS_W + 8 * MiB, W_LORA = WS_W + 10 * MiB, W_UQ = WS_W + 12 * MiB, W_UKV = WS_W + 13 * MiB;
constexpr size_t WS_H = 19 * MiB;
constexpr size_t WS_MIX = 51 * MiB;
constexpr size_t WS_R1 = 83 * MiB;
constexpr size_t R1_BYTES = 130547712;
constexpr size_t WS_HYIN = WS_R1 + 72 * MiB;
constexpr size_t WS_R2 = WS_R1 + R1_BYTES;
constexpr size_t WS_Q = WS_R2, WS_KV = WS_R2 + 24 * MiB, WS_VT = WS_R2 + 42 * MiB, WS_CKVA = WS_R2 + 60 * MiB, WS_KPEA = WS_R2 + 69 * MiB, WS_GFS = WS_R2 + 71 * MiB, WS_GFP = WS_R2 + 75 * MiB;
constexpr size_t WS_END = WS_R2 + 80 * MiB;

constexpr int LDS_BYTES = 159744;
constexpr int NTHREADS = 512;

struct P {
    const float* in[48];
    float* out;
    unsigned char* ws;
    int ph_lo, ph_hi;
};

__device__ __forceinline__ float bf2f(unsigned b) { return __uint_as_float(b << 16); }
__device__ __forceinline__ float bflo(unsigned w) { return __uint_as_float(w << 16); }
__device__ __forceinline__ float bfhi(unsigned w) { return __uint_as_float(w & 0xffff0000u); }
typedef __bf16 bf16x2_t __attribute__((ext_vector_type(2)));
__device__ __forceinline__ unsigned pk2(float lo, float hi) { const f32x2 v = {lo, hi}; return __builtin_bit_cast(unsigned, __builtin_convertvector(v, bf16x2_t)); }
__device__ __forceinline__ f32x4 unpk4(u32x2 w) { return (f32x4){bflo(w.x), bfhi(w.x), bflo(w.y), bfhi(w.y)}; }
__device__ __forceinline__ u32x2 pk4(f32x4 v) { return (u32x2){pk2(v.x, v.y), pk2(v.z, v.w)}; }
__device__ __forceinline__ float wave_sum(float v) {
#pragma unroll
    for (int o = 1; o < 64; o <<= 1) v += __shfl_xor(v, o);
    return v;
}
__device__ __forceinline__ float dpp_f(float x, int) { return x; }
#define DPPF(x, ctrl) __int_as_float(__builtin_amdgcn_update_dpp(0, __float_as_int(x), (ctrl), 0xF, 0xF, true))
__device__ __forceinline__ float red4(float x) { x += DPPF(x, 0xB1); x += DPPF(x, 0x4E); return x; }
__device__ __forceinline__ float red8(float x) { x = red4(x); x += DPPF(x, 0x141); return x; }
__device__ __forceinline__ float red16(float x) { x = red8(x); x += DPPF(x, 0x140); return x; }
__device__ __forceinline__ float sigmoidf_(float x) { return __builtin_amdgcn_rcpf(1.0f + __expf(-x)); }
__device__ __forceinline__ float siluf_(float x) { return x * __builtin_amdgcn_rcpf(1.0f + __expf(-x)); }
__device__ __forceinline__ float rsqrtf_(float x) { return __builtin_amdgcn_rsqf(x); }
__device__ __forceinline__ int cond_of_row(int row) { return row < MP ? 0 : 1 + ((row - MP) >> 10); }
__device__ __forceinline__ int tid_opaque() { int t = threadIdx.x; asm volatile("" : "+v"(t)); return t; }
#define LDS_WAIT() asm volatile("s_waitcnt lgkmcnt(0)" ::: "memory")

namespace pg8 {
#define PG8_LAS __attribute__((address_space(3)))
typedef unsigned short bf16_t;
typedef short bf16x8 __attribute__((ext_vector_type(8)));
typedef float f32x4 __attribute__((ext_vector_type(4)));
typedef unsigned u32x4 __attribute__((ext_vector_type(4)));
constexpr int BM = 256, BK = 64, HALF = 128, HTB = HALF * BK * 2  , STAGE_BYTES = 8 * HTB, NXCD = 8, WGM = 4;

__host__ __device__ __forceinline__ int lds_byte(int r, int c) { const int st = (r >> 4) * 2 + (c >> 5), rr = r & 15, cc = c & 31, ob = rr * 64 + cc * 2; return st * 1024 + (ob ^ (((ob >> 9) & 1) << 5)); }
__host__ __device__ __forceinline__ void stage_rc(int b, int& R, int& C) { const int st = b / 1024, sb = b % 1024, swz = sb ^ (((sb >> 9) & 1) << 5); R = (st >> 1) * 16 + swz / 64; C = (st & 1) * 32 + (swz % 64) / 2; }
__host__ __device__ __forceinline__ int perm32(int rho) { const int n = rho >> 4, i = rho & 15; return 8 * (i >> 2) + 4 * n + (i & 3); }

struct Unit { int pm, pn; };
struct Gemm { const bf16_t* A; const bf16_t* Bt; int M, N, K; };

struct StaticOrder {
    int nM, nN, nwg, G, c;
    __host__ __device__ void init(int M, int N, int G_, int c_) { nM = M / BM; nN = N / BM; nwg = nM * nN; G = G_; c = c_; }
    __host__ __device__ bool next(int i, Unit& u) const {
        const long L = (long)i * G + c; if (L >= nwg) return false;
        int wgid = (int)L; { const int q = nwg / NXCD, r = nwg % NXCD, xcd = wgid % NXCD, off = wgid / NXCD; wgid = (xcd < r ? xcd * (q + 1) : r * (q + 1) + (xcd - r) * q) + off; }
        const int nig = WGM * nN, gid = wgid / nig, fm = gid * WGM, gsz = (nM - fm) < WGM ? (nM - fm) : WGM;
        u.pm = fm + ((wgid % nig) % gsz); u.pn = (wgid % nig) / gsz; return true;
    }
    __device__ __forceinline__ void a_ready(const Unit&) const {}
    __device__ __forceinline__ void done(const Unit&) const {}
};
__device__ __forceinline__ unsigned cvt_pk_bf16(float lo, float hi) { unsigned r; asm volatile("v_cvt_pk_bf16_f32 %0, %1, %2" : "=v"(r) : "v"(lo), "v"(hi)); return r; }
typedef float f32x2 __attribute__((ext_vector_type(2)));
template <class Epi, class Sched, bool ALIGN_EPI = false, bool SP2 = false>
__device__ __forceinline__ void gemm_phase(PG8_LAS unsigned char* lds, const Gemm g, const Sched& S, const Epi& E) {
    const int tid = tid_opaque(), wid = __builtin_amdgcn_readfirstlane(tid >> 6), lane = tid & 63, wr = wid >> 2, wc = wid & 3, fr = lane & 15, fq = lane >> 4;
    const int K = g.K, nt = K / BK;
    unsigned voffA[2], voffB[2];
#pragma unroll
    for (int i = 0; i < 2; ++i) { int R, C; stage_rc(tid * 16 + i * 8192, R, C); const int Rb = Epi::PERM ? ((R & ~31) + perm32(R & 31)) : R;
        voffA[i] = (unsigned)(R * K + C) * 2u; voffB[i] = (unsigned)(Rb * K + C) * 2u; }
    const size_t kstep = (size_t)(BK * 2);
    const size_t hstep = (size_t)HALF * K * 2;
    const size_t tstep = 2 * hstep;
    const unsigned ldsw = (unsigned)wid * 1024u;
    const int aoff = lds_byte(wr * 64 + fr, fq * 8), boff = lds_byte(wc * 32 + fr, fq * 8);
#define PG8_SA(b, h) (((b) * 2 + (h)) * HTB)
#define PG8_SB(b, h) ((4 + (b) * 2 + (h)) * HTB)
#define PG8_STAGE(bufoff, gbase, voff) do { _Pragma("unroll") for (int _i = 0; _i < 2; ++_i) \
        __builtin_amdgcn_global_load_lds((const unsigned*)((const char*)(gbase) + (voff)[_i]), (PG8_LAS unsigned*)(lds + (bufoff) + ldsw + _i * 8192), 16, 0, 0); } while (0)
#define PG8_LDA(dst, b, h) do { _Pragma("unroll") for (int m = 0; m < 4; ++m) _Pragma("unroll") for (int k = 0; k < 2; ++k) dst[m][k] = *(const PG8_LAS bf16x8*)(lds + PG8_SA(b, h) + aoff + m * 2048 + k * 1024); } while (0)
#define PG8_LDB(dst, b, h) do { _Pragma("unroll") for (int n = 0; n < 2; ++n) _Pragma("unroll") for (int k = 0; k < 2; ++k) dst[n][k] = *(const PG8_LAS bf16x8*)(lds + PG8_SB(b, h) + boff + n * 2048 + k * 1024); } while (0)
#define PG8_MMA(ai, bj, At, Bt) do { __builtin_amdgcn_s_setprio(1); _Pragma("unroll") for (int m = 0; m < 4; ++m) _Pragma("unroll") for (int n = 0; n < 2; ++n) _Pragma("unroll") for (int k = 0; k < 2; ++k) \
        acc[ai][bj][m][n] = __builtin_amdgcn_mfma_f32_16x16x32_bf16(Bt[n][k], At[m][k], acc[ai][bj][m][n], 0, 0, 0); __builtin_amdgcn_s_setprio(0); } while (0)
#define PG8_WAIT_V(n) asm volatile("s_waitcnt vmcnt(" #n ")" ::: "memory")
#define PG8_WAIT_L(n) asm volatile("s_waitcnt lgkmcnt(" #n ")" ::: "memory")
#define PG8_BAR __builtin_amdgcn_s_barrier()
#define PG8_SCHED __builtin_amdgcn_sched_barrier(0)
    Unit cur, nxt; int ui = 0;
    if (!S.next(0, cur)) return;
    f32x4 acc[2][2][4][2];
#pragma unroll
    for (int a = 0; a < 2; ++a)
#pragma unroll
        for (int b = 0; b < 2; ++b)
#pragma unroll
            for (int m = 0; m < 4; ++m)
#pragma unroll
                for (int n = 0; n < 2; ++n) acc[a][b][m][n] = (f32x4){0.f, 0.f, 0.f, 0.f};
    bf16x8 At[4][2], B0[2][2], B1[2][2];
    const char* cA = (const char*)g.A + (size_t)cur.pm * tstep; const char* cB = (const char*)g.Bt + (size_t)cur.pn * tstep;
    S.a_ready(cur);
    if constexpr (SP2) {
        PG8_STAGE(PG8_SB(0, 0), cB, voffB); PG8_STAGE(PG8_SB(0, 1), cB + hstep, voffB); PG8_STAGE(PG8_SA(0, 0), cA, voffA); PG8_STAGE(PG8_SA(0, 1), cA + hstep, voffA);
        if (wr == 1) PG8_BAR;
        PG8_WAIT_V(2); PG8_BAR;
        PG8_STAGE(PG8_SB(1, 0), cB + kstep, voffB); PG8_STAGE(PG8_SA(1, 0), cA + kstep, voffA); PG8_STAGE(PG8_SB(1, 1), cB + hstep + kstep, voffB);
        PG8_WAIT_V(6); PG8_BAR;
    } else {
        PG8_STAGE(PG8_SB(0, 0), cB, voffB); PG8_STAGE(PG8_SA(0, 0), cA, voffA); PG8_STAGE(PG8_SB(0, 1), cB + hstep, voffB); PG8_STAGE(PG8_SA(0, 1), cA + hstep, voffA);
        if (wr == 1) PG8_BAR;
        PG8_WAIT_V(4); PG8_BAR;
        PG8_STAGE(PG8_SB(1, 0), cB + kstep, voffB); PG8_STAGE(PG8_SA(1, 0), cA + kstep, voffA); PG8_STAGE(PG8_SB(1, 1), cB + hstep + kstep, voffB);
        PG8_WAIT_V(6); PG8_BAR;
    }
    for (;;) {
        const bool has_next = S.next(ui + 1, nxt);
        const char* nA = has_next ? (const char*)g.A + (size_t)nxt.pm * tstep : cA; const char* nB = has_next ? (const char*)g.Bt + (size_t)nxt.pn * tstep : cB;
#pragma unroll 1
        for (int t = 0; t < nt; t += 2) {
            const bool last = (t == nt - 2);
            const char* a1 = cA + (size_t)(t + 1) * kstep;
            const char* a2 = last ? nA : cA + (size_t)(t + 2) * kstep; const char* b2 = last ? nB : cB + (size_t)(t + 2) * kstep;
            const char* a3 = a2 + kstep; const char* b3 = b2 + kstep;
            if (last && has_next) S.a_ready(nxt);
            if constexpr (SP2) {
            PG8_LDB(B0, 0, 0); PG8_LDB(B1, 0, 1); PG8_SCHED; PG8_LDA(At, 0, 0); PG8_STAGE(PG8_SA(1, 1), a1 + hstep, voffA);
            PG8_WAIT_V(8); PG8_WAIT_L(0); PG8_BAR; PG8_MMA(0, 0, At, B0); PG8_MMA(0, 1, At, B1); PG8_BAR; PG8_SCHED;
            PG8_LDA(At, 0, 1); PG8_STAGE(PG8_SB(0, 0), b2, voffB); PG8_STAGE(PG8_SB(0, 1), b2 + hstep, voffB); PG8_STAGE(PG8_SA(0, 0), a2, voffA);
            PG8_WAIT_V(8); PG8_WAIT_L(0); PG8_BAR; PG8_MMA(1, 0, At, B0); PG8_MMA(1, 1, At, B1); PG8_BAR; PG8_SCHED;
            PG8_LDB(B0, 1, 0); PG8_LDB(B1, 1, 1); PG8_SCHED; PG8_LDA(At, 1, 0); PG8_STAGE(PG8_SA(0, 1), a2 + hstep, voffA);
            PG8_WAIT_V(8); PG8_WAIT_L(0); PG8_BAR; PG8_MMA(0, 0, At, B0); PG8_MMA(0, 1, At, B1); PG8_BAR; PG8_SCHED;
            PG8_LDA(At, 1, 1); PG8_STAGE(PG8_SB(1, 0), b3, voffB); PG8_STAGE(PG8_SB(1, 1), b3 + hstep, voffB); PG8_STAGE(PG8_SA(1, 0), a3, voffA);
            PG8_WAIT_V(8); PG8_WAIT_L(0); PG8_BAR; PG8_MMA(1, 0, At, B0); PG8_MMA(1, 1, At, B1); PG8_BAR; PG8_SCHED;
            } else {
            PG8_LDB(B0, 0, 0); PG8_SCHED; PG8_LDA(At, 0, 0); PG8_STAGE(PG8_SA(1, 1), a1 + hstep, voffA);
            PG8_WAIT_L(8); PG8_BAR; PG8_WAIT_L(0); PG8_MMA(0, 0, At, B0); PG8_BAR; PG8_SCHED;
            PG8_LDB(B1, 0, 1); PG8_STAGE(PG8_SB(0, 0), b2, voffB);
            PG8_BAR; PG8_WAIT_L(0); PG8_MMA(0, 1, At, B1); PG8_BAR;
            PG8_LDA(At, 0, 1); PG8_STAGE(PG8_SA(0, 0), a2, voffA);
            PG8_BAR; PG8_WAIT_L(0); PG8_MMA(1, 0, At, B0); PG8_BAR; PG8_SCHED;
            PG8_STAGE(PG8_SB(0, 1), b2 + hstep, voffB);
            PG8_WAIT_V(6); PG8_BAR; PG8_MMA(1, 1, At, B1); PG8_BAR;
            PG8_LDB(B0, 1, 0); PG8_SCHED; PG8_LDA(At, 1, 0); PG8_STAGE(PG8_SA(0, 1), a2 + hstep, voffA);
            PG8_WAIT_L(8); PG8_BAR; PG8_WAIT_L(0); PG8_MMA(0, 0, At, B0); PG8_BAR; PG8_SCHED;
            PG8_LDB(B1, 1, 1); PG8_STAGE(PG8_SB(1, 0), b3, voffB);
            PG8_BAR; PG8_WAIT_L(0); PG8_MMA(0, 1, At, B1); PG8_BAR;
            PG8_LDA(At, 1, 1); PG8_STAGE(PG8_SA(1, 0), a3, voffA);
            PG8_BAR; PG8_WAIT_L(0); PG8_MMA(1, 0, At, B0); PG8_BAR; PG8_SCHED;
            PG8_STAGE(PG8_SB(1, 1), b3 + hstep, voffB);
            PG8_WAIT_V(6); PG8_BAR; PG8_MMA(1, 1, At, B1); PG8_BAR;
            }
        }
        if constexpr (ALIGN_EPI) { if (wr == 0) PG8_BAR; }
        if constexpr (!Epi::AFTER_DRAIN) { E(acc, cur, wr, wc, fr, fq); S.done(cur); }
        if (!has_next) break;
#pragma unroll
        for (int a = 0; a < 2; ++a)
#pragma unroll
            for (int b = 0; b < 2; ++b)
#pragma unroll
                for (int m = 0; m < 4; ++m)
#pragma unroll
                    for (int n = 0; n < 2; ++n) acc[a][b][m][n] = (f32x4){0.f, 0.f, 0.f, 0.f};
        cur = nxt; cA = nA; cB = nB; ++ui;
        if constexpr (ALIGN_EPI) { if (wr == 1) PG8_BAR; }
    }
    PG8_WAIT_V(0);
    if constexpr (!ALIGN_EPI) { if (wr == 0) PG8_BAR; }
    PG8_BAR;
    if constexpr (Epi::AFTER_DRAIN) { E.fused(acc, cur, wr, wc, fr, fq, lds, wid, lane); S.done(cur); }
#undef PG8_SA
#undef PG8_SB
#undef PG8_STAGE
#undef PG8_LDA
#undef PG8_LDB
#undef PG8_MMA
#undef PG8_WAIT_V
#undef PG8_WAIT_L
#undef PG8_BAR
#undef PG8_SCHED
}
}

using pg8::Unit;
typedef const f32x4 (&AccRef)[2][2][4][2];

struct EpiSwiglu {
    static constexpr bool PERM = true, AFTER_DRAIN = false;
    bf16* O;
    __device__ __forceinline__ void operator()(AccRef acc, const Unit& u, int wr, int wc, int fr, int fq) const {
        const int row0 = u.pm * 256 + wr * 64 + fr, col0 = u.pn * 128 + wc * 32 + 8 * fq;
#pragma unroll
        for (int ai = 0; ai < 2; ++ai)
#pragma unroll
            for (int m = 0; m < 4; ++m) {
                const f32x4 g0 = acc[ai][0][m][0], g1 = acc[ai][0][m][1], u0 = acc[ai][1][m][0], u1 = acc[ai][1][m][1];
                float v[8];
#pragma unroll
                for (int i = 0; i < 4; ++i) { v[i] = g0[i] * __builtin_amdgcn_rcpf(1.0f + __expf(-g0[i])) * u0[i]; v[4 + i] = g1[i] * __builtin_amdgcn_rcpf(1.0f + __expf(-g1[i])) * u1[i]; }
                u32x4 w; w.x = pk2(v[0], v[1]); w.y = pk2(v[2], v[3]); w.z = pk2(v[4], v[5]); w.w = pk2(v[6], v[7]);
                *(u32x4*)(O + (size_t)(row0 + ai * 128 + m * 16) * DFF + col0) = w;
            }
    }
};
struct EpiSwigluN {
    static constexpr bool PERM = true, AFTER_DRAIN = false;
    bf16* O; const float* ss; const float* cv;
    __device__ __forceinline__ void operator()(AccRef acc, const Unit& u, int wr, int wc, int fr, int fq) const {
        const int cond = u.pm < 32 ? 0 : 1 + ((u.pm - 32) >> 2);
        const int row0 = u.pm * 256 + wr * 64 + fr, col0 = u.pn * 128 + wc * 32 + 8 * fq, gc0 = u.pn * 256 + wc * 32 + 8 * fq;
        const float* cp = cv + (size_t)cond * 5632 + gc0;
        const f32x4 cg0 = *(const f32x4*)cp, cg1 = *(const f32x4*)(cp + 4), cu0 = *(const f32x4*)(cp + 128), cu1 = *(const f32x4*)(cp + 132);
#pragma unroll
        for (int ai = 0; ai < 2; ++ai)
#pragma unroll
            for (int m = 0; m < 4; ++m) {
                const int row = row0 + ai * 128 + m * 16;
                const float rs = ss[row];
                const f32x4 g0 = acc[ai][0][m][0] * rs + cg0, g1 = acc[ai][0][m][1] * rs + cg1, u0 = acc[ai][1][m][0] * rs + cu0, u1 = acc[ai][1][m][1] * rs + cu1;
                float v[8];
#pragma unroll
                for (int i = 0; i < 4; ++i) { v[i] = g0[i] * __builtin_amdgcn_rcpf(1.0f + __expf(-g0[i])) * u0[i]; v[4 + i] = g1[i] * __builtin_amdgcn_rcpf(1.0f + __expf(-g1[i])) * u1[i]; }
                u32x4 w; w.x = pk2(v[0], v[1]); w.y = pk2(v[2], v[3]); w.z = pk2(v[4], v[5]); w.w = pk2(v[6], v[7]);
                *(u32x4*)(O + (size_t)row * DFF + col0) = w;
            }
    }
};
struct EpiStoreN {
    static constexpr bool PERM = true, AFTER_DRAIN = false;
    bf16* O; int ldc; int ncols; const float* ss; const float* cv; int ncv;
    __device__ __forceinline__ void operator()(AccRef acc, const Unit& u, int wr, int wc, int fr, int fq) const {
        const int cond = u.pm < 32 ? 0 : 1 + ((u.pm - 32) >> 2);
        const int row0 = u.pm * 256 + wr * 64 + fr, col0 = u.pn * 256 + wc * 32 + 8 * fq;
        const float* cp = cv + (size_t)cond * ncv + col0;
        const f32x4 c00 = *(const f32x4*)cp, c01 = *(const f32x4*)(cp + 4), c10 = *(const f32x4*)(cp + 128), c11 = *(const f32x4*)(cp + 132);
#pragma unroll
        for (int ai = 0; ai < 2; ++ai)
#pragma unroll
            for (int m = 0; m < 4; ++m) {
                const int row = row0 + ai * 128 + m * 16;
                const float rs = ss[row];
                bf16* rowp = O + (size_t)row * ldc;
#pragma unroll
                for (int bj = 0; bj < 2; ++bj) { const int col = col0 + bj * 128;
                    const f32x4 v0 = acc[ai][bj][m][0] * rs + (bj ? c10 : c00), v1 = acc[ai][bj][m][1] * rs + (bj ? c11 : c01);
                    u32x4 w; w.x = pk2(v0[0], v0[1]); w.y = pk2(v0[2], v0[3]); w.z = pk2(v1[0], v1[1]); w.w = pk2(v1[2], v1[3]);
                    if (col < ncols) *(u32x4*)(rowp + col) = w; }
            }
    }
};
struct EpiResidN {
    static constexpr bool PERM = true, AFTER_DRAIN = false;
    const float* xin_p; const float* xin_s; float* xout; const float* gate_base;
    const float* gnext; const float* scn_base; bf16* xg; float* ss; float coef;
    __device__ __forceinline__ void operator()(AccRef acc, const Unit& u, int wr, int wc, int fr, int fq) const {
        const int cond = u.pm < 32 ? 0 : 1 + ((u.pm - 32) >> 2);
        const float* gate = gate_base + (size_t)cond * 9216; const float* scn = scn_base + (size_t)cond * 9216;
        const int row0 = u.pm * 256 + wr * 64 + fr, col0 = u.pn * 256 + wc * 32 + 8 * fq;
        float sq[2][4];
#pragma unroll
        for (int ai = 0; ai < 2; ++ai)
#pragma unroll
            for (int m = 0; m < 4; ++m) sq[ai][m] = 0.f;
        const float* xb = u.pm < 32 ? xin_p : xin_s - (size_t)MP * DM;
        const unsigned off0 = (unsigned)(row0 * DM + col0);
#pragma unroll
        for (int bj = 0; bj < 2; ++bj) {
            const int col = col0 + bj * 128;
            f32x4 gv[2], G[2];
#pragma unroll
            for (int n = 0; n < 2; ++n) { gv[n] = *(const f32x4*)(gate + col + 4 * n) * coef; G[n] = *(const f32x4*)(gnext + col + 4 * n) * (*(const f32x4*)(scn + col + 4 * n) + 1.0f); }
#pragma unroll
            for (int ai = 0; ai < 2; ++ai) {
                f32x4 xv[4][2];
#pragma unroll
                for (int m = 0; m < 4; ++m)
#pragma unroll
                    for (int n = 0; n < 2; ++n) xv[m][n] = *(const f32x4*)(xb + (off0 + (unsigned)((ai * 128 + m * 16) * DM + bj * 128 + 4 * n)));
                asm volatile("" ::: "memory");
#pragma unroll
                for (int m = 0; m < 4; ++m) {
                    const unsigned off = off0 + (unsigned)((ai * 128 + m * 16) * DM + bj * 128);
                    const f32x4 x0 = xv[m][0] + gv[0] * acc[ai][bj][m][0], x1 = xv[m][1] + gv[1] * acc[ai][bj][m][1];
                    *(f32x4*)(xout + off) = x0; *(f32x4*)(xout + off + 4) = x1;
                    const u32x2 w0 = pk4(x0 * G[0]), w1 = pk4(x1 * G[1]);
                    *(u32x4*)(xg + off) = (u32x4){w0.x, w0.y, w1.x, w1.y};
                    sq[ai][m] += x0.x * x0.x + x0.y * x0.y + x0.z * x0.z + x0.w * x0.w + x1.x * x1.x + x1.y * x1.y + x1.z * x1.z + x1.w * x1.w;
                }
                asm volatile("" ::: "memory");
            }
        }
#pragma unroll
        for (int ai = 0; ai < 2; ++ai)
#pragma unroll
            for (int m = 0; m < 4; ++m) {
                float t = sq[ai][m]; t += __shfl_xor(t, 16); t += __shfl_xor(t, 32);
                if (fq == 0) ss[(u.pn * 4 + wc) * M_TOK + row0 + ai * 128 + m * 16] = t;
            }
    }
};
struct EpiResid {
    static constexpr bool PERM = true, AFTER_DRAIN = false;
    const float* xin_p; const float* xin_s; float* xout; const float* gate_base; float coef;
    __device__ __forceinline__ void operator()(AccRef acc, const Unit& u, int wr, int wc, int fr, int fq) const {
        const int cond = u.pm < 32 ? 0 : 1 + ((u.pm - 32) >> 2);
        const float* gate = gate_base + (size_t)cond * 9216;
        const int row0 = u.pm * 256 + wr * 64 + fr, col0 = u.pn * 256 + wc * 32 + 8 * fq;
        const float* xb = u.pm < 32 ? xin_p : xin_s - (size_t)MP * DM;
        const unsigned off0 = (unsigned)(row0 * DM + col0);
#pragma unroll
        for (int bj = 0; bj < 2; ++bj) {
            const f32x4 gv0 = *(const f32x4*)(gate + col0 + bj * 128) * coef, gv1 = *(const f32x4*)(gate + col0 + bj * 128 + 4) * coef;
#pragma unroll
            for (int ai = 0; ai < 2; ++ai) {
                f32x4 xv[4][2];
#pragma unroll
                for (int m = 0; m < 4; ++m)
#pragma unroll
                    for (int n = 0; n < 2; ++n) xv[m][n] = *(const f32x4*)(xb + (off0 + (unsigned)((ai * 128 + m * 16) * DM + bj * 128 + 4 * n)));
                asm volatile("" ::: "memory");
#pragma unroll
                for (int m = 0; m < 4; ++m) {
                    const unsigned off = off0 + (unsigned)((ai * 128 + m * 16) * DM + bj * 128);
                    *(f32x4*)(xout + off) = xv[m][0] + gv0 * acc[ai][bj][m][0]; *(f32x4*)(xout + off + 4) = xv[m][1] + gv1 * acc[ai][bj][m][1];
                }
                asm volatile("" ::: "memory");
            }
        }
    }
};
struct EpiStore {
    static constexpr bool PERM = true, AFTER_DRAIN = false;
    bf16* O; int ldc; int ncols;
    __device__ __forceinline__ void operator()(AccRef acc, const Unit& u, int wr, int wc, int fr, int fq) const {
        const int row0 = u.pm * 256 + wr * 64 + fr, col0 = u.pn * 256 + wc * 32 + 8 * fq;
#pragma unroll
        for (int ai = 0; ai < 2; ++ai)
#pragma unroll
            for (int m = 0; m < 4; ++m) {
                bf16* rowp = O + (size_t)(row0 + ai * 128 + m * 16) * ldc;
#pragma unroll
                for (int bj = 0; bj < 2; ++bj) { const int col = col0 + bj * 128; const f32x4 v0 = acc[ai][bj][m][0], v1 = acc[ai][bj][m][1];
                    u32x4 w; w.x = pk2(v0[0], v0[1]); w.y = pk2(v0[2], v0[3]); w.z = pk2(v1[0], v1[1]); w.w = pk2(v1[2], v1[3]);
                    if (col < ncols) *(u32x4*)(rowp + col) = w; }
            }
    }
};
struct EpiLora {
    static constexpr bool PERM = true, AFTER_DRAIN = false;
    bf16* O; const float* w0; const float* a0;
    __device__ __forceinline__ void operator()(AccRef acc, const Unit& u, int wr, int wc, int fr, int fq) const {
        const int seg = u.pn >> 1;
        const float* bias = seg < 2 ? w0 + seg * 512 : a0 + (seg & 1) * 512;
        const int row0 = u.pm * 256 + wr * 64 + fr, ct0 = wc * 32 + 8 * fq;
#pragma unroll
        for (int bj = 0; bj < 2; ++bj) {
            const int cseg = (u.pn & 1) * 256 + ct0 + bj * 128;
            f32x4 b0 = {0.f, 0.f, 0.f, 0.f}, b1 = {0.f, 0.f, 0.f, 0.f};
            if (seg < 4) { b0 = *(const f32x4*)(bias + cseg); b1 = *(const f32x4*)(bias + cseg + 4); }
#pragma unroll
            for (int ai = 0; ai < 2; ++ai)
#pragma unroll
                for (int m = 0; m < 4; ++m) {
                    f32x4 v0 = acc[ai][bj][m][0] + b0, v1 = acc[ai][bj][m][1] + b1;
                    if (seg < 4) {
                        const float sc = seg < 2 ? 0.60653066f : 1.0f;
#pragma unroll
                        for (int i = 0; i < 4; ++i) { v0[i] = sc * sigmoidf_(v0[i]); v1[i] = sc * sigmoidf_(v1[i]); }
                    }
                    u32x4 w; w.x = pk2(v0[0], v0[1]); w.y = pk2(v0[2], v0[3]); w.z = pk2(v1[0], v1[1]); w.w = pk2(v1[2], v1[3]);
                    *(u32x4*)(O + (size_t)(row0 + ai * 128 + m * 16) * 2560 + u.pn * 256 + ct0 + bj * 128) = w;
                    asm volatile("" ::: "memory");
                }
        }
    }
};
struct EpiQ {
    static constexpr bool PERM = true, AFTER_DRAIN = false;
    bf16* O; const float* rope;
    __device__ __forceinline__ void operator()(AccRef acc, const Unit& u, int wr, int wc, int fr, int fq) const {
        const int row0 = u.pm * 256 + wr * 64 + fr, col0 = u.pn * 256 + wc * 32 + 8 * fq;
        const float qs = 0.10206207261596577f;
#pragma unroll
        for (int bj = 0; bj < 2; ++bj) {
            const int col = col0 + bj * 128, e0 = col % 96;
            const bool is_rope = e0 >= 64;
#pragma unroll
            for (int ai = 0; ai < 2; ++ai)
#pragma unroll
                for (int m = 0; m < 4; ++m) {
                    const int row = row0 + ai * 128 + m * 16;
                    f32x4 v0 = acc[ai][bj][m][0] * qs, v1 = acc[ai][bj][m][1] * qs;
                    if (is_rope && row >= MP) {
                        const int t = (row - MP) & 1023;
                        const float* rt = rope + (size_t)t * 32 + (e0 - 64);
                        const f32x4 c0 = *(const f32x4*)(rt), c1 = *(const f32x4*)(rt + 4);
                        f32x4 r0, r1;
                        r0[0] = v0[0] * c0[0] - v0[1] * c0[1]; r0[1] = v0[0] * c0[1] + v0[1] * c0[0];
                        r0[2] = v0[2] * c0[2] - v0[3] * c0[3]; r0[3] = v0[2] * c0[3] + v0[3] * c0[2];
                        r1[0] = v1[0] * c1[0] - v1[1] * c1[1]; r1[1] = v1[0] * c1[1] + v1[1] * c1[0];
                        r1[2] = v1[2] * c1[2] - v1[3] * c1[3]; r1[3] = v1[2] * c1[3] + v1[3] * c1[2];
                        v0 = r0; v1 = r1;
                    }
                    u32x4 w; w.x = pk2(v0[0], v0[1]); w.y = pk2(v0[2], v0[3]); w.z = pk2(v1[0], v1[1]); w.w = pk2(v1[2], v1[3]);
                    *(u32x4*)(O + (size_t)row * 768 + col) = w;
                    asm volatile("" ::: "memory");
                }
        }
    }
};

struct EpiKV {
    static constexpr bool PERM = true, AFTER_DRAIN = false;
    bf16* KN; bf16* VT; int nrows;
    __device__ __forceinline__ void operator()(AccRef acc, const Unit& u, int wr, int wc, int fr, int fq) const {
        const int row0 = u.pm * 256 + wr * 64 + fr, col0 = u.pn * 256 + wc * 32 + 8 * fq;
#pragma unroll
        for (int bj = 0; bj < 2; ++bj) {
            const int col = col0 + bj * 128, head = col >> 7, e0 = col & 127;
#pragma unroll
            for (int ai = 0; ai < 2; ++ai)
#pragma unroll
                for (int m = 0; m < 4; ++m) {
                    const int row = row0 + ai * 128 + m * 16;
                    const f32x4 v0 = acc[ai][bj][m][0], v1 = acc[ai][bj][m][1];
                    u32x4 w; w.x = pk2(v0[0], v0[1]); w.y = pk2(v0[2], v0[3]); w.z = pk2(v1[0], v1[1]); w.w = pk2(v1[2], v1[3]);
                    if (e0 < 64) *(u32x4*)(KN + (size_t)row * 512 + head * 64 + e0) = w;
                    else { bf16* vp = VT + (size_t)(head * 64 + e0 - 64) * nrows + row;
#pragma unroll
                        for (int i = 0; i < 4; ++i) { vp[(size_t)(2 * i) * nrows] = (bf16)(w[i] & 0xffffu); vp[(size_t)(2 * i + 1) * nrows] = (bf16)(w[i] >> 16); } }
                }
        }
    }
};

__device__ __forceinline__ void adaln_layer(const P& p, LAS unsigned char* lds, int l, int bfirst) {
    LAS float* scv = (LAS float*)lds;
    LAS float* red = scv + 9 * 1024;
    const int tid = tid_opaque(), tx = tid % 18, ty = tid / 18;
    const float* cc = p.in[6]; const float* cctx = p.in[7];
    float* mod = (float*)(p.ws + WS_MOD);
    if ((int)blockIdx.x < bfirst) return;
    __syncthreads();
    for (int i = tid; i < 9 * 1024; i += NTHREADS) { const int c = i >> 10, k = i & 1023; const float v = c == 0 ? cctx[k] : cc[(c - 1) * 1024 + k]; scv[i] = v / (1.0f + expf(-v)); }
    __syncthreads();
    for (int cgp = blockIdx.x - bfirst; cgp < 128; cgp += gridDim.x - bfirst) {
        const int col0 = cgp * 72 + tx * 4;
        const float* W = p.in[8] + (size_t)l * 1024 * 9216;
        f32x4 acc[9];
#pragma unroll
        for (int c = 0; c < 9; ++c) acc[c] = (f32x4){0.f, 0.f, 0.f, 0.f};
        if (ty < 28) {
#pragma unroll 8
            for (int k = ty; k < 1024; k += 28) {
                const f32x4 w = *(const f32x4*)(W + (size_t)k * 9216 + col0);
#pragma unroll
                for (int c = 0; c < 9; ++c) acc[c] += w * scv[c * 1024 + k];
            }
#pragma unroll
            for (int c = 0; c < 9; ++c) *(LAS f32x4*)(red + ty * 648 + c * 72 + tx * 4) = acc[c];
        }
        __syncthreads();
        for (int o = tid; o < 648; o += NTHREADS) {
            float s = 0.f;
            for (int y = 0; y < 28; ++y) s += red[y * 648 + o];
            const int c = o / 72, j = o % 72;
            mod[(size_t)(l * 9 + c) * 9216 + cgp * 72 + j] = s + p.in[9][l * 9216 + cgp * 72 + j];
        }
        __syncthreads();
    }
}
__device__ __forceinline__ void ph_rope_table(const P& p) {
    const int tid = tid_opaque();
    float* rope = (float*)(p.ws + WS_ROPE);
    for (int idx = blockIdx.x * NTHREADS + tid; idx < 1024 * 16; idx += gridDim.x * NTHREADS) {
        const int t = idx >> 4, i = idx & 15;
        const float pos = (float)(i < 8 ? (t >> 6) : (t & 63));
        const float inv = powf(10000.0f, -(float)(i & 7) / 8.0f);
        const float ang = pos * inv;
        rope[idx * 2] = cosf(ang); rope[idx * 2 + 1] = sinf(ang);
    }
}

__device__ __forceinline__ void norm_rows(const P& p, int layer, int j, const float* gvec, bool from_input) {
    const int tid = tid_opaque(), lane = tid & 63, wave = tid >> 6;
    const float* mod = (const float*)(p.ws + WS_MOD);
    const float* x = p.out;
    bf16* h = (bf16*)(p.ws + WS_H);
    const int nw = gridDim.x * 8;
    for (int row0 = blockIdx.x * 8 + wave; row0 < M_TOK; row0 += 4 * nw) {
        f32x4 v[4][4]; float ss[4];
#pragma unroll
        for (int r = 0; r < 4; ++r) {
            const int row = (row0 + r * nw) < M_TOK ? (row0 + r * nw) : (M_TOK - 1);
            const float* xr = from_input ? (row < MP ? p.in[0] + (size_t)row * DM : p.in[1] + (size_t)(row - MP) * DM) : x + (size_t)row * DM;
#pragma unroll
            for (int q = 0; q < 4; ++q) v[r][q] = *(const f32x4*)(xr + lane * 4 + 256 * q);
        }
#pragma unroll
        for (int r = 0; r < 4; ++r) { float s = 0.f;
#pragma unroll
            for (int q = 0; q < 4; ++q) s += v[r][q].x * v[r][q].x + v[r][q].y * v[r][q].y + v[r][q].z * v[r][q].z + v[r][q].w * v[r][q].w;
            ss[r] = s; }
#pragma unroll
        for (int o = 1; o < 64; o <<= 1) {
#pragma unroll
            for (int r = 0; r < 4; ++r) ss[r] += __shfl_xor(ss[r], o); }
#pragma unroll
        for (int r = 0; r < 4; ++r) {
            const int row = row0 + r * nw; if (row >= M_TOK) break;
            const float rstd = 1.0f / sqrtf(ss[r] * (1.0f / 1024.0f) + 1e-6f);
            const float* mrow = mod + (size_t)(layer * 9 + cond_of_row(row)) * 9216;
            const float* sh = mrow + (3 * j) * 1024; const float* sc = mrow + (3 * j + 1) * 1024;
#pragma unroll
            for (int q = 0; q < 4; ++q) {
                const int col = lane * 4 + 256 * q;
                const f32x4 g = *(const f32x4*)(gvec + col), s1 = *(const f32x4*)(sc + col), s0 = *(const f32x4*)(sh + col);
                const f32x4 y = (v[r][q] * rstd * g) * (s1 + 1.0f) + s0;
                *(u32x2*)(h + (size_t)row * DM + col) = pk4(y);
            }
        }
    }
}
__device__ __forceinline__ void first_rows(const P& p, const float* gvec, float* ss) {
    const int tid = tid_opaque(), lane = tid & 63, wave = tid >> 6;
    const float* mod = (const float*)(p.ws + WS_MOD);
    bf16* h = (bf16*)(p.ws + WS_H);
    const int nw = gridDim.x * 8;
    for (int row0 = blockIdx.x * 8 + wave; row0 < M_TOK; row0 += 4 * nw) {
        f32x4 v[4][4]; float sq[4];
#pragma unroll
        for (int r = 0; r < 4; ++r) {
            const int row = (row0 + r * nw) < M_TOK ? (row0 + r * nw) : (M_TOK - 1);
            const float* xr = row < MP ? p.in[0] + (size_t)row * DM : p.in[1] + (size_t)(row - MP) * DM;
#pragma unroll
            for (int q = 0; q < 4; ++q) v[r][q] = *(const f32x4*)(xr + lane * 4 + 256 * q);
        }
#pragma unroll
        for (int r = 0; r < 4; ++r) { float t = 0.f;
#pragma unroll
            for (int q = 0; q < 4; ++q) t += v[r][q].x * v[r][q].x + v[r][q].y * v[r][q].y + v[r][q].z * v[r][q].z + v[r][q].w * v[r][q].w;
            sq[r] = t; }
#pragma unroll
        for (int o = 1; o < 64; o <<= 1) {
#pragma unroll
            for (int r = 0; r < 4; ++r) sq[r] += __shfl_xor(sq[r], o); }
#pragma unroll
        for (int r = 0; r < 4; ++r) {
            const int row = row0 + r * nw; if (row >= M_TOK) break;
            if (lane == 0) ss[row] = rsqrtf_(sq[r] * (1.0f / 1024.0f) + 1e-6f);
            const float* sc = mod + (size_t)cond_of_row(row) * 9216 + 1024;
#pragma unroll
            for (int q = 0; q < 4; ++q) { const int col = lane * 4 + 256 * q;
                *(u32x2*)(h + (size_t)row * DM + col) = pk4(v[r][q] * (*(const f32x4*)(gvec + col) * (*(const f32x4*)(sc + col) + 1.0f))); }
        }
    }
}
__device__ __forceinline__ void final_norm_rows(const P& p) {
    const int tid = tid_opaque(), lane = tid & 63, wave = tid >> 6;
    float* x = p.out; const float* gvec = p.in[47];
    const int nw = gridDim.x * 8;
    for (int row0 = blockIdx.x * 8 + wave; row0 < M_TOK; row0 += 4 * nw) {
        f32x4 v[4][4]; float ss[4];
#pragma unroll
        for (int r = 0; r < 4; ++r) { const int row = (row0 + r * nw) < M_TOK ? (row0 + r * nw) : (M_TOK - 1);
#pragma unroll
            for (int q = 0; q < 4; ++q) v[r][q] = *(const f32x4*)(x + (size_t)row * DM + lane * 4 + 256 * q); }
#pragma unroll
        for (int r = 0; r < 4; ++r) { float s = 0.f;
#pragma unroll
            for (int q = 0; q < 4; ++q) s += v[r][q].x * v[r][q].x + v[r][q].y * v[r][q].y + v[r][q].z * v[r][q].z + v[r][q].w * v[r][q].w;
            ss[r] = s; }
#pragma unroll
        for (int o = 1; o < 64; o <<= 1) {
#pragma unroll
            for (int r = 0; r < 4; ++r) ss[r] += __shfl_xor(ss[r], o); }
#pragma unroll
        for (int r = 0; r < 4; ++r) { const int row = row0 + r * nw; if (row >= M_TOK) break;
            const float rstd = rsqrtf_(ss[r] * (1.0f / 1024.0f) + 1e-6f);
#pragma unroll
            for (int q = 0; q < 4; ++q) { const int col = lane * 4 + 256 * q; *(f32x4*)(x + (size_t)row * DM + col) = v[r][q] * rstd * *(const f32x4*)(gvec + col); } }
    }
}

template <int MODE>
__device__ __forceinline__ void transpose_w(const float* W, int ldw, int ncols_valid, int K, bf16* WT, int Nt, LAS unsigned char* lds, const float* shift = nullptr, float* cvo = nullptr, int ncv = 0, int rot = 0) {
    const int tid = tid_opaque(), lane = tid & 63, wave = tid >> 6;
    LAS float* scr = (LAS float*)(lds + wave * 16640);
    LAS float* shs = (LAS float*)(lds + 8 * 16640 + wave * 3072);
    const int nblk = Nt / 64, nitems = nblk * (K / 64);
    int vb = ((int)blockIdx.x + (int)gridDim.x - rot % (int)gridDim.x) % (int)gridDim.x;
    for (int it = vb * 8 + wave; it < nitems; it += gridDim.x * 8) {
        const int kb = it / nblk, nb = it % nblk, k0 = kb * 64;
        const int g0 = 2 * nb;
        const int sc0 = MODE == 1 ? (((g0 >> 2) & 1) * DFF + (g0 >> 3) * 128 + (g0 & 3) * 32) : nb * 64;
        const int c4 = (lane & 15) * 4, kr = lane >> 4; const bool ok = (sc0 + c4) < ncols_valid;
        f32x4 t[16];
#pragma unroll
        for (int i = 0; i < 16; ++i) t[i] = ok ? *(const f32x4*)(W + (size_t)(k0 + 4 * i + kr) * ldw + sc0 + c4) : (f32x4){0.f, 0.f, 0.f, 0.f};
#pragma unroll
        for (int i = 0; i < 16; ++i) { LAS float* d = scr + (4 * i + kr) * 65 + c4; d[0] = t[i].x; d[1] = t[i].y; d[2] = t[i].z; d[3] = t[i].w; }
        if (shift) {
#pragma unroll
            for (int cc = 0; cc < 9; ++cc) shs[lane * 12 + cc] = shift[(size_t)cc * 9216 + k0 + lane];
        }
        LDS_WAIT();
        if (shift) {
            float a9[9];
#pragma unroll
            for (int cc = 0; cc < 9; ++cc) a9[cc] = 0.f;
#pragma unroll 4
            for (int k = 0; k < 64; ++k) {
                const float w = scr[k * 65 + lane];
                const f32x4 s0 = *(const LAS f32x4*)(shs + k * 12), s1 = *(const LAS f32x4*)(shs + k * 12 + 4); const float s8 = shs[k * 12 + 8];
                a9[0] += w * s0.x; a9[1] += w * s0.y; a9[2] += w * s0.z; a9[3] += w * s0.w; a9[4] += w * s1.x; a9[5] += w * s1.y; a9[6] += w * s1.z; a9[7] += w * s1.w; a9[8] += w * s8;
            }
#pragma unroll
            for (int cc = 0; cc < 9; ++cc) __hip_atomic_fetch_add(cvo + (size_t)cc * ncv + nb * 64 + lane, a9[cc], __ATOMIC_RELAXED, __HIP_MEMORY_SCOPE_AGENT);
        }
        const int c = lane & 7;
#pragma unroll
        for (int j = 0; j < 8; ++j) {
            const int nn = (lane >> 3) + 8 * j; const LAS float* sp = scr + (8 * c) * 65 + nn;
            u32x4 o; o.x = pk2(sp[0 * 65], sp[1 * 65]); o.y = pk2(sp[2 * 65], sp[3 * 65]); o.z = pk2(sp[4 * 65], sp[5 * 65]); o.w = pk2(sp[6 * 65], sp[7 * 65]);
            *(u32x4*)(WT + (size_t)(nb * 64 + nn) * K + k0 + 8 * c) = o;
        }
        LDS_WAIT();
    }
}
__device__ __forceinline__ void convert_ffn_weights(const P& p, int layer, int which, LAS unsigned char* lds, const float* shift, float* cvo) {
    const float* wgu = p.in[which == 0 ? 13 : 15] + (size_t)layer * 1024 * 5632;
    const float* wdn = p.in[which == 0 ? 14 : 16] + (size_t)layer * 2816 * 1024;
    transpose_w<1>(wgu, 5632, 5632, 1024, (bf16*)(p.ws + W_GU), 5632, lds, shift, cvo, 5632);
    transpose_w<0>(wdn, 1024, 1024, 2816, (bf16*)(p.ws + W_DOWN), 1024, lds, nullptr, nullptr, 0, 176);
}
__device__ __forceinline__ void build_lora_w(const P& p) {
    bf16* WT = (bf16*)(p.ws + W_LORA);
    const float* w_up = p.in[21]; const float* a_up = p.in[23]; const float* g_up = p.in[24];
    for (int idx = blockIdx.x * NTHREADS + tid_opaque(); idx < 2560 * 384; idx += gridDim.x * NTHREADS) {
        const int n = idx / 384, k = idx % 384, seg = n >> 9, c = n & 511;
        float v = 0.f;
        if (seg == 0) { if (k < 64) v = w_up[(0 * 64 + k) * 512 + c]; }
        else if (seg == 1) { if (k >= 64 && k < 128) v = w_up[(1 * 64 + k - 64) * 512 + c]; }
        else if (seg == 2) { if (k >= 128 && k < 192) v = a_up[(0 * 64 + k - 128) * 512 + c]; }
        else if (seg == 3) { if (k >= 192 && k < 256) v = a_up[(1 * 64 + k - 192) * 512 + c]; }
        else { if (k >= 256) v = g_up[(k - 256) * 512 + c]; }
        WT[(size_t)n * 384 + k] = (bf16)(pk2(v, 0.f) & 0xffffu);
    }
}

__device__ __forceinline__ void ph_lora_in(const P& p) {
    const int tid = tid_opaque(), lane = tid & 63, wave = tid >> 6;
    const bf16* p0 = (const bf16*)(p.ws + WS_R1); bf16* LA = (bf16*)(p.ws + WS_H);
    const float* mu = p.in[19];
    const int nw = gridDim.x * 8;
    float m0[3], m1[3];
#pragma unroll
    for (int ch = 0; ch < 3; ++ch) { m0[ch] = mu[1536 + ch * 128 + lane * 2]; m1[ch] = mu[1536 + ch * 128 + lane * 2 + 1]; }
    for (int row0 = blockIdx.x * 8 + wave; row0 < M_TOK; row0 += 4 * nw) {
        unsigned cur[4][3], prv[4][3], nxt[4][3];
#pragma unroll
        for (int r = 0; r < 4; ++r) {
            const int row = (row0 + r * nw) < M_TOK ? (row0 + r * nw) : (M_TOK - 1);
            const int t = row < MP ? (row & 255) : ((row - MP) & 1023), L = row < MP ? 256 : 1024;
            const bool hp = t > 0, hn = t < L - 1;
#pragma unroll
            for (int ch = 0; ch < 3; ++ch) {
                const bf16* pc = p0 + (size_t)row * LDP0 + 1536 + ch * 128 + lane * 2;
                cur[r][ch] = *(const unsigned*)pc; prv[r][ch] = hp ? *(const unsigned*)(pc - LDP0) : 0u; nxt[r][ch] = hn ? *(const unsigned*)(pc + LDP0) : 0u;
            }
        }
#pragma unroll
        for (int r = 0; r < 4; ++r) {
            const int row = row0 + r * nw; if (row >= M_TOK) break;
#pragma unroll
            for (int ch = 0; ch < 3; ++ch) {
                float a0 = bflo(cur[r][ch]) + m0[ch] * (0.5f * (bflo(prv[r][ch]) + bflo(nxt[r][ch])) - bflo(cur[r][ch]));
                float a1 = bfhi(cur[r][ch]) + m1[ch] * (0.5f * (bfhi(prv[r][ch]) + bfhi(nxt[r][ch])) - bfhi(cur[r][ch]));
                if (ch == 0) { a0 = tanhf(a0); a1 = tanhf(a1); }
                if (ch == 2) { a0 = sigmoidf_(a0); a1 = sigmoidf_(a1); }
                *(unsigned*)(LA + (size_t)row * 384 + ch * 128 + lane * 2) = pk2(a0, a1);
            }
        }
    }
}

__device__ __forceinline__ void rwkv_item(const P& p, LAS unsigned char* lds, int kind, int b, int head, int dir) {
    constexpr int T = 32, NG = 8, GS = 1408;
    LAS float* grp = (LAS float*)lds;
    LAS float* raw = grp + 2 * NG * GS;
    LAS float* ybR = raw + T * 320;
    const int tid = tid_opaque(), lane = tid & 63, wave = tid >> 6, q = lane & 7, vl = lane >> 3, r0 = wave * 8 + vl;
    const int tt = tid >> 4, cgi = tid & 15;
    const int L = kind ? 1024 : 256, nblk = L / T;
    const int rowbase = kind ? MP + b * 1024 : b * 256;
    const bf16* p0 = (const bf16*)(p.ws + WS_R1);
    const bf16* lo = (const bf16*)(p.ws + WS_R2);
    bf16* Y = (bf16*)(p.ws + (dir == 0 ? WS_MIX : WS_H));
    const int colbase = head * 64;
    f32x2 S[4];
#pragma unroll
    for (int i = 0; i < 4; ++i) S[i] = (f32x2){0.f, 0.f};
    if (kind) { const float* s0 = p.in[2] + (((size_t)b * 2 + dir) * 8 + head) * 4096 + q * 8;
        const f32x4 a0 = *(const f32x4*)(s0 + r0 * 64), a1 = *(const f32x4*)(s0 + r0 * 64 + 4);
        S[0] = (f32x2){a0.x, a0.y}; S[1] = (f32x2){a0.z, a0.w}; S[2] = (f32x2){a1.x, a1.y}; S[3] = (f32x2){a1.z, a1.w}; }
    const int C = head * 64 + cgi * 4;
    const f32x4 cA = *(const f32x4*)(p.in[19] + C), cB = *(const f32x4*)(p.in[19] + 512 + C), cC = *(const f32x4*)(p.in[19] + 1024 + C);
    const f32x4 cD = *(const f32x4*)(p.in[25] + C), cE = *(const f32x4*)(p.in[26] + C);
    u32x2 ra0, ra1, ra2, rb0, rb1, rb2, rc0, rc1, rc2, rd, re;
    const u32x2 z2 = {0u, 0u};
#define RW_LOAD(blk) do { \
        const int n_ = (blk) * T + tt, t_ = dir ? L - 1 - n_ : n_; const size_t row_ = (size_t)(rowbase + t_); \
        const bool hp_ = t_ > 0, hn_ = t_ < L - 1; \
        const bf16* pr_ = p0 + row_ * LDP0 + head * 64 + cgi * 4; \
        ra1 = *(const u32x2*)pr_; ra0 = hp_ ? *(const u32x2*)(pr_ - LDP0) : z2; ra2 = hn_ ? *(const u32x2*)(pr_ + LDP0) : z2; \
        rb1 = *(const u32x2*)(pr_ + 512); rb0 = hp_ ? *(const u32x2*)(pr_ + 512 - LDP0) : z2; rb2 = hn_ ? *(const u32x2*)(pr_ + 512 + LDP0) : z2; \
        rc1 = *(const u32x2*)(pr_ + 1024); rc0 = hp_ ? *(const u32x2*)(pr_ + 1024 - LDP0) : z2; rc2 = hn_ ? *(const u32x2*)(pr_ + 1024 + LDP0) : z2; \
        rd = *(const u32x2*)(lo + row_ * 2560 + dir * 512 + head * 64 + cgi * 4); re = *(const u32x2*)(lo + row_ * 2560 + 1024 + dir * 512 + head * 64 + cgi * 4); \
    } while (0)
#define RW_PREP1(bi) do { \
        LAS float* rw_ = raw + tt * 320; const int c4_ = cgi * 4; \
        const f32x4 r1_ = unpk4(ra1), k1_ = unpk4(rb1), v1_ = unpk4(rc1); \
        const f32x4 r_ = r1_ + cA * ((unpk4(ra0) + unpk4(ra2)) * 0.5f - r1_); \
        const f32x4 k_ = k1_ + cB * ((unpk4(rb0) + unpk4(rb2)) * 0.5f - k1_); \
        const f32x4 v_ = v1_ + cC * ((unpk4(rc0) + unpk4(rc2)) * 0.5f - v1_); \
        f32x4 kk_ = k_ * cD; \
        const float ss_ = red16(kk_.x * kk_.x + kk_.y * kk_.y + kk_.z * kk_.z + kk_.w * kk_.w); \
        kk_ = kk_ * rsqrtf_(ss_ + 1e-6f); \
        const f32x4 ew_ = unpk4(rd), a_ = unpk4(re); \
        f32x4 w_; w_.x = __expf(-ew_.x); w_.y = __expf(-ew_.y); w_.z = __expf(-ew_.z); w_.w = __expf(-ew_.w); \
        *(LAS f32x4*)(rw_ + c4_) = kk_; *(LAS f32x4*)(rw_ + 64 + c4_) = w_; *(LAS f32x4*)(rw_ + 128 + c4_) = kk_ * a_; \
        *(LAS f32x4*)(rw_ + 192 + c4_) = k_ * ((a_ - 1.0f) * cE + 1.0f); *(LAS f32x4*)(rw_ + 256 + c4_) = r_; \
        *(LAS f32x4*)(grp + ((bi) * NG + (tt >> 2)) * GS + 1088 + (tt & 3) * 64 + c4_) = v_; \
    } while (0)
#define DOT16(aa_, bb_) red16((aa_)[0] * (bb_)[0] + (aa_)[1] * (bb_)[1] + (aa_)[2] * (bb_)[2] + (aa_)[3] * (bb_)[3])
#define RW_PREP2(bi) do { if (tid < 128) { \
        const int gq_ = tid >> 4, c4_ = cgi * 4; const LAS float* r4_ = raw + gq_ * 4 * 320 + c4_; LAS float* gi_ = grp + ((bi) * NG + gq_) * GS; \
        const f32x4 kk1 = *(const LAS f32x4*)(r4_), w1 = *(const LAS f32x4*)(r4_ + 64), b1 = *(const LAS f32x4*)(r4_ + 128), d1 = *(const LAS f32x4*)(r4_ + 192), q1 = *(const LAS f32x4*)(r4_ + 256); \
        const f32x4 kk2 = *(const LAS f32x4*)(r4_ + 320), w2 = *(const LAS f32x4*)(r4_ + 384), b2 = *(const LAS f32x4*)(r4_ + 448), d2 = *(const LAS f32x4*)(r4_ + 512), q2 = *(const LAS f32x4*)(r4_ + 576); \
        const f32x4 kk3 = *(const LAS f32x4*)(r4_ + 640), w3 = *(const LAS f32x4*)(r4_ + 704), b3 = *(const LAS f32x4*)(r4_ + 768), d3 = *(const LAS f32x4*)(r4_ + 832), q3 = *(const LAS f32x4*)(r4_ + 896); \
        const f32x4 kk4 = *(const LAS f32x4*)(r4_ + 960), w4 = *(const LAS f32x4*)(r4_ + 1024), b4 = *(const LAS f32x4*)(r4_ + 1088), d4 = *(const LAS f32x4*)(r4_ + 1152), q4 = *(const LAS f32x4*)(r4_ + 1216); \
        const f32x4 W02 = w1 * w2, W03 = W02 * w3, W04 = W03 * w4, W13 = w2 * w3, W14 = W13 * w4, W24 = w3 * w4; \
        *(LAS f32x4*)(gi_ + c4_) = kk1; *(LAS f32x4*)(gi_ + 64 + c4_) = w1 * kk2; *(LAS f32x4*)(gi_ + 128 + c4_) = W02 * kk3; *(LAS f32x4*)(gi_ + 192 + c4_) = W03 * kk4; \
        *(LAS f32x4*)(gi_ + 256 + c4_) = w1 * q1; *(LAS f32x4*)(gi_ + 320 + c4_) = W02 * q2; *(LAS f32x4*)(gi_ + 384 + c4_) = W03 * q3; *(LAS f32x4*)(gi_ + 448 + c4_) = W04 * q4; \
        *(LAS f32x4*)(gi_ + 512 + c4_) = d1 * W14; *(LAS f32x4*)(gi_ + 576 + c4_) = d2 * W24; *(LAS f32x4*)(gi_ + 640 + c4_) = d3 * w4; *(LAS f32x4*)(gi_ + 704 + c4_) = d4; \
        *(LAS f32x4*)(gi_ + 768 + c4_) = b1 * W14; *(LAS f32x4*)(gi_ + 832 + c4_) = b2 * W24; *(LAS f32x4*)(gi_ + 896 + c4_) = b3 * w4; *(LAS f32x4*)(gi_ + 960 + c4_) = b4; \
        *(LAS f32x4*)(gi_ + 1024 + c4_) = W04; \
        const f32x4 d1w2 = d1 * w2, d1w13 = d1 * W13, d1w14 = d1 * W14, d2w3 = d2 * w3, d2w24 = d2 * W24, d3w4 = d3 * w4; \
        const f32x4 b1w2 = b1 * w2, b1w13 = b1 * W13, b1w14 = b1 * W14, b2w3 = b2 * w3, b2w24 = b2 * W24, b3w4 = b3 * w4; \
        float sc_[32]; \
        sc_[0] = DOT16(d1, kk2); sc_[1] = DOT16(d1w2, kk3); sc_[2] = DOT16(d2, kk3); sc_[3] = DOT16(d1w13, kk4); sc_[4] = DOT16(d2w3, kk4); sc_[5] = DOT16(d3, kk4); \
        sc_[6] = DOT16(b1, kk2); sc_[7] = DOT16(b1w2, kk3); sc_[8] = DOT16(b2, kk3); sc_[9] = DOT16(b1w13, kk4); sc_[10] = DOT16(b2w3, kk4); sc_[11] = DOT16(b3, kk4); \
        sc_[12] = DOT16(d1, q1); sc_[13] = DOT16(d1w2, q2); sc_[14] = DOT16(d2, q2); sc_[15] = DOT16(d1w13, q3); sc_[16] = DOT16(d2w3, q3); sc_[17] = DOT16(d3, q3); \
        sc_[18] = DOT16(d1w14, q4); sc_[19] = DOT16(d2w24, q4); sc_[20] = DOT16(d3w4, q4); sc_[21] = DOT16(d4, q4); \
        sc_[22] = DOT16(b1, q1); sc_[23] = DOT16(b1w2, q2); sc_[24] = DOT16(b2, q2); sc_[25] = DOT16(b1w13, q3); sc_[26] = DOT16(b2w3, q3); sc_[27] = DOT16(b3, q3); \
        sc_[28] = DOT16(b1w14, q4); sc_[29] = DOT16(b2w24, q4); sc_[30] = DOT16(b3w4, q4); sc_[31] = DOT16(b4, q4); \
        if (cgi < 8) { _Pragma("unroll") for (int i_ = 0; i_ < 8; ++i_) if (cgi == i_) *(LAS f32x4*)(gi_ + 1344 + 4 * i_) = (f32x4){sc_[4 * i_], sc_[4 * i_ + 1], sc_[4 * i_ + 2], sc_[4 * i_ + 3]}; } \
    } } while (0)
    __syncthreads();
    RW_LOAD(0); RW_PREP1(0);
    __syncthreads();
    RW_PREP2(0);
    __syncthreads();
#pragma unroll 1
    for (int blk = 0; blk < nblk; ++blk) {
        const int bi = blk & 1;
        if (blk + 1 < nblk) RW_LOAD(blk + 1);
        LAS float* yb = ybR + bi * T * 64;
#pragma unroll 1
        for (int g = 0; g < NG; ++g) {
            const LAS float* gi = grp + (bi * NG + g) * GS;
            float dp[4], du[4];
#pragma unroll
            for (int t = 0; t < 4; ++t) {
                const f32x4 pa = *(const LAS f32x4*)(gi + t * 64 + q * 8), pb = *(const LAS f32x4*)(gi + t * 64 + q * 8 + 4);
                const f32x4 ua = *(const LAS f32x4*)(gi + 256 + t * 64 + q * 8), ub = *(const LAS f32x4*)(gi + 256 + t * 64 + q * 8 + 4);
                const f32x2 a = __builtin_elementwise_fma(S[0], (f32x2){pa.x, pa.y}, S[1] * (f32x2){pa.z, pa.w}) + __builtin_elementwise_fma(S[2], (f32x2){pb.x, pb.y}, S[3] * (f32x2){pb.z, pb.w});
                const f32x2 c = __builtin_elementwise_fma(S[0], (f32x2){ua.x, ua.y}, S[1] * (f32x2){ua.z, ua.w}) + __builtin_elementwise_fma(S[2], (f32x2){ub.x, ub.y}, S[3] * (f32x2){ub.z, ub.w});
                dp[t] = a.x + a.y; du[t] = c.x + c.y;
            }
#pragma unroll
            for (int t = 0; t < 4; ++t) { dp[t] = red8(dp[t]); du[t] = red8(du[t]); }
            const float v1 = gi[1088 + r0], v2 = gi[1152 + r0], v3 = gi[1216 + r0], v4 = gi[1280 + r0];
            const f32x4 A0 = *(const LAS f32x4*)(gi + 1344), A1 = *(const LAS f32x4*)(gi + 1348), B0 = *(const LAS f32x4*)(gi + 1352), E0 = *(const LAS f32x4*)(gi + 1356);
            const f32x4 E1 = *(const LAS f32x4*)(gi + 1360), E2 = *(const LAS f32x4*)(gi + 1364), F0 = *(const LAS f32x4*)(gi + 1368), F1 = *(const LAS f32x4*)(gi + 1372);
            const float g1 = dp[0];
            const float g2 = dp[1] + v1 * A0.x - g1 * A1.z;
            const float g3 = dp[2] + v1 * A0.y + v2 * A0.z - g1 * A1.w - g2 * B0.x;
            const float g4 = dp[3] + v1 * A0.w + v2 * A1.x + v3 * A1.y - g1 * B0.y - g2 * B0.z - g3 * B0.w;
            const float y1 = du[0] + v1 * E0.x - g1 * E2.z;
            const float y2 = du[1] + v1 * E0.y + v2 * E0.z - g1 * E2.w - g2 * F0.x;
            const float y3 = du[2] + v1 * E0.w + v2 * E1.x + v3 * E1.y - g1 * F0.y - g2 * F0.z - g3 * F0.w;
            const float y4 = du[3] + v1 * E1.z + v2 * E1.w + v3 * E2.x + v4 * E2.y - g1 * F1.x - g2 * F1.y - g3 * F1.z - g4 * F1.w;
            if (q == 0) { yb[(4 * g) * 64 + r0] = y1; yb[(4 * g + 1) * 64 + r0] = y2; yb[(4 * g + 2) * 64 + r0] = y3; yb[(4 * g + 3) * 64 + r0] = y4; }
            {
                const f32x4 wa = *(const LAS f32x4*)(gi + 1024 + q * 8), wb = *(const LAS f32x4*)(gi + 1024 + q * 8 + 4);
                f32x2 n0 = S[0] * (f32x2){wa.x, wa.y}, n1 = S[1] * (f32x2){wa.z, wa.w}, n2 = S[2] * (f32x2){wb.x, wb.y}, n3 = S[3] * (f32x2){wb.z, wb.w};
                const float vv[4] = {v1, v2, v3, v4}, gg[4] = {g1, g2, g3, g4};
#pragma unroll
                for (int j = 0; j < 4; ++j) {
                    const f32x4 da = *(const LAS f32x4*)(gi + 512 + j * 64 + q * 8), db = *(const LAS f32x4*)(gi + 512 + j * 64 + q * 8 + 4);
                    const f32x4 ba = *(const LAS f32x4*)(gi + 768 + j * 64 + q * 8), bb = *(const LAS f32x4*)(gi + 768 + j * 64 + q * 8 + 4);
                    const f32x2 vj = {vv[j], vv[j]}, ng = {-gg[j], -gg[j]};
                    n0 = __builtin_elementwise_fma(vj, (f32x2){da.x, da.y}, n0); n1 = __builtin_elementwise_fma(vj, (f32x2){da.z, da.w}, n1);
                    n2 = __builtin_elementwise_fma(vj, (f32x2){db.x, db.y}, n2); n3 = __builtin_elementwise_fma(vj, (f32x2){db.z, db.w}, n3);
                    n0 = __builtin_elementwise_fma(ng, (f32x2){ba.x, ba.y}, n0); n1 = __builtin_elementwise_fma(ng, (f32x2){ba.z, ba.w}, n1);
                    n2 = __builtin_elementwise_fma(ng, (f32x2){bb.x, bb.y}, n2); n3 = __builtin_elementwise_fma(ng, (f32x2){bb.z, bb.w}, n3);
                }
                S[0] = n0; S[1] = n1; S[2] = n2; S[3] = n3;
            }
        }
        if (blk + 1 < nblk) RW_PREP1(bi ^ 1);
        __syncthreads();
        if (blk + 1 < nblk) RW_PREP2(bi ^ 1);
        {
            const int r4 = cgi * 4, n = blk * T + tt, tk = dir ? L - 1 - n : n;
            const f32x4 yv = *(const LAS f32x4*)(yb + tt * 64 + r4);
            *(u32x2*)(Y + (size_t)(rowbase + tk) * 1024 + colbase + r4) = pk4(yv);
        }
        __syncthreads();
    }
#undef RW_LOAD
#undef RW_PREP1
#undef RW_PREP2
#undef DOT16
    if (!kind) { float* so = p.out + OUT_SRW + (((size_t)b * 2 + dir) * 8 + head) * 4096 + q * 8;
        *(f32x4*)(so + r0 * 64) = (f32x4){S[0].x, S[0].y, S[1].x, S[1].y}; *(f32x4*)(so + r0 * 64 + 4) = (f32x4){S[2].x, S[2].y, S[3].x, S[3].y}; }
}

__device__ __forceinline__ void gdn_item(const P& p, LAS unsigned char* lds, int kind, int b, int head, int dir, int half) {
    LAS bf16* Qs = (LAS bf16*)(lds);
    LAS bf16* Ks = (LAS bf16*)(lds + 17408);
    LAS bf16* KT = (LAS bf16*)(lds + 34816);
    LAS bf16* VT = (LAS bf16*)(lds + 53248);
    LAS bf16* ST = (LAS bf16*)(lds + 62464);
    LAS float* Lm = (LAS float*)(lds + 79872);
    LAS bf16* vnT = (LAS bf16*)(lds + 79872);
    LAS bf16* vnsT = (LAS bf16*)(lds + 79872 + 9216);
    LAS float* Tm = (LAS float*)(lds + 98304);
    LAS bf16* Tb = (LAS bf16*)(lds + 115712);
    LAS bf16* QKg = (LAS bf16*)(lds + 124928);
    LAS bf16* rT = (LAS bf16*)(lds + 134144);
    LAS float* gs = (LAS float*)(lds + 143360);
    LAS float* bs = gs + 64;
    LAS float* Gs = gs + 128;
    LAS float* eGs = gs + 192;
    LAS float* eGl = gs + 256;
    LAS float* misc = gs + 320;
    LAS float* CW = (LAS float*)(lds + 144896);
    LAS float* Ysc = (LAS float*)(lds + 148736);
    const int tid = tid_opaque(), lane = tid & 63, wave = tid >> 6, ln = lane & 15, h4 = lane >> 4;
    const int L = kind ? 1024 : 256, nch = L / 64, rowbase = kind ? MP + b * 1024 : b * 256;
    const bf16* p0 = (const bf16*)(p.ws + WS_R1);
    bf16* Y = (bf16*)(p.ws + (dir == 0 ? WS_MIX : WS_H));
    const int colbase = 512 + head * 128 + half * 64;
    const int pi = tid >> 3, c8 = tid & 7;
    const float gA = -expf(p.in[31][dir * 4 + head]), gB = p.in[32][dir * 4 + head];
    __syncthreads();
    for (int e = tid; e < 960; e += NTHREADS) {
        float v;
        if (e < 768) { const int part = e / 384, r = e % 384, tap = r >> 7, d = r & 127; v = p.in[30][tap * 1536 + part * 512 + head * 128 + d]; }
        else { const int r = e - 768, tap = r >> 6, c = r & 63; v = p.in[30][tap * 1536 + 1024 + head * 128 + half * 64 + c]; }
        CW[e] = v;
    }
    for (int e = tid; e < 64 * 72 / 2; e += NTHREADS) { ((LAS unsigned*)Tb)[e] = 0u; ((LAS unsigned*)QKg)[e] = 0u; }
    f32x4 accS[4];
#pragma unroll
    for (int vt = 0; vt < 4; ++vt) {
        accS[vt] = (f32x4){0.f, 0.f, 0.f, 0.f};
        if (kind) { const float* s0 = p.in[3] + (((size_t)b * 2 + dir) * 4 + head) * 16384 + half * 64 + vt * 16 + ln;
#pragma unroll
            for (int r = 0; r < 4; ++r) accS[vt][r] = s0[(size_t)(wave * 16 + h4 * 4 + r) * 128]; }
        *(LAS u32x2*)(ST + (vt * 16 + ln) * 136 + wave * 16 + h4 * 4) = pk4(accS[vt]);
    }
    u32x4 rq[3][2], rk[3][2], rv[3]; unsigned rab = 0u, rbb = 0u;
    const u32x4 z4 = {0u, 0u, 0u, 0u};
#define GD_LOAD(n) do { \
        const int i_ = (n) * 64 + pi, t_ = dir ? L - 1 - i_ : i_; const size_t row_ = (size_t)(rowbase + t_); \
        const bf16* pr_ = p0 + row_ * LDP0 + 1920 + head * 128 + c8 * 16; \
        const bf16* pv_ = p0 + row_ * LDP0 + 1920 + 1024 + head * 128 + half * 64 + c8 * 8; \
        _Pragma("unroll") for (int j_ = 0; j_ < 3; ++j_) { \
            const bool ok_ = (j_ == 1) || (j_ == 0 ? t_ > 0 : t_ < L - 1); const long o_ = (long)(j_ - 1) * LDP0; \
            rq[j_][0] = ok_ ? *(const u32x4*)(pr_ + o_) : z4; rq[j_][1] = ok_ ? *(const u32x4*)(pr_ + o_ + 8) : z4; \
            rk[j_][0] = ok_ ? *(const u32x4*)(pr_ + o_ + 512) : z4; rk[j_][1] = ok_ ? *(const u32x4*)(pr_ + o_ + 520) : z4; \
            rv[j_] = ok_ ? *(const u32x4*)(pv_ + o_) : z4; } \
        rab = p0[row_ * LDP0 + 3968 + dir * 8 + head]; rbb = p0[row_ * LDP0 + 3968 + dir * 8 + 4 + head]; \
    } while (0)
    GD_LOAD(0);
    __syncthreads();
#pragma unroll 1
    for (int n = 0; n < nch; ++n) {
        {
            const int pis = (((pi >> 3) ^ c8) << 3) | (pi & 7);
            {
                float xq[16]; float sq = 0.f;
#pragma unroll
                for (int e = 0; e < 16; ++e) { const int d = c8 * 16 + e; const int wi = e >> 1, hi = e & 1, vi = wi >> 2, ci = wi & 3;
                    const float q0 = hi ? bfhi(rq[0][vi][ci]) : bflo(rq[0][vi][ci]), q1 = hi ? bfhi(rq[1][vi][ci]) : bflo(rq[1][vi][ci]), q2 = hi ? bfhi(rq[2][vi][ci]) : bflo(rq[2][vi][ci]);
                    const float a = CW[d] * q0 + CW[128 + d] * q1 + CW[256 + d] * q2;
                    xq[e] = siluf_(a); sq += xq[e] * xq[e]; }
                sq = red8(sq);
                const float nq = 0.08838834764831845f * rsqrtf_(sq + 1e-6f);
                u32x4 w0, w1;
                w0.x = pk2(xq[0] * nq, xq[1] * nq); w0.y = pk2(xq[2] * nq, xq[3] * nq); w0.z = pk2(xq[4] * nq, xq[5] * nq); w0.w = pk2(xq[6] * nq, xq[7] * nq);
                w1.x = pk2(xq[8] * nq, xq[9] * nq); w1.y = pk2(xq[10] * nq, xq[11] * nq); w1.z = pk2(xq[12] * nq, xq[13] * nq); w1.w = pk2(xq[14] * nq, xq[15] * nq);
                *(LAS u32x4*)(Qs + pi * 136 + c8 * 16) = w0; *(LAS u32x4*)(Qs + pi * 136 + c8 * 16 + 8) = w1;
            }
            {
                float xk[16]; float sk = 0.f;
#pragma unroll
                for (int e = 0; e < 16; ++e) { const int d = c8 * 16 + e; const int wi = e >> 1, hi = e & 1, vi = wi >> 2, ci = wi & 3;
                    const float k0 = hi ? bfhi(rk[0][vi][ci]) : bflo(rk[0][vi][ci]), k1 = hi ? bfhi(rk[1][vi][ci]) : bflo(rk[1][vi][ci]), k2 = hi ? bfhi(rk[2][vi][ci]) : bflo(rk[2][vi][ci]);
                    const float c = CW[384 + d] * k0 + CW[512 + d] * k1 + CW[640 + d] * k2;
                    xk[e] = siluf_(c); sk += xk[e] * xk[e]; }
                sk = red8(sk);
                const float nk = rsqrtf_(sk + 1e-6f);
                u32x4 w0, w1;
                w0.x = pk2(xk[0] * nk, xk[1] * nk); w0.y = pk2(xk[2] * nk, xk[3] * nk); w0.z = pk2(xk[4] * nk, xk[5] * nk); w0.w = pk2(xk[6] * nk, xk[7] * nk);
                w1.x = pk2(xk[8] * nk, xk[9] * nk); w1.y = pk2(xk[10] * nk, xk[11] * nk); w1.z = pk2(xk[12] * nk, xk[13] * nk); w1.w = pk2(xk[14] * nk, xk[15] * nk);
                *(LAS u32x4*)(Ks + pi * 136 + c8 * 16) = w0; *(LAS u32x4*)(Ks + pi * 136 + c8 * 16 + 8) = w1;
#pragma unroll
                for (int e = 0; e < 4; ++e) {
                    KT[(c8 * 16 + 2 * e) * 72 + pis] = (bf16)(w0[e] & 0xffffu); KT[(c8 * 16 + 2 * e + 1) * 72 + pis] = (bf16)(w0[e] >> 16);
                    KT[(c8 * 16 + 8 + 2 * e) * 72 + pis] = (bf16)(w1[e] & 0xffffu); KT[(c8 * 16 + 8 + 2 * e + 1) * 72 + pis] = (bf16)(w1[e] >> 16); }
            }
#pragma unroll
            for (int e = 0; e < 8; ++e) { const int c = c8 * 8 + e; const int wi = e >> 1, hi = e & 1;
                const float v0 = hi ? bfhi(rv[0][wi]) : bflo(rv[0][wi]), v1 = hi ? bfhi(rv[1][wi]) : bflo(rv[1][wi]), v2 = hi ? bfhi(rv[2][wi]) : bflo(rv[2][wi]);
                const float a = CW[768 + c] * v0 + CW[832 + c] * v1 + CW[896 + c] * v2;
                VT[c * 72 + pis] = (bf16)(pk2(siluf_(a), 0.f) & 0xffffu); }
            if (c8 == 0) { const float xa = bf2f(rab) + gB; const float sp = xa > 20.f ? xa : log1pf(expf(xa)); gs[pi] = gA * sp; bs[pi] = 1.0f / (1.0f + expf(-bf2f(rbb))); }
        }
        __syncthreads();
        if (n + 1 < nch) GD_LOAD(n + 1);
        if (wave == 0) {
            float x = gs[lane];
            x += DPPF(x, 0x111); x += DPPF(x, 0x112); x += DPPF(x, 0x114); x += DPPF(x, 0x118);
            const int xi = __float_as_int(x);
            const float t0 = __int_as_float(__builtin_amdgcn_readlane(xi, 15)), t1 = __int_as_float(__builtin_amdgcn_readlane(xi, 31)), t2 = __int_as_float(__builtin_amdgcn_readlane(xi, 47));
            x += (lane >= 48) ? (t0 + t1 + t2) : ((lane >= 32) ? (t0 + t1) : ((lane >= 16) ? t0 : 0.f));
            const float Gl = __int_as_float(__builtin_amdgcn_readlane(__float_as_int(x), 63));
            Gs[lane] = x; eGs[lane] = __expf(x); eGl[lane] = __expf(Gl - x); if (lane == 0) misc[0] = __expf(Gl);
        }
        __syncthreads();
#pragma unroll 1
        for (int tix = wave; tix < 20; tix += 8) {
            const int x = tix < 10 ? tix : tix - 10;
            const int it = x >= 6 ? 3 : (x >= 3 ? 2 : (x >= 1 ? 1 : 0)), jt = x - (it * (it + 1)) / 2;
            f32x4 a = {0.f, 0.f, 0.f, 0.f};
            if (tix < 10) {
#pragma unroll
                for (int s = 0; s < 4; ++s) a = __builtin_amdgcn_mfma_f32_16x16x32_bf16(*(const LAS s16x8*)(Ks + (16 * it + ln) * 136 + 32 * s + 8 * h4), *(const LAS s16x8*)(Ks + (16 * jt + ln) * 136 + 32 * s + 8 * h4), a, 0, 0, 0);
                const int j = 16 * jt + ln; const float Gj = Gs[j];
#pragma unroll
                for (int r = 0; r < 4; ++r) { const int i = 16 * it + 4 * h4 + r; Lm[i * 72 + j] = i > j ? bs[i] * a[r] * __expf(Gs[i] - Gj) : 0.f; }
            } else {
#pragma unroll
                for (int s = 0; s < 4; ++s) a = __builtin_amdgcn_mfma_f32_16x16x32_bf16(*(const LAS s16x8*)(Ks + (16 * jt + ln) * 136 + 32 * s + 8 * h4), *(const LAS s16x8*)(Qs + (16 * it + ln) * 136 + 32 * s + 8 * h4), a, 0, 0, 0);
                const int i = 16 * it + ln; const float Gi = Gs[i]; f32x4 o;
#pragma unroll
                for (int r = 0; r < 4; ++r) { const int j = 16 * jt + 4 * h4 + r; o[r] = i >= j ? a[r] * __expf(Gi - Gs[j]) : 0.f; }
                *(LAS u32x2*)(QKg + i * 72 + 16 * jt + 4 * h4) = pk4(o);
            }
        }
        __syncthreads();
        if (wave == 0) {
            const int a = h4, c = ln; float xr[16];
#pragma unroll
            for (int r = 0; r < 16; ++r) { float s = (r == c) ? 1.0f : 0.0f;
#pragma unroll
                for (int m = 0; m < r; ++m) s -= Lm[(16 * a + r) * 72 + 16 * a + m] * xr[m];
                xr[r] = s; }
#pragma unroll
            for (int r = 0; r < 16; ++r) { Tm[(16 * a + r) * 68 + 16 * a + c] = xr[r]; Tb[(16 * a + r) * 72 + 16 * a + c] = (bf16)(pk2(xr[r], 0.f) & 0xffffu); }
        } else {
#pragma unroll 1
            for (int tk = wave - 1; tk < 16; tk += 7) {
                const int it = tk >> 2, vt = tk & 3; f32x4 a = {0.f, 0.f, 0.f, 0.f};
#pragma unroll
                for (int s = 0; s < 4; ++s) a = __builtin_amdgcn_mfma_f32_16x16x32_bf16(*(const LAS s16x8*)(Ks + (16 * it + ln) * 136 + 32 * s + 8 * h4), *(const LAS s16x8*)(ST + (16 * vt + ln) * 136 + 32 * s + 8 * h4), a, 0, 0, 0);
                const int v = 16 * vt + ln, i0 = 16 * it + 4 * h4;
                const f32x4 vj = unpk4(*(const LAS u32x2*)(VT + v * 72 + ((((i0 >> 3) ^ (v >> 3)) & 7) << 3) + (i0 & 7))), be = *(const LAS f32x4*)(bs + i0), eg = *(const LAS f32x4*)(eGs + i0);
                *(LAS u32x2*)(rT + v * 72 + i0) = pk4(be * (vj - eg * a));
            }
        }
        __syncthreads();
#pragma unroll 1
        for (int dist = 1; dist < 4; ++dist) {
            if (wave < 4 - dist) {
                const int bb = wave, aa = wave + dist; LAS float* ys = Ysc + wave * 272;
                f32x4 y = {0.f, 0.f, 0.f, 0.f};
                float la[3][4], tb[3][4];
#pragma unroll
                for (int mm = 0; mm < 3; ++mm)
#pragma unroll
                    for (int s = 0; s < 4; ++s) { const int m = bb + (mm < dist ? mm : 0);
                        la[mm][s] = Lm[(16 * aa + ln) * 72 + 16 * m + 4 * s + h4]; tb[mm][s] = Tm[(16 * m + 4 * s + h4) * 68 + 16 * bb + ln]; }
#pragma unroll
                for (int mm = 0; mm < 3; ++mm)
                    if (mm < dist) {
#pragma unroll
                        for (int s = 0; s < 4; ++s) y = __builtin_amdgcn_mfma_f32_16x16x4f32(la[mm][s], tb[mm][s], y, 0, 0, 0); }
#pragma unroll
                for (int r = 0; r < 4; ++r) ys[(4 * h4 + r) * 17 + ln] = y[r];
                f32x4 z = {0.f, 0.f, 0.f, 0.f};
#pragma unroll
                for (int s = 0; s < 4; ++s) z = __builtin_amdgcn_mfma_f32_16x16x4f32(Tm[(16 * aa + ln) * 68 + 16 * aa + 4 * s + h4], ys[(4 * s + h4) * 17 + ln], z, 0, 0, 0);
#pragma unroll
                for (int r = 0; r < 4; ++r) { const int i = 16 * aa + 4 * h4 + r, j = 16 * bb + ln; Tm[i * 68 + j] = -z[r]; Tb[i * 72 + j] = (bf16)(pk2(-z[r], 0.f) & 0xffffu); }
            }
            __syncthreads();
        }
#pragma unroll
        for (int u = 0; u < 2; ++u) {
            const int tile = 2 * wave + u, it = tile >> 2, vt = tile & 3; f32x4 a = {0.f, 0.f, 0.f, 0.f};
            a = __builtin_amdgcn_mfma_f32_16x16x32_bf16(*(const LAS s16x8*)(Tb + (16 * it + ln) * 72 + 8 * h4), *(const LAS s16x8*)(rT + (16 * vt + ln) * 72 + 8 * h4), a, 0, 0, 0);
            if (it >= 2) a = __builtin_amdgcn_mfma_f32_16x16x32_bf16(*(const LAS s16x8*)(Tb + (16 * it + ln) * 72 + 32 + 8 * h4), *(const LAS s16x8*)(rT + (16 * vt + ln) * 72 + 32 + 8 * h4), a, 0, 0, 0);
            const int v = 16 * vt + ln, i0 = 16 * it + 4 * h4;
            *(LAS u32x2*)(vnT + v * 72 + i0) = pk4(a); *(LAS u32x2*)(vnsT + v * 72 + i0) = pk4(a * *(const LAS f32x4*)(eGl + i0));
        }
        __syncthreads();
#pragma unroll
        for (int u = 0; u < 2; ++u) {
            const int tile = 2 * wave + u, vt = tile >> 2, it = tile & 3; f32x4 a = {0.f, 0.f, 0.f, 0.f};
#pragma unroll
            for (int s = 0; s < 4; ++s) a = __builtin_amdgcn_mfma_f32_16x16x32_bf16(*(const LAS s16x8*)(ST + (16 * vt + ln) * 136 + 32 * s + 8 * h4), *(const LAS s16x8*)(Qs + (16 * it + ln) * 136 + 32 * s + 8 * h4), a, 0, 0, 0);
            a = a * eGs[16 * it + ln];
            a = __builtin_amdgcn_mfma_f32_16x16x32_bf16(*(const LAS s16x8*)(vnT + (16 * vt + ln) * 72 + 8 * h4), *(const LAS s16x8*)(QKg + (16 * it + ln) * 72 + 8 * h4), a, 0, 0, 0);
            if (it >= 2) a = __builtin_amdgcn_mfma_f32_16x16x32_bf16(*(const LAS s16x8*)(vnT + (16 * vt + ln) * 72 + 32 + 8 * h4), *(const LAS s16x8*)(QKg + (16 * it + ln) * 72 + 32 + 8 * h4), a, 0, 0, 0);
            const int ic = n * 64 + 16 * it + ln, tk = dir ? L - 1 - ic : ic;
            *(u32x2*)(Y + (size_t)(rowbase + tk) * 1024 + colbase + 16 * vt + 4 * h4) = pk4(a);
        }
        {
            const float egl = misc[0];
#pragma unroll
            for (int vt = 0; vt < 4; ++vt) {
                f32x4 a = accS[vt] * egl;
#pragma unroll
                for (int s = 0; s < 2; ++s) a = __builtin_amdgcn_mfma_f32_16x16x32_bf16(*(const LAS s16x8*)(KT + (16 * wave + ln) * 72 + (((4 * s + h4) ^ wave) << 3)), *(const LAS s16x8*)(vnsT + (16 * vt + ln) * 72 + 32 * s + 8 * h4), a, 0, 0, 0);
                accS[vt] = a;
            }
        }
        __syncthreads();
#pragma unroll
        for (int vt = 0; vt < 4; ++vt) *(LAS u32x2*)(ST + (vt * 16 + ln) * 136 + wave * 16 + h4 * 4) = pk4(accS[vt]);
    }
#undef GD_LOAD
    if (!kind) { float* so = p.out + OUT_SGD + (((size_t)b * 2 + dir) * 4 + head) * 16384 + half * 64;
#pragma unroll
        for (int vt = 0; vt < 4; ++vt)
#pragma unroll
            for (int r = 0; r < 4; ++r) so[(size_t)(wave * 16 + h4 * 4 + r) * 128 + vt * 16 + ln] = accS[vt][r]; }
}
__device__ __forceinline__ void rwkv_idx(const P& p, LAS unsigned char* lds, int i) {
    const int kind = i < 128 ? 1 : 0, j = i < 128 ? i : i - 128;
    rwkv_item(p, lds, kind, j >> 4, (j >> 1) & 7, j & 1);
}
__device__ __forceinline__ void gdn_idx(const P& p, LAS unsigned char* lds, int i) {
    const int kind = i < 128 ? 1 : 0, j = i < 128 ? i : i - 128;
    gdn_item(p, lds, kind, j >> 4, (j >> 2) & 3, (j >> 1) & 1, j & 1);
}
__device__ __forceinline__ void ph_scan(const P& p, LAS unsigned char* lds) {
    const int B = blockIdx.x, G = gridDim.x;
    if (G == 256) {
        if (B < 128) { rwkv_idx(p, lds, B); for (int i = 0; i < 4; ++i) gdn_idx(p, lds, 128 + B * 4 + i); }
        else { gdn_idx(p, lds, B - 128); for (int i = 0; i < 4; ++i) rwkv_idx(p, lds, 128 + (B - 128) * 4 + i); }
    } else {
        for (int i = B; i < 640; i += G) { rwkv_idx(p, lds, i); gdn_idx(p, lds, i); }
    }
}

__device__ __forceinline__ void ph_post_ab(const P& p, bool dummy) {
    const int tid = tid_opaque(), lane = tid & 63, wave = tid >> 6;
    const bf16* p0 = (const bf16*)(p.ws + WS_R1); const bf16* lo = (const bf16*)(p.ws + WS_R2);
    bf16* MX = (bf16*)(p.ws + WS_MIX); const bf16* YB = (const bf16*)(p.ws + WS_H);
    bf16* MO = dummy ? (bf16*)(p.out + OUT_CKV) : MX;
    const int C = lane * 8;
    float mur[8], muk[8], muv[8], ka[8], rk[8], lw[8], lb[8], gn[8];
#pragma unroll
    for (int i = 0; i < 8; ++i) { mur[i] = p.in[19][C + i]; muk[i] = p.in[19][512 + C + i]; muv[i] = p.in[19][1024 + C + i]; ka[i] = p.in[26][C + i]; rk[i] = p.in[27][C + i];
        lw[i] = p.in[28][C + i]; lb[i] = p.in[29][C + i]; gn[i] = p.in[33][(C + i) & 127]; }
    for (int row = blockIdx.x * 8 + wave; row < M_TOK; row += gridDim.x * 8) {
        const int t = row < MP ? (row & 255) : ((row - MP) & 1023), L = row < MP ? 256 : 1024;
        const bool hp = t > 0, hn = t < L - 1;
        const u32x4 z4 = {0u, 0u, 0u, 0u};
        const bf16* pr = p0 + (size_t)row * LDP0 + C;
        float r[8], k[8], v[8];
        {
            const u32x4 c = *(const u32x4*)pr, a = hp ? *(const u32x4*)(pr - LDP0) : z4, n = hn ? *(const u32x4*)(pr + LDP0) : z4;
#pragma unroll
            for (int i = 0; i < 4; ++i) { float c0 = bflo(c[i]), c1 = bfhi(c[i]); r[2 * i] = c0 + mur[2 * i] * (0.5f * (bflo(a[i]) + bflo(n[i])) - c0); r[2 * i + 1] = c1 + mur[2 * i + 1] * (0.5f * (bfhi(a[i]) + bfhi(n[i])) - c1); }
        }
        {
            const u32x4 c = *(const u32x4*)(pr + 512), a = hp ? *(const u32x4*)(pr + 512 - LDP0) : z4, n = hn ? *(const u32x4*)(pr + 512 + LDP0) : z4;
#pragma unroll
            for (int i = 0; i < 4; ++i) { float c0 = bflo(c[i]), c1 = bfhi(c[i]); k[2 * i] = c0 + muk[2 * i] * (0.5f * (bflo(a[i]) + bflo(n[i])) - c0); k[2 * i + 1] = c1 + muk[2 * i + 1] * (0.5f * (bfhi(a[i]) + bfhi(n[i])) - c1); }
        }
        {
            const u32x4 c = *(const u32x4*)(pr + 1024), a = hp ? *(const u32x4*)(pr + 1024 - LDP0) : z4, n = hn ? *(const u32x4*)(pr + 1024 + LDP0) : z4;
#pragma unroll
            for (int i = 0; i < 4; ++i) { float c0 = bflo(c[i]), c1 = bfhi(c[i]); v[2 * i] = c0 + muv[2 * i] * (0.5f * (bflo(a[i]) + bflo(n[i])) - c0); v[2 * i + 1] = c1 + muv[2 * i + 1] * (0.5f * (bfhi(a[i]) + bfhi(n[i])) - c1); }
        }
        const u32x4 af = *(const u32x4*)(lo + (size_t)row * 2560 + 1024 + C), ab = *(const u32x4*)(lo + (size_t)row * 2560 + 1536 + C), gg = *(const u32x4*)(lo + (size_t)row * 2560 + 2048 + C);
        const u32x4 yf = *(const u32x4*)(MX + (size_t)row * 1024 + C), yb = *(const u32x4*)(YB + (size_t)row * 1024 + C);
        float y[8], s = 0.f, bon = 0.f;
#pragma unroll
        for (int i = 0; i < 4; ++i) {
            y[2 * i] = bflo(yf[i]) + bflo(yb[i]); y[2 * i + 1] = bfhi(yf[i]) + bfhi(yb[i]); s += y[2 * i] + y[2 * i + 1];
            const float am0 = 0.5f * (bflo(af[i]) + bflo(ab[i])), am1 = 0.5f * (bfhi(af[i]) + bfhi(ab[i]));
            bon += r[2 * i] * k[2 * i] * (1.0f + (am0 - 1.0f) * ka[2 * i]) * rk[2 * i] + r[2 * i + 1] * k[2 * i + 1] * (1.0f + (am1 - 1.0f) * ka[2 * i + 1]) * rk[2 * i + 1];
        }
        const float mean = red8(s) * (1.0f / 64.0f); bon = red8(bon);
        float q2 = 0.f;
#pragma unroll
        for (int i = 0; i < 8; ++i) { y[i] -= mean; q2 += y[i] * y[i]; }
        const float rstd = 1.0f / sqrtf(red8(q2) * (1.0f / 64.0f) + 64e-5f);
        u32x4 o;
#pragma unroll
        for (int i = 0; i < 4; ++i) {
            const float o0 = (y[2 * i] * rstd * lw[2 * i] + lb[2 * i] + bon * v[2 * i]) * bflo(gg[i]);
            const float o1 = (y[2 * i + 1] * rstd * lw[2 * i + 1] + lb[2 * i + 1] + bon * v[2 * i + 1]) * bfhi(gg[i]);
            o[i] = pk2(o0, o1);
        }
        const size_t orow = dummy ? (size_t)(row & 4095) : (size_t)row;
        *(u32x4*)(MO + orow * 1024 + C) = o;
        const u32x4 of = *(const u32x4*)(MX + (size_t)row * 1024 + 512 + C), ob = *(const u32x4*)(YB + (size_t)row * 1024 + 512 + C);
        const u32x4 zz = *(const u32x4*)(p0 + (size_t)row * LDP0 + 1920 + 1536 + C);
        float og[8], so = 0.f;
#pragma unroll
        for (int i = 0; i < 4; ++i) { og[2 * i] = bflo(of[i]) + bflo(ob[i]); og[2 * i + 1] = bfhi(of[i]) + bfhi(ob[i]); so += og[2 * i] * og[2 * i] + og[2 * i + 1] * og[2 * i + 1]; }
        const float rs = 1.0f / sqrtf(red16(so) * (1.0f / 128.0f) + 1e-6f);
        u32x4 o2;
#pragma unroll
        for (int i = 0; i < 4; ++i) { const float z0 = bflo(zz[i]), z1 = bfhi(zz[i]);
            o2[i] = pk2(og[2 * i] * rs * gn[2 * i] * siluf_(z0), og[2 * i + 1] * rs * gn[2 * i + 1] * siluf_(z1)); }
        *(u32x4*)(MO + orow * 1024 + 512 + C) = o2;
    }
}

__device__ __forceinline__ void ph_hyena_filters(const P& p, LAS unsigned char* lds) {
    LAS float* f0 = (LAS float*)lds;
    LAS float* h1 = f0 + 32 * 36;
    LAS float* h2 = h1 + 32 * 64;
    LAS bf16* stg = (LAS bf16*)(h2 + 64 * 32);
    LAS float* w1s = h2 + 64 * 32 + 8192;
    LAS float* w2s = w1s + 33 * 64;
    const int tid = tid_opaque();
    const float* b1 = p.in[41]; const float* b2 = p.in[43]; const float* w3 = p.in[44]; const float* fr = p.in[45];
    __syncthreads();
    if (blockIdx.x < 160) {
        for (int e = tid; e < 33 * 64; e += NTHREADS) w1s[e] = p.in[40][e];
        for (int e = tid; e < 64 * 64; e += NTHREADS) w2s[e] = p.in[42][e];
    }
    for (int item4 = blockIdx.x; item4 < 160; item4 += gridDim.x) {
        const int item = item4 >> 2, oo = item4 & 3;
        const int ls = item < 32 ? 1 : 0;
        const int L = ls ? 1024 : 256, t0 = (ls ? item : item - 32) * 32;
        const int o = tid + oo * 512;
        float wreg[16];
#pragma unroll
        for (int f = 0; f < 16; ++f) wreg[f] = w3[f * 2048 + o];
        __syncthreads();
        for (int e = tid; e < 32 * 33; e += NTHREADS) {
            const int pi = e / 33, f = e % 33; const float t = (float)(t0 + pi);
            float v;
            if (f == 0) v = t / (float)(L - 1);
            else { const int bi = (f - 1) & 15; const float band = 1e-4f + (15.0f - 1e-4f) * ((float)bi / 15.0f); const float ang = (6.283185307179586f / (float)L) * t * band; v = f <= 16 ? __cosf(ang) : -__sinf(ang); }
            f0[pi * 36 + f] = v;
        }
        __syncthreads();
        {
            const int j = tid & 63, pq = tid >> 6; const float bj = b1[j], fj = fr[j];
            float sacc[4] = {bj, bj, bj, bj};
#pragma unroll 3
            for (int f = 0; f < 33; ++f) { const float w = w1s[f * 64 + j];
#pragma unroll
                for (int i = 0; i < 4; ++i) sacc[i] += f0[(pq + 8 * i) * 36 + f] * w; }
#pragma unroll
            for (int i = 0; i < 4; ++i) h1[(pq + 8 * i) * 64 + j] = __sinf(fj * sacc[i]);
        }
        __syncthreads();
        {
            const int j = tid & 63, pq = tid >> 6; const float bj = b2[j], fj = fr[64 + j];
            float sacc[4] = {bj, bj, bj, bj};
#pragma unroll 4
            for (int f = 0; f < 64; ++f) { const float w = w2s[f * 64 + j];
#pragma unroll
                for (int i = 0; i < 4; ++i) sacc[i] += h1[(pq + 8 * i) * 64 + f] * w; }
#pragma unroll
            for (int i = 0; i < 4; ++i) h2[j * 32 + pq + 8 * i] = __sinf(fj * sacc[i]);
        }
        __syncthreads();
        bf16* G = (bf16*)(p.ws + (ls ? WS_GFS : WS_GFP));
        {
            const int c = o & 511;
            f32x4 sv[8];
#pragma unroll
            for (int i = 0; i < 8; ++i) sv[i] = (f32x4){0.f, 0.f, 0.f, 0.f};
#pragma unroll
            for (int fq = 0; fq < 4; ++fq) {
                float wn[16];
                if (fq < 3) {
#pragma unroll
                    for (int f = 0; f < 16; ++f) wn[f] = w3[((fq + 1) * 16 + f) * 2048 + o];
                }
#pragma unroll
                for (int f = 0; f < 16; ++f) { const float w = wreg[f]; const LAS f32x4* hp = (const LAS f32x4*)(h2 + (fq * 16 + f) * 32);
#pragma unroll
                    for (int i = 0; i < 8; ++i) sv[i] += hp[i] * w; }
                if (fq < 3) {
#pragma unroll
                    for (int f = 0; f < 16; ++f) wreg[f] = wn[f];
                }
            }
            const float delta = 3.0701134573253944f + (15.350567286626973f - 3.0701134573253944f) * ((float)c / 511.0f);
            const float inv = 1.0f / (float)(L - 1);
#pragma unroll
            for (int i = 0; i < 8; ++i) {
                const float ta = (float)(t0 + 4 * i) * inv, tb = (float)(t0 + 4 * i + 1) * inv, tc = (float)(t0 + 4 * i + 2) * inv, td = (float)(t0 + 4 * i + 3) * inv;
                *(LAS u32x2*)(stg + tid * 32 + 4 * i) = (u32x2){pk2(sv[i].x * __expf(-ta * delta), sv[i].y * __expf(-tb * delta)), pk2(sv[i].z * __expf(-tc * delta), sv[i].w * __expf(-td * delta))};
            }
            __syncthreads();
            const int lane = tid & 63, wv = tid >> 6, pi = lane & 31;
#pragma unroll 4
            for (int r = 0; r < 32; ++r) {
                const int col = wv * 64 + r * 2 + (lane >> 5);
                const int o2 = col + oo * 512, order2 = o2 >> 10, dr2 = (o2 >> 9) & 1, c2 = o2 & 511, t = t0 + pi;
                const bf16 hv = stg[col * 32 + pi];
                bf16* g = G + ((size_t)order2 * 512 + c2) * (2 * L);
                if (dr2 == 0) g[L - t] = hv;
                else if (t > 0) g[L + t] = hv;
                if (dr2 == 0 && t == 0) g[0] = 0;
            }
        }
    }
}

__device__ __forceinline__ void ph_mla_prep(const P& p, LAS unsigned char* lds) {
    const int tid = tid_opaque(), lane = tid & 63, wave = tid >> 6;
    const bf16* p1 = (const bf16*)(p.ws + WS_R1);
    bf16* qn = (bf16*)(p.ws + WS_H); bf16* ckva = (bf16*)(p.ws + WS_CKVA); bf16* kpea = (bf16*)(p.ws + WS_KPEA);
    const float* rope = (const float*)(p.ws + WS_ROPE);
    const float* qg = p.in[35]; const float* kg = p.in[37];
    const int nw = gridDim.x * 8;
    for (int row0 = blockIdx.x * 8 + wave; row0 < M_TOK; row0 += 4 * nw) {
        unsigned qw[4][3], kw[4]; u32x2 vw[4]; float sq[4], sk[4];
#pragma unroll
        for (int r = 0; r < 4; ++r) {
            const int row = (row0 + r * nw) < M_TOK ? (row0 + r * nw) : (M_TOK - 1);
            const bf16* pr = p1 + (size_t)row * LDP1;
#pragma unroll
            for (int j = 0; j < 3; ++j) qw[r][j] = *(const unsigned*)(pr + j * 128 + lane * 2);
            vw[r] = *(const u32x2*)(pr + 384 + lane * 4);
            kw[r] = lane < 16 ? *(const unsigned*)(pr + 640 + lane * 2) : 0u;
        }
#pragma unroll
        for (int r = 0; r < 4; ++r) {
            float s = 0.f;
#pragma unroll
            for (int j = 0; j < 3; ++j) s += bflo(qw[r][j]) * bflo(qw[r][j]) + bfhi(qw[r][j]) * bfhi(qw[r][j]);
            sq[r] = s;
            const f32x4 kv = unpk4(vw[r]); sk[r] = kv.x * kv.x + kv.y * kv.y + kv.z * kv.z + kv.w * kv.w;
        }
#pragma unroll
        for (int o = 1; o < 64; o <<= 1) {
#pragma unroll
            for (int r = 0; r < 4; ++r) { sq[r] += __shfl_xor(sq[r], o); sk[r] += __shfl_xor(sk[r], o); } }
#pragma unroll
        for (int r = 0; r < 4; ++r) {
            const int row = row0 + r * nw; if (row >= M_TOK) break;
            const float rq = rsqrtf_(sq[r] * (1.0f / 384.0f) + 1e-6f), rk = rsqrtf_(sk[r] * (1.0f / 256.0f) + 1e-6f);
#pragma unroll
            for (int j = 0; j < 3; ++j) { const int col = j * 128 + lane * 2; *(unsigned*)(qn + (size_t)row * 384 + col) = pk2(bflo(qw[r][j]) * rq * qg[col], bfhi(qw[r][j]) * rq * qg[col + 1]); }
            const f32x4 ck = unpk4(vw[r]) * rk * *(const f32x4*)(kg + lane * 4);
            *(u32x2*)(ckva + (size_t)row * 256 + lane * 4) = pk4(ck);
            if (row < MP) *(f32x4*)(p.out + OUT_CKV + (size_t)row * 256 + lane * 4) = ck;
            if (lane < 16) {
                float x1 = bflo(kw[r]), x2 = bfhi(kw[r]);
                if (row < MP) { *(f32x2*)(p.out + OUT_KPE + (size_t)row * 32 + lane * 2) = (f32x2){x1, x2}; }
                else { const int tq = (row - MP) & 1023; const f32x2 cs = *(const f32x2*)(rope + (size_t)tq * 32 + lane * 2); const float a = x1 * cs.x - x2 * cs.y, bq = x1 * cs.y + x2 * cs.x; x1 = a; x2 = bq; }
                *(unsigned*)(kpea + (size_t)row * 32 + lane * 2) = pk2(x1, x2);
            }
        }
    }
    for (int r2 = blockIdx.x * 8 + wave; r2 < 2048; r2 += nw) {
        const int row = M_TOK + r2;
        const f32x4 cv = *(const f32x4*)(p.in[4] + (size_t)r2 * 256 + lane * 4);
        *(u32x2*)(ckva + (size_t)row * 256 + lane * 4) = pk4(cv);
        if (lane < 16) { const f32x2 kp = *(const f32x2*)(p.in[5] + (size_t)r2 * 32 + lane * 2); *(unsigned*)(kpea + (size_t)row * 32 + lane * 2) = pk2(kp.x, kp.y); }
    }
    LAS float* tile = (LAS float*)(lds + wave * 8832);
    bf16* HT = (bf16*)(p.ws + WS_HYIN);
    const float* cw = p.in[39];
    for (int it = blockIdx.x * 8 + wave; it < 256 * 48; it += gridDim.x * 8) {
        const int rt = it / 48, cb = it % 48;
        const int r0 = rt * 64, col0 = 672 + cb * 32;
        const int t0 = r0 < MP ? (r0 & 255) : ((r0 - MP) & 1023), L = r0 < MP ? 256 : 1024;
        unsigned wv[17];
#pragma unroll
        for (int i = 0; i < 17; ++i) {
            const int rr = i * 4 + (lane >> 4), tt = t0 - 1 + rr;
            wv[i] = (rr < 66 && tt >= 0 && tt < L) ? *(const unsigned*)(p1 + (size_t)(r0 - 1 + rr) * LDP1 + col0 + (lane & 15) * 2) : 0u;
        }
#pragma unroll
        for (int i = 0; i < 17; ++i) {
            const int rr = i * 4 + (lane >> 4);
            if (rr < 66) { tile[rr * 33 + (lane & 15) * 2] = bflo(wv[i]); tile[rr * 33 + (lane & 15) * 2 + 1] = bfhi(wv[i]); }
        }
        LDS_WAIT();
#pragma unroll 8
        for (int c = 0; c < 32; ++c) {
            const int ch = cb * 32 + c;
            const float v = cw[ch] * tile[lane * 33 + c] + cw[1536 + ch] * tile[(lane + 1) * 33 + c] + cw[3072 + ch] * tile[(lane + 2) * 33 + c];
            HT[(size_t)ch * M_TOK + r0 + lane] = (bf16)(pk2(v, 0.f) & 0xffffu);
        }
        LDS_WAIT();
    }
}

__device__ __forceinline__ void attn_item(const P& p, LAS unsigned char* lds, int kind, int b, int head, int qt) {
    constexpr int TILE_B = 64 * 104 * 2 + 64 * 72 * 2;
    const int tid = tid_opaque(), lane = tid & 63, wave = tid >> 6, ln = lane & 15, h = lane >> 4;
    const bf16* Q = (const bf16*)(p.ws + WS_Q); const bf16* KN = (const bf16*)(p.ws + WS_KV); const bf16* VT = (const bf16*)(p.ws + WS_VT); const bf16* KPE = (const bf16*)(p.ws + WS_KPEA);
    bf16* MX = (bf16*)(p.ws + WS_MIX);
    const int nkeys = kind ? 1280 : 256, rowbase = kind ? MP + b * 1024 : b * 256, ntiles = nkeys / 64;
    const int qrow = rowbase + qt * 128 + wave * 16 + ln;
    s16x8 qf[3];
#pragma unroll
    for (int s = 0; s < 3; ++s) qf[s] = *(const s16x8*)(Q + (size_t)qrow * 768 + head * 96 + 32 * s + 8 * h);
    f32x4 o[4];
#pragma unroll
    for (int i = 0; i < 4; ++i) o[i] = (f32x4){0.f, 0.f, 0.f, 0.f};
    float mrun = -1e30f, lrun = 0.f;
    const int k0key = tid / 12, k0ch = tid % 12, k1key = (tid + 512) / 12, k1ch = (tid + 512) % 12, vv = tid >> 3, vkc = tid & 7;
    u32x4 Ak0, Ak1 = {0u, 0u, 0u, 0u}, Av, Bk0, Bk1 = {0u, 0u, 0u, 0u}, Bv;
#define ATT_LOAD(X, it) do { const int j0_ = (it) * 64; \
        const int kb_ = kind ? (j0_ < 1024 ? MP + b * 1024 + j0_ : M_TOK + b * 256 + (j0_ - 1024)) : b * 256 + j0_; \
        X##k0 = *(const u32x4*)(k0ch < 8 ? KN + (size_t)(kb_ + k0key) * 512 + head * 64 + k0ch * 8 : KPE + (size_t)(kb_ + k0key) * 32 + (k0ch - 8) * 8); \
        if (tid < 256) X##k1 = *(const u32x4*)(k1ch < 8 ? KN + (size_t)(kb_ + k1key) * 512 + head * 64 + k1ch * 8 : KPE + (size_t)(kb_ + k1key) * 32 + (k1ch - 8) * 8); \
        X##v = *(const u32x4*)(VT + (size_t)(head * 64 + vv) * (M_TOK + 2048) + kb_ + vkc * 8); } while (0)
#define ATT_STORE(X, Kt_, Vt_) do { *(LAS u32x4*)(Kt_ + k0key * 104 + k0ch * 8) = X##k0; \
        if (tid < 256) *(LAS u32x4*)(Kt_ + k1key * 104 + k1ch * 8) = X##k1; \
        *(LAS u32x4*)(Vt_ + vv * 72 + vkc * 8) = X##v; } while (0)
    __syncthreads();
    ATT_LOAD(A, 0);
    if (ntiles > 1) ATT_LOAD(B, 1);
#pragma unroll 1
    for (int it = 0; it < ntiles; ++it) {
        LAS bf16* Kt = (LAS bf16*)(lds + (it & 1) * TILE_B);
        LAS bf16* Vt = Kt + 64 * 104;
        if (it & 1) ATT_STORE(B, Kt, Vt); else ATT_STORE(A, Kt, Vt);
        __syncthreads();
        if (it + 2 < ntiles) { if (it & 1) ATT_LOAD(B, it + 2); else ATT_LOAD(A, it + 2); }
        f32x4 sc[4]; float mx = -1e30f;
#pragma unroll
        for (int kt = 0; kt < 4; ++kt) {
            f32x4 a = {0.f, 0.f, 0.f, 0.f};
#pragma unroll
            for (int s = 0; s < 3; ++s) { const s16x8 kf = *(const LAS s16x8*)(Kt + (kt * 16 + ln) * 104 + 32 * s + 8 * h); a = __builtin_amdgcn_mfma_f32_16x16x32_bf16(kf, qf[s], a, 0, 0, 0); }
            sc[kt] = a; mx = fmaxf(mx, fmaxf(fmaxf(a[0], a[1]), fmaxf(a[2], a[3])));
        }
        mx = fmaxf(mx, __shfl_xor(mx, 16)); mx = fmaxf(mx, __shfl_xor(mx, 32));
        const float mnew = fmaxf(mrun, mx), alpha = __expf(mrun - mnew);
        mrun = mnew;
        float ps = 0.f;
#pragma unroll
        for (int kt = 0; kt < 4; ++kt)
#pragma unroll
            for (int r = 0; r < 4; ++r) { sc[kt][r] = __expf(sc[kt][r] - mnew); ps += sc[kt][r]; }
        lrun = lrun * alpha + ps;
#pragma unroll
        for (int i = 0; i < 4; ++i) o[i] = o[i] * alpha;
#pragma unroll
        for (int s = 0; s < 2; ++s) {
            u32x4 pw; pw.x = pk2(sc[2 * s][0], sc[2 * s][1]); pw.y = pk2(sc[2 * s][2], sc[2 * s][3]); pw.z = pk2(sc[2 * s + 1][0], sc[2 * s + 1][1]); pw.w = pk2(sc[2 * s + 1][2], sc[2 * s + 1][3]);
            const s16x8 pf = __builtin_bit_cast(s16x8, pw);
#pragma unroll
            for (int vt = 0; vt < 4; ++vt) {
                const LAS bf16* vp = Vt + (vt * 16 + ln) * 72 + 32 * s + 4 * h;
                const u32x2 lo2 = *(const LAS u32x2*)vp, hi2 = *(const LAS u32x2*)(vp + 16);
                const u32x4 vw = {lo2.x, lo2.y, hi2.x, hi2.y};
                o[vt] = __builtin_amdgcn_mfma_f32_16x16x32_bf16(__builtin_bit_cast(s16x8, vw), pf, o[vt], 0, 0, 0);
            }
        }
    }
#undef ATT_LOAD
#undef ATT_STORE
    lrun += __shfl_xor(lrun, 16); lrun += __shfl_xor(lrun, 32);
    const float inv = 1.0f / lrun;
#pragma unroll
    for (int vt = 0; vt < 4; ++vt) *(u32x2*)(MX + (size_t)qrow * 1024 + head * 64 + vt * 16 + 4 * h) = pk4(o[vt] * inv);
}

__device__ __forceinline__ void hyena_item(const P& p, LAS unsigned char* lds, int kind, int cgp) {
    const int tid = tid_opaque(), lane = tid & 63, wave = tid >> 6, ci = wave >> 2, qtr = wave & 3;
    const int L = kind ? 1024 : 256, NB = kind ? 8 : 32, base = kind ? MP : 0, c = cgp * 2 + ci;
    const int DMAX = kind ? 31 : 7;
    constexpr int ZCH = 8704;
    LAS bf16* zb = (LAS bf16*)lds;
    LAS bf16* gb = zb + 2 * ZCH;
    const bf16* HT = (const bf16*)(p.ws + WS_HYIN);
    const bf16* G = (const bf16*)(p.ws + (kind ? WS_GFS : WS_GFP));
    bf16* HO = (bf16*)(p.ws + WS_H);
    __syncthreads();
    const int Lp = L + 8;
    for (int i = tid; i < 2 * 1024; i += NTHREADS) { const int cc = i >> 10, off = (i & 1023) * 8;
        *(LAS u32x4*)(zb + cc * ZCH + (off / L) * Lp + (off % L)) = *(const u32x4*)(HT + (size_t)(cgp * 2 + cc) * M_TOK + base + off); }
    for (int i = tid; i < 4 * (2 * L / 8); i += NTHREADS) { const int co = i / (2 * L / 8), off = (i % (2 * L / 8)) * 8, cc = co >> 1, od = co & 1;
        *(LAS u32x4*)(gb + (cc * 2 + od) * 2 * L + off) = *(const u32x4*)(G + ((size_t)od * 512 + cgp * 2 + cc) * (2 * L) + off); }
    __syncthreads();
    const int n = lane & 31, h = lane >> 5;
    const int jl = kind ? (n & 3) : 0, bb = kind ? (n >> 2) : n;
    const LAS bf16* zc = zb + ci * ZCH + bb * Lp;
#pragma unroll 1
    for (int order = 0; order < 2; ++order) {
        const LAS bf16* gr = gb + (ci * 2 + order) * 2 * L;
        f32x16 acc[2];
#pragma unroll
        for (int g = 0; g < 2; ++g)
#pragma unroll
            for (int r = 0; r < 16; ++r) acc[g][r] = 0.f;
        const int Ilo_w = kind ? 8 * qtr : 2 * qtr, Ihi_w = kind ? 8 * qtr + 7 : 2 * qtr + 1;
        int Dlo = Ilo_w - (L / 32 - 1), Dhi = Ihi_w; if (Dlo < -DMAX) Dlo = -DMAX; if (Dhi > DMAX) Dhi = DMAX;
#pragma unroll 1
        for (int D = Dlo; D <= Dhi; ++D) {
#pragma unroll
            for (int ks = 0; ks < 2; ++ks) {
                const int idx = L - 32 * D + 16 * ks + 8 * h - n;
                u32x4 aw;
                aw.x = (unsigned)gr[idx] | ((unsigned)gr[idx + 1] << 16); aw.y = (unsigned)gr[idx + 2] | ((unsigned)gr[idx + 3] << 16);
                aw.z = (unsigned)gr[idx + 4] | ((unsigned)gr[idx + 5] << 16); aw.w = (unsigned)gr[idx + 6] | ((unsigned)gr[idx + 7] << 16);
                const s16x8 af = __builtin_bit_cast(s16x8, aw);
#pragma unroll
                for (int g = 0; g < 2; ++g) {
                    const int og = qtr * 2 + g;
                    const int Ilo = kind ? 4 * og : og, Ihi = kind ? 4 * og + 3 : og;
                    if (Ihi - D >= 0 && Ilo - D <= (L / 32 - 1)) {
                        const int J = (kind ? 4 * og + jl : og) - D;
                        u32x4 bw = {0u, 0u, 0u, 0u};
                        if (J >= 0 && J < L / 32) bw = *(const LAS u32x4*)(zc + 32 * J + 16 * ks + 8 * h);
                        acc[g] = __builtin_amdgcn_mfma_f32_32x32x16_bf16(af, __builtin_bit_cast(s16x8, bw), acc[g], 0, 0, 0);
                    }
                }
            }
        }
        const float bias = p.in[46][order * 512 + c];
        const bf16* gate = HT + (size_t)((order + 1) * 512 + c) * M_TOK + base + bb * L;
        u32x2 zn[2][4];
#pragma unroll
        for (int g = 0; g < 2; ++g) {
            const int og = qtr * 2 + g, I = kind ? 4 * og + jl : og;
#pragma unroll
            for (int rq = 0; rq < 4; ++rq) {
                const int t = 32 * I + 8 * rq + 4 * h;
                const f32x4 zo = unpk4(*(const LAS u32x2*)(zc + t)), gt = unpk4(*(const u32x2*)(gate + t));
                f32x4 y; y.x = acc[g][4 * rq]; y.y = acc[g][4 * rq + 1]; y.z = acc[g][4 * rq + 2]; y.w = acc[g][4 * rq + 3];
                zn[g][rq] = pk4(gt * (y + zo * bias));
            }
        }
        if (order == 0) {
            __syncthreads();
#pragma unroll
            for (int g = 0; g < 2; ++g) { const int og = qtr * 2 + g, I = kind ? 4 * og + jl : og;
#pragma unroll
                for (int rq = 0; rq < 4; ++rq) *(LAS u32x2*)(zb + ci * ZCH + bb * Lp + 32 * I + 8 * rq + 4 * h) = zn[g][rq]; }
            __syncthreads();
        } else {
#pragma unroll
            for (int g = 0; g < 2; ++g) { const int og = qtr * 2 + g, I = kind ? 4 * og + jl : og;
#pragma unroll
                for (int rq = 0; rq < 4; ++rq) { const int t = 32 * I + 8 * rq + 4 * h; *(u32x2*)(HO + (size_t)c * M_TOK + base + bb * L + t) = zn[g][rq]; } }
        }
    }
}
#ifndef DUP_SUB
#define DUP_SUB 3
#endif
__device__ __forceinline__ void ph_attn_hyena(const P& p, LAS unsigned char* lds, bool dummy) {
    const int B = blockIdx.x, G = gridDim.x;
#ifndef T_NO_ATTN
    if (!dummy || (DUP_SUB & 1))
    for (int i = B; i < 1024; i += G) { if (i < 512) attn_item(p, lds, 1, i >> 6, (i >> 3) & 7, i & 7); else { const int j = i - 512; attn_item(p, lds, 0, j >> 4, (j >> 1) & 7, j & 1); } }
#endif
#ifndef T_NO_HY
    if (!dummy || (DUP_SUB & 2))
    for (int i = B; i < 512; i += G) { hyena_item(p, lds, i < 256 ? 1 : 0, i & 255); }
#endif
}

__device__ __forceinline__ void ph_hy_transpose(const P& p, LAS unsigned char* lds) {
    const int tid = tid_opaque(), lane = tid & 63, wave = tid >> 6;
    LAS bf16* tile = (LAS bf16*)(lds + wave * 9216);
    const bf16* HO = (const bf16*)(p.ws + WS_H); bf16* MX = (bf16*)(p.ws + WS_MIX);
    for (int it = blockIdx.x * 8 + wave; it < 2048; it += gridDim.x * 8) {
        const int rt = it >> 3, cb = it & 7, r0 = rt * 64, c0 = cb * 64;
#pragma unroll
        for (int i = 0; i < 8; ++i) { const int id = i * 64 + lane, c = id >> 3, rc = id & 7;
            *(LAS u32x4*)(tile + c * 72 + rc * 8) = *(const u32x4*)(HO + (size_t)(c0 + c) * M_TOK + r0 + rc * 8); }
        LDS_WAIT();
        bf16* dst = MX + (size_t)(r0 + lane) * 1024 + 512 + c0;
#pragma unroll
        for (int j = 0; j < 8; ++j) {
            u32x4 w;
#pragma unroll
            for (int i = 0; i < 4; ++i) { const unsigned a = tile[(j * 8 + 2 * i) * 72 + lane], bq = tile[(j * 8 + 2 * i + 1) * 72 + lane]; w[i] = a | (bq << 16); }
            *(u32x4*)(dst + j * 8) = w;
        }
        LDS_WAIT();
    }
}

#define XB_TMO      128
#define XB_XCNT(j)  (256  + 64 * (j))
#define XB_XSUB(j)  (1280 + 64 * (j))
#define XB_XGEN(j)  (2304 + 64 * (j))
#define XB_TOP      3328
#define XB_TOPGEN   3392
#define XCD_BAR_WORDS 3456
#define XB_SPIN_CAP (1u << 18)

__device__ __forceinline__ unsigned xb_ld(unsigned* p)              { return __hip_atomic_load(p, __ATOMIC_RELAXED, __HIP_MEMORY_SCOPE_AGENT); }
__device__ __forceinline__ unsigned xb_add(unsigned* p, unsigned v) { return __hip_atomic_fetch_add(p, v, __ATOMIC_RELAXED, __HIP_MEMORY_SCOPE_AGENT); }
__device__ __forceinline__ unsigned xb_xcc_id() { return (unsigned)__builtin_amdgcn_s_getreg((3 << 11) | 20) & 0xFu; }
#define XB_SPIN(cond, bar) do { unsigned _sp = 0; while (cond) { __builtin_amdgcn_s_sleep(1); \
    if ((++_sp & 255u) == 0u) { if (xb_ld(&(bar)[XB_TMO])) break; if (_sp > XB_SPIN_CAP) { atomicAdd(&(bar)[XB_TMO], 1u); break; } } } } while (0)

struct XcdBarrier {
    unsigned* bar; unsigned x;
    volatile LAS unsigned* st;
};

__device__ __forceinline__ XcdBarrier xcd_barrier_post(unsigned* bar, volatile LAS unsigned* st) {
    XcdBarrier b; b.bar = bar; b.x = xb_xcc_id(); b.st = st;
    if (threadIdx.x == 0) (void)xb_add(&bar[XB_XCNT(b.x)], 1u);
    return b;
}
__device__ __forceinline__ void xcd_barrier_complete(unsigned* bar, unsigned x, unsigned& nloc, unsigned& nx) {
    const unsigned G = gridDim.x * gridDim.y * gridDim.z;
    unsigned sum, cnt, mine, sp = 0u;
    for (;;) {
        sum = 0u; cnt = 0u; mine = 0u;
#pragma unroll
        for (unsigned j = 0; j < 16; ++j) { const unsigned c = xb_ld(&bar[XB_XCNT(j)]); sum += c; cnt += (c > 0u) ? 1u : 0u; mine = (j == x) ? c : mine; }
        if (sum == G) break;
        __builtin_amdgcn_s_sleep(1);
        if ((++sp & 255u) == 0u) { if (xb_ld(&bar[XB_TMO])) break; if (sp > XB_SPIN_CAP) { atomicAdd(&bar[XB_TMO], 1u); break; } }
    }
    nloc = mine > 0u ? mine : 1u; nx = cnt > 0u ? cnt : 1u;
}

__device__ __forceinline__ void xcd_barrier(const XcdBarrier& b) {
    asm volatile("s_waitcnt vmcnt(0)" ::: "memory");
    __syncthreads();
    if (threadIdx.x == 0) {
        unsigned* bar = b.bar;
        __builtin_amdgcn_s_waitcnt(0);
        unsigned nloc = b.st[0], nx = b.st[1];
        if (nloc == 0u) { xcd_barrier_complete(bar, b.x, nloc, nx); b.st[0] = nloc; b.st[1] = nx; }
        const unsigned old = xb_add(&bar[XB_XSUB(b.x)], 1u);
        const unsigned gen = old / nloc;
        if (old + 1u == (gen + 1u) * nloc) {
            __builtin_amdgcn_fence(__ATOMIC_RELEASE, "agent");
            asm volatile("s_waitcnt vmcnt(0)" ::: "memory");
            const unsigned og = xb_add(&bar[XB_TOP], 1u);
            const unsigned tg = og / nx;
            if (og + 1u == (tg + 1u) * nx) xb_add(&bar[XB_TOPGEN], 1u);
            else XB_SPIN(xb_ld(&bar[XB_TOPGEN]) == tg, bar);
            __builtin_amdgcn_fence(__ATOMIC_ACQUIRE, "agent");
            xb_add(&bar[XB_XGEN(b.x)], 1u);
            asm volatile("s_waitcnt vmcnt(0)" ::: "memory");
        } else {
            XB_SPIN(xb_ld(&bar[XB_XGEN(b.x)]) == gen, bar);
            __builtin_amdgcn_fence(__ATOMIC_ACQUIRE, "agent");
            asm volatile("s_waitcnt vmcnt(0)" ::: "memory");
        }
    }
    __syncthreads();
}


template <class Epi>
__device__ __forceinline__ void run_gemm(LAS unsigned char* lds, const bf16* A, const bf16* Bt, int M, int N, int K, const Epi& E, int rot = 0) {
    asm volatile("" : "+s"(K));
    pg8::Gemm g{A, Bt, M, N, K}; pg8::StaticOrder S; S.init(M, N, (int)gridDim.x, (int)((blockIdx.x + gridDim.x - rot) % gridDim.x));
    pg8::gemm_phase<Epi, pg8::StaticOrder, true, true>(lds, g, S, E);
}

#ifndef DUP_PH
#define DUP_PH (-1)
#endif
__device__ __forceinline__ void run_phase(const P& p, LAS unsigned char* lds, int k, bool dummy) {
    if (k == 0) {
        { float* cvz0 = (float*)(p.ws + WS_CV); for (int i = blockIdx.x * NTHREADS + tid_opaque(); i < 2 * CV_STRIDE; i += gridDim.x * NTHREADS) cvz0[i] = 0.f; }
        adaln_layer(p, lds, 0, 0); adaln_layer(p, lds, 1, (int)gridDim.x / 2); ph_rope_table(p); return; }
    if (k == 27) { final_norm_rows(p); return; }
    const int layer = (k - 1) / 13, sub = (k - 1) % 13;
    float* x = p.out;
    const float* mod = (const float*)(p.ws + WS_MOD);
    bf16* H = (bf16*)(p.ws + WS_H); bf16* R1 = (bf16*)(p.ws + WS_R1);
    float* ssb = (float*)(p.ws + WS_SS); float* cvb = (float*)(p.ws + WS_CV); float* ssp = (float*)(p.ws + WS_R2);
    switch (sub) {
    case 0: case 3: case 10: {
        const int jn = sub == 0 ? 0 : (sub == 3 ? 1 : 2), uu = 3 * layer + jn;
        float* cvo = cvb + (size_t)(uu & 1) * CV_STRIDE; float* cvz = cvb + (size_t)((uu + 1) & 1) * CV_STRIDE;
        const float* shift = mod + (size_t)layer * 9 * 9216 + (3 * jn) * 1024;
        for (int i = blockIdx.x * NTHREADS + tid_opaque(); i < CV_STRIDE; i += gridDim.x * NTHREADS) cvz[i] = 0.f;
        if (uu == 0) first_rows(p, p.in[10], ssb);
        else { const int t = tid_opaque();
            if (t < 64) for (int row = blockIdx.x * 64 + t; row < M_TOK; row += gridDim.x * 64) { float a = 0.f;
#pragma unroll
                for (int q = 0; q < 16; ++q) a += ssp[q * M_TOK + row];
                ssb[row] = rsqrtf_(a * (1.0f / 1024.0f) + 1e-6f); } }
        if (sub != 3) convert_ffn_weights(p, layer, sub == 0 ? 0 : 1, lds, shift, cvo);
        else {
            transpose_w<0>(p.in[17] + (size_t)layer * 1024 * 1024, 1024, 1024, 1024, (bf16*)(p.ws + W_OUT), 1024, lds, nullptr, nullptr, 0, layer == 0 ? 128 : 232);
            if (layer == 0) { transpose_w<0>(p.in[18], 3984, 3984, 1024, (bf16*)(p.ws + W_IN), 4096, lds, shift, cvo, 4096); build_lora_w(p); }
            else { transpose_w<0>(p.in[34], 2208, 2208, 1024, (bf16*)(p.ws + W_IN), 2304, lds, shift, cvo, 2304, 160);
                transpose_w<0>(p.in[36], 768, 768, 384, (bf16*)(p.ws + W_UQ), 768, lds, nullptr, nullptr, 0, 8);
                transpose_w<0>(p.in[38], 1024, 1024, 256, (bf16*)(p.ws + W_UKV), 1024, lds, nullptr, nullptr, 0, 17);
                ph_hyena_filters(p, lds); }
        }
    } break;
    case 1: case 11: { const int uu = 3 * layer + (sub == 1 ? 0 : 2);
        run_gemm(lds, H, (const bf16*)(p.ws + W_GU), M_TOK, 5632, 1024, EpiSwigluN{R1, ssb, cvb + (size_t)(uu & 1) * CV_STRIDE}); } break;
    case 2: case 12: {
        const bool first = layer == 0 && sub == 2;
        const float* xp = first ? p.in[0] : x; const float* xs = first ? p.in[1] : x + (size_t)MP * DM;
        const float* gate = mod + (size_t)layer * 9 * 9216 + (sub == 2 ? 2 : 8) * 1024;
        if (layer == 1 && sub == 12) { const EpiResid E{xp, xs, x, gate, 0.5f}; run_gemm(lds, R1, (const bf16*)(p.ws + W_DOWN), M_TOK, 1024, 2816, E); }
        else {
            const int ln = sub == 12 ? layer + 1 : layer, jn = sub == 2 ? 1 : 0, uu = 3 * ln + jn;
            const EpiResidN E{xp, xs, x, gate, p.in[jn == 0 ? 10 : 11] + ln * 1024, mod + (size_t)ln * 9 * 9216 + (3 * jn + 1) * 1024, H, ssp, 0.5f};
            run_gemm(lds, R1, (const bf16*)(p.ws + W_DOWN), M_TOK, 1024, 2816, E);
        }
    } break;
    case 9: {
        const int uu = 3 * layer + 2;
        const EpiResidN E{x, x + (size_t)MP * DM, x, mod + (size_t)layer * 9 * 9216 + 5 * 1024, p.in[12] + layer * 1024, mod + (size_t)layer * 9 * 9216 + 7 * 1024, H, ssp, 1.0f};
        run_gemm(lds, (const bf16*)(p.ws + WS_MIX), (const bf16*)(p.ws + W_OUT), M_TOK, 1024, 1024, E);
    } break;
    case 4: {
        const int N = layer == 0 ? 4096 : 2304, ld = layer == 0 ? LDP0 : LDP1, uu = 3 * layer + 1;
        run_gemm(lds, H, (const bf16*)(p.ws + W_IN), M_TOK, N, 1024, EpiStoreN{R1, ld, ld, ssb, cvb + (size_t)(uu & 1) * CV_STRIDE, N});
    } break;
    case 5: if (layer == 0) ph_lora_in(p); else ph_mla_prep(p, lds); break;
    case 6:
        if (layer == 0) run_gemm(lds, H, (const bf16*)(p.ws + W_LORA), M_TOK, 2560, 384, EpiLora{(bf16*)(p.ws + WS_R2), p.in[20], p.in[22]});
        else { run_gemm(lds, (const bf16*)(p.ws + WS_CKVA), (const bf16*)(p.ws + W_UKV), M_TOK + 2048, 1024, 256, EpiKV{(bf16*)(p.ws + WS_KV), (bf16*)(p.ws + WS_VT), M_TOK + 2048});
            run_gemm(lds, H, (const bf16*)(p.ws + W_UQ), M_TOK, 768, 384, EpiQ{(bf16*)(p.ws + WS_Q), (const float*)(p.ws + WS_ROPE)}, 32); }
        break;
    case 7: if (layer == 0) ph_scan(p, lds); else ph_attn_hyena(p, lds, dummy); break;
    case 8: if (layer == 0) ph_post_ab(p, dummy); else ph_hy_transpose(p, lds); break;
    default: break;
    }
}

__global__ void __launch_bounds__(NTHREADS, 2) hybrid_fwd(P p) {
    extern __shared__ __attribute__((aligned(16))) unsigned char lds_raw[];
    LAS unsigned char* lds = (LAS unsigned char*)lds_raw;
    cg::grid_group grid = cg::this_grid();
    volatile LAS unsigned* bst = (volatile LAS unsigned*)(lds + LDS_BYTES - 64);
    if (threadIdx.x < 16) bst[threadIdx.x] = 0u;
    __syncthreads();
    XcdBarrier bar = xcd_barrier_post((unsigned*)(p.ws + WS_CTL) + 1024, bst);
#pragma unroll 1
    for (int k = p.ph_lo; k < p.ph_hi; ++k) {
        const int nrep = (DUP_PH >= 0 && k == DUP_PH) ? 2 : 1;
#pragma unroll 1
        for (int rep = 0; rep < nrep; ++rep) { run_phase(p, lds, k, rep + 1 < nrep); if (rep + 1 < nrep) __syncthreads(); }
        if (k + 1 < p.ph_hi) { if (p.ph_hi < 0) grid.sync(); else { xcd_barrier(bar);
        } }
    }
}

extern "C" void kernel_launch(void* const* d_in, const int* in_sizes, int n_in, void* d_out, int out_size, void* d_ws, size_t ws_size, hipStream_t stream) {
    static int grid = 0;
    if (grid == 0) {
        if (n_in != 48 || out_size != 25427968 || ws_size < WS_END) {
            fprintf(stderr, "kernel_launch: expected 48 inputs, 25427968 outputs, >= %zu B workspace; got %d, %d, %zu\n", (size_t)WS_END, n_in, out_size, ws_size);
            grid = -1; return;
        }
        int dev = 0, cus = 0, per_cu = 0;
        hipGetDevice(&dev);
        hipDeviceGetAttribute(&cus, hipDeviceAttributeMultiprocessorCount, dev);
        hipFuncSetAttribute((const void*)hybrid_fwd, hipFuncAttributeMaxDynamicSharedMemorySize, LDS_BYTES);
        hipOccupancyMaxActiveBlocksPerMultiprocessor(&per_cu, (const void*)hybrid_fwd, NTHREADS, LDS_BYTES);
        if (per_cu < 1) { fprintf(stderr, "kernel_launch: occupancy query says %d blocks/CU\n", per_cu); per_cu = 1; }
        (void)hipGetLastError();
        grid = cus;
    }
    if (grid < 0) return;
    (void)hipMemsetAsync((char*)d_ws + WS_CTL, 0, 24 * 1024, stream);
    P prm{};
    for (int i = 0; i < 48; ++i) prm.in[i] = (const float*)d_in[i];
    prm.out = (float*)d_out; prm.ws = (unsigned char*)d_ws;
#ifndef N_SPLIT
    prm.ph_lo = 0; prm.ph_hi = 28;
    void* args[] = {&prm};
    hipError_t e = hipLaunchCooperativeKernel((const void*)hybrid_fwd, dim3(grid), dim3(NTHREADS), args, LDS_BYTES, stream);
    if (e != hipSuccess) fprintf(stderr, "cooperative launch failed: %s (grid %d)\n", hipGetErrorString(e), grid);
#else
    for (int k = 0; k < 28; ++k) {
        prm.ph_lo = k; prm.ph_hi = k + 1;
        void* args[] = {&prm};
        hipError_t e = hipLaunchCooperativeKernel((const void*)hybrid_fwd, dim3(grid), dim3(NTHREADS), args, LDS_BYTES, stream);
        if (e != hipSuccess) { fprintf(stderr, "launch %d failed: %s\n", k, hipGetErrorString(e)); break; }
    }
#endif
}
```

```cpp
#include <hip/hip_runtime.h>
#include <hip/hip_cooperative_groups.h>
#include <cstdio>
#include <cstdint>
namespace cg = cooperative_groups;

#define LAS __attribute__((address_space(3)))
typedef unsigned short bf16;
typedef float f32x2 __attribute__((ext_vector_type(2)));
typedef float f32x4 __attribute__((ext_vector_type(4)));
typedef float f32x16 __attribute__((ext_vector_type(16)));
typedef unsigned u32x2 __attribute__((ext_vector_type(2)));
typedef unsigned u32x4 __attribute__((ext_vector_type(4)));
typedef short s16x8 __attribute__((ext_vector_type(8)));

constexpr int M_TOK = 16384, MP = 8192, DM = 1024, DFF = 2816;
constexpr int LDP0 = 3984, LDP1 = 2304;
constexpr int OUT_YS = 8388608, OUT_SRW = 16777216, OUT_SGD = 18874368, OUT_CKV = 23068672, OUT_KPE = 25165824;

constexpr size_t MiB = 1ull << 20;
constexpr size_t WS_CTL = 0;
constexpr size_t WS_SS = 64 * 1024;
constexpr size_t WS_ROPE = 512 * 1024;
constexpr size_t WS_CV = 2 * 1048576 + 16 * 1048576 + 524288;
constexpr int CV_STRIDE = 9 * 5632;
constexpr size_t WS_MOD = 1 * MiB;
constexpr size_t WS_W = 2 * MiB;
constexpr size_t W_GU = WS_W, W_DOWN = WS_W + 11 * MiB;
constexpr size_t W_IN = WS_W, W_OUT = WS_W + 8 * MiB, W_LORA = WS_W + 10 * MiB, W_UQ = WS_W + 12 * MiB, W_UKV = WS_W + 13 * MiB;
constexpr size_t WS_H = 19 * MiB;
constexpr size_t WS_MIX = 51 * MiB;
constexpr size_t WS_R1 = 83 * MiB;
constexpr size_t R1_BYTES = 130547712;
constexpr size_t WS_HYIN = WS_R1 + 72 * MiB;
constexpr size_t WS_R2 = WS_R1 + R1_BYTES;
constexpr size_t WS_Q = WS_R2, WS_KV = WS_R2 + 24 * MiB, WS_VT = WS_R2 + 42 * MiB, WS_CKVA = WS_R2 + 60 * MiB, WS_KPEA = WS_R2 + 69 * MiB, WS_GFS = WS_R2 + 71 * MiB, WS_GFP = WS_R2 + 75 * MiB;
constexpr size_t WS_END = WS_R2 + 80 * MiB;

constexpr int LDS_BYTES = 159744;
constexpr int NTHREADS = 512;

struct P {
    const float* in[48];
    float* out;
    unsigned char* ws;
    int ph_lo, ph_hi;
};

__device__ __forceinline__ float bf2f(unsigned b) { return __uint_as_float(b << 16); }
__device__ __forceinline__ float bflo(unsigned w) { return __uint_as_float(w << 16); }
__device__ __forceinline__ float bfhi(unsigned w) { return __uint_as_float(w & 0xffff0000u); }
typedef __bf16 bf16x2_t __attribute__((ext_vector_type(2)));
__device__ __forceinline__ unsigned pk2(float lo, float hi) { const f32x2 v = {lo, hi}; return __builtin_bit_cast(unsigned, __builtin_convertvector(v, bf16x2_t)); }
__device__ __forceinline__ f32x4 unpk4(u32x2 w) { return (f32x4){bflo(w.x), bfhi(w.x), bflo(w.y), bfhi(w.y)}; }
__device__ __forceinline__ u32x2 pk4(f32x4 v) { return (u32x2){pk2(v.x, v.y), pk2(v.z, v.w)}; }
__device__ __forceinline__ float wave_sum(float v) {
#pragma unroll
    for (int o = 1; o < 64; o <<= 1) v += __shfl_xor(v, o);
    return v;
}
__device__ __forceinline__ float dpp_f(float x, int) { return x; }
#define DPPF(x, ctrl) __int_as_float(__builtin_amdgcn_update_dpp(0, __float_as_int(x), (ctrl), 0xF, 0xF, true))
__device__ __forceinline__ float red4(float x) { x += DPPF(x, 0xB1); x += DPPF(x, 0x4E); return x; }
__device__ __forceinline__ float red8(float x) { x = red4(x); x += DPPF(x, 0x141); return x; }
__device__ __forceinline__ float red16(float x) { x = red8(x); x += DPPF(x, 0x140); return x; }
__device__ __forceinline__ float sigmoidf_(float x) { return __builtin_amdgcn_rcpf(1.0f + __expf(-x)); }
__device__ __forceinline__ float siluf_(float x) { return x * __builtin_amdgcn_rcpf(1.0f + __expf(-x)); }
__device__ __forceinline__ float rsqrtf_(float x) { return __builtin_amdgcn_rsqf(x); }
__device__ __forceinline__ int cond_of_row(int row) { return row < MP ? 0 : 1 + ((row - MP) >> 10); }
__device__ __forceinline__ int tid_opaque() { int t = threadIdx.x; asm volatile("" : "+v"(t)); return t; }
#define LDS_WAIT() asm volatile("s_waitcnt lgkmcnt(0)" ::: "memory")

namespace pg8 {
#define PG8_LAS __attribute__((address_space(3)))
typedef unsigned short bf16_t;
typedef short bf16x8 __attribute__((ext_vector_type(8)));
typedef float f32x4 __attribute__((ext_vector_type(4)));
typedef unsigned u32x4 __attribute__((ext_vector_type(4)));
constexpr int BM = 256, BK = 64, HALF = 128, HTB = HALF * BK * 2  , STAGE_BYTES = 8 * HTB, NXCD = 8, WGM = 4;

__host__ __device__ __forceinline__ int lds_byte(int r, int c) { const int st = (r >> 4) * 2 + (c >> 5), rr = r & 15, cc = c & 31, ob = rr * 64 + cc * 2; return st * 1024 + (ob ^ (((ob >> 9) & 1) << 5)); }
__host__ __device__ __forceinline__ void stage_rc(int b, int& R, int& C) { const int st = b / 1024, sb = b % 1024, swz = sb ^ (((sb >> 9) & 1) << 5); R = (st >> 1) * 16 + swz / 64; C = (st & 1) * 32 + (swz % 64) / 2; }
__host__ __device__ __forceinline__ int perm32(int rho) { const int n = rho >> 4, i = rho & 15; return 8 * (i >> 2) + 4 * n + (i & 3); }

struct Unit { int pm, pn; };
struct Gemm { const bf16_t* A; const bf16_t* Bt; int M, N, K; };

struct StaticOrder {
    int nM, nN, nwg, G, c;
    __host__ __device__ void init(int M, int N, int G_, int c_) { nM = M / BM; nN = N / BM; nwg = nM * nN; G = G_; c = c_; }
    __host__ __device__ bool next(int i, Unit& u) const {
        const long L = (long)i * G + c; if (L >= nwg) return false;
        int wgid = (int)L; { const int q = nwg / NXCD, r = nwg % NXCD, xcd = wgid % NXCD, off = wgid / NXCD; wgid = (xcd < r ? xcd * (q + 1) : r * (q + 1) + (xcd - r) * q) + off; }
        const int nig = WGM * nN, gid = wgid / nig, fm = gid * WGM, gsz = (nM - fm) < WGM ? (nM - fm) : WGM;
        u.pm = fm + ((wgid % nig) % gsz); u.pn = (wgid % nig) / gsz; return true;
    }
    __device__ __forceinline__ void a_ready(const Unit&) const {}
    __device__ __forceinline__ void done(const Unit&) const {}
};
__device__ __forceinline__ unsigned cvt_pk_bf16(float lo, float hi) { unsigned r; asm volatile("v_cvt_pk_bf16_f32 %0, %1, %2" : "=v"(r) : "v"(lo), "v"(hi)); return r; }
typedef float f32x2 __attribute__((ext_vector_type(2)));
template <class Epi, class Sched, bool ALIGN_EPI = false, bool SP2 = false>
__device__ __forceinline__ void gemm_phase(PG8_LAS unsigned char* lds, const Gemm g, const Sched& S, const Epi& E) {
    const int tid = tid_opaque(), wid = __builtin_amdgcn_readfirstlane(tid >> 6), lane = tid & 63, wr = wid >> 2, wc = wid & 3, fr = lane & 15, fq = lane >> 4;
    const int K = g.K, nt = K / BK;
    unsigned voffA[2], voffB[2];
#pragma unroll
    for (int i = 0; i < 2; ++i) { int R, C; stage_rc(tid * 16 + i * 8192, R, C); const int Rb = Epi::PERM ? ((R & ~31) + perm32(R & 31)) : R;
        voffA[i] = (unsigned)(R * K + C) * 2u; voffB[i] = (unsigned)(Rb * K + C) * 2u; }
    const size_t kstep = (size_t)(BK * 2);
    const size_t hstep = (size_t)HALF * K * 2;
    const size_t tstep = 2 * hstep;
    const unsigned ldsw = (unsigned)wid * 1024u;
    const int aoff = lds_byte(wr * 64 + fr, fq * 8), boff = lds_byte(wc * 32 + fr, fq * 8);
#define PG8_SA(b, h) (((b) * 2 + (h)) * HTB)
#define PG8_SB(b, h) ((4 + (b) * 2 + (h)) * HTB)
#define PG8_STAGE(bufoff, gbase, voff) do { _Pragma("unroll") for (int _i = 0; _i < 2; ++_i) \
        __builtin_amdgcn_global_load_lds((const unsigned*)((const char*)(gbase) + (voff)[_i]), (PG8_LAS unsigned*)(lds + (bufoff) + ldsw + _i * 8192), 16, 0, 0); } while (0)
#define PG8_LDA(dst, b, h) do { _Pragma("unroll") for (int m = 0; m < 4; ++m) _Pragma("unroll") for (int k = 0; k < 2; ++k) dst[m][k] = *(const PG8_LAS bf16x8*)(lds + PG8_SA(b, h) + aoff + m * 2048 + k * 1024); } while (0)
#define PG8_LDB(dst, b, h) do { _Pragma("unroll") for (int n = 0; n < 2; ++n) _Pragma("unroll") for (int k = 0; k < 2; ++k) dst[n][k] = *(const PG8_LAS bf16x8*)(lds + PG8_SB(b, h) + boff + n * 2048 + k * 1024); } while (0)
#define PG8_MMA(ai, bj, At, Bt) do { __builtin_amdgcn_s_setprio(1); _Pragma("unroll") for (int m = 0; m < 4; ++m) _Pragma("unroll") for (int n = 0; n < 2; ++n) _Pragma("unroll") for (int k = 0; k < 2; ++k) \
        acc[ai][bj][m][n] = __builtin_amdgcn_mfma_f32_16x16x32_bf16(Bt[n][k], At[m][k], acc[ai][bj][m][n], 0, 0, 0); __builtin_amdgcn_s_setprio(0); } while (0)
#define PG8_WAIT_V(n) asm volatile("s_waitcnt vmcnt(" #n ")" ::: "memory")
#define PG8_WAIT_L(n) asm volatile("s_waitcnt lgkmcnt(" #n ")" ::: "memory")
#define PG8_BAR __builtin_amdgcn_s_barrier()
#define PG8_SCHED __builtin_amdgcn_sched_barrier(0)
    Unit cur, nxt; int ui = 0;
    if (!S.next(0, cur)) return;
    f32x4 acc[2][2][4][2];
#pragma unroll
    for (int a = 0; a < 2; ++a)
#pragma unroll
        for (int b = 0; b < 2; ++b)
#pragma unroll
            for (int m = 0; m < 4; ++m)
#pragma unroll
                for (int n = 0; n < 2; ++n) acc[a][b][m][n] = (f32x4){0.f, 0.f, 0.f, 0.f};
    bf16x8 At[4][2], B0[2][2], B1[2][2];
    const char* cA = (const char*)g.A + (size_t)cur.pm * tstep; const char* cB = (const char*)g.Bt + (size_t)cur.pn * tstep;
    S.a_ready(cur);
    if constexpr (SP2) {
        PG8_STAGE(PG8_SB(0, 0), cB, voffB); PG8_STAGE(PG8_SB(0, 1), cB + hstep, voffB); PG8_STAGE(PG8_SA(0, 0), cA, voffA); PG8_STAGE(PG8_SA(0, 1), cA + hstep, voffA);
        if (wr == 1) PG8_BAR;
        PG8_WAIT_V(2); PG8_BAR;
        PG8_STAGE(PG8_SB(1, 0), cB + kstep, voffB); PG8_STAGE(PG8_SA(1, 0), cA + kstep, voffA); PG8_STAGE(PG8_SB(1, 1), cB + hstep + kstep, voffB);
        PG8_WAIT_V(6); PG8_BAR;
    } else {
        PG8_STAGE(PG8_SB(0, 0), cB, voffB); PG8_STAGE(PG8_SA(0, 0), cA, voffA); PG8_STAGE(PG8_SB(0, 1), cB + hstep, voffB); PG8_STAGE(PG8_SA(0, 1), cA + hstep, voffA);
        if (wr == 1) PG8_BAR;
        PG8_WAIT_V(4); PG8_BAR;
        PG8_STAGE(PG8_SB(1, 0), cB + kstep, voffB); PG8_STAGE(PG8_SA(1, 0), cA + kstep, voffA); PG8_STAGE(PG8_SB(1, 1), cB + hstep + kstep, voffB);
        PG8_WAIT_V(6); PG8_BAR;
    }
    for (;;) {
        const bool has_next = S.next(ui + 1, nxt);
        const char* nA = has_next ? (const char*)g.A + (size_t)nxt.pm * tstep : cA; const char* nB = has_next ? (const char*)g.Bt + (size_t)nxt.pn * tstep : cB;
#pragma unroll 1
        for (int t = 0; t < nt; t += 2) {
            const bool last = (t == nt - 2);
            const char* a1 = cA + (size_t)(t + 1) * kstep;
            const char* a2 = last ? nA : cA + (size_t)(t + 2) * kstep; const char* b2 = last ? nB : cB + (size_t)(t + 2) * kstep;
            const char* a3 = a2 + kstep; const char* b3 = b2 + kstep;
            if (last && has_next) S.a_ready(nxt);
            if constexpr (SP2) {
            PG8_LDB(B0, 0, 0); PG8_LDB(B1, 0, 1); PG8_SCHED; PG8_LDA(At, 0, 0); PG8_STAGE(PG8_SA(1, 1), a1 + hstep, voffA);
            PG8_WAIT_V(8); PG8_WAIT_L(0); PG8_BAR; PG8_MMA(0, 0, At, B0); PG8_MMA(0, 1, At, B1); PG8_BAR; PG8_SCHED;
            PG8_LDA(At, 0, 1); PG8_STAGE(PG8_SB(0, 0), b2, voffB); PG8_STAGE(PG8_SB(0, 1), b2 + hstep, voffB); PG8_STAGE(PG8_SA(0, 0), a2, voffA);
            PG8_WAIT_V(8); PG8_WAIT_L(0); PG8_BAR; PG8_MMA(1, 0, At, B0); PG8_MMA(1, 1, At, B1); PG8_BAR; PG8_SCHED;
            PG8_LDB(B0, 1, 0); PG8_LDB(B1, 1, 1); PG8_SCHED; PG8_LDA(At, 1, 0); PG8_STAGE(PG8_SA(0, 1), a2 + hstep, voffA);
            PG8_WAIT_V(8); PG8_WAIT_L(0); PG8_BAR; PG8_MMA(0, 0, At, B0); PG8_MMA(0, 1, At, B1); PG8_BAR; PG8_SCHED;
            PG8_LDA(At, 1, 1); PG8_STAGE(PG8_SB(1, 0), b3, voffB); PG8_STAGE(PG8_SB(1, 1), b3 + hstep, voffB); PG8_STAGE(PG8_SA(1, 0), a3, voffA);
            PG8_WAIT_V(8); PG8_WAIT_L(0); PG8_BAR; PG8_MMA(1, 0, At, B0); PG8_MMA(1, 1, At, B1); PG8_BAR; PG8_SCHED;
            } else {
            PG8_LDB(B0, 0, 0); PG8_SCHED; PG8_LDA(At, 0, 0); PG8_STAGE(PG8_SA(1, 1), a1 + hstep, voffA);
            PG8_WAIT_L(8); PG8_BAR; PG8_WAIT_L(0); PG8_MMA(0, 0, At, B0); PG8_BAR; PG8_SCHED;
            PG8_LDB(B1, 0, 1); PG8_STAGE(PG8_SB(0, 0), b2, voffB);
            PG8_BAR; PG8_WAIT_L(0); PG8_MMA(0, 1, At, B1); PG8_BAR;
            PG8_LDA(At, 0, 1); PG8_STAGE(PG8_SA(0, 0), a2, voffA);
            PG8_BAR; PG8_WAIT_L(0); PG8_MMA(1, 0, At, B0); PG8_BAR; PG8_SCHED;
            PG8_STAGE(PG8_SB(0, 1), b2 + hstep, voffB);
            PG8_WAIT_V(6); PG8_BAR; PG8_MMA(1, 1, At, B1); PG8_BAR;
            PG8_LDB(B0, 1, 0); PG8_SCHED; PG8_LDA(At, 1, 0); PG8_STAGE(PG8_SA(0, 1), a2 + hstep, voffA);
            PG8_WAIT_L(8); PG8_BAR; PG8_WAIT_L(0); PG8_MMA(0, 0, At, B0); PG8_BAR; PG8_SCHED;
            PG8_LDB(B1, 1, 1); PG8_STAGE(PG8_SB(1, 0), b3, voffB);
            PG8_BAR; PG8_WAIT_L(0); PG8_MMA(0, 1, At, B1); PG8_BAR;
            PG8_LDA(At, 1, 1); PG8_STAGE(PG8_SA(1, 0), a3, voffA);
            PG8_BAR; PG8_WAIT_L(0); PG8_MMA(1, 0, At, B0); PG8_BAR; PG8_SCHED;
            PG8_STAGE(PG8_SB(1, 1), b3 + hstep, voffB);
            PG8_WAIT_V(6); PG8_BAR; PG8_MMA(1, 1, At, B1); PG8_BAR;
            }
        }
        if constexpr (ALIGN_EPI) { if (wr == 0) PG8_BAR; }
        if constexpr (!Epi::AFTER_DRAIN) { E(acc, cur, wr, wc, fr, fq); S.done(cur); }
        if (!has_next) break;
#pragma unroll
        for (int a = 0; a < 2; ++a)
#pragma unroll
            for (int b = 0; b < 2; ++b)
#pragma unroll
                for (int m = 0; m < 4; ++m)
#pragma unroll
                    for (int n = 0; n < 2; ++n) acc[a][b][m][n] = (f32x4){0.f, 0.f, 0.f, 0.f};
        cur = nxt; cA = nA; cB = nB; ++ui;
        if constexpr (ALIGN_EPI) { if (wr == 1) PG8_BAR; }
    }
    PG8_WAIT_V(0);
    if constexpr (!ALIGN_EPI) { if (wr == 0) PG8_BAR; }
    PG8_BAR;
    if constexpr (Epi::AFTER_DRAIN) { E.fused(acc, cur, wr, wc, fr, fq, lds, wid, lane); S.done(cur); }
#undef PG8_SA
#undef PG8_SB
#undef PG8_STAGE
#undef PG8_LDA
#undef PG8_LDB
#undef PG8_MMA
#undef PG8_WAIT_V
#undef PG8_WAIT_L
#undef PG8_BAR
#undef PG8_SCHED
}
}

using pg8::Unit;
typedef const f32x4 (&AccRef)[2][2][4][2];

struct EpiSwiglu {
    static constexpr bool PERM = true, AFTER_DRAIN = false;
    bf16* O;
    __device__ __forceinline__ void operator()(AccRef acc, const Unit& u, int wr, int wc, int fr, int fq) const {
        const int row0 = u.pm * 256 + wr * 64 + fr, col0 = u.pn * 128 + wc * 32 + 8 * fq;
#pragma unroll
        for (int ai = 0; ai < 2; ++ai)
#pragma unroll
            for (int m = 0; m < 4; ++m) {
                const f32x4 g0 = acc[ai][0][m][0], g1 = acc[ai][0][m][1], u0 = acc[ai][1][m][0], u1 = acc[ai][1][m][1];
                float v[8];
#pragma unroll
                for (int i = 0; i < 4; ++i) { v[i] = g0[i] * __builtin_amdgcn_rcpf(1.0f + __expf(-g0[i])) * u0[i]; v[4 + i] = g1[i] * __builtin_amdgcn_rcpf(1.0f + __expf(-g1[i])) * u1[i]; }
                u32x4 w; w.x = pk2(v[0], v[1]); w.y = pk2(v[2], v[3]); w.z = pk2(v[4], v[5]); w.w = pk2(v[6], v[7]);
                *(u32x4*)(O + (size_t)(row0 + ai * 128 + m * 16) * DFF + col0) = w;
            }
    }
};
struct EpiSwigluN {
    static constexpr bool PERM = true, AFTER_DRAIN = false;
    bf16* O; const float* ss; const float* cv;
    __device__ __forceinline__ void operator()(AccRef acc, const Unit& u, int wr, int wc, int fr, int fq) const {
        const int cond = u.pm < 32 ? 0 : 1 + ((u.pm - 32) >> 2);
        const int row0 = u.pm * 256 + wr * 64 + fr, col0 = u.pn * 128 + wc * 32 + 8 * fq, gc0 = u.pn * 256 + wc * 32 + 8 * fq;
        const float* cp = cv + (size_t)cond * 5632 + gc0;
        const f32x4 cg0 = *(const f32x4*)cp, cg1 = *(const f32x4*)(cp + 4), cu0 = *(const f32x4*)(cp + 128), cu1 = *(const f32x4*)(cp + 132);
#pragma unroll
        for (int ai = 0; ai < 2; ++ai)
#pragma unroll
            for (int m = 0; m < 4; ++m) {
                const int row = row0 + ai * 128 + m * 16;
                const float rs = ss[row];
                const f32x4 g0 = acc[ai][0][m][0] * rs + cg0, g1 = acc[ai][0][m][1] * rs + cg1, u0 = acc[ai][1][m][0] * rs + cu0, u1 = acc[ai][1][m][1] * rs + cu1;
                float v[8];
#pragma unroll
                for (int i = 0; i < 4; ++i) { v[i] = g0[i] * __builtin_amdgcn_rcpf(1.0f + __expf(-g0[i])) * u0[i]; v[4 + i] = g1[i] * __builtin_amdgcn_rcpf(1.0f + __expf(-g1[i])) * u1[i]; }
                u32x4 w; w.x = pk2(v[0], v[1]); w.y = pk2(v[2], v[3]); w.z = pk2(v[4], v[5]); w.w = pk2(v[6], v[7]);
                *(u32x4*)(O + (size_t)row * DFF + col0) = w;
            }
    }
};
struct EpiStoreN {
    static constexpr bool PERM = true, AFTER_DRAIN = false;
    bf16* O; int ldc; int ncols; const float* ss; const float* cv; int ncv;
    __device__ __forceinline__ void operator()(AccRef acc, const Unit& u, int wr, int wc, int fr, int fq) const {
        const int cond = u.pm < 32 ? 0 : 1 + ((u.pm - 32) >> 2);
        const int row0 = u.pm * 256 + wr * 64 + fr, col0 = u.pn * 256 + wc * 32 + 8 * fq;
        const float* cp = cv + (size_t)cond * ncv + col0;
        const f32x4 c00 = *(const f32x4*)cp, c01 = *(const f32x4*)(cp + 4), c10 = *(const f32x4*)(cp + 128), c11 = *(const f32x4*)(cp + 132);
#pragma unroll
        for (int ai = 0; ai < 2; ++ai)
#pragma unroll
            for (int m = 0; m < 4; ++m) {
                const int row = row0 + ai * 128 + m * 16;
                const float rs = ss[row];
                bf16* rowp = O + (size_t)row * ldc;
#pragma unroll
                for (int bj = 0; bj < 2; ++bj) { const int col = col0 + bj * 128;
                    const f32x4 v0 = acc[ai][bj][m][0] * rs + (bj ? c10 : c00), v1 = acc[ai][bj][m][1] * rs + (bj ? c11 : c01);
                    u32x4 w; w.x = pk2(v0[0], v0[1]); w.y = pk2(v0[2], v0[3]); w.z = pk2(v1[0], v1[1]); w.w = pk2(v1[2], v1[3]);
                    if (col < ncols) *(u32x4*)(rowp + col) = w; }
            }
    }
};
struct EpiResidN {
    static constexpr bool PERM = true, AFTER_DRAIN = false;
    const float* xin_p; const float* xin_s; float* xout; const float* gate_base;
    const float* gnext; const float* scn_base; bf16* xg; float* ss; float coef;
    __device__ __forceinline__ void operator()(AccRef acc, const Unit& u, int wr, int wc, int fr, int fq) const {
        const int cond = u.pm < 32 ? 0 : 1 + ((u.pm - 32) >> 2);
        const float* gate = gate_base + (size_t)cond * 9216; const float* scn = scn_base + (size_t)cond * 9216;
        const int row0 = u.pm * 256 + wr * 64 + fr, col0 = u.pn * 256 + wc * 32 + 8 * fq;
        float sq[2][4];
#pragma unroll
        for (int ai = 0; ai < 2; ++ai)
#pragma unroll
            for (int m = 0; m < 4; ++m) sq[ai][m] = 0.f;
        const float* xb = u.pm < 32 ? xin_p : xin_s - (size_t)MP * DM;
        const unsigned off0 = (unsigned)(row0 * DM + col0);
#pragma unroll
        for (int bj = 0; bj < 2; ++bj) {
            const int col = col0 + bj * 128;
            f32x4 gv[2], G[2];
#pragma unroll
            for (int n = 0; n < 2; ++n) { gv[n] = *(const f32x4*)(gate + col + 4 * n) * coef; G[n] = *(const f32x4*)(gnext + col + 4 * n) * (*(const f32x4*)(scn + col + 4 * n) + 1.0f); }
#pragma unroll
            for (int ai = 0; ai < 2; ++ai) {
                f32x4 xv[4][2];
#pragma unroll
                for (int m = 0; m < 4; ++m)
#pragma unroll
                    for (int n = 0; n < 2; ++n) xv[m][n] = *(const f32x4*)(xb + (off0 + (unsigned)((ai * 128 + m * 16) * DM + bj * 128 + 4 * n)));
                asm volatile("" ::: "memory");
#pragma unroll
                for (int m = 0; m < 4; ++m) {
                    const unsigned off = off0 + (unsigned)((ai * 128 + m * 16) * DM + bj * 128);
                    const f32x4 x0 = xv[m][0] + gv[0] * acc[ai][bj][m][0], x1 = xv[m][1] + gv[1] * acc[ai][bj][m][1];
                    *(f32x4*)(xout + off) = x0; *(f32x4*)(xout + off + 4) = x1;
                    const u32x2 w0 = pk4(x0 * G[0]), w1 = pk4(x1 * G[1]);
                    *(u32x4*)(xg + off) = (u32x4){w0.x, w0.y, w1.x, w1.y};
                    sq[ai][m] += x0.x * x0.x + x0.y * x0.y + x0.z * x0.z + x0.w * x0.w + x1.x * x1.x + x1.y * x1.y + x1.z * x1.z + x1.w * x1.w;
                }
                asm volatile("" ::: "memory");
            }
        }
#pragma unroll
        for (int ai = 0; ai < 2; ++ai)
#pragma unroll
            for (int m = 0; m < 4; ++m) {
                float t = sq[ai][m]; t += __shfl_xor(t, 16); t += __shfl_xor(t, 32);
                if (fq == 0) ss[(u.pn * 4 + wc) * M_TOK + row0 + ai * 128 + m * 16] = t;
            }
    }
};
struct EpiResid {
    static constexpr bool PERM = true, AFTER_DRAIN = false;
    const float* xin_p; const float* xin_s; float* xout; const float* gate_base; float coef;
    __device__ __forceinline__ void operator()(AccRef acc, const Unit& u, int wr, int wc, int fr, int fq) const {
        const int cond = u.pm < 32 ? 0 : 1 + ((u.pm - 32) >> 2);
        const float* gate = gate_base + (size_t)cond * 9216;
        const int row0 = u.pm * 256 + wr * 64 + fr, col0 = u.pn * 256 + wc * 32 + 8 * fq;
        const float* xb = u.pm < 32 ? xin_p : xin_s - (size_t)MP * DM;
        const unsigned off0 = (unsigned)(row0 * DM + col0);
#pragma unroll
        for (int bj = 0; bj < 2; ++bj) {
            const f32x4 gv0 = *(const f32x4*)(gate + col0 + bj * 128) * coef, gv1 = *(const f32x4*)(gate + col0 + bj * 128 + 4) * coef;
#pragma unroll
            for (int ai = 0; ai < 2; ++ai) {
                f32x4 xv[4][2];
#pragma unroll
                for (int m = 0; m < 4; ++m)
#pragma unroll
                    for (int n = 0; n < 2; ++n) xv[m][n] = *(const f32x4*)(xb + (off0 + (unsigned)((ai * 128 + m * 16) * DM + bj * 128 + 4 * n)));
                asm volatile("" ::: "memory");
#pragma unroll
                for (int m = 0; m < 4; ++m) {
                    const unsigned off = off0 + (unsigned)((ai * 128 + m * 16) * DM + bj * 128);
                    *(f32x4*)(xout + off) = xv[m][0] + gv0 * acc[ai][bj][m][0]; *(f32x4*)(xout + off + 4) = xv[m][1] + gv1 * acc[ai][bj][m][1];
                }
                asm volatile("" ::: "memory");
            }
        }
    }
};
struct EpiStore {
    static constexpr bool PERM = true, AFTER_DRAIN = false;
    bf16* O; int ldc; int ncols;
    __device__ __forceinline__ void operator()(AccRef acc, const Unit& u, int wr, int wc, int fr, int fq) const {
        const int row0 = u.pm * 256 + wr * 64 + fr, col0 = u.pn * 256 + wc * 32 + 8 * fq;
#pragma unroll
        for (int ai = 0; ai < 2; ++ai)
#pragma unroll
            for (int m = 0; m < 4; ++m) {
                bf16* rowp = O + (size_t)(row0 + ai * 128 + m * 16) * ldc;
#pragma unroll
                for (int bj = 0; bj < 2; ++bj) { const int col = col0 + bj * 128; const f32x4 v0 = acc[ai][bj][m][0], v1 = acc[ai][bj][m][1];
                    u32x4 w; w.x = pk2(v0[0], v0[1]); w.y = pk2(v0[2], v0[3]); w.z = pk2(v1[0], v1[1]); w.w = pk2(v1[2], v1[3]);
                    if (col < ncols) *(u32x4*)(rowp + col) = w; }
            }
    }
};
struct EpiLora {
    static constexpr bool PERM = true, AFTER_DRAIN = false;
    bf16* O; const float* w0; const float* a0;
    __device__ __forceinline__ void operator()(AccRef acc, const Unit& u, int wr, int wc, int fr, int fq) const {
        const int seg = u.pn >> 1;
        const float* bias = seg < 2 ? w0 + seg * 512 : a0 + (seg & 1) * 512;
        const int row0 = u.pm * 256 + wr * 64 + fr, ct0 = wc * 32 + 8 * fq;
#pragma unroll
        for (int bj = 0; bj < 2; ++bj) {
            const int cseg = (u.pn & 1) * 256 + ct0 + bj * 128;
            f32x4 b0 = {0.f, 0.f, 0.f, 0.f}, b1 = {0.f, 0.f, 0.f, 0.f};
            if (seg < 4) { b0 = *(const f32x4*)(bias + cseg); b1 = *(const f32x4*)(bias + cseg + 4); }
#pragma unroll
            for (int ai = 0; ai < 2; ++ai)
#pragma unroll
                for (int m = 0; m < 4; ++m) {
                    f32x4 v0 = acc[ai][bj][m][0] + b0, v1 = acc[ai][bj][m][1] + b1;
                    if (seg < 4) {
                        const float sc = seg < 2 ? 0.60653066f : 1.0f;
#pragma unroll
                        for (int i = 0; i < 4; ++i) { v0[i] = sc * sigmoidf_(v0[i]); v1[i] = sc * sigmoidf_(v1[i]); }
                    }
                    u32x4 w; w.x = pk2(v0[0], v0[1]); w.y = pk2(v0[2], v0[3]); w.z = pk2(v1[0], v1[1]); w.w = pk2(v1[2], v1[3]);
                    *(u32x4*)(O + (size_t)(row0 + ai * 128 + m * 16) * 2560 + u.pn * 256 + ct0 + bj * 128) = w;
                    asm volatile("" ::: "memory");
                }
        }
    }
};
struct EpiQ {
    static constexpr bool PERM = true, AFTER_DRAIN = false;
    bf16* O; const float* rope;
    __device__ __forceinline__ void operator()(AccRef acc, const Unit& u, int wr, int wc, int fr, int fq) const {
        const int row0 = u.pm * 256 + wr * 64 + fr, col0 = u.pn * 256 + wc * 32 + 8 * fq;
        const float qs = 0.10206207261596577f;
#pragma unroll
        for (int bj = 0; bj < 2; ++bj) {
            const int col = col0 + bj * 128, e0 = col % 96;
            const bool is_rope = e0 >= 64;
#pragma unroll
            for (int ai = 0; ai < 2; ++ai)
#pragma unroll
                for (int m = 0; m < 4; ++m) {
                    const int row = row0 + ai * 128 + m * 16;
                    f32x4 v0 = acc[ai][bj][m][0] * qs, v1 = acc[ai][bj][m][1] * qs;
                    if (is_rope && row >= MP) {
                        const int t = (row - MP) & 1023;
                        const float* rt = rope + (size_t)t * 32 + (e0 - 64);
                        const f32x4 c0 = *(const f32x4*)(rt), c1 = *(const f32x4*)(rt + 4);
                        f32x4 r0, r1;
                        r0[0] = v0[0] * c0[0] - v0[1] * c0[1]; r0[1] = v0[0] * c0[1] + v0[1] * c0[0];
                        r0[2] = v0[2] * c0[2] - v0[3] * c0[3]; r0[3] = v0[2] * c0[3] + v0[3] * c0[2];
                        r1[0] = v1[0] * c1[0] - v1[1] * c1[1]; r1[1] = v1[0] * c1[1] + v1[1] * c1[0];
                        r1[2] = v1[2] * c1[2] - v1[3] * c1[3]; r1[3] = v1[2] * c1[3] + v1[3] * c1[2];
                        v0 = r0; v1 = r1;
                    }
                    u32x4 w; w.x = pk2(v0[0], v0[1]); w.y = pk2(v0[2], v0[3]); w.z = pk2(v1[0], v1[1]); w.w = pk2(v1[2], v1[3]);
                    *(u32x4*)(O + (size_t)row * 768 + col) = w;
                    asm volatile("" ::: "memory");
                }
        }
    }
};

struct EpiKV {
    static constexpr bool PERM = true, AFTER_DRAIN = false;
    bf16* KN; bf16* VT; int nrows;
    __device__ __forceinline__ void operator()(AccRef acc, const Unit& u, int wr, int wc, int fr, int fq) const {
        const int row0 = u.pm * 256 + wr * 64 + fr, col0 = u.pn * 256 + wc * 32 + 8 * fq;
#pragma unroll
        for (int bj = 0; bj < 2; ++bj) {
            const int col = col0 + bj * 128, head = col >> 7, e0 = col & 127;
#pragma unroll
            for (int ai = 0; ai < 2; ++ai)
#pragma unroll
                for (int m = 0; m < 4; ++m) {
                    const int row = row0 + ai * 128 + m * 16;
                    const f32x4 v0 = acc[ai][bj][m][0], v1 = acc[ai][bj][m][1];
                    u32x4 w; w.x = pk2(v0[0], v0[1]); w.y = pk2(v0[2], v0[3]); w.z = pk2(v1[0], v1[1]); w.w = pk2(v1[2], v1[3]);
                    if (e0 < 64) *(u32x4*)(KN + (size_t)row * 512 + head * 64 + e0) = w;
                    else { bf16* vp = VT + (size_t)(head * 64 + e0 - 64) * nrows + row;
#pragma unroll
                        for (int i = 0; i < 4; ++i) { vp[(size_t)(2 * i) * nrows] = (bf16)(w[i] & 0xffffu); vp[(size_t)(2 * i + 1) * nrows] = (bf16)(w[i] >> 16); } }
                }
        }
    }
};

__device__ __forceinline__ void adaln_layer(const P& p, LAS unsigned char* lds, int l, int bfirst) {
    LAS float* scv = (LAS float*)lds;
    LAS float* red = scv + 9 * 1024;
    const int tid = tid_opaque(), tx = tid % 18, ty = tid / 18;
    const float* cc = p.in[6]; const float* cctx = p.in[7];
    float* mod = (float*)(p.ws + WS_MOD);
    if ((int)blockIdx.x < bfirst) return;
    __syncthreads();
    for (int i = tid; i < 9 * 1024; i += NTHREADS) { const int c = i >> 10, k = i & 1023; const float v = c == 0 ? cctx[k] : cc[(c - 1) * 1024 + k]; scv[i] = v / (1.0f + expf(-v)); }
    __syncthreads();
    for (int cgp = blockIdx.x - bfirst; cgp < 128; cgp += gridDim.x - bfirst) {
        const int col0 = cgp * 72 + tx * 4;
        const float* W = p.in[8] + (size_t)l * 1024 * 9216;
        f32x4 acc[9];
#pragma unroll
        for (int c = 0; c < 9; ++c) acc[c] = (f32x4){0.f, 0.f, 0.f, 0.f};
        if (ty < 28) {
#pragma unroll 8
            for (int k = ty; k < 1024; k += 28) {
                const f32x4 w = *(const f32x4*)(W + (size_t)k * 9216 + col0);
#pragma unroll
                for (int c = 0; c < 9; ++c) acc[c] += w * scv[c * 1024 + k];
            }
#pragma unroll
            for (int c = 0; c < 9; ++c) *(LAS f32x4*)(red + ty * 648 + c * 72 + tx * 4) = acc[c];
        }
        __syncthreads();
        for (int o = tid; o < 648; o += NTHREADS) {
            float s = 0.f;
            for (int y = 0; y < 28; ++y) s += red[y * 648 + o];
            const int c = o / 72, j = o % 72;
            mod[(size_t)(l * 9 + c) * 9216 + cgp * 72 + j] = s + p.in[9][l * 9216 + cgp * 72 + j];
        }
        __syncthreads();
    }
}
__device__ __forceinline__ void ph_rope_table(const P& p) {
    const int tid = tid_opaque();
    float* rope = (float*)(p.ws + WS_ROPE);
    for (int idx = blockIdx.x * NTHREADS + tid; idx < 1024 * 16; idx += gridDim.x * NTHREADS) {
        const int t = idx >> 4, i = idx & 15;
        const float pos = (float)(i < 8 ? (t >> 6) : (t & 63));
        const float inv = powf(10000.0f, -(float)(i & 7) / 8.0f);
        const float ang = pos * inv;
        rope[idx * 2] = cosf(ang); rope[idx * 2 + 1] = sinf(ang);
    }
}

__device__ __forceinline__ void norm_rows(const P& p, int layer, int j, const float* gvec, bool from_input) {
    const int tid = tid_opaque(), lane = tid & 63, wave = tid >> 6;
    const float* mod = (const float*)(p.ws + WS_MOD);
    const float* x = p.out;
    bf16* h = (bf16*)(p.ws + WS_H);
    const int nw = gridDim.x * 8;
    for (int row0 = blockIdx.x * 8 + wave; row0 < M_TOK; row0 += 4 * nw) {
        f32x4 v[4][4]; float ss[4];
#pragma unroll
        for (int r = 0; r < 4; ++r) {
            const int row = (row0 + r * nw) < M_TOK ? (row0 + r * nw) : (M_TOK - 1);
            const float* xr = from_input ? (row < MP ? p.in[0] + (size_t)row * DM : p.in[1] + (size_t)(row - MP) * DM) : x + (size_t)row * DM;
#pragma unroll
            for (int q = 0; q < 4; ++q) v[r][q] = *(const f32x4*)(xr + lane * 4 + 256 * q);
        }
#pragma unroll
        for (int r = 0; r < 4; ++r) { float s = 0.f;
#pragma unroll
            for (int q = 0; q < 4; ++q) s += v[r][q].x * v[r][q].x + v[r][q].y * v[r][q].y + v[r][q].z * v[r][q].z + v[r][q].w * v[r][q].w;
            ss[r] = s; }
#pragma unroll
        for (int o = 1; o < 64; o <<= 1) {
#pragma unroll
            for (int r = 0; r < 4; ++r) ss[r] += __shfl_xor(ss[r], o); }
#pragma unroll
        for (int r = 0; r < 4; ++r) {
            const int row = row0 + r * nw; if (row >= M_TOK) break;
            const float rstd = 1.0f / sqrtf(ss[r] * (1.0f / 1024.0f) + 1e-6f);
            const float* mrow = mod + (size_t)(layer * 9 + cond_of_row(row)) * 9216;
            const float* sh = mrow + (3 * j) * 1024; const float* sc = mrow + (3 * j + 1) * 1024;
#pragma unroll
            for (int q = 0; q < 4; ++q) {
                const int col = lane * 4 + 256 * q;
                const f32x4 g = *(const f32x4*)(gvec + col), s1 = *(const f32x4*)(sc + col), s0 = *(const f32x4*)(sh + col);
                const f32x4 y = (v[r][q] * rstd * g) * (s1 + 1.0f) + s0;
                *(u32x2*)(h + (size_t)row * DM + col) = pk4(y);
            }
        }
    }
}
__device__ __forceinline__ void first_rows(const P& p, const float* gvec, float* ss) {
    const int tid = tid_opaque(), lane = tid & 63, wave = tid >> 6;
    const float* mod = (const float*)(p.ws + WS_MOD);
    bf16* h = (bf16*)(p.ws + WS_H);
    const int nw = gridDim.x * 8;
    for (int row0 = blockIdx.x * 8 + wave; row0 < M_TOK; row0 += 4 * nw) {
        f32x4 v[4][4]; float sq[4];
#pragma unroll
        for (int r = 0; r < 4; ++r) {
            const int row = (row0 + r * nw) < M_TOK ? (row0 + r * nw) : (M_TOK - 1);
            const float* xr = row < MP ? p.in[0] + (size_t)row * DM : p.in[1] + (size_t)(row - MP) * DM;
#pragma unroll
            for (int q = 0; q < 4; ++q) v[r][q] = *(const f32x4*)(xr + lane * 4 + 256 * q);
        }
#pragma unroll
        for (int r = 0; r < 4; ++r) { float t = 0.f;
#pragma unroll
            for (int q = 0; q < 4; ++q) t += v[r][q].x * v[r][q].x + v[r][q].y * v[r][q].y + v[r][q].z * v[r][q].z + v[r][q].w * v[r][q].w;
            sq[r] = t; }
#pragma unroll
        for (int o = 1; o < 64; o <<= 1) {
#pragma unroll
            for (int r = 0; r < 4; ++r) sq[r] += __shfl_xor(sq[r], o); }
#pragma unroll
        for (int r = 0; r < 4; ++r) {
            const int row = row0 + r * nw; if (row >= M_TOK) break;
            if (lane == 0) ss[row] = rsqrtf_(sq[r] * (1.0f / 1024.0f) + 1e-6f);
            const float* sc = mod + (size_t)cond_of_row(row) * 9216 + 1024;
#pragma unroll
            for (int q = 0; q < 4; ++q) { const int col = lane * 4 + 256 * q;
                *(u32x2*)(h + (size_t)row * DM + col) = pk4(v[r][q] * (*(const f32x4*)(gvec + col) * (*(const f32x4*)(sc + col) + 1.0f))); }
        }
    }
}
__device__ __forceinline__ void final_norm_rows(const P& p) {
    const int tid = tid_opaque(), lane = tid & 63, wave = tid >> 6;
    float* x = p.out; const float* gvec = p.in[47];
    const int nw = gridDim.x * 8;
    for (int row0 = blockIdx.x * 8 + wave; row0 < M_TOK; row0 += 4 * nw) {
        f32x4 v[4][4]; float ss[4];
#pragma unroll
        for (int r = 0; r < 4; ++r) { const int row = (row0 + r * nw) < M_TOK ? (row0 + r * nw) : (M_TOK - 1);
#pragma unroll
            for (int q = 0; q < 4; ++q) v[r][q] = *(const f32x4*)(x + (size_t)row * DM + lane * 4 + 256 * q); }
#pragma unroll
        for (int r = 0; r < 4; ++r) { float s = 0.f;
#pragma unroll
            for (int q = 0; q < 4; ++q) s += v[r][q].x * v[r][q].x + v[r][q].y * v[r][q].y + v[r][q].z * v[r][q].z + v[r][q].w * v[r][q].w;
            ss[r] = s; }
#pragma unroll
        for (int o = 1; o < 64; o <<= 1) {
#pragma unroll
            for (int r = 0; r < 4; ++r) ss[r] += __shfl_xor(ss[r], o); }
#pragma unroll
        for (int r = 0; r < 4; ++r) { const int row = row0 + r * nw; if (row >= M_TOK) break;
            const float rstd = rsqrtf_(ss[r] * (1.0f / 1024.0f) + 1e-6f);
#pragma unroll
            for (int q = 0; q < 4; ++q) { const int col = lane * 4 + 256 * q; *(f32x4*)(x + (size_t)row * DM + col) = v[r][q] * rstd * *(const f32x4*)(gvec + col); } }
    }
}

template <int MODE>
__device__ __forceinline__ void transpose_w(const float* W, int ldw, int ncols_valid, int K, bf16* WT, int Nt, LAS unsigned char* lds, const float* shift = nullptr, float* cvo = nullptr, int ncv = 0, int rot = 0) {
    const int tid = tid_opaque(), lane = tid & 63, wave = tid >> 6;
    LAS float* scr = (LAS float*)(lds + wave * 16640);
    LAS float* shs = (LAS float*)(lds + 8 * 16640 + wave * 3072);
    const int nblk = Nt / 64, nitems = nblk * (K / 64);
    int vb = ((int)blockIdx.x + (int)gridDim.x - rot % (int)gridDim.x) % (int)gridDim.x;
    for (int it = vb * 8 + wave; it < nitems; it += gridDim.x * 8) {
        const int kb = it / nblk, nb = it % nblk, k0 = kb * 64;
        const int g0 = 2 * nb;
        const int sc0 = MODE == 1 ? (((g0 >> 2) & 1) * DFF + (g0 >> 3) * 128 + (g0 & 3) * 32) : nb * 64;
        const int c4 = (lane & 15) * 4, kr = lane >> 4; const bool ok = (sc0 + c4) < ncols_valid;
        f32x4 t[16];
#pragma unroll
        for (int i = 0; i < 16; ++i) t[i] = ok ? *(const f32x4*)(W + (size_t)(k0 + 4 * i + kr) * ldw + sc0 + c4) : (f32x4){0.f, 0.f, 0.f, 0.f};
#pragma unroll
        for (int i = 0; i < 16; ++i) { LAS float* d = scr + (4 * i + kr) * 65 + c4; d[0] = t[i].x; d[1] = t[i].y; d[2] = t[i].z; d[3] = t[i].w; }
        if (shift) {
#pragma unroll
            for (int cc = 0; cc < 9; ++cc) shs[lane * 12 + cc] = shift[(size_t)cc * 9216 + k0 + lane];
        }
        LDS_WAIT();
        if (shift) {
            float a9[9];
#pragma unroll
            for (int cc = 0; cc < 9; ++cc) a9[cc] = 0.f;
#pragma unroll 4
            for (int k = 0; k < 64; ++k) {
                const float w = scr[k * 65 + lane];
                const f32x4 s0 = *(const LAS f32x4*)(shs + k * 12), s1 = *(const LAS f32x4*)(shs + k * 12 + 4); const float s8 = shs[k * 12 + 8];
                a9[0] += w * s0.x; a9[1] += w * s0.y; a9[2] += w * s0.z; a9[3] += w * s0.w; a9[4] += w * s1.x; a9[5] += w * s1.y; a9[6] += w * s1.z; a9[7] += w * s1.w; a9[8] += w * s8;
            }
#pragma unroll
            for (int cc = 0; cc < 9; ++cc) __hip_atomic_fetch_add(cvo + (size_t)cc * ncv + nb * 64 + lane, a9[cc], __ATOMIC_RELAXED, __HIP_MEMORY_SCOPE_AGENT);
        }
        const int c = lane & 7;
#pragma unroll
        for (int j = 0; j < 8; ++j) {
            const int nn = (lane >> 3) + 8 * j; const LAS float* sp = scr + (8 * c) * 65 + nn;
            u32x4 o; o.x = pk2(sp[0 * 65], sp[1 * 65]); o.y = pk2(sp[2 * 65], sp[3 * 65]); o.z = pk2(sp[4 * 65], sp[5 * 65]); o.w = pk2(sp[6 * 65], sp[7 * 65]);
            *(u32x4*)(WT + (size_t)(nb * 64 + nn) * K + k0 + 8 * c) = o;
        }
        LDS_WAIT();
    }
}
__device__ __forceinline__ void convert_ffn_weights(const P& p, int layer, int which, LAS unsigned char* lds, const float* shift, float* cvo) {
    const float* wgu = p.in[which == 0 ? 13 : 15] + (size_t)layer * 1024 * 5632;
    const float* wdn = p.in[which == 0 ? 14 : 16] + (size_t)layer * 2816 * 1024;
    transpose_w<1>(wgu, 5632, 5632, 1024, (bf16*)(p.ws + W_GU), 5632, lds, shift, cvo, 5632);
    transpose_w<0>(wdn, 1024, 1024, 2816, (bf16*)(p.ws + W_DOWN), 1024, lds, nullptr, nullptr, 0, 176);
}
__device__ __forceinline__ void build_lora_w(const P& p) {
    bf16* WT = (bf16*)(p.ws + W_LORA);
    const float* w_up = p.in[21]; const float* a_up = p.in[23]; const float* g_up = p.in[24];
    for (int idx = blockIdx.x * NTHREADS + tid_opaque(); idx < 2560 * 384; idx += gridDim.x * NTHREADS) {
        const int n = idx / 384, k = idx % 384, seg = n >> 9, c = n & 511;
        float v = 0.f;
        if (seg == 0) { if (k < 64) v = w_up[(0 * 64 + k) * 512 + c]; }
        else if (seg == 1) { if (k >= 64 && k < 128) v = w_up[(1 * 64 + k - 64) * 512 + c]; }
        else if (seg == 2) { if (k >= 128 && k < 192) v = a_up[(0 * 64 + k - 128) * 512 + c]; }
        else if (seg == 3) { if (k >= 192 && k < 256) v = a_up[(1 * 64 + k - 192) * 512 + c]; }
        else { if (k >= 256) v = g_up[(k - 256) * 512 + c]; }
        WT[(size_t)n * 384 + k] = (bf16)(pk2(v, 0.f) & 0xffffu);
    }
}

__device__ __forceinline__ void ph_lora_in(const P& p) {
    const int tid = tid_opaque(), lane = tid & 63, wave = tid >> 6;
    const bf16* p0 = (const bf16*)(p.ws + WS_R1); bf16* LA = (bf16*)(p.ws + WS_H);
    const float* mu = p.in[19];
    const int nw = gridDim.x * 8;
    float m0[3], m1[3];
#pragma unroll
    for (int ch = 0; ch < 3; ++ch) { m0[ch] = mu[1536 + ch * 128 + lane * 2]; m1[ch] = mu[1536 + ch * 128 + lane * 2 + 1]; }
    for (int row0 = blockIdx.x * 8 + wave; row0 < M_TOK; row0 += 4 * nw) {
        unsigned cur[4][3], prv[4][3], nxt[4][3];
#pragma unroll
        for (int r = 0; r < 4; ++r) {
            const int row = (row0 + r * nw) < M_TOK ? (row0 + r * nw) : (M_TOK - 1);
            const int t = row < MP ? (row & 255) : ((row - MP) & 1023), L = row < MP ? 256 : 1024;
            const bool hp = t > 0, hn = t < L - 1;
#pragma unroll
            for (int ch = 0; ch < 3; ++ch) {
                const bf16* pc = p0 + (size_t)row * LDP0 + 1536 + ch * 128 + lane * 2;
                cur[r][ch] = *(const unsigned*)pc; prv[r][ch] = hp ? *(const unsigned*)(pc - LDP0) : 0u; nxt[r][ch] = hn ? *(const unsigned*)(pc + LDP0) : 0u;
            }
        }
#pragma unroll
        for (int r = 0; r < 4; ++r) {
            const int row = row0 + r * nw; if (row >= M_TOK) break;
#pragma unroll
            for (int ch = 0; ch < 3; ++ch) {
                float a0 = bflo(cur[r][ch]) + m0[ch] * (0.5f * (bflo(prv[r][ch]) + bflo(nxt[r][ch])) - bflo(cur[r][ch]));
                float a1 = bfhi(cur[r][ch]) + m1[ch] * (0.5f * (bfhi(prv[r][ch]) + bfhi(nxt[r][ch])) - bfhi(cur[r][ch]));
                if (ch == 0) { a0 = tanhf(a0); a1 = tanhf(a1); }
                if (ch == 2) { a0 = sigmoidf_(a0); a1 = sigmoidf_(a1); }
                *(unsigned*)(LA + (size_t)row * 384 + ch * 128 + lane * 2) = pk2(a0, a1);
            }
        }
    }
}

__device__ __forceinline__ void rwkv_item(const P& p, LAS unsigned char* lds, int kind, int b, int head, int dir) {
    constexpr int T = 32, NG = 8, GS = 1408;
    LAS float* grp = (LAS float*)lds;
    LAS float* raw = grp + 2 * NG * GS;
    LAS float* ybR = raw + T * 320;
    const int tid = tid_opaque(), lane = tid & 63, wave = tid >> 6, q = lane & 7, vl = lane >> 3, r0 = wave * 8 + vl;
    const int tt = tid >> 4, cgi = tid & 15;
    const int L = kind ? 1024 : 256, nblk = L / T;
    const int rowbase = kind ? MP + b * 1024 : b * 256;
    const bf16* p0 = (const bf16*)(p.ws + WS_R1);
    const bf16* lo = (const bf16*)(p.ws + WS_R2);
    bf16* Y = (bf16*)(p.ws + (dir == 0 ? WS_MIX : WS_H));
    const int colbase = head * 64;
    f32x2 S[4];
#pragma unroll
    for (int i = 0; i < 4; ++i) S[i] = (f32x2){0.f, 0.f};
    if (kind) { const float* s0 = p.in[2] + (((size_t)b * 2 + dir) * 8 + head) * 4096 + q * 8;
        const f32x4 a0 = *(const f32x4*)(s0 + r0 * 64), a1 = *(const f32x4*)(s0 + r0 * 64 + 4);
        S[0] = (f32x2){a0.x, a0.y}; S[1] = (f32x2){a0.z, a0.w}; S[2] = (f32x2){a1.x, a1.y}; S[3] = (f32x2){a1.z, a1.w}; }
    const int C = head * 64 + cgi * 4;
    const f32x4 cA = *(const f32x4*)(p.in[19] + C), cB = *(const f32x4*)(p.in[19] + 512 + C), cC = *(const f32x4*)(p.in[19] + 1024 + C);
    const f32x4 cD = *(const f32x4*)(p.in[25] + C), cE = *(const f32x4*)(p.in[26] + C);
    u32x2 ra0, ra1, ra2, rb0, rb1, rb2, rc0, rc1, rc2, rd, re;
    const u32x2 z2 = {0u, 0u};
#define RW_LOAD(blk) do { \
        const int n_ = (blk) * T + tt, t_ = dir ? L - 1 - n_ : n_; const size_t row_ = (size_t)(rowbase + t_); \
        const bool hp_ = t_ > 0, hn_ = t_ < L - 1; \
        const bf16* pr_ = p0 + row_ * LDP0 + head * 64 + cgi * 4; \
        ra1 = *(const u32x2*)pr_; ra0 = hp_ ? *(const u32x2*)(pr_ - LDP0) : z2; ra2 = hn_ ? *(const u32x2*)(pr_ + LDP0) : z2; \
        rb1 = *(const u32x2*)(pr_ + 512); rb0 = hp_ ? *(const u32x2*)(pr_ + 512 - LDP0) : z2; rb2 = hn_ ? *(const u32x2*)(pr_ + 512 + LDP0) : z2; \
        rc1 = *(const u32x2*)(pr_ + 1024); rc0 = hp_ ? *(const u32x2*)(pr_ + 1024 - LDP0) : z2; rc2 = hn_ ? *(const u32x2*)(pr_ + 1024 + LDP0) : z2; \
        rd = *(const u32x2*)(lo + row_ * 2560 + dir * 512 + head * 64 + cgi * 4); re = *(const u32x2*)(lo + row_ * 2560 + 1024 + dir * 512 + head * 64 + cgi * 4); \
    } while (0)
#define RW_PREP1(bi) do { \
        LAS float* rw_ = raw + tt * 320; const int c4_ = cgi * 4; \
        const f32x4 r1_ = unpk4(ra1), k1_ = unpk4(rb1), v1_ = unpk4(rc1); \
        const f32x4 r_ = r1_ + cA * ((unpk4(ra0) + unpk4(ra2)) * 0.5f - r1_); \
        const f32x4 k_ = k1_ + cB * ((unpk4(rb0) + unpk4(rb2)) * 0.5f - k1_); \
        const f32x4 v_ = v1_ + cC * ((unpk4(rc0) + unpk4(rc2)) * 0.5f - v1_); \
        f32x4 kk_ = k_ * cD; \
        const float ss_ = red16(kk_.x * kk_.x + kk_.y * kk_.y + kk_.z * kk_.z + kk_.w * kk_.w); \
        kk_ = kk_ * rsqrtf_(ss_ + 1e-6f); \
        const f32x4 ew_ = unpk4(rd), a_ = unpk4(re); \
        f32x4 w_; w_.x = __expf(-ew_.x); w_.y = __expf(-ew_.y); w_.z = __expf(-ew_.z); w_.w = __expf(-ew_.w); \
        *(LAS f32x4*)(rw_ + c4_) = kk_; *(LAS f32x4*)(rw_ + 64 + c4_) = w_; *(LAS f32x4*)(rw_ + 128 + c4_) = kk_ * a_; \
        *(LAS f32x4*)(rw_ + 192 + c4_) = k_ * ((a_ - 1.0f) * cE + 1.0f); *(LAS f32x4*)(rw_ + 256 + c4_) = r_; \
        *(LAS f32x4*)(grp + ((bi) * NG + (tt >> 2)) * GS + 1088 + (tt & 3) * 64 + c4_) = v_; \
    } while (0)
#define DOT16(aa_, bb_) red16((aa_)[0] * (bb_)[0] + (aa_)[1] * (bb_)[1] + (aa_)[2] * (bb_)[2] + (aa_)[3] * (bb_)[3])
#define RW_PREP2(bi) do { if (tid < 128) { \
        const int gq_ = tid >> 4, c4_ = cgi * 4; const LAS float* r4_ = raw + gq_ * 4 * 320 + c4_; LAS float* gi_ = grp + ((bi) * NG + gq_) * GS; \
        const f32x4 kk1 = *(const LAS f32x4*)(r4_), w1 = *(const LAS f32x4*)(r4_ + 64), b1 = *(const LAS f32x4*)(r4_ + 128), d1 = *(const LAS f32x4*)(r4_ + 192), q1 = *(const LAS f32x4*)(r4_ + 256); \
        const f32x4 kk2 = *(const LAS f32x4*)(r4_ + 320), w2 = *(const LAS f32x4*)(r4_ + 384), b2 = *(const LAS f32x4*)(r4_ + 448), d2 = *(const LAS f32x4*)(r4_ + 512), q2 = *(const LAS f32x4*)(r4_ + 576); \
        const f32x4 kk3 = *(const LAS f32x4*)(r4_ + 640), w3 = *(const LAS f32x4*)(r4_ + 704), b3 = *(const LAS f32x4*)(r4_ + 768), d3 = *(const LAS f32x4*)(r4_ + 832), q3 = *(const LAS f32x4*)(r4_ + 896); \
        const f32x4 kk4 = *(const LAS f32x4*)(r4_ + 960), w4 = *(const LAS f32x4*)(r4_ + 1024), b4 = *(const LAS f32x4*)(r4_ + 1088), d4 = *(const LAS f32x4*)(r4_ + 1152), q4 = *(const LAS f32x4*)(r4_ + 1216); \
        const f32x4 W02 = w1 * w2, W03 = W02 * w3, W04 = W03 * w4, W13 = w2 * w3, W14 = W13 * w4, W24 = w3 * w4; \
        *(LAS f32x4*)(gi_ + c4_) = kk1; *(LAS f32x4*)(gi_ + 64 + c4_) = w1 * kk2; *(LAS f32x4*)(gi_ + 128 + c4_) = W02 * kk3; *(LAS f32x4*)(gi_ + 192 + c4_) = W03 * kk4; \
        *(LAS f32x4*)(gi_ + 256 + c4_) = w1 * q1; *(LAS f32x4*)(gi_ + 320 + c4_) = W02 * q2; *(LAS f32x4*)(gi_ + 384 + c4_) = W03 * q3; *(LAS f32x4*)(gi_ + 448 + c4_) = W04 * q4; \
        *(LAS f32x4*)(gi_ + 512 + c4_) = d1 * W14; *(LAS f32x4*)(gi_ + 576 + c4_) = d2 * W24; *(LAS f32x4*)(gi_ + 640 + c4_) = d3 * w4; *(LAS f32x4*)(gi_ + 704 + c4_) = d4; \
        *(LAS f32x4*)(gi_ + 768 + c4_) = b1 * W14; *(LAS f32x4*)(gi_ + 832 + c4_) = b2 * W24; *(LAS f32x4*)(gi_ + 896 + c4_) = b3 * w4; *(LAS f32x4*)(gi_ + 960 + c4_) = b4; \
        *(LAS f32x4*)(gi_ + 1024 + c4_) = W04; \
        const f32x4 d1w2 = d1 * w2, d1w13 = d1 * W13, d1w14 = d1 * W14, d2w3 = d2 * w3, d2w24 = d2 * W24, d3w4 = d3 * w4; \
        const f32x4 b1w2 = b1 * w2, b1w13 = b1 * W13, b1w14 = b1 * W14, b2w3 = b2 * w3, b2w24 = b2 * W24, b3w4 = b3 * w4; \
        float sc_[32]; \
        sc_[0] = DOT16(d1, kk2); sc_[1] = DOT16(d1w2, kk3); sc_[2] = DOT16(d2, kk3); sc_[3] = DOT16(d1w13, kk4); sc_[4] = DOT16(d2w3, kk4); sc_[5] = DOT16(d3, kk4); \
        sc_[6] = DOT16(b1, kk2); sc_[7] = DOT16(b1w2, kk3); sc_[8] = DOT16(b2, kk3); sc_[9] = DOT16(b1w13, kk4); sc_[10] = DOT16(b2w3, kk4); sc_[11] = DOT16(b3, kk4); \
        sc_[12] = DOT16(d1, q1); sc_[13] = DOT16(d1w2, q2); sc_[14] = DOT16(d2, q2); sc_[15] = DOT16(d1w13, q3); sc_[16] = DOT16(d2w3, q3); sc_[17] = DOT16(d3, q3); \
        sc_[18] = DOT16(d1w14, q4); sc_[19] = DOT16(d2w24, q4); sc_[20] = DOT16(d3w4, q4); sc_[21] = DOT16(d4, q4); \
        sc_[22] = DOT16(b1, q1); sc_[23] = DOT16(b1w2, q2); sc_[24] = DOT16(b2, q2); sc_[25] = DOT16(b1w13, q3); sc_[26] = DOT16(b2w3, q3); sc_[27] = DOT16(b3, q3); \
        sc_[28] = DOT16(b1w14, q4); sc_[29] = DOT16(b2w24, q4); sc_[30] = DOT16(b3w4, q4); sc_[31] = DOT16(b4, q4); \
        if (cgi < 8) { _Pragma("unroll") for (int i_ = 0; i_ < 8; ++i_) if (cgi == i_) *(LAS f32x4*)(gi_ + 1344 + 4 * i_) = (f32x4){sc_[4 * i_], sc_[4 * i_ + 1], sc_[4 * i_ + 2], sc_[4 * i_ + 3]}; } \
    } } while (0)
    __syncthreads();
    RW_LOAD(0); RW_PREP1(0);
    __syncthreads();
    RW_PREP2(0);
    __syncthreads();
#pragma unroll 1
    for (int blk = 0; blk < nblk; ++blk) {
        const int bi = blk & 1;
        if (blk + 1 < nblk) RW_LOAD(blk + 1);
        LAS float* yb = ybR + bi * T * 64;
#pragma unroll 1
        for (int g = 0; g < NG; ++g) {
            const LAS float* gi = grp + (bi * NG + g) * GS;
            float dp[4], du[4];
#pragma unroll
            for (int t = 0; t < 4; ++t) {
                const f32x4 pa = *(const LAS f32x4*)(gi + t * 64 + q * 8), pb = *(const LAS f32x4*)(gi + t * 64 + q * 8 + 4);
                const f32x4 ua = *(const LAS f32x4*)(gi + 256 + t * 64 + q * 8), ub = *(const LAS f32x4*)(gi + 256 + t * 64 + q * 8 + 4);
                const f32x2 a = __builtin_elementwise_fma(S[0], (f32x2){pa.x, pa.y}, S[1] * (f32x2){pa.z, pa.w}) + __builtin_elementwise_fma(S[2], (f32x2){pb.x, pb.y}, S[3] * (f32x2){pb.z, pb.w});
                const f32x2 c = __builtin_elementwise_fma(S[0], (f32x2){ua.x, ua.y}, S[1] * (f32x2){ua.z, ua.w}) + __builtin_elementwise_fma(S[2], (f32x2){ub.x, ub.y}, S[3] * (f32x2){ub.z, ub.w});
                dp[t] = a.x + a.y; du[t] = c.x + c.y;
            }
#pragma unroll
            for (int t = 0; t < 4; ++t) { dp[t] = red8(dp[t]); du[t] = red8(du[t]); }
            const float v1 = gi[1088 + r0], v2 = gi[1152 + r0], v3 = gi[1216 + r0], v4 = gi[1280 + r0];
            const f32x4 A0 = *(const LAS f32x4*)(gi + 1344), A1 = *(const LAS f32x4*)(gi + 1348), B0 = *(const LAS f32x4*)(gi + 1352), E0 = *(const LAS f32x4*)(gi + 1356);
            const f32x4 E1 = *(const LAS f32x4*)(gi + 1360), E2 = *(const LAS f32x4*)(gi + 1364), F0 = *(const LAS f32x4*)(gi + 1368), F1 = *(const LAS f32x4*)(gi + 1372);
            const float g1 = dp[0];
            const float g2 = dp[1] + v1 * A0.x - g1 * A1.z;
            const float g3 = dp[2] + v1 * A0.y + v2 * A0.z - g1 * A1.w - g2 * B0.x;
            const float g4 = dp[3] + v1 * A0.w + v2 * A1.x + v3 * A1.y - g1 * B0.y - g2 * B0.z - g3 * B0.w;
            const float y1 = du[0] + v1 * E0.x - g1 * E2.z;
            const float y2 = du[1] + v1 * E0.y + v2 * E0.z - g1 * E2.w - g2 * F0.x;
            const float y3 = du[2] + v1 * E0.w + v2 * E1.x + v3 * E1.y - g1 * F0.y - g2 * F0.z - g3 * F0.w;
            const float y4 = du[3] + v1 * E1.z + v2 * E1.w + v3 * E2.x + v4 * E2.y - g1 * F1.x - g2 * F1.y - g3 * F1.z - g4 * F1.w;
            if (q == 0) { yb[(4 * g) * 64 + r0] = y1; yb[(4 * g + 1) * 64 + r0] = y2; yb[(4 * g + 2) * 64 + r0] = y3; yb[(4 * g + 3) * 64 + r0] = y4; }
            {
                const f32x4 wa = *(const LAS f32x4*)(gi + 1024 + q * 8), wb = *(const LAS f32x4*)(gi + 1024 + q * 8 + 4);
                f32x2 n0 = S[0] * (f32x2){wa.x, wa.y}, n1 = S[1] * (f32x2){wa.z, wa.w}, n2 = S[2] * (f32x2){wb.x, wb.y}, n3 = S[3] * (f32x2){wb.z, wb.w};
                const float vv[4] = {v1, v2, v3, v4}, gg[4] = {g1, g2, g3, g4};
#pragma unroll
                for (int j = 0; j < 4; ++j) {
                    const f32x4 da = *(const LAS f32x4*)(gi + 512 + j * 64 + q * 8), db = *(const LAS f32x4*)(gi + 512 + j * 64 + q * 8 + 4);
                    const f32x4 ba = *(const LAS f32x4*)(gi + 768 + j * 64 + q * 8), bb = *(const LAS f32x4*)(gi + 768 + j * 64 + q * 8 + 4);
                    const f32x2 vj = {vv[j], vv[j]}, ng = {-gg[j], -gg[j]};
                    n0 = __builtin_elementwise_fma(vj, (f32x2){da.x, da.y}, n0); n1 = __builtin_elementwise_fma(vj, (f32x2){da.z, da.w}, n1);
                    n2 = __builtin_elementwise_fma(vj, (f32x2){db.x, db.y}, n2); n3 = __builtin_elementwise_fma(vj, (f32x2){db.z, db.w}, n3);
                    n0 = __builtin_elementwise_fma(ng, (f32x2){ba.x, ba.y}, n0); n1 = __builtin_elementwise_fma(ng, (f32x2){ba.z, ba.w}, n1);
                    n2 = __builtin_elementwise_fma(ng, (f32x2){bb.x, bb.y}, n2); n3 = __builtin_elementwise_fma(ng, (f32x2){bb.z, bb.w}, n3);
                }
                S[0] = n0; S[1] = n1; S[2] = n2; S[3] = n3;
            }
        }
        if (blk + 1 < nblk) RW_PREP1(bi ^ 1);
        __syncthreads();
        if (blk + 1 < nblk) RW_PREP2(bi ^ 1);
        {
            const int r4 = cgi * 4, n = blk * T + tt, tk = dir ? L - 1 - n : n;
            const f32x4 yv = *(const LAS f32x4*)(yb + tt * 64 + r4);
            *(u32x2*)(Y + (size_t)(rowbase + tk) * 1024 + colbase + r4) = pk4(yv);
        }
        __syncthreads();
    }
#undef RW_LOAD
#undef RW_PREP1
#undef RW_PREP2
#undef DOT16
    if (!kind) { float* so = p.out + OUT_SRW + (((size_t)b * 2 + dir) * 8 + head) * 4096 + q * 8;
        *(f32x4*)(so + r0 * 64) = (f32x4){S[0].x, S[0].y, S[1].x, S[1].y}; *(f32x4*)(so + r0 * 64 + 4) = (f32x4){S[2].x, S[2].y, S[3].x, S[3].y}; }
}

__device__ __forceinline__ void gdn_item(const P& p, LAS unsigned char* lds, int kind, int b, int head, int dir, int half) {
    LAS bf16* Qs = (LAS bf16*)(lds);
    LAS bf16* Ks = (LAS bf16*)(lds + 17408);
    LAS bf16* KT = (LAS bf16*)(lds + 34816);
    LAS bf16* VT = (LAS bf16*)(lds + 53248);
    LAS bf16* ST = (LAS bf16*)(lds + 62464);
    LAS float* Lm = (LAS float*)(lds + 79872);
    LAS bf16* vnT = (LAS bf16*)(lds + 79872);
    LAS bf16* vnsT = (LAS bf16*)(lds + 79872 + 9216);
    LAS float* Tm = (LAS float*)(lds + 98304);
    LAS bf16* Tb = (LAS bf16*)(lds + 115712);
    LAS bf16* QKg = (LAS bf16*)(lds + 124928);
    LAS bf16* rT = (LAS bf16*)(lds + 134144);
    LAS float* gs = (LAS float*)(lds + 143360);
    LAS float* bs = gs + 64;
    LAS float* Gs = gs + 128;
    LAS float* eGs = gs + 192;
    LAS float* eGl = gs + 256;
    LAS float* misc = gs + 320;
    LAS float* CW = (LAS float*)(lds + 144896);
    LAS float* Ysc = (LAS float*)(lds + 148736);
    const int tid = tid_opaque(), lane = tid & 63, wave = tid >> 6, ln = lane & 15, h4 = lane >> 4;
    const int L = kind ? 1024 : 256, nch = L / 64, rowbase = kind ? MP + b * 1024 : b * 256;
    const bf16* p0 = (const bf16*)(p.ws + WS_R1);
    bf16* Y = (bf16*)(p.ws + (dir == 0 ? WS_MIX : WS_H));
    const int colbase = 512 + head * 128 + half * 64;
    const int pi = tid >> 3, c8 = tid & 7;
    const float gA = -expf(p.in[31][dir * 4 + head]), gB = p.in[32][dir * 4 + head];
    __syncthreads();
    for (int e = tid; e < 960; e += NTHREADS) {
        float v;
        if (e < 768) { const int part = e / 384, r = e % 384, tap = r >> 7, d = r & 127; v = p.in[30][tap * 1536 + part * 512 + head * 128 + d]; }
        else { const int r = e - 768, tap = r >> 6, c = r & 63; v = p.in[30][tap * 1536 + 1024 + head * 128 + half * 64 + c]; }
        CW[e] = v;
    }
    for (int e = tid; e < 64 * 72 / 2; e += NTHREADS) { ((LAS unsigned*)Tb)[e] = 0u; ((LAS unsigned*)QKg)[e] = 0u; }
    f32x4 accS[4];
#pragma unroll
    for (int vt = 0; vt < 4; ++vt) {
        accS[vt] = (f32x4){0.f, 0.f, 0.f, 0.f};
        if (kind) { const float* s0 = p.in[3] + (((size_t)b * 2 + dir) * 4 + head) * 16384 + half * 64 + vt * 16 + ln;
#pragma unroll
            for (int r = 0; r < 4; ++r) accS[vt][r] = s0[(size_t)(wave * 16 + h4 * 4 + r) * 128]; }
        *(LAS u32x2*)(ST + (vt * 16 + ln) * 136 + wave * 16 + h4 * 4) = pk4(accS[vt]);
    }
    u32x4 rq[3][2], rk[3][2], rv[3]; unsigned rab = 0u, rbb = 0u;
    const u32x4 z4 = {0u, 0u, 0u, 0u};
#define GD_LOAD(n) do { \
        const int i_ = (n) * 64 + pi, t_ = dir ? L - 1 - i_ : i_; const size_t row_ = (size_t)(rowbase + t_); \
        const bf16* pr_ = p0 + row_ * LDP0 + 1920 + head * 128 + c8 * 16; \
        const bf16* pv_ = p0 + row_ * LDP0 + 1920 + 1024 + head * 128 + half * 64 + c8 * 8; \
        _Pragma("unroll") for (int j_ = 0; j_ < 3; ++j_) { \
            const bool ok_ = (j_ == 1) || (j_ == 0 ? t_ > 0 : t_ < L - 1); const long o_ = (long)(j_ - 1) * LDP0; \
            rq[j_][0] = ok_ ? *(const u32x4*)(pr_ + o_) : z4; rq[j_][1] = ok_ ? *(const u32x4*)(pr_ + o_ + 8) : z4; \
            rk[j_][0] = ok_ ? *(const u32x4*)(pr_ + o_ + 512) : z4; rk[j_][1] = ok_ ? *(const u32x4*)(pr_ + o_ + 520) : z4; \
            rv[j_] = ok_ ? *(const u32x4*)(pv_ + o_) : z4; } \
        rab = p0[row_ * LDP0 + 3968 + dir * 8 + head]; rbb = p0[row_ * LDP0 + 3968 + dir * 8 + 4 + head]; \
    } while (0)
    GD_LOAD(0);
    __syncthreads();
#pragma unroll 1
    for (int n = 0; n < nch; ++n) {
        {
            const int pis = (((pi >> 3) ^ c8) << 3) | (pi & 7);
            {
                float xq[16]; float sq = 0.f;
#pragma unroll
                for (int e = 0; e < 16; ++e) { const int d = c8 * 16 + e; const int wi = e >> 1, hi = e & 1, vi = wi >> 2, ci = wi & 3;
                    const float q0 = hi ? bfhi(rq[0][vi][ci]) : bflo(rq[0][vi][ci]), q1 = hi ? bfhi(rq[1][vi][ci]) : bflo(rq[1][vi][ci]), q2 = hi ? bfhi(rq[2][vi][ci]) : bflo(rq[2][vi][ci]);
                    const float a = CW[d] * q0 + CW[128 + d] * q1 + CW[256 + d] * q2;
                    xq[e] = siluf_(a); sq += xq[e] * xq[e]; }
                sq = red8(sq);
                const float nq = 0.08838834764831845f * rsqrtf_(sq + 1e-6f);
                u32x4 w0, w1;
                w0.x = pk2(xq[0] * nq, xq[1] * nq); w0.y = pk2(xq[2] * nq, xq[3] * nq); w0.z = pk2(xq[4] * nq, xq[5] * nq); w0.w = pk2(xq[6] * nq, xq[7] * nq);
                w1.x = pk2(xq[8] * nq, xq[9] * nq); w1.y = pk2(xq[10] * nq, xq[11] * nq); w1.z = pk2(xq[12] * nq, xq[13] * nq); w1.w = pk2(xq[14] * nq, xq[15] * nq);
                *(LAS u32x4*)(Qs + pi * 136 + c8 * 16) = w0; *(LAS u32x4*)(Qs + pi * 136 + c8 * 16 + 8) = w1;
            }
            {
                float xk[16]; float sk = 0.f;
#pragma unroll
                for (int e = 0; e < 16; ++e) { const int d = c8 * 16 + e; const int wi = e >> 1, hi = e & 1, vi = wi >> 2, ci = wi & 3;
                    const float k0 = hi ? bfhi(rk[0][vi][ci]) : bflo(rk[0][vi][ci]), k1 = hi ? bfhi(rk[1][vi][ci]) : bflo(rk[1][vi][ci]), k2 = hi ? bfhi(rk[2][vi][ci]) : bflo(rk[2][vi][ci]);
                    const float c = CW[384 + d] * k0 + CW[512 + d] * k1 + CW[640 + d] * k2;
                    xk[e] = siluf_(c); sk += xk[e] * xk[e]; }
                sk = red8(sk);
                const float nk = rsqrtf_(sk + 1e-6f);
                u32x4 w0, w1;
                w0.x = pk2(xk[0] * nk, xk[1] * nk); w0.y = pk2(xk[2] * nk, xk[3] * nk); w0.z = pk2(xk[4] * nk, xk[5] * nk); w0.w = pk2(xk[6] * nk, xk[7] * nk);
                w1.x = pk2(xk[8] * nk, xk[9] * nk); w1.y = pk2(xk[10] * nk, xk[11] * nk); w1.z = pk2(xk[12] * nk, xk[13] * nk); w1.w = pk2(xk[14] * nk, xk[15] * nk);
                *(LAS u32x4*)(Ks + pi * 136 + c8 * 16) = w0; *(LAS u32x4*)(Ks + pi * 136 + c8 * 16 + 8) = w1;
#pragma unroll
                for (int e = 0; e < 4; ++e) {
                    KT[(c8 * 16 + 2 * e) * 72 + pis] = (bf16)(w0[e] & 0xffffu); KT[(c8 * 16 + 2 * e + 1) * 72 + pis] = (bf16)(w0[e] >> 16);
                    KT[(c8 * 16 + 8 + 2 * e) * 72 + pis] = (bf16)(w1[e] & 0xffffu); KT[(c8 * 16 + 8 + 2 * e + 1) * 72 + pis] = (bf16)(w1[e] >> 16); }
            }
#pragma unroll
            for (int e = 0; e < 8; ++e) { const int c = c8 * 8 + e; const int wi = e >> 1, hi = e & 1;
                const float v0 = hi ? bfhi(rv[0][wi]) : bflo(rv[0][wi]), v1 = hi ? bfhi(rv[1][wi]) : bflo(rv[1][wi]), v2 = hi ? bfhi(rv[2][wi]) : bflo(rv[2][wi]);
                const float a = CW[768 + c] * v0 + CW[832 + c] * v1 + CW[896 + c] * v2;
                VT[c * 72 + pis] = (bf16)(pk2(siluf_(a), 0.f) & 0xffffu); }
            if (c8 == 0) { const float xa = bf2f(rab) + gB; const float sp = xa > 20.f ? xa : log1pf(expf(xa)); gs[pi] = gA * sp; bs[pi] = 1.0f / (1.0f + expf(-bf2f(rbb))); }
        }
        __syncthreads();
        if (n + 1 < nch) GD_LOAD(n + 1);
        if (wave == 0) {
            float x = gs[lane];
            x += DPPF(x, 0x111); x += DPPF(x, 0x112); x += DPPF(x, 0x114); x += DPPF(x, 0x118);
            const int xi = __float_as_int(x);
            const float t0 = __int_as_float(__builtin_amdgcn_readlane(xi, 15)), t1 = __int_as_float(__builtin_amdgcn_readlane(xi, 31)), t2 = __int_as_float(__builtin_amdgcn_readlane(xi, 47));
            x += (lane >= 48) ? (t0 + t1 + t2) : ((lane >= 32) ? (t0 + t1) : ((lane >= 16) ? t0 : 0.f));
            const float Gl = __int_as_float(__builtin_amdgcn_readlane(__float_as_int(x), 63));
            Gs[lane] = x; eGs[lane] = __expf(x); eGl[lane] = __expf(Gl - x); if (lane == 0) misc[0] = __expf(Gl);
        }
        __syncthreads();
#pragma unroll 1
        for (int tix = wave; tix < 20; tix += 8) {
            const int x = tix < 10 ? tix : tix - 10;
            const int it = x >= 6 ? 3 : (x >= 3 ? 2 : (x >= 1 ? 1 : 0)), jt = x - (it * (it + 1)) / 2;
            f32x4 a = {0.f, 0.f, 0.f, 0.f};
            if (tix < 10) {
#pragma unroll
                for (int s = 0; s < 4; ++s) a = __builtin_amdgcn_mfma_f32_16x16x32_bf16(*(const LAS s16x8*)(Ks + (16 * it + ln) * 136 + 32 * s + 8 * h4), *(const LAS s16x8*)(Ks + (16 * jt + ln) * 136 + 32 * s + 8 * h4), a, 0, 0, 0);
                const int j = 16 * jt + ln; const float Gj = Gs[j];
#pragma unroll
                for (int r = 0; r < 4; ++r) { const int i = 16 * it + 4 * h4 + r; Lm[i * 72 + j] = i > j ? bs[i] * a[r] * __expf(Gs[i] - Gj) : 0.f; }
            } else {
#pragma unroll
                for (int s = 0; s < 4; ++s) a = __builtin_amdgcn_mfma_f32_16x16x32_bf16(*(const LAS s16x8*)(Ks + (16 * jt + ln) * 136 + 32 * s + 8 * h4), *(const LAS s16x8*)(Qs + (16 * it + ln) * 136 + 32 * s + 8 * h4), a, 0, 0, 0);
                const int i = 16 * it + ln; const float Gi = Gs[i]; f32x4 o;
#pragma unroll
                for (int r = 0; r < 4; ++r) { const int j = 16 * jt + 4 * h4 + r; o[r] = i >= j ? a[r] * __expf(Gi - Gs[j]) : 0.f; }
                *(LAS u32x2*)(QKg + i * 72 + 16 * jt + 4 * h4) = pk4(o);
            }
        }
        __syncthreads();
        if (wave == 0) {
            const int a = h4, c = ln; float xr[16];
#pragma unroll
            for (int r = 0; r < 16; ++r) { float s = (r == c) ? 1.0f : 0.0f;
#pragma unroll
                for (int m = 0; m < r; ++m) s -= Lm[(16 * a + r) * 72 + 16 * a + m] * xr[m];
                xr[r] = s; }
#pragma unroll
            for (int r = 0; r < 16; ++r) { Tm[(16 * a + r) * 68 + 16 * a + c] = xr[r]; Tb[(16 * a + r) * 72 + 16 * a + c] = (bf16)(pk2(xr[r], 0.f) & 0xffffu); }
        } else {
#pragma unroll 1
            for (int tk = wave - 1; tk < 16; tk += 7) {
                const int it = tk >> 2, vt = tk & 3; f32x4 a = {0.f, 0.f, 0.f, 0.f};
#pragma unroll
                for (int s = 0; s < 4; ++s) a = __builtin_amdgcn_mfma_f32_16x16x32_bf16(*(const LAS s16x8*)(Ks + (16 * it + ln) * 136 + 32 * s + 8 * h4), *(const LAS s16x8*)(ST + (16 * vt + ln) * 136 + 32 * s + 8 * h4), a, 0, 0, 0);
                const int v = 16 * vt + ln, i0 = 16 * it + 4 * h4;
                const f32x4 vj = unpk4(*(const LAS u32x2*)(VT + v * 72 + ((((i0 >> 3) ^ (v >> 3)) & 7) << 3) + (i0 & 7))), be = *(const LAS f32x4*)(bs + i0), eg = *(const LAS f32x4*)(eGs + i0);
                *(LAS u32x2*)(rT + v * 72 + i0) = pk4(be * (vj - eg * a));
            }
        }
        __syncthreads();
#pragma unroll 1
        for (int dist = 1; dist < 4; ++dist) {
            if (wave < 4 - dist) {
                const int bb = wave, aa = wave + dist; LAS float* ys = Ysc + wave * 272;
                f32x4 y = {0.f, 0.f, 0.f, 0.f};
                float la[3][4], tb[3][4];
#pragma unroll
                for (int mm = 0; mm < 3; ++mm)
#pragma unroll
                    for (int s = 0; s < 4; ++s) { const int m = bb + (mm < dist ? mm : 0);
                        la[mm][s] = Lm[(16 * aa + ln) * 72 + 16 * m + 4 * s + h4]; tb[mm][s] = Tm[(16 * m + 4 * s + h4) * 68 + 16 * bb + ln]; }
#pragma unroll
                for (int mm = 0; mm < 3; ++mm)
                    if (mm < dist) {
#pragma unroll
                        for (int s = 0; s < 4; ++s) y = __builtin_amdgcn_mfma_f32_16x16x4f32(la[mm][s], tb[mm][s], y, 0, 0, 0); }
#pragma unroll
                for (int r = 0; r < 4; ++r) ys[(4 * h4 + r) * 17 + ln] = y[r];
                f32x4 z = {0.f, 0.f, 0.f, 0.f};
#pragma unroll
                for (int s = 0; s < 4; ++s) z = __builtin_amdgcn_mfma_f32_16x16x4f32(Tm[(16 * aa + ln) * 68 + 16 * aa + 4 * s + h4], ys[(4 * s + h4) * 17 + ln], z, 0, 0, 0);
#pragma unroll
                for (int r = 0; r < 4; ++r) { const int i = 16 * aa + 4 * h4 + r, j = 16 * bb + ln; Tm[i * 68 + j] = -z[r]; Tb[i * 72 + j] = (bf16)(pk2(-z[r], 0.f) & 0xffffu); }
            }
            __syncthreads();
        }
#pragma unroll
        for (int u = 0; u < 2; ++u) {
            const int tile = 2 * wave + u, it = tile >> 2, vt = tile & 3; f32x4 a = {0.f, 0.f, 0.f, 0.f};
            a = __builtin_amdgcn_mfma_f32_16x16x32_bf16(*(const LAS s16x8*)(Tb + (16 * it + ln) * 72 + 8 * h4), *(const LAS s16x8*)(rT + (16 * vt + ln) * 72 + 8 * h4), a, 0, 0, 0);
            if (it >= 2) a = __builtin_amdgcn_mfma_f32_16x16x32_bf16(*(const LAS s16x8*)(Tb + (16 * it + ln) * 72 + 32 + 8 * h4), *(const LAS s16x8*)(rT + (16 * vt + ln) * 72 + 32 + 8 * h4), a, 0, 0, 0);
            const int v = 16 * vt + ln, i0 = 16 * it + 4 * h4;
            *(LAS u32x2*)(vnT + v * 72 + i0) = pk4(a); *(LAS u32x2*)(vnsT + v * 72 + i0) = pk4(a * *(const LAS f32x4*)(eGl + i0));
        }
        __syncthreads();
#pragma unroll
        for (int u = 0; u < 2; ++u) {
            const int tile = 2 * wave + u, vt = tile >> 2, it = tile & 3; f32x4 a = {0.f, 0.f, 0.f, 0.f};
#pragma unroll
            for (int s = 0; s < 4; ++s) a = __builtin_amdgcn_mfma_f32_16x16x32_bf16(*(const LAS s16x8*)(ST + (16 * vt + ln) * 136 + 32 * s + 8 * h4), *(const LAS s16x8*)(Qs + (16 * it + ln) * 136 + 32 * s + 8 * h4), a, 0, 0, 0);
            a = a * eGs[16 * it + ln];
            a = __builtin_amdgcn_mfma_f32_16x16x32_bf16(*(const LAS s16x8*)(vnT + (16 * vt + ln) * 72 + 8 * h4), *(const LAS s16x8*)(QKg + (16 * it + ln) * 72 + 8 * h4), a, 0, 0, 0);
            if (it >= 2) a = __builtin_amdgcn_mfma_f32_16x16x32_bf16(*(const LAS s16x8*)(vnT + (16 * vt + ln) * 72 + 32 + 8 * h4), *(const LAS s16x8*)(QKg + (16 * it + ln) * 72 + 32 + 8 * h4), a, 0, 0, 0);
            const int ic = n * 64 + 16 * it + ln, tk = dir ? L - 1 - ic : ic;
            *(u32x2*)(Y + (size_t)(rowbase + tk) * 1024 + colbase + 16 * vt + 4 * h4) = pk4(a);
        }
        {
            const float egl = misc[0];
#pragma unroll
            for (int vt = 0; vt < 4; ++vt) {
                f32x4 a = accS[vt] * egl;
#pragma unroll
                for (int s = 0; s < 2; ++s) a = __builtin_amdgcn_mfma_f32_16x16x32_bf16(*(const LAS s16x8*)(KT + (16 * wave + ln) * 72 + (((4 * s + h4) ^ wave) << 3)), *(const LAS s16x8*)(vnsT + (16 * vt + ln) * 72 + 32 * s + 8 * h4), a, 0, 0, 0);
                accS[vt] = a;
            }
        }
        __syncthreads();
#pragma unroll
        for (int vt = 0; vt < 4; ++vt) *(LAS u32x2*)(ST + (vt * 16 + ln) * 136 + wave * 16 + h4 * 4) = pk4(accS[vt]);
    }
#undef GD_LOAD
    if (!kind) { float* so = p.out + OUT_SGD + (((size_t)b * 2 + dir) * 4 + head) * 16384 + half * 64;
#pragma unroll
        for (int vt = 0; vt < 4; ++vt)
#pragma unroll
            for (int r = 0; r < 4; ++r) so[(size_t)(wave * 16 + h4 * 4 + r) * 128 + vt * 16 + ln] = accS[vt][r]; }
}
__device__ __forceinline__ void rwkv_idx(const P& p, LAS unsigned char* lds, int i) {
    const int kind = i < 128 ? 1 : 0, j = i < 128 ? i : i - 128;
    rwkv_item(p, lds, kind, j >> 4, (j >> 1) & 7, j & 1);
}
__device__ __forceinline__ void gdn_idx(const P& p, LAS unsigned char* lds, int i) {
    const int kind = i < 128 ? 1 : 0, j = i < 128 ? i : i - 128;
    gdn_item(p, lds, kind, j >> 4, (j >> 2) & 3, (j >> 1) & 1, j & 1);
}
__device__ __forceinline__ void ph_scan(const P& p, LAS unsigned char* lds) {
    const int B = blockIdx.x, G = gridDim.x;
    if (G == 256) {
        if (B < 128) { rwkv_idx(p, lds, B); for (int i = 0; i < 4; ++i) gdn_idx(p, lds, 128 + B * 4 + i); }
        else { gdn_idx(p, lds, B - 128); for (int i = 0; i < 4; ++i) rwkv_idx(p, lds, 128 + (B - 128) * 4 + i); }
    } else {
        for (int i = B; i < 640; i += G) { rwkv_idx(p, lds, i); gdn_idx(p, lds, i); }
    }
}

__device__ __forceinline__ void ph_post_ab(const P& p, bool dummy) {
    const int tid = tid_opaque(), lane = tid & 63, wave = tid >> 6;
    const bf16* p0 = (const bf16*)(p.ws + WS_R1); const bf16* lo = (const bf16*)(p.ws + WS_R2);
    bf16* MX = (bf16*)(p.ws + WS_MIX); const bf16* YB = (const bf16*)(p.ws + WS_H);
    bf16* MO = dummy ? (bf16*)(p.out + OUT_CKV) : MX;
    const int C = lane * 8;
    float mur[8], muk[8], muv[8], ka[8], rk[8], lw[8], lb[8], gn[8];
#pragma unroll
    for (int i = 0; i < 8; ++i) { mur[i] = p.in[19][C + i]; muk[i] = p.in[19][512 + C + i]; muv[i] = p.in[19][1024 + C + i]; ka[i] = p.in[26][C + i]; rk[i] = p.in[27][C + i];
        lw[i] = p.in[28][C + i]; lb[i] = p.in[29][C + i]; gn[i] = p.in[33][(C + i) & 127]; }
    for (int row = blockIdx.x * 8 + wave; row < M_TOK; row += gridDim.x * 8) {
        const int t = row < MP ? (row & 255) : ((row - MP) & 1023), L = row < MP ? 256 : 1024;
        const bool hp = t > 0, hn = t < L - 1;
        const u32x4 z4 = {0u, 0u, 0u, 0u};
        const bf16* pr = p0 + (size_t)row * LDP0 + C;
        float r[8], k[8], v[8];
        {
            const u32x4 c = *(const u32x4*)pr, a = hp ? *(const u32x4*)(pr - LDP0) : z4, n = hn ? *(const u32x4*)(pr + LDP0) : z4;
#pragma unroll
            for (int i = 0; i < 4; ++i) { float c0 = bflo(c[i]), c1 = bfhi(c[i]); r[2 * i] = c0 + mur[2 * i] * (0.5f * (bflo(a[i]) + bflo(n[i])) - c0); r[2 * i + 1] = c1 + mur[2 * i + 1] * (0.5f * (bfhi(a[i]) + bfhi(n[i])) - c1); }
        }
        {
            const u32x4 c = *(const u32x4*)(pr + 512), a = hp ? *(const u32x4*)(pr + 512 - LDP0) : z4, n = hn ? *(const u32x4*)(pr + 512 + LDP0) : z4;
#pragma unroll
            for (int i = 0; i < 4; ++i) { float c0 = bflo(c[i]), c1 = bfhi(c[i]); k[2 * i] = c0 + muk[2 * i] * (0.5f * (bflo(a[i]) + bflo(n[i])) - c0); k[2 * i + 1] = c1 + muk[2 * i + 1] * (0.5f * (bfhi(a[i]) + bfhi(n[i])) - c1); }
        }
        {
            const u32x4 c = *(const u32x4*)(pr + 1024), a = hp ? *(const u32x4*)(pr + 1024 - LDP0) : z4, n = hn ? *(const u32x4*)(pr + 1024 + LDP0) : z4;
#pragma unroll
            for (int i = 0; i < 4; ++i) { float c0 = bflo(c[i]), c1 = bfhi(c[i]); v[2 * i] = c0 + muv[2 * i] * (0.5f * (bflo(a[i]) + bflo(n[i])) - c0); v[2 * i + 1] = c1 + muv[2 * i + 1] * (0.5f * (bfhi(a[i]) + bfhi(n[i])) - c1); }
        }
        const u32x4 af = *(const u32x4*)(lo + (size_t)row * 2560 + 1024 + C), ab = *(const u32x4*)(lo + (size_t)row * 2560 + 1536 + C), gg = *(const u32x4*)(lo + (size_t)row * 2560 + 2048 + C);
        const u32x4 yf = *(const u32x4*)(MX + (size_t)row * 1024 + C), yb = *(const u32x4*)(YB + (size_t)row * 1024 + C);
        float y[8], s = 0.f, bon = 0.f;
#pragma unroll
        for (int i = 0; i < 4; ++i) {
            y[2 * i] = bflo(yf[i]) + bflo(yb[i]); y[2 * i + 1] = bfhi(yf[i]) + bfhi(yb[i]); s += y[2 * i] + y[2 * i + 1];
            const float am0 = 0.5f * (bflo(af[i]) + bflo(ab[i])), am1 = 0.5f * (bfhi(af[i]) + bfhi(ab[i]));
            bon += r[2 * i] * k[2 * i] * (1.0f + (am0 - 1.0f) * ka[2 * i]) * rk[2 * i] + r[2 * i + 1] * k[2 * i + 1] * (1.0f + (am1 - 1.0f) * ka[2 * i + 1]) * rk[2 * i + 1];
        }
        const float mean = red8(s) * (1.0f / 64.0f); bon = red8(bon);
        float q2 = 0.f;
#pragma unroll
        for (int i = 0; i < 8; ++i) { y[i] -= mean; q2 += y[i] * y[i]; }
        const float rstd = 1.0f / sqrtf(red8(q2) * (1.0f / 64.0f) + 64e-5f);
        u32x4 o;
#pragma unroll
        for (int i = 0; i < 4; ++i) {
            const float o0 = (y[2 * i] * rstd * lw[2 * i] + lb[2 * i] + bon * v[2 * i]) * bflo(gg[i]);
            const float o1 = (y[2 * i + 1] * rstd * lw[2 * i + 1] + lb[2 * i + 1] + bon * v[2 * i + 1]) * bfhi(gg[i]);
            o[i] = pk2(o0, o1);
        }
        const size_t orow = dummy ? (size_t)(row & 4095) : (size_t)row;
        *(u32x4*)(MO + orow * 1024 + C) = o;
        const u32x4 of = *(const u32x4*)(MX + (size_t)row * 1024 + 512 + C), ob = *(const u32x4*)(YB + (size_t)row * 1024 + 512 + C);
        const u32x4 zz = *(const u32x4*)(p0 + (size_t)row * LDP0 + 1920 + 1536 + C);
        float og[8], so = 0.f;
#pragma unroll
        for (int i = 0; i < 4; ++i) { og[2 * i] = bflo(of[i]) + bflo(ob[i]); og[2 * i + 1] = bfhi(of[i]) + bfhi(ob[i]); so += og[2 * i] * og[2 * i] + og[2 * i + 1] * og[2 * i + 1]; }
        const float rs = 1.0f / sqrtf(red16(so) * (1.0f / 128.0f) + 1e-6f);
        u32x4 o2;
#pragma unroll
        for (int i = 0; i < 4; ++i) { const float z0 = bflo(zz[i]), z1 = bfhi(zz[i]);
            o2[i] = pk2(og[2 * i] * rs * gn[2 * i] * siluf_(z0), og[2 * i + 1] * rs * gn[2 * i + 1] * siluf_(z1)); }
        *(u32x4*)(MO + orow * 1024 + 512 + C) = o2;
    }
}

__device__ __forceinline__ void ph_hyena_filters(const P& p, LAS unsigned char* lds) {
    LAS float* f0 = (LAS float*)lds;
    LAS float* h1 = f0 + 32 * 36;
    LAS float* h2 = h1 + 32 * 64;
    LAS bf16* stg = (LAS bf16*)(h2 + 64 * 32);
    LAS float* w1s = h2 + 64 * 32 + 8192;
    LAS float* w2s = w1s + 33 * 64;
    const int tid = tid_opaque();
    const float* b1 = p.in[41]; const float* b2 = p.in[43]; const float* w3 = p.in[44]; const float* fr = p.in[45];
    __syncthreads();
    if (blockIdx.x < 160) {
        for (int e = tid; e < 33 * 64; e += NTHREADS) w1s[e] = p.in[40][e];
        for (int e = tid; e < 64 * 64; e += NTHREADS) w2s[e] = p.in[42][e];
    }
    for (int item4 = blockIdx.x; item4 < 160; item4 += gridDim.x) {
        const int item = item4 >> 2, oo = item4 & 3;
        const int ls = item < 32 ? 1 : 0;
        const int L = ls ? 1024 : 256, t0 = (ls ? item : item - 32) * 32;
        const int o = tid + oo * 512;
        float wreg[16];
#pragma unroll
        for (int f = 0; f < 16; ++f) wreg[f] = w3[f * 2048 + o];
        __syncthreads();
        for (int e = tid; e < 32 * 33; e += NTHREADS) {
            const int pi = e / 33, f = e % 33; const float t = (float)(t0 + pi);
            float v;
            if (f == 0) v = t / (float)(L - 1);
            else { const int bi = (f - 1) & 15; const float band = 1e-4f + (15.0f - 1e-4f) * ((float)bi / 15.0f); const float ang = (6.283185307179586f / (float)L) * t * band; v = f <= 16 ? __cosf(ang) : -__sinf(ang); }
            f0[pi * 36 + f] = v;
        }
        __syncthreads();
        {
            const int j = tid & 63, pq = tid >> 6; const float bj = b1[j], fj = fr[j];
            float sacc[4] = {bj, bj, bj, bj};
#pragma unroll 3
            for (int f = 0; f < 33; ++f) { const float w = w1s[f * 64 + j];
#pragma unroll
                for (int i = 0; i < 4; ++i) sacc[i] += f0[(pq + 8 * i) * 36 + f] * w; }
#pragma unroll
            for (int i = 0; i < 4; ++i) h1[(pq + 8 * i) * 64 + j] = __sinf(fj * sacc[i]);
        }
        __syncthreads();
        {
            const int j = tid & 63, pq = tid >> 6; const float bj = b2[j], fj = fr[64 + j];
            float sacc[4] = {bj, bj, bj, bj};
#pragma unroll 4
            for (int f = 0; f < 64; ++f) { const float w = w2s[f * 64 + j];
#pragma unroll
                for (int i = 0; i < 4; ++i) sacc[i] += h1[(pq + 8 * i) * 64 + f] * w; }
#pragma unroll
            for (int i = 0; i < 4; ++i) h2[j * 32 + pq + 8 * i] = __sinf(fj * sacc[i]);
        }
        __syncthreads();
        bf16* G = (bf16*)(p.ws + (ls ? WS_GFS : WS_GFP));
        {
            const int c = o & 511;
            f32x4 sv[8];
#pragma unroll
            for (int i = 0; i < 8; ++i) sv[i] = (f32x4){0.f, 0.f, 0.f, 0.f};
#pragma unroll
            for (int fq = 0; fq < 4; ++fq) {
                float wn[16];
                if (fq < 3) {
#pragma unroll
                    for (int f = 0; f < 16; ++f) wn[f] = w3[((fq + 1) * 16 + f) * 2048 + o];
                }
#pragma unroll
                for (int f = 0; f < 16; ++f) { const float w = wreg[f]; const LAS f32x4* hp = (const LAS f32x4*)(h2 + (fq * 16 + f) * 32);
#pragma unroll
                    for (int i = 0; i < 8; ++i) sv[i] += hp[i] * w; }
                if (fq < 3) {
#pragma unroll
                    for (int f = 0; f < 16; ++f) wreg[f] = wn[f];
                }
            }
            const float delta = 3.0701134573253944f + (15.350567286626973f - 3.0701134573253944f) * ((float)c / 511.0f);
            const float inv = 1.0f / (float)(L - 1);
#pragma unroll
            for (int i = 0; i < 8; ++i) {
                const float ta = (float)(t0 + 4 * i) * inv, tb = (float)(t0 + 4 * i + 1) * inv, tc = (float)(t0 + 4 * i + 2) * inv, td = (float)(t0 + 4 * i + 3) * inv;
                *(LAS u32x2*)(stg + tid * 32 + 4 * i) = (u32x2){pk2(sv[i].x * __expf(-ta * delta), sv[i].y * __expf(-tb * delta)), pk2(sv[i].z * __expf(-tc * delta), sv[i].w * __expf(-td * delta))};
            }
            __syncthreads();
            const int lane = tid & 63, wv = tid >> 6, pi = lane & 31;
#pragma unroll 4
            for (int r = 0; r < 32; ++r) {
                const int col = wv * 64 + r * 2 + (lane >> 5);
                const int o2 = col + oo * 512, order2 = o2 >> 10, dr2 = (o2 >> 9) & 1, c2 = o2 & 511, t = t0 + pi;
                const bf16 hv = stg[col * 32 + pi];
                bf16* g = G + ((size_t)order2 * 512 + c2) * (2 * L);
                if (dr2 == 0) g[L - t] = hv;
                else if (t > 0) g[L + t] = hv;
                if (dr2 == 0 && t == 0) g[0] = 0;
            }
        }
    }
}

__device__ __forceinline__ void ph_mla_prep(const P& p, LAS unsigned char* lds) {
    const int tid = tid_opaque(), lane = tid & 63, wave = tid >> 6;
    const bf16* p1 = (const bf16*)(p.ws + WS_R1);
    bf16* qn = (bf16*)(p.ws + WS_H); bf16* ckva = (bf16*)(p.ws + WS_CKVA); bf16* kpea = (bf16*)(p.ws + WS_KPEA);
    const float* rope = (const float*)(p.ws + WS_ROPE);
    const float* qg = p.in[35]; const float* kg = p.in[37];
    const int nw = gridDim.x * 8;
    for (int row0 = blockIdx.x * 8 + wave; row0 < M_TOK; row0 += 4 * nw) {
        unsigned qw[4][3], kw[4]; u32x2 vw[4]; float sq[4], sk[4];
#pragma unroll
        for (int r = 0; r < 4; ++r) {
            const int row = (row0 + r * nw) < M_TOK ? (row0 + r * nw) : (M_TOK - 1);
            const bf16* pr = p1 + (size_t)row * LDP1;
#pragma unroll
            for (int j = 0; j < 3; ++j) qw[r][j] = *(const unsigned*)(pr + j * 128 + lane * 2);
            vw[r] = *(const u32x2*)(pr + 384 + lane * 4);
            kw[r] = lane < 16 ? *(const unsigned*)(pr + 640 + lane * 2) : 0u;
        }
#pragma unroll
        for (int r = 0; r < 4; ++r) {
            float s = 0.f;
#pragma unroll
            for (int j = 0; j < 3; ++j) s += bflo(qw[r][j]) * bflo(qw[r][j]) + bfhi(qw[r][j]) * bfhi(qw[r][j]);
            sq[r] = s;
            const f32x4 kv = unpk4(vw[r]); sk[r] = kv.x * kv.x + kv.y * kv.y + kv.z * kv.z + kv.w * kv.w;
        }
#pragma unroll
        for (int o = 1; o < 64; o <<= 1) {
#pragma unroll
            for (int r = 0; r < 4; ++r) { sq[r] += __shfl_xor(sq[r], o); sk[r] += __shfl_xor(sk[r], o); } }
#pragma unroll
        for (int r = 0; r < 4; ++r) {
            const int row = row0 + r * nw; if (row >= M_TOK) break;
            const float rq = rsqrtf_(sq[r] * (1.0f / 384.0f) + 1e-6f), rk = rsqrtf_(sk[r] * (1.0f / 256.0f) + 1e-6f);
#pragma unroll
            for (int j = 0; j < 3; ++j) { const int col = j * 128 + lane * 2; *(unsigned*)(qn + (size_t)row * 384 + col) = pk2(bflo(qw[r][j]) * rq * qg[col], bfhi(qw[r][j]) * rq * qg[col + 1]); }
            const f32x4 ck = unpk4(vw[r]) * rk * *(const f32x4*)(kg + lane * 4);
            *(u32x2*)(ckva + (size_t)row * 256 + lane * 4) = pk4(ck);
            if (row < MP) *(f32x4*)(p.out + OUT_CKV + (size_t)row * 256 + lane * 4) = ck;
            if (lane < 16) {
                float x1 = bflo(kw[r]), x2 = bfhi(kw[r]);
                if (row < MP) { *(f32x2*)(p.out + OUT_KPE + (size_t)row * 32 + lane * 2) = (f32x2){x1, x2}; }
                else { const int tq = (row - MP) & 1023; const f32x2 cs = *(const f32x2*)(rope + (size_t)tq * 32 + lane * 2); const float a = x1 * cs.x - x2 * cs.y, bq = x1 * cs.y + x2 * cs.x; x1 = a; x2 = bq; }
                *(unsigned*)(kpea + (size_t)row * 32 + lane * 2) = pk2(x1, x2);
            }
        }
    }
    for (int r2 = blockIdx.x * 8 + wave; r2 < 2048; r2 += nw) {
        const int row = M_TOK + r2;
        const f32x4 cv = *(const f32x4*)(p.in[4] + (size_t)r2 * 256 + lane * 4);
        *(u32x2*)(ckva + (size_t)row * 256 + lane * 4) = pk4(cv);
        if (lane < 16) { const f32x2 kp = *(const f32x2*)(p.in[5] + (size_t)r2 * 32 + lane * 2); *(unsigned*)(kpea + (size_t)row * 32 + lane * 2) = pk2(kp.x, kp.y); }
    }
    LAS float* tile = (LAS float*)(lds + wave * 8832);
    bf16* HT = (bf16*)(p.ws + WS_HYIN);
    const float* cw = p.in[39];
    for (int it = blockIdx.x * 8 + wave; it < 256 * 48; it += gridDim.x * 8) {
        const int rt = it / 48, cb = it % 48;
        const int r0 = rt * 64, col0 = 672 + cb * 32;
        const int t0 = r0 < MP ? (r0 & 255) : ((r0 - MP) & 1023), L = r0 < MP ? 256 : 1024;
        unsigned wv[17];
#pragma unroll
        for (int i = 0; i < 17; ++i) {
            const int rr = i * 4 + (lane >> 4), tt = t0 - 1 + rr;
            wv[i] = (rr < 66 && tt >= 0 && tt < L) ? *(const unsigned*)(p1 + (size_t)(r0 - 1 + rr) * LDP1 + col0 + (lane & 15) * 2) : 0u;
        }
#pragma unroll
        for (int i = 0; i < 17; ++i) {
            const int rr = i * 4 + (lane >> 4);
            if (rr < 66) { tile[rr * 33 + (lane & 15) * 2] = bflo(wv[i]); tile[rr * 33 + (lane & 15) * 2 + 1] = bfhi(wv[i]); }
        }
        LDS_WAIT();
#pragma unroll 8
        for (int c = 0; c < 32; ++c) {
            const int ch = cb * 32 + c;
            const float v = cw[ch] * tile[lane * 33 + c] + cw[1536 + ch] * tile[(lane + 1) * 33 + c] + cw[3072 + ch] * tile[(lane + 2) * 33 + c];
            HT[(size_t)ch * M_TOK + r0 + lane] = (bf16)(pk2(v, 0.f) & 0xffffu);
        }
        LDS_WAIT();
    }
}

__device__ __forceinline__ void attn_item(const P& p, LAS unsigned char* lds, int kind, int b, int head, int qt) {
    constexpr int TILE_B = 64 * 104 * 2 + 64 * 72 * 2;
    const int tid = tid_opaque(), lane = tid & 63, wave = tid >> 6, ln = lane & 15, h = lane >> 4;
    const bf16* Q = (const bf16*)(p.ws + WS_Q); const bf16* KN = (const bf16*)(p.ws + WS_KV); const bf16* VT = (const bf16*)(p.ws + WS_VT); const bf16* KPE = (const bf16*)(p.ws + WS_KPEA);
    bf16* MX = (bf16*)(p.ws + WS_MIX);
    const int nkeys = kind ? 1280 : 256, rowbase = kind ? MP + b * 1024 : b * 256, ntiles = nkeys / 64;
    const int qrow = rowbase + qt * 128 + wave * 16 + ln;
    s16x8 qf[3];
#pragma unroll
    for (int s = 0; s < 3; ++s) qf[s] = *(const s16x8*)(Q + (size_t)qrow * 768 + head * 96 + 32 * s + 8 * h);
    f32x4 o[4];
#pragma unroll
    for (int i = 0; i < 4; ++i) o[i] = (f32x4){0.f, 0.f, 0.f, 0.f};
    float mrun = -1e30f, lrun = 0.f;
    const int k0key = tid / 12, k0ch = tid % 12, k1key = (tid + 512) / 12, k1ch = (tid + 512) % 12, vv = tid >> 3, vkc = tid & 7;
    u32x4 Ak0, Ak1 = {0u, 0u, 0u, 0u}, Av, Bk0, Bk1 = {0u, 0u, 0u, 0u}, Bv;
#define ATT_LOAD(X, it) do { const int j0_ = (it) * 64; \
        const int kb_ = kind ? (j0_ < 1024 ? MP + b * 1024 + j0_ : M_TOK + b * 256 + (j0_ - 1024)) : b * 256 + j0_; \
        X##k0 = *(const u32x4*)(k0ch < 8 ? KN + (size_t)(kb_ + k0key) * 512 + head * 64 + k0ch * 8 : KPE + (size_t)(kb_ + k0key) * 32 + (k0ch - 8) * 8); \
        if (tid < 256) X##k1 = *(const u32x4*)(k1ch < 8 ? KN + (size_t)(kb_ + k1key) * 512 + head * 64 + k1ch * 8 : KPE + (size_t)(kb_ + k1key) * 32 + (k1ch - 8) * 8); \
        X##v = *(const u32x4*)(VT + (size_t)(head * 64 + vv) * (M_TOK + 2048) + kb_ + vkc * 8); } while (0)
#define ATT_STORE(X, Kt_, Vt_) do { *(LAS u32x4*)(Kt_ + k0key * 104 + k0ch * 8) = X##k0; \
        if (tid < 256) *(LAS u32x4*)(Kt_ + k1key * 104 + k1ch * 8) = X##k1; \
        *(LAS u32x4*)(Vt_ + vv * 72 + vkc * 8) = X##v; } while (0)
    __syncthreads();
    ATT_LOAD(A, 0);
    if (ntiles > 1) ATT_LOAD(B, 1);
#pragma unroll 1
    for (int it = 0; it < ntiles; ++it) {
        LAS bf16* Kt = (LAS bf16*)(lds + (it & 1) * TILE_B);
        LAS bf16* Vt = Kt + 64 * 104;
        if (it & 1) ATT_STORE(B, Kt, Vt); else ATT_STORE(A, Kt, Vt);
        __syncthreads();
        if (it + 2 < ntiles) { if (it & 1) ATT_LOAD(B, it + 2); else ATT_LOAD(A, it + 2); }
        f32x4 sc[4]; float mx = -1e30f;
#pragma unroll
        for (int kt = 0; kt < 4; ++kt) {
            f32x4 a = {0.f, 0.f, 0.f, 0.f};
#pragma unroll
            for (int s = 0; s < 3; ++s) { const s16x8 kf = *(const LAS s16x8*)(Kt + (kt * 16 + ln) * 104 + 32 * s + 8 * h); a = __builtin_amdgcn_mfma_f32_16x16x32_bf16(kf, qf[s], a, 0, 0, 0); }
            sc[kt] = a; mx = fmaxf(mx, fmaxf(fmaxf(a[0], a[1]), fmaxf(a[2], a[3])));
        }
        mx = fmaxf(mx, __shfl_xor(mx, 16)); mx = fmaxf(mx, __shfl_xor(mx, 32));
        const float mnew = fmaxf(mrun, mx), alpha = __expf(mrun - mnew);
        mrun = mnew;
        float ps = 0.f;
#pragma unroll
        for (int kt = 0; kt < 4; ++kt)
#pragma unroll
            for (int r = 0; r < 4; ++r) { sc[kt][r] = __expf(sc[kt][r] - mnew); ps += sc[kt][r]; }
        lrun = lrun * alpha + ps;
#pragma unroll
        for (int i = 0; i < 4; ++i) o[i] = o[i] * alpha;
#pragma unroll
        for (int s = 0; s < 2; ++s) {
            u32x4 pw; pw.x = pk2(sc[2 * s][0], sc[2 * s][1]); pw.y = pk2(sc[2 * s][2], sc[2 * s][3]); pw.z = pk2(sc[2 * s + 1][0], sc[2 * s + 1][1]); pw.w = pk2(sc[2 * s + 1][2], sc[2 * s + 1][3]);
            const s16x8 pf = __builtin_bit_cast(s16x8, pw);
#pragma unroll
            for (int vt = 0; vt < 4; ++vt) {
                const LAS bf16* vp = Vt + (vt * 16 + ln) * 72 + 32 * s + 4 * h;
                const u32x2 lo2 = *(const LAS u32x2*)vp, hi2 = *(const LAS u32x2*)(vp + 16);
                const u32x4 vw = {lo2.x, lo2.y, hi2.x, hi2.y};
                o[vt] = __builtin_amdgcn_mfma_f32_16x16x32_bf16(__builtin_bit_cast(s16x8, vw), pf, o[vt], 0, 0, 0);
            }
        }
    }
#undef ATT_LOAD
#undef ATT_STORE
    lrun += __shfl_xor(lrun, 16); lrun += __shfl_xor(lrun, 32);
    const float inv = 1.0f / lrun;
#pragma unroll
    for (int vt = 0; vt < 4; ++vt) *(u32x2*)(MX + (size_t)qrow * 1024 + head * 64 + vt * 16 + 4 * h) = pk4(o[vt] * inv);
}

__device__ __forceinline__ void hyena_item(const P& p, LAS unsigned char* lds, int kind, int cgp) {
    const int tid = tid_opaque(), lane = tid & 63, wave = tid >> 6, ci = wave >> 2, qtr = wave & 3;
    const int L = kind ? 1024 : 256, NB = kind ? 8 : 32, base = kind ? MP : 0, c = cgp * 2 + ci;
    const int DMAX = kind ? 31 : 7;
    constexpr int ZCH = 8704;
    LAS bf16* zb = (LAS bf16*)lds;
    LAS bf16* gb = zb + 2 * ZCH;
    const bf16* HT = (const bf16*)(p.ws + WS_HYIN);
    const bf16* G = (const bf16*)(p.ws + (kind ? WS_GFS : WS_GFP));
    bf16* HO = (bf16*)(p.ws + WS_H);
    __syncthreads();
    const int Lp = L + 8;
    for (int i = tid; i < 2 * 1024; i += NTHREADS) { const int cc = i >> 10, off = (i & 1023) * 8;
        *(LAS u32x4*)(zb + cc * ZCH + (off / L) * Lp + (off % L)) = *(const u32x4*)(HT + (size_t)(cgp * 2 + cc) * M_TOK + base + off); }
    for (int i = tid; i < 4 * (2 * L / 8); i += NTHREADS) { const int co = i / (2 * L / 8), off = (i % (2 * L / 8)) * 8, cc = co >> 1, od = co & 1;
        *(LAS u32x4*)(gb + (cc * 2 + od) * 2 * L + off) = *(const u32x4*)(G + ((size_t)od * 512 + cgp * 2 + cc) * (2 * L) + off); }
    __syncthreads();
    const int n = lane & 31, h = lane >> 5;
    const int jl = kind ? (n & 3) : 0, bb = kind ? (n >> 2) : n;
    const LAS bf16* zc = zb + ci * ZCH + bb * Lp;
#pragma unroll 1
    for (int order = 0; order < 2; ++order) {
        const LAS bf16* gr = gb + (ci * 2 + order) * 2 * L;
        f32x16 acc[2];
#pragma unroll
        for (int g = 0; g < 2; ++g)
#pragma unroll
            for (int r = 0; r < 16; ++r) acc[g][r] = 0.f;
        const int Ilo_w = kind ? 8 * qtr : 2 * qtr, Ihi_w = kind ? 8 * qtr + 7 : 2 * qtr + 1;
        int Dlo = Ilo_w - (L / 32 - 1), Dhi = Ihi_w; if (Dlo < -DMAX) Dlo = -DMAX; if (Dhi > DMAX) Dhi = DMAX;
#pragma unroll 1
        for (int D = Dlo; D <= Dhi; ++D) {
#pragma unroll
            for (int ks = 0; ks < 2; ++ks) {
                const int idx = L - 32 * D + 16 * ks + 8 * h - n;
                u32x4 aw;
                aw.x = (unsigned)gr[idx] | ((unsigned)gr[idx + 1] << 16); aw.y = (unsigned)gr[idx + 2] | ((unsigned)gr[idx + 3] << 16);
                aw.z = (unsigned)gr[idx + 4] | ((unsigned)gr[idx + 5] << 16); aw.w = (unsigned)gr[idx + 6] | ((unsigned)gr[idx + 7] << 16);
                const s16x8 af = __builtin_bit_cast(s16x8, aw);
#pragma unroll
                for (int g = 0; g < 2; ++g) {
                    const int og = qtr * 2 + g;
                    const int J = (kind ? 4 * og + jl : og) - D;
                    const bool ok = J >= 0 && J < L / 32;
                    u32x4 bw = *(const LAS u32x4*)(zc + 32 * (ok ? J : 0) + 16 * ks + 8 * h);
                    bw.x = ok ? bw.x : 0u; bw.y = ok ? bw.y : 0u; bw.z = ok ? bw.z : 0u; bw.w = ok ? bw.w : 0u;
                    acc[g] = __builtin_amdgcn_mfma_f32_32x32x16_bf16(af, __builtin_bit_cast(s16x8, bw), acc[g], 0, 0, 0);
                }
            }
        }
        const float bias = p.in[46][order * 512 + c];
        const bf16* gate = HT + (size_t)((order + 1) * 512 + c) * M_TOK + base + bb * L;
        u32x2 zn[2][4];
#pragma unroll
        for (int g = 0; g < 2; ++g) {
            const int og = qtr * 2 + g, I = kind ? 4 * og + jl : og;
#pragma unroll
            for (int rq = 0; rq < 4; ++rq) {
                const int t = 32 * I + 8 * rq + 4 * h;
                const f32x4 zo = unpk4(*(const LAS u32x2*)(zc + t)), gt = unpk4(*(const u32x2*)(gate + t));
                f32x4 y; y.x = acc[g][4 * rq]; y.y = acc[g][4 * rq + 1]; y.z = acc[g][4 * rq + 2]; y.w = acc[g][4 * rq + 3];
                zn[g][rq] = pk4(gt * (y + zo * bias));
            }
        }
        if (order == 0) {
            __syncthreads();
#pragma unroll
            for (int g = 0; g < 2; ++g) { const int og = qtr * 2 + g, I = kind ? 4 * og + jl : og;
#pragma unroll
                for (int rq = 0; rq < 4; ++rq) *(LAS u32x2*)(zb + ci * ZCH + bb * Lp + 32 * I + 8 * rq + 4 * h) = zn[g][rq]; }
            __syncthreads();
        } else {
#pragma unroll
            for (int g = 0; g < 2; ++g) { const int og = qtr * 2 + g, I = kind ? 4 * og + jl : og;
#pragma unroll
                for (int rq = 0; rq < 4; ++rq) { const int t = 32 * I + 8 * rq + 4 * h; *(u32x2*)(HO + (size_t)c * M_TOK + base + bb * L + t) = zn[g][rq]; } }
        }
    }
}
#ifndef DUP_SUB
#define DUP_SUB 3
#endif
__device__ __forceinline__ void ph_attn_hyena(const P& p, LAS unsigned char* lds, bool dummy) {
    const int B = blockIdx.x, G = gridDim.x;
#ifndef T_NO_ATTN
    if (!dummy || (DUP_SUB & 1))
    for (int i = B; i < 1024; i += G) { if (i < 512) attn_item(p, lds, 1, i >> 6, (i >> 3) & 7, i & 7); else { const int j = i - 512; attn_item(p, lds, 0, j >> 4, (j >> 1) & 7, j & 1); } }
#endif
#ifndef T_NO_HY
    if (!dummy || (DUP_SUB & 2))
    for (int i = B; i < 512; i += G) { hyena_item(p, lds, i < 256 ? 1 : 0, i & 255); }
#endif
}

__device__ __forceinline__ void ph_hy_transpose(const P& p, LAS unsigned char* lds) {
    const int tid = tid_opaque(), lane = tid & 63, wave = tid >> 6;
    LAS bf16* tile = (LAS bf16*)(lds + wave * 9216);
    const bf16* HO = (const bf16*)(p.ws + WS_H); bf16* MX = (bf16*)(p.ws + WS_MIX);
    for (int it = blockIdx.x * 8 + wave; it < 2048; it += gridDim.x * 8) {
        const int rt = it >> 3, cb = it & 7, r0 = rt * 64, c0 = cb * 64;
#pragma unroll
        for (int i = 0; i < 8; ++i) { const int id = i * 64 + lane, c = id >> 3, rc = id & 7;
            *(LAS u32x4*)(tile + c * 72 + rc * 8) = *(const u32x4*)(HO + (size_t)(c0 + c) * M_TOK + r0 + rc * 8); }
        LDS_WAIT();
        bf16* dst = MX + (size_t)(r0 + lane) * 1024 + 512 + c0;
#pragma unroll
        for (int j = 0; j < 8; ++j) {
            u32x4 w;
#pragma unroll
            for (int i = 0; i < 4; ++i) { const unsigned a = tile[(j * 8 + 2 * i) * 72 + lane], bq = tile[(j * 8 + 2 * i + 1) * 72 + lane]; w[i] = a | (bq << 16); }
            *(u32x4*)(dst + j * 8) = w;
        }
        LDS_WAIT();
    }
}

#define XB_TMO      128
#define XB_XCNT(j)  (256  + 64 * (j))
#define XB_XSUB(j)  (1280 + 64 * (j))
#define XB_XGEN(j)  (2304 + 64 * (j))
#define XB_TOP      3328
#define XB_TOPGEN   3392
#define XCD_BAR_WORDS 3456
#define XB_SPIN_CAP (1u << 18)

__device__ __forceinline__ unsigned xb_ld(unsigned* p)              { return __hip_atomic_load(p, __ATOMIC_RELAXED, __HIP_MEMORY_SCOPE_AGENT); }
__device__ __forceinline__ unsigned xb_add(unsigned* p, unsigned v) { return __hip_atomic_fetch_add(p, v, __ATOMIC_RELAXED, __HIP_MEMORY_SCOPE_AGENT); }
__device__ __forceinline__ unsigned xb_xcc_id() { return (unsigned)__builtin_amdgcn_s_getreg((3 << 11) | 20) & 0xFu; }
#define XB_SPIN(cond, bar) do { unsigned _sp = 0; while (cond) { __builtin_amdgcn_s_sleep(1); \
    if ((++_sp & 255u) == 0u) { if (xb_ld(&(bar)[XB_TMO])) break; if (_sp > XB_SPIN_CAP) { atomicAdd(&(bar)[XB_TMO], 1u); break; } } } } while (0)

struct XcdBarrier {
    unsigned* bar; unsigned x;
    volatile LAS unsigned* st;
};

__device__ __forceinline__ XcdBarrier xcd_barrier_post(unsigned* bar, volatile LAS unsigned* st) {
    XcdBarrier b; b.bar = bar; b.x = xb_xcc_id(); b.st = st;
    if (threadIdx.x == 0) (void)xb_add(&bar[XB_XCNT(b.x)], 1u);
    return b;
}
__device__ __forceinline__ void xcd_barrier_complete(unsigned* bar, unsigned x, unsigned& nloc, unsigned& nx) {
    const unsigned G = gridDim.x * gridDim.y * gridDim.z;
    unsigned sum, cnt, mine, sp = 0u;
    for (;;) {
        sum = 0u; cnt = 0u; mine = 0u;
#pragma unroll
        for (unsigned j = 0; j < 16; ++j) { const unsigned c = xb_ld(&bar[XB_XCNT(j)]); sum += c; cnt += (c > 0u) ? 1u : 0u; mine = (j == x) ? c : mine; }
        if (sum == G) break;
        __builtin_amdgcn_s_sleep(1);
        if ((++sp & 255u) == 0u) { if (xb_ld(&bar[XB_TMO])) break; if (sp > XB_SPIN_CAP) { atomicAdd(&bar[XB_TMO], 1u); break; } }
    }
    nloc = mine > 0u ? mine : 1u; nx = cnt > 0u ? cnt : 1u;
}

__device__ __forceinline__ void xcd_barrier(const XcdBarrier& b) {
    asm volatile("s_waitcnt vmcnt(0)" ::: "memory");
    __syncthreads();
    if (threadIdx.x == 0) {
        unsigned* bar = b.bar;
        __builtin_amdgcn_s_waitcnt(0);
        unsigned nloc = b.st[0], nx = b.st[1];
        if (nloc == 0u) { xcd_barrier_complete(bar, b.x, nloc, nx); b.st[0] = nloc; b.st[1] = nx; }
        const unsigned old = xb_add(&bar[XB_XSUB(b.x)], 1u);
        const unsigned gen = old / nloc;
        if (old + 1u == (gen + 1u) * nloc) {
            __builtin_amdgcn_fence(__ATOMIC_RELEASE, "agent");
            asm volatile("s_waitcnt vmcnt(0)" ::: "memory");
            const unsigned og = xb_add(&bar[XB_TOP], 1u);
            const unsigned tg = og / nx;
            if (og + 1u == (tg + 1u) * nx) xb_add(&bar[XB_TOPGEN], 1u);
            else XB_SPIN(xb_ld(&bar[XB_TOPGEN]) == tg, bar);
            __builtin_amdgcn_fence(__ATOMIC_ACQUIRE, "agent");
            xb_add(&bar[XB_XGEN(b.x)], 1u);
            asm volatile("s_waitcnt vmcnt(0)" ::: "memory");
        } else {
            XB_SPIN(xb_ld(&bar[XB_XGEN(b.x)]) == gen, bar);
            __builtin_amdgcn_fence(__ATOMIC_ACQUIRE, "agent");
            asm volatile("s_waitcnt vmcnt(0)" ::: "memory");
        }
    }
    __syncthreads();
}


template <class Epi>
__device__ __forceinline__ void run_gemm(LAS unsigned char* lds, const bf16* A, const bf16* Bt, int M, int N, int K, const Epi& E, int rot = 0) {
    asm volatile("" : "+s"(K));
    pg8::Gemm g{A, Bt, M, N, K}; pg8::StaticOrder S; S.init(M, N, (int)gridDim.x, (int)((blockIdx.x + gridDim.x - rot) % gridDim.x));
    pg8::gemm_phase<Epi, pg8::StaticOrder, true, true>(lds, g, S, E);
}

#ifndef DUP_PH
#define DUP_PH (-1)
#endif
__device__ __forceinline__ void run_phase(const P& p, LAS unsigned char* lds, int k, bool dummy) {
    if (k == 0) {
        { float* cvz0 = (float*)(p.ws + WS_CV); for (int i = blockIdx.x * NTHREADS + tid_opaque(); i < 2 * CV_STRIDE; i += gridDim.x * NTHREADS) cvz0[i] = 0.f; }
        adaln_layer(p, lds, 0, 0); adaln_layer(p, lds, 1, (int)gridDim.x / 2); ph_rope_table(p); return; }
    if (k == 27) { final_norm_rows(p); return; }
    const int layer = (k - 1) / 13, sub = (k - 1) % 13;
    float* x = p.out;
    const float* mod = (const float*)(p.ws + WS_MOD);
    bf16* H = (bf16*)(p.ws + WS_H); bf16* R1 = (bf16*)(p.ws + WS_R1);
    float* ssb = (float*)(p.ws + WS_SS); float* cvb = (float*)(p.ws + WS_CV); float* ssp = (float*)(p.ws + WS_R2);
    switch (sub) {
    case 0: case 3: case 10: {
        const int jn = sub == 0 ? 0 : (sub == 3 ? 1 : 2), uu = 3 * layer + jn;
        float* cvo = cvb + (size_t)(uu & 1) * CV_STRIDE; float* cvz = cvb + (size_t)((uu + 1) & 1) * CV_STRIDE;
        const float* shift = mod + (size_t)layer * 9 * 9216 + (3 * jn) * 1024;
        for (int i = blockIdx.x * NTHREADS + tid_opaque(); i < CV_STRIDE; i += gridDim.x * NTHREADS) cvz[i] = 0.f;
        if (uu == 0) first_rows(p, p.in[10], ssb);
        else { const int t = tid_opaque();
            if (t < 64) for (int row = blockIdx.x * 64 + t; row < M_TOK; row += gridDim.x * 64) { float a = 0.f;
#pragma unroll
                for (int q = 0; q < 16; ++q) a += ssp[q * M_TOK + row];
                ssb[row] = rsqrtf_(a * (1.0f / 1024.0f) + 1e-6f); } }
        if (sub != 3) convert_ffn_weights(p, layer, sub == 0 ? 0 : 1, lds, shift, cvo);
        else {
            transpose_w<0>(p.in[17] + (size_t)layer * 1024 * 1024, 1024, 1024, 1024, (bf16*)(p.ws + W_OUT), 1024, lds, nullptr, nullptr, 0, layer == 0 ? 128 : 232);
            if (layer == 0) { transpose_w<0>(p.in[18], 3984, 3984, 1024, (bf16*)(p.ws + W_IN), 4096, lds, shift, cvo, 4096); build_lora_w(p); }
            else { transpose_w<0>(p.in[34], 2208, 2208, 1024, (bf16*)(p.ws + W_IN), 2304, lds, shift, cvo, 2304, 160);
                transpose_w<0>(p.in[36], 768, 768, 384, (bf16*)(p.ws + W_UQ), 768, lds, nullptr, nullptr, 0, 8);
                transpose_w<0>(p.in[38], 1024, 1024, 256, (bf16*)(p.ws + W_UKV), 1024, lds, nullptr, nullptr, 0, 17);
                ph_hyena_filters(p, lds); }
        }
    } break;
    case 1: case 11: { const int uu = 3 * layer + (sub == 1 ? 0 : 2);
        run_gemm(lds, H, (const bf16*)(p.ws + W_GU), M_TOK, 5632, 1024, EpiSwigluN{R1, ssb, cvb + (size_t)(uu & 1) * CV_STRIDE}); } break;
    case 2: case 12: {
        const bool first = layer == 0 && sub == 2;
        const float* xp = first ? p.in[0] : x; const float* xs = first ? p.in[1] : x + (size_t)MP * DM;
        const float* gate = mod + (size_t)layer * 9 * 9216 + (sub == 2 ? 2 : 8) * 1024;
        if (layer == 1 && sub == 12) { const EpiResid E{xp, xs, x, gate, 0.5f}; run_gemm(lds, R1, (const bf16*)(p.ws + W_DOWN), M_TOK, 1024, 2816, E); }
        else {
            const int ln = sub == 12 ? layer + 1 : layer, jn = sub == 2 ? 1 : 0, uu = 3 * ln + jn;
            const EpiResidN E{xp, xs, x, gate, p.in[jn == 0 ? 10 : 11] + ln * 1024, mod + (size_t)ln * 9 * 9216 + (3 * jn + 1) * 1024, H, ssp, 0.5f};
            run_gemm(lds, R1, (const bf16*)(p.ws + W_DOWN), M_TOK, 1024, 2816, E);
        }
    } break;
    case 9: {
        const int uu = 3 * layer + 2;
        const EpiResidN E{x, x + (size_t)MP * DM, x, mod + (size_t)layer * 9 * 9216 + 5 * 1024, p.in[12] + layer * 1024, mod + (size_t)layer * 9 * 9216 + 7 * 1024, H, ssp, 1.0f};
        run_gemm(lds, (const bf16*)(p.ws + WS_MIX), (const bf16*)(p.ws + W_OUT), M_TOK, 1024, 1024, E);
    } break;
    case 4: {
        const int N = layer == 0 ? 4096 : 2304, ld = layer == 0 ? LDP0 : LDP1, uu = 3 * layer + 1;
        run_gemm(lds, H, (const bf16*)(p.ws + W_IN), M_TOK, N, 1024, EpiStoreN{R1, ld, ld, ssb, cvb + (size_t)(uu & 1) * CV_STRIDE, N});
    } break;
    case 5: if (layer == 0) ph_lora_in(p); else ph_mla_prep(p, lds); break;
    case 6:
        if (layer == 0) run_gemm(lds, H, (const bf16*)(p.ws + W_LORA), M_TOK, 2560, 384, EpiLora{(bf16*)(p.ws + WS_R2), p.in[20], p.in[22]});
        else { run_gemm(lds, (const bf16*)(p.ws + WS_CKVA), (const bf16*)(p.ws + W_UKV), M_TOK + 2048, 1024, 256, EpiKV{(bf16*)(p.ws + WS_KV), (bf16*)(p.ws + WS_VT), M_TOK + 2048});
            run_gemm(lds, H, (const bf16*)(p.ws + W_UQ), M_TOK, 768, 384, EpiQ{(bf16*)(p.ws + WS_Q), (const float*)(p.ws + WS_ROPE)}, 32); }
        break;
    case 7: if (layer == 0) ph_scan(p, lds); else ph_attn_hyena(p, lds, dummy); break;
    case 8: if (layer == 0) ph_post_ab(p, dummy); else ph_hy_transpose(p, lds); break;
    default: break;
    }
}

__global__ void __launch_bounds__(NTHREADS, 2) hybrid_fwd(P p) {
    extern __shared__ __attribute__((aligned(16))) unsigned char lds_raw[];
    LAS unsigned char* lds = (LAS unsigned char*)lds_raw;
    cg::grid_group grid = cg::this_grid();
    volatile LAS unsigned* bst = (volatile LAS unsigned*)(lds + LDS_BYTES - 64);
    if (threadIdx.x < 16) bst[threadIdx.x] = 0u;
    __syncthreads();
    XcdBarrier bar = xcd_barrier_post((unsigned*)(p.ws + WS_CTL) + 1024, bst);
#pragma unroll 1
    for (int k = p.ph_lo; k < p.ph_hi; ++k) {
        const int nrep = (DUP_PH >= 0 && k == DUP_PH) ? 2 : 1;
#pragma unroll 1
        for (int rep = 0; rep < nrep; ++rep) { run_phase(p, lds, k, rep + 1 < nrep); if (rep + 1 < nrep) __syncthreads(); }
        if (k + 1 < p.ph_hi) { if (p.ph_hi < 0) grid.sync(); else { xcd_barrier(bar);
        } }
    }
}

extern "C" void kernel_launch(void* const* d_in, const int* in_sizes, int n_in, void* d_out, int out_size, void* d_ws, size_t ws_size, hipStream_t stream) {
    static int grid = 0;
    if (grid == 0) {
        if (n_in != 48 || out_size != 25427968 || ws_size < WS_END) {
            fprintf(stderr, "kernel_launch: expected 48 inputs, 25427968 outputs, >= %zu B workspace; got %d, %d, %zu\n", (size_t)WS_END, n_in, out_size, ws_size);
            grid = -1; return;
        }
        int dev = 0, cus = 0, per_cu = 0;
        hipGetDevice(&dev);
        hipDeviceGetAttribute(&cus, hipDeviceAttributeMultiprocessorCount, dev);
        hipFuncSetAttribute((const void*)hybrid_fwd, hipFuncAttributeMaxDynamicSharedMemorySize, LDS_BYTES);
        hipOccupancyMaxActiveBlocksPerMultiprocessor(&per_cu, (const void*)hybrid_fwd, NTHREADS, LDS_BYTES);
        if (per_cu < 1) { fprintf(stderr, "kernel_launch: occupancy query says %d blocks/CU\n", per_cu); per_cu = 1; }
        (void)hipGetLastError();
        grid = cus;
    }
    if (grid < 0) return;
    (void)hipMemsetAsync((char*)d_ws + WS_CTL, 0, 24 * 1024, stream);
    P prm{};
    for (int i = 0; i < 48; ++i) prm.in[i] = (const float*)d_in[i];
    prm.out = (float*)d_out; prm.ws = (unsigned char*)d_ws;
#ifndef N_SPLIT
    prm.ph_lo = 0; prm.ph_hi = 28;
    void* args[] = {&prm};
    hipError_t e = hipLaunchCooperativeKernel((const void*)hybrid_fwd, dim3(grid), dim3(NTHREADS), args, LDS_BYTES, stream);
    if (e != hipSuccess) fprintf(stderr, "cooperative launch failed: %s (grid %d)\n", hipGetErrorString(e), grid);
#else
    for (int k = 0; k < 28; ++k) {
        prm.ph_lo = k; prm.ph_hi = k + 1;
        void* args[] = {&prm};
        hipError_t e = hipLaunchCooperativeKernel((const void*)hybrid_fwd, dim3(grid), dim3(NTHREADS), args, LDS_BYTES, stream);
        if (e != hipSuccess) { fprintf(stderr, "launch %d failed: %s\n", k, hipGetErrorString(e)); break; }
    }
#endif
}
```

```cpp
#include <hip/hip_runtime.h>
#include <hip/hip_cooperative_groups.h>
#include <cstdio>
#include <cstdint>
namespace cg = cooperative_groups;

#define LAS __attribute__((address_space(3)))
typedef unsigned short bf16;
typedef float f32x2 __attribute__((ext_vector_type(2)));
typedef float f32x4 __attribute__((ext_vector_type(4)));
typedef float f32x16 __attribute__((ext_vector_type(16)));
typedef unsigned u32x2 __attribute__((ext_vector_type(2)));
typedef unsigned u32x4 __attribute__((ext_vector_type(4)));
typedef short s16x8 __attribute__((ext_vector_type(8)));

constexpr int M_TOK = 16384, MP = 8192, DM = 1024, DFF = 2816;
constexpr int LDP0 = 3984, LDP1 = 2304;
constexpr int OUT_YS = 8388608, OUT_SRW = 16777216, OUT_SGD = 18874368, OUT_CKV = 23068672, OUT_KPE = 25165824;

constexpr size_t MiB = 1ull << 20;
constexpr size_t WS_CTL = 0;
constexpr size_t WS_SS = 64 * 1024;
constexpr size_t WS_ROPE = 512 * 1024;
constexpr size_t WS_CV = 2 * 1048576 + 16 * 1048576 + 524288;
constexpr int CV_STRIDE = 9 * 5632;
constexpr size_t WS_MOD = 1 * MiB;
constexpr size_t WS_W = 2 * MiB;
constexpr size_t W_GU = WS_W, W_DOWN = WS_W + 11 * MiB;
constexpr size_t W_IN = WS_W, W_OUT = WS_W + 8 * MiB, W_LORA = WS_W + 10 * MiB, W_UQ = WS_W + 12 * MiB, W_UKV = WS_W + 13 * MiB;
constexpr size_t WS_H = 19 * MiB;
constexpr size_t WS_MIX = 51 * MiB;
constexpr size_t WS_R1 = 83 * MiB;
constexpr size_t R1_BYTES = 130547712;
constexpr size_t WS_HYIN = WS_R1 + 72 * MiB;
constexpr size_t WS_R2 = WS_R1 + R1_BYTES;
constexpr size_t WS_Q = WS_R2, WS_KV = WS_R2 + 24 * MiB, WS_VT = WS_R2 + 42 * MiB, WS_CKVA = WS_R2 + 60 * MiB, WS_KPEA = WS_R2 + 69 * MiB, WS_GFS = WS_R2 + 71 * MiB, WS_GFP = WS_R2 + 75 * MiB;
constexpr size_t WS_END = WS_R2 + 80 * MiB;

constexpr int LDS_BYTES = 159744;
constexpr int NTHREADS = 512;

struct P {
    const float* in[48];
    float* out;
    unsigned char* ws;
    int ph_lo, ph_hi;
};

__device__ __forceinline__ float bf2f(unsigned b) { return __uint_as_float(b << 16); }
__device__ __forceinline__ float bflo(unsigned w) { return __uint_as_float(w << 16); }
__device__ __forceinline__ float bfhi(unsigned w) { return __uint_as_float(w & 0xffff0000u); }
typedef __bf16 bf16x2_t __attribute__((ext_vector_type(2)));
__device__ __forceinline__ unsigned pk2(float lo, float hi) { const f32x2 v = {lo, hi}; return __builtin_bit_cast(unsigned, __builtin_convertvector(v, bf16x2_t)); }
__device__ __forceinline__ f32x4 unpk4(u32x2 w) { return (f32x4){bflo(w.x), bfhi(w.x), bflo(w.y), bfhi(w.y)}; }
__device__ __forceinline__ u32x2 pk4(f32x4 v) { return (u32x2){pk2(v.x, v.y), pk2(v.z, v.w)}; }
__device__ __forceinline__ float wave_sum(float v) {
#pragma unroll
    for (int o = 1; o < 64; o <<= 1) v += __shfl_xor(v, o);
    return v;
}
__device__ __forceinline__ float dpp_f(float x, int) { return x; }
#define DPPF(x, ctrl) __int_as_float(__builtin_amdgcn_update_dpp(0, __float_as_int(x), (ctrl), 0xF, 0xF, true))
__device__ __forceinline__ float red4(float x) { x += DPPF(x, 0xB1); x += DPPF(x, 0x4E); return x; }
__device__ __forceinline__ float red8(float x) { x = red4(x); x += DPPF(x, 0x141); return x; }
__device__ __forceinline__ float red16(float x) { x = red8(x); x += DPPF(x, 0x140); return x; }
__device__ __forceinline__ float sigmoidf_(float x) { return __builtin_amdgcn_rcpf(1.0f + __expf(-x)); }
__device__ __forceinline__ float siluf_(float x) { return x * __builtin_amdgcn_rcpf(1.0f + __expf(-x)); }
__device__ __forceinline__ float rsqrtf_(float x) { return __builtin_amdgcn_rsqf(x); }
__device__ __forceinline__ int cond_of_row(int row) { return row < MP ? 0 : 1 + ((row - MP) >> 10); }
__device__ __forceinline__ int tid_opaque() { int t = threadIdx.x; asm volatile("" : "+v"(t)); return t; }
#define LDS_WAIT() asm volatile("s_waitcnt lgkmcnt(0)" ::: "memory")

namespace pg8 {
#define PG8_LAS __attribute__((address_space(3)))
typedef unsigned short bf16_t;
typedef short bf16x8 __attribute__((ext_vector_type(8)));
typedef float f32x4 __attribute__((ext_vector_type(4)));
typedef unsigned u32x4 __attribute__((ext_vector_type(4)));
constexpr int BM = 256, BK = 64, HALF = 128, HTB = HALF * BK * 2  , STAGE_BYTES = 8 * HTB, NXCD = 8, WGM = 4;

__host__ __device__ __forceinline__ int lds_byte(int r, int c) { const int st = (r >> 4) * 2 + (c >> 5), rr = r & 15, cc = c & 31, ob = rr * 64 + cc * 2; return st * 1024 + (ob ^ (((ob >> 9) & 1) << 5)); }
__host__ __device__ __forceinline__ void stage_rc(int b, int& R, int& C) { const int st = b / 1024, sb = b % 1024, swz = sb ^ (((sb >> 9) & 1) << 5); R = (st >> 1) * 16 + swz / 64; C = (st & 1) * 32 + (swz % 64) / 2; }
__host__ __device__ __forceinline__ int perm32(int rho) { const int n = rho >> 4, i = rho & 15; return 8 * (i >> 2) + 4 * n + (i & 3); }

struct Unit { int pm, pn; };
struct Gemm { const bf16_t* A; const bf16_t* Bt; int M, N, K; };

struct StaticOrder {
    int nM, nN, nwg, G, c;
    __host__ __device__ void init(int M, int N, int G_, int c_) { nM = M / BM; nN = N / BM; nwg = nM * nN; G = G_; c = c_; }
    __host__ __device__ bool next(int i, Unit& u) const {
        const long L = (long)i * G + c; if (L >= nwg) return false;
        int wgid = (int)L; { const int q = nwg / NXCD, r = nwg % NXCD, xcd = wgid % NXCD, off = wgid / NXCD; wgid = (xcd < r ? xcd * (q + 1) : r * (q + 1) + (xcd - r) * q) + off; }
        const int nig = WGM * nN, gid = wgid / nig, fm = gid * WGM, gsz = (nM - fm) < WGM ? (nM - fm) : WGM;
        u.pm = fm + ((wgid % nig) % gsz); u.pn = (wgid % nig) / gsz; return true;
    }
    __device__ __forceinline__ void a_ready(const Unit&) const {}
    __device__ __forceinline__ void done(const Unit&) const {}
};
__device__ __forceinline__ unsigned cvt_pk_bf16(float lo, float hi) { unsigned r; asm volatile("v_cvt_pk_bf16_f32 %0, %1, %2" : "=v"(r) : "v"(lo), "v"(hi)); return r; }
typedef float f32x2 __attribute__((ext_vector_type(2)));
template <class Epi, class Sched, bool ALIGN_EPI = false, bool SP2 = false>
__device__ __forceinline__ void gemm_phase(PG8_LAS unsigned char* lds, const Gemm g, const Sched& S, const Epi& E) {
    const int tid = tid_opaque(), wid = __builtin_amdgcn_readfirstlane(tid >> 6), lane = tid & 63, wr = wid >> 2, wc = wid & 3, fr = lane & 15, fq = lane >> 4;
    const int K = g.K, nt = K / BK;
    unsigned voffA[2], voffB[2];
#pragma unroll
    for (int i = 0; i < 2; ++i) { int R, C; stage_rc(tid * 16 + i * 8192, R, C); const int Rb = Epi::PERM ? ((R & ~31) + perm32(R & 31)) : R;
        voffA[i] = (unsigned)(R * K + C) * 2u; voffB[i] = (unsigned)(Rb * K + C) * 2u; }
    const size_t kstep = (size_t)(BK * 2);
    const size_t hstep = (size_t)HALF * K * 2;
    const size_t tstep = 2 * hstep;
    const unsigned ldsw = (unsigned)wid * 1024u;
    const int aoff = lds_byte(wr * 64 + fr, fq * 8), boff = lds_byte(wc * 32 + fr, fq * 8);
#define PG8_SA(b, h) (((b) * 2 + (h)) * HTB)
#define PG8_SB(b, h) ((4 + (b) * 2 + (h)) * HTB)
#define PG8_STAGE(bufoff, gbase, voff) do { _Pragma("unroll") for (int _i = 0; _i < 2; ++_i) \
        __builtin_amdgcn_global_load_lds((const unsigned*)((const char*)(gbase) + (voff)[_i]), (PG8_LAS unsigned*)(lds + (bufoff) + ldsw + _i * 8192), 16, 0, 0); } while (0)
#define PG8_LDA(dst, b, h) do { _Pragma("unroll") for (int m = 0; m < 4; ++m) _Pragma("unroll") for (int k = 0; k < 2; ++k) dst[m][k] = *(const PG8_LAS bf16x8*)(lds + PG8_SA(b, h) + aoff + m * 2048 + k * 1024); } while (0)
#define PG8_LDB(dst, b, h) do { _Pragma("unroll") for (int n = 0; n < 2; ++n) _Pragma("unroll") for (int k = 0; k < 2; ++k) dst[n][k] = *(const PG8_LAS bf16x8*)(lds + PG8_SB(b, h) + boff + n * 2048 + k * 1024); } while (0)
#define PG8_MMA(ai, bj, At, Bt) do { __builtin_amdgcn_s_setprio(1); _Pragma("unroll") for (int m = 0; m < 4; ++m) _Pragma("unroll") for (int n = 0; n < 2; ++n) _Pragma("unroll") for (int k = 0; k < 2; ++k) \
        acc[ai][bj][m][n] = __builtin_amdgcn_mfma_f32_16x16x32_bf16(Bt[n][k], At[m][k], acc[ai][bj][m][n], 0, 0, 0); __builtin_amdgcn_s_setprio(0); } while (0)
#define PG8_WAIT_V(n) asm volatile("s_waitcnt vmcnt(" #n ")" ::: "memory")
#define PG8_WAIT_L(n) asm volatile("s_waitcnt lgkmcnt(" #n ")" ::: "memory")
#define PG8_BAR __builtin_amdgcn_s_barrier()
#define PG8_SCHED __builtin_amdgcn_sched_barrier(0)
    Unit cur, nxt; int ui = 0;
    if (!S.next(0, cur)) return;
    f32x4 acc[2][2][4][2];
#pragma unroll
    for (int a = 0; a < 2; ++a)
#pragma unroll
        for (int b = 0; b < 2; ++b)
#pragma unroll
            for (int m = 0; m < 4; ++m)
#pragma unroll
                for (int n = 0; n < 2; ++n) acc[a][b][m][n] = (f32x4){0.f, 0.f, 0.f, 0.f};
    bf16x8 At[4][2], B0[2][2], B1[2][2];
    const char* cA = (const char*)g.A + (size_t)cur.pm * tstep; const char* cB = (const char*)g.Bt + (size_t)cur.pn * tstep;
    S.a_ready(cur);
    if constexpr (SP2) {
        PG8_STAGE(PG8_SB(0, 0), cB, voffB); PG8_STAGE(PG8_SB(0, 1), cB + hstep, voffB); PG8_STAGE(PG8_SA(0, 0), cA, voffA); PG8_STAGE(PG8_SA(0, 1), cA + hstep, voffA);
        if (wr == 1) PG8_BAR;
        PG8_WAIT_V(2); PG8_BAR;
        PG8_STAGE(PG8_SB(1, 0), cB + kstep, voffB); PG8_STAGE(PG8_SA(1, 0), cA + kstep, voffA); PG8_STAGE(PG8_SB(1, 1), cB + hstep + kstep, voffB);
        PG8_WAIT_V(6); PG8_BAR;
    } else {
        PG8_STAGE(PG8_SB(0, 0), cB, voffB); PG8_STAGE(PG8_SA(0, 0), cA, voffA); PG8_STAGE(PG8_SB(0, 1), cB + hstep, voffB); PG8_STAGE(PG8_SA(0, 1), cA + hstep, voffA);
        if (wr == 1) PG8_BAR;
        PG8_WAIT_V(4); PG8_BAR;
        PG8_STAGE(PG8_SB(1, 0), cB + kstep, voffB); PG8_STAGE(PG8_SA(1, 0), cA + kstep, voffA); PG8_STAGE(PG8_SB(1, 1), cB + hstep + kstep, voffB);
        PG8_WAIT_V(6); PG8_BAR;
    }
    for (;;) {
        const bool has_next = S.next(ui + 1, nxt);
        const char* nA = has_next ? (const char*)g.A + (size_t)nxt.pm * tstep : cA; const char* nB = has_next ? (const char*)g.Bt + (size_t)nxt.pn * tstep : cB;
#pragma unroll 1
        for (int t = 0; t < nt; t += 2) {
            const bool last = (t == nt - 2);
            const char* a1 = cA + (size_t)(t + 1) * kstep;
            const char* a2 = last ? nA : cA + (size_t)(t + 2) * kstep; const char* b2 = last ? nB : cB + (size_t)(t + 2) * kstep;
            const char* a3 = a2 + kstep; const char* b3 = b2 + kstep;
            if (last && has_next) S.a_ready(nxt);
            if constexpr (SP2) {
            PG8_LDB(B0, 0, 0); PG8_LDB(B1, 0, 1); PG8_SCHED; PG8_LDA(At, 0, 0); PG8_STAGE(PG8_SA(1, 1), a1 + hstep, voffA);
            PG8_WAIT_V(8); PG8_WAIT_L(0); PG8_BAR; PG8_MMA(0, 0, At, B0); PG8_MMA(0, 1, At, B1); PG8_BAR; PG8_SCHED;
            PG8_LDA(At, 0, 1); PG8_STAGE(PG8_SB(0, 0), b2, voffB); PG8_STAGE(PG8_SB(0, 1), b2 + hstep, voffB); PG8_STAGE(PG8_SA(0, 0), a2, voffA);
            PG8_WAIT_V(8); PG8_WAIT_L(0); PG8_BAR; PG8_MMA(1, 0, At, B0); PG8_MMA(1, 1, At, B1); PG8_BAR; PG8_SCHED;
            PG8_LDB(B0, 1, 0); PG8_LDB(B1, 1, 1); PG8_SCHED; PG8_LDA(At, 1, 0); PG8_STAGE(PG8_SA(0, 1), a2 + hstep, voffA);
            PG8_WAIT_V(8); PG8_WAIT_L(0); PG8_BAR; PG8_MMA(0, 0, At, B0); PG8_MMA(0, 1, At, B1); PG8_BAR; PG8_SCHED;
            PG8_LDA(At, 1, 1); PG8_STAGE(PG8_SB(1, 0), b3, voffB); PG8_STAGE(PG8_SB(1, 1), b3 + hstep, voffB); PG8_STAGE(PG8_SA(1, 0), a3, voffA);
            PG8_WAIT_V(8); PG8_WAIT_L(0); PG8_BAR; PG8_MMA(1, 0, At, B0); PG8_MMA(1, 1, At, B1); PG8_BAR; PG8_SCHED;
            } else {
            PG8_LDB(B0, 0, 0); PG8_SCHED; PG8_LDA(At, 0, 0); PG8_STAGE(PG8_SA(1, 1), a1 + hstep, voffA);
            PG8_WAIT_L(8); PG8_BAR; PG8_WAIT_L(0); PG8_MMA(0, 0, At, B0); PG8_BAR; PG8_SCHED;
            PG8_LDB(B1, 0, 1); PG8_STAGE(PG8_SB(0, 0), b2, voffB);
            PG8_BAR; PG8_WAIT_L(0); PG8_MMA(0, 1, At, B1); PG8_BAR;
            PG8_LDA(At, 0, 1); PG8_STAGE(PG8_SA(0, 0), a2, voffA);
            PG8_BAR; PG8_WAIT_L(0); PG8_MMA(1, 0, At, B0); PG8_BAR; PG8_SCHED;
            PG8_STAGE(PG8_SB(0, 1), b2 + hstep, voffB);
            PG8_WAIT_V(6); PG8_BAR; PG8_MMA(1, 1, At, B1); PG8_BAR;
            PG8_LDB(B0, 1, 0); PG8_SCHED; PG8_LDA(At, 1, 0); PG8_STAGE(PG8_SA(0, 1), a2 + hstep, voffA);
            PG8_WAIT_L(8); PG8_BAR; PG8_WAIT_L(0); PG8_MMA(0, 0, At, B0); PG8_BAR; PG8_SCHED;
            PG8_LDB(B1, 1, 1); PG8_STAGE(PG8_SB(1, 0), b3, voffB);
            PG8_BAR; PG8_WAIT_L(0); PG8_MMA(0, 1, At, B1); PG8_BAR;
            PG8_LDA(At, 1, 1); PG8_STAGE(PG8_SA(1, 0), a3, voffA);
            PG8_BAR; PG8_WAIT_L(0); PG8_MMA(1, 0, At, B0); PG8_BAR; PG8_SCHED;
            PG8_STAGE(PG8_SB(1, 1), b3 + hstep, voffB);
            PG8_WAIT_V(6); PG8_BAR; PG8_MMA(1, 1, At, B1); PG8_BAR;
            }
        }
        if constexpr (ALIGN_EPI) { if (wr == 0) PG8_BAR; }
        if constexpr (!Epi::AFTER_DRAIN) { E(acc, cur, wr, wc, fr, fq); S.done(cur); }
        if (!has_next) break;
#pragma unroll
        for (int a = 0; a < 2; ++a)
#pragma unroll
            for (int b = 0; b < 2; ++b)
#pragma unroll
                for (int m = 0; m < 4; ++m)
#pragma unroll
                    for (int n = 0; n < 2; ++n) acc[a][b][m][n] = (f32x4){0.f, 0.f, 0.f, 0.f};
        cur = nxt; cA = nA; cB = nB; ++ui;
        if constexpr (ALIGN_EPI) { if (wr == 1) PG8_BAR; }
    }
    PG8_WAIT_V(0);
    if constexpr (!ALIGN_EPI) { if (wr == 0) PG8_BAR; }
    PG8_BAR;
    if constexpr (Epi::AFTER_DRAIN) { E.fused(acc, cur, wr, wc, fr, fq, lds, wid, lane); S.done(cur); }
#undef PG8_SA
#undef PG8_SB
#undef PG8_STAGE
#undef PG8_LDA
#undef PG8_LDB
#undef PG8_MMA
#undef PG8_WAIT_V
#undef PG8_WAIT_L
#undef PG8_BAR
#undef PG8_SCHED
}
}

using pg8::Unit;
typedef const f32x4 (&AccRef)[2][2][4][2];

struct EpiSwiglu {
    static constexpr bool PERM = true, AFTER_DRAIN = false;
    bf16* O;
    __device__ __forceinline__ void operator()(AccRef acc, const Unit& u, int wr, int wc, int fr, int fq) const {
        const int row0 = u.pm * 256 + wr * 64 + fr, col0 = u.pn * 128 + wc * 32 + 8 * fq;
#pragma unroll
        for (int ai = 0; ai < 2; ++ai)
#pragma unroll
            for (int m = 0; m < 4; ++m) {
                const f32x4 g0 = acc[ai][0][m][0], g1 = acc[ai][0][m][1], u0 = acc[ai][1][m][0], u1 = acc[ai][1][m][1];
                float v[8];
#pragma unroll
                for (int i = 0; i < 4; ++i) { v[i] = g0[i] * __builtin_amdgcn_rcpf(1.0f + __expf(-g0[i])) * u0[i]; v[4 + i] = g1[i] * __builtin_amdgcn_rcpf(1.0f + __expf(-g1[i])) * u1[i]; }
                u32x4 w; w.x = pk2(v[0], v[1]); w.y = pk2(v[2], v[3]); w.z = pk2(v[4], v[5]); w.w = pk2(v[6], v[7]);
                *(u32x4*)(O + (size_t)(row0 + ai * 128 + m * 16) * DFF + col0) = w;
            }
    }
};
struct EpiSwigluN {
    static constexpr bool PERM = true, AFTER_DRAIN = false;
    bf16* O; const float* ss; const float* cv;
    __device__ __forceinline__ void operator()(AccRef acc, const Unit& u, int wr, int wc, int fr, int fq) const {
        const int cond = u.pm < 32 ? 0 : 1 + ((u.pm - 32) >> 2);
        const int row0 = u.pm * 256 + wr * 64 + fr, col0 = u.pn * 128 + wc * 32 + 8 * fq, gc0 = u.pn * 256 + wc * 32 + 8 * fq;
        const float* cp = cv + (size_t)cond * 5632 + gc0;
        const f32x4 cg0 = *(const f32x4*)cp, cg1 = *(const f32x4*)(cp + 4), cu0 = *(const f32x4*)(cp + 128), cu1 = *(const f32x4*)(cp + 132);
#pragma unroll
        for (int ai = 0; ai < 2; ++ai)
#pragma unroll
            for (int m = 0; m < 4; ++m) {
                const int row = row0 + ai * 128 + m * 16;
                const float rs = ss[row];
                const f32x4 g0 = acc[ai][0][m][0] * rs + cg0, g1 = acc[ai][0][m][1] * rs + cg1, u0 = acc[ai][1][m][0] * rs + cu0, u1 = acc[ai][1][m][1] * rs + cu1;
                float v[8];
#pragma unroll
                for (int i = 0; i < 4; ++i) { v[i] = g0[i] * __builtin_amdgcn_rcpf(1.0f + __expf(-g0[i])) * u0[i]; v[4 + i] = g1[i] * __builtin_amdgcn_rcpf(1.0f + __expf(-g1[i])) * u1[i]; }
                u32x4 w; w.x = pk2(v[0], v[1]); w.y = pk2(v[2], v[3]); w.z = pk2(v[4], v[5]); w.w = pk2(v[6], v[7]);
                *(u32x4*)(O + (size_t)row * DFF + col0) = w;
            }
    }
};
struct EpiStoreN {
    static constexpr bool PERM = true, AFTER_DRAIN = false;
    bf16* O; int ldc; int ncols; const float* ss; const float* cv; int ncv;
    __device__ __forceinline__ void operator()(AccRef acc, const Unit& u, int wr, int wc, int fr, int fq) const {
        const int cond = u.pm < 32 ? 0 : 1 + ((u.pm - 32) >> 2);
        const int row0 = u.pm * 256 + wr * 64 + fr, col0 = u.pn * 256 + wc * 32 + 8 * fq;
        const float* cp = cv + (size_t)cond * ncv + col0;
        const f32x4 c00 = *(const f32x4*)cp, c01 = *(const f32x4*)(cp + 4), c10 = *(const f32x4*)(cp + 128), c11 = *(const f32x4*)(cp + 132);
#pragma unroll
        for (int ai = 0; ai < 2; ++ai)
#pragma unroll
            for (int m = 0; m < 4; ++m) {
                const int row = row0 + ai * 128 + m * 16;
                const float rs = ss[row];
                bf16* rowp = O + (size_t)row * ldc;
#pragma unroll
                for (int bj = 0; bj < 2; ++bj) { const int col = col0 + bj * 128;
                    const f32x4 v0 = acc[ai][bj][m][0] * rs + (bj ? c10 : c00), v1 = acc[ai][bj][m][1] * rs + (bj ? c11 : c01);
                    u32x4 w; w.x = pk2(v0[0], v0[1]); w.y = pk2(v0[2], v0[3]); w.z = pk2(v1[0], v1[1]); w.w = pk2(v1[2], v1[3]);
                    if (col < ncols) *(u32x4*)(rowp + col) = w; }
            }
    }
};
struct EpiResidN {
    static constexpr bool PERM = true, AFTER_DRAIN = false;
    const float* xin_p; const float* xin_s; float* xout; const float* gate_base;
    const float* gnext; const float* scn_base; bf16* xg; float* ss; float coef;
    __device__ __forceinline__ void operator()(AccRef acc, const Unit& u, int wr, int wc, int fr, int fq) const {
        const int cond = u.pm < 32 ? 0 : 1 + ((u.pm - 32) >> 2);
        const float* gate = gate_base + (size_t)cond * 9216; const float* scn = scn_base + (size_t)cond * 9216;
        const int row0 = u.pm * 256 + wr * 64 + fr, col0 = u.pn * 256 + wc * 32 + 8 * fq;
        float sq[2][4];
#pragma unroll
        for (int ai = 0; ai < 2; ++ai)
#pragma unroll
            for (int m = 0; m < 4; ++m) sq[ai][m] = 0.f;
        const float* xb = u.pm < 32 ? xin_p : xin_s - (size_t)MP * DM;
        const unsigned off0 = (unsigned)(row0 * DM + col0);
#pragma unroll
        for (int bj = 0; bj < 2; ++bj) {
            const int col = col0 + bj * 128;
            f32x4 gv[2], G[2];
#pragma unroll
            for (int n = 0; n < 2; ++n) { gv[n] = *(const f32x4*)(gate + col + 4 * n) * coef; G[n] = *(const f32x4*)(gnext + col + 4 * n) * (*(const f32x4*)(scn + col + 4 * n) + 1.0f); }
#pragma unroll
            for (int ai = 0; ai < 2; ++ai) {
                f32x4 xv[4][2];
#pragma unroll
                for (int m = 0; m < 4; ++m)
#pragma unroll
                    for (int n = 0; n < 2; ++n) xv[m][n] = *(const f32x4*)(xb + (off0 + (unsigned)((ai * 128 + m * 16) * DM + bj * 128 + 4 * n)));
                asm volatile("" ::: "memory");
#pragma unroll
                for (int m = 0; m < 4; ++m) {
                    const unsigned off = off0 + (unsigned)((ai * 128 + m * 16) * DM + bj * 128);
                    const f32x4 x0 = xv[m][0] + gv[0] * acc[ai][bj][m][0], x1 = xv[m][1] + gv[1] * acc[ai][bj][m][1];
                    *(f32x4*)(xout + off) = x0; *(f32x4*)(xout + off + 4) = x1;
                    const u32x2 w0 = pk4(x0 * G[0]), w1 = pk4(x1 * G[1]);
                    *(u32x4*)(xg + off) = (u32x4){w0.x, w0.y, w1.x, w1.y};
                    sq[ai][m] += x0.x * x0.x + x0.y * x0.y + x0.z * x0.z + x0.w * x0.w + x1.x * x1.x + x1.y * x1.y + x1.z * x1.z + x1.w * x1.w;
                }
                asm volatile("" ::: "memory");
            }
        }
#pragma unroll
        for (int ai = 0; ai < 2; ++ai)
#pragma unroll
            for (int m = 0; m < 4; ++m) {
                float t = sq[ai][m]; t += __shfl_xor(t, 16); t += __shfl_xor(t, 32);
                if (fq == 0) ss[(u.pn * 4 + wc) * M_TOK + row0 + ai * 128 + m * 16] = t;
            }
    }
};
struct EpiResid {
    static constexpr bool PERM = true, AFTER_DRAIN = false;
    const float* xin_p; const float* xin_s; float* xout; const float* gate_base; float coef;
    __device__ __forceinline__ void operator()(AccRef acc, const Unit& u, int wr, int wc, int fr, int fq) const {
        const int cond = u.pm < 32 ? 0 : 1 + ((u.pm - 32) >> 2);
        const float* gate = gate_base + (size_t)cond * 9216;
        const int row0 = u.pm * 256 + wr * 64 + fr, col0 = u.pn * 256 + wc * 32 + 8 * fq;
        const float* xb = u.pm < 32 ? xin_p : xin_s - (size_t)MP * DM;
        const unsigned off0 = (unsigned)(row0 * DM + col0);
#pragma unroll
        for (int bj = 0; bj < 2; ++bj) {
            const f32x4 gv0 = *(const f32x4*)(gate + col0 + bj * 128) * coef, gv1 = *(const f32x4*)(gate + col0 + bj * 128 + 4) * coef;
#pragma unroll
            for (int ai = 0; ai < 2; ++ai) {
                f32x4 xv[4][2];
#pragma unroll
                for (int m = 0; m < 4; ++m)
#pragma unroll
                    for (int n = 0; n < 2; ++n) xv[m][n] = *(const f32x4*)(xb + (off0 + (unsigned)((ai * 128 + m * 16) * DM + bj * 128 + 4 * n)));
                asm volatile("" ::: "memory");
#pragma unroll
                for (int m = 0; m < 4; ++m) {
                    const unsigned off = off0 + (unsigned)((ai * 128 + m * 16) * DM + bj * 128);
                    *(f32x4*)(xout + off) = xv[m][0] + gv0 * acc[ai][bj][m][0]; *(f32x4*)(xout + off + 4) = xv[m][1] + gv1 * acc[ai][bj][m][1];
                }
                asm volatile("" ::: "memory");
            }
        }
    }
};
struct EpiStore {
    static constexpr bool PERM = true, AFTER_DRAIN = false;
    bf16* O; int ldc; int ncols;
    __device__ __forceinline__ void operator()(AccRef acc, const Unit& u, int wr, int wc, int fr, int fq) const {
        const int row0 = u.pm * 256 + wr * 64 + fr, col0 = u.pn * 256 + wc * 32 + 8 * fq;
#pragma unroll
        for (int ai = 0; ai < 2; ++ai)
#pragma unroll
            for (int m = 0; m < 4; ++m) {
                bf16* rowp = O + (size_t)(row0 + ai * 128 + m * 16) * ldc;
#pragma unroll
                for (int bj = 0; bj < 2; ++bj) { const int col = col0 + bj * 128; const f32x4 v0 = acc[ai][bj][m][0], v1 = acc[ai][bj][m][1];
                    u32x4 w; w.x = pk2(v0[0], v0[1]); w.y = pk2(v0[2], v0[3]); w.z = pk2(v1[0], v1[1]); w.w = pk2(v1[2], v1[3]);
                    if (col < ncols) *(u32x4*)(rowp + col) = w; }
            }
    }
};
struct EpiLora {
    static constexpr bool PERM = true, AFTER_DRAIN = false;
    bf16* O; const float* w0; const float* a0;
    __device__ __forceinline__ void operator()(AccRef acc, const Unit& u, int wr, int wc, int fr, int fq) const {
        const int seg = u.pn >> 1;
        const float* bias = seg < 2 ? w0 + seg * 512 : a0 + (seg & 1) * 512;
        const int row0 = u.pm * 256 + wr * 64 + fr, ct0 = wc * 32 + 8 * fq;
#pragma unroll
        for (int bj = 0; bj < 2; ++bj) {
            const int cseg = (u.pn & 1) * 256 + ct0 + bj * 128;
            f32x4 b0 = {0.f, 0.f, 0.f, 0.f}, b1 = {0.f, 0.f, 0.f, 0.f};
            if (seg < 4) { b0 = *(const f32x4*)(bias + cseg); b1 = *(const f32x4*)(bias + cseg + 4); }
#pragma unroll
            for (int ai = 0; ai < 2; ++ai)
#pragma unroll
                for (int m = 0; m < 4; ++m) {
                    f32x4 v0 = acc[ai][bj][m][0] + b0, v1 = acc[ai][bj][m][1] + b1;
                    if (seg < 4) {
                        const float sc = seg < 2 ? 0.60653066f : 1.0f;
#pragma unroll
                        for (int i = 0; i < 4; ++i) { v0[i] = sc * sigmoidf_(v0[i]); v1[i] = sc * sigmoidf_(v1[i]); }
                    }
                    u32x4 w; w.x = pk2(v0[0], v0[1]); w.y = pk2(v0[2], v0[3]); w.z = pk2(v1[0], v1[1]); w.w = pk2(v1[2], v1[3]);
                    *(u32x4*)(O + (size_t)(row0 + ai * 128 + m * 16) * 2560 + u.pn * 256 + ct0 + bj * 128) = w;
                    asm volatile("" ::: "memory");
                }
        }
    }
};
struct EpiQ {
    static constexpr bool PERM = true, AFTER_DRAIN = false;
    bf16* O; const float* rope;
    __device__ __forceinline__ void operator()(AccRef acc, const Unit& u, int wr, int wc, int fr, int fq) const {
        const int row0 = u.pm * 256 + wr * 64 + fr, col0 = u.pn * 256 + wc * 32 + 8 * fq;
        const float qs = 0.10206207261596577f;
#pragma unroll
        for (int bj = 0; bj < 2; ++bj) {
            const int col = col0 + bj * 128, e0 = col % 96;
            const bool is_rope = e0 >= 64;
#pragma unroll
            for (int ai = 0; ai < 2; ++ai)
#pragma unroll
                for (int m = 0; m < 4; ++m) {
                    const int row = row0 + ai * 128 + m * 16;
                    f32x4 v0 = acc[ai][bj][m][0] * qs, v1 = acc[ai][bj][m][1] * qs;
                    if (is_rope && row >= MP) {
                        const int t = (row - MP) & 1023;
                        const float* rt = rope + (size_t)t * 32 + (e0 - 64);
                        const f32x4 c0 = *(const f32x4*)(rt), c1 = *(const f32x4*)(rt + 4);
                        f32x4 r0, r1;
                        r0[0] = v0[0] * c0[0] - v0[1] * c0[1]; r0[1] = v0[0] * c0[1] + v0[1] * c0[0];
                        r0[2] = v0[2] * c0[2] - v0[3] * c0[3]; r0[3] = v0[2] * c0[3] + v0[3] * c0[2];
                        r1[0] = v1[0] * c1[0] - v1[1] * c1[1]; r1[1] = v1[0] * c1[1] + v1[1] * c1[0];
                        r1[2] = v1[2] * c1[2] - v1[3] * c1[3]; r1[3] = v1[2] * c1[3] + v1[3] * c1[2];
                        v0 = r0; v1 = r1;
                    }
                    u32x4 w; w.x = pk2(v0[0], v0[1]); w.y = pk2(v0[2], v0[3]); w.z = pk2(v1[0], v1[1]); w.w = pk2(v1[2], v1[3]);
                    *(u32x4*)(O + (size_t)row * 768 + col) = w;
                    asm volatile("" ::: "memory");
                }
        }
    }
};

struct EpiKV {
    static constexpr bool PERM = true, AFTER_DRAIN = false;
    bf16* KN; bf16* VT; int nrows;
    __device__ __forceinline__ void operator()(AccRef acc, const Unit& u, int wr, int wc, int fr, int fq) const {
        const int row0 = u.pm * 256 + wr * 64 + fr, col0 = u.pn * 256 + wc * 32 + 8 * fq;
#pragma unroll
        for (int bj = 0; bj < 2; ++bj) {
            const int col = col0 + bj * 128, head = col >> 7, e0 = col & 127;
#pragma unroll
            for (int ai = 0; ai < 2; ++ai)
#pragma unroll
                for (int m = 0; m < 4; ++m) {
                    const int row = row0 + ai * 128 + m * 16;
                    const f32x4 v0 = acc[ai][bj][m][0], v1 = acc[ai][bj][m][1];
                    u32x4 w; w.x = pk2(v0[0], v0[1]); w.y = pk2(v0[2], v0[3]); w.z = pk2(v1[0], v1[1]); w.w = pk2(v1[2], v1[3]);
                    if (e0 < 64) *(u32x4*)(KN + (size_t)row * 512 + head * 64 + e0) = w;
                    else { bf16* vp = VT + (size_t)(head * 64 + e0 - 64) * nrows + row;
#pragma unroll
                        for (int i = 0; i < 4; ++i) { vp[(size_t)(2 * i) * nrows] = (bf16)(w[i] & 0xffffu); vp[(size_t)(2 * i + 1) * nrows] = (bf16)(w[i] >> 16); } }
                }
        }
    }
};

__device__ __forceinline__ void adaln_layer(const P& p, LAS unsigned char* lds, int l, int bfirst) {
    LAS float* scv = (LAS float*)lds;
    LAS float* red = scv + 9 * 1024;
    const int tid = tid_opaque(), tx = tid % 18, ty = tid / 18;
    const float* cc = p.in[6]; const float* cctx = p.in[7];
    float* mod = (float*)(p.ws + WS_MOD);
    if ((int)blockIdx.x < bfirst) return;
    __syncthreads();
    for (int i = tid; i < 9 * 1024; i += NTHREADS) { const int c = i >> 10, k = i & 1023; const float v = c == 0 ? cctx[k] : cc[(c - 1) * 1024 + k]; scv[i] = v / (1.0f + expf(-v)); }
    __syncthreads();
    for (int cgp = blockIdx.x - bfirst; cgp < 128; cgp += gridDim.x - bfirst) {
        const int col0 = cgp * 72 + tx * 4;
        const float* W = p.in[8] + (size_t)l * 1024 * 9216;
        f32x4 acc[9];
#pragma unroll
        for (int c = 0; c < 9; ++c) acc[c] = (f32x4){0.f, 0.f, 0.f, 0.f};
        if (ty < 28) {
#pragma unroll 8
            for (int k = ty; k < 1024; k += 28) {
                const f32x4 w = *(const f32x4*)(W + (size_t)k * 9216 + col0);
#pragma unroll
                for (int c = 0; c < 9; ++c) acc[c] += w * scv[c * 1024 + k];
            }
#pragma unroll
            for (int c = 0; c < 9; ++c) *(LAS f32x4*)(red + ty * 648 + c * 72 + tx * 4) = acc[c];
        }
        __syncthreads();
        for (int o = tid; o < 648; o += NTHREADS) {
            float s = 0.f;
            for (int y = 0; y < 28; ++y) s += red[y * 648 + o];
            const int c = o / 72, j = o % 72;
            mod[(size_t)(l * 9 + c) * 9216 + cgp * 72 + j] = s + p.in[9][l * 9216 + cgp * 72 + j];
        }
        __syncthreads();
    }
}
__device__ __forceinline__ void ph_rope_table(const P& p) {
    const int tid = tid_opaque();
    float* rope = (float*)(p.ws + WS_ROPE);
    for (int idx = blockIdx.x * NTHREADS + tid; idx < 1024 * 16; idx += gridDim.x * NTHREADS) {
        const int t = idx >> 4, i = idx & 15;
        const float pos = (float)(i < 8 ? (t >> 6) : (t & 63));
        const float inv = powf(10000.0f, -(float)(i & 7) / 8.0f);
        const float ang = pos * inv;
        rope[idx * 2] = cosf(ang); rope[idx * 2 + 1] = sinf(ang);
    }
}

__device__ __forceinline__ void norm_rows(const P& p, int layer, int j, const float* gvec, bool from_input) {
    const int tid = tid_opaque(), lane = tid & 63, wave = tid >> 6;
    const float* mod = (const float*)(p.ws + WS_MOD);
    const float* x = p.out;
    bf16* h = (bf16*)(p.ws + WS_H);
    const int nw = gridDim.x * 8;
    for (int row0 = blockIdx.x * 8 + wave; row0 < M_TOK; row0 += 4 * nw) {
        f32x4 v[4][4]; float ss[4];
#pragma unroll
        for (int r = 0; r < 4; ++r) {
            const int row = (row0 + r * nw) < M_TOK ? (row0 + r * nw) : (M_TOK - 1);
            const float* xr = from_input ? (row < MP ? p.in[0] + (size_t)row * DM : p.in[1] + (size_t)(row - MP) * DM) : x + (size_t)row * DM;
#pragma unroll
            for (int q = 0; q < 4; ++q) v[r][q] = *(const f32x4*)(xr + lane * 4 + 256 * q);
        }
#pragma unroll
        for (int r = 0; r < 4; ++r) { float s = 0.f;
#pragma unroll
            for (int q = 0; q < 4; ++q) s += v[r][q].x * v[r][q].x + v[r][q].y * v[r][q].y + v[r][q].z * v[r][q].z + v[r][q].w * v[r][q].w;
            ss[r] = s; }
#pragma unroll
        for (int o = 1; o < 64; o <<= 1) {
#pragma unroll
            for (int r = 0; r < 4; ++r) ss[r] += __shfl_xor(ss[r], o); }
#pragma unroll
        for (int r = 0; r < 4; ++r) {
            const int row = row0 + r * nw; if (row >= M_TOK) break;
            const float rstd = 1.0f / sqrtf(ss[r] * (1.0f / 1024.0f) + 1e-6f);
            const float* mrow = mod + (size_t)(layer * 9 + cond_of_row(row)) * 9216;
            const float* sh = mrow + (3 * j) * 1024; const float* sc = mrow + (3 * j + 1) * 1024;
#pragma unroll
            for (int q = 0; q < 4; ++q) {
                const int col = lane * 4 + 256 * q;
                const f32x4 g = *(const f32x4*)(gvec + col), s1 = *(const f32x4*)(sc + col), s0 = *(const f32x4*)(sh + col);
                const f32x4 y = (v[r][q] * rstd * g) * (s1 + 1.0f) + s0;
                *(u32x2*)(h + (size_t)row * DM + col) = pk4(y);
            }
        }
    }
}
__device__ __forceinline__ void first_rows(const P& p, const float* gvec, float* ss) {
    const int tid = tid_opaque(), lane = tid & 63, wave = tid >> 6;
    const float* mod = (const float*)(p.ws + WS_MOD);
    bf16* h = (bf16*)(p.ws + WS_H);
    const int nw = gridDim.x * 8;
    for (int row0 = blockIdx.x * 8 + wave; row0 < M_TOK; row0 += 4 * nw) {
        f32x4 v[4][4]; float sq[4];
#pragma unroll
        for (int r = 0; r < 4; ++r) {
            const int row = (row0 + r * nw) < M_TOK ? (row0 + r * nw) : (M_TOK - 1);
            const float* xr = row < MP ? p.in[0] + (size_t)row * DM : p.in[1] + (size_t)(row - MP) * DM;
#pragma unroll
            for (int q = 0; q < 4; ++q) v[r][q] = *(const f32x4*)(xr + lane * 4 + 256 * q);
        }
#pragma unroll
        for (int r = 0; r < 4; ++r) { float t = 0.f;
#pragma unroll
            for (int q = 0; q < 4; ++q) t += v[r][q].x * v[r][q].x + v[r][q].y * v[r][q].y + v[r][q].z * v[r][q].z + v[r][q].w * v[r][q].w;
            sq[r] = t; }
#pragma unroll
        for (int o = 1; o < 64; o <<= 1) {
#pragma unroll
            for (int r = 0; r < 4; ++r) sq[r] += __shfl_xor(sq[r], o); }
#pragma unroll
        for (int r = 0; r < 4; ++r) {
            const int row = row0 + r * nw; if (row >= M_TOK) break;
            if (lane == 0) ss[row] = rsqrtf_(sq[r] * (1.0f / 1024.0f) + 1e-6f);
            const float* sc = mod + (size_t)cond_of_row(row) * 9216 + 1024;
#pragma unroll
            for (int q = 0; q < 4; ++q) { const int col = lane * 4 + 256 * q;
                *(u32x2*)(h + (size_t)row * DM + col) = pk4(v[r][q] * (*(const f32x4*)(gvec + col) * (*(const f32x4*)(sc + col) + 1.0f))); }
        }
    }
}
__device__ __forceinline__ void final_norm_rows(const P& p) {
    const int tid = tid_opaque(), lane = tid & 63, wave = tid >> 6;
    float* x = p.out; const float* gvec = p.in[47];
    const int nw = gridDim.x * 8;
    for (int row0 = blockIdx.x * 8 + wave; row0 < M_TOK; row0 += 4 * nw) {
        f32x4 v[4][4]; float ss[4];
#pragma unroll
        for (int r = 0; r < 4; ++r) { const int row = (row0 + r * nw) < M_TOK ? (row0 + r * nw) : (M_TOK - 1);
#pragma unroll
            for (int q = 0; q < 4; ++q) v[r][q] = *(const f32x4*)(x + (size_t)row * DM + lane * 4 + 256 * q); }
#pragma unroll
        for (int r = 0; r < 4; ++r) { float s = 0.f;
#pragma unroll
            for (int q = 0; q < 4; ++q) s += v[r][q].x * v[r][q].x + v[r][q].y * v[r][q].y + v[r][q].z * v[r][q].z + v[r][q].w * v[r][q].w;
            ss[r] = s; }
#pragma unroll
        for (int o = 1; o < 64; o <<= 1) {
#pragma unroll
            for (int r = 0; r < 4; ++r) ss[r] += __shfl_xor(ss[r], o); }
#pragma unroll
        for (int r = 0; r < 4; ++r) { const int row = row0 + r * nw; if (row >= M_TOK) break;
            const float rstd = rsqrtf_(ss[r] * (1.0f / 1024.0f) + 1e-6f);
#pragma unroll
            for (int q = 0; q < 4; ++q) { const int col = lane * 4 + 256 * q; *(f32x4*)(x + (size_t)row * DM + col) = v[r][q] * rstd * *(const f32x4*)(gvec + col); } }
    }
}

template <int MODE>
__device__ __forceinline__ void transpose_w(const float* W, int ldw, int ncols_valid, int K, bf16* WT, int Nt, LAS unsigned char* lds, const float* shift = nullptr, float* cvo = nullptr, int ncv = 0, int rot = 0) {
    const int tid = tid_opaque(), lane = tid & 63, wave = tid >> 6;
    LAS float* scr = (LAS float*)(lds + wave * 16640);
    LAS float* shs = (LAS float*)(lds + 8 * 16640 + wave * 3072);
    const int nblk = Nt / 64, nitems = nblk * (K / 64);
    int vb = ((int)blockIdx.x + (int)gridDim.x - rot % (int)gridDim.x) % (int)gridDim.x;
    for (int it = vb * 8 + wave; it < nitems; it += gridDim.x * 8) {
        const int kb = it / nblk, nb = it % nblk, k0 = kb * 64;
        const int g0 = 2 * nb;
        const int sc0 = MODE == 1 ? (((g0 >> 2) & 1) * DFF + (g0 >> 3) * 128 + (g0 & 3) * 32) : nb * 64;
        const int c4 = (lane & 15) * 4, kr = lane >> 4; const bool ok = (sc0 + c4) < ncols_valid;
        f32x4 t[16];
#pragma unroll
        for (int i = 0; i < 16; ++i) t[i] = ok ? *(const f32x4*)(W + (size_t)(k0 + 4 * i + kr) * ldw + sc0 + c4) : (f32x4){0.f, 0.f, 0.f, 0.f};
#pragma unroll
        for (int i = 0; i < 16; ++i) { LAS float* d = scr + (4 * i + kr) * 65 + c4; d[0] = t[i].x; d[1] = t[i].y; d[2] = t[i].z; d[3] = t[i].w; }
        if (shift) {
#pragma unroll
            for (int cc = 0; cc < 9; ++cc) shs[lane * 12 + cc] = shift[(size_t)cc * 9216 + k0 + lane];
        }
        LDS_WAIT();
        if (shift) {
            float a9[9];
#pragma unroll
            for (int cc = 0; cc < 9; ++cc) a9[cc] = 0.f;
#pragma unroll 4
            for (int k = 0; k < 64; ++k) {
                const float w = scr[k * 65 + lane];
                const f32x4 s0 = *(const LAS f32x4*)(shs + k * 12), s1 = *(const LAS f32x4*)(shs + k * 12 + 4); const float s8 = shs[k * 12 + 8];
                a9[0] += w * s0.x; a9[1] += w * s0.y; a9[2] += w * s0.z; a9[3] += w * s0.w; a9[4] += w * s1.x; a9[5] += w * s1.y; a9[6] += w * s1.z; a9[7] += w * s1.w; a9[8] += w * s8;
            }
#pragma unroll
            for (int cc = 0; cc < 9; ++cc) __hip_atomic_fetch_add(cvo + (size_t)cc * ncv + nb * 64 + lane, a9[cc], __ATOMIC_RELAXED, __HIP_MEMORY_SCOPE_AGENT);
        }
        const int c = lane & 7;
#pragma unroll
        for (int j = 0; j < 8; ++j) {
            const int nn = (lane >> 3) + 8 * j; const LAS float* sp = scr + (8 * c) * 65 + nn;
            u32x4 o; o.x = pk2(sp[0 * 65], sp[1 * 65]); o.y = pk2(sp[2 * 65], sp[3 * 65]); o.z = pk2(sp[4 * 65], sp[5 * 65]); o.w = pk2(sp[6 * 65], sp[7 * 65]);
            *(u32x4*)(WT + (size_t)(nb * 64 + nn) * K + k0 + 8 * c) = o;
        }
        LDS_WAIT();
    }
}
__device__ __forceinline__ void convert_ffn_weights(const P& p, int layer, int which, LAS unsigned char* lds, const float* shift, float* cvo) {
    const float* wgu = p.in[which == 0 ? 13 : 15] + (size_t)layer * 1024 * 5632;
    const float* wdn = p.in[which == 0 ? 14 : 16] + (size_t)layer * 2816 * 1024;
    transpose_w<1>(wgu, 5632, 5632, 1024, (bf16*)(p.ws + W_GU), 5632, lds, shift, cvo, 5632);
    transpose_w<0>(wdn, 1024, 1024, 2816, (bf16*)(p.ws + W_DOWN), 1024, lds, nullptr, nullptr, 0, 176);
}
__device__ __forceinline__ void build_lora_w(const P& p) {
    bf16* WT = (bf16*)(p.ws + W_LORA);
    const float* w_up = p.in[21]; const float* a_up = p.in[23]; const float* g_up = p.in[24];
    for (int idx = blockIdx.x * NTHREADS + tid_opaque(); idx < 2560 * 384; idx += gridDim.x * NTHREADS) {
        const int n = idx / 384, k = idx % 384, seg = n >> 9, c = n & 511;
        float v = 0.f;
        if (seg == 0) { if (k < 64) v = w_up[(0 * 64 + k) * 512 + c]; }
        else if (seg == 1) { if (k >= 64 && k < 128) v = w_up[(1 * 64 + k - 64) * 512 + c]; }
        else if (seg == 2) { if (k >= 128 && k < 192) v = a_up[(0 * 64 + k - 128) * 512 + c]; }
        else if (seg == 3) { if (k >= 192 && k < 256) v = a_up[(1 * 64 + k - 192) * 512 + c]; }
        else { if (k >= 256) v = g_up[(k - 256) * 512 + c]; }
        WT[(size_t)n * 384 + k] = (bf16)(pk2(v, 0.f) & 0xffffu);
    }
}

__device__ __forceinline__ void ph_lora_in(const P& p) {
    const int tid = tid_opaque(), lane = tid & 63, wave = tid >> 6;
    const bf16* p0 = (const bf16*)(p.ws + WS_R1); bf16* LA = (bf16*)(p.ws + WS_H);
    const float* mu = p.in[19];
    const int nw = gridDim.x * 8;
    float m0[3], m1[3];
#pragma unroll
    for (int ch = 0; ch < 3; ++ch) { m0[ch] = mu[1536 + ch * 128 + lane * 2]; m1[ch] = mu[1536 + ch * 128 + lane * 2 + 1]; }
    for (int row0 = blockIdx.x * 8 + wave; row0 < M_TOK; row0 += 4 * nw) {
        unsigned cur[4][3], prv[4][3], nxt[4][3];
#pragma unroll
        for (int r = 0; r < 4; ++r) {
            const int row = (row0 + r * nw) < M_TOK ? (row0 + r * nw) : (M_TOK - 1);
            const int t = row < MP ? (row & 255) : ((row - MP) & 1023), L = row < MP ? 256 : 1024;
            const bool hp = t > 0, hn = t < L - 1;
#pragma unroll
            for (int ch = 0; ch < 3; ++ch) {
                const bf16* pc = p0 + (size_t)row * LDP0 + 1536 + ch * 128 + lane * 2;
                cur[r][ch] = *(const unsigned*)pc; prv[r][ch] = hp ? *(const unsigned*)(pc - LDP0) : 0u; nxt[r][ch] = hn ? *(const unsigned*)(pc + LDP0) : 0u;
            }
        }
#pragma unroll
        for (int r = 0; r < 4; ++r) {
            const int row = row0 + r * nw; if (row >= M_TOK) break;
#pragma unroll
            for (int ch = 0; ch < 3; ++ch) {
                float a0 = bflo(cur[r][ch]) + m0[ch] * (0.5f * (bflo(prv[r][ch]) + bflo(nxt[r][ch])) - bflo(cur[r][ch]));
                float a1 = bfhi(cur[r][ch]) + m1[ch] * (0.5f * (bfhi(prv[r][ch]) + bfhi(nxt[r][ch])) - bfhi(cur[r][ch]));
                if (ch == 0) { a0 = tanhf(a0); a1 = tanhf(a1); }
                if (ch == 2) { a0 = sigmoidf_(a0); a1 = sigmoidf_(a1); }
                *(unsigned*)(LA + (size_t)row * 384 + ch * 128 + lane * 2) = pk2(a0, a1);
            }
        }
    }
}

__device__ __forceinline__ void rwkv_item(const P& p, LAS unsigned char* lds, int kind, int b, int head, int dir) {
    constexpr int T = 32, NG = 8, GS = 1408;
    LAS float* grp = (LAS float*)lds;
    LAS float* raw = grp + 2 * NG * GS;
    LAS float* ybR = raw + T * 320;
    const int tid = tid_opaque(), lane = tid & 63, wave = tid >> 6, q = lane & 7, vl = lane >> 3, r0 = wave * 8 + vl;
    const int tt = tid >> 4, cgi = tid & 15;
    const int L = kind ? 1024 : 256, nblk = L / T;
    const int rowbase = kind ? MP + b * 1024 : b * 256;
    const bf16* p0 = (const bf16*)(p.ws + WS_R1);
    const bf16* lo = (const bf16*)(p.ws + WS_R2);
    bf16* Y = (bf16*)(p.ws + (dir == 0 ? WS_MIX : WS_H));
    const int colbase = head * 64;
    f32x2 S[4];
#pragma unroll
    for (int i = 0; i < 4; ++i) S[i] = (f32x2){0.f, 0.f};
    if (kind) { const float* s0 = p.in[2] + (((size_t)b * 2 + dir) * 8 + head) * 4096 + q * 8;
        const f32x4 a0 = *(const f32x4*)(s0 + r0 * 64), a1 = *(const f32x4*)(s0 + r0 * 64 + 4);
        S[0] = (f32x2){a0.x, a0.y}; S[1] = (f32x2){a0.z, a0.w}; S[2] = (f32x2){a1.x, a1.y}; S[3] = (f32x2){a1.z, a1.w}; }
    const int C = head * 64 + cgi * 4;
    const f32x4 cA = *(const f32x4*)(p.in[19] + C), cB = *(const f32x4*)(p.in[19] + 512 + C), cC = *(const f32x4*)(p.in[19] + 1024 + C);
    const f32x4 cD = *(const f32x4*)(p.in[25] + C), cE = *(const f32x4*)(p.in[26] + C);
    u32x2 ra0, ra1, ra2, rb0, rb1, rb2, rc0, rc1, rc2, rd, re;
    const u32x2 z2 = {0u, 0u};
#define RW_LOAD(blk) do { \
        const int n_ = (blk) * T + tt, t_ = dir ? L - 1 - n_ : n_; const size_t row_ = (size_t)(rowbase + t_); \
        const bool hp_ = t_ > 0, hn_ = t_ < L - 1; \
        const bf16* pr_ = p0 + row_ * LDP0 + head * 64 + cgi * 4; \
        ra1 = *(const u32x2*)pr_; ra0 = hp_ ? *(const u32x2*)(pr_ - LDP0) : z2; ra2 = hn_ ? *(const u32x2*)(pr_ + LDP0) : z2; \
        rb1 = *(const u32x2*)(pr_ + 512); rb0 = hp_ ? *(const u32x2*)(pr_ + 512 - LDP0) : z2; rb2 = hn_ ? *(const u32x2*)(pr_ + 512 + LDP0) : z2; \
        rc1 = *(const u32x2*)(pr_ + 1024); rc0 = hp_ ? *(const u32x2*)(pr_ + 1024 - LDP0) : z2; rc2 = hn_ ? *(const u32x2*)(pr_ + 1024 + LDP0) : z2; \
        rd = *(const u32x2*)(lo + row_ * 2560 + dir * 512 + head * 64 + cgi * 4); re = *(const u32x2*)(lo + row_ * 2560 + 1024 + dir * 512 + head * 64 + cgi * 4); \
    } while (0)
#define RW_PREP1(bi) do { \
        LAS float* rw_ = raw + tt * 320; const int c4_ = cgi * 4; \
        const f32x4 r1_ = unpk4(ra1), k1_ = unpk4(rb1), v1_ = unpk4(rc1); \
        const f32x4 r_ = r1_ + cA * ((unpk4(ra0) + unpk4(ra2)) * 0.5f - r1_); \
        const f32x4 k_ = k1_ + cB * ((unpk4(rb0) + unpk4(rb2)) * 0.5f - k1_); \
        const f32x4 v_ = v1_ + cC * ((unpk4(rc0) + unpk4(rc2)) * 0.5f - v1_); \
        f32x4 kk_ = k_ * cD; \
        const float ss_ = red16(kk_.x * kk_.x + kk_.y * kk_.y + kk_.z * kk_.z + kk_.w * kk_.w); \
        kk_ = kk_ * rsqrtf_(ss_ + 1e-6f); \
        const f32x4 ew_ = unpk4(rd), a_ = unpk4(re); \
        f32x4 w_; w_.x = __expf(-ew_.x); w_.y = __expf(-ew_.y); w_.z = __expf(-ew_.z); w_.w = __expf(-ew_.w); \
        *(LAS f32x4*)(rw_ + c4_) = kk_; *(LAS f32x4*)(rw_ + 64 + c4_) = w_; *(LAS f32x4*)(rw_ + 128 + c4_) = kk_ * a_; \
        *(LAS f32x4*)(rw_ + 192 + c4_) = k_ * ((a_ - 1.0f) * cE + 1.0f); *(LAS f32x4*)(rw_ + 256 + c4_) = r_; \
        *(LAS f32x4*)(grp + ((bi) * NG + (tt >> 2)) * GS + 1088 + (tt & 3) * 64 + c4_) = v_; \
    } while (0)
#define DOT16(aa_, bb_) red16((aa_)[0] * (bb_)[0] + (aa_)[1] * (bb_)[1] + (aa_)[2] * (bb_)[2] + (aa_)[3] * (bb_)[3])
#define RW_PREP2(bi) do { if (tid < 128) { \
        const int gq_ = tid >> 4, c4_ = cgi * 4; const LAS float* r4_ = raw + gq_ * 4 * 320 + c4_; LAS float* gi_ = grp + ((bi) * NG + gq_) * GS; \
        const f32x4 kk1 = *(const LAS f32x4*)(r4_), w1 = *(const LAS f32x4*)(r4_ + 64), b1 = *(const LAS f32x4*)(r4_ + 128), d1 = *(const LAS f32x4*)(r4_ + 192), q1 = *(const LAS f32x4*)(r4_ + 256); \
        const f32x4 kk2 = *(const LAS f32x4*)(r4_ + 320), w2 = *(const LAS f32x4*)(r4_ + 384), b2 = *(const LAS f32x4*)(r4_ + 448), d2 = *(const LAS f32x4*)(r4_ + 512), q2 = *(const LAS f32x4*)(r4_ + 576); \
        const f32x4 kk3 = *(const LAS f32x4*)(r4_ + 640), w3 = *(const LAS f32x4*)(r4_ + 704), b3 = *(const LAS f32x4*)(r4_ + 768), d3 = *(const LAS f32x4*)(r4_ + 832), q3 = *(const LAS f32x4*)(r4_ + 896); \
        const f32x4 kk4 = *(const LAS f32x4*)(r4_ + 960), w4 = *(const LAS f32x4*)(r4_ + 1024), b4 = *(const LAS f32x4*)(r4_ + 1088), d4 = *(const LAS f32x4*)(r4_ + 1152), q4 = *(const LAS f32x4*)(r4_ + 1216); \
        const f32x4 W02 = w1 * w2, W03 = W02 * w3, W04 = W03 * w4, W13 = w2 * w3, W14 = W13 * w4, W24 = w3 * w4; \
        *(LAS f32x4*)(gi_ + c4_) = kk1; *(LAS f32x4*)(gi_ + 64 + c4_) = w1 * kk2; *(LAS f32x4*)(gi_ + 128 + c4_) = W02 * kk3; *(LAS f32x4*)(gi_ + 192 + c4_) = W03 * kk4; \
        *(LAS f32x4*)(gi_ + 256 + c4_) = w1 * q1; *(LAS f32x4*)(gi_ + 320 + c4_) = W02 * q2; *(LAS f32x4*)(gi_ + 384 + c4_) = W03 * q3; *(LAS f32x4*)(gi_ + 448 + c4_) = W04 * q4; \
        *(LAS f32x4*)(gi_ + 512 + c4_) = d1 * W14; *(LAS f32x4*)(gi_ + 576 + c4_) = d2 * W24; *(LAS f32x4*)(gi_ + 640 + c4_) = d3 * w4; *(LAS f32x4*)(gi_ + 704 + c4_) = d4; \
        *(LAS f32x4*)(gi_ + 768 + c4_) = b1 * W14; *(LAS f32x4*)(gi_ + 832 + c4_) = b2 * W24; *(LAS f32x4*)(gi_ + 896 + c4_) = b3 * w4; *(LAS f32x4*)(gi_ + 960 + c4_) = b4; \
        *(LAS f32x4*)(gi_ + 1024 + c4_) = W04; \
        const f32x4 d1w2 = d1 * w2, d1w13 = d1 * W13, d1w14 = d1 * W14, d2w3 = d2 * w3, d2w24 = d2 * W24, d3w4 = d3 * w4; \
        const f32x4 b1w2 = b1 * w2, b1w13 = b1 * W13, b1w14 = b1 * W14, b2w3 = b2 * w3, b2w24 = b2 * W24, b3w4 = b3 * w4; \
        float sc_[32]; \
        sc_[0] = DOT16(d1, kk2); sc_[1] = DOT16(d1w2, kk3); sc_[2] = DOT16(d2, kk3); sc_[3] = DOT16(d1w13, kk4); sc_[4] = DOT16(d2w3, kk4); sc_[5] = DOT16(d3, kk4); \
        sc_[6] = DOT16(b1, kk2); sc_[7] = DOT16(b1w2, kk3); sc_[8] = DOT16(b2, kk3); sc_[9] = DOT16(b1w13, kk4); sc_[10] = DOT16(b2w3, kk4); sc_[11] = DOT16(b3, kk4); \
        sc_[12] = DOT16(d1, q1); sc_[13] = DOT16(d1w2, q2); sc_[14] = DOT16(d2, q2); sc_[15] = DOT16(d1w13, q3); sc_[16] = DOT16(d2w3, q3); sc_[17] = DOT16(d3, q3); \
        sc_[18] = DOT16(d1w14, q4); sc_[19] = DOT16(d2w24, q4); sc_[20] = DOT16(d3w4, q4); sc_[21] = DOT16(d4, q4); \
        sc_[22] = DOT16(b1, q1); sc_[23] = DOT16(b1w2, q2); sc_[24] = DOT16(b2, q2); sc_[25] = DOT16(b1w13, q3); sc_[26] = DOT16(b2w3, q3); sc_[27] = DOT16(b3, q3); \
        sc_[28] = DOT16(b1w14, q4); sc_[29] = DOT16(b2w24, q4); sc_[30] = DOT16(b3w4, q4); sc_[31] = DOT16(b4, q4); \
        if (cgi < 8) { _Pragma("unroll") for (int i_ = 0; i_ < 8; ++i_) if (cgi == i_) *(LAS f32x4*)(gi_ + 1344 + 4 * i_) = (f32x4){sc_[4 * i_], sc_[4 * i_ + 1], sc_[4 * i_ + 2], sc_[4 * i_ + 3]}; } \
    } } while (0)
    __syncthreads();
    RW_LOAD(0); RW_PREP1(0);
    __syncthreads();
    RW_PREP2(0);
    __syncthreads();
#pragma unroll 1
    for (int blk = 0; blk < nblk; ++blk) {
        const int bi = blk & 1;
        if (blk + 1 < nblk) RW_LOAD(blk + 1);
        LAS float* yb = ybR + bi * T * 64;
#pragma unroll 1
        for (int g = 0; g < NG; ++g) {
            const LAS float* gi = grp + (bi * NG + g) * GS;
            float dp[4], du[4];
#pragma unroll
            for (int t = 0; t < 4; ++t) {
                const f32x4 pa = *(const LAS f32x4*)(gi + t * 64 + q * 8), pb = *(const LAS f32x4*)(gi + t * 64 + q * 8 + 4);
                const f32x4 ua = *(const LAS f32x4*)(gi + 256 + t * 64 + q * 8), ub = *(const LAS f32x4*)(gi + 256 + t * 64 + q * 8 + 4);
                const f32x2 a = __builtin_elementwise_fma(S[0], (f32x2){pa.x, pa.y}, S[1] * (f32x2){pa.z, pa.w}) + __builtin_elementwise_fma(S[2], (f32x2){pb.x, pb.y}, S[3] * (f32x2){pb.z, pb.w});
                const f32x2 c = __builtin_elementwise_fma(S[0], (f32x2){ua.x, ua.y}, S[1] * (f32x2){ua.z, ua.w}) + __builtin_elementwise_fma(S[2], (f32x2){ub.x, ub.y}, S[3] * (f32x2){ub.z, ub.w});
                dp[t] = a.x + a.y; du[t] = c.x + c.y;
            }
#pragma unroll
            for (int t = 0; t < 4; ++t) { dp[t] = red8(dp[t]); du[t] = red8(du[t]); }
            const float v1 = gi[1088 + r0], v2 = gi[1152 + r0], v3 = gi[1216 + r0], v4 = gi[1280 + r0];
            const f32x4 A0 = *(const LAS f32x4*)(gi + 1344), A1 = *(const LAS f32x4*)(gi + 1348), B0 = *(const LAS f32x4*)(gi + 1352), E0 = *(const LAS f32x4*)(gi + 1356);
            const f32x4 E1 = *(const LAS f32x4*)(gi + 1360), E2 = *(const LAS f32x4*)(gi + 1364), F0 = *(const LAS f32x4*)(gi + 1368), F1 = *(const LAS f32x4*)(gi + 1372);
            const float g1 = dp[0];
            const float g2 = dp[1] + v1 * A0.x - g1 * A1.z;
            const float g3 = dp[2] + v1 * A0.y + v2 * A0.z - g1 * A1.w - g2 * B0.x;
            const float g4 = dp[3] + v1 * A0.w + v2 * A1.x + v3 * A1.y - g1 * B0.y - g2 * B0.z - g3 * B0.w;
            const float y1 = du[0] + v1 * E0.x - g1 * E2.z;
            const float y2 = du[1] + v1 * E0.y + v2 * E0.z - g1 * E2.w - g2 * F0.x;
            const float y3 = du[2] + v1 * E0.w + v2 * E1.x + v3 * E1.y - g1 * F0.y - g2 * F0.z - g3 * F0.w;
            const float y4 = du[3] + v1 * E1.z + v2 * E1.w + v3 * E2.x + v4 * E2.y - g1 * F1.x - g2 * F1.y - g3 * F1.z - g4 * F1.w;
            if (q == 0) { yb[(4 * g) * 64 + r0] = y1; yb[(4 * g + 1) * 64 + r0] = y2; yb[(4 * g + 2) * 64 + r0] = y3; yb[(4 * g + 3) * 64 + r0] = y4; }
            {
                const f32x4 wa = *(const LAS f32x4*)(gi + 1024 + q * 8), wb = *(const LAS f32x4*)(gi + 1024 + q * 8 + 4);
                f32x2 n0 = S[0] * (f32x2){wa.x, wa.y}, n1 = S[1] * (f32x2){wa.z, wa.w}, n2 = S[2] * (f32x2){wb.x, wb.y}, n3 = S[3] * (f32x2){wb.z, wb.w};
                const float vv[4] = {v1, v2, v3, v4}, gg[4] = {g1, g2, g3, g4};
#pragma unroll
                for (int j = 0; j < 4; ++j) {
                    const f32x4 da = *(const LAS f32x4*)(gi + 512 + j * 64 + q * 8), db = *(const LAS f32x4*)(gi + 512 + j * 64 + q * 8 + 4);
                    const f32x4 ba = *(const LAS f32x4*)(gi + 768 + j * 64 + q * 8), bb = *(const LAS f32x4*)(gi + 768 + j * 64 + q * 8 + 4);
                    const f32x2 vj = {vv[j], vv[j]}, ng = {-gg[j], -gg[j]};
                    n0 = __builtin_elementwise_fma(vj, (f32x2){da.x, da.y}, n0); n1 = __builtin_elementwise_fma(vj, (f32x2){da.z, da.w}, n1);
                    n2 = __builtin_elementwise_fma(vj, (f32x2){db.x, db.y}, n2); n3 = __builtin_elementwise_fma(vj, (f32x2){db.z, db.w}, n3);
                    n0 = __builtin_elementwise_fma(ng, (f32x2){ba.x, ba.y}, n0); n1 = __builtin_elementwise_fma(ng, (f32x2){ba.z, ba.w}, n1);
                    n2 = __builtin_elementwise_fma(ng, (f32x2){bb.x, bb.y}, n2); n3 = __builtin_elementwise_fma(ng, (f32x2){bb.z, bb.w}, n3);
                }
                S[0] = n0; S[1] = n1; S[2] = n2; S[3] = n3;
            }
        }
        if (blk + 1 < nblk) RW_PREP1(bi ^ 1);
        __syncthreads();
        if (blk + 1 < nblk) RW_PREP2(bi ^ 1);
        {
            const int r4 = cgi * 4, n = blk * T + tt, tk = dir ? L - 1 - n : n;
            const f32x4 yv = *(const LAS f32x4*)(yb + tt * 64 + r4);
            *(u32x2*)(Y + (size_t)(rowbase + tk) * 1024 + colbase + r4) = pk4(yv);
        }
        __syncthreads();
    }
#undef RW_LOAD
#undef RW_PREP1
#undef RW_PREP2
#undef DOT16
    if (!kind) { float* so = p.out + OUT_SRW + (((size_t)b * 2 + dir) * 8 + head) * 4096 + q * 8;
        *(f32x4*)(so + r0 * 64) = (f32x4){S[0].x, S[0].y, S[1].x, S[1].y}; *(f32x4*)(so + r0 * 64 + 4) = (f32x4){S[2].x, S[2].y, S[3].x, S[3].y}; }
}

__device__ __forceinline__ void gdn_item(const P& p, LAS unsigned char* lds, int kind, int b, int head, int dir, int half) {
    LAS bf16* Qs = (LAS bf16*)(lds);
    LAS bf16* Ks = (LAS bf16*)(lds + 17408);
    LAS bf16* KT = (LAS bf16*)(lds + 34816);
    LAS bf16* VT = (LAS bf16*)(lds + 53248);
    LAS bf16* ST = (LAS bf16*)(lds + 62464);
    LAS float* Lm = (LAS float*)(lds + 79872);
    LAS bf16* vnT = (LAS bf16*)(lds + 79872);
    LAS bf16* vnsT = (LAS bf16*)(lds + 79872 + 9216);
    LAS float* Tm = (LAS float*)(lds + 98304);
    LAS bf16* Tb = (LAS bf16*)(lds + 115712);
    LAS bf16* QKg = (LAS bf16*)(lds + 124928);
    LAS bf16* rT = (LAS bf16*)(lds + 134144);
    LAS float* gs = (LAS float*)(lds + 143360);
    LAS float* bs = gs + 64;
    LAS float* Gs = gs + 128;
    LAS float* eGs = gs + 192;
    LAS float* eGl = gs + 256;
    LAS float* misc = gs + 320;
    LAS float* CW = (LAS float*)(lds + 144896);
    LAS float* Ysc = (LAS float*)(lds + 148736);
    const int tid = tid_opaque(), lane = tid & 63, wave = tid >> 6, ln = lane & 15, h4 = lane >> 4;
    const int L = kind ? 1024 : 256, nch = L / 64, rowbase = kind ? MP + b * 1024 : b * 256;
    const bf16* p0 = (const bf16*)(p.ws + WS_R1);
    bf16* Y = (bf16*)(p.ws + (dir == 0 ? WS_MIX : WS_H));
    const int colbase = 512 + head * 128 + half * 64;
    const int pi = tid >> 3, c8 = tid & 7;
    const float gA = -expf(p.in[31][dir * 4 + head]), gB = p.in[32][dir * 4 + head];
    __syncthreads();
    for (int e = tid; e < 960; e += NTHREADS) {
        float v;
        if (e < 768) { const int part = e / 384, r = e % 384, tap = r >> 7, d = r & 127; v = p.in[30][tap * 1536 + part * 512 + head * 128 + d]; }
        else { const int r = e - 768, tap = r >> 6, c = r & 63; v = p.in[30][tap * 1536 + 1024 + head * 128 + half * 64 + c]; }
        CW[e] = v;
    }
    for (int e = tid; e < 64 * 72 / 2; e += NTHREADS) { ((LAS unsigned*)Tb)[e] = 0u; ((LAS unsigned*)QKg)[e] = 0u; }
    f32x4 accS[4];
#pragma unroll
    for (int vt = 0; vt < 4; ++vt) {
        accS[vt] = (f32x4){0.f, 0.f, 0.f, 0.f};
        if (kind) { const float* s0 = p.in[3] + (((size_t)b * 2 + dir) * 4 + head) * 16384 + half * 64 + vt * 16 + ln;
#pragma unroll
            for (int r = 0; r < 4; ++r) accS[vt][r] = s0[(size_t)(wave * 16 + h4 * 4 + r) * 128]; }
        *(LAS u32x2*)(ST + (vt * 16 + ln) * 136 + wave * 16 + h4 * 4) = pk4(accS[vt]);
    }
    u32x4 rq[3][2], rk[3][2], rv[3]; unsigned rab = 0u, rbb = 0u;
    const u32x4 z4 = {0u, 0u, 0u, 0u};
#define GD_LOAD(n) do { \
        const int i_ = (n) * 64 + pi, t_ = dir ? L - 1 - i_ : i_; const size_t row_ = (size_t)(rowbase + t_); \
        const bf16* pr_ = p0 + row_ * LDP0 + 1920 + head * 128 + c8 * 16; \
        const bf16* pv_ = p0 + row_ * LDP0 + 1920 + 1024 + head * 128 + half * 64 + c8 * 8; \
        _Pragma("unroll") for (int j_ = 0; j_ < 3; ++j_) { \
            const bool ok_ = (j_ == 1) || (j_ == 0 ? t_ > 0 : t_ < L - 1); const long o_ = (long)(j_ - 1) * LDP0; \
            rq[j_][0] = ok_ ? *(const u32x4*)(pr_ + o_) : z4; rq[j_][1] = ok_ ? *(const u32x4*)(pr_ + o_ + 8) : z4; \
            rk[j_][0] = ok_ ? *(const u32x4*)(pr_ + o_ + 512) : z4; rk[j_][1] = ok_ ? *(const u32x4*)(pr_ + o_ + 520) : z4; \
            rv[j_] = ok_ ? *(const u32x4*)(pv_ + o_) : z4; } \
        rab = p0[row_ * LDP0 + 3968 + dir * 8 + head]; rbb = p0[row_ * LDP0 + 3968 + dir * 8 + 4 + head]; \
    } while (0)
    GD_LOAD(0);
    __syncthreads();
#pragma unroll 1
    for (int n = 0; n < nch; ++n) {
        {
            const int pis = (((pi >> 3) ^ c8) << 3) | (pi & 7);
            {
                float xq[16]; float sq = 0.f;
#pragma unroll
                for (int e = 0; e < 16; ++e) { const int d = c8 * 16 + e; const int wi = e >> 1, hi = e & 1, vi = wi >> 2, ci = wi & 3;
                    const float q0 = hi ? bfhi(rq[0][vi][ci]) : bflo(rq[0][vi][ci]), q1 = hi ? bfhi(rq[1][vi][ci]) : bflo(rq[1][vi][ci]), q2 = hi ? bfhi(rq[2][vi][ci]) : bflo(rq[2][vi][ci]);
                    const float a = CW[d] * q0 + CW[128 + d] * q1 + CW[256 + d] * q2;
                    xq[e] = siluf_(a); sq += xq[e] * xq[e]; }
                sq = red8(sq);
                const float nq = 0.08838834764831845f * rsqrtf_(sq + 1e-6f);
                u32x4 w0, w1;
                w0.x = pk2(xq[0] * nq, xq[1] * nq); w0.y = pk2(xq[2] * nq, xq[3] * nq); w0.z = pk2(xq[4] * nq, xq[5] * nq); w0.w = pk2(xq[6] * nq, xq[7] * nq);
                w1.x = pk2(xq[8] * nq, xq[9] * nq); w1.y = pk2(xq[10] * nq, xq[11] * nq); w1.z = pk2(xq[12] * nq, xq[13] * nq); w1.w = pk2(xq[14] * nq, xq[15] * nq);
                *(LAS u32x4*)(Qs + pi * 136 + c8 * 16) = w0; *(LAS u32x4*)(Qs + pi * 136 + c8 * 16 + 8) = w1;
            }
            {
                float xk[16]; float sk = 0.f;
#pragma unroll
                for (int e = 0; e < 16; ++e) { const int d = c8 * 16 + e; const int wi = e >> 1, hi = e & 1, vi = wi >> 2, ci = wi & 3;
                    const float k0 = hi ? bfhi(rk[0][vi][ci]) : bflo(rk[0][vi][ci]), k1 = hi ? bfhi(rk[1][vi][ci]) : bflo(rk[1][vi][ci]), k2 = hi ? bfhi(rk[2][vi][ci]) : bflo(rk[2][vi][ci]);
                    const float c = CW[384 + d] * k0 + CW[512 + d] * k1 + CW[640 + d] * k2;
                    xk[e] = siluf_(c); sk += xk[e] * xk[e]; }
                sk = red8(sk);
                const float nk = rsqrtf_(sk + 1e-6f);
                u32x4 w0, w1;
                w0.x = pk2(xk[0] * nk, xk[1] * nk); w0.y = pk2(xk[2] * nk, xk[3] * nk); w0.z = pk2(xk[4] * nk, xk[5] * nk); w0.w = pk2(xk[6] * nk, xk[7] * nk);
                w1.x = pk2(xk[8] * nk, xk[9] * nk); w1.y = pk2(xk[10] * nk, xk[11] * nk); w1.z = pk2(xk[12] * nk, xk[13] * nk); w1.w = pk2(xk[14] * nk, xk[15] * nk);
                *(LAS u32x4*)(Ks + pi * 136 + c8 * 16) = w0; *(LAS u32x4*)(Ks + pi * 136 + c8 * 16 + 8) = w1;
#pragma unroll
                for (int e = 0; e < 4; ++e) {
                    KT[(c8 * 16 + 2 * e) * 72 + pis] = (bf16)(w0[e] & 0xffffu); KT[(c8 * 16 + 2 * e + 1) * 72 + pis] = (bf16)(w0[e] >> 16);
                    KT[(c8 * 16 + 8 + 2 * e) * 72 + pis] = (bf16)(w1[e] & 0xffffu); KT[(c8 * 16 + 8 + 2 * e + 1) * 72 + pis] = (bf16)(w1[e] >> 16); }
            }
#pragma unroll
            for (int e = 0; e < 8; ++e) { const int c = c8 * 8 + e; const int wi = e >> 1, hi = e & 1;
                const float v0 = hi ? bfhi(rv[0][wi]) : bflo(rv[0][wi]), v1 = hi ? bfhi(rv[1][wi]) : bflo(rv[1][wi]), v2 = hi ? bfhi(rv[2][wi]) : bflo(rv[2][wi]);
                const float a = CW[768 + c] * v0 + CW[832 + c] * v1 + CW[896 + c] * v2;
                VT[c * 72 + pis] = (bf16)(pk2(siluf_(a), 0.f) & 0xffffu); }
            if (c8 == 0) { const float xa = bf2f(rab) + gB; const float sp = xa > 20.f ? xa : log1pf(expf(xa)); gs[pi] = gA * sp; bs[pi] = 1.0f / (1.0f + expf(-bf2f(rbb))); }
        }
        __syncthreads();
        if (n + 1 < nch) GD_LOAD(n + 1);
        if (wave == 0) {
            float x = gs[lane];
            x += DPPF(x, 0x111); x += DPPF(x, 0x112); x += DPPF(x, 0x114); x += DPPF(x, 0x118);
            const int xi = __float_as_int(x);
            const float t0 = __int_as_float(__builtin_amdgcn_readlane(xi, 15)), t1 = __int_as_float(__builtin_amdgcn_readlane(xi, 31)), t2 = __int_as_float(__builtin_amdgcn_readlane(xi, 47));
            x += (lane >= 48) ? (t0 + t1 + t2) : ((lane >= 32) ? (t0 + t1) : ((lane >= 16) ? t0 : 0.f));
            const float Gl = __int_as_float(__builtin_amdgcn_readlane(__float_as_int(x), 63));
            Gs[lane] = x; eGs[lane] = __expf(x); eGl[lane] = __expf(Gl - x); if (lane == 0) misc[0] = __expf(Gl);
        }
        __syncthreads();
#pragma unroll 1
        for (int tix = wave; tix < 20; tix += 8) {
            const int x = tix < 10 ? tix : tix - 10;
            const int it = x >= 6 ? 3 : (x >= 3 ? 2 : (x >= 1 ? 1 : 0)), jt = x - (it * (it + 1)) / 2;
            f32x4 a = {0.f, 0.f, 0.f, 0.f};
            if (tix < 10) {
#pragma unroll
                for (int s = 0; s < 4; ++s) a = __builtin_amdgcn_mfma_f32_16x16x32_bf16(*(const LAS s16x8*)(Ks + (16 * it + ln) * 136 + 32 * s + 8 * h4), *(const LAS s16x8*)(Ks + (16 * jt + ln) * 136 + 32 * s + 8 * h4), a, 0, 0, 0);
                const int j = 16 * jt + ln; const float Gj = Gs[j];
#pragma unroll
                for (int r = 0; r < 4; ++r) { const int i = 16 * it + 4 * h4 + r; Lm[i * 72 + j] = i > j ? bs[i] * a[r] * __expf(Gs[i] - Gj) : 0.f; }
            } else {
#pragma unroll
                for (int s = 0; s < 4; ++s) a = __builtin_amdgcn_mfma_f32_16x16x32_bf16(*(const LAS s16x8*)(Ks + (16 * jt + ln) * 136 + 32 * s + 8 * h4), *(const LAS s16x8*)(Qs + (16 * it + ln) * 136 + 32 * s + 8 * h4), a, 0, 0, 0);
                const int i = 16 * it + ln; const float Gi = Gs[i]; f32x4 o;
#pragma unroll
                for (int r = 0; r < 4; ++r) { const int j = 16 * jt + 4 * h4 + r; o[r] = i >= j ? a[r] * __expf(Gi - Gs[j]) : 0.f; }
                *(LAS u32x2*)(QKg + i * 72 + 16 * jt + 4 * h4) = pk4(o);
            }
        }
        __syncthreads();
        if (wave == 0) {
            const int a = h4, c = ln; float xr[16];
#pragma unroll
            for (int r = 0; r < 16; ++r) { float s = (r == c) ? 1.0f : 0.0f;
#pragma unroll
                for (int m = 0; m < r; ++m) s -= Lm[(16 * a + r) * 72 + 16 * a + m] * xr[m];
                xr[r] = s; }
#pragma unroll
            for (int r = 0; r < 16; ++r) { Tm[(16 * a + r) * 68 + 16 * a + c] = xr[r]; Tb[(16 * a + r) * 72 + 16 * a + c] = (bf16)(pk2(xr[r], 0.f) & 0xffffu); }
        } else {
#pragma unroll 1
            for (int tk = wave - 1; tk < 16; tk += 7) {
                const int it = tk >> 2, vt = tk & 3; f32x4 a = {0.f, 0.f, 0.f, 0.f};
#pragma unroll
                for (int s = 0; s < 4; ++s) a = __builtin_amdgcn_mfma_f32_16x16x32_bf16(*(const LAS s16x8*)(Ks + (16 * it + ln) * 136 + 32 * s + 8 * h4), *(const LAS s16x8*)(ST + (16 * vt + ln) * 136 + 32 * s + 8 * h4), a, 0, 0, 0);
                const int v = 16 * vt + ln, i0 = 16 * it + 4 * h4;
                const f32x4 vj = unpk4(*(const LAS u32x2*)(VT + v * 72 + ((((i0 >> 3) ^ (v >> 3)) & 7) << 3) + (i0 & 7))), be = *(const LAS f32x4*)(bs + i0), eg = *(const LAS f32x4*)(eGs + i0);
                *(LAS u32x2*)(rT + v * 72 + i0) = pk4(be * (vj - eg * a));
            }
        }
        __syncthreads();
#pragma unroll 1
        for (int dist = 1; dist < 4; ++dist) {
            if (wave < 4 - dist) {
                const int bb = wave, aa = wave + dist; LAS float* ys = Ysc + wave * 272;
                f32x4 y = {0.f, 0.f, 0.f, 0.f};
                float la[3][4], tb[3][4];
#pragma unroll
                for (int mm = 0; mm < 3; ++mm)
#pragma unroll
                    for (int s = 0; s < 4; ++s) { const int m = bb + (mm < dist ? mm : 0);
                        la[mm][s] = Lm[(16 * aa + ln) * 72 + 16 * m + 4 * s + h4]; tb[mm][s] = Tm[(16 * m + 4 * s + h4) * 68 + 16 * bb + ln]; }
#pragma unroll
                for (int mm = 0; mm < 3; ++mm)
                    if (mm < dist) {
#pragma unroll
                        for (int s = 0; s < 4; ++s) y = __builtin_amdgcn_mfma_f32_16x16x4f32(la[mm][s], tb[mm][s], y, 0, 0, 0); }
#pragma unroll
                for (int r = 0; r < 4; ++r) ys[(4 * h4 + r) * 17 + ln] = y[r];
                f32x4 z = {0.f, 0.f, 0.f, 0.f};
#pragma unroll
                for (int s = 0; s < 4; ++s) z = __builtin_amdgcn_mfma_f32_16x16x4f32(Tm[(16 * aa + ln) * 68 + 16 * aa + 4 * s + h4], ys[(4 * s + h4) * 17 + ln], z, 0, 0, 0);
#pragma unroll
                for (int r = 0; r < 4; ++r) { const int i = 16 * aa + 4 * h4 + r, j = 16 * bb + ln; Tm[i * 68 + j] = -z[r]; Tb[i * 72 + j] = (bf16)(pk2(-z[r], 0.f) & 0xffffu); }
            }
            __syncthreads();
        }
#pragma unroll
        for (int u = 0; u < 2; ++u) {
            const int tile = 2 * wave + u, it = tile >> 2, vt = tile & 3; f32x4 a = {0.f, 0.f, 0.f, 0.f};
            a = __builtin_amdgcn_mfma_f32_16x16x32_bf16(*(const LAS s16x8*)(Tb + (16 * it + ln) * 72 + 8 * h4), *(const LAS s16x8*)(rT + (16 * vt + ln) * 72 + 8 * h4), a, 0, 0, 0);
            if (it >= 2) a = __builtin_amdgcn_mfma_f32_16x16x32_bf16(*(const LAS s16x8*)(Tb + (16 * it + ln) * 72 + 32 + 8 * h4), *(const LAS s16x8*)(rT + (16 * vt + ln) * 72 + 32 + 8 * h4), a, 0, 0, 0);
            const int v = 16 * vt + ln, i0 = 16 * it + 4 * h4;
            *(LAS u32x2*)(vnT + v * 72 + i0) = pk4(a); *(LAS u32x2*)(vnsT + v * 72 + i0) = pk4(a * *(const LAS f32x4*)(eGl + i0));
        }
        __syncthreads();
#pragma unroll
        for (int u = 0; u < 2; ++u) {
            const int tile = 2 * wave + u, vt = tile >> 2, it = tile & 3; f32x4 a = {0.f, 0.f, 0.f, 0.f};
#pragma unroll
            for (int s = 0; s < 4; ++s) a = __builtin_amdgcn_mfma_f32_16x16x32_bf16(*(const LAS s16x8*)(ST + (16 * vt + ln) * 136 + 32 * s + 8 * h4), *(const LAS s16x8*)(Qs + (16 * it + ln) * 136 + 32 * s + 8 * h4), a, 0, 0, 0);
            a = a * eGs[16 * it + ln];
            a = __builtin_amdgcn_mfma_f32_16x16x32_bf16(*(const LAS s16x8*)(vnT + (16 * vt + ln) * 72 + 8 * h4), *(const LAS s16x8*)(QKg + (16 * it + ln) * 72 + 8 * h4), a, 0, 0, 0);
            if (it >= 2) a = __builtin_amdgcn_mfma_f32_16x16x32_bf16(*(const LAS s16x8*)(vnT + (16 * vt + ln) * 72 + 32 + 8 * h4), *(const LAS s16x8*)(QKg + (16 * it + ln) * 72 + 32 + 8 * h4), a, 0, 0, 0);
            const int ic = n * 64 + 16 * it + ln, tk = dir ? L - 1 - ic : ic;
            *(u32x2*)(Y + (size_t)(rowbase + tk) * 1024 + colbase + 16 * vt + 4 * h4) = pk4(a);
        }
        {
            const float egl = misc[0];
#pragma unroll
            for (int vt = 0; vt < 4; ++vt) {
                f32x4 a = accS[vt] * egl;
#pragma unroll
                for (int s = 0; s < 2; ++s) a = __builtin_amdgcn_mfma_f32_16x16x32_bf16(*(const LAS s16x8*)(KT + (16 * wave + ln) * 72 + (((4 * s + h4) ^ wave) << 3)), *(const LAS s16x8*)(vnsT + (16 * vt + ln) * 72 + 32 * s + 8 * h4), a, 0, 0, 0);
                accS[vt] = a;
            }
        }
        __syncthreads();
#pragma unroll
        for (int vt = 0; vt < 4; ++vt) *(LAS u32x2*)(ST + (vt * 16 + ln) * 136 + wave * 16 + h4 * 4) = pk4(accS[vt]);
    }
#undef GD_LOAD
    if (!kind) { float* so = p.out + OUT_SGD + (((size_t)b * 2 + dir) * 4 + head) * 16384 + half * 64;
#pragma unroll
        for (int vt = 0; vt < 4; ++vt)
#pragma unroll
            for (int r = 0; r < 4; ++r) so[(size_t)(wave * 16 + h4 * 4 + r) * 128 + vt * 16 + ln] = accS[vt][r]; }
}
__device__ __forceinline__ void rwkv_idx(const P& p, LAS unsigned char* lds, int i) {
    const int kind = i < 128 ? 1 : 0, j = i < 128 ? i : i - 128;
    rwkv_item(p, lds, kind, j >> 4, (j >> 1) & 7, j & 1);
}
__device__ __forceinline__ void gdn_idx(const P& p, LAS unsigned char* lds, int i) {
    const int kind = i < 128 ? 1 : 0, j = i < 128 ? i : i - 128;
    gdn_item(p, lds, kind, j >> 4, (j >> 2) & 3, (j >> 1) & 1, j & 1);
}
__device__ __forceinline__ void ph_scan(const P& p, LAS unsigned char* lds) {
    const int B = blockIdx.x, G = gridDim.x;
    if (G == 256) {
        if (B < 128) { rwkv_idx(p, lds, B); for (int i = 0; i < 4; ++i) gdn_idx(p, lds, 128 + B * 4 + i); }
        else { gdn_idx(p, lds, B - 128); for (int i = 0; i < 4; ++i) rwkv_idx(p, lds, 128 + (B - 128) * 4 + i); }
    } else {
        for (int i = B; i < 640; i += G) { rwkv_idx(p, lds, i); gdn_idx(p, lds, i); }
    }
}

__device__ __forceinline__ void ph_post_ab(const P& p, bool dummy) {
    const int tid = tid_opaque(), lane = tid & 63, wave = tid >> 6;
    const bf16* p0 = (const bf16*)(p.ws + WS_R1); const bf16* lo = (const bf16*)(p.ws + WS_R2);
    bf16* MX = (bf16*)(p.ws + WS_MIX); const bf16* YB = (const bf16*)(p.ws + WS_H);
    bf16* MO = dummy ? (bf16*)(p.out + OUT_CKV) : MX;
    const int C = lane * 8;
    float mur[8], muk[8], muv[8], ka[8], rk[8], lw[8], lb[8], gn[8];
#pragma unroll
    for (int i = 0; i < 8; ++i) { mur[i] = p.in[19][C + i]; muk[i] = p.in[19][512 + C + i]; muv[i] = p.in[19][1024 + C + i]; ka[i] = p.in[26][C + i]; rk[i] = p.in[27][C + i];
        lw[i] = p.in[28][C + i]; lb[i] = p.in[29][C + i]; gn[i] = p.in[33][(C + i) & 127]; }
    for (int row = blockIdx.x * 8 + wave; row < M_TOK; row += gridDim.x * 8) {
        const int t = row < MP ? (row & 255) : ((row - MP) & 1023), L = row < MP ? 256 : 1024;
        const bool hp = t > 0, hn = t < L - 1;
        const u32x4 z4 = {0u, 0u, 0u, 0u};
        const bf16* pr = p0 + (size_t)row * LDP0 + C;
        float r[8], k[8], v[8];
        {
            const u32x4 c = *(const u32x4*)pr, a = hp ? *(const u32x4*)(pr - LDP0) : z4, n = hn ? *(const u32x4*)(pr + LDP0) : z4;
#pragma unroll
            for (int i = 0; i < 4; ++i) { float c0 = bflo(c[i]), c1 = bfhi(c[i]); r[2 * i] = c0 + mur[2 * i] * (0.5f * (bflo(a[i]) + bflo(n[i])) - c0); r[2 * i + 1] = c1 + mur[2 * i + 1] * (0.5f * (bfhi(a[i]) + bfhi(n[i])) - c1); }
        }
        {
            const u32x4 c = *(const u32x4*)(pr + 512), a = hp ? *(const u32x4*)(pr + 512 - LDP0) : z4, n = hn ? *(const u32x4*)(pr + 512 + LDP0) : z4;
#pragma unroll
            for (int i = 0; i < 4; ++i) { float c0 = bflo(c[i]), c1 = bfhi(c[i]); k[2 * i] = c0 + muk[2 * i] * (0.5f * (bflo(a[i]) + bflo(n[i])) - c0); k[2 * i + 1] = c1 + muk[2 * i + 1] * (0.5f * (bfhi(a[i]) + bfhi(n[i])) - c1); }
        }
        {
            const u32x4 c = *(const u32x4*)(pr + 1024), a = hp ? *(const u32x4*)(pr + 1024 - LDP0) : z4, n = hn ? *(const u32x4*)(pr + 1024 + LDP0) : z4;
#pragma unroll
            for (int i = 0; i < 4; ++i) { float c0 = bflo(c[i]), c1 = bfhi(c[i]); v[2 * i] = c0 + muv[2 * i] * (0.5f * (bflo(a[i]) + bflo(n[i])) - c0); v[2 * i + 1] = c1 + muv[2 * i + 1] * (0.5f * (bfhi(a[i]) + bfhi(n[i])) - c1); }
        }
        const u32x4 af = *(const u32x4*)(lo + (size_t)row * 2560 + 1024 + C), ab = *(const u32x4*)(lo + (size_t)row * 2560 + 1536 + C), gg = *(const u32x4*)(lo + (size_t)row * 2560 + 2048 + C);
        const u32x4 yf = *(const u32x4*)(MX + (size_t)row * 1024 + C), yb = *(const u32x4*)(YB + (size_t)row * 1024 + C);
        float y[8], s = 0.f, bon = 0.f;
#pragma unroll
        for (int i = 0; i < 4; ++i) {
            y[2 * i] = bflo(yf[i]) + bflo(yb[i]); y[2 * i + 1] = bfhi(yf[i]) + bfhi(yb[i]); s += y[2 * i] + y[2 * i + 1];
            const float am0 = 0.5f * (bflo(af[i]) + bflo(ab[i])), am1 = 0.5f * (bfhi(af[i]) + bfhi(ab[i]));
            bon += r[2 * i] * k[2 * i] * (1.0f + (am0 - 1.0f) * ka[2 * i]) * rk[2 * i] + r[2 * i + 1] * k[2 * i + 1] * (1.0f + (am1 - 1.0f) * ka[2 * i + 1]) * rk[2 * i + 1];
        }
        const float mean = red8(s) * (1.0f / 64.0f); bon = red8(bon);
        float q2 = 0.f;
#pragma unroll
        for (int i = 0; i < 8; ++i) { y[i] -= mean; q2 += y[i] * y[i]; }
        const float rstd = 1.0f / sqrtf(red8(q2) * (1.0f / 64.0f) + 64e-5f);
        u32x4 o;
#pragma unroll
        for (int i = 0; i < 4; ++i) {
            const float o0 = (y[2 * i] * rstd * lw[2 * i] + lb[2 * i] + bon * v[2 * i]) * bflo(gg[i]);
            const float o1 = (y[2 * i + 1] * rstd * lw[2 * i + 1] + lb[2 * i + 1] + bon * v[2 * i + 1]) * bfhi(gg[i]);
            o[i] = pk2(o0, o1);
        }
        const size_t orow = dummy ? (size_t)(row & 4095) : (size_t)row;
        *(u32x4*)(MO + orow * 1024 + C) = o;
        const u32x4 of = *(const u32x4*)(MX + (size_t)row * 1024 + 512 + C), ob = *(const u32x4*)(YB + (size_t)row * 1024 + 512 + C);
        const u32x4 zz = *(const u32x4*)(p0 + (size_t)row * LDP0 + 1920 + 1536 + C);
        float og[8], so = 0.f;
#pragma unroll
        for (int i = 0; i < 4; ++i) { og[2 * i] = bflo(of[i]) + bflo(ob[i]); og[2 * i + 1] = bfhi(of[i]) + bfhi(ob[i]); so += og[2 * i] * og[2 * i] + og[2 * i + 1] * og[2 * i + 1]; }
        const float rs = 1.0f / sqrtf(red16(so) * (1.0f / 128.0f) + 1e-6f);
        u32x4 o2;
#pragma unroll
        for (int i = 0; i < 4; ++i) { const float z0 = bflo(zz[i]), z1 = bfhi(zz[i]);
            o2[i] = pk2(og[2 * i] * rs * gn[2 * i] * siluf_(z0), og[2 * i + 1] * rs * gn[2 * i + 1] * siluf_(z1)); }
        *(u32x4*)(MO + orow * 1024 + 512 + C) = o2;
    }
}

__device__ __forceinline__ void ph_hyena_filters(const P& p, LAS unsigned char* lds) {
    LAS float* f0 = (LAS float*)lds;
    LAS float* h1 = f0 + 32 * 36;
    LAS float* h2 = h1 + 32 * 64;
    LAS bf16* stg = (LAS bf16*)(h2 + 64 * 32);
    LAS float* w1s = h2 + 64 * 32 + 8192;
    LAS float* w2s = w1s + 33 * 64;
    const int tid = tid_opaque();
    const float* b1 = p.in[41]; const float* b2 = p.in[43]; const float* w3 = p.in[44]; const float* fr = p.in[45];
    __syncthreads();
    if (blockIdx.x < 160) {
        for (int e = tid; e < 33 * 64; e += NTHREADS) w1s[e] = p.in[40][e];
        for (int e = tid; e < 64 * 64; e += NTHREADS) w2s[e] = p.in[42][e];
    }
    for (int item4 = blockIdx.x; item4 < 160; item4 += gridDim.x) {
        const int item = item4 >> 2, oo = item4 & 3;
        const int ls = item < 32 ? 1 : 0;
        const int L = ls ? 1024 : 256, t0 = (ls ? item : item - 32) * 32;
        const int o = tid + oo * 512;
        float wreg[16];
#pragma unroll
        for (int f = 0; f < 16; ++f) wreg[f] = w3[f * 2048 + o];
        __syncthreads();
        for (int e = tid; e < 32 * 33; e += NTHREADS) {
            const int pi = e / 33, f = e % 33; const float t = (float)(t0 + pi);
            float v;
            if (f == 0) v = t / (float)(L - 1);
            else { const int bi = (f - 1) & 15; const float band = 1e-4f + (15.0f - 1e-4f) * ((float)bi / 15.0f); const float ang = (6.283185307179586f / (float)L) * t * band; v = f <= 16 ? __cosf(ang) : -__sinf(ang); }
            f0[pi * 36 + f] = v;
        }
        __syncthreads();
        {
            const int j = tid & 63, pq = tid >> 6; const float bj = b1[j], fj = fr[j];
            float sacc[4] = {bj, bj, bj, bj};
#pragma unroll 3
            for (int f = 0; f < 33; ++f) { const float w = w1s[f * 64 + j];
#pragma unroll
                for (int i = 0; i < 4; ++i) sacc[i] += f0[(pq + 8 * i) * 36 + f] * w; }
#pragma unroll
            for (int i = 0; i < 4; ++i) h1[(pq + 8 * i) * 64 + j] = __sinf(fj * sacc[i]);
        }
        __syncthreads();
        {
            const int j = tid & 63, pq = tid >> 6; const float bj = b2[j], fj = fr[64 + j];
            float sacc[4] = {bj, bj, bj, bj};
#pragma unroll 4
            for (int f = 0; f < 64; ++f) { const float w = w2s[f * 64 + j];
#pragma unroll
                for (int i = 0; i < 4; ++i) sacc[i] += h1[(pq + 8 * i) * 64 + f] * w; }
#pragma unroll
            for (int i = 0; i < 4; ++i) h2[j * 32 + pq + 8 * i] = __sinf(fj * sacc[i]);
        }
        __syncthreads();
        bf16* G = (bf16*)(p.ws + (ls ? WS_GFS : WS_GFP));
        {
            const int c = o & 511;
            f32x4 sv[8];
#pragma unroll
            for (int i = 0; i < 8; ++i) sv[i] = (f32x4){0.f, 0.f, 0.f, 0.f};
#pragma unroll
            for (int fq = 0; fq < 4; ++fq) {
                float wn[16];
                if (fq < 3) {
#pragma unroll
                    for (int f = 0; f < 16; ++f) wn[f] = w3[((fq + 1) * 16 + f) * 2048 + o];
                }
#pragma unroll
                for (int f = 0; f < 16; ++f) { const float w = wreg[f]; const LAS f32x4* hp = (const LAS f32x4*)(h2 + (fq * 16 + f) * 32);
#pragma unroll
                    for (int i = 0; i < 8; ++i) sv[i] += hp[i] * w; }
                if (fq < 3) {
#pragma unroll
                    for (int f = 0; f < 16; ++f) wreg[f] = wn[f];
                }
            }
            const float delta = 3.0701134573253944f + (15.350567286626973f - 3.0701134573253944f) * ((float)c / 511.0f);
            const float inv = 1.0f / (float)(L - 1);
#pragma unroll
            for (int i = 0; i < 8; ++i) {
                const float ta = (float)(t0 + 4 * i) * inv, tb = (float)(t0 + 4 * i + 1) * inv, tc = (float)(t0 + 4 * i + 2) * inv, td = (float)(t0 + 4 * i + 3) * inv;
                *(LAS u32x2*)(stg + tid * 32 + 4 * i) = (u32x2){pk2(sv[i].x * __expf(-ta * delta), sv[i].y * __expf(-tb * delta)), pk2(sv[i].z * __expf(-tc * delta), sv[i].w * __expf(-td * delta))};
            }
            __syncthreads();
            const int lane = tid & 63, wv = tid >> 6, pi = lane & 31;
#pragma unroll 4
            for (int r = 0; r < 32; ++r) {
                const int col = wv * 64 + r * 2 + (lane >> 5);
                const int o2 = col + oo * 512, order2 = o2 >> 10, dr2 = (o2 >> 9) & 1, c2 = o2 & 511, t = t0 + pi;
                const bf16 hv = stg[col * 32 + pi];
                bf16* g = G + ((size_t)order2 * 512 + c2) * (2 * L);
                if (dr2 == 0) g[L - t] = hv;
                else if (t > 0) g[L + t] = hv;
                if (dr2 == 0 && t == 0) g[0] = 0;
            }
        }
    }
}

__device__ __forceinline__ void ph_mla_prep(const P& p, LAS unsigned char* lds) {
    const int tid = tid_opaque(), lane = tid & 63, wave = tid >> 6;
    const bf16* p1 = (const bf16*)(p.ws + WS_R1);
    bf16* qn = (bf16*)(p.ws + WS_H); bf16* ckva = (bf16*)(p.ws + WS_CKVA); bf16* kpea = (bf16*)(p.ws + WS_KPEA);
    const float* rope = (const float*)(p.ws + WS_ROPE);
    const float* qg = p.in[35]; const float* kg = p.in[37];
    const int nw = gridDim.x * 8;
    for (int row0 = blockIdx.x * 8 + wave; row0 < M_TOK; row0 += 4 * nw) {
        unsigned qw[4][3], kw[4]; u32x2 vw[4]; float sq[4], sk[4];
#pragma unroll
        for (int r = 0; r < 4; ++r) {
            const int row = (row0 + r * nw) < M_TOK ? (row0 + r * nw) : (M_TOK - 1);
            const bf16* pr = p1 + (size_t)row * LDP1;
#pragma unroll
            for (int j = 0; j < 3; ++j) qw[r][j] = *(const unsigned*)(pr + j * 128 + lane * 2);
            vw[r] = *(const u32x2*)(pr + 384 + lane * 4);
            kw[r] = lane < 16 ? *(const unsigned*)(pr + 640 + lane * 2) : 0u;
        }
#pragma unroll
        for (int r = 0; r < 4; ++r) {
            float s = 0.f;
#pragma unroll
            for (int j = 0; j < 3; ++j) s += bflo(qw[r][j]) * bflo(qw[r][j]) + bfhi(qw[r][j]) * bfhi(qw[r][j]);
            sq[r] = s;
            const f32x4 kv = unpk4(vw[r]); sk[r] = kv.x * kv.x + kv.y * kv.y + kv.z * kv.z + kv.w * kv.w;
        }
#pragma unroll
        for (int o = 1; o < 64; o <<= 1) {
#pragma unroll
            for (int r = 0; r < 4; ++r) { sq[r] += __shfl_xor(sq[r], o); sk[r] += __shfl_xor(sk[r], o); } }
#pragma unroll
        for (int r = 0; r < 4; ++r) {
            const int row = row0 + r * nw; if (row >= M_TOK) break;
            const float rq = rsqrtf_(sq[r] * (1.0f / 384.0f) + 1e-6f), rk = rsqrtf_(sk[r] * (1.0f / 256.0f) + 1e-6f);
#pragma unroll
            for (int j = 0; j < 3; ++j) { const int col = j * 128 + lane * 2; *(unsigned*)(qn + (size_t)row * 384 + col) = pk2(bflo(qw[r][j]) * rq * qg[col], bfhi(qw[r][j]) * rq * qg[col + 1]); }
            const f32x4 ck = unpk4(vw[r]) * rk * *(const f32x4*)(kg + lane * 4);
            *(u32x2*)(ckva + (size_t)row * 256 + lane * 4) = pk4(ck);
            if (row < MP) *(f32x4*)(p.out + OUT_CKV + (size_t)row * 256 + lane * 4) = ck;
            if (lane < 16) {
                float x1 = bflo(kw[r]), x2 = bfhi(kw[r]);
                if (row < MP) { *(f32x2*)(p.out + OUT_KPE + (size_t)row * 32 + lane * 2) = (f32x2){x1, x2}; }
                else { const int tq = (row - MP) & 1023; const f32x2 cs = *(const f32x2*)(rope + (size_t)tq * 32 + lane * 2); const float a = x1 * cs.x - x2 * cs.y, bq = x1 * cs.y + x2 * cs.x; x1 = a; x2 = bq; }
                *(unsigned*)(kpea + (size_t)row * 32 + lane * 2) = pk2(x1, x2);
            }
        }
    }
    for (int r2 = blockIdx.x * 8 + wave; r2 < 2048; r2 += nw) {
        const int row = M_TOK + r2;
        const f32x4 cv = *(const f32x4*)(p.in[4] + (size_t)r2 * 256 + lane * 4);
        *(u32x2*)(ckva + (size_t)row * 256 + lane * 4) = pk4(cv);
        if (lane < 16) { const f32x2 kp = *(const f32x2*)(p.in[5] + (size_t)r2 * 32 + lane * 2); *(unsigned*)(kpea + (size_t)row * 32 + lane * 2) = pk2(kp.x, kp.y); }
    }
    LAS float* tile = (LAS float*)(lds + wave * 8832);
    bf16* HT = (bf16*)(p.ws + WS_HYIN);
    const float* cw = p.in[39];
    for (int it = blockIdx.x * 8 + wave; it < 256 * 48; it += gridDim.x * 8) {
        const int rt = it / 48, cb = it % 48;
        const int r0 = rt * 64, col0 = 672 + cb * 32;
        const int t0 = r0 < MP ? (r0 & 255) : ((r0 - MP) & 1023), L = r0 < MP ? 256 : 1024;
        unsigned wv[17];
#pragma unroll
        for (int i = 0; i < 17; ++i) {
            const int rr = i * 4 + (lane >> 4), tt = t0 - 1 + rr;
            wv[i] = (rr < 66 && tt >= 0 && tt < L) ? *(const unsigned*)(p1 + (size_t)(r0 - 1 + rr) * LDP1 + col0 + (lane & 15) * 2) : 0u;
        }
#pragma unroll
        for (int i = 0; i < 17; ++i) {
            const int rr = i * 4 + (lane >> 4);
            if (rr < 66) { tile[rr * 33 + (lane & 15) * 2] = bflo(wv[i]); tile[rr * 33 + (lane & 15) * 2 + 1] = bfhi(wv[i]); }
        }
        LDS_WAIT();
#pragma unroll 8
        for (int c = 0; c < 32; ++c) {
            const int ch = cb * 32 + c;
            const float v = cw[ch] * tile[lane * 33 + c] + cw[1536 + ch] * tile[(lane + 1) * 33 + c] + cw[3072 + ch] * tile[(lane + 2) * 33 + c];
            HT[(size_t)ch * M_TOK + r0 + lane] = (bf16)(pk2(v, 0.f) & 0xffffu);
        }
        LDS_WAIT();
    }
}

__device__ __forceinline__ void attn_item(const P& p, LAS unsigned char* lds, int kind, int b, int head, int qt) {
    constexpr int TILE_B = 64 * 104 * 2 + 64 * 72 * 2;
    const int tid = tid_opaque(), lane = tid & 63, wave = tid >> 6, ln = lane & 15, h = lane >> 4;
    const bf16* Q = (const bf16*)(p.ws + WS_Q); const bf16* KN = (const bf16*)(p.ws + WS_KV); const bf16* VT = (const bf16*)(p.ws + WS_VT); const bf16* KPE = (const bf16*)(p.ws + WS_KPEA);
    bf16* MX = (bf16*)(p.ws + WS_MIX);
    const int nkeys = kind ? 1280 : 256, rowbase = kind ? MP + b * 1024 : b * 256, ntiles = nkeys / 64;
    const int qrow = rowbase + qt * 128 + wave * 16 + ln;
    s16x8 qf[3];
#pragma unroll
    for (int s = 0; s < 3; ++s) qf[s] = *(const s16x8*)(Q + (size_t)qrow * 768 + head * 96 + 32 * s + 8 * h);
    f32x4 o[4];
#pragma unroll
    for (int i = 0; i < 4; ++i) o[i] = (f32x4){0.f, 0.f, 0.f, 0.f};
    float mrun = -1e30f, lrun = 0.f;
    const int k0key = tid / 12, k0ch = tid % 12, k1key = (tid + 512) / 12, k1ch = (tid + 512) % 12, vv = tid >> 3, vkc = tid & 7;
    u32x4 Ak0, Ak1 = {0u, 0u, 0u, 0u}, Av, Bk0, Bk1 = {0u, 0u, 0u, 0u}, Bv;
#define ATT_LOAD(X, it) do { const int j0_ = (it) * 64; \
        const int kb_ = kind ? (j0_ < 1024 ? MP + b * 1024 + j0_ : M_TOK + b * 256 + (j0_ - 1024)) : b * 256 + j0_; \
        X##k0 = *(const u32x4*)(k0ch < 8 ? KN + (size_t)(kb_ + k0key) * 512 + head * 64 + k0ch * 8 : KPE + (size_t)(kb_ + k0key) * 32 + (k0ch - 8) * 8); \
        if (tid < 256) X##k1 = *(const u32x4*)(k1ch < 8 ? KN + (size_t)(kb_ + k1key) * 512 + head * 64 + k1ch * 8 : KPE + (size_t)(kb_ + k1key) * 32 + (k1ch - 8) * 8); \
        X##v = *(const u32x4*)(VT + (size_t)(head * 64 + vv) * (M_TOK + 2048) + kb_ + vkc * 8); } while (0)
#define ATT_STORE(X, Kt_, Vt_) do { *(LAS u32x4*)(Kt_ + k0key * 104 + k0ch * 8) = X##k0; \
        if (tid < 256) *(LAS u32x4*)(Kt_ + k1key * 104 + k1ch * 8) = X##k1; \
        *(LAS u32x4*)(Vt_ + vv * 72 + vkc * 8) = X##v; } while (0)
    __syncthreads();
    ATT_LOAD(A, 0);
    if (ntiles > 1) ATT_LOAD(B, 1);
#pragma unroll 1
    for (int it = 0; it < ntiles; ++it) {
        LAS bf16* Kt = (LAS bf16*)(lds + (it & 1) * TILE_B);
        LAS bf16* Vt = Kt + 64 * 104;
        if (it & 1) ATT_STORE(B, Kt, Vt); else ATT_STORE(A, Kt, Vt);
        __syncthreads();
        if (it + 2 < ntiles) { if (it & 1) ATT_LOAD(B, it + 2); else ATT_LOAD(A, it + 2); }
        f32x4 sc[4]; float mx = -1e30f;
#pragma unroll
        for (int kt = 0; kt < 4; ++kt) {
            f32x4 a = {0.f, 0.f, 0.f, 0.f};
#pragma unroll
            for (int s = 0; s < 3; ++s) { const s16x8 kf = *(const LAS s16x8*)(Kt + (kt * 16 + ln) * 104 + 32 * s + 8 * h); a = __builtin_amdgcn_mfma_f32_16x16x32_bf16(kf, qf[s], a, 0, 0, 0); }
            sc[kt] = a; mx = fmaxf(mx, fmaxf(fmaxf(a[0], a[1]), fmaxf(a[2], a[3])));
        }
        mx = fmaxf(mx, __shfl_xor(mx, 16)); mx = fmaxf(mx, __shfl_xor(mx, 32));
        const float mnew = fmaxf(mrun, mx), alpha = __expf(mrun - mnew);
        mrun = mnew;
        float ps = 0.f;
#pragma unroll
        for (int kt = 0; kt < 4; ++kt)
#pragma unroll
            for (int r = 0; r < 4; ++r) { sc[kt][r] = __expf(sc[kt][r] - mnew); ps += sc[kt][r]; }
        lrun = lrun * alpha + ps;
#pragma unroll
        for (int i = 0; i < 4; ++i) o[i] = o[i] * alpha;
#pragma unroll
        for (int s = 0; s < 2; ++s) {
            u32x4 pw; pw.x = pk2(sc[2 * s][0], sc[2 * s][1]); pw.y = pk2(sc[2 * s][2], sc[2 * s][3]); pw.z = pk2(sc[2 * s + 1][0], sc[2 * s + 1][1]); pw.w = pk2(sc[2 * s + 1][2], sc[2 * s + 1][3]);
            const s16x8 pf = __builtin_bit_cast(s16x8, pw);
#pragma unroll
            for (int vt = 0; vt < 4; ++vt) {
                const LAS bf16* vp = Vt + (vt * 16 + ln) * 72 + 32 * s + 4 * h;
                const u32x2 lo2 = *(const LAS u32x2*)vp, hi2 = *(const LAS u32x2*)(vp + 16);
                const u32x4 vw = {lo2.x, lo2.y, hi2.x, hi2.y};
                o[vt] = __builtin_amdgcn_mfma_f32_16x16x32_bf16(__builtin_bit_cast(s16x8, vw), pf, o[vt], 0, 0, 0);
            }
        }
    }
#undef ATT_LOAD
#undef ATT_STORE
    lrun += __shfl_xor(lrun, 16); lrun += __shfl_xor(lrun, 32);
    const float inv = 1.0f / lrun;
#pragma unroll
    for (int vt = 0; vt < 4; ++vt) *(u32x2*)(MX + (size_t)qrow * 1024 + head * 64 + vt * 16 + 4 * h) = pk4(o[vt] * inv);
}

__device__ __forceinline__ void hyena_item(const P& p, LAS unsigned char* lds, int kind, int cgp) {
    const int tid = tid_opaque(), lane = tid & 63, wave = tid >> 6, ci = wave >> 2, qtr = wave & 3;
    const int L = kind ? 1024 : 256, NB = kind ? 8 : 32, base = kind ? MP : 0, c = cgp * 2 + ci;
    const int DMAX = kind ? 31 : 7;
    constexpr int ZCH = 8704;
    LAS bf16* zb = (LAS bf16*)lds;
    LAS bf16* gb = zb + 2 * ZCH;
    LAS bf16* gb1 = gb + 4 * 2048;
    LAS bf16* gl = gb1 + 4 * 2048;
    const bf16* HT = (const bf16*)(p.ws + WS_HYIN);
    const bf16* G = (const bf16*)(p.ws + (kind ? WS_GFS : WS_GFP));
    bf16* HO = (bf16*)(p.ws + WS_H);
    __syncthreads();
    const int Lp = L + 8;
    for (int i = tid; i < 2 * 1024; i += NTHREADS) { const int cc = i >> 10, off = (i & 1023) * 8;
        *(LAS u32x4*)(zb + cc * ZCH + (off / L) * Lp + (off % L)) = *(const u32x4*)(HT + (size_t)(cgp * 2 + cc) * M_TOK + base + off); }
    for (int i = tid; i < 4 * (2 * L / 8); i += NTHREADS) { const int co = i / (2 * L / 8), off = (i % (2 * L / 8)) * 8, cc = co >> 1, od = co & 1;
        *(LAS u32x4*)(gb + (cc * 2 + od) * 2 * L + off) = *(const u32x4*)(G + ((size_t)od * 512 + cgp * 2 + cc) * (2 * L) + off);
        *(LAS u32x4*)(gb1 + (cc * 2 + od) * 2 * L + off) = *(const u32x4*)(G + ((size_t)od * 512 + cgp * 2 + cc) * (2 * L) + off + 1); }
    for (int i = tid; i < 4 * 1024; i += NTHREADS) { const int oc = i >> 10, off = (i & 1023) * 8;
        *(LAS u32x4*)(gl + oc * ZCH + (off / L) * Lp + (off % L)) = *(const u32x4*)(HT + (size_t)(((oc >> 1) + 1) * 512 + cgp * 2 + (oc & 1)) * M_TOK + base + off); }
    __syncthreads();
    const int n = lane & 31, h = lane >> 5;
    const int jl = kind ? (n & 3) : 0, bb = kind ? (n >> 2) : n;
    const LAS bf16* zc = zb + ci * ZCH + bb * Lp;
#pragma unroll 1
    for (int order = 0; order < 2; ++order) {
        const LAS bf16* gr = (n & 1) ? gb1 + (ci * 2 + order) * 2 * L - 1 : gb + (ci * 2 + order) * 2 * L;
        f32x16 acc[2];
#pragma unroll
        for (int g = 0; g < 2; ++g)
#pragma unroll
            for (int r = 0; r < 16; ++r) acc[g][r] = 0.f;
        const int Ilo_w = kind ? 8 * qtr : 2 * qtr, Ihi_w = kind ? 8 * qtr + 7 : 2 * qtr + 1;
        int Dlo = Ilo_w - (L / 32 - 1), Dhi = Ihi_w; if (Dlo < -DMAX) Dlo = -DMAX; if (Dhi > DMAX) Dhi = DMAX;
#define HY_LOAD(DD, A0, A1, B00, B01, B10, B11) do { \
            const volatile LAS unsigned* ap_ = (const volatile LAS unsigned*)(gr + (L - 32 * (DD) + 8 * h - n)); \
            A0.x = ap_[0]; A0.y = ap_[1]; A0.z = ap_[2]; A0.w = ap_[3]; A1.x = ap_[8]; A1.y = ap_[9]; A1.z = ap_[10]; A1.w = ap_[11]; \
            const int J0_ = (kind ? 8 * qtr + jl : 2 * qtr) - (DD), J1_ = (kind ? 8 * qtr + 4 + jl : 2 * qtr + 1) - (DD); \
            const bool k0_ = J0_ >= 0 && J0_ < L / 32, k1_ = J1_ >= 0 && J1_ < L / 32; \
            const LAS bf16* z0_ = zc + 32 * (k0_ ? J0_ : 0) + 8 * h; const LAS bf16* z1_ = zc + 32 * (k1_ ? J1_ : 0) + 8 * h; \
            B00 = *(const LAS u32x4*)z0_; B10 = *(const LAS u32x4*)(z0_ + 16); B01 = *(const LAS u32x4*)z1_; B11 = *(const LAS u32x4*)(z1_ + 16); \
            B00.x = k0_ ? B00.x : 0u; B00.y = k0_ ? B00.y : 0u; B00.z = k0_ ? B00.z : 0u; B00.w = k0_ ? B00.w : 0u; B10.x = k0_ ? B10.x : 0u; B10.y = k0_ ? B10.y : 0u; B10.z = k0_ ? B10.z : 0u; B10.w = k0_ ? B10.w : 0u; \
            B01.x = k1_ ? B01.x : 0u; B01.y = k1_ ? B01.y : 0u; B01.z = k1_ ? B01.z : 0u; B01.w = k1_ ? B01.w : 0u; B11.x = k1_ ? B11.x : 0u; B11.y = k1_ ? B11.y : 0u; B11.z = k1_ ? B11.z : 0u; B11.w = k1_ ? B11.w : 0u; \
        } while (0)
        u32x4 cA0, cA1, cB00, cB01, cB10, cB11;
        HY_LOAD(Dlo, cA0, cA1, cB00, cB01, cB10, cB11);
#pragma unroll 1
        for (int D = Dlo; D <= Dhi; ++D) {
            u32x4 nA0, nA1, nB00, nB01, nB10, nB11;
            HY_LOAD(D + 1, nA0, nA1, nB00, nB01, nB10, nB11);
            acc[0] = __builtin_amdgcn_mfma_f32_32x32x16_bf16(__builtin_bit_cast(s16x8, cA0), __builtin_bit_cast(s16x8, cB00), acc[0], 0, 0, 0);
            acc[1] = __builtin_amdgcn_mfma_f32_32x32x16_bf16(__builtin_bit_cast(s16x8, cA0), __builtin_bit_cast(s16x8, cB01), acc[1], 0, 0, 0);
            acc[0] = __builtin_amdgcn_mfma_f32_32x32x16_bf16(__builtin_bit_cast(s16x8, cA1), __builtin_bit_cast(s16x8, cB10), acc[0], 0, 0, 0);
            acc[1] = __builtin_amdgcn_mfma_f32_32x32x16_bf16(__builtin_bit_cast(s16x8, cA1), __builtin_bit_cast(s16x8, cB11), acc[1], 0, 0, 0);
            cA0 = nA0; cA1 = nA1; cB00 = nB00; cB01 = nB01; cB10 = nB10; cB11 = nB11;
        }
#undef HY_LOAD
        const float bias = p.in[46][order * 512 + c];
        const LAS bf16* gate = gl + (order * 2 + ci) * ZCH + bb * Lp;
        u32x2 zn[2][4];
#pragma unroll
        for (int g = 0; g < 2; ++g) {
            const int og = qtr * 2 + g, I = kind ? 4 * og + jl : og;
#pragma unroll
            for (int rq = 0; rq < 4; ++rq) {
                const int t = 32 * I + 8 * rq + 4 * h;
                const f32x4 zo = unpk4(*(const LAS u32x2*)(zc + t)), gt = unpk4(*(const LAS u32x2*)(gate + t));
                f32x4 y; y.x = acc[g][4 * rq]; y.y = acc[g][4 * rq + 1]; y.z = acc[g][4 * rq + 2]; y.w = acc[g][4 * rq + 3];
                zn[g][rq] = pk4(gt * (y + zo * bias));
            }
        }
        __syncthreads();
#pragma unroll
        for (int g = 0; g < 2; ++g) { const int og = qtr * 2 + g, I = kind ? 4 * og + jl : og;
#pragma unroll
            for (int rq = 0; rq < 4; ++rq) *(LAS u32x2*)(zb + ci * ZCH + bb * Lp + 32 * I + 8 * rq + 4 * h) = zn[g][rq]; }
        __syncthreads();
    }
    for (int i = tid; i < 2 * 1024; i += NTHREADS) { const int cc = i >> 10, off = (i & 1023) * 8;
        *(u32x4*)(HO + (size_t)(cgp * 2 + cc) * M_TOK + base + off) = *(const LAS u32x4*)(zb + cc * ZCH + (off / L) * Lp + (off % L)); }
}
#ifndef DUP_SUB
#define DUP_SUB 3
#endif
__device__ __forceinline__ void ph_attn_hyena(const P& p, LAS unsigned char* lds, bool dummy) {
    const int B = blockIdx.x, G = gridDim.x;
#ifndef T_NO_ATTN
    if (!dummy || (DUP_SUB & 1))
    for (int i = B; i < 1024; i += G) { if (i < 512) attn_item(p, lds, 1, i >> 6, (i >> 3) & 7, i & 7); else { const int j = i - 512; attn_item(p, lds, 0, j >> 4, (j >> 1) & 7, j & 1); } }
#endif
#ifndef T_NO_HY
    if (!dummy || (DUP_SUB & 2))
    for (int i = B; i < 512; i += G) { hyena_item(p, lds, i < 256 ? 1 : 0, i & 255); }
#endif
}

__device__ __forceinline__ void ph_hy_transpose(const P& p, LAS unsigned char* lds) {
    const int tid = tid_opaque(), lane = tid & 63, wave = tid >> 6;
    LAS bf16* tile = (LAS bf16*)(lds + wave * 9216);
    const bf16* HO = (const bf16*)(p.ws + WS_H); bf16* MX = (bf16*)(p.ws + WS_MIX);
    for (int it = blockIdx.x * 8 + wave; it < 2048; it += gridDim.x * 8) {
        const int rt = it >> 3, cb = it & 7, r0 = rt * 64, c0 = cb * 64;
#pragma unroll
        for (int i = 0; i < 8; ++i) { const int id = i * 64 + lane, c = id >> 3, rc = id & 7;
            *(LAS u32x4*)(tile + c * 72 + rc * 8) = *(const u32x4*)(HO + (size_t)(c0 + c) * M_TOK + r0 + rc * 8); }
        LDS_WAIT();
        bf16* dst = MX + (size_t)(r0 + lane) * 1024 + 512 + c0;
#pragma unroll
        for (int j = 0; j < 8; ++j) {
            u32x4 w;
#pragma unroll
            for (int i = 0; i < 4; ++i) { const unsigned a = tile[(j * 8 + 2 * i) * 72 + lane], bq = tile[(j * 8 + 2 * i + 1) * 72 + lane]; w[i] = a | (bq << 16); }
            *(u32x4*)(dst + j * 8) = w;
        }
        LDS_WAIT();
    }
}

#define XB_TMO      128
#define XB_XCNT(j)  (256  + 64 * (j))
#define XB_XSUB(j)  (1280 + 64 * (j))
#define XB_XGEN(j)  (2304 + 64 * (j))
#define XB_TOP      3328
#define XB_TOPGEN   3392
#define XCD_BAR_WORDS 3456
#define XB_SPIN_CAP (1u << 18)

__device__ __forceinline__ unsigned xb_ld(unsigned* p)              { return __hip_atomic_load(p, __ATOMIC_RELAXED, __HIP_MEMORY_SCOPE_AGENT); }
__device__ __forceinline__ unsigned xb_add(unsigned* p, unsigned v) { return __hip_atomic_fetch_add(p, v, __ATOMIC_RELAXED, __HIP_MEMORY_SCOPE_AGENT); }
__device__ __forceinline__ unsigned xb_xcc_id() { return (unsigned)__builtin_amdgcn_s_getreg((3 << 11) | 20) & 0xFu; }
#define XB_SPIN(cond, bar) do { unsigned _sp = 0; while (cond) { __builtin_amdgcn_s_sleep(1); \
    if ((++_sp & 255u) == 0u) { if (xb_ld(&(bar)[XB_TMO])) break; if (_sp > XB_SPIN_CAP) { atomicAdd(&(bar)[XB_TMO], 1u); break; } } } } while (0)

struct XcdBarrier {
    unsigned* bar; unsigned x;
    volatile LAS unsigned* st;
};

__device__ __forceinline__ XcdBarrier xcd_barrier_post(unsigned* bar, volatile LAS unsigned* st) {
    XcdBarrier b; b.bar = bar; b.x = xb_xcc_id(); b.st = st;
    if (threadIdx.x == 0) (void)xb_add(&bar[XB_XCNT(b.x)], 1u);
    return b;
}
__device__ __forceinline__ void xcd_barrier_complete(unsigned* bar, unsigned x, unsigned& nloc, unsigned& nx) {
    const unsigned G = gridDim.x * gridDim.y * gridDim.z;
    unsigned sum, cnt, mine, sp = 0u;
    for (;;) {
        sum = 0u; cnt = 0u; mine = 0u;
#pragma unroll
        for (unsigned j = 0; j < 16; ++j) { const unsigned c = xb_ld(&bar[XB_XCNT(j)]); sum += c; cnt += (c > 0u) ? 1u : 0u; mine = (j == x) ? c : mine; }
        if (sum == G) break;
        __builtin_amdgcn_s_sleep(1);
        if ((++sp & 255u) == 0u) { if (xb_ld(&bar[XB_TMO])) break; if (sp > XB_SPIN_CAP) { atomicAdd(&bar[XB_TMO], 1u); break; } }
    }
    nloc = mine > 0u ? mine : 1u; nx = cnt > 0u ? cnt : 1u;
}

__device__ __forceinline__ void xcd_barrier(const XcdBarrier& b) {
    asm volatile("s_waitcnt vmcnt(0)" ::: "memory");
    __syncthreads();
    if (threadIdx.x == 0) {
        unsigned* bar = b.bar;
        __builtin_amdgcn_s_waitcnt(0);
        unsigned nloc = b.st[0], nx = b.st[1];
        if (nloc == 0u) { xcd_barrier_complete(bar, b.x, nloc, nx); b.st[0] = nloc; b.st[1] = nx; }
        const unsigned old = xb_add(&bar[XB_XSUB(b.x)], 1u);
        const unsigned gen = old / nloc;
        if (old + 1u == (gen + 1u) * nloc) {
            __builtin_amdgcn_fence(__ATOMIC_RELEASE, "agent");
            asm volatile("s_waitcnt vmcnt(0)" ::: "memory");
            const unsigned og = xb_add(&bar[XB_TOP], 1u);
            const unsigned tg = og / nx;
            if (og + 1u == (tg + 1u) * nx) xb_add(&bar[XB_TOPGEN], 1u);
            else XB_SPIN(xb_ld(&bar[XB_TOPGEN]) == tg, bar);
            __builtin_amdgcn_fence(__ATOMIC_ACQUIRE, "agent");
            xb_add(&bar[XB_XGEN(b.x)], 1u);
            asm volatile("s_waitcnt vmcnt(0)" ::: "memory");
        } else {
            XB_SPIN(xb_ld(&bar[XB_XGEN(b.x)]) == gen, bar);
            __builtin_amdgcn_fence(__ATOMIC_ACQUIRE, "agent");
            asm volatile("s_waitcnt vmcnt(0)" ::: "memory");
        }
    }
    __syncthreads();
}


template <class Epi>
__device__ __forceinline__ void run_gemm(LAS unsigned char* lds, const bf16* A, const bf16* Bt, int M, int N, int K, const Epi& E, int rot = 0) {
    asm volatile("" : "+s"(K));
    pg8::Gemm g{A, Bt, M, N, K}; pg8::StaticOrder S; S.init(M, N, (int)gridDim.x, (int)((blockIdx.x + gridDim.x - rot) % gridDim.x));
    pg8::gemm_phase<Epi, pg8::StaticOrder, true, true>(lds, g, S, E);
}

#ifndef DUP_PH
#define DUP_PH (-1)
#endif
__device__ __forceinline__ void run_phase(const P& p, LAS unsigned char* lds, int k, bool dummy) {
    if (k == 0) {
        { float* cvz0 = (float*)(p.ws + WS_CV); for (int i = blockIdx.x * NTHREADS + tid_opaque(); i < 2 * CV_STRIDE; i += gridDim.x * NTHREADS) cvz0[i] = 0.f; }
        adaln_layer(p, lds, 0, 0); adaln_layer(p, lds, 1, (int)gridDim.x / 2); ph_rope_table(p); return; }
    if (k == 27) { final_norm_rows(p); return; }
    const int layer = (k - 1) / 13, sub = (k - 1) % 13;
    float* x = p.out;
    const float* mod = (const float*)(p.ws + WS_MOD);
    bf16* H = (bf16*)(p.ws + WS_H); bf16* R1 = (bf16*)(p.ws + WS_R1);
    float* ssb = (float*)(p.ws + WS_SS); float* cvb = (float*)(p.ws + WS_CV); float* ssp = (float*)(p.ws + WS_R2);
    switch (sub) {
    case 0: case 3: case 10: {
        const int jn = sub == 0 ? 0 : (sub == 3 ? 1 : 2), uu = 3 * layer + jn;
        float* cvo = cvb + (size_t)(uu & 1) * CV_STRIDE; float* cvz = cvb + (size_t)((uu + 1) & 1) * CV_STRIDE;
        const float* shift = mod + (size_t)layer * 9 * 9216 + (3 * jn) * 1024;
        for (int i = blockIdx.x * NTHREADS + tid_opaque(); i < CV_STRIDE; i += gridDim.x * NTHREADS) cvz[i] = 0.f;
        if (uu == 0) first_rows(p, p.in[10], ssb);
        else { const int t = tid_opaque();
            if (t < 64) for (int row = blockIdx.x * 64 + t; row < M_TOK; row += gridDim.x * 64) { float a = 0.f;
#pragma unroll
                for (int q = 0; q < 16; ++q) a += ssp[q * M_TOK + row];
                ssb[row] = rsqrtf_(a * (1.0f / 1024.0f) + 1e-6f); } }
        if (sub != 3) convert_ffn_weights(p, layer, sub == 0 ? 0 : 1, lds, shift, cvo);
        else {
            transpose_w<0>(p.in[17] + (size_t)layer * 1024 * 1024, 1024, 1024, 1024, (bf16*)(p.ws + W_OUT), 1024, lds, nullptr, nullptr, 0, layer == 0 ? 128 : 232);
            if (layer == 0) { transpose_w<0>(p.in[18], 3984, 3984, 1024, (bf16*)(p.ws + W_IN), 4096, lds, shift, cvo, 4096); build_lora_w(p); }
            else { transpose_w<0>(p.in[34], 2208, 2208, 1024, (bf16*)(p.ws + W_IN), 2304, lds, shift, cvo, 2304, 160);
                transpose_w<0>(p.in[36], 768, 768, 384, (bf16*)(p.ws + W_UQ), 768, lds, nullptr, nullptr, 0, 8);
                transpose_w<0>(p.in[38], 1024, 1024, 256, (bf16*)(p.ws + W_UKV), 1024, lds, nullptr, nullptr, 0, 17);
                ph_hyena_filters(p, lds); }
        }
    } break;
    case 1: case 11: { const int uu = 3 * layer + (sub == 1 ? 0 : 2);
        run_gemm(lds, H, (const bf16*)(p.ws + W_GU), M_TOK, 5632, 1024, EpiSwigluN{R1, ssb, cvb + (size_t)(uu & 1) * CV_STRIDE}); } break;
    case 2: case 12: {
        const bool first = layer == 0 && sub == 2;
        const float* xp = first ? p.in[0] : x; const float* xs = first ? p.in[1] : x + (size_t)MP * DM;
        const float* gate = mod + (size_t)layer * 9 * 9216 + (sub == 2 ? 2 : 8) * 1024;
        if (layer == 1 && sub == 12) { const EpiResid E{xp, xs, x, gate, 0.5f}; run_gemm(lds, R1, (const bf16*)(p.ws + W_DOWN), M_TOK, 1024, 2816, E); }
        else {
            const int ln = sub == 12 ? layer + 1 : layer, jn = sub == 2 ? 1 : 0, uu = 3 * ln + jn;
            const EpiResidN E{xp, xs, x, gate, p.in[jn == 0 ? 10 : 11] + ln * 1024, mod + (size_t)ln * 9 * 9216 + (3 * jn + 1) * 1024, H, ssp, 0.5f};
            run_gemm(lds, R1, (const bf16*)(p.ws + W_DOWN), M_TOK, 1024, 2816, E);
        }
    } break;
    case 9: {
        const int uu = 3 * layer + 2;
        const EpiResidN E{x, x + (size_t)MP * DM, x, mod + (size_t)layer * 9 * 9216 + 5 * 1024, p.in[12] + layer * 1024, mod + (size_t)layer * 9 * 9216 + 7 * 1024, H, ssp, 1.0f};
        run_gemm(lds, (const bf16*)(p.ws + WS_MIX), (const bf16*)(p.ws + W_OUT), M_TOK, 1024, 1024, E);
    } break;
    case 4: {
        const int N = layer == 0 ? 4096 : 2304, ld = layer == 0 ? LDP0 : LDP1, uu = 3 * layer + 1;
        run_gemm(lds, H, (const bf16*)(p.ws + W_IN), M_TOK, N, 1024, EpiStoreN{R1, ld, ld, ssb, cvb + (size_t)(uu & 1) * CV_STRIDE, N});
    } break;
    case 5: if (layer == 0) ph_lora_in(p); else ph_mla_prep(p, lds); break;
    case 6:
        if (layer == 0) run_gemm(lds, H, (const bf16*)(p.ws + W_LORA), M_TOK, 2560, 384, EpiLora{(bf16*)(p.ws + WS_R2), p.in[20], p.in[22]});
        else { run_gemm(lds, (const bf16*)(p.ws + WS_CKVA), (const bf16*)(p.ws + W_UKV), M_TOK + 2048, 1024, 256, EpiKV{(bf16*)(p.ws + WS_KV), (bf16*)(p.ws + WS_VT), M_TOK + 2048});
            run_gemm(lds, H, (const bf16*)(p.ws + W_UQ), M_TOK, 768, 384, EpiQ{(bf16*)(p.ws + WS_Q), (const float*)(p.ws + WS_ROPE)}, 32); }
        break;
    case 7: if (layer == 0) ph_scan(p, lds); else ph_attn_hyena(p, lds, dummy); break;
    case 8: if (layer == 0) ph_post_ab(p, dummy); else ph_hy_transpose(p, lds); break;
    default: break;
    }
}

__global__ void __launch_bounds__(NTHREADS, 2) hybrid_fwd(P p) {
    extern __shared__ __attribute__((aligned(16))) unsigned char lds_raw[];
    LAS unsigned char* lds = (LAS unsigned char*)lds_raw;
    cg::grid_group grid = cg::this_grid();
    volatile LAS unsigned* bst = (volatile LAS unsigned*)(lds + LDS_BYTES - 64);
    if (threadIdx.x < 16) bst[threadIdx.x] = 0u;
    __syncthreads();
    XcdBarrier bar = xcd_barrier_post((unsigned*)(p.ws + WS_CTL) + 1024, bst);
#pragma unroll 1
    for (int k = p.ph_lo; k < p.ph_hi; ++k) {
        const int nrep = (DUP_PH >= 0 && k == DUP_PH) ? 2 : 1;
#pragma unroll 1
        for (int rep = 0; rep < nrep; ++rep) { run_phase(p, lds, k, rep + 1 < nrep); if (rep + 1 < nrep) __syncthreads(); }
        if (k + 1 < p.ph_hi) { if (p.ph_hi < 0) grid.sync(); else { xcd_barrier(bar);
        } }
    }
}

extern "C" void kernel_launch(void* const* d_in, const int* in_sizes, int n_in, void* d_out, int out_size, void* d_ws, size_t ws_size, hipStream_t stream) {
    static int grid = 0;
    if (grid == 0) {
        if (n_in != 48 || out_size != 25427968 || ws_size < WS_END) {
            fprintf(stderr, "kernel_launch: expected 48 inputs, 25427968 outputs, >= %zu B workspace; got %d, %d, %zu\n", (size_t)WS_END, n_in, out_size, ws_size);
            grid = -1; return;
        }
        int dev = 0, cus = 0, per_cu = 0;
        hipGetDevice(&dev);
        hipDeviceGetAttribute(&cus, hipDeviceAttributeMultiprocessorCount, dev);
        hipFuncSetAttribute((const void*)hybrid_fwd, hipFuncAttributeMaxDynamicSharedMemorySize, LDS_BYTES);
        hipOccupancyMaxActiveBlocksPerMultiprocessor(&per_cu, (const void*)hybrid_fwd, NTHREADS, LDS_BYTES);
        if (per_cu < 1) { fprintf(stderr, "kernel_launch: occupancy query says %d blocks/CU\n", per_cu); per_cu = 1; }
        (void)hipGetLastError();
        grid = cus;
    }
    if (grid < 0) return;
    (void)hipMemsetAsync((char*)d_ws + WS_CTL, 0, 24 * 1024, stream);
    P prm{};
    for (int i = 0; i < 48; ++i) prm.in[i] = (const float*)d_in[i];
    prm.out = (float*)d_out; prm.ws = (unsigned char*)d_ws;
#ifndef N_SPLIT
    prm.ph_lo = 0; prm.ph_hi = 28;
    void* args[] = {&prm};
    hipError_t e = hipLaunchCooperativeKernel((const void*)hybrid_fwd, dim3(grid), dim3(NTHREADS), args, LDS_BYTES, stream);
    if (e != hipSuccess) fprintf(stderr, "cooperative launch failed: %s (grid %d)\n", hipGetErrorString(e), grid);
#else
    for (int k = 0; k < 28; ++k) {
        prm.ph_lo = k; prm.ph_hi = k + 1;
        void* args[] = {&prm};
        hipError_t e = hipLaunchCooperativeKernel((const void*)hybrid_fwd, dim3(grid), dim3(NTHREADS), args, LDS_BYTES, stream);
        if (e != hipSuccess) { fprintf(stderr, "launch %d failed: %s\n", k, hipGetErrorString(e)); break; }
    }
#endif
}
```

```cpp
#include <hip/hip_runtime.h>
#include <hip/hip_cooperative_groups.h>
#include <cstdio>
#include <cstdint>
namespace cg = cooperative_groups;

#define LAS __attribute__((address_space(3)))
typedef unsigned short bf16;
typedef float f32x2 __attribute__((ext_vector_type(2)));
typedef float f32x4 __attribute__((ext_vector_type(4)));
typedef float f32x16 __attribute__((ext_vector_type(16)));
typedef unsigned u32x2 __attribute__((ext_vector_type(2)));
typedef unsigned u32x4 __attribute__((ext_vector_type(4)));
typedef short s16x8 __attribute__((ext_vector_type(8)));

constexpr int M_TOK = 16384, MP = 8192, DM = 1024, DFF = 2816;
constexpr int LDP0 = 3984, LDP1 = 2304;
constexpr int OUT_YS = 8388608, OUT_SRW = 16777216, OUT_SGD = 18874368, OUT_CKV = 23068672, OUT_KPE = 25165824;

constexpr size_t MiB = 1ull << 20;
constexpr size_t WS_CTL = 0;
constexpr size_t WS_SS = 64 * 1024;
constexpr size_t WS_ROPE = 512 * 1024;
constexpr size_t WS_CV = 2 * 1048576 + 16 * 1048576 + 524288;
constexpr int CV_STRIDE = 9 * 5632;
constexpr size_t WS_MOD = 1 * MiB;
constexpr size_t WS_W = 2 * MiB;
constexpr size_t W_GU = WS_W, W_DOWN = WS_W + 11 * MiB;
constexpr size_t W_IN = WS_W, W_OUT = WS_W + 8 * MiB, W_LORA = WS_W + 10 * MiB, W_UQ = WS_W + 12 * MiB, W_UKV = WS_W + 13 * MiB;
constexpr size_t WS_H = 19 * MiB;
constexpr size_t WS_MIX = 51 * MiB;
constexpr size_t WS_R1 = 83 * MiB;
constexpr size_t R1_BYTES = 130547712;
constexpr size_t WS_HYIN = WS_R1 + 72 * MiB;
constexpr size_t WS_R2 = WS_R1 + R1_BYTES;
constexpr size_t WS_Q = WS_R2, WS_KV = WS_R2 + 24 * MiB, WS_VT = WS_R2 + 42 * MiB, WS_CKVA = WS_R2 + 60 * MiB, WS_KPEA = WS_R2 + 69 * MiB, WS_GFS = WS_R2 + 71 * MiB, WS_GFP = WS_R2 + 75 * MiB;
constexpr size_t WS_END = WS_R2 + 80 * MiB;

constexpr int LDS_BYTES = 159744;
constexpr int NTHREADS = 512;

struct P {
    const float* in[48];
    float* out;
    unsigned char* ws;
    int ph_lo, ph_hi;
};

__device__ __forceinline__ float bf2f(unsigned b) { return __uint_as_float(b << 16); }
__device__ __forceinline__ float bflo(unsigned w) { return __uint_as_float(w << 16); }
__device__ __forceinline__ float bfhi(unsigned w) { return __uint_as_float(w & 0xffff0000u); }
typedef __bf16 bf16x2_t __attribute__((ext_vector_type(2)));
__device__ __forceinline__ unsigned pk2(float lo, float hi) { const f32x2 v = {lo, hi}; return __builtin_bit_cast(unsigned, __builtin_convertvector(v, bf16x2_t)); }
__device__ __forceinline__ f32x4 unpk4(u32x2 w) { return (f32x4){bflo(w.x), bfhi(w.x), bflo(w.y), bfhi(w.y)}; }
__device__ __forceinline__ u32x2 pk4(f32x4 v) { return (u32x2){pk2(v.x, v.y), pk2(v.z, v.w)}; }
__device__ __forceinline__ float wave_sum(float v) {
#pragma unroll
    for (int o = 1; o < 64; o <<= 1) v += __shfl_xor(v, o);
    return v;
}
__device__ __forceinline__ float dpp_f(float x, int) { return x; }
#define DPPF(x, ctrl) __int_as_float(__builtin_amdgcn_update_dpp(0, __float_as_int(x), (ctrl), 0xF, 0xF, true))
__device__ __forceinline__ float red4(float x) { x += DPPF(x, 0xB1); x += DPPF(x, 0x4E); return x; }
__device__ __forceinline__ float red8(float x) { x = red4(x); x += DPPF(x, 0x141); return x; }
__device__ __forceinline__ float red16(float x) { x = red8(x); x += DPPF(x, 0x140); return x; }
__device__ __forceinline__ float sigmoidf_(float x) { return __builtin_amdgcn_rcpf(1.0f + __expf(-x)); }
__device__ __forceinline__ float siluf_(float x) { return x * __builtin_amdgcn_rcpf(1.0f + __expf(-x)); }
__device__ __forceinline__ float rsqrtf_(float x) { return __builtin_amdgcn_rsqf(x); }
__device__ __forceinline__ int cond_of_row(int row) { return row < MP ? 0 : 1 + ((row - MP) >> 10); }
__device__ __forceinline__ int tid_opaque() { int t = threadIdx.x; asm volatile("" : "+v"(t)); return t; }
#define LDS_WAIT() asm volatile("s_waitcnt lgkmcnt(0)" ::: "memory")

namespace pg8 {
#define PG8_LAS __attribute__((address_space(3)))
typedef unsigned short bf16_t;
typedef short bf16x8 __attribute__((ext_vector_type(8)));
typedef float f32x4 __attribute__((ext_vector_type(4)));
typedef unsigned u32x4 __attribute__((ext_vector_type(4)));
constexpr int BM = 256, BK = 64, HALF = 128, HTB = HALF * BK * 2  , STAGE_BYTES = 8 * HTB, NXCD = 8, WGM = 4;

__host__ __device__ __forceinline__ int lds_byte(int r, int c) { const int st = (r >> 4) * 2 + (c >> 5), rr = r & 15, cc = c & 31, ob = rr * 64 + cc * 2; return st * 1024 + (ob ^ (((ob >> 9) & 1) << 5)); }
__host__ __device__ __forceinline__ void stage_rc(int b, int& R, int& C) { const int st = b / 1024, sb = b % 1024, swz = sb ^ (((sb >> 9) & 1) << 5); R = (st >> 1) * 16 + swz / 64; C = (st & 1) * 32 + (swz % 64) / 2; }
__host__ __device__ __forceinline__ int perm32(int rho) { const int n = rho >> 4, i = rho & 15; return 8 * (i >> 2) + 4 * n + (i & 3); }

struct Unit { int pm, pn; };
struct Gemm { const bf16_t* A; const bf16_t* Bt; int M, N, K; };

struct StaticOrder {
    int nM, nN, nwg, G, c;
    __host__ __device__ void init(int M, int N, int G_, int c_) { nM = M / BM; nN = N / BM; nwg = nM * nN; G = G_; c = c_; }
    __host__ __device__ bool next(int i, Unit& u) const {
        const long L = (long)i * G + c; if (L >= nwg) return false;
        int wgid = (int)L; { const int q = nwg / NXCD, r = nwg % NXCD, xcd = wgid % NXCD, off = wgid / NXCD; wgid = (xcd < r ? xcd * (q + 1) : r * (q + 1) + (xcd - r) * q) + off; }
        const int nig = WGM * nN, gid = wgid / nig, fm = gid * WGM, gsz = (nM - fm) < WGM ? (nM - fm) : WGM;
        u.pm = fm + ((wgid % nig) % gsz); u.pn = (wgid % nig) / gsz; return true;
    }
    __device__ __forceinline__ void a_ready(const Unit&) const {}
    __device__ __forceinline__ void done(const Unit&) const {}
};
__device__ __forceinline__ unsigned cvt_pk_bf16(float lo, float hi) { unsigned r; asm volatile("v_cvt_pk_bf16_f32 %0, %1, %2" : "=v"(r) : "v"(lo), "v"(hi)); return r; }
typedef float f32x2 __attribute__((ext_vector_type(2)));
template <class Epi, class Sched, bool ALIGN_EPI = false, bool SP2 = false>
__device__ __forceinline__ void gemm_phase(PG8_LAS unsigned char* lds, const Gemm g, const Sched& S, const Epi& E) {
    const int tid = tid_opaque(), wid = __builtin_amdgcn_readfirstlane(tid >> 6), lane = tid & 63, wr = wid >> 2, wc = wid & 3, fr = lane & 15, fq = lane >> 4;
    const int K = g.K, nt = K / BK;
    unsigned voffA[2], voffB[2];
#pragma unroll
    for (int i = 0; i < 2; ++i) { int R, C; stage_rc(tid * 16 + i * 8192, R, C); const int Rb = Epi::PERM ? ((R & ~31) + perm32(R & 31)) : R;
        voffA[i] = (unsigned)(R * K + C) * 2u; voffB[i] = (unsigned)(Rb * K + C) * 2u; }
    const size_t kstep = (size_t)(BK * 2);
    const size_t hstep = (size_t)HALF * K * 2;
    const size_t tstep = 2 * hstep;
    const unsigned ldsw = (unsigned)wid * 1024u;
    const int aoff = lds_byte(wr * 64 + fr, fq * 8), boff = lds_byte(wc * 32 + fr, fq * 8);
#define PG8_SA(b, h) (((b) * 2 + (h)) * HTB)
#define PG8_SB(b, h) ((4 + (b) * 2 + (h)) * HTB)
#define PG8_STAGE(bufoff, gbase, voff) do { _Pragma("unroll") for (int _i = 0; _i < 2; ++_i) \
        __builtin_amdgcn_global_load_lds((const unsigned*)((const char*)(gbase) + (voff)[_i]), (PG8_LAS unsigned*)(lds + (bufoff) + ldsw + _i * 8192), 16, 0, 0); } while (0)
#define PG8_LDA(dst, b, h) do { _Pragma("unroll") for (int m = 0; m < 4; ++m) _Pragma("unroll") for (int k = 0; k < 2; ++k) dst[m][k] = *(const PG8_LAS bf16x8*)(lds + PG8_SA(b, h) + aoff + m * 2048 + k * 1024); } while (0)
#define PG8_LDB(dst, b, h) do { _Pragma("unroll") for (int n = 0; n < 2; ++n) _Pragma("unroll") for (int k = 0; k < 2; ++k) dst[n][k] = *(const PG8_LAS bf16x8*)(lds + PG8_SB(b, h) + boff + n * 2048 + k * 1024); } while (0)
#define PG8_MMA(ai, bj, At, Bt) do { __builtin_amdgcn_s_setprio(1); _Pragma("unroll") for (int m = 0; m < 4; ++m) _Pragma("unroll") for (int n = 0; n < 2; ++n) _Pragma("unroll") for (int k = 0; k < 2; ++k) \
        acc[ai][bj][m][n] = __builtin_amdgcn_mfma_f32_16x16x32_bf16(Bt[n][k], At[m][k], acc[ai][bj][m][n], 0, 0, 0); __builtin_amdgcn_s_setprio(0); } while (0)
#define PG8_WAIT_V(n) asm volatile("s_waitcnt vmcnt(" #n ")" ::: "memory")
#define PG8_WAIT_L(n) asm volatile("s_waitcnt lgkmcnt(" #n ")" ::: "memory")
#define PG8_BAR __builtin_amdgcn_s_barrier()
#define PG8_SCHED __builtin_amdgcn_sched_barrier(0)
    Unit cur, nxt; int ui = 0;
    if (!S.next(0, cur)) return;
    f32x4 acc[2][2][4][2];
#pragma unroll
    for (int a = 0; a < 2; ++a)
#pragma unroll
        for (int b = 0; b < 2; ++b)
#pragma unroll
            for (int m = 0; m < 4; ++m)
#pragma unroll
                for (int n = 0; n < 2; ++n) acc[a][b][m][n] = (f32x4){0.f, 0.f, 0.f, 0.f};
    bf16x8 At[4][2], B0[2][2], B1[2][2];
    const char* cA = (const char*)g.A + (size_t)cur.pm * tstep; const char* cB = (const char*)g.Bt + (size_t)cur.pn * tstep;
    S.a_ready(cur);
    if constexpr (SP2) {
        PG8_STAGE(PG8_SB(0, 0), cB, voffB); PG8_STAGE(PG8_SB(0, 1), cB + hstep, voffB); PG8_STAGE(PG8_SA(0, 0), cA, voffA); PG8_STAGE(PG8_SA(0, 1), cA + hstep, voffA);
        if (wr == 1) PG8_BAR;
        PG8_WAIT_V(2); PG8_BAR;
        PG8_STAGE(PG8_SB(1, 0), cB + kstep, voffB); PG8_STAGE(PG8_SA(1, 0), cA + kstep, voffA); PG8_STAGE(PG8_SB(1, 1), cB + hstep + kstep, voffB);
        PG8_WAIT_V(6); PG8_BAR;
    } else {
        PG8_STAGE(PG8_SB(0, 0), cB, voffB); PG8_STAGE(PG8_SA(0, 0), cA, voffA); PG8_STAGE(PG8_SB(0, 1), cB + hstep, voffB); PG8_STAGE(PG8_SA(0, 1), cA + hstep, voffA);
        if (wr == 1) PG8_BAR;
        PG8_WAIT_V(4); PG8_BAR;
        PG8_STAGE(PG8_SB(1, 0), cB + kstep, voffB); PG8_STAGE(PG8_SA(1, 0), cA + kstep, voffA); PG8_STAGE(PG8_SB(1, 1), cB + hstep + kstep, voffB);
        PG8_WAIT_V(6); PG8_BAR;
    }
    for (;;) {
        const bool has_next = S.next(ui + 1, nxt);
        const char* nA = has_next ? (const char*)g.A + (size_t)nxt.pm * tstep : cA; const char* nB = has_next ? (const char*)g.Bt + (size_t)nxt.pn * tstep : cB;
#pragma unroll 1
        for (int t = 0; t < nt; t += 2) {
            const bool last = (t == nt - 2);
            const char* a1 = cA + (size_t)(t + 1) * kstep;
            const char* a2 = last ? nA : cA + (size_t)(t + 2) * kstep; const char* b2 = last ? nB : cB + (size_t)(t + 2) * kstep;
            const char* a3 = a2 + kstep; const char* b3 = b2 + kstep;
            if (last && has_next) S.a_ready(nxt);
            if constexpr (SP2) {
            PG8_LDB(B0, 0, 0); PG8_LDB(B1, 0, 1); PG8_SCHED; PG8_LDA(At, 0, 0); PG8_STAGE(PG8_SA(1, 1), a1 + hstep, voffA);
            PG8_WAIT_V(8); PG8_WAIT_L(0); PG8_BAR; PG8_MMA(0, 0, At, B0); PG8_MMA(0, 1, At, B1); PG8_BAR; PG8_SCHED;
            PG8_LDA(At, 0, 1); PG8_STAGE(PG8_SB(0, 0), b2, voffB); PG8_STAGE(PG8_SB(0, 1), b2 + hstep, voffB); PG8_STAGE(PG8_SA(0, 0), a2, voffA);
            PG8_WAIT_V(8); PG8_WAIT_L(0); PG8_BAR; PG8_MMA(1, 0, At, B0); PG8_MMA(1, 1, At, B1); PG8_BAR; PG8_SCHED;
            PG8_LDB(B0, 1, 0); PG8_LDB(B1, 1, 1); PG8_SCHED; PG8_LDA(At, 1, 0); PG8_STAGE(PG8_SA(0, 1), a2 + hstep, voffA);
            PG8_WAIT_V(8); PG8_WAIT_L(0); PG8_BAR; PG8_MMA(0, 0, At, B0); PG8_MMA(0, 1, At, B1); PG8_BAR; PG8_SCHED;
            PG8_LDA(At, 1, 1); PG8_STAGE(PG8_SB(1, 0), b3, voffB); PG8_STAGE(PG8_SB(1, 1), b3 + hstep, voffB); PG8_STAGE(PG8_SA(1, 0), a3, voffA);
            PG8_WAIT_V(8); PG8_WAIT_L(0); PG8_BAR; PG8_MMA(1, 0, At, B0); PG8_MMA(1, 1, At, B1); PG8_BAR; PG8_SCHED;
            } else {
            PG8_LDB(B0, 0, 0); PG8_SCHED; PG8_LDA(At, 0, 0); PG8_STAGE(PG8_SA(1, 1), a1 + hstep, voffA);
            PG8_WAIT_L(8); PG8_BAR; PG8_WAIT_L(0); PG8_MMA(0, 0, At, B0); PG8_BAR; PG8_SCHED;
            PG8_LDB(B1, 0, 1); PG8_STAGE(PG8_SB(0, 0), b2, voffB);
            PG8_BAR; PG8_WAIT_L(0); PG8_MMA(0, 1, At, B1); PG8_BAR;
            PG8_LDA(At, 0, 1); PG8_STAGE(PG8_SA(0, 0), a2, voffA);
            PG8_BAR; PG8_WAIT_L(0); PG8_MMA(1, 0, At, B0); PG8_BAR; PG8_SCHED;
            PG8_STAGE(PG8_SB(0, 1), b2 + hstep, voffB);
            PG8_WAIT_V(6); PG8_BAR; PG8_MMA(1, 1, At, B1); PG8_BAR;
            PG8_LDB(B0, 1, 0); PG8_SCHED; PG8_LDA(At, 1, 0); PG8_STAGE(PG8_SA(0, 1), a2 + hstep, voffA);
            PG8_WAIT_L(8); PG8_BAR; PG8_WAIT_L(0); PG8_MMA(0, 0, At, B0); PG8_BAR; PG8_SCHED;
            PG8_LDB(B1, 1, 1); PG8_STAGE(PG8_SB(1, 0), b3, voffB);
            PG8_BAR; PG8_WAIT_L(0); PG8_MMA(0, 1, At, B1); PG8_BAR;
            PG8_LDA(At, 1, 1); PG8_STAGE(PG8_SA(1, 0), a3, voffA);
            PG8_BAR; PG8_WAIT_L(0); PG8_MMA(1, 0, At, B0); PG8_BAR; PG8_SCHED;
            PG8_STAGE(PG8_SB(1, 1), b3 + hstep, voffB);
            PG8_WAIT_V(6); PG8_BAR; PG8_MMA(1, 1, At, B1); PG8_BAR;
            }
        }
        if constexpr (ALIGN_EPI) { if (wr == 0) PG8_BAR; }
        if constexpr (!Epi::AFTER_DRAIN) { E(acc, cur, wr, wc, fr, fq); S.done(cur); }
        if (!has_next) break;
#pragma unroll
        for (int a = 0; a < 2; ++a)
#pragma unroll
            for (int b = 0; b < 2; ++b)
#pragma unroll
                for (int m = 0; m < 4; ++m)
#pragma unroll
                    for (int n = 0; n < 2; ++n) acc[a][b][m][n] = (f32x4){0.f, 0.f, 0.f, 0.f};
        cur = nxt; cA = nA; cB = nB; ++ui;
        if constexpr (ALIGN_EPI) { if (wr == 1) PG8_BAR; }
    }
    PG8_WAIT_V(0);
    if constexpr (!ALIGN_EPI) { if (wr == 0) PG8_BAR; }
    PG8_BAR;
    if constexpr (Epi::AFTER_DRAIN) { E.fused(acc, cur, wr, wc, fr, fq, lds, wid, lane); S.done(cur); }
#undef PG8_SA
#undef PG8_SB
#undef PG8_STAGE
#undef PG8_LDA
#undef PG8_LDB
#undef PG8_MMA
#undef PG8_WAIT_V
#undef PG8_WAIT_L
#undef PG8_BAR
#undef PG8_SCHED
}
}

using pg8::Unit;
typedef const f32x4 (&AccRef)[2][2][4][2];

struct EpiSwiglu {
    static constexpr bool PERM = true, AFTER_DRAIN = false;
    bf16* O;
    __device__ __forceinline__ void operator()(AccRef acc, const Unit& u, int wr, int wc, int fr, int fq) const {
        const int row0 = u.pm * 256 + wr * 64 + fr, col0 = u.pn * 128 + wc * 32 + 8 * fq;
#pragma unroll
        for (int ai = 0; ai < 2; ++ai)
#pragma unroll
            for (int m = 0; m < 4; ++m) {
                const f32x4 g0 = acc[ai][0][m][0], g1 = acc[ai][0][m][1], u0 = acc[ai][1][m][0], u1 = acc[ai][1][m][1];
                float v[8];
#pragma unroll
                for (int i = 0; i < 4; ++i) { v[i] = g0[i] * __builtin_amdgcn_rcpf(1.0f + __expf(-g0[i])) * u0[i]; v[4 + i] = g1[i] * __builtin_amdgcn_rcpf(1.0f + __expf(-g1[i])) * u1[i]; }
                u32x4 w; w.x = pk2(v[0], v[1]); w.y = pk2(v[2], v[3]); w.z = pk2(v[4], v[5]); w.w = pk2(v[6], v[7]);
                *(u32x4*)(O + (size_t)(row0 + ai * 128 + m * 16) * DFF + col0) = w;
            }
    }
};
struct EpiSwigluN {
    static constexpr bool PERM = true, AFTER_DRAIN = false;
    bf16* O; const float* ss; const float* cv;
    __device__ __forceinline__ void operator()(AccRef acc, const Unit& u, int wr, int wc, int fr, int fq) const {
        const int cond = u.pm < 32 ? 0 : 1 + ((u.pm - 32) >> 2);
        const int row0 = u.pm * 256 + wr * 64 + fr, col0 = u.pn * 128 + wc * 32 + 8 * fq, gc0 = u.pn * 256 + wc * 32 + 8 * fq;
        const float* cp = cv + (size_t)cond * 5632 + gc0;
        const f32x4 cg0 = *(const f32x4*)cp, cg1 = *(const f32x4*)(cp + 4), cu0 = *(const f32x4*)(cp + 128), cu1 = *(const f32x4*)(cp + 132);
#pragma unroll
        for (int ai = 0; ai < 2; ++ai)
#pragma unroll
            for (int m = 0; m < 4; ++m) {
                const int row = row0 + ai * 128 + m * 16;
                const float rs = ss[row];
                const f32x4 g0 = acc[ai][0][m][0] * rs + cg0, g1 = acc[ai][0][m][1] * rs + cg1, u0 = acc[ai][1][m][0] * rs + cu0, u1 = acc[ai][1][m][1] * rs + cu1;
                float v[8];
#pragma unroll
                for (int i = 0; i < 4; ++i) { v[i] = g0[i] * __builtin_amdgcn_rcpf(1.0f + __expf(-g0[i])) * u0[i]; v[4 + i] = g1[i] * __builtin_amdgcn_rcpf(1.0f + __expf(-g1[i])) * u1[i]; }
                u32x4 w; w.x = pk2(v[0], v[1]); w.y = pk2(v[2], v[3]); w.z = pk2(v[4], v[5]); w.w = pk2(v[6], v[7]);
                *(u32x4*)(O + (size_t)row * DFF + col0) = w;
            }
    }
};
struct EpiStoreN {
    static constexpr bool PERM = true, AFTER_DRAIN = false;
    bf16* O; int ldc; int ncols; const float* ss; const float* cv; int ncv;
    __device__ __forceinline__ void operator()(AccRef acc, const Unit& u, int wr, int wc, int fr, int fq) const {
        const int cond = u.pm < 32 ? 0 : 1 + ((u.pm - 32) >> 2);
        const int row0 = u.pm * 256 + wr * 64 + fr, col0 = u.pn * 256 + wc * 32 + 8 * fq;
        const float* cp = cv + (size_t)cond * ncv + col0;
        const f32x4 c00 = *(const f32x4*)cp, c01 = *(const f32x4*)(cp + 4), c10 = *(const f32x4*)(cp + 128), c11 = *(const f32x4*)(cp + 132);
#pragma unroll
        for (int ai = 0; ai < 2; ++ai)
#pragma unroll
            for (int m = 0; m < 4; ++m) {
                const int row = row0 + ai * 128 + m * 16;
                const float rs = ss[row];
                bf16* rowp = O + (size_t)row * ldc;
#pragma unroll
                for (int bj = 0; bj < 2; ++bj) { const int col = col0 + bj * 128;
                    const f32x4 v0 = acc[ai][bj][m][0] * rs + (bj ? c10 : c00), v1 = acc[ai][bj][m][1] * rs + (bj ? c11 : c01);
                    u32x4 w; w.x = pk2(v0[0], v0[1]); w.y = pk2(v0[2], v0[3]); w.z = pk2(v1[0], v1[1]); w.w = pk2(v1[2], v1[3]);
                    if (col < ncols) *(u32x4*)(rowp + col) = w; }
            }
    }
};
struct EpiResidN {
    static constexpr bool PERM = true, AFTER_DRAIN = false;
    const float* xin_p; const float* xin_s; float* xout; const float* gate_base;
    const float* gnext; const float* scn_base; bf16* xg; float* ss; float coef;
    __device__ __forceinline__ void operator()(AccRef acc, const Unit& u, int wr, int wc, int fr, int fq) const {
        const int cond = u.pm < 32 ? 0 : 1 + ((u.pm - 32) >> 2);
        const float* gate = gate_base + (size_t)cond * 9216; const float* scn = scn_base + (size_t)cond * 9216;
        const int row0 = u.pm * 256 + wr * 64 + fr, col0 = u.pn * 256 + wc * 32 + 8 * fq;
        float sq[2][4];
#pragma unroll
        for (int ai = 0; ai < 2; ++ai)
#pragma unroll
            for (int m = 0; m < 4; ++m) sq[ai][m] = 0.f;
        const float* xb = u.pm < 32 ? xin_p : xin_s - (size_t)MP * DM;
        const unsigned off0 = (unsigned)(row0 * DM + col0);
#pragma unroll
        for (int bj = 0; bj < 2; ++bj) {
            const int col = col0 + bj * 128;
            f32x4 gv[2], G[2];
#pragma unroll
            for (int n = 0; n < 2; ++n) { gv[n] = *(const f32x4*)(gate + col + 4 * n) * coef; G[n] = *(const f32x4*)(gnext + col + 4 * n) * (*(const f32x4*)(scn + col + 4 * n) + 1.0f); }
#pragma unroll
            for (int ai = 0; ai < 2; ++ai) {
                f32x4 xv[4][2];
#pragma unroll
                for (int m = 0; m < 4; ++m)
#pragma unroll
                    for (int n = 0; n < 2; ++n) xv[m][n] = *(const f32x4*)(xb + (off0 + (unsigned)((ai * 128 + m * 16) * DM + bj * 128 + 4 * n)));
                asm volatile("" ::: "memory");
#pragma unroll
                for (int m = 0; m < 4; ++m) {
                    const unsigned off = off0 + (unsigned)((ai * 128 + m * 16) * DM + bj * 128);
                    const f32x4 x0 = xv[m][0] + gv[0] * acc[ai][bj][m][0], x1 = xv[m][1] + gv[1] * acc[ai][bj][m][1];
                    *(f32x4*)(xout + off) = x0; *(f32x4*)(xout + off + 4) = x1;
                    const u32x2 w0 = pk4(x0 * G[0]), w1 = pk4(x1 * G[1]);
                    *(u32x4*)(xg + off) = (u32x4){w0.x, w0.y, w1.x, w1.y};
                    sq[ai][m] += x0.x * x0.x + x0.y * x0.y + x0.z * x0.z + x0.w * x0.w + x1.x * x1.x + x1.y * x1.y + x1.z * x1.z + x1.w * x1.w;
                }
                asm volatile("" ::: "memory");
            }
        }
#pragma unroll
        for (int ai = 0; ai < 2; ++ai)
#pragma unroll
            for (int m = 0; m < 4; ++m) {
                float t = sq[ai][m]; t += __shfl_xor(t, 16); t += __shfl_xor(t, 32);
                if (fq == 0) ss[(u.pn * 4 + wc) * M_TOK + row0 + ai * 128 + m * 16] = t;
            }
    }
};
struct EpiResid {
    static constexpr bool PERM = true, AFTER_DRAIN = false;
    const float* xin_p; const float* xin_s; float* xout; const float* gate_base; float coef;
    __device__ __forceinline__ void operator()(AccRef acc, const Unit& u, int wr, int wc, int fr, int fq) const {
        const int cond = u.pm < 32 ? 0 : 1 + ((u.pm - 32) >> 2);
        const float* gate = gate_base + (size_t)cond * 9216;
        const int row0 = u.pm * 256 + wr * 64 + fr, col0 = u.pn * 256 + wc * 32 + 8 * fq;
        const float* xb = u.pm < 32 ? xin_p : xin_s - (size_t)MP * DM;
        const unsigned off0 = (unsigned)(row0 * DM + col0);
#pragma unroll
        for (int bj = 0; bj < 2; ++bj) {
            const f32x4 gv0 = *(const f32x4*)(gate + col0 + bj * 128) * coef, gv1 = *(const f32x4*)(gate + col0 + bj * 128 + 4) * coef;
#pragma unroll
            for (int ai = 0; ai < 2; ++ai) {
                f32x4 xv[4][2];
#pragma unroll
                for (int m = 0; m < 4; ++m)
#pragma unroll
                    for (int n = 0; n < 2; ++n) xv[m][n] = *(const f32x4*)(xb + (off0 + (unsigned)((ai * 128 + m * 16) * DM + bj * 128 + 4 * n)));
                asm volatile("" ::: "memory");
#pragma unroll
                for (int m = 0; m < 4; ++m) {
                    const unsigned off = off0 + (unsigned)((ai * 128 + m * 16) * DM + bj * 128);
                    *(f32x4*)(xout + off) = xv[m][0] + gv0 * acc[ai][bj][m][0]; *(f32x4*)(xout + off + 4) = xv[m][1] + gv1 * acc[ai][bj][m][1];
                }
                asm volatile("" ::: "memory");
            }
        }
    }
};
struct EpiStore {
    static constexpr bool PERM = true, AFTER_DRAIN = false;
    bf16* O; int ldc; int ncols;
    __device__ __forceinline__ void operator()(AccRef acc, const Unit& u, int wr, int wc, int fr, int fq) const {
        const int row0 = u.pm * 256 + wr * 64 + fr, col0 = u.pn * 256 + wc * 32 + 8 * fq;
#pragma unroll
        for (int ai = 0; ai < 2; ++ai)
#pragma unroll
            for (int m = 0; m < 4; ++m) {
                bf16* rowp = O + (size_t)(row0 + ai * 128 + m * 16) * ldc;
#pragma unroll
                for (int bj = 0; bj < 2; ++bj) { const int col = col0 + bj * 128; const f32x4 v0 = acc[ai][bj][m][0], v1 = acc[ai][bj][m][1];
                    u32x4 w; w.x = pk2(v0[0], v0[1]); w.y = pk2(v0[2], v0[3]); w.z = pk2(v1[0], v1[1]); w.w = pk2(v1[2], v1[3]);
                    if (col < ncols) *(u32x4*)(rowp + col) = w; }
            }
    }
};
struct EpiLora {
    static constexpr bool PERM = true, AFTER_DRAIN = false;
    bf16* O; const float* w0; const float* a0;
    __device__ __forceinline__ void operator()(AccRef acc, const Unit& u, int wr, int wc, int fr, int fq) const {
        const int seg = u.pn >> 1;
        const float* bias = seg < 2 ? w0 + seg * 512 : a0 + (seg & 1) * 512;
        const int row0 = u.pm * 256 + wr * 64 + fr, ct0 = wc * 32 + 8 * fq;
#pragma unroll
        for (int bj = 0; bj < 2; ++bj) {
            const int cseg = (u.pn & 1) * 256 + ct0 + bj * 128;
            f32x4 b0 = {0.f, 0.f, 0.f, 0.f}, b1 = {0.f, 0.f, 0.f, 0.f};
            if (seg < 4) { b0 = *(const f32x4*)(bias + cseg); b1 = *(const f32x4*)(bias + cseg + 4); }
#pragma unroll
            for (int ai = 0; ai < 2; ++ai)
#pragma unroll
                for (int m = 0; m < 4; ++m) {
                    f32x4 v0 = acc[ai][bj][m][0] + b0, v1 = acc[ai][bj][m][1] + b1;
                    if (seg < 4) {
                        const float sc = seg < 2 ? 0.60653066f : 1.0f;
#pragma unroll
                        for (int i = 0; i < 4; ++i) { v0[i] = sc * sigmoidf_(v0[i]); v1[i] = sc * sigmoidf_(v1[i]); }
                    }
                    u32x4 w; w.x = pk2(v0[0], v0[1]); w.y = pk2(v0[2], v0[3]); w.z = pk2(v1[0], v1[1]); w.w = pk2(v1[2], v1[3]);
                    *(u32x4*)(O + (size_t)(row0 + ai * 128 + m * 16) * 2560 + u.pn * 256 + ct0 + bj * 128) = w;
                    asm volatile("" ::: "memory");
                }
        }
    }
};
struct EpiQ {
    static constexpr bool PERM = true, AFTER_DRAIN = false;
    bf16* O; const float* rope;
    __device__ __forceinline__ void operator()(AccRef acc, const Unit& u, int wr, int wc, int fr, int fq) const {
        const int row0 = u.pm * 256 + wr * 64 + fr, col0 = u.pn * 256 + wc * 32 + 8 * fq;
        const float qs = 0.10206207261596577f;
#pragma unroll
        for (int bj = 0; bj < 2; ++bj) {
            const int col = col0 + bj * 128, e0 = col % 96;
            const bool is_rope = e0 >= 64;
#pragma unroll
            for (int ai = 0; ai < 2; ++ai)
#pragma unroll
                for (int m = 0; m < 4; ++m) {
                    const int row = row0 + ai * 128 + m * 16;
                    f32x4 v0 = acc[ai][bj][m][0] * qs, v1 = acc[ai][bj][m][1] * qs;
                    if (is_rope && row >= MP) {
                        const int t = (row - MP) & 1023;
                        const float* rt = rope + (size_t)t * 32 + (e0 - 64);
                        const f32x4 c0 = *(const f32x4*)(rt), c1 = *(const f32x4*)(rt + 4);
                        f32x4 r0, r1;
                        r0[0] = v0[0] * c0[0] - v0[1] * c0[1]; r0[1] = v0[0] * c0[1] + v0[1] * c0[0];
                        r0[2] = v0[2] * c0[2] - v0[3] * c0[3]; r0[3] = v0[2] * c0[3] + v0[3] * c0[2];
                        r1[0] = v1[0] * c1[0] - v1[1] * c1[1]; r1[1] = v1[0] * c1[1] + v1[1] * c1[0];
                        r1[2] = v1[2] * c1[2] - v1[3] * c1[3]; r1[3] = v1[2] * c1[3] + v1[3] * c1[2];
                        v0 = r0; v1 = r1;
                    }
                    u32x4 w; w.x = pk2(v0[0], v0[1]); w.y = pk2(v0[2], v0[3]); w.z = pk2(v1[0], v1[1]); w.w = pk2(v1[2], v1[3]);
                    *(u32x4*)(O + (size_t)row * 768 + col) = w;
                    asm volatile("" ::: "memory");
                }
        }
    }
};

struct EpiKV {
    static constexpr bool PERM = true, AFTER_DRAIN = false;
    bf16* KN; bf16* VT; int nrows;
    __device__ __forceinline__ void operator()(AccRef acc, const Unit& u, int wr, int wc, int fr, int fq) const {
        const int row0 = u.pm * 256 + wr * 64 + fr, col0 = u.pn * 256 + wc * 32 + 8 * fq;
#pragma unroll
        for (int bj = 0; bj < 2; ++bj) {
            const int col = col0 + bj * 128, head = col >> 7, e0 = col & 127;
#pragma unroll
            for (int ai = 0; ai < 2; ++ai)
#pragma unroll
                for (int m = 0; m < 4; ++m) {
                    const int row = row0 + ai * 128 + m * 16;
                    const f32x4 v0 = acc[ai][bj][m][0], v1 = acc[ai][bj][m][1];
                    u32x4 w; w.x = pk2(v0[0], v0[1]); w.y = pk2(v0[2], v0[3]); w.z = pk2(v1[0], v1[1]); w.w = pk2(v1[2], v1[3]);
                    if (e0 < 64) *(u32x4*)(KN + (size_t)row * 512 + head * 64 + e0) = w;
                    else { bf16* vp = VT + (size_t)(head * 64 + e0 - 64) * nrows + row;
#pragma unroll
                        for (int i = 0; i < 4; ++i) { vp[(size_t)(2 * i) * nrows] = (bf16)(w[i] & 0xffffu); vp[(size_t)(2 * i + 1) * nrows] = (bf16)(w[i] >> 16); } }
                }
        }
    }
};

__device__ __forceinline__ void adaln_layer(const P& p, LAS unsigned char* lds, int l, int bfirst) {
    LAS float* scv = (LAS float*)lds;
    LAS float* red = scv + 9 * 1024;
    const int tid = tid_opaque(), tx = tid % 18, ty = tid / 18;
    const float* cc = p.in[6]; const float* cctx = p.in[7];
    float* mod = (float*)(p.ws + WS_MOD);
    if ((int)blockIdx.x < bfirst) return;
    __syncthreads();
    for (int i = tid; i < 9 * 1024; i += NTHREADS) { const int c = i >> 10, k = i & 1023; const float v = c == 0 ? cctx[k] : cc[(c - 1) * 1024 + k]; scv[i] = v / (1.0f + expf(-v)); }
    __syncthreads();
    for (int cgp = blockIdx.x - bfirst; cgp < 128; cgp += gridDim.x - bfirst) {
        const int col0 = cgp * 72 + tx * 4;
        const float* W = p.in[8] + (size_t)l * 1024 * 9216;
        f32x4 acc[9];
#pragma unroll
        for (int c = 0; c < 9; ++c) acc[c] = (f32x4){0.f, 0.f, 0.f, 0.f};
        if (ty < 28) {
#pragma unroll 8
            for (int k = ty; k < 1024; k += 28) {
                const f32x4 w = *(const f32x4*)(W + (size_t)k * 9216 + col0);
#pragma unroll
                for (int c = 0; c < 9; ++c) acc[c] += w * scv[c * 1024 + k];
            }
#pragma unroll
            for (int c = 0; c < 9; ++c) *(LAS f32x4*)(red + ty * 648 + c * 72 + tx * 4) = acc[c];
        }
        __syncthreads();
        for (int o = tid; o < 648; o += NTHREADS) {
            float s = 0.f;
            for (int y = 0; y < 28; ++y) s += red[y * 648 + o];
            const int c = o / 72, j = o % 72;
            mod[(size_t)(l * 9 + c) * 9216 + cgp * 72 + j] = s + p.in[9][l * 9216 + cgp * 72 + j];
        }
        __syncthreads();
    }
}
__device__ __forceinline__ void ph_rope_table(const P& p) {
    const int tid = tid_opaque();
    float* rope = (float*)(p.ws + WS_ROPE);
    for (int idx = blockIdx.x * NTHREADS + tid; idx < 1024 * 16; idx += gridDim.x * NTHREADS) {
        const int t = idx >> 4, i = idx & 15;
        const float pos = (float)(i < 8 ? (t >> 6) : (t & 63));
        const float inv = powf(10000.0f, -(float)(i & 7) / 8.0f);
        const float ang = pos * inv;
        rope[idx * 2] = cosf(ang); rope[idx * 2 + 1] = sinf(ang);
    }
}

__device__ __forceinline__ void norm_rows(const P& p, int layer, int j, const float* gvec, bool from_input) {
    const int tid = tid_opaque(), lane = tid & 63, wave = tid >> 6;
    const float* mod = (const float*)(p.ws + WS_MOD);
    const float* x = p.out;
    bf16* h = (bf16*)(p.ws + WS_H);
    const int nw = gridDim.x * 8;
    for (int row0 = blockIdx.x * 8 + wave; row0 < M_TOK; row0 += 4 * nw) {
        f32x4 v[4][4]; float ss[4];
#pragma unroll
        for (int r = 0; r < 4; ++r) {
            const int row = (row0 + r * nw) < M_TOK ? (row0 + r * nw) : (M_TOK - 1);
            const float* xr = from_input ? (row < MP ? p.in[0] + (size_t)row * DM : p.in[1] + (size_t)(row - MP) * DM) : x + (size_t)row * DM;
#pragma unroll
            for (int q = 0; q < 4; ++q) v[r][q] = *(const f32x4*)(xr + lane * 4 + 256 * q);
        }
#pragma unroll
        for (int r = 0; r < 4; ++r) { float s = 0.f;
#pragma unroll
            for (int q = 0; q < 4; ++q) s += v[r][q].x * v[r][q].x + v[r][q].y * v[r][q].y + v[r][q].z * v[r][q].z + v[r][q].w * v[r][q].w;
            ss[r] = s; }
#pragma unroll
        for (int o = 1; o < 64; o <<= 1) {
#pragma unroll
            for (int r = 0; r < 4; ++r) ss[r] += __shfl_xor(ss[r], o); }
#pragma unroll
        for (int r = 0; r < 4; ++r) {
            const int row = row0 + r * nw; if (row >= M_TOK) break;
            const float rstd = 1.0f / sqrtf(ss[r] * (1.0f / 1024.0f) + 1e-6f);
            const float* mrow = mod + (size_t)(layer * 9 + cond_of_row(row)) * 9216;
            const float* sh = mrow + (3 * j) * 1024; const float* sc = mrow + (3 * j + 1) * 1024;
#pragma unroll
            for (int q = 0; q < 4; ++q) {
                const int col = lane * 4 + 256 * q;
                const f32x4 g = *(const f32x4*)(gvec + col), s1 = *(const f32x4*)(sc + col), s0 = *(const f32x4*)(sh + col);
                const f32x4 y = (v[r][q] * rstd * g) * (s1 + 1.0f) + s0;
                *(u32x2*)(h + (size_t)row * DM + col) = pk4(y);
            }
        }
    }
}
__device__ __forceinline__ void first_rows(const P& p, const float* gvec, float* ss) {
    const int tid = tid_opaque(), lane = tid & 63, wave = tid >> 6;
    const float* mod = (const float*)(p.ws + WS_MOD);
    bf16* h = (bf16*)(p.ws + WS_H);
    const int nw = gridDim.x * 8;
    for (int row0 = blockIdx.x * 8 + wave; row0 < M_TOK; row0 += 4 * nw) {
        f32x4 v[4][4]; float sq[4];
#pragma unroll
        for (int r = 0; r < 4; ++r) {
            const int row = (row0 + r * nw) < M_TOK ? (row0 + r * nw) : (M_TOK - 1);
            const float* xr = row < MP ? p.in[0] + (size_t)row * DM : p.in[1] + (size_t)(row - MP) * DM;
#pragma unroll
            for (int q = 0; q < 4; ++q) v[r][q] = *(const f32x4*)(xr + lane * 4 + 256 * q);
        }
#pragma unroll
        for (int r = 0; r < 4; ++r) { float t = 0.f;
#pragma unroll
            for (int q = 0; q < 4; ++q) t += v[r][q].x * v[r][q].x + v[r][q].y * v[r][q].y + v[r][q].z * v[r][q].z + v[r][q].w * v[r][q].w;
            sq[r] = t; }
#pragma unroll
        for (int o = 1; o < 64; o <<= 1) {
#pragma unroll
            for (int r = 0; r < 4; ++r) sq[r] += __shfl_xor(sq[r], o); }
#pragma unroll
        for (int r = 0; r < 4; ++r) {
            const int row = row0 + r * nw; if (row >= M_TOK) break;
            if (lane == 0) ss[row] = rsqrtf_(sq[r] * (1.0f / 1024.0f) + 1e-6f);
            const float* sc = mod + (size_t)cond_of_row(row) * 9216 + 1024;
#pragma unroll
            for (int q = 0; q < 4; ++q) { const int col = lane * 4 + 256 * q;
                *(u32x2*)(h + (size_t)row * DM + col) = pk4(v[r][q] * (*(const f32x4*)(gvec + col) * (*(const f32x4*)(sc + col) + 1.0f))); }
        }
    }
}
__device__ __forceinline__ void final_norm_rows(const P& p) {
    const int tid = tid_opaque(), lane = tid & 63, wave = tid >> 6;
    float* x = p.out; const float* gvec = p.in[47];
    const int nw = gridDim.x * 8;
    for (int row0 = blockIdx.x * 8 + wave; row0 < M_TOK; row0 += 4 * nw) {
        f32x4 v[4][4]; float ss[4];
#pragma unroll
        for (int r = 0; r < 4; ++r) { const int row = (row0 + r * nw) < M_TOK ? (row0 + r * nw) : (M_TOK - 1);
#pragma unroll
            for (int q = 0; q < 4; ++q) v[r][q] = *(const f32x4*)(x + (size_t)row * DM + lane * 4 + 256 * q); }
#pragma unroll
        for (int r = 0; r < 4; ++r) { float s = 0.f;
#pragma unroll
            for (int q = 0; q < 4; ++q) s += v[r][q].x * v[r][q].x + v[r][q].y * v[r][q].y + v[r][q].z * v[r][q].z + v[r][q].w * v[r][q].w;
            ss[r] = s; }
#pragma unroll
        for (int o = 1; o < 64; o <<= 1) {
#pragma unroll
            for (int r = 0; r < 4; ++r) ss[r] += __shfl_xor(ss[r], o); }
#pragma unroll
        for (int r = 0; r < 4; ++r) { const int row = row0 + r * nw; if (row >= M_TOK) break;
            const float rstd = rsqrtf_(ss[r] * (1.0f / 1024.0f) + 1e-6f);
#pragma unroll
            for (int q = 0; q < 4; ++q) { const int col = lane * 4 + 256 * q; *(f32x4*)(x + (size_t)row * DM + col) = v[r][q] * rstd * *(const f32x4*)(gvec + col); } }
    }
}

template <int MODE>
__device__ __forceinline__ void transpose_w(const float* W, int ldw, int ncols_valid, int K, bf16* WT, int Nt, LAS unsigned char* lds, const float* shift = nullptr, float* cvo = nullptr, int ncv = 0, int rot = 0) {
    const int tid = tid_opaque(), lane = tid & 63, wave = tid >> 6;
    LAS float* scr = (LAS float*)(lds + wave * 16640);
    LAS float* shs = (LAS float*)(lds + 8 * 16640 + wave * 3072);
    const int nblk = Nt / 64, nitems = nblk * (K / 64);
    int vb = ((int)blockIdx.x + (int)gridDim.x - rot % (int)gridDim.x) % (int)gridDim.x;
    for (int it = vb * 8 + wave; it < nitems; it += gridDim.x * 8) {
        const int kb = it / nblk, nb = it % nblk, k0 = kb * 64;
        const int g0 = 2 * nb;
        const int sc0 = MODE == 1 ? (((g0 >> 2) & 1) * DFF + (g0 >> 3) * 128 + (g0 & 3) * 32) : nb * 64;
        const int c4 = (lane & 15) * 4, kr = lane >> 4; const bool ok = (sc0 + c4) < ncols_valid;
        f32x4 t[16];
#pragma unroll
        for (int i = 0; i < 16; ++i) t[i] = ok ? *(const f32x4*)(W + (size_t)(k0 + 4 * i + kr) * ldw + sc0 + c4) : (f32x4){0.f, 0.f, 0.f, 0.f};
#pragma unroll
        for (int i = 0; i < 16; ++i) { LAS float* d = scr + (4 * i + kr) * 65 + c4; d[0] = t[i].x; d[1] = t[i].y; d[2] = t[i].z; d[3] = t[i].w; }
        if (shift) {
#pragma unroll
            for (int cc = 0; cc < 9; ++cc) shs[lane * 12 + cc] = shift[(size_t)cc * 9216 + k0 + lane];
        }
        LDS_WAIT();
        if (shift) {
            float a9[9];
#pragma unroll
            for (int cc = 0; cc < 9; ++cc) a9[cc] = 0.f;
#pragma unroll 4
            for (int k = 0; k < 64; ++k) {
                const float w = scr[k * 65 + lane];
                const f32x4 s0 = *(const LAS f32x4*)(shs + k * 12), s1 = *(const LAS f32x4*)(shs + k * 12 + 4); const float s8 = shs[k * 12 + 8];
                a9[0] += w * s0.x; a9[1] += w * s0.y; a9[2] += w * s0.z; a9[3] += w * s0.w; a9[4] += w * s1.x; a9[5] += w * s1.y; a9[6] += w * s1.z; a9[7] += w * s1.w; a9[8] += w * s8;
            }
#pragma unroll
            for (int cc = 0; cc < 9; ++cc) __hip_atomic_fetch_add(cvo + (size_t)cc * ncv + nb * 64 + lane, a9[cc], __ATOMIC_RELAXED, __HIP_MEMORY_SCOPE_AGENT);
        }
        const int c = lane & 7;
#pragma unroll
        for (int j = 0; j < 8; ++j) {
            const int nn = (lane >> 3) + 8 * j; const LAS float* sp = scr + (8 * c) * 65 + nn;
            u32x4 o; o.x = pk2(sp[0 * 65], sp[1 * 65]); o.y = pk2(sp[2 * 65], sp[3 * 65]); o.z = pk2(sp[4 * 65], sp[5 * 65]); o.w = pk2(sp[6 * 65], sp[7 * 65]);
            *(u32x4*)(WT + (size_t)(nb * 64 + nn) * K + k0 + 8 * c) = o;
        }
        LDS_WAIT();
    }
}
__device__ __forceinline__ void convert_ffn_weights(const P& p, int layer, int which, LAS unsigned char* lds, const float* shift, float* cvo) {
    const float* wgu = p.in[which == 0 ? 13 : 15] + (size_t)layer * 1024 * 5632;
    const float* wdn = p.in[which == 0 ? 14 : 16] + (size_t)layer * 2816 * 1024;
    transpose_w<1>(wgu, 5632, 5632, 1024, (bf16*)(p.ws + W_GU), 5632, lds, shift, cvo, 5632);
    transpose_w<0>(wdn, 1024, 1024, 2816, (bf16*)(p.ws + W_DOWN), 1024, lds, nullptr, nullptr, 0, 176);
}
__device__ __forceinline__ void build_lora_w(const P& p) {
    bf16* WT = (bf16*)(p.ws + W_LORA);
    const float* w_up = p.in[21]; const float* a_up = p.in[23]; const float* g_up = p.in[24];
    for (int idx = blockIdx.x * NTHREADS + tid_opaque(); idx < 2560 * 384; idx += gridDim.x * NTHREADS) {
        const int n = idx / 384, k = idx % 384, seg = n >> 9, c = n & 511;
        float v = 0.f;
        if (seg == 0) { if (k < 64) v = w_up[(0 * 64 + k) * 512 + c]; }
        else if (seg == 1) { if (k >= 64 && k < 128) v = w_up[(1 * 64 + k - 64) * 512 + c]; }
        else if (seg == 2) { if (k >= 128 && k < 192) v = a_up[(0 * 64 + k - 128) * 512 + c]; }
        else if (seg == 3) { if (k >= 192 && k < 256) v = a_up[(1 * 64 + k - 192) * 512 + c]; }
        else { if (k >= 256) v = g_up[(k - 256) * 512 + c]; }
        WT[(size_t)n * 384 + k] = (bf16)(pk2(v, 0.f) & 0xffffu);
    }
}

__device__ __forceinline__ void ph_lora_in(const P& p) {
    const int tid = tid_opaque(), lane = tid & 63, wave = tid >> 6;
    const bf16* p0 = (const bf16*)(p.ws + WS_R1); bf16* LA = (bf16*)(p.ws + WS_H);
    const float* mu = p.in[19];
    const int nw = gridDim.x * 8;
    float m0[3], m1[3];
#pragma unroll
    for (int ch = 0; ch < 3; ++ch) { m0[ch] = mu[1536 + ch * 128 + lane * 2]; m1[ch] = mu[1536 + ch * 128 + lane * 2 + 1]; }
    for (int row0 = blockIdx.x * 8 + wave; row0 < M_TOK; row0 += 4 * nw) {
        unsigned cur[4][3], prv[4][3], nxt[4][3];
#pragma unroll
        for (int r = 0; r < 4; ++r) {
            const int row = (row0 + r * nw) < M_TOK ? (row0 + r * nw) : (M_TOK - 1);
            const int t = row < MP ? (row & 255) : ((row - MP) & 1023), L = row < MP ? 256 : 1024;
            const bool hp = t > 0, hn = t < L - 1;
#pragma unroll
            for (int ch = 0; ch < 3; ++ch) {
                const bf16* pc = p0 + (size_t)row * LDP0 + 1536 + ch * 128 + lane * 2;
                cur[r][ch] = *(const unsigned*)pc; prv[r][ch] = hp ? *(const unsigned*)(pc - LDP0) : 0u; nxt[r][ch] = hn ? *(const unsigned*)(pc + LDP0) : 0u;
            }
        }
#pragma unroll
        for (int r = 0; r < 4; ++r) {
            const int row = row0 + r * nw; if (row >= M_TOK) break;
#pragma unroll
            for (int ch = 0; ch < 3; ++ch) {
                float a0 = bflo(cur[r][ch]) + m0[ch] * (0.5f * (bflo(prv[r][ch]) + bflo(nxt[r][ch])) - bflo(cur[r][ch]));
                float a1 = bfhi(cur[r][ch]) + m1[ch] * (0.5f * (bfhi(prv[r][ch]) + bfhi(nxt[r][ch])) - bfhi(cur[r][ch]));
                if (ch == 0) { a0 = tanhf(a0); a1 = tanhf(a1); }
                if (ch == 2) { a0 = sigmoidf_(a0); a1 = sigmoidf_(a1); }
                *(unsigned*)(LA + (size_t)row * 384 + ch * 128 + lane * 2) = pk2(a0, a1);
            }
        }
    }
}

__device__ __forceinline__ void rwkv_item(const P& p, LAS unsigned char* lds, int kind, int b, int head, int dir) {
    constexpr int T = 32, NG = 8, GS = 1408;
    LAS float* grp = (LAS float*)lds;
    LAS float* raw = grp + 2 * NG * GS;
    LAS float* ybR = raw + T * 320;
    const int tid = tid_opaque(), lane = tid & 63, wave = tid >> 6, q = lane & 7, vl = lane >> 3, r0 = wave * 8 + vl;
    const int tt = tid >> 4, cgi = tid & 15;
    const int L = kind ? 1024 : 256, nblk = L / T;
    const int rowbase = kind ? MP + b * 1024 : b * 256;
    const bf16* p0 = (const bf16*)(p.ws + WS_R1);
    const bf16* lo = (const bf16*)(p.ws + WS_R2);
    bf16* Y = (bf16*)(p.ws + (dir == 0 ? WS_MIX : WS_H));
    const int colbase = head * 64;
    f32x2 S[4];
#pragma unroll
    for (int i = 0; i < 4; ++i) S[i] = (f32x2){0.f, 0.f};
    if (kind) { const float* s0 = p.in[2] + (((size_t)b * 2 + dir) * 8 + head) * 4096 + q * 8;
        const f32x4 a0 = *(const f32x4*)(s0 + r0 * 64), a1 = *(const f32x4*)(s0 + r0 * 64 + 4);
        S[0] = (f32x2){a0.x, a0.y}; S[1] = (f32x2){a0.z, a0.w}; S[2] = (f32x2){a1.x, a1.y}; S[3] = (f32x2){a1.z, a1.w}; }
    const int C = head * 64 + cgi * 4;
    const f32x4 cA = *(const f32x4*)(p.in[19] + C), cB = *(const f32x4*)(p.in[19] + 512 + C), cC = *(const f32x4*)(p.in[19] + 1024 + C);
    const f32x4 cD = *(const f32x4*)(p.in[25] + C), cE = *(const f32x4*)(p.in[26] + C);
    u32x2 ra0, ra1, ra2, rb0, rb1, rb2, rc0, rc1, rc2, rd, re;
    const u32x2 z2 = {0u, 0u};
#define RW_LOAD(blk) do { \
        const int n_ = (blk) * T + tt, t_ = dir ? L - 1 - n_ : n_; const size_t row_ = (size_t)(rowbase + t_); \
        const bool hp_ = t_ > 0, hn_ = t_ < L - 1; \
        const bf16* pr_ = p0 + row_ * LDP0 + head * 64 + cgi * 4; \
        ra1 = *(const u32x2*)pr_; ra0 = hp_ ? *(const u32x2*)(pr_ - LDP0) : z2; ra2 = hn_ ? *(const u32x2*)(pr_ + LDP0) : z2; \
        rb1 = *(const u32x2*)(pr_ + 512); rb0 = hp_ ? *(const u32x2*)(pr_ + 512 - LDP0) : z2; rb2 = hn_ ? *(const u32x2*)(pr_ + 512 + LDP0) : z2; \
        rc1 = *(const u32x2*)(pr_ + 1024); rc0 = hp_ ? *(const u32x2*)(pr_ + 1024 - LDP0) : z2; rc2 = hn_ ? *(const u32x2*)(pr_ + 1024 + LDP0) : z2; \
        rd = *(const u32x2*)(lo + row_ * 2560 + dir * 512 + head * 64 + cgi * 4); re = *(const u32x2*)(lo + row_ * 2560 + 1024 + dir * 512 + head * 64 + cgi * 4); \
    } while (0)
#define RW_PREP1(bi) do { \
        LAS float* rw_ = raw + tt * 320; const int c4_ = cgi * 4; \
        const f32x4 r1_ = unpk4(ra1), k1_ = unpk4(rb1), v1_ = unpk4(rc1); \
        const f32x4 r_ = r1_ + cA * ((unpk4(ra0) + unpk4(ra2)) * 0.5f - r1_); \
        const f32x4 k_ = k1_ + cB * ((unpk4(rb0) + unpk4(rb2)) * 0.5f - k1_); \
        const f32x4 v_ = v1_ + cC * ((unpk4(rc0) + unpk4(rc2)) * 0.5f - v1_); \
        f32x4 kk_ = k_ * cD; \
        const float ss_ = red16(kk_.x * kk_.x + kk_.y * kk_.y + kk_.z * kk_.z + kk_.w * kk_.w); \
        kk_ = kk_ * rsqrtf_(ss_ + 1e-6f); \
        const f32x4 ew_ = unpk4(rd), a_ = unpk4(re); \
        f32x4 w_; w_.x = __expf(-ew_.x); w_.y = __expf(-ew_.y); w_.z = __expf(-ew_.z); w_.w = __expf(-ew_.w); \
        *(LAS f32x4*)(rw_ + c4_) = kk_; *(LAS f32x4*)(rw_ + 64 + c4_) = w_; *(LAS f32x4*)(rw_ + 128 + c4_) = kk_ * a_; \
        *(LAS f32x4*)(rw_ + 192 + c4_) = k_ * ((a_ - 1.0f) * cE + 1.0f); *(LAS f32x4*)(rw_ + 256 + c4_) = r_; \
        *(LAS f32x4*)(grp + ((bi) * NG + (tt >> 2)) * GS + 1088 + (tt & 3) * 64 + c4_) = v_; \
    } while (0)
#define DOT16(aa_, bb_) red16((aa_)[0] * (bb_)[0] + (aa_)[1] * (bb_)[1] + (aa_)[2] * (bb_)[2] + (aa_)[3] * (bb_)[3])
#define RW_PREP2(bi) do { if (tid < 128) { \
        const int gq_ = tid >> 4, c4_ = cgi * 4; const LAS float* r4_ = raw + gq_ * 4 * 320 + c4_; LAS float* gi_ = grp + ((bi) * NG + gq_) * GS; \
        const f32x4 kk1 = *(const LAS f32x4*)(r4_), w1 = *(const LAS f32x4*)(r4_ + 64), b1 = *(const LAS f32x4*)(r4_ + 128), d1 = *(const LAS f32x4*)(r4_ + 192), q1 = *(const LAS f32x4*)(r4_ + 256); \
        const f32x4 kk2 = *(const LAS f32x4*)(r4_ + 320), w2 = *(const LAS f32x4*)(r4_ + 384), b2 = *(const LAS f32x4*)(r4_ + 448), d2 = *(const LAS f32x4*)(r4_ + 512), q2 = *(const LAS f32x4*)(r4_ + 576); \
        const f32x4 kk3 = *(const LAS f32x4*)(r4_ + 640), w3 = *(const LAS f32x4*)(r4_ + 704), b3 = *(const LAS f32x4*)(r4_ + 768), d3 = *(const LAS f32x4*)(r4_ + 832), q3 = *(const LAS f32x4*)(r4_ + 896); \
        const f32x4 kk4 = *(const LAS f32x4*)(r4_ + 960), w4 = *(const LAS f32x4*)(r4_ + 1024), b4 = *(const LAS f32x4*)(r4_ + 1088), d4 = *(const LAS f32x4*)(r4_ + 1152), q4 = *(const LAS f32x4*)(r4_ + 1216); \
        const f32x4 W02 = w1 * w2, W03 = W02 * w3, W04 = W03 * w4, W13 = w2 * w3, W14 = W13 * w4, W24 = w3 * w4; \
        *(LAS f32x4*)(gi_ + c4_) = kk1; *(LAS f32x4*)(gi_ + 64 + c4_) = w1 * kk2; *(LAS f32x4*)(gi_ + 128 + c4_) = W02 * kk3; *(LAS f32x4*)(gi_ + 192 + c4_) = W03 * kk4; \
        *(LAS f32x4*)(gi_ + 256 + c4_) = w1 * q1; *(LAS f32x4*)(gi_ + 320 + c4_) = W02 * q2; *(LAS f32x4*)(gi_ + 384 + c4_) = W03 * q3; *(LAS f32x4*)(gi_ + 448 + c4_) = W04 * q4; \
        *(LAS f32x4*)(gi_ + 512 + c4_) = d1 * W14; *(LAS f32x4*)(gi_ + 576 + c4_) = d2 * W24; *(LAS f32x4*)(gi_ + 640 + c4_) = d3 * w4; *(LAS f32x4*)(gi_ + 704 + c4_) = d4; \
        *(LAS f32x4*)(gi_ + 768 + c4_) = b1 * W14; *(LAS f32x4*)(gi_ + 832 + c4_) = b2 * W24; *(LAS f32x4*)(gi_ + 896 + c4_) = b3 * w4; *(LAS f32x4*)(gi_ + 960 + c4_) = b4; \
        *(LAS f32x4*)(gi_ + 1024 + c4_) = W04; \
        const f32x4 d1w2 = d1 * w2, d1w13 = d1 * W13, d1w14 = d1 * W14, d2w3 = d2 * w3, d2w24 = d2 * W24, d3w4 = d3 * w4; \
        const f32x4 b1w2 = b1 * w2, b1w13 = b1 * W13, b1w14 = b1 * W14, b2w3 = b2 * w3, b2w24 = b2 * W24, b3w4 = b3 * w4; \
        float sc_[32]; \
        sc_[0] = DOT16(d1, kk2); sc_[1] = DOT16(d1w2, kk3); sc_[2] = DOT16(d2, kk3); sc_[3] = DOT16(d1w13, kk4); sc_[4] = DOT16(d2w3, kk4); sc_[5] = DOT16(d3, kk4); \
        sc_[6] = DOT16(b1, kk2); sc_[7] = DOT16(b1w2, kk3); sc_[8] = DOT16(b2, kk3); sc_[9] = DOT16(b1w13, kk4); sc_[10] = DOT16(b2w3, kk4); sc_[11] = DOT16(b3, kk4); \
        sc_[12] = DOT16(d1, q1); sc_[13] = DOT16(d1w2, q2); sc_[14] = DOT16(d2, q2); sc_[15] = DOT16(d1w13, q3); sc_[16] = DOT16(d2w3, q3); sc_[17] = DOT16(d3, q3); \
        sc_[18] = DOT16(d1w14, q4); sc_[19] = DOT16(d2w24, q4); sc_[20] = DOT16(d3w4, q4); sc_[21] = DOT16(d4, q4); \
        sc_[22] = DOT16(b1, q1); sc_[23] = DOT16(b1w2, q2); sc_[24] = DOT16(b2, q2); sc_[25] = DOT16(b1w13, q3); sc_[26] = DOT16(b2w3, q3); sc_[27] = DOT16(b3, q3); \
        sc_[28] = DOT16(b1w14, q4); sc_[29] = DOT16(b2w24, q4); sc_[30] = DOT16(b3w4, q4); sc_[31] = DOT16(b4, q4); \
        if (cgi < 8) { _Pragma("unroll") for (int i_ = 0; i_ < 8; ++i_) if (cgi == i_) *(LAS f32x4*)(gi_ + 1344 + 4 * i_) = (f32x4){sc_[4 * i_], sc_[4 * i_ + 1], sc_[4 * i_ + 2], sc_[4 * i_ + 3]}; } \
    } } while (0)
    __syncthreads();
    RW_LOAD(0); RW_PREP1(0);
    __syncthreads();
    RW_PREP2(0);
    __syncthreads();
#pragma unroll 1
    for (int blk = 0; blk < nblk; ++blk) {
        const int bi = blk & 1;
        if (blk + 1 < nblk) RW_LOAD(blk + 1);
        LAS float* yb = ybR + bi * T * 64;
#pragma unroll 1
        for (int g = 0; g < NG; ++g) {
            const LAS float* gi = grp + (bi * NG + g) * GS;
            float dp[4], du[4];
#pragma unroll
            for (int t = 0; t < 4; ++t) {
                const f32x4 pa = *(const LAS f32x4*)(gi + t * 64 + q * 8), pb = *(const LAS f32x4*)(gi + t * 64 + q * 8 + 4);
                const f32x4 ua = *(const LAS f32x4*)(gi + 256 + t * 64 + q * 8), ub = *(const LAS f32x4*)(gi + 256 + t * 64 + q * 8 + 4);
                const f32x2 a = __builtin_elementwise_fma(S[0], (f32x2){pa.x, pa.y}, S[1] * (f32x2){pa.z, pa.w}) + __builtin_elementwise_fma(S[2], (f32x2){pb.x, pb.y}, S[3] * (f32x2){pb.z, pb.w});
                const f32x2 c = __builtin_elementwise_fma(S[0], (f32x2){ua.x, ua.y}, S[1] * (f32x2){ua.z, ua.w}) + __builtin_elementwise_fma(S[2], (f32x2){ub.x, ub.y}, S[3] * (f32x2){ub.z, ub.w});
                dp[t] = a.x + a.y; du[t] = c.x + c.y;
            }
#pragma unroll
            for (int t = 0; t < 4; ++t) { dp[t] = red8(dp[t]); du[t] = red8(du[t]); }
            const float v1 = gi[1088 + r0], v2 = gi[1152 + r0], v3 = gi[1216 + r0], v4 = gi[1280 + r0];
            const f32x4 A0 = *(const LAS f32x4*)(gi + 1344), A1 = *(const LAS f32x4*)(gi + 1348), B0 = *(const LAS f32x4*)(gi + 1352), E0 = *(const LAS f32x4*)(gi + 1356);
            const f32x4 E1 = *(const LAS f32x4*)(gi + 1360), E2 = *(const LAS f32x4*)(gi + 1364), F0 = *(const LAS f32x4*)(gi + 1368), F1 = *(const LAS f32x4*)(gi + 1372);
            const float g1 = dp[0];
            const float g2 = dp[1] + v1 * A0.x - g1 * A1.z;
            const float g3 = dp[2] + v1 * A0.y + v2 * A0.z - g1 * A1.w - g2 * B0.x;
            const float g4 = dp[3] + v1 * A0.w + v2 * A1.x + v3 * A1.y - g1 * B0.y - g2 * B0.z - g3 * B0.w;
            const float y1 = du[0] + v1 * E0.x - g1 * E2.z;
            const float y2 = du[1] + v1 * E0.y + v2 * E0.z - g1 * E2.w - g2 * F0.x;
            const float y3 = du[2] + v1 * E0.w + v2 * E1.x + v3 * E1.y - g1 * F0.y - g2 * F0.z - g3 * F0.w;
            const float y4 = du[3] + v1 * E1.z + v2 * E1.w + v3 * E2.x + v4 * E2.y - g1 * F1.x - g2 * F1.y - g3 * F1.z - g4 * F1.w;
            if (q == 0) { yb[(4 * g) * 64 + r0] = y1; yb[(4 * g + 1) * 64 + r0] = y2; yb[(4 * g + 2) * 64 + r0] = y3; yb[(4 * g + 3) * 64 + r0] = y4; }
            {
                const f32x4 wa = *(const LAS f32x4*)(gi + 1024 + q * 8), wb = *(const LAS f32x4*)(gi + 1024 + q * 8 + 4);
                f32x2 n0 = S[0] * (f32x2){wa.x, wa.y}, n1 = S[1] * (f32x2){wa.z, wa.w}, n2 = S[2] * (f32x2){wb.x, wb.y}, n3 = S[3] * (f32x2){wb.z, wb.w};
                const float vv[4] = {v1, v2, v3, v4}, gg[4] = {g1, g2, g3, g4};
#pragma unroll
                for (int j = 0; j < 4; ++j) {
                    const f32x4 da = *(const LAS f32x4*)(gi + 512 + j * 64 + q * 8), db = *(const LAS f32x4*)(gi + 512 + j * 64 + q * 8 + 4);
                    const f32x4 ba = *(const LAS f32x4*)(gi + 768 + j * 64 + q * 8), bb = *(const LAS f32x4*)(gi + 768 + j * 64 + q * 8 + 4);
                    const f32x2 vj = {vv[j], vv[j]}, ng = {-gg[j], -gg[j]};
                    n0 = __builtin_elementwise_fma(vj, (f32x2){da.x, da.y}, n0); n1 = __builtin_elementwise_fma(vj, (f32x2){da.z, da.w}, n1);
                    n2 = __builtin_elementwise_fma(vj, (f32x2){db.x, db.y}, n2); n3 = __builtin_elementwise_fma(vj, (f32x2){db.z, db.w}, n3);
                    n0 = __builtin_elementwise_fma(ng, (f32x2){ba.x, ba.y}, n0); n1 = __builtin_elementwise_fma(ng, (f32x2){ba.z, ba.w}, n1);
                    n2 = __builtin_elementwise_fma(ng, (f32x2){bb.x, bb.y}, n2); n3 = __builtin_elementwise_fma(ng, (f32x2){bb.z, bb.w}, n3);
                }
                S[0] = n0; S[1] = n1; S[2] = n2; S[3] = n3;
            }
        }
        if (blk + 1 < nblk) RW_PREP1(bi ^ 1);
        __syncthreads();
        if (blk + 1 < nblk) RW_PREP2(bi ^ 1);
        {
            const int r4 = cgi * 4, n = blk * T + tt, tk = dir ? L - 1 - n : n;
            const f32x4 yv = *(const LAS f32x4*)(yb + tt * 64 + r4);
            *(u32x2*)(Y + (size_t)(rowbase + tk) * 1024 + colbase + r4) = pk4(yv);
        }
        __syncthreads();
    }
#undef RW_LOAD
#undef RW_PREP1
#undef RW_PREP2
#undef DOT16
    if (!kind) { float* so = p.out + OUT_SRW + (((size_t)b * 2 + dir) * 8 + head) * 4096 + q * 8;
        *(f32x4*)(so + r0 * 64) = (f32x4){S[0].x, S[0].y, S[1].x, S[1].y}; *(f32x4*)(so + r0 * 64 + 4) = (f32x4){S[2].x, S[2].y, S[3].x, S[3].y}; }
}

__device__ __forceinline__ void gdn_item(const P& p, LAS unsigned char* lds, int kind, int b, int head, int dir, int half) {
    LAS bf16* Qs = (LAS bf16*)(lds);
    LAS bf16* Ks = (LAS bf16*)(lds + 17408);
    LAS bf16* KT = (LAS bf16*)(lds + 34816);
    LAS bf16* VT = (LAS bf16*)(lds + 53248);
    LAS bf16* ST = (LAS bf16*)(lds + 62464);
    LAS float* Lm = (LAS float*)(lds + 79872);
    LAS bf16* vnT = (LAS bf16*)(lds + 79872);
    LAS bf16* vnsT = (LAS bf16*)(lds + 79872 + 9216);
    LAS float* Tm = (LAS float*)(lds + 98304);
    LAS bf16* Tb = (LAS bf16*)(lds + 115712);
    LAS bf16* QKg = (LAS bf16*)(lds + 124928);
    LAS bf16* rT = (LAS bf16*)(lds + 134144);
    LAS float* gs = (LAS float*)(lds + 143360);
    LAS float* bs = gs + 64;
    LAS float* Gs = gs + 128;
    LAS float* eGs = gs + 192;
    LAS float* eGl = gs + 256;
    LAS float* misc = gs + 320;
    LAS float* CW = (LAS float*)(lds + 144896);
    LAS float* Ysc = (LAS float*)(lds + 148736);
    const int tid = tid_opaque(), lane = tid & 63, wave = tid >> 6, ln = lane & 15, h4 = lane >> 4;
    const int L = kind ? 1024 : 256, nch = L / 64, rowbase = kind ? MP + b * 1024 : b * 256;
    const bf16* p0 = (const bf16*)(p.ws + WS_R1);
    bf16* Y = (bf16*)(p.ws + (dir == 0 ? WS_MIX : WS_H));
    const int colbase = 512 + head * 128 + half * 64;
    const int pi = tid >> 3, c8 = tid & 7;
    const float gA = -expf(p.in[31][dir * 4 + head]), gB = p.in[32][dir * 4 + head];
    __syncthreads();
    for (int e = tid; e < 960; e += NTHREADS) {
        float v;
        if (e < 768) { const int part = e / 384, r = e % 384, tap = r >> 7, d = r & 127; v = p.in[30][tap * 1536 + part * 512 + head * 128 + d]; }
        else { const int r = e - 768, tap = r >> 6, c = r & 63; v = p.in[30][tap * 1536 + 1024 + head * 128 + half * 64 + c]; }
        CW[e] = v;
    }
    for (int e = tid; e < 64 * 72 / 2; e += NTHREADS) { ((LAS unsigned*)Tb)[e] = 0u; ((LAS unsigned*)QKg)[e] = 0u; }
    f32x4 accS[4];
#pragma unroll
    for (int vt = 0; vt < 4; ++vt) {
        accS[vt] = (f32x4){0.f, 0.f, 0.f, 0.f};
        if (kind) { const float* s0 = p.in[3] + (((size_t)b * 2 + dir) * 4 + head) * 16384 + half * 64 + vt * 16 + ln;
#pragma unroll
            for (int r = 0; r < 4; ++r) accS[vt][r] = s0[(size_t)(wave * 16 + h4 * 4 + r) * 128]; }
        *(LAS u32x2*)(ST + (vt * 16 + ln) * 136 + wave * 16 + h4 * 4) = pk4(accS[vt]);
    }
    u32x4 rq[3][2], rk[3][2], rv[3]; unsigned rab = 0u, rbb = 0u;
    const u32x4 z4 = {0u, 0u, 0u, 0u};
#define GD_LOAD(n) do { \
        const int i_ = (n) * 64 + pi, t_ = dir ? L - 1 - i_ : i_; const size_t row_ = (size_t)(rowbase + t_); \
        const bf16* pr_ = p0 + row_ * LDP0 + 1920 + head * 128 + c8 * 16; \
        const bf16* pv_ = p0 + row_ * LDP0 + 1920 + 1024 + head * 128 + half * 64 + c8 * 8; \
        _Pragma("unroll") for (int j_ = 0; j_ < 3; ++j_) { \
            const bool ok_ = (j_ == 1) || (j_ == 0 ? t_ > 0 : t_ < L - 1); const long o_ = (long)(j_ - 1) * LDP0; \
            rq[j_][0] = ok_ ? *(const u32x4*)(pr_ + o_) : z4; rq[j_][1] = ok_ ? *(const u32x4*)(pr_ + o_ + 8) : z4; \
            rk[j_][0] = ok_ ? *(const u32x4*)(pr_ + o_ + 512) : z4; rk[j_][1] = ok_ ? *(const u32x4*)(pr_ + o_ + 520) : z4; \
            rv[j_] = ok_ ? *(const u32x4*)(pv_ + o_) : z4; } \
        rab = p0[row_ * LDP0 + 3968 + dir * 8 + head]; rbb = p0[row_ * LDP0 + 3968 + dir * 8 + 4 + head]; \
    } while (0)
    GD_LOAD(0);
    __syncthreads();
#pragma unroll 1
    for (int n = 0; n < nch; ++n) {
        {
            const int pis = (((pi >> 3) ^ c8) << 3) | (pi & 7);
            {
                float xq[16]; float sq = 0.f;
#pragma unroll
                for (int e = 0; e < 16; ++e) { const int d = c8 * 16 + e; const int wi = e >> 1, hi = e & 1, vi = wi >> 2, ci = wi & 3;
                    const float q0 = hi ? bfhi(rq[0][vi][ci]) : bflo(rq[0][vi][ci]), q1 = hi ? bfhi(rq[1][vi][ci]) : bflo(rq[1][vi][ci]), q2 = hi ? bfhi(rq[2][vi][ci]) : bflo(rq[2][vi][ci]);
                    const float a = CW[d] * q0 + CW[128 + d] * q1 + CW[256 + d] * q2;
                    xq[e] = siluf_(a); sq += xq[e] * xq[e]; }
                sq = red8(sq);
                const float nq = 0.08838834764831845f * rsqrtf_(sq + 1e-6f);
                u32x4 w0, w1;
                w0.x = pk2(xq[0] * nq, xq[1] * nq); w0.y = pk2(xq[2] * nq, xq[3] * nq); w0.z = pk2(xq[4] * nq, xq[5] * nq); w0.w = pk2(xq[6] * nq, xq[7] * nq);
                w1.x = pk2(xq[8] * nq, xq[9] * nq); w1.y = pk2(xq[10] * nq, xq[11] * nq); w1.z = pk2(xq[12] * nq, xq[13] * nq); w1.w = pk2(xq[14] * nq, xq[15] * nq);
                *(LAS u32x4*)(Qs + pi * 136 + c8 * 16) = w0; *(LAS u32x4*)(Qs + pi * 136 + c8 * 16 + 8) = w1;
            }
            {
                float xk[16]; float sk = 0.f;
#pragma unroll
                for (int e = 0; e < 16; ++e) { const int d = c8 * 16 + e; const int wi = e >> 1, hi = e & 1, vi = wi >> 2, ci = wi & 3;
                    const float k0 = hi ? bfhi(rk[0][vi][ci]) : bflo(rk[0][vi][ci]), k1 = hi ? bfhi(rk[1][vi][ci]) : bflo(rk[1][vi][ci]), k2 = hi ? bfhi(rk[2][vi][ci]) : bflo(rk[2][vi][ci]);
                    const float c = CW[384 + d] * k0 + CW[512 + d] * k1 + CW[640 + d] * k2;
                    xk[e] = siluf_(c); sk += xk[e] * xk[e]; }
                sk = red8(sk);
                const float nk = rsqrtf_(sk + 1e-6f);
                u32x4 w0, w1;
                w0.x = pk2(xk[0] * nk, xk[1] * nk); w0.y = pk2(xk[2] * nk, xk[3] * nk); w0.z = pk2(xk[4] * nk, xk[5] * nk); w0.w = pk2(xk[6] * nk, xk[7] * nk);
                w1.x = pk2(xk[8] * nk, xk[9] * nk); w1.y = pk2(xk[10] * nk, xk[11] * nk); w1.z = pk2(xk[12] * nk, xk[13] * nk); w1.w = pk2(xk[14] * nk, xk[15] * nk);
                *(LAS u32x4*)(Ks + pi * 136 + c8 * 16) = w0; *(LAS u32x4*)(Ks + pi * 136 + c8 * 16 + 8) = w1;
#pragma unroll
                for (int e = 0; e < 4; ++e) {
                    KT[(c8 * 16 + 2 * e) * 72 + pis] = (bf16)(w0[e] & 0xffffu); KT[(c8 * 16 + 2 * e + 1) * 72 + pis] = (bf16)(w0[e] >> 16);
                    KT[(c8 * 16 + 8 + 2 * e) * 72 + pis] = (bf16)(w1[e] & 0xffffu); KT[(c8 * 16 + 8 + 2 * e + 1) * 72 + pis] = (bf16)(w1[e] >> 16); }
            }
#pragma unroll
            for (int e = 0; e < 8; ++e) { const int c = c8 * 8 + e; const int wi = e >> 1, hi = e & 1;
                const float v0 = hi ? bfhi(rv[0][wi]) : bflo(rv[0][wi]), v1 = hi ? bfhi(rv[1][wi]) : bflo(rv[1][wi]), v2 = hi ? bfhi(rv[2][wi]) : bflo(rv[2][wi]);
                const float a = CW[768 + c] * v0 + CW[832 + c] * v1 + CW[896 + c] * v2;
                VT[c * 72 + pis] = (bf16)(pk2(siluf_(a), 0.f) & 0xffffu); }
            if (c8 == 0) { const float xa = bf2f(rab) + gB; const float sp = xa > 20.f ? xa : log1pf(expf(xa)); gs[pi] = gA * sp; bs[pi] = 1.0f / (1.0f + expf(-bf2f(rbb))); }
        }
        __syncthreads();
        if (n + 1 < nch) GD_LOAD(n + 1);
        if (wave == 0) {
            float x = gs[lane];
            x += DPPF(x, 0x111); x += DPPF(x, 0x112); x += DPPF(x, 0x114); x += DPPF(x, 0x118);
            const int xi = __float_as_int(x);
            const float t0 = __int_as_float(__builtin_amdgcn_readlane(xi, 15)), t1 = __int_as_float(__builtin_amdgcn_readlane(xi, 31)), t2 = __int_as_float(__builtin_amdgcn_readlane(xi, 47));
            x += (lane >= 48) ? (t0 + t1 + t2) : ((lane >= 32) ? (t0 + t1) : ((lane >= 16) ? t0 : 0.f));
            const float Gl = __int_as_float(__builtin_amdgcn_readlane(__float_as_int(x), 63));
            Gs[lane] = x; eGs[lane] = __expf(x); eGl[lane] = __expf(Gl - x); if (lane == 0) misc[0] = __expf(Gl);
        }
        __syncthreads();
#pragma unroll 1
        for (int tix = wave; tix < 20; tix += 8) {
            const int x = tix < 10 ? tix : tix - 10;
            const int it = x >= 6 ? 3 : (x >= 3 ? 2 : (x >= 1 ? 1 : 0)), jt = x - (it * (it + 1)) / 2;
            f32x4 a = {0.f, 0.f, 0.f, 0.f};
            if (tix < 10) {
#pragma unroll
                for (int s = 0; s < 4; ++s) a = __builtin_amdgcn_mfma_f32_16x16x32_bf16(*(const LAS s16x8*)(Ks + (16 * it + ln) * 136 + 32 * s + 8 * h4), *(const LAS s16x8*)(Ks + (16 * jt + ln) * 136 + 32 * s + 8 * h4), a, 0, 0, 0);
                const int j = 16 * jt + ln; const float Gj = Gs[j];
#pragma unroll
                for (int r = 0; r < 4; ++r) { const int i = 16 * it + 4 * h4 + r; Lm[i * 72 + j] = i > j ? bs[i] * a[r] * __expf(Gs[i] - Gj) : 0.f; }
            } else {
#pragma unroll
                for (int s = 0; s < 4; ++s) a = __builtin_amdgcn_mfma_f32_16x16x32_bf16(*(const LAS s16x8*)(Ks + (16 * jt + ln) * 136 + 32 * s + 8 * h4), *(const LAS s16x8*)(Qs + (16 * it + ln) * 136 + 32 * s + 8 * h4), a, 0, 0, 0);
                const int i = 16 * it + ln; const float Gi = Gs[i]; f32x4 o;
#pragma unroll
                for (int r = 0; r < 4; ++r) { const int j = 16 * jt + 4 * h4 + r; o[r] = i >= j ? a[r] * __expf(Gi - Gs[j]) : 0.f; }
                *(LAS u32x2*)(QKg + i * 72 + 16 * jt + 4 * h4) = pk4(o);
            }
        }
        __syncthreads();
        if (wave == 0) {
            const int a = h4, c = ln; float xr[16];
#pragma unroll
            for (int r = 0; r < 16; ++r) { float s = (r == c) ? 1.0f : 0.0f;
#pragma unroll
                for (int m = 0; m < r; ++m) s -= Lm[(16 * a + r) * 72 + 16 * a + m] * xr[m];
                xr[r] = s; }
#pragma unroll
            for (int r = 0; r < 16; ++r) { Tm[(16 * a + r) * 68 + 16 * a + c] = xr[r]; Tb[(16 * a + r) * 72 + 16 * a + c] = (bf16)(pk2(xr[r], 0.f) & 0xffffu); }
        } else {
#pragma unroll 1
            for (int tk = wave - 1; tk < 16; tk += 7) {
                const int it = tk >> 2, vt = tk & 3; f32x4 a = {0.f, 0.f, 0.f, 0.f};
#pragma unroll
                for (int s = 0; s < 4; ++s) a = __builtin_amdgcn_mfma_f32_16x16x32_bf16(*(const LAS s16x8*)(Ks + (16 * it + ln) * 136 + 32 * s + 8 * h4), *(const LAS s16x8*)(ST + (16 * vt + ln) * 136 + 32 * s + 8 * h4), a, 0, 0, 0);
                const int v = 16 * vt + ln, i0 = 16 * it + 4 * h4;
                const f32x4 vj = unpk4(*(const LAS u32x2*)(VT + v * 72 + ((((i0 >> 3) ^ (v >> 3)) & 7) << 3) + (i0 & 7))), be = *(const LAS f32x4*)(bs + i0), eg = *(const LAS f32x4*)(eGs + i0);
                *(LAS u32x2*)(rT + v * 72 + i0) = pk4(be * (vj - eg * a));
            }
        }
        __syncthreads();
#pragma unroll 1
        for (int dist = 1; dist < 4; ++dist) {
            if (wave < 4 - dist) {
                const int bb = wave, aa = wave + dist; LAS float* ys = Ysc + wave * 272;
                f32x4 y = {0.f, 0.f, 0.f, 0.f};
                float la[3][4], tb[3][4];
#pragma unroll
                for (int mm = 0; mm < 3; ++mm)
#pragma unroll
                    for (int s = 0; s < 4; ++s) { const int m = bb + (mm < dist ? mm : 0);
                        la[mm][s] = Lm[(16 * aa + ln) * 72 + 16 * m + 4 * s + h4]; tb[mm][s] = Tm[(16 * m + 4 * s + h4) * 68 + 16 * bb + ln]; }
#pragma unroll
                for (int mm = 0; mm < 3; ++mm)
                    if (mm < dist) {
#pragma unroll
                        for (int s = 0; s < 4; ++s) y = __builtin_amdgcn_mfma_f32_16x16x4f32(la[mm][s], tb[mm][s], y, 0, 0, 0); }
#pragma unroll
                for (int r = 0; r < 4; ++r) ys[(4 * h4 + r) * 17 + ln] = y[r];
                f32x4 z = {0.f, 0.f, 0.f, 0.f};
#pragma unroll
                for (int s = 0; s < 4; ++s) z = __builtin_amdgcn_mfma_f32_16x16x4f32(Tm[(16 * aa + ln) * 68 + 16 * aa + 4 * s + h4], ys[(4 * s + h4) * 17 + ln], z, 0, 0, 0);
#pragma unroll
                for (int r = 0; r < 4; ++r) { const int i = 16 * aa + 4 * h4 + r, j = 16 * bb + ln; Tm[i * 68 + j] = -z[r]; Tb[i * 72 + j] = (bf16)(pk2(-z[r], 0.f) & 0xffffu); }
            }
            __syncthreads();
        }
#pragma unroll
        for (int u = 0; u < 2; ++u) {
            const int tile = 2 * wave + u, it = tile >> 2, vt = tile & 3; f32x4 a = {0.f, 0.f, 0.f, 0.f};
            a = __builtin_amdgcn_mfma_f32_16x16x32_bf16(*(const LAS s16x8*)(Tb + (16 * it + ln) * 72 + 8 * h4), *(const LAS s16x8*)(rT + (16 * vt + ln) * 72 + 8 * h4), a, 0, 0, 0);
            if (it >= 2) a = __builtin_amdgcn_mfma_f32_16x16x32_bf16(*(const LAS s16x8*)(Tb + (16 * it + ln) * 72 + 32 + 8 * h4), *(const LAS s16x8*)(rT + (16 * vt + ln) * 72 + 32 + 8 * h4), a, 0, 0, 0);
            const int v = 16 * vt + ln, i0 = 16 * it + 4 * h4;
            *(LAS u32x2*)(vnT + v * 72 + i0) = pk4(a); *(LAS u32x2*)(vnsT + v * 72 + i0) = pk4(a * *(const LAS f32x4*)(eGl + i0));
        }
        __syncthreads();
#pragma unroll
        for (int u = 0; u < 2; ++u) {
            const int tile = 2 * wave + u, vt = tile >> 2, it = tile & 3; f32x4 a = {0.f, 0.f, 0.f, 0.f};
#pragma unroll
            for (int s = 0; s < 4; ++s) a = __builtin_amdgcn_mfma_f32_16x16x32_bf16(*(const LAS s16x8*)(ST + (16 * vt + ln) * 136 + 32 * s + 8 * h4), *(const LAS s16x8*)(Qs + (16 * it + ln) * 136 + 32 * s + 8 * h4), a, 0, 0, 0);
            a = a * eGs[16 * it + ln];
            a = __builtin_amdgcn_mfma_f32_16x16x32_bf16(*(const LAS s16x8*)(vnT + (16 * vt + ln) * 72 + 8 * h4), *(const LAS s16x8*)(QKg + (16 * it + ln) * 72 + 8 * h4), a, 0, 0, 0);
            if (it >= 2) a = __builtin_amdgcn_mfma_f32_16x16x32_bf16(*(const LAS s16x8*)(vnT + (16 * vt + ln) * 72 + 32 + 8 * h4), *(const LAS s16x8*)(QKg + (16 * it + ln) * 72 + 32 + 8 * h4), a, 0, 0, 0);
            const int ic = n * 64 + 16 * it + ln, tk = dir ? L - 1 - ic : ic;
            *(u32x2*)(Y + (size_t)(rowbase + tk) * 1024 + colbase + 16 * vt + 4 * h4) = pk4(a);
        }
        {
            const float egl = misc[0];
#pragma unroll
            for (int vt = 0; vt < 4; ++vt) {
                f32x4 a = accS[vt] * egl;
#pragma unroll
                for (int s = 0; s < 2; ++s) a = __builtin_amdgcn_mfma_f32_16x16x32_bf16(*(const LAS s16x8*)(KT + (16 * wave + ln) * 72 + (((4 * s + h4) ^ wave) << 3)), *(const LAS s16x8*)(vnsT + (16 * vt + ln) * 72 + 32 * s + 8 * h4), a, 0, 0, 0);
                accS[vt] = a;
            }
        }
        __syncthreads();
#pragma unroll
        for (int vt = 0; vt < 4; ++vt) *(LAS u32x2*)(ST + (vt * 16 + ln) * 136 + wave * 16 + h4 * 4) = pk4(accS[vt]);
    }
#undef GD_LOAD
    if (!kind) { float* so = p.out + OUT_SGD + (((size_t)b * 2 + dir) * 4 + head) * 16384 + half * 64;
#pragma unroll
        for (int vt = 0; vt < 4; ++vt)
#pragma unroll
            for (int r = 0; r < 4; ++r) so[(size_t)(wave * 16 + h4 * 4 + r) * 128 + vt * 16 + ln] = accS[vt][r]; }
}
__device__ __forceinline__ void rwkv_idx(const P& p, LAS unsigned char* lds, int i) {
    const int kind = i < 128 ? 1 : 0, j = i < 128 ? i : i - 128;
    rwkv_item(p, lds, kind, j >> 4, (j >> 1) & 7, j & 1);
}
__device__ __forceinline__ void gdn_idx(const P& p, LAS unsigned char* lds, int i) {
    const int kind = i < 128 ? 1 : 0, j = i < 128 ? i : i - 128;
    gdn_item(p, lds, kind, j >> 4, (j >> 2) & 3, (j >> 1) & 1, j & 1);
}
__device__ __forceinline__ void ph_scan(const P& p, LAS unsigned char* lds) {
    const int B = blockIdx.x, G = gridDim.x;
    if (G == 256) {
        if (B < 128) { rwkv_idx(p, lds, B); for (int i = 0; i < 4; ++i) gdn_idx(p, lds, 128 + B * 4 + i); }
        else { gdn_idx(p, lds, B - 128); for (int i = 0; i < 4; ++i) rwkv_idx(p, lds, 128 + (B - 128) * 4 + i); }
    } else {
        for (int i = B; i < 640; i += G) { rwkv_idx(p, lds, i); gdn_idx(p, lds, i); }
    }
}

__device__ __forceinline__ void ph_post_ab(const P& p, bool dummy) {
    const int tid = tid_opaque(), lane = tid & 63, wave = tid >> 6;
    const bf16* p0 = (const bf16*)(p.ws + WS_R1); const bf16* lo = (const bf16*)(p.ws + WS_R2);
    bf16* MX = (bf16*)(p.ws + WS_MIX); const bf16* YB = (const bf16*)(p.ws + WS_H);
    bf16* MO = dummy ? (bf16*)(p.out + OUT_CKV) : MX;
    const int C = lane * 8;
    float mur[8], muk[8], muv[8], ka[8], rk[8], lw[8], lb[8], gn[8];
#pragma unroll
    for (int i = 0; i < 8; ++i) { mur[i] = p.in[19][C + i]; muk[i] = p.in[19][512 + C + i]; muv[i] = p.in[19][1024 + C + i]; ka[i] = p.in[26][C + i]; rk[i] = p.in[27][C + i];
        lw[i] = p.in[28][C + i]; lb[i] = p.in[29][C + i]; gn[i] = p.in[33][(C + i) & 127]; }
    for (int row = blockIdx.x * 8 + wave; row < M_TOK; row += gridDim.x * 8) {
        const int t = row < MP ? (row & 255) : ((row - MP) & 1023), L = row < MP ? 256 : 1024;
        const bool hp = t > 0, hn = t < L - 1;
        const u32x4 z4 = {0u, 0u, 0u, 0u};
        const bf16* pr = p0 + (size_t)row * LDP0 + C;
        float r[8], k[8], v[8];
        {
            const u32x4 c = *(const u32x4*)pr, a = hp ? *(const u32x4*)(pr - LDP0) : z4, n = hn ? *(const u32x4*)(pr + LDP0) : z4;
#pragma unroll
            for (int i = 0; i < 4; ++i) { float c0 = bflo(c[i]), c1 = bfhi(c[i]); r[2 * i] = c0 + mur[2 * i] * (0.5f * (bflo(a[i]) + bflo(n[i])) - c0); r[2 * i + 1] = c1 + mur[2 * i + 1] * (0.5f * (bfhi(a[i]) + bfhi(n[i])) - c1); }
        }
        {
            const u32x4 c = *(const u32x4*)(pr + 512), a = hp ? *(const u32x4*)(pr + 512 - LDP0) : z4, n = hn ? *(const u32x4*)(pr + 512 + LDP0) : z4;
#pragma unroll
            for (int i = 0; i < 4; ++i) { float c0 = bflo(c[i]), c1 = bfhi(c[i]); k[2 * i] = c0 + muk[2 * i] * (0.5f * (bflo(a[i]) + bflo(n[i])) - c0); k[2 * i + 1] = c1 + muk[2 * i + 1] * (0.5f * (bfhi(a[i]) + bfhi(n[i])) - c1); }
        }
        {
            const u32x4 c = *(const u32x4*)(pr + 1024), a = hp ? *(const u32x4*)(pr + 1024 - LDP0) : z4, n = hn ? *(const u32x4*)(pr + 1024 + LDP0) : z4;
#pragma unroll
            for (int i = 0; i < 4; ++i) { float c0 = bflo(c[i]), c1 = bfhi(c[i]); v[2 * i] = c0 + muv[2 * i] * (0.5f * (bflo(a[i]) + bflo(n[i])) - c0); v[2 * i + 1] = c1 + muv[2 * i + 1] * (0.5f * (bfhi(a[i]) + bfhi(n[i])) - c1); }
        }
        const u32x4 af = *(const u32x4*)(lo + (size_t)row * 2560 + 1024 + C), ab = *(const u32x4*)(lo + (size_t)row * 2560 + 1536 + C), gg = *(const u32x4*)(lo + (size_t)row * 2560 + 2048 + C);
        const u32x4 yf = *(const u32x4*)(MX + (size_t)row * 1024 + C), yb = *(const u32x4*)(YB + (size_t)row * 1024 + C);
        float y[8], s = 0.f, bon = 0.f;
#pragma unroll
        for (int i = 0; i < 4; ++i) {
            y[2 * i] = bflo(yf[i]) + bflo(yb[i]); y[2 * i + 1] = bfhi(yf[i]) + bfhi(yb[i]); s += y[2 * i] + y[2 * i + 1];
            const float am0 = 0.5f * (bflo(af[i]) + bflo(ab[i])), am1 = 0.5f * (bfhi(af[i]) + bfhi(ab[i]));
            bon += r[2 * i] * k[2 * i] * (1.0f + (am0 - 1.0f) * ka[2 * i]) * rk[2 * i] + r[2 * i + 1] * k[2 * i + 1] * (1.0f + (am1 - 1.0f) * ka[2 * i + 1]) * rk[2 * i + 1];
        }
        const float mean = red8(s) * (1.0f / 64.0f); bon = red8(bon);
        float q2 = 0.f;
#pragma unroll
        for (int i = 0; i < 8; ++i) { y[i] -= mean; q2 += y[i] * y[i]; }
        const float rstd = 1.0f / sqrtf(red8(q2) * (1.0f / 64.0f) + 64e-5f);
        u32x4 o;
#pragma unroll
        for (int i = 0; i < 4; ++i) {
            const float o0 = (y[2 * i] * rstd * lw[2 * i] + lb[2 * i] + bon * v[2 * i]) * bflo(gg[i]);
            const float o1 = (y[2 * i + 1] * rstd * lw[2 * i + 1] + lb[2 * i + 1] + bon * v[2 * i + 1]) * bfhi(gg[i]);
            o[i] = pk2(o0, o1);
        }
        const size_t orow = dummy ? (size_t)(row & 4095) : (size_t)row;
        *(u32x4*)(MO + orow * 1024 + C) = o;
        const u32x4 of = *(const u32x4*)(MX + (size_t)row * 1024 + 512 + C), ob = *(const u32x4*)(YB + (size_t)row * 1024 + 512 + C);
        const u32x4 zz = *(const u32x4*)(p0 + (size_t)row * LDP0 + 1920 + 1536 + C);
        float og[8], so = 0.f;
#pragma unroll
        for (int i = 0; i < 4; ++i) { og[2 * i] = bflo(of[i]) + bflo(ob[i]); og[2 * i + 1] = bfhi(of[i]) + bfhi(ob[i]); so += og[2 * i] * og[2 * i] + og[2 * i + 1] * og[2 * i + 1]; }
        const float rs = 1.0f / sqrtf(red16(so) * (1.0f / 128.0f) + 1e-6f);
        u32x4 o2;
#pragma unroll
        for (int i = 0; i < 4; ++i) { const float z0 = bflo(zz[i]), z1 = bfhi(zz[i]);
            o2[i] = pk2(og[2 * i] * rs * gn[2 * i] * siluf_(z0), og[2 * i + 1] * rs * gn[2 * i + 1] * siluf_(z1)); }
        *(u32x4*)(MO + orow * 1024 + 512 + C) = o2;
    }
}

__device__ __forceinline__ void ph_hyena_filters(const P& p, LAS unsigned char* lds) {
    LAS float* f0 = (LAS float*)lds;
    LAS float* h1 = f0 + 32 * 36;
    LAS float* h2 = h1 + 32 * 64;
    LAS bf16* stg = (LAS bf16*)(h2 + 64 * 32);
    LAS float* w1s = h2 + 64 * 32 + 8192;
    LAS float* w2s = w1s + 33 * 64;
    const int tid = tid_opaque();
    const float* b1 = p.in[41]; const float* b2 = p.in[43]; const float* w3 = p.in[44]; const float* fr = p.in[45];
    __syncthreads();
    if (blockIdx.x < 160) {
        for (int e = tid; e < 33 * 64; e += NTHREADS) w1s[e] = p.in[40][e];
        for (int e = tid; e < 64 * 64; e += NTHREADS) w2s[e] = p.in[42][e];
    }
    for (int item4 = blockIdx.x; item4 < 160; item4 += gridDim.x) {
        const int item = item4 >> 2, oo = item4 & 3;
        const int ls = item < 32 ? 1 : 0;
        const int L = ls ? 1024 : 256, t0 = (ls ? item : item - 32) * 32;
        const int o = tid + oo * 512;
        float wreg[16];
#pragma unroll
        for (int f = 0; f < 16; ++f) wreg[f] = w3[f * 2048 + o];
        __syncthreads();
        for (int e = tid; e < 32 * 33; e += NTHREADS) {
            const int pi = e / 33, f = e % 33; const float t = (float)(t0 + pi);
            float v;
            if (f == 0) v = t / (float)(L - 1);
            else { const int bi = (f - 1) & 15; const float band = 1e-4f + (15.0f - 1e-4f) * ((float)bi / 15.0f); const float ang = (6.283185307179586f / (float)L) * t * band; v = f <= 16 ? __cosf(ang) : -__sinf(ang); }
            f0[pi * 36 + f] = v;
        }
        __syncthreads();
        {
            const int j = tid & 63, pq = tid >> 6; const float bj = b1[j], fj = fr[j];
            float sacc[4] = {bj, bj, bj, bj};
#pragma unroll 3
            for (int f = 0; f < 33; ++f) { const float w = w1s[f * 64 + j];
#pragma unroll
                for (int i = 0; i < 4; ++i) sacc[i] += f0[(pq + 8 * i) * 36 + f] * w; }
#pragma unroll
            for (int i = 0; i < 4; ++i) h1[(pq + 8 * i) * 64 + j] = __sinf(fj * sacc[i]);
        }
        __syncthreads();
        {
            const int j = tid & 63, pq = tid >> 6; const float bj = b2[j], fj = fr[64 + j];
            float sacc[4] = {bj, bj, bj, bj};
#pragma unroll 4
            for (int f = 0; f < 64; ++f) { const float w = w2s[f * 64 + j];
#pragma unroll
                for (int i = 0; i < 4; ++i) sacc[i] += h1[(pq + 8 * i) * 64 + f] * w; }
#pragma unroll
            for (int i = 0; i < 4; ++i) h2[j * 32 + pq + 8 * i] = __sinf(fj * sacc[i]);
        }
        __syncthreads();
        bf16* G = (bf16*)(p.ws + (ls ? WS_GFS : WS_GFP));
        {
            const int c = o & 511;
            f32x4 sv[8];
#pragma unroll
            for (int i = 0; i < 8; ++i) sv[i] = (f32x4){0.f, 0.f, 0.f, 0.f};
#pragma unroll
            for (int fq = 0; fq < 4; ++fq) {
                float wn[16];
                if (fq < 3) {
#pragma unroll
                    for (int f = 0; f < 16; ++f) wn[f] = w3[((fq + 1) * 16 + f) * 2048 + o];
                }
#pragma unroll
                for (int f = 0; f < 16; ++f) { const float w = wreg[f]; const LAS f32x4* hp = (const LAS f32x4*)(h2 + (fq * 16 + f) * 32);
#pragma unroll
                    for (int i = 0; i < 8; ++i) sv[i] += hp[i] * w; }
                if (fq < 3) {
#pragma unroll
                    for (int f = 0; f < 16; ++f) wreg[f] = wn[f];
                }
            }
            const float delta = 3.0701134573253944f + (15.350567286626973f - 3.0701134573253944f) * ((float)c / 511.0f);
            const float inv = 1.0f / (float)(L - 1);
#pragma unroll
            for (int i = 0; i < 8; ++i) {
                const float ta = (float)(t0 + 4 * i) * inv, tb = (float)(t0 + 4 * i + 1) * inv, tc = (float)(t0 + 4 * i + 2) * inv, td = (float)(t0 + 4 * i + 3) * inv;
                *(LAS u32x2*)(stg + tid * 32 + 4 * i) = (u32x2){pk2(sv[i].x * __expf(-ta * delta), sv[i].y * __expf(-tb * delta)), pk2(sv[i].z * __expf(-tc * delta), sv[i].w * __expf(-td * delta))};
            }
            __syncthreads();
            const int lane = tid & 63, wv = tid >> 6, pi = lane & 31;
#pragma unroll 4
            for (int r = 0; r < 32; ++r) {
                const int col = wv * 64 + r * 2 + (lane >> 5);
                const int o2 = col + oo * 512, order2 = o2 >> 10, dr2 = (o2 >> 9) & 1, c2 = o2 & 511, t = t0 + pi;
                const bf16 hv = stg[col * 32 + pi];
                bf16* g = G + ((size_t)order2 * 512 + c2) * (2 * L);
                if (dr2 == 0) g[L - t] = hv;
                else if (t > 0) g[L + t] = hv;
                if (dr2 == 0 && t == 0) g[0] = 0;
            }
        }
    }
}

__device__ __forceinline__ void ph_mla_prep(const P& p, LAS unsigned char* lds) {
    const int tid = tid_opaque(), lane = tid & 63, wave = tid >> 6;
    const bf16* p1 = (const bf16*)(p.ws + WS_R1);
    bf16* qn = (bf16*)(p.ws + WS_H); bf16* ckva = (bf16*)(p.ws + WS_CKVA); bf16* kpea = (bf16*)(p.ws + WS_KPEA);
    const float* rope = (const float*)(p.ws + WS_ROPE);
    const float* qg = p.in[35]; const float* kg = p.in[37];
    const int nw = gridDim.x * 8;
    for (int row0 = blockIdx.x * 8 + wave; row0 < M_TOK; row0 += 4 * nw) {
        unsigned qw[4][3], kw[4]; u32x2 vw[4]; float sq[4], sk[4];
#pragma unroll
        for (int r = 0; r < 4; ++r) {
            const int row = (row0 + r * nw) < M_TOK ? (row0 + r * nw) : (M_TOK - 1);
            const bf16* pr = p1 + (size_t)row * LDP1;
#pragma unroll
            for (int j = 0; j < 3; ++j) qw[r][j] = *(const unsigned*)(pr + j * 128 + lane * 2);
            vw[r] = *(const u32x2*)(pr + 384 + lane * 4);
            kw[r] = lane < 16 ? *(const unsigned*)(pr + 640 + lane * 2) : 0u;
        }
#pragma unroll
        for (int r = 0; r < 4; ++r) {
            float s = 0.f;
#pragma unroll
            for (int j = 0; j < 3; ++j) s += bflo(qw[r][j]) * bflo(qw[r][j]) + bfhi(qw[r][j]) * bfhi(qw[r][j]);
            sq[r] = s;
            const f32x4 kv = unpk4(vw[r]); sk[r] = kv.x * kv.x + kv.y * kv.y + kv.z * kv.z + kv.w * kv.w;
        }
#pragma unroll
        for (int o = 1; o < 64; o <<= 1) {
#pragma unroll
            for (int r = 0; r < 4; ++r) { sq[r] += __shfl_xor(sq[r], o); sk[r] += __shfl_xor(sk[r], o); } }
#pragma unroll
        for (int r = 0; r < 4; ++r) {
            const int row = row0 + r * nw; if (row >= M_TOK) break;
            const float rq = rsqrtf_(sq[r] * (1.0f / 384.0f) + 1e-6f), rk = rsqrtf_(sk[r] * (1.0f / 256.0f) + 1e-6f);
#pragma unroll
            for (int j = 0; j < 3; ++j) { const int col = j * 128 + lane * 2; *(unsigned*)(qn + (size_t)row * 384 + col) = pk2(bflo(qw[r][j]) * rq * qg[col], bfhi(qw[r][j]) * rq * qg[col + 1]); }
            const f32x4 ck = unpk4(vw[r]) * rk * *(const f32x4*)(kg + lane * 4);
            *(u32x2*)(ckva + (size_t)row * 256 + lane * 4) = pk4(ck);
            if (row < MP) *(f32x4*)(p.out + OUT_CKV + (size_t)row * 256 + lane * 4) = ck;
            if (lane < 16) {
                float x1 = bflo(kw[r]), x2 = bfhi(kw[r]);
                if (row < MP) { *(f32x2*)(p.out + OUT_KPE + (size_t)row * 32 + lane * 2) = (f32x2){x1, x2}; }
                else { const int tq = (row - MP) & 1023; const f32x2 cs = *(const f32x2*)(rope + (size_t)tq * 32 + lane * 2); const float a = x1 * cs.x - x2 * cs.y, bq = x1 * cs.y + x2 * cs.x; x1 = a; x2 = bq; }
                *(unsigned*)(kpea + (size_t)row * 32 + lane * 2) = pk2(x1, x2);
            }
        }
    }
    for (int r2 = blockIdx.x * 8 + wave; r2 < 2048; r2 += nw) {
        const int row = M_TOK + r2;
        const f32x4 cv = *(const f32x4*)(p.in[4] + (size_t)r2 * 256 + lane * 4);
        *(u32x2*)(ckva + (size_t)row * 256 + lane * 4) = pk4(cv);
        if (lane < 16) { const f32x2 kp = *(const f32x2*)(p.in[5] + (size_t)r2 * 32 + lane * 2); *(unsigned*)(kpea + (size_t)row * 32 + lane * 2) = pk2(kp.x, kp.y); }
    }
    LAS float* tile = (LAS float*)(lds + wave * 8832);
    bf16* HT = (bf16*)(p.ws + WS_HYIN);
    const float* cw = p.in[39];
    for (int it = blockIdx.x * 8 + wave; it < 256 * 48; it += gridDim.x * 8) {
        const int rt = it / 48, cb = it % 48;
        const int r0 = rt * 64, col0 = 672 + cb * 32;
        const int t0 = r0 < MP ? (r0 & 255) : ((r0 - MP) & 1023), L = r0 < MP ? 256 : 1024;
        unsigned wv[17];
#pragma unroll
        for (int i = 0; i < 17; ++i) {
            const int rr = i * 4 + (lane >> 4), tt = t0 - 1 + rr;
            wv[i] = (rr < 66 && tt >= 0 && tt < L) ? *(const unsigned*)(p1 + (size_t)(r0 - 1 + rr) * LDP1 + col0 + (lane & 15) * 2) : 0u;
        }
#pragma unroll
        for (int i = 0; i < 17; ++i) {
            const int rr = i * 4 + (lane >> 4);
            if (rr < 66) { tile[rr * 33 + (lane & 15) * 2] = bflo(wv[i]); tile[rr * 33 + (lane & 15) * 2 + 1] = bfhi(wv[i]); }
        }
        LDS_WAIT();
#pragma unroll 8
        for (int c = 0; c < 32; ++c) {
            const int ch = cb * 32 + c;
            const float v = cw[ch] * tile[lane * 33 + c] + cw[1536 + ch] * tile[(lane + 1) * 33 + c] + cw[3072 + ch] * tile[(lane + 2) * 33 + c];
            HT[(size_t)ch * M_TOK + r0 + lane] = (bf16)(pk2(v, 0.f) & 0xffffu);
        }
        LDS_WAIT();
    }
}

__device__ __forceinline__ void attn_item(const P& p, LAS unsigned char* lds, int kind, int b, int head, int qt) {
    constexpr int KT_H = 128 * 104, VT_H = 64 * 136, TILE_B = (KT_H + VT_H) * 2;
    const int tid = tid_opaque(), lane = tid & 63, wave = tid >> 6, ln = lane & 15, h = lane >> 4;
    const bf16* Q = (const bf16*)(p.ws + WS_Q); const bf16* KN = (const bf16*)(p.ws + WS_KV); const bf16* VT = (const bf16*)(p.ws + WS_VT); const bf16* KPE = (const bf16*)(p.ws + WS_KPEA);
    bf16* MX = (bf16*)(p.ws + WS_MIX);
    const int nkeys = kind ? 1280 : 256, rowbase = kind ? MP + b * 1024 : b * 256, ntiles = nkeys / 128;
    const int qrow = rowbase + qt * 128 + wave * 16 + ln;
    s16x8 qf[3];
#pragma unroll
    for (int s = 0; s < 3; ++s) qf[s] = *(const s16x8*)(Q + (size_t)qrow * 768 + head * 96 + 32 * s + 8 * h);
    f32x4 o[4];
#pragma unroll
    for (int i = 0; i < 4; ++i) o[i] = (f32x4){0.f, 0.f, 0.f, 0.f};
    float mrun = -1e30f, lrun = 0.f;
    u32x4 Ak[3], Av[2], Bk[3], Bv[2];
#define ATT_LOAD(X, it) do { const int j0_ = (it) * 128; \
        const int kb_ = kind ? (j0_ < 1024 ? MP + b * 1024 + j0_ : M_TOK + b * 256 + (j0_ - 1024)) : b * 256 + j0_; \
        _Pragma("unroll") for (int i_ = 0; i_ < 3; ++i_) { const int c_ = tid + 512 * i_, key_ = c_ / 12, ch_ = c_ % 12; \
            X##k[i_] = *(const u32x4*)(ch_ < 8 ? KN + (size_t)(kb_ + key_) * 512 + head * 64 + ch_ * 8 : KPE + (size_t)(kb_ + key_) * 32 + (ch_ - 8) * 8); } \
        _Pragma("unroll") for (int i_ = 0; i_ < 2; ++i_) { const int c_ = tid + 512 * i_; \
            X##v[i_] = *(const u32x4*)(VT + (size_t)(head * 64 + (c_ >> 4)) * (M_TOK + 2048) + kb_ + (c_ & 15) * 8); } } while (0)
#define ATT_STORE(X, Kt_, Vt_) do { \
        _Pragma("unroll") for (int i_ = 0; i_ < 3; ++i_) { const int c_ = tid + 512 * i_; *(LAS u32x4*)(Kt_ + (c_ / 12) * 104 + (c_ % 12) * 8) = X##k[i_]; } \
        _Pragma("unroll") for (int i_ = 0; i_ < 2; ++i_) { const int c_ = tid + 512 * i_; *(LAS u32x4*)(Vt_ + (c_ >> 4) * 136 + (c_ & 15) * 8) = X##v[i_]; } } while (0)
    __syncthreads();
    ATT_LOAD(A, 0);
    if (ntiles > 1) ATT_LOAD(B, 1);
#pragma unroll 1
    for (int it = 0; it < ntiles; ++it) {
        LAS bf16* Kt = (LAS bf16*)(lds + (it & 1) * TILE_B);
        LAS bf16* Vt = Kt + KT_H;
        if (it & 1) ATT_STORE(B, Kt, Vt); else ATT_STORE(A, Kt, Vt);
        __syncthreads();
        if (it + 2 < ntiles) { if (it & 1) ATT_LOAD(B, it + 2); else ATT_LOAD(A, it + 2); }
        f32x4 sc[8]; float mx = -1e30f;
#pragma unroll
        for (int kt = 0; kt < 8; ++kt) {
            f32x4 a = {0.f, 0.f, 0.f, 0.f};
#pragma unroll
            for (int s = 0; s < 3; ++s) { const s16x8 kf = *(const LAS s16x8*)(Kt + (kt * 16 + ln) * 104 + 32 * s + 8 * h); a = __builtin_amdgcn_mfma_f32_16x16x32_bf16(kf, qf[s], a, 0, 0, 0); }
            sc[kt] = a; mx = fmaxf(mx, fmaxf(fmaxf(a[0], a[1]), fmaxf(a[2], a[3])));
        }
        mx = fmaxf(mx, __shfl_xor(mx, 16)); mx = fmaxf(mx, __shfl_xor(mx, 32));
        const float mnew = fmaxf(mrun, mx), alpha = __expf(mrun - mnew);
        mrun = mnew;
        float ps = 0.f;
#pragma unroll
        for (int kt = 0; kt < 8; ++kt)
#pragma unroll
            for (int r = 0; r < 4; ++r) { sc[kt][r] = __expf(sc[kt][r] - mnew); ps += sc[kt][r]; }
        lrun = lrun * alpha + ps;
#pragma unroll
        for (int i = 0; i < 4; ++i) o[i] = o[i] * alpha;
#pragma unroll
        for (int s = 0; s < 4; ++s) {
            u32x4 pw; pw.x = pk2(sc[2 * s][0], sc[2 * s][1]); pw.y = pk2(sc[2 * s][2], sc[2 * s][3]); pw.z = pk2(sc[2 * s + 1][0], sc[2 * s + 1][1]); pw.w = pk2(sc[2 * s + 1][2], sc[2 * s + 1][3]);
            const s16x8 pf = __builtin_bit_cast(s16x8, pw);
#pragma unroll
            for (int vt = 0; vt < 4; ++vt) {
                const LAS bf16* vp = Vt + (vt * 16 + ln) * 136 + 32 * s + 4 * h;
                const u32x2 lo2 = *(const LAS u32x2*)vp, hi2 = *(const LAS u32x2*)(vp + 16);
                const u32x4 vw = {lo2.x, lo2.y, hi2.x, hi2.y};
                o[vt] = __builtin_amdgcn_mfma_f32_16x16x32_bf16(__builtin_bit_cast(s16x8, vw), pf, o[vt], 0, 0, 0);
            }
        }
    }
#undef ATT_LOAD
#undef ATT_STORE
    lrun += __shfl_xor(lrun, 16); lrun += __shfl_xor(lrun, 32);
    const float inv = 1.0f / lrun;
#pragma unroll
    for (int vt = 0; vt < 4; ++vt) *(u32x2*)(MX + (size_t)qrow * 1024 + head * 64 + vt * 16 + 4 * h) = pk4(o[vt] * inv);
}

__device__ __forceinline__ void hyena_item(const P& p, LAS unsigned char* lds, int kind, int cgp) {
    const int tid = tid_opaque(), lane = tid & 63, wave = tid >> 6, ci = wave >> 2, qtr = wave & 3;
    const int L = kind ? 1024 : 256, NB = kind ? 8 : 32, base = kind ? MP : 0, c = cgp * 2 + ci;
    const int DMAX = kind ? 31 : 7;
    constexpr int ZCH = 8704;
    LAS bf16* zb = (LAS bf16*)lds;
    LAS bf16* gb = zb + 2 * ZCH;
    LAS bf16* gb1 = gb + 4 * 2048;
    LAS bf16* gl = gb1 + 4 * 2048;
    const bf16* HT = (const bf16*)(p.ws + WS_HYIN);
    const bf16* G = (const bf16*)(p.ws + (kind ? WS_GFS : WS_GFP));
    bf16* HO = (bf16*)(p.ws + WS_H);
    __syncthreads();
    const int Lp = L + 8;
    for (int i = tid; i < 2 * 1024; i += NTHREADS) { const int cc = i >> 10, off = (i & 1023) * 8;
        *(LAS u32x4*)(zb + cc * ZCH + (off / L) * Lp + (off % L)) = *(const u32x4*)(HT + (size_t)(cgp * 2 + cc) * M_TOK + base + off); }
    for (int i = tid; i < 4 * (2 * L / 8); i += NTHREADS) { const int co = i / (2 * L / 8), off = (i % (2 * L / 8)) * 8, cc = co >> 1, od = co & 1;
        *(LAS u32x4*)(gb + (cc * 2 + od) * 2 * L + off) = *(const u32x4*)(G + ((size_t)od * 512 + cgp * 2 + cc) * (2 * L) + off);
        *(LAS u32x4*)(gb1 + (cc * 2 + od) * 2 * L + off) = *(const u32x4*)(G + ((size_t)od * 512 + cgp * 2 + cc) * (2 * L) + off + 1); }
    for (int i = tid; i < 4 * 1024; i += NTHREADS) { const int oc = i >> 10, off = (i & 1023) * 8;
        *(LAS u32x4*)(gl + oc * ZCH + (off / L) * Lp + (off % L)) = *(const u32x4*)(HT + (size_t)(((oc >> 1) + 1) * 512 + cgp * 2 + (oc & 1)) * M_TOK + base + off); }
    __syncthreads();
    const int n = lane & 31, h = lane >> 5;
    const int jl = kind ? (n & 3) : 0, bb = kind ? (n >> 2) : n;
    const LAS bf16* zc = zb + ci * ZCH + bb * Lp;
#pragma unroll 1
    for (int order = 0; order < 2; ++order) {
        const LAS bf16* gr = (n & 1) ? gb1 + (ci * 2 + order) * 2 * L - 1 : gb + (ci * 2 + order) * 2 * L;
        f32x16 acc[2];
#pragma unroll
        for (int g = 0; g < 2; ++g)
#pragma unroll
            for (int r = 0; r < 16; ++r) acc[g][r] = 0.f;
        const int Ilo_w = kind ? 8 * qtr : 2 * qtr, Ihi_w = kind ? 8 * qtr + 7 : 2 * qtr + 1;
        int Dlo = Ilo_w - (L / 32 - 1), Dhi = Ihi_w; if (Dlo < -DMAX) Dlo = -DMAX; if (Dhi > DMAX) Dhi = DMAX;
#define HY_LOAD(DD, A0, A1, B00, B01, B10, B11) do { \
            const volatile LAS unsigned* ap_ = (const volatile LAS unsigned*)(gr + (L - 32 * (DD) + 8 * h - n)); \
            A0.x = ap_[0]; A0.y = ap_[1]; A0.z = ap_[2]; A0.w = ap_[3]; A1.x = ap_[8]; A1.y = ap_[9]; A1.z = ap_[10]; A1.w = ap_[11]; \
            const int J0_ = (kind ? 8 * qtr + jl : 2 * qtr) - (DD), J1_ = (kind ? 8 * qtr + 4 + jl : 2 * qtr + 1) - (DD); \
            const bool k0_ = J0_ >= 0 && J0_ < L / 32, k1_ = J1_ >= 0 && J1_ < L / 32; \
            const LAS bf16* z0_ = zc + 32 * (k0_ ? J0_ : 0) + 8 * h; const LAS bf16* z1_ = zc + 32 * (k1_ ? J1_ : 0) + 8 * h; \
            B00 = *(const LAS u32x4*)z0_; B10 = *(const LAS u32x4*)(z0_ + 16); B01 = *(const LAS u32x4*)z1_; B11 = *(const LAS u32x4*)(z1_ + 16); \
            B00.x = k0_ ? B00.x : 0u; B00.y = k0_ ? B00.y : 0u; B00.z = k0_ ? B00.z : 0u; B00.w = k0_ ? B00.w : 0u; B10.x = k0_ ? B10.x : 0u; B10.y = k0_ ? B10.y : 0u; B10.z = k0_ ? B10.z : 0u; B10.w = k0_ ? B10.w : 0u; \
            B01.x = k1_ ? B01.x : 0u; B01.y = k1_ ? B01.y : 0u; B01.z = k1_ ? B01.z : 0u; B01.w = k1_ ? B01.w : 0u; B11.x = k1_ ? B11.x : 0u; B11.y = k1_ ? B11.y : 0u; B11.z = k1_ ? B11.z : 0u; B11.w = k1_ ? B11.w : 0u; \
        } while (0)
        u32x4 cA0, cA1, cB00, cB01, cB10, cB11;
        HY_LOAD(Dlo, cA0, cA1, cB00, cB01, cB10, cB11);
#pragma unroll 1
        for (int D = Dlo; D <= Dhi; ++D) {
            u32x4 nA0, nA1, nB00, nB01, nB10, nB11;
            HY_LOAD(D + 1, nA0, nA1, nB00, nB01, nB10, nB11);
            acc[0] = __builtin_amdgcn_mfma_f32_32x32x16_bf16(__builtin_bit_cast(s16x8, cA0), __builtin_bit_cast(s16x8, cB00), acc[0], 0, 0, 0);
            acc[1] = __builtin_amdgcn_mfma_f32_32x32x16_bf16(__builtin_bit_cast(s16x8, cA0), __builtin_bit_cast(s16x8, cB01), acc[1], 0, 0, 0);
            acc[0] = __builtin_amdgcn_mfma_f32_32x32x16_bf16(__builtin_bit_cast(s16x8, cA1), __builtin_bit_cast(s16x8, cB10), acc[0], 0, 0, 0);
            acc[1] = __builtin_amdgcn_mfma_f32_32x32x16_bf16(__builtin_bit_cast(s16x8, cA1), __builtin_bit_cast(s16x8, cB11), acc[1], 0, 0, 0);
            cA0 = nA0; cA1 = nA1; cB00 = nB00; cB01 = nB01; cB10 = nB10; cB11 = nB11;
        }
#undef HY_LOAD
        const float bias = p.in[46][order * 512 + c];
        const LAS bf16* gate = gl + (order * 2 + ci) * ZCH + bb * Lp;
        u32x2 zn[2][4];
#pragma unroll
        for (int g = 0; g < 2; ++g) {
            const int og = qtr * 2 + g, I = kind ? 4 * og + jl : og;
#pragma unroll
            for (int rq = 0; rq < 4; ++rq) {
                const int t = 32 * I + 8 * rq + 4 * h;
                const f32x4 zo = unpk4(*(const LAS u32x2*)(zc + t)), gt = unpk4(*(const LAS u32x2*)(gate + t));
                f32x4 y; y.x = acc[g][4 * rq]; y.y = acc[g][4 * rq + 1]; y.z = acc[g][4 * rq + 2]; y.w = acc[g][4 * rq + 3];
                zn[g][rq] = pk4(gt * (y + zo * bias));
            }
        }
        __syncthreads();
#pragma unroll
        for (int g = 0; g < 2; ++g) { const int og = qtr * 2 + g, I = kind ? 4 * og + jl : og;
#pragma unroll
            for (int rq = 0; rq < 4; ++rq) *(LAS u32x2*)(zb + ci * ZCH + bb * Lp + 32 * I + 8 * rq + 4 * h) = zn[g][rq]; }
        __syncthreads();
    }
    for (int i = tid; i < 2 * 1024; i += NTHREADS) { const int cc = i >> 10, off = (i & 1023) * 8;
        *(u32x4*)(HO + (size_t)(cgp * 2 + cc) * M_TOK + base + off) = *(const LAS u32x4*)(zb + cc * ZCH + (off / L) * Lp + (off % L)); }
}
#ifndef DUP_SUB
#define DUP_SUB 3
#endif
__device__ __forceinline__ void ph_attn_hyena(const P& p, LAS unsigned char* lds, bool dummy) {
    const int B = blockIdx.x, G = gridDim.x;
#ifndef T_NO_ATTN
    if (!dummy || (DUP_SUB & 1))
    for (int i = B; i < 1024; i += G) { if (i < 512) attn_item(p, lds, 1, i >> 6, (i >> 3) & 7, i & 7); else { const int j = i - 512; attn_item(p, lds, 0, j >> 4, (j >> 1) & 7, j & 1); } }
#endif
#ifndef T_NO_HY
    if (!dummy || (DUP_SUB & 2))
    for (int i = B; i < 512; i += G) { hyena_item(p, lds, i < 256 ? 1 : 0, i & 255); }
#endif
}

__device__ __forceinline__ void ph_hy_transpose(const P& p, LAS unsigned char* lds) {
    const int tid = tid_opaque(), lane = tid & 63, wave = tid >> 6;
    LAS bf16* tile = (LAS bf16*)(lds + wave * 9216);
    const bf16* HO = (const bf16*)(p.ws + WS_H); bf16* MX = (bf16*)(p.ws + WS_MIX);
    for (int it = blockIdx.x * 8 + wave; it < 2048; it += gridDim.x * 8) {
        const int rt = it >> 3, cb = it & 7, r0 = rt * 64, c0 = cb * 64;
#pragma unroll
        for (int i = 0; i < 8; ++i) { const int id = i * 64 + lane, c = id >> 3, rc = id & 7;
            *(LAS u32x4*)(tile + c * 72 + rc * 8) = *(const u32x4*)(HO + (size_t)(c0 + c) * M_TOK + r0 + rc * 8); }
        LDS_WAIT();
        bf16* dst = MX + (size_t)(r0 + lane) * 1024 + 512 + c0;
#pragma unroll
        for (int j = 0; j < 8; ++j) {
            u32x4 w;
#pragma unroll
            for (int i = 0; i < 4; ++i) { const unsigned a = tile[(j * 8 + 2 * i) * 72 + lane], bq = tile[(j * 8 + 2 * i + 1) * 72 + lane]; w[i] = a | (bq << 16); }
            *(u32x4*)(dst + j * 8) = w;
        }
        LDS_WAIT();
    }
}

#define XB_TMO      128
#define XB_XCNT(j)  (256  + 64 * (j))
#define XB_XSUB(j)  (1280 + 64 * (j))
#define XB_XGEN(j)  (2304 + 64 * (j))
#define XB_TOP      3328
#define XB_TOPGEN   3392
#define XCD_BAR_WORDS 3456
#define XB_SPIN_CAP (1u << 18)

__device__ __forceinline__ unsigned xb_ld(unsigned* p)              { return __hip_atomic_load(p, __ATOMIC_RELAXED, __HIP_MEMORY_SCOPE_AGENT); }
__device__ __forceinline__ unsigned xb_add(unsigned* p, unsigned v) { return __hip_atomic_fetch_add(p, v, __ATOMIC_RELAXED, __HIP_MEMORY_SCOPE_AGENT); }
__device__ __forceinline__ unsigned xb_xcc_id() { return (unsigned)__builtin_amdgcn_s_getreg((3 << 11) | 20) & 0xFu; }
#define XB_SPIN(cond, bar) do { unsigned _sp = 0; while (cond) { __builtin_amdgcn_s_sleep(1); \
    if ((++_sp & 255u) == 0u) { if (xb_ld(&(bar)[XB_TMO])) break; if (_sp > XB_SPIN_CAP) { atomicAdd(&(bar)[XB_TMO], 1u); break; } } } } while (0)

struct XcdBarrier {
    unsigned* bar; unsigned x;
    volatile LAS unsigned* st;
};

__device__ __forceinline__ XcdBarrier xcd_barrier_post(unsigned* bar, volatile LAS unsigned* st) {
    XcdBarrier b; b.bar = bar; b.x = xb_xcc_id(); b.st = st;
    if (threadIdx.x == 0) (void)xb_add(&bar[XB_XCNT(b.x)], 1u);
    return b;
}
__device__ __forceinline__ void xcd_barrier_complete(unsigned* bar, unsigned x, unsigned& nloc, unsigned& nx) {
    const unsigned G = gridDim.x * gridDim.y * gridDim.z;
    unsigned sum, cnt, mine, sp = 0u;
    for (;;) {
        sum = 0u; cnt = 0u; mine = 0u;
#pragma unroll
        for (unsigned j = 0; j < 16; ++j) { const unsigned c = xb_ld(&bar[XB_XCNT(j)]); sum += c; cnt += (c > 0u) ? 1u : 0u; mine = (j == x) ? c : mine; }
        if (sum == G) break;
        __builtin_amdgcn_s_sleep(1);
        if ((++sp & 255u) == 0u) { if (xb_ld(&bar[XB_TMO])) break; if (sp > XB_SPIN_CAP) { atomicAdd(&bar[XB_TMO], 1u); break; } }
    }
    nloc = mine > 0u ? mine : 1u; nx = cnt > 0u ? cnt : 1u;
}

__device__ __forceinline__ void xcd_barrier(const XcdBarrier& b) {
    asm volatile("s_waitcnt vmcnt(0)" ::: "memory");
    __syncthreads();
    if (threadIdx.x == 0) {
        unsigned* bar = b.bar;
        __builtin_amdgcn_s_waitcnt(0);
        unsigned nloc = b.st[0], nx = b.st[1];
        if (nloc == 0u) { xcd_barrier_complete(bar, b.x, nloc, nx); b.st[0] = nloc; b.st[1] = nx; }
        const unsigned old = xb_add(&bar[XB_XSUB(b.x)], 1u);
        const unsigned gen = old / nloc;
        if (old + 1u == (gen + 1u) * nloc) {
            __builtin_amdgcn_fence(__ATOMIC_RELEASE, "agent");
            asm volatile("s_waitcnt vmcnt(0)" ::: "memory");
            const unsigned og = xb_add(&bar[XB_TOP], 1u);
            const unsigned tg = og / nx;
            if (og + 1u == (tg + 1u) * nx) xb_add(&bar[XB_TOPGEN], 1u);
            else XB_SPIN(xb_ld(&bar[XB_TOPGEN]) == tg, bar);
            __builtin_amdgcn_fence(__ATOMIC_ACQUIRE, "agent");
            xb_add(&bar[XB_XGEN(b.x)], 1u);
            asm volatile("s_waitcnt vmcnt(0)" ::: "memory");
        } else {
            XB_SPIN(xb_ld(&bar[XB_XGEN(b.x)]) == gen, bar);
            __builtin_amdgcn_fence(__ATOMIC_ACQUIRE, "agent");
            asm volatile("s_waitcnt vmcnt(0)" ::: "memory");
        }
    }
    __syncthreads();
}


template <class Epi>
__device__ __forceinline__ void run_gemm(LAS unsigned char* lds, const bf16* A, const bf16* Bt, int M, int N, int K, const Epi& E, int rot = 0) {
    asm volatile("" : "+s"(K));
    pg8::Gemm g{A, Bt, M, N, K}; pg8::StaticOrder S; S.init(M, N, (int)gridDim.x, (int)((blockIdx.x + gridDim.x - rot) % gridDim.x));
    pg8::gemm_phase<Epi, pg8::StaticOrder, true, true>(lds, g, S, E);
}

#ifndef DUP_PH
#define DUP_PH (-1)
#endif
__device__ __forceinline__ void run_phase(const P& p, LAS unsigned char* lds, int k, bool dummy) {
    if (k == 0) {
        { float* cvz0 = (float*)(p.ws + WS_CV); for (int i = blockIdx.x * NTHREADS + tid_opaque(); i < 2 * CV_STRIDE; i += gridDim.x * NTHREADS) cvz0[i] = 0.f; }
        adaln_layer(p, lds, 0, 0); adaln_layer(p, lds, 1, (int)gridDim.x / 2); ph_rope_table(p); return; }
    if (k == 27) { final_norm_rows(p); return; }
    const int layer = (k - 1) / 13, sub = (k - 1) % 13;
    float* x = p.out;
    const float* mod = (const float*)(p.ws + WS_MOD);
    bf16* H = (bf16*)(p.ws + WS_H); bf16* R1 = (bf16*)(p.ws + WS_R1);
    float* ssb = (float*)(p.ws + WS_SS); float* cvb = (float*)(p.ws + WS_CV); float* ssp = (float*)(p.ws + WS_R2);
    switch (sub) {
    case 0: case 3: case 10: {
        const int jn = sub == 0 ? 0 : (sub == 3 ? 1 : 2), uu = 3 * layer + jn;
        float* cvo = cvb + (size_t)(uu & 1) * CV_STRIDE; float* cvz = cvb + (size_t)((uu + 1) & 1) * CV_STRIDE;
        const float* shift = mod + (size_t)layer * 9 * 9216 + (3 * jn) * 1024;
        for (int i = blockIdx.x * NTHREADS + tid_opaque(); i < CV_STRIDE; i += gridDim.x * NTHREADS) cvz[i] = 0.f;
        if (uu == 0) first_rows(p, p.in[10], ssb);
        else { const int t = tid_opaque();
            if (t < 64) for (int row = blockIdx.x * 64 + t; row < M_TOK; row += gridDim.x * 64) { float a = 0.f;
#pragma unroll
                for (int q = 0; q < 16; ++q) a += ssp[q * M_TOK + row];
                ssb[row] = rsqrtf_(a * (1.0f / 1024.0f) + 1e-6f); } }
        if (sub != 3) convert_ffn_weights(p, layer, sub == 0 ? 0 : 1, lds, shift, cvo);
        else {
            transpose_w<0>(p.in[17] + (size_t)layer * 1024 * 1024, 1024, 1024, 1024, (bf16*)(p.ws + W_OUT), 1024, lds, nullptr, nullptr, 0, layer == 0 ? 128 : 232);
            if (layer == 0) { transpose_w<0>(p.in[18], 3984, 3984, 1024, (bf16*)(p.ws + W_IN), 4096, lds, shift, cvo, 4096); build_lora_w(p); }
            else { transpose_w<0>(p.in[34], 2208, 2208, 1024, (bf16*)(p.ws + W_IN), 2304, lds, shift, cvo, 2304, 160);
                transpose_w<0>(p.in[36], 768, 768, 384, (bf16*)(p.ws + W_UQ), 768, lds, nullptr, nullptr, 0, 8);
                transpose_w<0>(p.in[38], 1024, 1024, 256, (bf16*)(p.ws + W_UKV), 1024, lds, nullptr, nullptr, 0, 17);
                ph_hyena_filters(p, lds); }
        }
    } break;
    case 1: case 11: { const int uu = 3 * layer + (sub == 1 ? 0 : 2);
        run_gemm(lds, H, (const bf16*)(p.ws + W_GU), M_TOK, 5632, 1024, EpiSwigluN{R1, ssb, cvb + (size_t)(uu & 1) * CV_STRIDE}); } break;
    case 2: case 12: {
        const bool first = layer == 0 && sub == 2;
        const float* xp = first ? p.in[0] : x; const float* xs = first ? p.in[1] : x + (size_t)MP * DM;
        const float* gate = mod + (size_t)layer * 9 * 9216 + (sub == 2 ? 2 : 8) * 1024;
        if (layer == 1 && sub == 12) { const EpiResid E{xp, xs, x, gate, 0.5f}; run_gemm(lds, R1, (const bf16*)(p.ws + W_DOWN), M_TOK, 1024, 2816, E); }
        else {
            const int ln = sub == 12 ? layer + 1 : layer, jn = sub == 2 ? 1 : 0, uu = 3 * ln + jn;
            const EpiResidN E{xp, xs, x, gate, p.in[jn == 0 ? 10 : 11] + ln * 1024, mod + (size_t)ln * 9 * 9216 + (3 * jn + 1) * 1024, H, ssp, 0.5f};
            run_gemm(lds, R1, (const bf16*)(p.ws + W_DOWN), M_TOK, 1024, 2816, E);
        }
    } break;
    case 9: {
        const int uu = 3 * layer + 2;
        const EpiResidN E{x, x + (size_t)MP * DM, x, mod + (size_t)layer * 9 * 9216 + 5 * 1024, p.in[12] + layer * 1024, mod + (size_t)layer * 9 * 9216 + 7 * 1024, H, ssp, 1.0f};
        run_gemm(lds, (const bf16*)(p.ws + WS_MIX), (const bf16*)(p.ws + W_OUT), M_TOK, 1024, 1024, E);
    } break;
    case 4: {
        const int N = layer == 0 ? 4096 : 2304, ld = layer == 0 ? LDP0 : LDP1, uu = 3 * layer + 1;
        run_gemm(lds, H, (const bf16*)(p.ws + W_IN), M_TOK, N, 1024, EpiStoreN{R1, ld, ld, ssb, cvb + (size_t)(uu & 1) * CV_STRIDE, N});
    } break;
    case 5: if (layer == 0) ph_lora_in(p); else ph_mla_prep(p, lds); break;
    case 6:
        if (layer == 0) run_gemm(lds, H, (const bf16*)(p.ws + W_LORA), M_TOK, 2560, 384, EpiLora{(bf16*)(p.ws + WS_R2), p.in[20], p.in[22]});
        else { run_gemm(lds, (const bf16*)(p.ws + WS_CKVA), (const bf16*)(p.ws + W_UKV), M_TOK + 2048, 1024, 256, EpiKV{(bf16*)(p.ws + WS_KV), (bf16*)(p.ws + WS_VT), M_TOK + 2048});
            run_gemm(lds, H, (const bf16*)(p.ws + W_UQ), M_TOK, 768, 384, EpiQ{(bf16*)(p.ws + WS_Q), (const float*)(p.ws + WS_ROPE)}, 32); }
        break;
    case 7: if (layer == 0) ph_scan(p, lds); else ph_attn_hyena(p, lds, dummy); break;
    case 8: if (layer == 0) ph_post_ab(p, dummy); else ph_hy_transpose(p, lds); break;
    default: break;
    }
}

__global__ void __launch_bounds__(NTHREADS, 2) hybrid_fwd(P p) {
    extern __shared__ __attribute__((aligned(16))) unsigned char lds_raw[];
    LAS unsigned char* lds = (LAS unsigned char*)lds_raw;
    cg::grid_group grid = cg::this_grid();
    volatile LAS unsigned* bst = (volatile LAS unsigned*)(lds + LDS_BYTES - 64);
    if (threadIdx.x < 16) bst[threadIdx.x] = 0u;
    __syncthreads();
    XcdBarrier bar = xcd_barrier_post((unsigned*)(p.ws + WS_CTL) + 1024, bst);
#pragma unroll 1
    for (int k = p.ph_lo; k < p.ph_hi; ++k) {
        const int nrep = (DUP_PH >= 0 && k == DUP_PH) ? 2 : 1;
#pragma unroll 1
        for (int rep = 0; rep < nrep; ++rep) { run_phase(p, lds, k, rep + 1 < nrep); if (rep + 1 < nrep) __syncthreads(); }
        if (k + 1 < p.ph_hi) { if (p.ph_hi < 0) grid.sync(); else { xcd_barrier(bar);
        } }
    }
}

extern "C" void kernel_launch(void* const* d_in, const int* in_sizes, int n_in, void* d_out, int out_size, void* d_ws, size_t ws_size, hipStream_t stream) {
    static int grid = 0;
    if (grid == 0) {
        if (n_in != 48 || out_size != 25427968 || ws_size < WS_END) {
            fprintf(stderr, "kernel_launch: expected 48 inputs, 25427968 outputs, >= %zu B workspace; got %d, %d, %zu\n", (size_t)WS_END, n_in, out_size, ws_size);
            grid = -1; return;
        }
        int dev = 0, cus = 0, per_cu = 0;
        hipGetDevice(&dev);
        hipDeviceGetAttribute(&cus, hipDeviceAttributeMultiprocessorCount, dev);
        hipFuncSetAttribute((const void*)hybrid_fwd, hipFuncAttributeMaxDynamicSharedMemorySize, LDS_BYTES);
        hipOccupancyMaxActiveBlocksPerMultiprocessor(&per_cu, (const void*)hybrid_fwd, NTHREADS, LDS_BYTES);
        if (per_cu < 1) { fprintf(stderr, "kernel_launch: occupancy query says %d blocks/CU\n", per_cu); per_cu = 1; }
        (void)hipGetLastError();
        grid = cus;
    }
    if (grid < 0) return;
    (void)hipMemsetAsync((char*)d_ws + WS_CTL, 0, 24 * 1024, stream);
    P prm{};
    for (int i = 0; i < 48; ++i) prm.in[i] = (const float*)d_in[i];
    prm.out = (float*)d_out; prm.ws = (unsigned char*)d_ws;
#ifndef N_SPLIT
    prm.ph_lo = 0; prm.ph_hi = 28;
    void* args[] = {&prm};
    hipError_t e = hipLaunchCooperativeKernel((const void*)hybrid_fwd, dim3(grid), dim3(NTHREADS), args, LDS_BYTES, stream);
    if (e != hipSuccess) fprintf(stderr, "cooperative launch failed: %s (grid %d)\n", hipGetErrorString(e), grid);
#else
    for (int k = 0; k < 28; ++k) {
        prm.ph_lo = k; prm.ph_hi = k + 1;
        void* args[] = {&prm};
        hipError_t e = hipLaunchCooperativeKernel((const void*)hybrid_fwd, dim3(grid), dim3(NTHREADS), args, LDS_BYTES, stream);
        if (e != hipSuccess) { fprintf(stderr, "launch %d failed: %s\n", k, hipGetErrorString(e)); break; }
    }
#endif
}
```

```cpp
#include <hip/hip_runtime.h>
#include <hip/hip_cooperative_groups.h>
#include <cstdio>
#include <cstdint>
namespace cg = cooperative_groups;

#define LAS __attribute__((address_space(3)))
typedef unsigned short bf16;
typedef float f32x2 __attribute__((ext_vector_type(2)));
typedef float f32x4 __attribute__((ext_vector_type(4)));
typedef float f32x16 __attribute__((ext_vector_type(16)));
typedef unsigned u32x2 __attribute__((ext_vector_type(2)));
typedef unsigned u32x4 __attribute__((ext_vector_type(4)));
typedef short s16x8 __attribute__((ext_vector_type(8)));

constexpr int M_TOK = 16384, MP = 8192, DM = 1024, DFF = 2816;
constexpr int LDP0 = 3984, LDP1 = 2304;
constexpr int OUT_YS = 8388608, OUT_SRW = 16777216, OUT_SGD = 18874368, OUT_CKV = 23068672, OUT_KPE = 25165824;

constexpr size_t MiB = 1ull << 20;
constexpr size_t WS_CTL = 0;
constexpr size_t WS_SS = 64 * 1024;
constexpr size_t WS_ROPE = 512 * 1024;
constexpr size_t WS_CV = 2 * 1048576 + 16 * 1048576 + 524288;
constexpr int CV_STRIDE = 9 * 5632;
constexpr size_t WS_MOD = 1 * MiB;
constexpr size_t WS_W = 2 * MiB;
constexpr size_t W_GU = WS_W, W_DOWN = WS_W + 11 * MiB;
constexpr size_t W_IN = WS_W, W_OUT = WS_W + 8 * MiB, W_LORA = WS_W + 10 * MiB, W_UQ = WS_W + 12 * MiB, W_UKV = WS_W + 13 * MiB;
constexpr size_t WS_H = 19 * MiB;
constexpr size_t WS_MIX = 51 * MiB;
constexpr size_t WS_R1 = 83 * MiB;
constexpr size_t R1_BYTES = 130547712;
constexpr size_t WS_HYIN = WS_R1 + 72 * MiB;
constexpr size_t WS_R2 = WS_R1 + R1_BYTES;
constexpr size_t WS_Q = WS_R2, WS_KV = WS_R2 + 24 * MiB, WS_VT = WS_R2 + 42 * MiB, WS_CKVA = WS_R2 + 60 * MiB, WS_KPEA = WS_R2 + 69 * MiB, WS_GFS = WS_R2 + 71 * MiB, WS_GFP = WS_R2 + 75 * MiB;
constexpr size_t WS_END = WS_R2 + 80 * MiB;

constexpr int LDS_BYTES = 159744;
constexpr int NTHREADS = 512;

struct P {
    const float* in[48];
    float* out;
    unsigned char* ws;
    int ph_lo, ph_hi;
};

__device__ __forceinline__ float bf2f(unsigned b) { return __uint_as_float(b << 16); }
__device__ __forceinline__ float bflo(unsigned w) { return __uint_as_float(w << 16); }
__device__ __forceinline__ float bfhi(unsigned w) { return __uint_as_float(w & 0xffff0000u); }
typedef __bf16 bf16x2_t __attribute__((ext_vector_type(2)));
__device__ __forceinline__ unsigned pk2(float lo, float hi) { const f32x2 v = {lo, hi}; return __builtin_bit_cast(unsigned, __builtin_convertvector(v, bf16x2_t)); }
__device__ __forceinline__ f32x4 unpk4(u32x2 w) { return (f32x4){bflo(w.x), bfhi(w.x), bflo(w.y), bfhi(w.y)}; }
__device__ __forceinline__ u32x2 pk4(f32x4 v) { return (u32x2){pk2(v.x, v.y), pk2(v.z, v.w)}; }
__device__ __forceinline__ float wave_sum(float v) {
#pragma unroll
    for (int o = 1; o < 64; o <<= 1) v += __shfl_xor(v, o);
    return v;
}
__device__ __forceinline__ float dpp_f(float x, int) { return x; }
#define DPPF(x, ctrl) __int_as_float(__builtin_amdgcn_update_dpp(0, __float_as_int(x), (ctrl), 0xF, 0xF, true))
__device__ __forceinline__ float red4(float x) { x += DPPF(x, 0xB1); x += DPPF(x, 0x4E); return x; }
__device__ __forceinline__ float red8(float x) { x = red4(x); x += DPPF(x, 0x141); return x; }
__device__ __forceinline__ float red16(float x) { x = red8(x); x += DPPF(x, 0x140); return x; }
__device__ __forceinline__ float sigmoidf_(float x) { return __builtin_amdgcn_rcpf(1.0f + __expf(-x)); }
__device__ __forceinline__ float siluf_(float x) { return x * __builtin_amdgcn_rcpf(1.0f + __expf(-x)); }
__device__ __forceinline__ float rsqrtf_(float x) { return __builtin_amdgcn_rsqf(x); }
__device__ __forceinline__ int cond_of_row(int row) { return row < MP ? 0 : 1 + ((row - MP) >> 10); }
__device__ __forceinline__ int tid_opaque() { int t = threadIdx.x; asm volatile("" : "+v"(t)); return t; }
#define LDS_WAIT() asm volatile("s_waitcnt lgkmcnt(0)" ::: "memory")

namespace pg8 {
#define PG8_LAS __attribute__((address_space(3)))
typedef unsigned short bf16_t;
typedef short bf16x8 __attribute__((ext_vector_type(8)));
typedef float f32x4 __attribute__((ext_vector_type(4)));
typedef unsigned u32x4 __attribute__((ext_vector_type(4)));
constexpr int BM = 256, BK = 64, HALF = 128, HTB = HALF * BK * 2  , STAGE_BYTES = 8 * HTB, NXCD = 8, WGM = 4;

__host__ __device__ __forceinline__ int lds_byte(int r, int c) { const int st = (r >> 4) * 2 + (c >> 5), rr = r & 15, cc = c & 31, ob = rr * 64 + cc * 2; return st * 1024 + (ob ^ (((ob >> 9) & 1) << 5)); }
__host__ __device__ __forceinline__ void stage_rc(int b, int& R, int& C) { const int st = b / 1024, sb = b % 1024, swz = sb ^ (((sb >> 9) & 1) << 5); R = (st >> 1) * 16 + swz / 64; C = (st & 1) * 32 + (swz % 64) / 2; }
__host__ __device__ __forceinline__ int perm32(int rho) { const int n = rho >> 4, i = rho & 15; return 8 * (i >> 2) + 4 * n + (i & 3); }

struct Unit { int pm, pn; };
struct Gemm { const bf16_t* A; const bf16_t* Bt; int M, N, K; };

struct StaticOrder {
    int nM, nN, nwg, G, c;
    __host__ __device__ void init(int M, int N, int G_, int c_) { nM = M / BM; nN = N / BM; nwg = nM * nN; G = G_; c = c_; }
    __host__ __device__ bool next(int i, Unit& u) const {
        const long L = (long)i * G + c; if (L >= nwg) return false;
        int wgid = (int)L; { const int q = nwg / NXCD, r = nwg % NXCD, xcd = wgid % NXCD, off = wgid / NXCD; wgid = (xcd < r ? xcd * (q + 1) : r * (q + 1) + (xcd - r) * q) + off; }
        const int nig = WGM * nN, gid = wgid / nig, fm = gid * WGM, gsz = (nM - fm) < WGM ? (nM - fm) : WGM;
        u.pm = fm + ((wgid % nig) % gsz); u.pn = (wgid % nig) / gsz; return true;
    }
    __device__ __forceinline__ void a_ready(const Unit&) const {}
    __device__ __forceinline__ void done(const Unit&) const {}
};
__device__ __forceinline__ unsigned cvt_pk_bf16(float lo, float hi) { unsigned r; asm volatile("v_cvt_pk_bf16_f32 %0, %1, %2" : "=v"(r) : "v"(lo), "v"(hi)); return r; }
typedef float f32x2 __attribute__((ext_vector_type(2)));
template <class Epi, class Sched, bool ALIGN_EPI = false, bool SP2 = false>
__device__ __forceinline__ void gemm_phase(PG8_LAS unsigned char* lds, const Gemm g, const Sched& S, const Epi& E) {
    const int tid = tid_opaque(), wid = __builtin_amdgcn_readfirstlane(tid >> 6), lane = tid & 63, wr = wid >> 2, wc = wid & 3, fr = lane & 15, fq = lane >> 4;
    const int K = g.K, nt = K / BK;
    unsigned voffA[2], voffB[2];
#pragma unroll
    for (int i = 0; i < 2; ++i) { int R, C; stage_rc(tid * 16 + i * 8192, R, C); const int Rb = Epi::PERM ? ((R & ~31) + perm32(R & 31)) : R;
        voffA[i] = (unsigned)(R * K + C) * 2u; voffB[i] = (unsigned)(Rb * K + C) * 2u; }
    const size_t kstep = (size_t)(BK * 2);
    const size_t hstep = (size_t)HALF * K * 2;
    const size_t tstep = 2 * hstep;
    const unsigned ldsw = (unsigned)wid * 1024u;
    const int aoff = lds_byte(wr * 64 + fr, fq * 8), boff = lds_byte(wc * 32 + fr, fq * 8);
#define PG8_SA(b, h) (((b) * 2 + (h)) * HTB)
#define PG8_SB(b, h) ((4 + (b) * 2 + (h)) * HTB)
#define PG8_STAGE(bufoff, gbase, voff) do { _Pragma("unroll") for (int _i = 0; _i < 2; ++_i) \
        __builtin_amdgcn_global_load_lds((const unsigned*)((const char*)(gbase) + (voff)[_i]), (PG8_LAS unsigned*)(lds + (bufoff) + ldsw + _i * 8192), 16, 0, 0); } while (0)
#define PG8_LDA(dst, b, h) do { _Pragma("unroll") for (int m = 0; m < 4; ++m) _Pragma("unroll") for (int k = 0; k < 2; ++k) dst[m][k] = *(const PG8_LAS bf16x8*)(lds + PG8_SA(b, h) + aoff + m * 2048 + k * 1024); } while (0)
#define PG8_LDB(dst, b, h) do { _Pragma("unroll") for (int n = 0; n < 2; ++n) _Pragma("unroll") for (int k = 0; k < 2; ++k) dst[n][k] = *(const PG8_LAS bf16x8*)(lds + PG8_SB(b, h) + boff + n * 2048 + k * 1024); } while (0)
#define PG8_MMA(ai, bj, At, Bt) do { __builtin_amdgcn_s_setprio(1); _Pragma("unroll") for (int m = 0; m < 4; ++m) _Pragma("unroll") for (int n = 0; n < 2; ++n) _Pragma("unroll") for (int k = 0; k < 2; ++k) \
        acc[ai][bj][m][n] = __builtin_amdgcn_mfma_f32_16x16x32_bf16(Bt[n][k], At[m][k], acc[ai][bj][m][n], 0, 0, 0); __builtin_amdgcn_s_setprio(0); } while (0)
#define PG8_WAIT_V(n) asm volatile("s_waitcnt vmcnt(" #n ")" ::: "memory")
#define PG8_WAIT_L(n) asm volatile("s_waitcnt lgkmcnt(" #n ")" ::: "memory")
#define PG8_BAR __builtin_amdgcn_s_barrier()
#define PG8_SCHED __builtin_amdgcn_sched_barrier(0)
    Unit cur, nxt; int ui = 0;
    if (!S.next(0, cur)) return;
    f32x4 acc[2][2][4][2];
#pragma unroll
    for (int a = 0; a < 2; ++a)
#pragma unroll
        for (int b = 0; b < 2; ++b)
#pragma unroll
            for (int m = 0; m < 4; ++m)
#pragma unroll
                for (int n = 0; n < 2; ++n) acc[a][b][m][n] = (f32x4){0.f, 0.f, 0.f, 0.f};
    bf16x8 At[4][2], B0[2][2], B1[2][2];
    const char* cA = (const char*)g.A + (size_t)cur.pm * tstep; const char* cB = (const char*)g.Bt + (size_t)cur.pn * tstep;
    S.a_ready(cur);
    if constexpr (SP2) {
        PG8_STAGE(PG8_SB(0, 0), cB, voffB); PG8_STAGE(PG8_SB(0, 1), cB + hstep, voffB); PG8_STAGE(PG8_SA(0, 0), cA, voffA); PG8_STAGE(PG8_SA(0, 1), cA + hstep, voffA);
        if (wr == 1) PG8_BAR;
        PG8_WAIT_V(2); PG8_BAR;
        PG8_STAGE(PG8_SB(1, 0), cB + kstep, voffB); PG8_STAGE(PG8_SA(1, 0), cA + kstep, voffA); PG8_STAGE(PG8_SB(1, 1), cB + hstep + kstep, voffB);
        PG8_WAIT_V(6); PG8_BAR;
    } else {
        PG8_STAGE(PG8_SB(0, 0), cB, voffB); PG8_STAGE(PG8_SA(0, 0), cA, voffA); PG8_STAGE(PG8_SB(0, 1), cB + hstep, voffB); PG8_STAGE(PG8_SA(0, 1), cA + hstep, voffA);
        if (wr == 1) PG8_BAR;
        PG8_WAIT_V(4); PG8_BAR;
        PG8_STAGE(PG8_SB(1, 0), cB + kstep, voffB); PG8_STAGE(PG8_SA(1, 0), cA + kstep, voffA); PG8_STAGE(PG8_SB(1, 1), cB + hstep + kstep, voffB);
        PG8_WAIT_V(6); PG8_BAR;
    }
    for (;;) {
        const bool has_next = S.next(ui + 1, nxt);
        const char* nA = has_next ? (const char*)g.A + (size_t)nxt.pm * tstep : cA; const char* nB = has_next ? (const char*)g.Bt + (size_t)nxt.pn * tstep : cB;
#pragma unroll 1
        for (int t = 0; t < nt; t += 2) {
            const bool last = (t == nt - 2);
            const char* a1 = cA + (size_t)(t + 1) * kstep;
            const char* a2 = last ? nA : cA + (size_t)(t + 2) * kstep; const char* b2 = last ? nB : cB + (size_t)(t + 2) * kstep;
            const char* a3 = a2 + kstep; const char* b3 = b2 + kstep;
            if (last && has_next) S.a_ready(nxt);
            if constexpr (SP2) {
            PG8_LDB(B0, 0, 0); PG8_LDB(B1, 0, 1); PG8_SCHED; PG8_LDA(At, 0, 0); PG8_STAGE(PG8_SA(1, 1), a1 + hstep, voffA);
            PG8_WAIT_V(8); PG8_WAIT_L(0); PG8_BAR; PG8_MMA(0, 0, At, B0); PG8_MMA(0, 1, At, B1); PG8_BAR; PG8_SCHED;
            PG8_LDA(At, 0, 1); PG8_STAGE(PG8_SB(0, 0), b2, voffB); PG8_STAGE(PG8_SB(0, 1), b2 + hstep, voffB); PG8_STAGE(PG8_SA(0, 0), a2, voffA);
            PG8_WAIT_V(8); PG8_WAIT_L(0); PG8_BAR; PG8_MMA(1, 0, At, B0); PG8_MMA(1, 1, At, B1); PG8_BAR; PG8_SCHED;
            PG8_LDB(B0, 1, 0); PG8_LDB(B1, 1, 1); PG8_SCHED; PG8_LDA(At, 1, 0); PG8_STAGE(PG8_SA(0, 1), a2 + hstep, voffA);
            PG8_WAIT_V(8); PG8_WAIT_L(0); PG8_BAR; PG8_MMA(0, 0, At, B0); PG8_MMA(0, 1, At, B1); PG8_BAR; PG8_SCHED;
            PG8_LDA(At, 1, 1); PG8_STAGE(PG8_SB(1, 0), b3, voffB); PG8_STAGE(PG8_SB(1, 1), b3 + hstep, voffB); PG8_STAGE(PG8_SA(1, 0), a3, voffA);
            PG8_WAIT_V(8); PG8_WAIT_L(0); PG8_BAR; PG8_MMA(1, 0, At, B0); PG8_MMA(1, 1, At, B1); PG8_BAR; PG8_SCHED;
            } else {
            PG8_LDB(B0, 0, 0); PG8_SCHED; PG8_LDA(At, 0, 0); PG8_STAGE(PG8_SA(1, 1), a1 + hstep, voffA);
            PG8_WAIT_L(8); PG8_BAR; PG8_WAIT_L(0); PG8_MMA(0, 0, At, B0); PG8_BAR; PG8_SCHED;
            PG8_LDB(B1, 0, 1); PG8_STAGE(PG8_SB(0, 0), b2, voffB);
            PG8_BAR; PG8_WAIT_L(0); PG8_MMA(0, 1, At, B1); PG8_BAR;
            PG8_LDA(At, 0, 1); PG8_STAGE(PG8_SA(0, 0), a2, voffA);
            PG8_BAR; PG8_WAIT_L(0); PG8_MMA(1, 0, At, B0); PG8_BAR; PG8_SCHED;
            PG8_STAGE(PG8_SB(0, 1), b2 + hstep, voffB);
            PG8_WAIT_V(6); PG8_BAR; PG8_MMA(1, 1, At, B1); PG8_BAR;
            PG8_LDB(B0, 1, 0); PG8_SCHED; PG8_LDA(At, 1, 0); PG8_STAGE(PG8_SA(0, 1), a2 + hstep, voffA);
            PG8_WAIT_L(8); PG8_BAR; PG8_WAIT_L(0); PG8_MMA(0, 0, At, B0); PG8_BAR; PG8_SCHED;
            PG8_LDB(B1, 1, 1); PG8_STAGE(PG8_SB(1, 0), b3, voffB);
            PG8_BAR; PG8_WAIT_L(0); PG8_MMA(0, 1, At, B1); PG8_BAR;
            PG8_LDA(At, 1, 1); PG8_STAGE(PG8_SA(1, 0), a3, voffA);
            PG8_BAR; PG8_WAIT_L(0); PG8_MMA(1, 0, At, B0); PG8_BAR; PG8_SCHED;
            PG8_STAGE(PG8_SB(1, 1), b3 + hstep, voffB);
            PG8_WAIT_V(6); PG8_BAR; PG8_MMA(1, 1, At, B1); PG8_BAR;
            }
        }
        if constexpr (ALIGN_EPI) { if (wr == 0) PG8_BAR; }
        if constexpr (!Epi::AFTER_DRAIN) { E(acc, cur, wr, wc, fr, fq); S.done(cur); }
        if (!has_next) break;
#pragma unroll
        for (int a = 0; a < 2; ++a)
#pragma unroll
            for (int b = 0; b < 2; ++b)
#pragma unroll
                for (int m = 0; m < 4; ++m)
#pragma unroll
                    for (int n = 0; n < 2; ++n) acc[a][b][m][n] = (f32x4){0.f, 0.f, 0.f, 0.f};
        cur = nxt; cA = nA; cB = nB; ++ui;
        if constexpr (ALIGN_EPI) { if (wr == 1) PG8_BAR; }
    }
    PG8_WAIT_V(0);
    if constexpr (!ALIGN_EPI) { if (wr == 0) PG8_BAR; }
    PG8_BAR;
    if constexpr (Epi::AFTER_DRAIN) { E.fused(acc, cur, wr, wc, fr, fq, lds, wid, lane); S.done(cur); }
#undef PG8_SA
#undef PG8_SB
#undef PG8_STAGE
#undef PG8_LDA
#undef PG8_LDB
#undef PG8_MMA
#undef PG8_WAIT_V
#undef PG8_WAIT_L
#undef PG8_BAR
#undef PG8_SCHED
}
}

using pg8::Unit;
typedef const f32x4 (&AccRef)[2][2][4][2];

struct EpiSwiglu {
    static constexpr bool PERM = true, AFTER_DRAIN = false;
    bf16* O;
    __device__ __forceinline__ void operator()(AccRef acc, const Unit& u, int wr, int wc, int fr, int fq) const {
        const int row0 = u.pm * 256 + wr * 64 + fr, col0 = u.pn * 128 + wc * 32 + 8 * fq;
#pragma unroll
        for (int ai = 0; ai < 2; ++ai)
#pragma unroll
            for (int m = 0; m < 4; ++m) {
                const f32x4 g0 = acc[ai][0][m][0], g1 = acc[ai][0][m][1], u0 = acc[ai][1][m][0], u1 = acc[ai][1][m][1];
                float v[8];
#pragma unroll
                for (int i = 0; i < 4; ++i) { v[i] = g0[i] * __builtin_amdgcn_rcpf(1.0f + __expf(-g0[i])) * u0[i]; v[4 + i] = g1[i] * __builtin_amdgcn_rcpf(1.0f + __expf(-g1[i])) * u1[i]; }
                u32x4 w; w.x = pk2(v[0], v[1]); w.y = pk2(v[2], v[3]); w.z = pk2(v[4], v[5]); w.w = pk2(v[6], v[7]);
                *(u32x4*)(O + (size_t)(row0 + ai * 128 + m * 16) * DFF + col0) = w;
            }
    }
};
struct EpiSwigluN {
    static constexpr bool PERM = true, AFTER_DRAIN = false;
    bf16* O; const float* ss; const float* cv;
    __device__ __forceinline__ void operator()(AccRef acc, const Unit& u, int wr, int wc, int fr, int fq) const {
        const int cond = u.pm < 32 ? 0 : 1 + ((u.pm - 32) >> 2);
        const int row0 = u.pm * 256 + wr * 64 + fr, col0 = u.pn * 128 + wc * 32 + 8 * fq, gc0 = u.pn * 256 + wc * 32 + 8 * fq;
        const float* cp = cv + (size_t)cond * 5632 + gc0;
        const f32x4 cg0 = *(const f32x4*)cp, cg1 = *(const f32x4*)(cp + 4), cu0 = *(const f32x4*)(cp + 128), cu1 = *(const f32x4*)(cp + 132);
#pragma unroll
        for (int ai = 0; ai < 2; ++ai)
#pragma unroll
            for (int m = 0; m < 4; ++m) {
                const int row = row0 + ai * 128 + m * 16;
                const float rs = ss[row];
                const f32x4 g0 = acc[ai][0][m][0] * rs + cg0, g1 = acc[ai][0][m][1] * rs + cg1, u0 = acc[ai][1][m][0] * rs + cu0, u1 = acc[ai][1][m][1] * rs + cu1;
                float v[8];
#pragma unroll
                for (int i = 0; i < 4; ++i) { v[i] = g0[i] * __builtin_amdgcn_rcpf(1.0f + __expf(-g0[i])) * u0[i]; v[4 + i] = g1[i] * __builtin_amdgcn_rcpf(1.0f + __expf(-g1[i])) * u1[i]; }
                u32x4 w; w.x = pk2(v[0], v[1]); w.y = pk2(v[2], v[3]); w.z = pk2(v[4], v[5]); w.w = pk2(v[6], v[7]);
                *(u32x4*)(O + (size_t)row * DFF + col0) = w;
            }
    }
};
struct EpiStoreN {
    static constexpr bool PERM = true, AFTER_DRAIN = false;
    bf16* O; int ldc; int ncols; const float* ss; const float* cv; int ncv;
    __device__ __forceinline__ void operator()(AccRef acc, const Unit& u, int wr, int wc, int fr, int fq) const {
        const int cond = u.pm < 32 ? 0 : 1 + ((u.pm - 32) >> 2);
        const int row0 = u.pm * 256 + wr * 64 + fr, col0 = u.pn * 256 + wc * 32 + 8 * fq;
        const float* cp = cv + (size_t)cond * ncv + col0;
        const f32x4 c00 = *(const f32x4*)cp, c01 = *(const f32x4*)(cp + 4), c10 = *(const f32x4*)(cp + 128), c11 = *(const f32x4*)(cp + 132);
#pragma unroll
        for (int ai = 0; ai < 2; ++ai)
#pragma unroll
            for (int m = 0; m < 4; ++m) {
                const int row = row0 + ai * 128 + m * 16;
                const float rs = ss[row];
                bf16* rowp = O + (size_t)row * ldc;
#pragma unroll
                for (int bj = 0; bj < 2; ++bj) { const int col = col0 + bj * 128;
                    const f32x4 v0 = acc[ai][bj][m][0] * rs + (bj ? c10 : c00), v1 = acc[ai][bj][m][1] * rs + (bj ? c11 : c01);
                    u32x4 w; w.x = pk2(v0[0], v0[1]); w.y = pk2(v0[2], v0[3]); w.z = pk2(v1[0], v1[1]); w.w = pk2(v1[2], v1[3]);
                    if (col < ncols) *(u32x4*)(rowp + col) = w; }
            }
    }
};
struct EpiResidN {
    static constexpr bool PERM = true, AFTER_DRAIN = false;
    const float* xin_p; const float* xin_s; float* xout; const float* gate_base;
    const float* gnext; const float* scn_base; bf16* xg; float* ss; float coef;
    __device__ __forceinline__ void operator()(AccRef acc, const Unit& u, int wr, int wc, int fr, int fq) const {
        const int cond = u.pm < 32 ? 0 : 1 + ((u.pm - 32) >> 2);
        const float* gate = gate_base + (size_t)cond * 9216; const float* scn = scn_base + (size_t)cond * 9216;
        const int row0 = u.pm * 256 + wr * 64 + fr, col0 = u.pn * 256 + wc * 32 + 8 * fq;
        float sq[2][4];
#pragma unroll
        for (int ai = 0; ai < 2; ++ai)
#pragma unroll
            for (int m = 0; m < 4; ++m) sq[ai][m] = 0.f;
        const float* xb = u.pm < 32 ? xin_p : xin_s - (size_t)MP * DM;
        const unsigned off0 = (unsigned)(row0 * DM + col0);
#pragma unroll
        for (int bj = 0; bj < 2; ++bj) {
            const int col = col0 + bj * 128;
            f32x4 gv[2], G[2];
#pragma unroll
            for (int n = 0; n < 2; ++n) { gv[n] = *(const f32x4*)(gate + col + 4 * n) * coef; G[n] = *(const f32x4*)(gnext + col + 4 * n) * (*(const f32x4*)(scn + col + 4 * n) + 1.0f); }
#pragma unroll
            for (int ai = 0; ai < 2; ++ai) {
                f32x4 xv[4][2];
#pragma unroll
                for (int m = 0; m < 4; ++m)
#pragma unroll
                    for (int n = 0; n < 2; ++n) xv[m][n] = *(const f32x4*)(xb + (off0 + (unsigned)((ai * 128 + m * 16) * DM + bj * 128 + 4 * n)));
                asm volatile("" ::: "memory");
#pragma unroll
                for (int m = 0; m < 4; ++m) {
                    const unsigned off = off0 + (unsigned)((ai * 128 + m * 16) * DM + bj * 128);
                    const f32x4 x0 = xv[m][0] + gv[0] * acc[ai][bj][m][0], x1 = xv[m][1] + gv[1] * acc[ai][bj][m][1];
                    *(f32x4*)(xout + off) = x0; *(f32x4*)(xout + off + 4) = x1;
                    const u32x2 w0 = pk4(x0 * G[0]), w1 = pk4(x1 * G[1]);
                    *(u32x4*)(xg + off) = (u32x4){w0.x, w0.y, w1.x, w1.y};
                    sq[ai][m] += x0.x * x0.x + x0.y * x0.y + x0.z * x0.z + x0.w * x0.w + x1.x * x1.x + x1.y * x1.y + x1.z * x1.z + x1.w * x1.w;
                }
                asm volatile("" ::: "memory");
            }
        }
#pragma unroll
        for (int ai = 0; ai < 2; ++ai)
#pragma unroll
            for (int m = 0; m < 4; ++m) {
                float t = sq[ai][m]; t += __shfl_xor(t, 16); t += __shfl_xor(t, 32);
                if (fq == 0) ss[(u.pn * 4 + wc) * M_TOK + row0 + ai * 128 + m * 16] = t;
            }
    }
};
struct EpiResid {
    static constexpr bool PERM = true, AFTER_DRAIN = false;
    const float* xin_p; const float* xin_s; float* xout; const float* gate_base; float coef;
    __device__ __forceinline__ void operator()(AccRef acc, const Unit& u, int wr, int wc, int fr, int fq) const {
        const int cond = u.pm < 32 ? 0 : 1 + ((u.pm - 32) >> 2);
        const float* gate = gate_base + (size_t)cond * 9216;
        const int row0 = u.pm * 256 + wr * 64 + fr, col0 = u.pn * 256 + wc * 32 + 8 * fq;
        const float* xb = u.pm < 32 ? xin_p : xin_s - (size_t)MP * DM;
        const unsigned off0 = (unsigned)(row0 * DM + col0);
#pragma unroll
        for (int bj = 0; bj < 2; ++bj) {
            const f32x4 gv0 = *(const f32x4*)(gate + col0 + bj * 128) * coef, gv1 = *(const f32x4*)(gate + col0 + bj * 128 + 4) * coef;
#pragma unroll
            for (int ai = 0; ai < 2; ++ai) {
                f32x4 xv[4][2];
#pragma unroll
                for (int m = 0; m < 4; ++m)
#pragma unroll
                    for (int n = 0; n < 2; ++n) xv[m][n] = *(const f32x4*)(xb + (off0 + (unsigned)((ai * 128 + m * 16) * DM + bj * 128 + 4 * n)));
                asm volatile("" ::: "memory");
#pragma unroll
                for (int m = 0; m < 4; ++m) {
                    const unsigned off = off0 + (unsigned)((ai * 128 + m * 16) * DM + bj * 128);
                    *(f32x4*)(xout + off) = xv[m][0] + gv0 * acc[ai][bj][m][0]; *(f32x4*)(xout + off + 4) = xv[m][1] + gv1 * acc[ai][bj][m][1];
                }
                asm volatile("" ::: "memory");
            }
        }
    }
};
struct EpiStore {
    static constexpr bool PERM = true, AFTER_DRAIN = false;
    bf16* O; int ldc; int ncols;
    __device__ __forceinline__ void operator()(AccRef acc, const Unit& u, int wr, int wc, int fr, int fq) const {
        const int row0 = u.pm * 256 + wr * 64 + fr, col0 = u.pn * 256 + wc * 32 + 8 * fq;
#pragma unroll
        for (int ai = 0; ai < 2; ++ai)
#pragma unroll
            for (int m = 0; m < 4; ++m) {
                bf16* rowp = O + (size_t)(row0 + ai * 128 + m * 16) * ldc;
#pragma unroll
                for (int bj = 0; bj < 2; ++bj) { const int col = col0 + bj * 128; const f32x4 v0 = acc[ai][bj][m][0], v1 = acc[ai][bj][m][1];
                    u32x4 w; w.x = pk2(v0[0], v0[1]); w.y = pk2(v0[2], v0[3]); w.z = pk2(v1[0], v1[1]); w.w = pk2(v1[2], v1[3]);
                    if (col < ncols) *(u32x4*)(rowp + col) = w; }
            }
    }
};
struct EpiLora {
    static constexpr bool PERM = true, AFTER_DRAIN = false;
    bf16* O; const float* w0; const float* a0;
    __device__ __forceinline__ void operator()(AccRef acc, const Unit& u, int wr, int wc, int fr, int fq) const {
        const int seg = u.pn >> 1;
        const float* bias = seg < 2 ? w0 + seg * 512 : a0 + (seg & 1) * 512;
        const int row0 = u.pm * 256 + wr * 64 + fr, ct0 = wc * 32 + 8 * fq;
#pragma unroll
        for (int bj = 0; bj < 2; ++bj) {
            const int cseg = (u.pn & 1) * 256 + ct0 + bj * 128;
            f32x4 b0 = {0.f, 0.f, 0.f, 0.f}, b1 = {0.f, 0.f, 0.f, 0.f};
            if (seg < 4) { b0 = *(const f32x4*)(bias + cseg); b1 = *(const f32x4*)(bias + cseg + 4); }
#pragma unroll
            for (int ai = 0; ai < 2; ++ai)
#pragma unroll
                for (int m = 0; m < 4; ++m) {
                    f32x4 v0 = acc[ai][bj][m][0] + b0, v1 = acc[ai][bj][m][1] + b1;
                    if (seg < 4) {
                        const float sc = seg < 2 ? 0.60653066f : 1.0f;
#pragma unroll
                        for (int i = 0; i < 4; ++i) { v0[i] = sc * sigmoidf_(v0[i]); v1[i] = sc * sigmoidf_(v1[i]); }
                    }
                    u32x4 w; w.x = pk2(v0[0], v0[1]); w.y = pk2(v0[2], v0[3]); w.z = pk2(v1[0], v1[1]); w.w = pk2(v1[2], v1[3]);
                    *(u32x4*)(O + (size_t)(row0 + ai * 128 + m * 16) * 2560 + u.pn * 256 + ct0 + bj * 128) = w;
                    asm volatile("" ::: "memory");
                }
        }
    }
};
struct EpiQ {
    static constexpr bool PERM = true, AFTER_DRAIN = false;
    bf16* O; const float* rope;
    __device__ __forceinline__ void operator()(AccRef acc, const Unit& u, int wr, int wc, int fr, int fq) const {
        const int row0 = u.pm * 256 + wr * 64 + fr, col0 = u.pn * 256 + wc * 32 + 8 * fq;
        const float qs = 0.10206207261596577f;
#pragma unroll
        for (int bj = 0; bj < 2; ++bj) {
            const int col = col0 + bj * 128, e0 = col % 96;
            const bool is_rope = e0 >= 64;
#pragma unroll
            for (int ai = 0; ai < 2; ++ai)
#pragma unroll
                for (int m = 0; m < 4; ++m) {
                    const int row = row0 + ai * 128 + m * 16;
                    f32x4 v0 = acc[ai][bj][m][0] * qs, v1 = acc[ai][bj][m][1] * qs;
                    if (is_rope && row >= MP) {
                        const int t = (row - MP) & 1023;
                        const float* rt = rope + (size_t)t * 32 + (e0 - 64);
                        const f32x4 c0 = *(const f32x4*)(rt), c1 = *(const f32x4*)(rt + 4);
                        f32x4 r0, r1;
                        r0[0] = v0[0] * c0[0] - v0[1] * c0[1]; r0[1] = v0[0] * c0[1] + v0[1] * c0[0];
                        r0[2] = v0[2] * c0[2] - v0[3] * c0[3]; r0[3] = v0[2] * c0[3] + v0[3] * c0[2];
                        r1[0] = v1[0] * c1[0] - v1[1] * c1[1]; r1[1] = v1[0] * c1[1] + v1[1] * c1[0];
                        r1[2] = v1[2] * c1[2] - v1[3] * c1[3]; r1[3] = v1[2] * c1[3] + v1[3] * c1[2];
                        v0 = r0; v1 = r1;
                    }
                    u32x4 w; w.x = pk2(v0[0], v0[1]); w.y = pk2(v0[2], v0[3]); w.z = pk2(v1[0], v1[1]); w.w = pk2(v1[2], v1[3]);
                    *(u32x4*)(O + (size_t)row * 768 + col) = w;
                    asm volatile("" ::: "memory");
                }
        }
    }
};

struct EpiKV {
    static constexpr bool PERM = true, AFTER_DRAIN = false;
    bf16* KN; bf16* VT; int nrows;
    __device__ __forceinline__ void operator()(AccRef acc, const Unit& u, int wr, int wc, int fr, int fq) const {
        const int row0 = u.pm * 256 + wr * 64 + fr, col0 = u.pn * 256 + wc * 32 + 8 * fq;
#pragma unroll
        for (int bj = 0; bj < 2; ++bj) {
            const int col = col0 + bj * 128, head = col >> 7, e0 = col & 127;
#pragma unroll
            for (int ai = 0; ai < 2; ++ai)
#pragma unroll
                for (int m = 0; m < 4; ++m) {
                    const int row = row0 + ai * 128 + m * 16;
                    const f32x4 v0 = acc[ai][bj][m][0], v1 = acc[ai][bj][m][1];
                    u32x4 w; w.x = pk2(v0[0], v0[1]); w.y = pk2(v0[2], v0[3]); w.z = pk2(v1[0], v1[1]); w.w = pk2(v1[2], v1[3]);
                    if (e0 < 64) *(u32x4*)(KN + (size_t)row * 512 + head * 64 + e0) = w;
                    else { bf16* vp = VT + (size_t)(head * 64 + e0 - 64) * nrows + row;
#pragma unroll
                        for (int i = 0; i < 4; ++i) { vp[(size_t)(2 * i) * nrows] = (bf16)(w[i] & 0xffffu); vp[(size_t)(2 * i + 1) * nrows] = (bf16)(w[i] >> 16); } }
                }
        }
    }
};

__device__ __forceinline__ void adaln_layer(const P& p, LAS unsigned char* lds, int l, int bfirst) {
    LAS float* scv = (LAS float*)lds;
    LAS float* red = scv + 9 * 1024;
    const int tid = tid_opaque(), tx = tid % 18, ty = tid / 18;
    const float* cc = p.in[6]; const float* cctx = p.in[7];
    float* mod = (float*)(p.ws + WS_MOD);
    if ((int)blockIdx.x < bfirst) return;
    __syncthreads();
    for (int i = tid; i < 9 * 1024; i += NTHREADS) { const int c = i >> 10, k = i & 1023; const float v = c == 0 ? cctx[k] : cc[(c - 1) * 1024 + k]; scv[i] = v / (1.0f + expf(-v)); }
    __syncthreads();
    for (int cgp = blockIdx.x - bfirst; cgp < 128; cgp += gridDim.x - bfirst) {
        const int col0 = cgp * 72 + tx * 4;
        const float* W = p.in[8] + (size_t)l * 1024 * 9216;
        f32x4 acc[9];
#pragma unroll
        for (int c = 0; c < 9; ++c) acc[c] = (f32x4){0.f, 0.f, 0.f, 0.f};
        if (ty < 28) {
#pragma unroll 8
            for (int k = ty; k < 1024; k += 28) {
                const f32x4 w = *(const f32x4*)(W + (size_t)k * 9216 + col0);
#pragma unroll
                for (int c = 0; c < 9; ++c) acc[c] += w * scv[c * 1024 + k];
            }
#pragma unroll
            for (int c = 0; c < 9; ++c) *(LAS f32x4*)(red + ty * 648 + c * 72 + tx * 4) = acc[c];
        }
        __syncthreads();
        for (int o = tid; o < 648; o += NTHREADS) {
            float s = 0.f;
            for (int y = 0; y < 28; ++y) s += red[y * 648 + o];
            const int c = o / 72, j = o % 72;
            mod[(size_t)(l * 9 + c) * 9216 + cgp * 72 + j] = s + p.in[9][l * 9216 + cgp * 72 + j];
        }
        __syncthreads();
    }
}
__device__ __forceinline__ void ph_rope_table(const P& p) {
    const int tid = tid_opaque();
    float* rope = (float*)(p.ws + WS_ROPE);
    for (int idx = blockIdx.x * NTHREADS + tid; idx < 1024 * 16; idx += gridDim.x * NTHREADS) {
        const int t = idx >> 4, i = idx & 15;
        const float pos = (float)(i < 8 ? (t >> 6) : (t & 63));
        const float inv = powf(10000.0f, -(float)(i & 7) / 8.0f);
        const float ang = pos * inv;
        rope[idx * 2] = cosf(ang); rope[idx * 2 + 1] = sinf(ang);
    }
}

__device__ __forceinline__ void norm_rows(const P& p, int layer, int j, const float* gvec, bool from_input) {
    const int tid = tid_opaque(), lane = tid & 63, wave = tid >> 6;
    const float* mod = (const float*)(p.ws + WS_MOD);
    const float* x = p.out;
    bf16* h = (bf16*)(p.ws + WS_H);
    const int nw = gridDim.x * 8;
    for (int row0 = blockIdx.x * 8 + wave; row0 < M_TOK; row0 += 4 * nw) {
        f32x4 v[4][4]; float ss[4];
#pragma unroll
        for (int r = 0; r < 4; ++r) {
            const int row = (row0 + r * nw) < M_TOK ? (row0 + r * nw) : (M_TOK - 1);
            const float* xr = from_input ? (row < MP ? p.in[0] + (size_t)row * DM : p.in[1] + (size_t)(row - MP) * DM) : x + (size_t)row * DM;
#pragma unroll
            for (int q = 0; q < 4; ++q) v[r][q] = *(const f32x4*)(xr + lane * 4 + 256 * q);
        }
#pragma unroll
        for (int r = 0; r < 4; ++r) { float s = 0.f;
#pragma unroll
            for (int q = 0; q < 4; ++q) s += v[r][q].x * v[r][q].x + v[r][q].y * v[r][q].y + v[r][q].z * v[r][q].z + v[r][q].w * v[r][q].w;
            ss[r] = s; }
#pragma unroll
        for (int o = 1; o < 64; o <<= 1) {
#pragma unroll
            for (int r = 0; r < 4; ++r) ss[r] += __shfl_xor(ss[r], o); }
#pragma unroll
        for (int r = 0; r < 4; ++r) {
            const int row = row0 + r * nw; if (row >= M_TOK) break;
            const float rstd = 1.0f / sqrtf(ss[r] * (1.0f / 1024.0f) + 1e-6f);
            const float* mrow = mod + (size_t)(layer * 9 + cond_of_row(row)) * 9216;
            const float* sh = mrow + (3 * j) * 1024; const float* sc = mrow + (3 * j + 1) * 1024;
#pragma unroll
            for (int q = 0; q < 4; ++q) {
                const int col = lane * 4 + 256 * q;
                const f32x4 g = *(const f32x4*)(gvec + col), s1 = *(const f32x4*)(sc + col), s0 = *(const f32x4*)(sh + col);
                const f32x4 y = (v[r][q] * rstd * g) * (s1 + 1.0f) + s0;
                *(u32x2*)(h + (size_t)row * DM + col) = pk4(y);
            }
        }
    }
}
__device__ __forceinline__ void first_rows(const P& p, const float* gvec, float* ss) {
    const int tid = tid_opaque(), lane = tid & 63, wave = tid >> 6;
    const float* mod = (const float*)(p.ws + WS_MOD);
    bf16* h = (bf16*)(p.ws + WS_H);
    const int nw = gridDim.x * 8;
    for (int row0 = blockIdx.x * 8 + wave; row0 < M_TOK; row0 += 4 * nw) {
        f32x4 v[4][4]; float sq[4];
#pragma unroll
        for (int r = 0; r < 4; ++r) {
            const int row = (row0 + r * nw) < M_TOK ? (row0 + r * nw) : (M_TOK - 1);
            const float* xr = row < MP ? p.in[0] + (size_t)row * DM : p.in[1] + (size_t)(row - MP) * DM;
#pragma unroll
            for (int q = 0; q < 4; ++q) v[r][q] = *(const f32x4*)(xr + lane * 4 + 256 * q);
        }
#pragma unroll
        for (int r = 0; r < 4; ++r) { float t = 0.f;
#pragma unroll
            for (int q = 0; q < 4; ++q) t += v[r][q].x * v[r][q].x + v[r][q].y * v[r][q].y + v[r][q].z * v[r][q].z + v[r][q].w * v[r][q].w;
            sq[r] = t; }
#pragma unroll
        for (int o = 1; o < 64; o <<= 1) {
#pragma unroll
            for (int r = 0; r < 4; ++r) sq[r] += __shfl_xor(sq[r], o); }
#pragma unroll
        for (int r = 0; r < 4; ++r) {
            const int row = row0 + r * nw; if (row >= M_TOK) break;
            if (lane == 0) ss[row] = rsqrtf_(sq[r] * (1.0f / 1024.0f) + 1e-6f);
            const float* sc = mod + (size_t)cond_of_row(row) * 9216 + 1024;
#pragma unroll
            for (int q = 0; q < 4; ++q) { const int col = lane * 4 + 256 * q;
                *(u32x2*)(h + (size_t)row * DM + col) = pk4(v[r][q] * (*(const f32x4*)(gvec + col) * (*(const f32x4*)(sc + col) + 1.0f))); }
        }
    }
}
__device__ __forceinline__ void final_norm_rows(const P& p) {
    const int tid = tid_opaque(), lane = tid & 63, wave = tid >> 6;
    float* x = p.out; const float* gvec = p.in[47];
    const int nw = gridDim.x * 8;
    for (int row0 = blockIdx.x * 8 + wave; row0 < M_TOK; row0 += 4 * nw) {
        f32x4 v[4][4]; float ss[4];
#pragma unroll
        for (int r = 0; r < 4; ++r) { const int row = (row0 + r * nw) < M_TOK ? (row0 + r * nw) : (M_TOK - 1);
#pragma unroll
            for (int q = 0; q < 4; ++q) v[r][q] = *(const f32x4*)(x + (size_t)row * DM + lane * 4 + 256 * q); }
#pragma unroll
        for (int r = 0; r < 4; ++r) { float s = 0.f;
#pragma unroll
            for (int q = 0; q < 4; ++q) s += v[r][q].x * v[r][q].x + v[r][q].y * v[r][q].y + v[r][q].z * v[r][q].z + v[r][q].w * v[r][q].w;
            ss[r] = s; }
#pragma unroll
        for (int o = 1; o < 64; o <<= 1) {
#pragma unroll
            for (int r = 0; r < 4; ++r) ss[r] += __shfl_xor(ss[r], o); }
#pragma unroll
        for (int r = 0; r < 4; ++r) { const int row = row0 + r * nw; if (row >= M_TOK) break;
            const float rstd = rsqrtf_(ss[r] * (1.0f / 1024.0f) + 1e-6f);
#pragma unroll
            for (int q = 0; q < 4; ++q) { const int col = lane * 4 + 256 * q; *(f32x4*)(x + (size_t)row * DM + col) = v[r][q] * rstd * *(const f32x4*)(gvec + col); } }
    }
}

template <int MODE>
__device__ __forceinline__ void transpose_w(const float* W, int ldw, int ncols_valid, int K, bf16* WT, int Nt, LAS unsigned char* lds, const float* shift = nullptr, float* cvo = nullptr, int ncv = 0, int rot = 0) {
    const int tid = tid_opaque(), lane = tid & 63, wave = tid >> 6;
    LAS float* scr = (LAS float*)(lds + wave * 16640);
    LAS float* shs = (LAS float*)(lds + 8 * 16640 + wave * 3072);
    const int nblk = Nt / 64, nitems = nblk * (K / 64);
    int vb = ((int)blockIdx.x + (int)gridDim.x - rot % (int)gridDim.x) % (int)gridDim.x;
    for (int it = vb * 8 + wave; it < nitems; it += gridDim.x * 8) {
        const int kb = it / nblk, nb = it % nblk, k0 = kb * 64;
        const int g0 = 2 * nb;
        const int sc0 = MODE == 1 ? (((g0 >> 2) & 1) * DFF + (g0 >> 3) * 128 + (g0 & 3) * 32) : nb * 64;
        const int c4 = (lane & 15) * 4, kr = lane >> 4; const bool ok = (sc0 + c4) < ncols_valid;
        f32x4 t[16];
#pragma unroll
        for (int i = 0; i < 16; ++i) t[i] = ok ? *(const f32x4*)(W + (size_t)(k0 + 4 * i + kr) * ldw + sc0 + c4) : (f32x4){0.f, 0.f, 0.f, 0.f};
#pragma unroll
        for (int i = 0; i < 16; ++i) { LAS float* d = scr + (4 * i + kr) * 65 + c4; d[0] = t[i].x; d[1] = t[i].y; d[2] = t[i].z; d[3] = t[i].w; }
        if (shift) {
#pragma unroll
            for (int cc = 0; cc < 9; ++cc) shs[lane * 12 + cc] = shift[(size_t)cc * 9216 + k0 + lane];
        }
        LDS_WAIT();
        if (shift) {
            float a9[9];
#pragma unroll
            for (int cc = 0; cc < 9; ++cc) a9[cc] = 0.f;
#pragma unroll 4
            for (int k = 0; k < 64; ++k) {
                const float w = scr[k * 65 + lane];
                const f32x4 s0 = *(const LAS f32x4*)(shs + k * 12), s1 = *(const LAS f32x4*)(shs + k * 12 + 4); const float s8 = shs[k * 12 + 8];
                a9[0] += w * s0.x; a9[1] += w * s0.y; a9[2] += w * s0.z; a9[3] += w * s0.w; a9[4] += w * s1.x; a9[5] += w * s1.y; a9[6] += w * s1.z; a9[7] += w * s1.w; a9[8] += w * s8;
            }
#pragma unroll
            for (int cc = 0; cc < 9; ++cc) __hip_atomic_fetch_add(cvo + (size_t)cc * ncv + nb * 64 + lane, a9[cc], __ATOMIC_RELAXED, __HIP_MEMORY_SCOPE_AGENT);
        }
        const int c = lane & 7;
#pragma unroll
        for (int j = 0; j < 8; ++j) {
            const int nn = (lane >> 3) + 8 * j; const LAS float* sp = scr + (8 * c) * 65 + nn;
            u32x4 o; o.x = pk2(sp[0 * 65], sp[1 * 65]); o.y = pk2(sp[2 * 65], sp[3 * 65]); o.z = pk2(sp[4 * 65], sp[5 * 65]); o.w = pk2(sp[6 * 65], sp[7 * 65]);
            *(u32x4*)(WT + (size_t)(nb * 64 + nn) * K + k0 + 8 * c) = o;
        }
        LDS_WAIT();
    }
}
__device__ __forceinline__ void convert_ffn_weights(const P& p, int layer, int which, LAS unsigned char* lds, const float* shift, float* cvo) {
    const float* wgu = p.in[which == 0 ? 13 : 15] + (size_t)layer * 1024 * 5632;
    const float* wdn = p.in[which == 0 ? 14 : 16] + (size_t)layer * 2816 * 1024;
    transpose_w<1>(wgu, 5632, 5632, 1024, (bf16*)(p.ws + W_GU), 5632, lds, shift, cvo, 5632);
    transpose_w<0>(wdn, 1024, 1024, 2816, (bf16*)(p.ws + W_DOWN), 1024, lds, nullptr, nullptr, 0, 176);
}
__device__ __forceinline__ void build_lora_w(const P& p) {
    bf16* WT = (bf16*)(p.ws + W_LORA);
    const float* w_up = p.in[21]; const float* a_up = p.in[23]; const float* g_up = p.in[24];
    for (int idx = blockIdx.x * NTHREADS + tid_opaque(); idx < 2560 * 384; idx += gridDim.x * NTHREADS) {
        const int n = idx / 384, k = idx % 384, seg = n >> 9, c = n & 511;
        float v = 0.f;
        if (seg == 0) { if (k < 64) v = w_up[(0 * 64 + k) * 512 + c]; }
        else if (seg == 1) { if (k >= 64 && k < 128) v = w_up[(1 * 64 + k - 64) * 512 + c]; }
        else if (seg == 2) { if (k >= 128 && k < 192) v = a_up[(0 * 64 + k - 128) * 512 + c]; }
        else if (seg == 3) { if (k >= 192 && k < 256) v = a_up[(1 * 64 + k - 192) * 512 + c]; }
        else { if (k >= 256) v = g_up[(k - 256) * 512 + c]; }
        WT[(size_t)n * 384 + k] = (bf16)(pk2(v, 0.f) & 0xffffu);
    }
}

__device__ __forceinline__ void ph_lora_in(const P& p) {
    const int tid = tid_opaque(), lane = tid & 63, wave = tid >> 6;
    const bf16* p0 = (const bf16*)(p.ws + WS_R1); bf16* LA = (bf16*)(p.ws + WS_H);
    const float* mu = p.in[19];
    const int nw = gridDim.x * 8;
    float m0[3], m1[3];
#pragma unroll
    for (int ch = 0; ch < 3; ++ch) { m0[ch] = mu[1536 + ch * 128 + lane * 2]; m1[ch] = mu[1536 + ch * 128 + lane * 2 + 1]; }
    for (int row0 = blockIdx.x * 8 + wave; row0 < M_TOK; row0 += 4 * nw) {
        unsigned cur[4][3], prv[4][3], nxt[4][3];
#pragma unroll
        for (int r = 0; r < 4; ++r) {
            const int row = (row0 + r * nw) < M_TOK ? (row0 + r * nw) : (M_TOK - 1);
            const int t = row < MP ? (row & 255) : ((row - MP) & 1023), L = row < MP ? 256 : 1024;
            const bool hp = t > 0, hn = t < L - 1;
#pragma unroll
            for (int ch = 0; ch < 3; ++ch) {
                const bf16* pc = p0 + (size_t)row * LDP0 + 1536 + ch * 128 + lane * 2;
                cur[r][ch] = *(const unsigned*)pc; prv[r][ch] = hp ? *(const unsigned*)(pc - LDP0) : 0u; nxt[r][ch] = hn ? *(const unsigned*)(pc + LDP0) : 0u;
            }
        }
#pragma unroll
        for (int r = 0; r < 4; ++r) {
            const int row = row0 + r * nw; if (row >= M_TOK) break;
#pragma unroll
            for (int ch = 0; ch < 3; ++ch) {
                float a0 = bflo(cur[r][ch]) + m0[ch] * (0.5f * (bflo(prv[r][ch]) + bflo(nxt[r][ch])) - bflo(cur[r][ch]));
                float a1 = bfhi(cur[r][ch]) + m1[ch] * (0.5f * (bfhi(prv[r][ch]) + bfhi(nxt[r][ch])) - bfhi(cur[r][ch]));
                if (ch == 0) { a0 = tanhf(a0); a1 = tanhf(a1); }
                if (ch == 2) { a0 = sigmoidf_(a0); a1 = sigmoidf_(a1); }
                *(unsigned*)(LA + (size_t)row * 384 + ch * 128 + lane * 2) = pk2(a0, a1);
            }
        }
    }
}

__device__ __forceinline__ void rwkv_item(const P& p, LAS unsigned char* lds, int kind, int b, int head, int dir) {
    constexpr int T = 32, NG = 8, GS = 1408;
    LAS float* grp = (LAS float*)lds;
    LAS float* raw = grp + 2 * NG * GS;
    LAS float* ybR = raw + T * 320;
    const int tid = tid_opaque(), lane = tid & 63, wave = tid >> 6, q = lane & 7, vl = lane >> 3, r0 = wave * 8 + vl;
    const int tt = tid >> 4, cgi = tid & 15;
    const int L = kind ? 1024 : 256, nblk = L / T;
    const int rowbase = kind ? MP + b * 1024 : b * 256;
    const bf16* p0 = (const bf16*)(p.ws + WS_R1);
    const bf16* lo = (const bf16*)(p.ws + WS_R2);
    bf16* Y = (bf16*)(p.ws + (dir == 0 ? WS_MIX : WS_H));
    const int colbase = head * 64;
    f32x2 S[4];
#pragma unroll
    for (int i = 0; i < 4; ++i) S[i] = (f32x2){0.f, 0.f};
    if (kind) { const float* s0 = p.in[2] + (((size_t)b * 2 + dir) * 8 + head) * 4096 + q * 8;
        const f32x4 a0 = *(const f32x4*)(s0 + r0 * 64), a1 = *(const f32x4*)(s0 + r0 * 64 + 4);
        S[0] = (f32x2){a0.x, a0.y}; S[1] = (f32x2){a0.z, a0.w}; S[2] = (f32x2){a1.x, a1.y}; S[3] = (f32x2){a1.z, a1.w}; }
    const int C = head * 64 + cgi * 4;
    const f32x4 cA = *(const f32x4*)(p.in[19] + C), cB = *(const f32x4*)(p.in[19] + 512 + C), cC = *(const f32x4*)(p.in[19] + 1024 + C);
    const f32x4 cD = *(const f32x4*)(p.in[25] + C), cE = *(const f32x4*)(p.in[26] + C);
    u32x2 ra0, ra1, ra2, rb0, rb1, rb2, rc0, rc1, rc2, rd, re;
    const u32x2 z2 = {0u, 0u};
#define RW_LOAD(blk) do { \
        const int n_ = (blk) * T + tt, t_ = dir ? L - 1 - n_ : n_; const size_t row_ = (size_t)(rowbase + t_); \
        const bool hp_ = t_ > 0, hn_ = t_ < L - 1; \
        const bf16* pr_ = p0 + row_ * LDP0 + head * 64 + cgi * 4; \
        ra1 = *(const u32x2*)pr_; ra0 = hp_ ? *(const u32x2*)(pr_ - LDP0) : z2; ra2 = hn_ ? *(const u32x2*)(pr_ + LDP0) : z2; \
        rb1 = *(const u32x2*)(pr_ + 512); rb0 = hp_ ? *(const u32x2*)(pr_ + 512 - LDP0) : z2; rb2 = hn_ ? *(const u32x2*)(pr_ + 512 + LDP0) : z2; \
        rc1 = *(const u32x2*)(pr_ + 1024); rc0 = hp_ ? *(const u32x2*)(pr_ + 1024 - LDP0) : z2; rc2 = hn_ ? *(const u32x2*)(pr_ + 1024 + LDP0) : z2; \
        rd = *(const u32x2*)(lo + row_ * 2560 + dir * 512 + head * 64 + cgi * 4); re = *(const u32x2*)(lo + row_ * 2560 + 1024 + dir * 512 + head * 64 + cgi * 4); \
    } while (0)
#define RW_PREP1(bi) do { \
        LAS float* rw_ = raw + tt * 320; const int c4_ = cgi * 4; \
        const f32x4 r1_ = unpk4(ra1), k1_ = unpk4(rb1), v1_ = unpk4(rc1); \
        const f32x4 r_ = r1_ + cA * ((unpk4(ra0) + unpk4(ra2)) * 0.5f - r1_); \
        const f32x4 k_ = k1_ + cB * ((unpk4(rb0) + unpk4(rb2)) * 0.5f - k1_); \
        const f32x4 v_ = v1_ + cC * ((unpk4(rc0) + unpk4(rc2)) * 0.5f - v1_); \
        f32x4 kk_ = k_ * cD; \
        const float ss_ = red16(kk_.x * kk_.x + kk_.y * kk_.y + kk_.z * kk_.z + kk_.w * kk_.w); \
        kk_ = kk_ * rsqrtf_(ss_ + 1e-6f); \
        const f32x4 ew_ = unpk4(rd), a_ = unpk4(re); \
        f32x4 w_; w_.x = __expf(-ew_.x); w_.y = __expf(-ew_.y); w_.z = __expf(-ew_.z); w_.w = __expf(-ew_.w); \
        *(LAS f32x4*)(rw_ + c4_) = kk_; *(LAS f32x4*)(rw_ + 64 + c4_) = w_; *(LAS f32x4*)(rw_ + 128 + c4_) = kk_ * a_; \
        *(LAS f32x4*)(rw_ + 192 + c4_) = k_ * ((a_ - 1.0f) * cE + 1.0f); *(LAS f32x4*)(rw_ + 256 + c4_) = r_; \
        *(LAS f32x4*)(grp + ((bi) * NG + (tt >> 2)) * GS + 1088 + (tt & 3) * 64 + c4_) = v_; \
    } while (0)
#define DOT16(aa_, bb_) red16((aa_)[0] * (bb_)[0] + (aa_)[1] * (bb_)[1] + (aa_)[2] * (bb_)[2] + (aa_)[3] * (bb_)[3])
#define RW_PREP2(bi) do { if (tid < 128) { \
        const int gq_ = tid >> 4, c4_ = cgi * 4; const LAS float* r4_ = raw + gq_ * 4 * 320 + c4_; LAS float* gi_ = grp + ((bi) * NG + gq_) * GS; \
        const f32x4 kk1 = *(const LAS f32x4*)(r4_), w1 = *(const LAS f32x4*)(r4_ + 64), b1 = *(const LAS f32x4*)(r4_ + 128), d1 = *(const LAS f32x4*)(r4_ + 192), q1 = *(const LAS f32x4*)(r4_ + 256); \
        const f32x4 kk2 = *(const LAS f32x4*)(r4_ + 320), w2 = *(const LAS f32x4*)(r4_ + 384), b2 = *(const LAS f32x4*)(r4_ + 448), d2 = *(const LAS f32x4*)(r4_ + 512), q2 = *(const LAS f32x4*)(r4_ + 576); \
        const f32x4 kk3 = *(const LAS f32x4*)(r4_ + 640), w3 = *(const LAS f32x4*)(r4_ + 704), b3 = *(const LAS f32x4*)(r4_ + 768), d3 = *(const LAS f32x4*)(r4_ + 832), q3 = *(const LAS f32x4*)(r4_ + 896); \
        const f32x4 kk4 = *(const LAS f32x4*)(r4_ + 960), w4 = *(const LAS f32x4*)(r4_ + 1024), b4 = *(const LAS f32x4*)(r4_ + 1088), d4 = *(const LAS f32x4*)(r4_ + 1152), q4 = *(const LAS f32x4*)(r4_ + 1216); \
        const f32x4 W02 = w1 * w2, W03 = W02 * w3, W04 = W03 * w4, W13 = w2 * w3, W14 = W13 * w4, W24 = w3 * w4; \
        *(LAS f32x4*)(gi_ + c4_) = kk1; *(LAS f32x4*)(gi_ + 64 + c4_) = w1 * kk2; *(LAS f32x4*)(gi_ + 128 + c4_) = W02 * kk3; *(LAS f32x4*)(gi_ + 192 + c4_) = W03 * kk4; \
        *(LAS f32x4*)(gi_ + 256 + c4_) = w1 * q1; *(LAS f32x4*)(gi_ + 320 + c4_) = W02 * q2; *(LAS f32x4*)(gi_ + 384 + c4_) = W03 * q3; *(LAS f32x4*)(gi_ + 448 + c4_) = W04 * q4; \
        *(LAS f32x4*)(gi_ + 512 + c4_) = d1 * W14; *(LAS f32x4*)(gi_ + 576 + c4_) = d2 * W24; *(LAS f32x4*)(gi_ + 640 + c4_) = d3 * w4; *(LAS f32x4*)(gi_ + 704 + c4_) = d4; \
        *(LAS f32x4*)(gi_ + 768 + c4_) = b1 * W14; *(LAS f32x4*)(gi_ + 832 + c4_) = b2 * W24; *(LAS f32x4*)(gi_ + 896 + c4_) = b3 * w4; *(LAS f32x4*)(gi_ + 960 + c4_) = b4; \
        *(LAS f32x4*)(gi_ + 1024 + c4_) = W04; \
        const f32x4 d1w2 = d1 * w2, d1w13 = d1 * W13, d1w14 = d1 * W14, d2w3 = d2 * w3, d2w24 = d2 * W24, d3w4 = d3 * w4; \
        const f32x4 b1w2 = b1 * w2, b1w13 = b1 * W13, b1w14 = b1 * W14, b2w3 = b2 * w3, b2w24 = b2 * W24, b3w4 = b3 * w4; \
        float sc_[32]; \
        sc_[0] = DOT16(d1, kk2); sc_[1] = DOT16(d1w2, kk3); sc_[2] = DOT16(d2, kk3); sc_[3] = DOT16(d1w13, kk4); sc_[4] = DOT16(d2w3, kk4); sc_[5] = DOT16(d3, kk4); \
        sc_[6] = DOT16(b1, kk2); sc_[7] = DOT16(b1w2, kk3); sc_[8] = DOT16(b2, kk3); sc_[9] = DOT16(b1w13, kk4); sc_[10] = DOT16(b2w3, kk4); sc_[11] = DOT16(b3, kk4); \
        sc_[12] = DOT16(d1, q1); sc_[13] = DOT16(d1w2, q2); sc_[14] = DOT16(d2, q2); sc_[15] = DOT16(d1w13, q3); sc_[16] = DOT16(d2w3, q3); sc_[17] = DOT16(d3, q3); \
        sc_[18] = DOT16(d1w14, q4); sc_[19] = DOT16(d2w24, q4); sc_[20] = DOT16(d3w4, q4); sc_[21] = DOT16(d4, q4); \
        sc_[22] = DOT16(b1, q1); sc_[23] = DOT16(b1w2, q2); sc_[24] = DOT16(b2, q2); sc_[25] = DOT16(b1w13, q3); sc_[26] = DOT16(b2w3, q3); sc_[27] = DOT16(b3, q3); \
        sc_[28] = DOT16(b1w14, q4); sc_[29] = DOT16(b2w24, q4); sc_[30] = DOT16(b3w4, q4); sc_[31] = DOT16(b4, q4); \
        if (cgi < 8) { _Pragma("unroll") for (int i_ = 0; i_ < 8; ++i_) if (cgi == i_) *(LAS f32x4*)(gi_ + 1344 + 4 * i_) = (f32x4){sc_[4 * i_], sc_[4 * i_ + 1], sc_[4 * i_ + 2], sc_[4 * i_ + 3]}; } \
    } } while (0)
    __syncthreads();
    RW_LOAD(0); RW_PREP1(0);
    __syncthreads();
    RW_PREP2(0);
    __syncthreads();
#pragma unroll 1
    for (int blk = 0; blk < nblk; ++blk) {
        const int bi = blk & 1;
        if (blk + 1 < nblk) RW_LOAD(blk + 1);
        LAS float* yb = ybR + bi * T * 64;
#pragma unroll 1
        for (int g = 0; g < NG; ++g) {
            const LAS float* gi = grp + (bi * NG + g) * GS;
            float dp[4], du[4];
#pragma unroll
            for (int t = 0; t < 4; ++t) {
                const f32x4 pa = *(const LAS f32x4*)(gi + t * 64 + q * 8), pb = *(const LAS f32x4*)(gi + t * 64 + q * 8 + 4);
                const f32x4 ua = *(const LAS f32x4*)(gi + 256 + t * 64 + q * 8), ub = *(const LAS f32x4*)(gi + 256 + t * 64 + q * 8 + 4);
                const f32x2 a = __builtin_elementwise_fma(S[0], (f32x2){pa.x, pa.y}, S[1] * (f32x2){pa.z, pa.w}) + __builtin_elementwise_fma(S[2], (f32x2){pb.x, pb.y}, S[3] * (f32x2){pb.z, pb.w});
                const f32x2 c = __builtin_elementwise_fma(S[0], (f32x2){ua.x, ua.y}, S[1] * (f32x2){ua.z, ua.w}) + __builtin_elementwise_fma(S[2], (f32x2){ub.x, ub.y}, S[3] * (f32x2){ub.z, ub.w});
                dp[t] = a.x + a.y; du[t] = c.x + c.y;
            }
#pragma unroll
            for (int t = 0; t < 4; ++t) { dp[t] = red8(dp[t]); du[t] = red8(du[t]); }
            const float v1 = gi[1088 + r0], v2 = gi[1152 + r0], v3 = gi[1216 + r0], v4 = gi[1280 + r0];
            const f32x4 A0 = *(const LAS f32x4*)(gi + 1344), A1 = *(const LAS f32x4*)(gi + 1348), B0 = *(const LAS f32x4*)(gi + 1352), E0 = *(const LAS f32x4*)(gi + 1356);
            const f32x4 E1 = *(const LAS f32x4*)(gi + 1360), E2 = *(const LAS f32x4*)(gi + 1364), F0 = *(const LAS f32x4*)(gi + 1368), F1 = *(const LAS f32x4*)(gi + 1372);
            const float g1 = dp[0];
            const float g2 = dp[1] + v1 * A0.x - g1 * A1.z;
            const float g3 = dp[2] + v1 * A0.y + v2 * A0.z - g1 * A1.w - g2 * B0.x;
            const float g4 = dp[3] + v1 * A0.w + v2 * A1.x + v3 * A1.y - g1 * B0.y - g2 * B0.z - g3 * B0.w;
            const float y1 = du[0] + v1 * E0.x - g1 * E2.z;
            const float y2 = du[1] + v1 * E0.y + v2 * E0.z - g1 * E2.w - g2 * F0.x;
            const float y3 = du[2] + v1 * E0.w + v2 * E1.x + v3 * E1.y - g1 * F0.y - g2 * F0.z - g3 * F0.w;
            const float y4 = du[3] + v1 * E1.z + v2 * E1.w + v3 * E2.x + v4 * E2.y - g1 * F1.x - g2 * F1.y - g3 * F1.z - g4 * F1.w;
            if (q == 0) { yb[(4 * g) * 64 + r0] = y1; yb[(4 * g + 1) * 64 + r0] = y2; yb[(4 * g + 2) * 64 + r0] = y3; yb[(4 * g + 3) * 64 + r0] = y4; }
            {
                const f32x4 wa = *(const LAS f32x4*)(gi + 1024 + q * 8), wb = *(const LAS f32x4*)(gi + 1024 + q * 8 + 4);
                f32x2 n0 = S[0] * (f32x2){wa.x, wa.y}, n1 = S[1] * (f32x2){wa.z, wa.w}, n2 = S[2] * (f32x2){wb.x, wb.y}, n3 = S[3] * (f32x2){wb.z, wb.w};
                const float vv[4] = {v1, v2, v3, v4}, gg[4] = {g1, g2, g3, g4};
#pragma unroll
                for (int j = 0; j < 4; ++j) {
                    const f32x4 da = *(const LAS f32x4*)(gi + 512 + j * 64 + q * 8), db = *(const LAS f32x4*)(gi + 512 + j * 64 + q * 8 + 4);
                    const f32x4 ba = *(const LAS f32x4*)(gi + 768 + j * 64 + q * 8), bb = *(const LAS f32x4*)(gi + 768 + j * 64 + q * 8 + 4);
                    const f32x2 vj = {vv[j], vv[j]}, ng = {-gg[j], -gg[j]};
                    n0 = __builtin_elementwise_fma(vj, (f32x2){da.x, da.y}, n0); n1 = __builtin_elementwise_fma(vj, (f32x2){da.z, da.w}, n1);
                    n2 = __builtin_elementwise_fma(vj, (f32x2){db.x, db.y}, n2); n3 = __builtin_elementwise_fma(vj, (f32x2){db.z, db.w}, n3);
                    n0 = __builtin_elementwise_fma(ng, (f32x2){ba.x, ba.y}, n0); n1 = __builtin_elementwise_fma(ng, (f32x2){ba.z, ba.w}, n1);
                    n2 = __builtin_elementwise_fma(ng, (f32x2){bb.x, bb.y}, n2); n3 = __builtin_elementwise_fma(ng, (f32x2){bb.z, bb.w}, n3);
                }
                S[0] = n0; S[1] = n1; S[2] = n2; S[3] = n3;
            }
        }
        if (blk + 1 < nblk) RW_PREP1(bi ^ 1);
        __syncthreads();
        if (blk + 1 < nblk) RW_PREP2(bi ^ 1);
        {
            const int r4 = cgi * 4, n = blk * T + tt, tk = dir ? L - 1 - n : n;
            const f32x4 yv = *(const LAS f32x4*)(yb + tt * 64 + r4);
            *(u32x2*)(Y + (size_t)(rowbase + tk) * 1024 + colbase + r4) = pk4(yv);
        }
        __syncthreads();
    }
#undef RW_LOAD
#undef RW_PREP1
#undef RW_PREP2
#undef DOT16
    if (!kind) { float* so = p.out + OUT_SRW + (((size_t)b * 2 + dir) * 8 + head) * 4096 + q * 8;
        *(f32x4*)(so + r0 * 64) = (f32x4){S[0].x, S[0].y, S[1].x, S[1].y}; *(f32x4*)(so + r0 * 64 + 4) = (f32x4){S[2].x, S[2].y, S[3].x, S[3].y}; }
}

__device__ __forceinline__ void gdn_item(const P& p, LAS unsigned char* lds, int kind, int b, int head, int dir, int half) {
    LAS bf16* Qs = (LAS bf16*)(lds);
    LAS bf16* Ks = (LAS bf16*)(lds + 17408);
    LAS bf16* KT = (LAS bf16*)(lds + 34816);
    LAS bf16* VT = (LAS bf16*)(lds + 53248);
    LAS bf16* ST = (LAS bf16*)(lds + 62464);
    LAS float* Lm = (LAS float*)(lds + 79872);
    LAS bf16* vnT = (LAS bf16*)(lds + 79872);
    LAS bf16* vnsT = (LAS bf16*)(lds + 79872 + 9216);
    LAS float* Tm = (LAS float*)(lds + 98304);
    LAS bf16* Tb = (LAS bf16*)(lds + 115712);
    LAS bf16* QKg = (LAS bf16*)(lds + 124928);
    LAS bf16* rT = (LAS bf16*)(lds + 134144);
    LAS float* gs = (LAS float*)(lds + 143360);
    LAS float* bs = gs + 64;
    LAS float* Gs = gs + 128;
    LAS float* eGs = gs + 192;
    LAS float* eGl = gs + 256;
    LAS float* misc = gs + 320;
    LAS float* CW = (LAS float*)(lds + 144896);
    LAS float* Ysc = (LAS float*)(lds + 148736);
    const int tid = tid_opaque(), lane = tid & 63, wave = tid >> 6, ln = lane & 15, h4 = lane >> 4;
    const int L = kind ? 1024 : 256, nch = L / 64, rowbase = kind ? MP + b * 1024 : b * 256;
    const bf16* p0 = (const bf16*)(p.ws + WS_R1);
    bf16* Y = (bf16*)(p.ws + (dir == 0 ? WS_MIX : WS_H));
    const int colbase = 512 + head * 128 + half * 64;
    const int pi = tid >> 3, c8 = tid & 7;
    const float gA = -expf(p.in[31][dir * 4 + head]), gB = p.in[32][dir * 4 + head];
    __syncthreads();
    for (int e = tid; e < 960; e += NTHREADS) {
        float v;
        if (e < 768) { const int part = e / 384, r = e % 384, tap = r >> 7, d = r & 127; v = p.in[30][tap * 1536 + part * 512 + head * 128 + d]; }
        else { const int r = e - 768, tap = r >> 6, c = r & 63; v = p.in[30][tap * 1536 + 1024 + head * 128 + half * 64 + c]; }
        CW[e] = v;
    }
    for (int e = tid; e < 64 * 72 / 2; e += NTHREADS) { ((LAS unsigned*)Tb)[e] = 0u; ((LAS unsigned*)QKg)[e] = 0u; }
    f32x4 accS[4];
#pragma unroll
    for (int vt = 0; vt < 4; ++vt) {
        accS[vt] = (f32x4){0.f, 0.f, 0.f, 0.f};
        if (kind) { const float* s0 = p.in[3] + (((size_t)b * 2 + dir) * 4 + head) * 16384 + half * 64 + vt * 16 + ln;
#pragma unroll
            for (int r = 0; r < 4; ++r) accS[vt][r] = s0[(size_t)(wave * 16 + h4 * 4 + r) * 128]; }
        *(LAS u32x2*)(ST + (vt * 16 + ln) * 136 + wave * 16 + h4 * 4) = pk4(accS[vt]);
    }
    u32x4 rq[3][2], rk[3][2], rv[3]; unsigned rab = 0u, rbb = 0u;
    const u32x4 z4 = {0u, 0u, 0u, 0u};
#define GD_LOAD(n) do { \
        const int i_ = (n) * 64 + pi, t_ = dir ? L - 1 - i_ : i_; const size_t row_ = (size_t)(rowbase + t_); \
        const bf16* pr_ = p0 + row_ * LDP0 + 1920 + head * 128 + c8 * 16; \
        const bf16* pv_ = p0 + row_ * LDP0 + 1920 + 1024 + head * 128 + half * 64 + c8 * 8; \
        _Pragma("unroll") for (int j_ = 0; j_ < 3; ++j_) { \
            const bool ok_ = (j_ == 1) || (j_ == 0 ? t_ > 0 : t_ < L - 1); const long o_ = (long)(j_ - 1) * LDP0; \
            rq[j_][0] = ok_ ? *(const u32x4*)(pr_ + o_) : z4; rq[j_][1] = ok_ ? *(const u32x4*)(pr_ + o_ + 8) : z4; \
            rk[j_][0] = ok_ ? *(const u32x4*)(pr_ + o_ + 512) : z4; rk[j_][1] = ok_ ? *(const u32x4*)(pr_ + o_ + 520) : z4; \
            rv[j_] = ok_ ? *(const u32x4*)(pv_ + o_) : z4; } \
        rab = p0[row_ * LDP0 + 3968 + dir * 8 + head]; rbb = p0[row_ * LDP0 + 3968 + dir * 8 + 4 + head]; \
    } while (0)
    GD_LOAD(0);
    __syncthreads();
#pragma unroll 1
    for (int n = 0; n < nch; ++n) {
        {
            const int pis = (((pi >> 3) ^ c8) << 3) | (pi & 7);
            {
                float xq[16]; float sq = 0.f;
#pragma unroll
                for (int e = 0; e < 16; ++e) { const int d = c8 * 16 + e; const int wi = e >> 1, hi = e & 1, vi = wi >> 2, ci = wi & 3;
                    const float q0 = hi ? bfhi(rq[0][vi][ci]) : bflo(rq[0][vi][ci]), q1 = hi ? bfhi(rq[1][vi][ci]) : bflo(rq[1][vi][ci]), q2 = hi ? bfhi(rq[2][vi][ci]) : bflo(rq[2][vi][ci]);
                    const float a = CW[d] * q0 + CW[128 + d] * q1 + CW[256 + d] * q2;
                    xq[e] = siluf_(a); sq += xq[e] * xq[e]; }
                sq = red8(sq);
                const float nq = 0.08838834764831845f * rsqrtf_(sq + 1e-6f);
                u32x4 w0, w1;
                w0.x = pk2(xq[0] * nq, xq[1] * nq); w0.y = pk2(xq[2] * nq, xq[3] * nq); w0.z = pk2(xq[4] * nq, xq[5] * nq); w0.w = pk2(xq[6] * nq, xq[7] * nq);
                w1.x = pk2(xq[8] * nq, xq[9] * nq); w1.y = pk2(xq[10] * nq, xq[11] * nq); w1.z = pk2(xq[12] * nq, xq[13] * nq); w1.w = pk2(xq[14] * nq, xq[15] * nq);
                *(LAS u32x4*)(Qs + pi * 136 + c8 * 16) = w0; *(LAS u32x4*)(Qs + pi * 136 + c8 * 16 + 8) = w1;
            }
            {
                float xk[16]; float sk = 0.f;
#pragma unroll
                for (int e = 0; e < 16; ++e) { const int d = c8 * 16 + e; const int wi = e >> 1, hi = e & 1, vi = wi >> 2, ci = wi & 3;
                    const float k0 = hi ? bfhi(rk[0][vi][ci]) : bflo(rk[0][vi][ci]), k1 = hi ? bfhi(rk[1][vi][ci]) : bflo(rk[1][vi][ci]), k2 = hi ? bfhi(rk[2][vi][ci]) : bflo(rk[2][vi][ci]);
                    const float c = CW[384 + d] * k0 + CW[512 + d] * k1 + CW[640 + d] * k2;
                    xk[e] = siluf_(c); sk += xk[e] * xk[e]; }
                sk = red8(sk);
                const float nk = rsqrtf_(sk + 1e-6f);
                u32x4 w0, w1;
                w0.x = pk2(xk[0] * nk, xk[1] * nk); w0.y = pk2(xk[2] * nk, xk[3] * nk); w0.z = pk2(xk[4] * nk, xk[5] * nk); w0.w = pk2(xk[6] * nk, xk[7] * nk);
                w1.x = pk2(xk[8] * nk, xk[9] * nk); w1.y = pk2(xk[10] * nk, xk[11] * nk); w1.z = pk2(xk[12] * nk, xk[13] * nk); w1.w = pk2(xk[14] * nk, xk[15] * nk);
                *(LAS u32x4*)(Ks + pi * 136 + c8 * 16) = w0; *(LAS u32x4*)(Ks + pi * 136 + c8 * 16 + 8) = w1;
#pragma unroll
                for (int e = 0; e < 4; ++e) {
                    KT[(c8 * 16 + 2 * e) * 72 + pis] = (bf16)(w0[e] & 0xffffu); KT[(c8 * 16 + 2 * e + 1) * 72 + pis] = (bf16)(w0[e] >> 16);
                    KT[(c8 * 16 + 8 + 2 * e) * 72 + pis] = (bf16)(w1[e] & 0xffffu); KT[(c8 * 16 + 8 + 2 * e + 1) * 72 + pis] = (bf16)(w1[e] >> 16); }
            }
#pragma unroll
            for (int e = 0; e < 8; ++e) { const int c = c8 * 8 + e; const int wi = e >> 1, hi = e & 1;
                const float v0 = hi ? bfhi(rv[0][wi]) : bflo(rv[0][wi]), v1 = hi ? bfhi(rv[1][wi]) : bflo(rv[1][wi]), v2 = hi ? bfhi(rv[2][wi]) : bflo(rv[2][wi]);
                const float a = CW[768 + c] * v0 + CW[832 + c] * v1 + CW[896 + c] * v2;
                VT[c * 72 + pis] = (bf16)(pk2(siluf_(a), 0.f) & 0xffffu); }
            if (c8 == 0) { const float xa = bf2f(rab) + gB; const float sp = xa > 20.f ? xa : log1pf(expf(xa)); gs[pi] = gA * sp; bs[pi] = 1.0f / (1.0f + expf(-bf2f(rbb))); }
        }
        __syncthreads();
        if (n + 1 < nch) GD_LOAD(n + 1);
        if (wave == 0) {
            float x = gs[lane];
            x += DPPF(x, 0x111); x += DPPF(x, 0x112); x += DPPF(x, 0x114); x += DPPF(x, 0x118);
            const int xi = __float_as_int(x);
            const float t0 = __int_as_float(__builtin_amdgcn_readlane(xi, 15)), t1 = __int_as_float(__builtin_amdgcn_readlane(xi, 31)), t2 = __int_as_float(__builtin_amdgcn_readlane(xi, 47));
            x += (lane >= 48) ? (t0 + t1 + t2) : ((lane >= 32) ? (t0 + t1) : ((lane >= 16) ? t0 : 0.f));
            const float Gl = __int_as_float(__builtin_amdgcn_readlane(__float_as_int(x), 63));
            Gs[lane] = x; eGs[lane] = __expf(x); eGl[lane] = __expf(Gl - x); if (lane == 0) misc[0] = __expf(Gl);
        }
        __syncthreads();
#pragma unroll 1
        for (int tix = wave; tix < 20; tix += 8) {
            const int x = tix < 10 ? tix : tix - 10;
            const int it = x >= 6 ? 3 : (x >= 3 ? 2 : (x >= 1 ? 1 : 0)), jt = x - (it * (it + 1)) / 2;
            f32x4 a = {0.f, 0.f, 0.f, 0.f};
            if (tix < 10) {
#pragma unroll
                for (int s = 0; s < 4; ++s) a = __builtin_amdgcn_mfma_f32_16x16x32_bf16(*(const LAS s16x8*)(Ks + (16 * it + ln) * 136 + 32 * s + 8 * h4), *(const LAS s16x8*)(Ks + (16 * jt + ln) * 136 + 32 * s + 8 * h4), a, 0, 0, 0);
                const int j = 16 * jt + ln; const float Gj = Gs[j];
#pragma unroll
                for (int r = 0; r < 4; ++r) { const int i = 16 * it + 4 * h4 + r; Lm[i * 72 + j] = i > j ? bs[i] * a[r] * __expf(Gs[i] - Gj) : 0.f; }
            } else {
#pragma unroll
                for (int s = 0; s < 4; ++s) a = __builtin_amdgcn_mfma_f32_16x16x32_bf16(*(const LAS s16x8*)(Ks + (16 * jt + ln) * 136 + 32 * s + 8 * h4), *(const LAS s16x8*)(Qs + (16 * it + ln) * 136 + 32 * s + 8 * h4), a, 0, 0, 0);
                const int i = 16 * it + ln; const float Gi = Gs[i]; f32x4 o;
#pragma unroll
                for (int r = 0; r < 4; ++r) { const int j = 16 * jt + 4 * h4 + r; o[r] = i >= j ? a[r] * __expf(Gi - Gs[j]) : 0.f; }
                *(LAS u32x2*)(QKg + i * 72 + 16 * jt + 4 * h4) = pk4(o);
            }
        }
        __syncthreads();
        if (wave == 0) {
            const int a = h4, c = ln; float xr[16];
#pragma unroll
            for (int r = 0; r < 16; ++r) { float s = (r == c) ? 1.0f : 0.0f;
#pragma unroll
                for (int m = 0; m < r; ++m) s -= Lm[(16 * a + r) * 72 + 16 * a + m] * xr[m];
                xr[r] = s; }
#pragma unroll
            for (int r = 0; r < 16; ++r) { Tm[(16 * a + r) * 68 + 16 * a + c] = xr[r]; Tb[(16 * a + r) * 72 + 16 * a + c] = (bf16)(pk2(xr[r], 0.f) & 0xffffu); }
        } else {
#pragma unroll 1
            for (int tk = wave - 1; tk < 16; tk += 7) {
                const int it = tk >> 2, vt = tk & 3; f32x4 a = {0.f, 0.f, 0.f, 0.f};
#pragma unroll
                for (int s = 0; s < 4; ++s) a = __builtin_amdgcn_mfma_f32_16x16x32_bf16(*(const LAS s16x8*)(Ks + (16 * it + ln) * 136 + 32 * s + 8 * h4), *(const LAS s16x8*)(ST + (16 * vt + ln) * 136 + 32 * s + 8 * h4), a, 0, 0, 0);
                const int v = 16 * vt + ln, i0 = 16 * it + 4 * h4;
                const f32x4 vj = unpk4(*(const LAS u32x2*)(VT + v * 72 + ((((i0 >> 3) ^ (v >> 3)) & 7) << 3) + (i0 & 7))), be = *(const LAS f32x4*)(bs + i0), eg = *(const LAS f32x4*)(eGs + i0);
                *(LAS u32x2*)(rT + v * 72 + i0) = pk4(be * (vj - eg * a));
            }
        }
        __syncthreads();
#pragma unroll 1
        for (int dist = 1; dist < 4; ++dist) {
            if (wave < 4 - dist) {
                const int bb = wave, aa = wave + dist; LAS float* ys = Ysc + wave * 272;
                f32x4 y = {0.f, 0.f, 0.f, 0.f};
                float la[3][4], tb[3][4];
#pragma unroll
                for (int mm = 0; mm < 3; ++mm)
#pragma unroll
                    for (int s = 0; s < 4; ++s) { const int m = bb + (mm < dist ? mm : 0);
                        la[mm][s] = Lm[(16 * aa + ln) * 72 + 16 * m + 4 * s + h4]; tb[mm][s] = Tm[(16 * m + 4 * s + h4) * 68 + 16 * bb + ln]; }
#pragma unroll
                for (int mm = 0; mm < 3; ++mm)
                    if (mm < dist) {
#pragma unroll
                        for (int s = 0; s < 4; ++s) y = __builtin_amdgcn_mfma_f32_16x16x4f32(la[mm][s], tb[mm][s], y, 0, 0, 0); }
#pragma unroll
                for (int r = 0; r < 4; ++r) ys[(4 * h4 + r) * 17 + ln] = y[r];
                f32x4 z = {0.f, 0.f, 0.f, 0.f};
#pragma unroll
                for (int s = 0; s < 4; ++s) z = __builtin_amdgcn_mfma_f32_16x16x4f32(Tm[(16 * aa + ln) * 68 + 16 * aa + 4 * s + h4], ys[(4 * s + h4) * 17 + ln], z, 0, 0, 0);
#pragma unroll
                for (int r = 0; r < 4; ++r) { const int i = 16 * aa + 4 * h4 + r, j = 16 * bb + ln; Tm[i * 68 + j] = -z[r]; Tb[i * 72 + j] = (bf16)(pk2(-z[r], 0.f) & 0xffffu); }
            }
            __syncthreads();
        }
#pragma unroll
        for (int u = 0; u < 2; ++u) {
            const int tile = 2 * wave + u, it = tile >> 2, vt = tile & 3; f32x4 a = {0.f, 0.f, 0.f, 0.f};
            a = __builtin_amdgcn_mfma_f32_16x16x32_bf16(*(const LAS s16x8*)(Tb + (16 * it + ln) * 72 + 8 * h4), *(const LAS s16x8*)(rT + (16 * vt + ln) * 72 + 8 * h4), a, 0, 0, 0);
            if (it >= 2) a = __builtin_amdgcn_mfma_f32_16x16x32_bf16(*(const LAS s16x8*)(Tb + (16 * it + ln) * 72 + 32 + 8 * h4), *(const LAS s16x8*)(rT + (16 * vt + ln) * 72 + 32 + 8 * h4), a, 0, 0, 0);
            const int v = 16 * vt + ln, i0 = 16 * it + 4 * h4;
            *(LAS u32x2*)(vnT + v * 72 + i0) = pk4(a); *(LAS u32x2*)(vnsT + v * 72 + i0) = pk4(a * *(const LAS f32x4*)(eGl + i0));
        }
        __syncthreads();
#pragma unroll
        for (int u = 0; u < 2; ++u) {
            const int tile = 2 * wave + u, vt = tile >> 2, it = tile & 3; f32x4 a = {0.f, 0.f, 0.f, 0.f};
#pragma unroll
            for (int s = 0; s < 4; ++s) a = __builtin_amdgcn_mfma_f32_16x16x32_bf16(*(const LAS s16x8*)(ST + (16 * vt + ln) * 136 + 32 * s + 8 * h4), *(const LAS s16x8*)(Qs + (16 * it + ln) * 136 + 32 * s + 8 * h4), a, 0, 0, 0);
            a = a * eGs[16 * it + ln];
            a = __builtin_amdgcn_mfma_f32_16x16x32_bf16(*(const LAS s16x8*)(vnT + (16 * vt + ln) * 72 + 8 * h4), *(const LAS s16x8*)(QKg + (16 * it + ln) * 72 + 8 * h4), a, 0, 0, 0);
            if (it >= 2) a = __builtin_amdgcn_mfma_f32_16x16x32_bf16(*(const LAS s16x8*)(vnT + (16 * vt + ln) * 72 + 32 + 8 * h4), *(const LAS s16x8*)(QKg + (16 * it + ln) * 72 + 32 + 8 * h4), a, 0, 0, 0);
            const int ic = n * 64 + 16 * it + ln, tk = dir ? L - 1 - ic : ic;
            *(u32x2*)(Y + (size_t)(rowbase + tk) * 1024 + colbase + 16 * vt + 4 * h4) = pk4(a);
        }
        {
            const float egl = misc[0];
#pragma unroll
            for (int vt = 0; vt < 4; ++vt) {
                f32x4 a = accS[vt] * egl;
#pragma unroll
                for (int s = 0; s < 2; ++s) a = __builtin_amdgcn_mfma_f32_16x16x32_bf16(*(const LAS s16x8*)(KT + (16 * wave + ln) * 72 + (((4 * s + h4) ^ wave) << 3)), *(const LAS s16x8*)(vnsT + (16 * vt + ln) * 72 + 32 * s + 8 * h4), a, 0, 0, 0);
                accS[vt] = a;
            }
        }
        __syncthreads();
#pragma unroll
        for (int vt = 0; vt < 4; ++vt) *(LAS u32x2*)(ST + (vt * 16 + ln) * 136 + wave * 16 + h4 * 4) = pk4(accS[vt]);
    }
#undef GD_LOAD
    if (!kind) { float* so = p.out + OUT_SGD + (((size_t)b * 2 + dir) * 4 + head) * 16384 + half * 64;
#pragma unroll
        for (int vt = 0; vt < 4; ++vt)
#pragma unroll
            for (int r = 0; r < 4; ++r) so[(size_t)(wave * 16 + h4 * 4 + r) * 128 + vt * 16 + ln] = accS[vt][r]; }
}
__device__ __forceinline__ void rwkv_idx(const P& p, LAS unsigned char* lds, int i) {
    const int kind = i < 128 ? 1 : 0, j = i < 128 ? i : i - 128;
    rwkv_item(p, lds, kind, j >> 4, (j >> 1) & 7, j & 1);
}
__device__ __forceinline__ void gdn_idx(const P& p, LAS unsigned char* lds, int i) {
    const int kind = i < 128 ? 1 : 0, j = i < 128 ? i : i - 128;
    gdn_item(p, lds, kind, j >> 4, (j >> 2) & 3, (j >> 1) & 1, j & 1);
}
__device__ __forceinline__ void ph_scan(const P& p, LAS unsigned char* lds) {
    const int B = blockIdx.x, G = gridDim.x;
    if (G == 256) {
        if (B < 128) { rwkv_idx(p, lds, B); for (int i = 0; i < 4; ++i) gdn_idx(p, lds, 128 + B * 4 + i); }
        else { gdn_idx(p, lds, B - 128); for (int i = 0; i < 4; ++i) rwkv_idx(p, lds, 128 + (B - 128) * 4 + i); }
    } else {
        for (int i = B; i < 640; i += G) { rwkv_idx(p, lds, i); gdn_idx(p, lds, i); }
    }
}

__device__ __forceinline__ void ph_post_ab(const P& p, bool dummy) {
    const int tid = tid_opaque(), lane = tid & 63, wave = tid >> 6;
    const bf16* p0 = (const bf16*)(p.ws + WS_R1); const bf16* lo = (const bf16*)(p.ws + WS_R2);
    bf16* MX = (bf16*)(p.ws + WS_MIX); const bf16* YB = (const bf16*)(p.ws + WS_H);
    bf16* MO = dummy ? (bf16*)(p.out + OUT_CKV) : MX;
    const int C = lane * 8;
    float mur[8], muk[8], muv[8], ka[8], rk[8], lw[8], lb[8], gn[8];
#pragma unroll
    for (int i = 0; i < 8; ++i) { mur[i] = p.in[19][C + i]; muk[i] = p.in[19][512 + C + i]; muv[i] = p.in[19][1024 + C + i]; ka[i] = p.in[26][C + i]; rk[i] = p.in[27][C + i];
        lw[i] = p.in[28][C + i]; lb[i] = p.in[29][C + i]; gn[i] = p.in[33][(C + i) & 127]; }
    for (int row = blockIdx.x * 8 + wave; row < M_TOK; row += gridDim.x * 8) {
        const int t = row < MP ? (row & 255) : ((row - MP) & 1023), L = row < MP ? 256 : 1024;
        const bool hp = t > 0, hn = t < L - 1;
        const u32x4 z4 = {0u, 0u, 0u, 0u};
        const bf16* pr = p0 + (size_t)row * LDP0 + C;
        float r[8], k[8], v[8];
        {
            const u32x4 c = *(const u32x4*)pr, a = hp ? *(const u32x4*)(pr - LDP0) : z4, n = hn ? *(const u32x4*)(pr + LDP0) : z4;
#pragma unroll
            for (int i = 0; i < 4; ++i) { float c0 = bflo(c[i]), c1 = bfhi(c[i]); r[2 * i] = c0 + mur[2 * i] * (0.5f * (bflo(a[i]) + bflo(n[i])) - c0); r[2 * i + 1] = c1 + mur[2 * i + 1] * (0.5f * (bfhi(a[i]) + bfhi(n[i])) - c1); }
        }
        {
            const u32x4 c = *(const u32x4*)(pr + 512), a = hp ? *(const u32x4*)(pr + 512 - LDP0) : z4, n = hn ? *(const u32x4*)(pr + 512 + LDP0) : z4;
#pragma unroll
            for (int i = 0; i < 4; ++i) { float c0 = bflo(c[i]), c1 = bfhi(c[i]); k[2 * i] = c0 + muk[2 * i] * (0.5f * (bflo(a[i]) + bflo(n[i])) - c0); k[2 * i + 1] = c1 + muk[2 * i + 1] * (0.5f * (bfhi(a[i]) + bfhi(n[i])) - c1); }
        }
        {
            const u32x4 c = *(const u32x4*)(pr + 1024), a = hp ? *(const u32x4*)(pr + 1024 - LDP0) : z4, n = hn ? *(const u32x4*)(pr + 1024 + LDP0) : z4;
#pragma unroll
            for (int i = 0; i < 4; ++i) { float c0 = bflo(c[i]), c1 = bfhi(c[i]); v[2 * i] = c0 + muv[2 * i] * (0.5f * (bflo(a[i]) + bflo(n[i])) - c0); v[2 * i + 1] = c1 + muv[2 * i + 1] * (0.5f * (bfhi(a[i]) + bfhi(n[i])) - c1); }
        }
        const u32x4 af = *(const u32x4*)(lo + (size_t)row * 2560 + 1024 + C), ab = *(const u32x4*)(lo + (size_t)row * 2560 + 1536 + C), gg = *(const u32x4*)(lo + (size_t)row * 2560 + 2048 + C);
        const u32x4 yf = *(const u32x4*)(MX + (size_t)row * 1024 + C), yb = *(const u32x4*)(YB + (size_t)row * 1024 + C);
        float y[8], s = 0.f, bon = 0.f;
#pragma unroll
        for (int i = 0; i < 4; ++i) {
            y[2 * i] = bflo(yf[i]) + bflo(yb[i]); y[2 * i + 1] = bfhi(yf[i]) + bfhi(yb[i]); s += y[2 * i] + y[2 * i + 1];
            const float am0 = 0.5f * (bflo(af[i]) + bflo(ab[i])), am1 = 0.5f * (bfhi(af[i]) + bfhi(ab[i]));
            bon += r[2 * i] * k[2 * i] * (1.0f + (am0 - 1.0f) * ka[2 * i]) * rk[2 * i] + r[2 * i + 1] * k[2 * i + 1] * (1.0f + (am1 - 1.0f) * ka[2 * i + 1]) * rk[2 * i + 1];
        }
        const float mean = red8(s) * (1.0f / 64.0f); bon = red8(bon);
        float q2 = 0.f;
#pragma unroll
        for (int i = 0; i < 8; ++i) { y[i] -= mean; q2 += y[i] * y[i]; }
        const float rstd = 1.0f / sqrtf(red8(q2) * (1.0f / 64.0f) + 64e-5f);
        u32x4 o;
#pragma unroll
        for (int i = 0; i < 4; ++i) {
            const float o0 = (y[2 * i] * rstd * lw[2 * i] + lb[2 * i] + bon * v[2 * i]) * bflo(gg[i]);
            const float o1 = (y[2 * i + 1] * rstd * lw[2 * i + 1] + lb[2 * i + 1] + bon * v[2 * i + 1]) * bfhi(gg[i]);
            o[i] = pk2(o0, o1);
        }
        const size_t orow = dummy ? (size_t)(row & 4095) : (size_t)row;
        *(u32x4*)(MO + orow * 1024 + C) = o;
        const u32x4 of = *(const u32x4*)(MX + (size_t)row * 1024 + 512 + C), ob = *(const u32x4*)(YB + (size_t)row * 1024 + 512 + C);
        const u32x4 zz = *(const u32x4*)(p0 + (size_t)row * LDP0 + 1920 + 1536 + C);
        float og[8], so = 0.f;
#pragma unroll
        for (int i = 0; i < 4; ++i) { og[2 * i] = bflo(of[i]) + bflo(ob[i]); og[2 * i + 1] = bfhi(of[i]) + bfhi(ob[i]); so += og[2 * i] * og[2 * i] + og[2 * i + 1] * og[2 * i + 1]; }
        const float rs = 1.0f / sqrtf(red16(so) * (1.0f / 128.0f) + 1e-6f);
        u32x4 o2;
#pragma unroll
        for (int i = 0; i < 4; ++i) { const float z0 = bflo(zz[i]), z1 = bfhi(zz[i]);
            o2[i] = pk2(og[2 * i] * rs * gn[2 * i] * siluf_(z0), og[2 * i + 1] * rs * gn[2 * i + 1] * siluf_(z1)); }
        *(u32x4*)(MO + orow * 1024 + 512 + C) = o2;
    }
}

__device__ __forceinline__ void ph_hyena_filters(const P& p, LAS unsigned char* lds) {
    LAS float* f0 = (LAS float*)lds;
    LAS float* h1 = f0 + 32 * 36;
    LAS float* h2 = h1 + 32 * 64;
    LAS bf16* stg = (LAS bf16*)(h2 + 64 * 32);
    LAS float* w1s = h2 + 64 * 32 + 8192;
    LAS float* w2s = w1s + 33 * 64;
    const int tid = tid_opaque();
    const float* b1 = p.in[41]; const float* b2 = p.in[43]; const float* w3 = p.in[44]; const float* fr = p.in[45];
    __syncthreads();
    if (blockIdx.x < 160) {
        for (int e = tid; e < 33 * 64; e += NTHREADS) w1s[e] = p.in[40][e];
        for (int e = tid; e < 64 * 64; e += NTHREADS) w2s[e] = p.in[42][e];
    }
    for (int item4 = blockIdx.x; item4 < 160; item4 += gridDim.x) {
        const int item = item4 >> 2, oo = item4 & 3;
        const int ls = item < 32 ? 1 : 0;
        const int L = ls ? 1024 : 256, t0 = (ls ? item : item - 32) * 32;
        const int o = tid + oo * 512;
        float wreg[16];
#pragma unroll
        for (int f = 0; f < 16; ++f) wreg[f] = w3[f * 2048 + o];
        __syncthreads();
        for (int e = tid; e < 32 * 33; e += NTHREADS) {
            const int pi = e / 33, f = e % 33; const float t = (float)(t0 + pi);
            float v;
            if (f == 0) v = t / (float)(L - 1);
            else { const int bi = (f - 1) & 15; const float band = 1e-4f + (15.0f - 1e-4f) * ((float)bi / 15.0f); const float ang = (6.283185307179586f / (float)L) * t * band; v = f <= 16 ? __cosf(ang) : -__sinf(ang); }
            f0[pi * 36 + f] = v;
        }
        __syncthreads();
        {
            const int j = tid & 63, pq = tid >> 6; const float bj = b1[j], fj = fr[j];
            float sacc[4] = {bj, bj, bj, bj};
#pragma unroll 3
            for (int f = 0; f < 33; ++f) { const float w = w1s[f * 64 + j];
#pragma unroll
                for (int i = 0; i < 4; ++i) sacc[i] += f0[(pq + 8 * i) * 36 + f] * w; }
#pragma unroll
            for (int i = 0; i < 4; ++i) h1[(pq + 8 * i) * 64 + j] = __sinf(fj * sacc[i]);
        }
        __syncthreads();
        {
            const int j = tid & 63, pq = tid >> 6; const float bj = b2[j], fj = fr[64 + j];
            float sacc[4] = {bj, bj, bj, bj};
#pragma unroll 4
            for (int f = 0; f < 64; ++f) { const float w = w2s[f * 64 + j];
#pragma unroll
                for (int i = 0; i < 4; ++i) sacc[i] += h1[(pq + 8 * i) * 64 + f] * w; }
#pragma unroll
            for (int i = 0; i < 4; ++i) h2[j * 32 + pq + 8 * i] = __sinf(fj * sacc[i]);
        }
        __syncthreads();
        bf16* G = (bf16*)(p.ws + (ls ? WS_GFS : WS_GFP));
        {
            const int c = o & 511;
            f32x4 sv[8];
#pragma unroll
            for (int i = 0; i < 8; ++i) sv[i] = (f32x4){0.f, 0.f, 0.f, 0.f};
#pragma unroll
            for (int fq = 0; fq < 4; ++fq) {
                float wn[16];
                if (fq < 3) {
#pragma unroll
                    for (int f = 0; f < 16; ++f) wn[f] = w3[((fq + 1) * 16 + f) * 2048 + o];
                }
#pragma unroll
                for (int f = 0; f < 16; ++f) { const float w = wreg[f]; const LAS f32x4* hp = (const LAS f32x4*)(h2 + (fq * 16 + f) * 32);
#pragma unroll
                    for (int i = 0; i < 8; ++i) sv[i] += hp[i] * w; }
                if (fq < 3) {
#pragma unroll
                    for (int f = 0; f < 16; ++f) wreg[f] = wn[f];
                }
            }
            const float delta = 3.0701134573253944f + (15.350567286626973f - 3.0701134573253944f) * ((float)c / 511.0f);
            const float inv = 1.0f / (float)(L - 1);
#pragma unroll
            for (int i = 0; i < 8; ++i) {
                const float ta = (float)(t0 + 4 * i) * inv, tb = (float)(t0 + 4 * i + 1) * inv, tc = (float)(t0 + 4 * i + 2) * inv, td = (float)(t0 + 4 * i + 3) * inv;
                *(LAS u32x2*)(stg + tid * 32 + 4 * i) = (u32x2){pk2(sv[i].x * __expf(-ta * delta), sv[i].y * __expf(-tb * delta)), pk2(sv[i].z * __expf(-tc * delta), sv[i].w * __expf(-td * delta))};
            }
            __syncthreads();
            const int lane = tid & 63, wv = tid >> 6, pi = lane & 31;
#pragma unroll 4
            for (int r = 0; r < 32; ++r) {
                const int col = wv * 64 + r * 2 + (lane >> 5);
                const int o2 = col + oo * 512, order2 = o2 >> 10, dr2 = (o2 >> 9) & 1, c2 = o2 & 511, t = t0 + pi;
                const bf16 hv = stg[col * 32 + pi];
                bf16* g = G + ((size_t)order2 * 512 + c2) * (2 * L);
                if (dr2 == 0) g[L - t] = hv;
                else if (t > 0) g[L + t] = hv;
                if (dr2 == 0 && t == 0) g[0] = 0;
            }
        }
    }
}

__device__ __forceinline__ void ph_mla_prep(const P& p, LAS unsigned char* lds) {
    const int tid = tid_opaque(), lane = tid & 63, wave = tid >> 6;
    const bf16* p1 = (const bf16*)(p.ws + WS_R1);
    bf16* qn = (bf16*)(p.ws + WS_H); bf16* ckva = (bf16*)(p.ws + WS_CKVA); bf16* kpea = (bf16*)(p.ws + WS_KPEA);
    const float* rope = (const float*)(p.ws + WS_ROPE);
    const float* qg = p.in[35]; const float* kg = p.in[37];
    const int nw = gridDim.x * 8;
    for (int row0 = blockIdx.x * 8 + wave; row0 < M_TOK; row0 += 4 * nw) {
        unsigned qw[4][3], kw[4]; u32x2 vw[4]; float sq[4], sk[4];
#pragma unroll
        for (int r = 0; r < 4; ++r) {
            const int row = (row0 + r * nw) < M_TOK ? (row0 + r * nw) : (M_TOK - 1);
            const bf16* pr = p1 + (size_t)row * LDP1;
#pragma unroll
            for (int j = 0; j < 3; ++j) qw[r][j] = *(const unsigned*)(pr + j * 128 + lane * 2);
            vw[r] = *(const u32x2*)(pr + 384 + lane * 4);
            kw[r] = lane < 16 ? *(const unsigned*)(pr + 640 + lane * 2) : 0u;
        }
#pragma unroll
        for (int r = 0; r < 4; ++r) {
            float s = 0.f;
#pragma unroll
            for (int j = 0; j < 3; ++j) s += bflo(qw[r][j]) * bflo(qw[r][j]) + bfhi(qw[r][j]) * bfhi(qw[r][j]);
            sq[r] = s;
            const f32x4 kv = unpk4(vw[r]); sk[r] = kv.x * kv.x + kv.y * kv.y + kv.z * kv.z + kv.w * kv.w;
        }
#pragma unroll
        for (int o = 1; o < 64; o <<= 1) {
#pragma unroll
            for (int r = 0; r < 4; ++r) { sq[r] += __shfl_xor(sq[r], o); sk[r] += __shfl_xor(sk[r], o); } }
#pragma unroll
        for (int r = 0; r < 4; ++r) {
            const int row = row0 + r * nw; if (row >= M_TOK) break;
            const float rq = rsqrtf_(sq[r] * (1.0f / 384.0f) + 1e-6f), rk = rsqrtf_(sk[r] * (1.0f / 256.0f) + 1e-6f);
#pragma unroll
            for (int j = 0; j < 3; ++j) { const int col = j * 128 + lane * 2; *(unsigned*)(qn + (size_t)row * 384 + col) = pk2(bflo(qw[r][j]) * rq * qg[col], bfhi(qw[r][j]) * rq * qg[col + 1]); }
            const f32x4 ck = unpk4(vw[r]) * rk * *(const f32x4*)(kg + lane * 4);
            *(u32x2*)(ckva + (size_t)row * 256 + lane * 4) = pk4(ck);
            if (row < MP) *(f32x4*)(p.out + OUT_CKV + (size_t)row * 256 + lane * 4) = ck;
            if (lane < 16) {
                float x1 = bflo(kw[r]), x2 = bfhi(kw[r]);
                if (row < MP) { *(f32x2*)(p.out + OUT_KPE + (size_t)row * 32 + lane * 2) = (f32x2){x1, x2}; }
                else { const int tq = (row - MP) & 1023; const f32x2 cs = *(const f32x2*)(rope + (size_t)tq * 32 + lane * 2); const float a = x1 * cs.x - x2 * cs.y, bq = x1 * cs.y + x2 * cs.x; x1 = a; x2 = bq; }
                *(unsigned*)(kpea + (size_t)row * 32 + lane * 2) = pk2(x1, x2);
            }
        }
    }
    for (int r2 = blockIdx.x * 8 + wave; r2 < 2048; r2 += nw) {
        const int row = M_TOK + r2;
        const f32x4 cv = *(const f32x4*)(p.in[4] + (size_t)r2 * 256 + lane * 4);
        *(u32x2*)(ckva + (size_t)row * 256 + lane * 4) = pk4(cv);
        if (lane < 16) { const f32x2 kp = *(const f32x2*)(p.in[5] + (size_t)r2 * 32 + lane * 2); *(unsigned*)(kpea + (size_t)row * 32 + lane * 2) = pk2(kp.x, kp.y); }
    }
    LAS float* tile = (LAS float*)(lds + wave * 8832);
    bf16* HT = (bf16*)(p.ws + WS_HYIN);
    const float* cw = p.in[39];
    for (int it = blockIdx.x * 8 + wave; it < 256 * 48; it += gridDim.x * 8) {
        const int rt = it / 48, cb = it % 48;
        const int r0 = rt * 64, col0 = 672 + cb * 32;
        const int t0 = r0 < MP ? (r0 & 255) : ((r0 - MP) & 1023), L = r0 < MP ? 256 : 1024;
        unsigned wv[17];
#pragma unroll
        for (int i = 0; i < 17; ++i) {
            const int rr = i * 4 + (lane >> 4), tt = t0 - 1 + rr;
            wv[i] = (rr < 66 && tt >= 0 && tt < L) ? *(const unsigned*)(p1 + (size_t)(r0 - 1 + rr) * LDP1 + col0 + (lane & 15) * 2) : 0u;
        }
#pragma unroll
        for (int i = 0; i < 17; ++i) {
            const int rr = i * 4 + (lane >> 4);
            if (rr < 66) { tile[rr * 33 + (lane & 15) * 2] = bflo(wv[i]); tile[rr * 33 + (lane & 15) * 2 + 1] = bfhi(wv[i]); }
        }
        LDS_WAIT();
#pragma unroll 8
        for (int c = 0; c < 32; ++c) {
            const int ch = cb * 32 + c;
            const float v = cw[ch] * tile[lane * 33 + c] + cw[1536 + ch] * tile[(lane + 1) * 33 + c] + cw[3072 + ch] * tile[(lane + 2) * 33 + c];
            HT[(size_t)ch * M_TOK + r0 + lane] = (bf16)(pk2(v, 0.f) & 0xffffu);
        }
        LDS_WAIT();
    }
}

__device__ __forceinline__ void attn_item(const P& p, LAS unsigned char* lds, int kind, int b, int head, int qt) {
    constexpr int KT_H = 128 * 104, VT_H = 64 * 136, TILE_B = (KT_H + VT_H) * 2;
    const int tid = tid_opaque(), lane = tid & 63, wave = tid >> 6, ln = lane & 15, h = lane >> 4;
    const bf16* Q = (const bf16*)(p.ws + WS_Q); const bf16* KN = (const bf16*)(p.ws + WS_KV); const bf16* VT = (const bf16*)(p.ws + WS_VT); const bf16* KPE = (const bf16*)(p.ws + WS_KPEA);
    bf16* MX = (bf16*)(p.ws + WS_MIX);
    const int nkeys = kind ? 1280 : 256, rowbase = kind ? MP + b * 1024 : b * 256, ntiles = nkeys / 128;
    const int qrow = rowbase + qt * 256 + wave * 32 + ln;
    s16x8 qf[2][3];
#pragma unroll
    for (int j = 0; j < 2; ++j)
#pragma unroll
        for (int s = 0; s < 3; ++s) qf[j][s] = *(const s16x8*)(Q + (size_t)(qrow + 16 * j) * 768 + head * 96 + 32 * s + 8 * h);
    f32x4 o[2][4];
#pragma unroll
    for (int j = 0; j < 2; ++j)
#pragma unroll
        for (int i = 0; i < 4; ++i) o[j][i] = (f32x4){0.f, 0.f, 0.f, 0.f};
    float mrun[2] = {-1e30f, -1e30f}, lrun[2] = {0.f, 0.f};
    u32x4 Ak[3], Av[2], Bk[3], Bv[2];
#define ATT_LOAD(X, it) do { const int j0_ = (it) * 128; \
        const int kb_ = kind ? (j0_ < 1024 ? MP + b * 1024 + j0_ : M_TOK + b * 256 + (j0_ - 1024)) : b * 256 + j0_; \
        _Pragma("unroll") for (int i_ = 0; i_ < 3; ++i_) { const int c_ = tid + 512 * i_, key_ = c_ / 12, ch_ = c_ % 12; \
            X##k[i_] = *(const u32x4*)(ch_ < 8 ? KN + (size_t)(kb_ + key_) * 512 + head * 64 + ch_ * 8 : KPE + (size_t)(kb_ + key_) * 32 + (ch_ - 8) * 8); } \
        _Pragma("unroll") for (int i_ = 0; i_ < 2; ++i_) { const int c_ = tid + 512 * i_; \
            X##v[i_] = *(const u32x4*)(VT + (size_t)(head * 64 + (c_ >> 4)) * (M_TOK + 2048) + kb_ + (c_ & 15) * 8); } } while (0)
#define ATT_STORE(X, Kt_, Vt_) do { \
        _Pragma("unroll") for (int i_ = 0; i_ < 3; ++i_) { const int c_ = tid + 512 * i_; *(LAS u32x4*)(Kt_ + (c_ / 12) * 104 + (c_ % 12) * 8) = X##k[i_]; } \
        _Pragma("unroll") for (int i_ = 0; i_ < 2; ++i_) { const int c_ = tid + 512 * i_; *(LAS u32x4*)(Vt_ + (c_ >> 4) * 136 + (c_ & 15) * 8) = X##v[i_]; } } while (0)
    __syncthreads();
    ATT_LOAD(A, 0);
    if (ntiles > 1) ATT_LOAD(B, 1);
#pragma unroll 1
    for (int it = 0; it < ntiles; ++it) {
        LAS bf16* Kt = (LAS bf16*)(lds + (it & 1) * TILE_B);
        LAS bf16* Vt = Kt + KT_H;
        if (it & 1) ATT_STORE(B, Kt, Vt); else ATT_STORE(A, Kt, Vt);
        __syncthreads();
        if (it + 2 < ntiles) { if (it & 1) ATT_LOAD(B, it + 2); else ATT_LOAD(A, it + 2); }
        f32x4 sc[2][8]; float mx[2] = {-1e30f, -1e30f};
#pragma unroll
        for (int kt = 0; kt < 8; ++kt) {
            f32x4 a0 = {0.f, 0.f, 0.f, 0.f}, a1 = a0;
#pragma unroll
            for (int s = 0; s < 3; ++s) { const s16x8 kf = *(const LAS s16x8*)(Kt + (kt * 16 + ln) * 104 + 32 * s + 8 * h);
                a0 = __builtin_amdgcn_mfma_f32_16x16x32_bf16(kf, qf[0][s], a0, 0, 0, 0); a1 = __builtin_amdgcn_mfma_f32_16x16x32_bf16(kf, qf[1][s], a1, 0, 0, 0); }
            sc[0][kt] = a0; mx[0] = fmaxf(mx[0], fmaxf(fmaxf(a0[0], a0[1]), fmaxf(a0[2], a0[3])));
            sc[1][kt] = a1; mx[1] = fmaxf(mx[1], fmaxf(fmaxf(a1[0], a1[1]), fmaxf(a1[2], a1[3])));
        }
        s16x8 pf[2][4];
#pragma unroll
        for (int j = 0; j < 2; ++j) {
            float m = mx[j];
            m = fmaxf(m, __shfl_xor(m, 16)); m = fmaxf(m, __shfl_xor(m, 32));
            const float mnew = fmaxf(mrun[j], m), alpha = __expf(mrun[j] - mnew);
            mrun[j] = mnew;
            float ps = 0.f;
#pragma unroll
            for (int kt = 0; kt < 8; ++kt)
#pragma unroll
                for (int r = 0; r < 4; ++r) { sc[j][kt][r] = __expf(sc[j][kt][r] - mnew); ps += sc[j][kt][r]; }
            lrun[j] = lrun[j] * alpha + ps;
#pragma unroll
            for (int i = 0; i < 4; ++i) o[j][i] = o[j][i] * alpha;
#pragma unroll
            for (int s = 0; s < 4; ++s) {
                u32x4 pw; pw.x = pk2(sc[j][2 * s][0], sc[j][2 * s][1]); pw.y = pk2(sc[j][2 * s][2], sc[j][2 * s][3]); pw.z = pk2(sc[j][2 * s + 1][0], sc[j][2 * s + 1][1]); pw.w = pk2(sc[j][2 * s + 1][2], sc[j][2 * s + 1][3]);
                pf[j][s] = __builtin_bit_cast(s16x8, pw);
            }
        }
#pragma unroll
        for (int s = 0; s < 4; ++s) {
#pragma unroll
            for (int vt = 0; vt < 4; ++vt) {
                const LAS bf16* vp = Vt + (vt * 16 + ln) * 136 + 32 * s + 4 * h;
                const u32x2 lo2 = *(const LAS u32x2*)vp, hi2 = *(const LAS u32x2*)(vp + 16);
                const u32x4 vw = {lo2.x, lo2.y, hi2.x, hi2.y};
                o[0][vt] = __builtin_amdgcn_mfma_f32_16x16x32_bf16(__builtin_bit_cast(s16x8, vw), pf[0][s], o[0][vt], 0, 0, 0);
                o[1][vt] = __builtin_amdgcn_mfma_f32_16x16x32_bf16(__builtin_bit_cast(s16x8, vw), pf[1][s], o[1][vt], 0, 0, 0);
            }
        }
    }
#undef ATT_LOAD
#undef ATT_STORE
#pragma unroll
    for (int j = 0; j < 2; ++j) {
        float l = lrun[j]; l += __shfl_xor(l, 16); l += __shfl_xor(l, 32);
        const float inv = 1.0f / l;
#pragma unroll
        for (int vt = 0; vt < 4; ++vt) *(u32x2*)(MX + (size_t)(qrow + 16 * j) * 1024 + head * 64 + vt * 16 + 4 * h) = pk4(o[j][vt] * inv);
    }
}

__device__ __forceinline__ void hyena_item(const P& p, LAS unsigned char* lds, int kind, int cgp) {
    const int tid = tid_opaque(), lane = tid & 63, wave = tid >> 6, ci = wave >> 2, qtr = wave & 3;
    const int L = kind ? 1024 : 256, NB = kind ? 8 : 32, base = kind ? MP : 0, c = cgp * 2 + ci;
    const int DMAX = kind ? 31 : 7;
    constexpr int ZCH = 8704;
    LAS bf16* zb = (LAS bf16*)lds;
    LAS bf16* gb = zb + 2 * ZCH;
    LAS bf16* gb1 = gb + 4 * 2048;
    LAS bf16* gl = gb1 + 4 * 2048;
    const bf16* HT = (const bf16*)(p.ws + WS_HYIN);
    const bf16* G = (const bf16*)(p.ws + (kind ? WS_GFS : WS_GFP));
    bf16* HO = (bf16*)(p.ws + WS_H);
    __syncthreads();
    const int Lp = L + 8;
    for (int i = tid; i < 2 * 1024; i += NTHREADS) { const int cc = i >> 10, off = (i & 1023) * 8;
        *(LAS u32x4*)(zb + cc * ZCH + (off / L) * Lp + (off % L)) = *(const u32x4*)(HT + (size_t)(cgp * 2 + cc) * M_TOK + base + off); }
    for (int i = tid; i < 4 * (2 * L / 8); i += NTHREADS) { const int co = i / (2 * L / 8), off = (i % (2 * L / 8)) * 8, cc = co >> 1, od = co & 1;
        *(LAS u32x4*)(gb + (cc * 2 + od) * 2 * L + off) = *(const u32x4*)(G + ((size_t)od * 512 + cgp * 2 + cc) * (2 * L) + off);
        *(LAS u32x4*)(gb1 + (cc * 2 + od) * 2 * L + off) = *(const u32x4*)(G + ((size_t)od * 512 + cgp * 2 + cc) * (2 * L) + off + 1); }
    for (int i = tid; i < 4 * 1024; i += NTHREADS) { const int oc = i >> 10, off = (i & 1023) * 8;
        *(LAS u32x4*)(gl + oc * ZCH + (off / L) * Lp + (off % L)) = *(const u32x4*)(HT + (size_t)(((oc >> 1) + 1) * 512 + cgp * 2 + (oc & 1)) * M_TOK + base + off); }
    __syncthreads();
    const int n = lane & 31, h = lane >> 5;
    const int jl = kind ? (n & 3) : 0, bb = kind ? (n >> 2) : n;
    const LAS bf16* zc = zb + ci * ZCH + bb * Lp;
#pragma unroll 1
    for (int order = 0; order < 2; ++order) {
        const LAS bf16* gr = (n & 1) ? gb1 + (ci * 2 + order) * 2 * L - 1 : gb + (ci * 2 + order) * 2 * L;
        f32x16 acc[2];
#pragma unroll
        for (int g = 0; g < 2; ++g)
#pragma unroll
            for (int r = 0; r < 16; ++r) acc[g][r] = 0.f;
        const int Ilo_w = kind ? 8 * qtr : 2 * qtr, Ihi_w = kind ? 8 * qtr + 7 : 2 * qtr + 1;
        int Dlo = Ilo_w - (L / 32 - 1), Dhi = Ihi_w; if (Dlo < -DMAX) Dlo = -DMAX; if (Dhi > DMAX) Dhi = DMAX;
#define HY_LOAD(DD, A0, A1, B00, B01, B10, B11) do { \
            const volatile LAS unsigned* ap_ = (const volatile LAS unsigned*)(gr + (L - 32 * (DD) + 8 * h - n)); \
            A0.x = ap_[0]; A0.y = ap_[1]; A0.z = ap_[2]; A0.w = ap_[3]; A1.x = ap_[8]; A1.y = ap_[9]; A1.z = ap_[10]; A1.w = ap_[11]; \
            const int J0_ = (kind ? 8 * qtr + jl : 2 * qtr) - (DD), J1_ = (kind ? 8 * qtr + 4 + jl : 2 * qtr + 1) - (DD); \
            const bool k0_ = J0_ >= 0 && J0_ < L / 32, k1_ = J1_ >= 0 && J1_ < L / 32; \
            const LAS bf16* z0_ = zc + 32 * (k0_ ? J0_ : 0) + 8 * h; const LAS bf16* z1_ = zc + 32 * (k1_ ? J1_ : 0) + 8 * h; \
            B00 = *(const LAS u32x4*)z0_; B10 = *(const LAS u32x4*)(z0_ + 16); B01 = *(const LAS u32x4*)z1_; B11 = *(const LAS u32x4*)(z1_ + 16); \
            B00.x = k0_ ? B00.x : 0u; B00.y = k0_ ? B00.y : 0u; B00.z = k0_ ? B00.z : 0u; B00.w = k0_ ? B00.w : 0u; B10.x = k0_ ? B10.x : 0u; B10.y = k0_ ? B10.y : 0u; B10.z = k0_ ? B10.z : 0u; B10.w = k0_ ? B10.w : 0u; \
            B01.x = k1_ ? B01.x : 0u; B01.y = k1_ ? B01.y : 0u; B01.z = k1_ ? B01.z : 0u; B01.w = k1_ ? B01.w : 0u; B11.x = k1_ ? B11.x : 0u; B11.y = k1_ ? B11.y : 0u; B11.z = k1_ ? B11.z : 0u; B11.w = k1_ ? B11.w : 0u; \
        } while (0)
        u32x4 cA0, cA1, cB00, cB01, cB10, cB11;
        HY_LOAD(Dlo, cA0, cA1, cB00, cB01, cB10, cB11);
#pragma unroll 1
        for (int D = Dlo; D <= Dhi; ++D) {
            u32x4 nA0, nA1, nB00, nB01, nB10, nB11;
            HY_LOAD(D + 1, nA0, nA1, nB00, nB01, nB10, nB11);
            acc[0] = __builtin_amdgcn_mfma_f32_32x32x16_bf16(__builtin_bit_cast(s16x8, cA0), __builtin_bit_cast(s16x8, cB00), acc[0], 0, 0, 0);
            acc[1] = __builtin_amdgcn_mfma_f32_32x32x16_bf16(__builtin_bit_cast(s16x8, cA0), __builtin_bit_cast(s16x8, cB01), acc[1], 0, 0, 0);
            acc[0] = __builtin_amdgcn_mfma_f32_32x32x16_bf16(__builtin_bit_cast(s16x8, cA1), __builtin_bit_cast(s16x8, cB10), acc[0], 0, 0, 0);
            acc[1] = __builtin_amdgcn_mfma_f32_32x32x16_bf16(__builtin_bit_cast(s16x8, cA1), __builtin_bit_cast(s16x8, cB11), acc[1], 0, 0, 0);
            cA0 = nA0; cA1 = nA1; cB00 = nB00; cB01 = nB01; cB10 = nB10; cB11 = nB11;
        }
#undef HY_LOAD
        const float bias = p.in[46][order * 512 + c];
        const LAS bf16* gate = gl + (order * 2 + ci) * ZCH + bb * Lp;
        u32x2 zn[2][4];
#pragma unroll
        for (int g = 0; g < 2; ++g) {
            const int og = qtr * 2 + g, I = kind ? 4 * og + jl : og;
#pragma unroll
            for (int rq = 0; rq < 4; ++rq) {
                const int t = 32 * I + 8 * rq + 4 * h;
                const f32x4 zo = unpk4(*(const LAS u32x2*)(zc + t)), gt = unpk4(*(const LAS u32x2*)(gate + t));
                f32x4 y; y.x = acc[g][4 * rq]; y.y = acc[g][4 * rq + 1]; y.z = acc[g][4 * rq + 2]; y.w = acc[g][4 * rq + 3];
                zn[g][rq] = pk4(gt * (y + zo * bias));
            }
        }
        __syncthreads();
#pragma unroll
        for (int g = 0; g < 2; ++g) { const int og = qtr * 2 + g, I = kind ? 4 * og + jl : og;
#pragma unroll
            for (int rq = 0; rq < 4; ++rq) *(LAS u32x2*)(zb + ci * ZCH + bb * Lp + 32 * I + 8 * rq + 4 * h) = zn[g][rq]; }
        __syncthreads();
    }
    for (int i = tid; i < 2 * 1024; i += NTHREADS) { const int cc = i >> 10, off = (i & 1023) * 8;
        *(u32x4*)(HO + (size_t)(cgp * 2 + cc) * M_TOK + base + off) = *(const LAS u32x4*)(zb + cc * ZCH + (off / L) * Lp + (off % L)); }
}
#ifndef DUP_SUB
#define DUP_SUB 3
#endif
__device__ __forceinline__ void ph_attn_hyena(const P& p, LAS unsigned char* lds, bool dummy) {
    const int B = blockIdx.x, G = gridDim.x;
#ifndef T_NO_ATTN
    if (!dummy || (DUP_SUB & 1))
    for (int i = B; i < 512; i += G) { if (i < 256) attn_item(p, lds, 1, i >> 5, (i >> 2) & 7, i & 3); else { const int j = i - 256; attn_item(p, lds, 0, j >> 3, j & 7, 0); } }
#endif
#ifndef T_NO_HY
    if (!dummy || (DUP_SUB & 2))
    for (int i = B; i < 512; i += G) { hyena_item(p, lds, i < 256 ? 1 : 0, i & 255); }
#endif
}

__device__ __forceinline__ void ph_hy_transpose(const P& p, LAS unsigned char* lds) {
    const int tid = tid_opaque(), lane = tid & 63, wave = tid >> 6;
    LAS bf16* tile = (LAS bf16*)(lds + wave * 9216);
    const bf16* HO = (const bf16*)(p.ws + WS_H); bf16* MX = (bf16*)(p.ws + WS_MIX);
    for (int it = blockIdx.x * 8 + wave; it < 2048; it += gridDim.x * 8) {
        const int rt = it >> 3, cb = it & 7, r0 = rt * 64, c0 = cb * 64;
#pragma unroll
        for (int i = 0; i < 8; ++i) { const int id = i * 64 + lane, c = id >> 3, rc = id & 7;
            *(LAS u32x4*)(tile + c * 72 + rc * 8) = *(const u32x4*)(HO + (size_t)(c0 + c) * M_TOK + r0 + rc * 8); }
        LDS_WAIT();
        bf16* dst = MX + (size_t)(r0 + lane) * 1024 + 512 + c0;
#pragma unroll
        for (int j = 0; j < 8; ++j) {
            u32x4 w;
#pragma unroll
            for (int i = 0; i < 4; ++i) { const unsigned a = tile[(j * 8 + 2 * i) * 72 + lane], bq = tile[(j * 8 + 2 * i + 1) * 72 + lane]; w[i] = a | (bq << 16); }
            *(u32x4*)(dst + j * 8) = w;
        }
        LDS_WAIT();
    }
}

#define XB_TMO      128
#define XB_XCNT(j)  (256  + 64 * (j))
#define XB_XSUB(j)  (1280 + 64 * (j))
#define XB_XGEN(j)  (2304 + 64 * (j))
#define XB_TOP      3328
#define XB_TOPGEN   3392
#define XCD_BAR_WORDS 3456
#define XB_SPIN_CAP (1u << 18)

__device__ __forceinline__ unsigned xb_ld(unsigned* p)              { return __hip_atomic_load(p, __ATOMIC_RELAXED, __HIP_MEMORY_SCOPE_AGENT); }
__device__ __forceinline__ unsigned xb_add(unsigned* p, unsigned v) { return __hip_atomic_fetch_add(p, v, __ATOMIC_RELAXED, __HIP_MEMORY_SCOPE_AGENT); }
__device__ __forceinline__ unsigned xb_xcc_id() { return (unsigned)__builtin_amdgcn_s_getreg((3 << 11) | 20) & 0xFu; }
#define XB_SPIN(cond, bar) do { unsigned _sp = 0; while (cond) { __builtin_amdgcn_s_sleep(1); \
    if ((++_sp & 255u) == 0u) { if (xb_ld(&(bar)[XB_TMO])) break; if (_sp > XB_SPIN_CAP) { atomicAdd(&(bar)[XB_TMO], 1u); break; } } } } while (0)

struct XcdBarrier {
    unsigned* bar; unsigned x;
    volatile LAS unsigned* st;
};

__device__ __forceinline__ XcdBarrier xcd_barrier_post(unsigned* bar, volatile LAS unsigned* st) {
    XcdBarrier b; b.bar = bar; b.x = xb_xcc_id(); b.st = st;
    if (threadIdx.x == 0) (void)xb_add(&bar[XB_XCNT(b.x)], 1u);
    return b;
}
__device__ __forceinline__ void xcd_barrier_complete(unsigned* bar, unsigned x, unsigned& nloc, unsigned& nx) {
    const unsigned G = gridDim.x * gridDim.y * gridDim.z;
    unsigned sum, cnt, mine, sp = 0u;
    for (;;) {
        sum = 0u; cnt = 0u; mine = 0u;
#pragma unroll
        for (unsigned j = 0; j < 16; ++j) { const unsigned c = xb_ld(&bar[XB_XCNT(j)]); sum += c; cnt += (c > 0u) ? 1u : 0u; mine = (j == x) ? c : mine; }
        if (sum == G) break;
        __builtin_amdgcn_s_sleep(1);
        if ((++sp & 255u) == 0u) { if (xb_ld(&bar[XB_TMO])) break; if (sp > XB_SPIN_CAP) { atomicAdd(&bar[XB_TMO], 1u); break; } }
    }
    nloc = mine > 0u ? mine : 1u; nx = cnt > 0u ? cnt : 1u;
}

__device__ __forceinline__ void xcd_barrier(const XcdBarrier& b) {
    asm volatile("s_waitcnt vmcnt(0)" ::: "memory");
    __syncthreads();
    if (threadIdx.x == 0) {
        unsigned* bar = b.bar;
        __builtin_amdgcn_s_waitcnt(0);
        unsigned nloc = b.st[0], nx = b.st[1];
        if (nloc == 0u) { xcd_barrier_complete(bar, b.x, nloc, nx); b.st[0] = nloc; b.st[1] = nx; }
        const unsigned old = xb_add(&bar[XB_XSUB(b.x)], 1u);
        const unsigned gen = old / nloc;
        if (old + 1u == (gen + 1u) * nloc) {
            __builtin_amdgcn_fence(__ATOMIC_RELEASE, "agent");
            asm volatile("s_waitcnt vmcnt(0)" ::: "memory");
            const unsigned og = xb_add(&bar[XB_TOP], 1u);
            const unsigned tg = og / nx;
            if (og + 1u == (tg + 1u) * nx) xb_add(&bar[XB_TOPGEN], 1u);
            else XB_SPIN(xb_ld(&bar[XB_TOPGEN]) == tg, bar);
            __builtin_amdgcn_fence(__ATOMIC_ACQUIRE, "agent");
            xb_add(&bar[XB_XGEN(b.x)], 1u);
            asm volatile("s_waitcnt vmcnt(0)" ::: "memory");
        } else {
            XB_SPIN(xb_ld(&bar[XB_XGEN(b.x)]) == gen, bar);
            __builtin_amdgcn_fence(__ATOMIC_ACQUIRE, "agent");
            asm volatile("s_waitcnt vmcnt(0)" ::: "memory");
        }
    }
    __syncthreads();
}


template <class Epi>
__device__ __forceinline__ void run_gemm(LAS unsigned char* lds, const bf16* A, const bf16* Bt, int M, int N, int K, const Epi& E, int rot = 0) {
    asm volatile("" : "+s"(K));
    pg8::Gemm g{A, Bt, M, N, K}; pg8::StaticOrder S; S.init(M, N, (int)gridDim.x, (int)((blockIdx.x + gridDim.x - rot) % gridDim.x));
    pg8::gemm_phase<Epi, pg8::StaticOrder, true, true>(lds, g, S, E);
}

#ifndef DUP_PH
#define DUP_PH (-1)
#endif
__device__ __forceinline__ void run_phase(const P& p, LAS unsigned char* lds, int k, bool dummy) {
    if (k == 0) {
        { float* cvz0 = (float*)(p.ws + WS_CV); for (int i = blockIdx.x * NTHREADS + tid_opaque(); i < 2 * CV_STRIDE; i += gridDim.x * NTHREADS) cvz0[i] = 0.f; }
        adaln_layer(p, lds, 0, 0); adaln_layer(p, lds, 1, (int)gridDim.x / 2); ph_rope_table(p); return; }
    if (k == 27) { final_norm_rows(p); return; }
    const int layer = (k - 1) / 13, sub = (k - 1) % 13;
    float* x = p.out;
    const float* mod = (const float*)(p.ws + WS_MOD);
    bf16* H = (bf16*)(p.ws + WS_H); bf16* R1 = (bf16*)(p.ws + WS_R1);
    float* ssb = (float*)(p.ws + WS_SS); float* cvb = (float*)(p.ws + WS_CV); float* ssp = (float*)(p.ws + WS_R2);
    switch (sub) {
    case 0: case 3: case 10: {
        const int jn = sub == 0 ? 0 : (sub == 3 ? 1 : 2), uu = 3 * layer + jn;
        float* cvo = cvb + (size_t)(uu & 1) * CV_STRIDE; float* cvz = cvb + (size_t)((uu + 1) & 1) * CV_STRIDE;
        const float* shift = mod + (size_t)layer * 9 * 9216 + (3 * jn) * 1024;
        for (int i = blockIdx.x * NTHREADS + tid_opaque(); i < CV_STRIDE; i += gridDim.x * NTHREADS) cvz[i] = 0.f;
        if (uu == 0) first_rows(p, p.in[10], ssb);
        else { const int t = tid_opaque();
            if (t < 64) for (int row = blockIdx.x * 64 + t; row < M_TOK; row += gridDim.x * 64) { float a = 0.f;
#pragma unroll
                for (int q = 0; q < 16; ++q) a += ssp[q * M_TOK + row];
                ssb[row] = rsqrtf_(a * (1.0f / 1024.0f) + 1e-6f); } }
        if (sub != 3) convert_ffn_weights(p, layer, sub == 0 ? 0 : 1, lds, shift, cvo);
        else {
            transpose_w<0>(p.in[17] + (size_t)layer * 1024 * 1024, 1024, 1024, 1024, (bf16*)(p.ws + W_OUT), 1024, lds, nullptr, nullptr, 0, layer == 0 ? 128 : 232);
            if (layer == 0) { transpose_w<0>(p.in[18], 3984, 3984, 1024, (bf16*)(p.ws + W_IN), 4096, lds, shift, cvo, 4096); build_lora_w(p); }
            else { transpose_w<0>(p.in[34], 2208, 2208, 1024, (bf16*)(p.ws + W_IN), 2304, lds, shift, cvo, 2304, 160);
                transpose_w<0>(p.in[36], 768, 768, 384, (bf16*)(p.ws + W_UQ), 768, lds, nullptr, nullptr, 0, 8);
                transpose_w<0>(p.in[38], 1024, 1024, 256, (bf16*)(p.ws + W_UKV), 1024, lds, nullptr, nullptr, 0, 17);
                ph_hyena_filters(p, lds); }
        }
    } break;
    case 1: case 11: { const int uu = 3 * layer + (sub == 1 ? 0 : 2);
        run_gemm(lds, H, (const bf16*)(p.ws + W_GU), M_TOK, 5632, 1024, EpiSwigluN{R1, ssb, cvb + (size_t)(uu & 1) * CV_STRIDE}); } break;
    case 2: case 12: {
        const bool first = layer == 0 && sub == 2;
        const float* xp = first ? p.in[0] : x; const float* xs = first ? p.in[1] : x + (size_t)MP * DM;
        const float* gate = mod + (size_t)layer * 9 * 9216 + (sub == 2 ? 2 : 8) * 1024;
        if (layer == 1 && sub == 12) { const EpiResid E{xp, xs, x, gate, 0.5f}; run_gemm(lds, R1, (const bf16*)(p.ws + W_DOWN), M_TOK, 1024, 2816, E); }
        else {
            const int ln = sub == 12 ? layer + 1 : layer, jn = sub == 2 ? 1 : 0, uu = 3 * ln + jn;
            const EpiResidN E{xp, xs, x, gate, p.in[jn == 0 ? 10 : 11] + ln * 1024, mod + (size_t)ln * 9 * 9216 + (3 * jn + 1) * 1024, H, ssp, 0.5f};
            run_gemm(lds, R1, (const bf16*)(p.ws + W_DOWN), M_TOK, 1024, 2816, E);
        }
    } break;
    case 9: {
        const int uu = 3 * layer + 2;
        const EpiResidN E{x, x + (size_t)MP * DM, x, mod + (size_t)layer * 9 * 9216 + 5 * 1024, p.in[12] + layer * 1024, mod + (size_t)layer * 9 * 9216 + 7 * 1024, H, ssp, 1.0f};
        run_gemm(lds, (const bf16*)(p.ws + WS_MIX), (const bf16*)(p.ws + W_OUT), M_TOK, 1024, 1024, E);
    } break;
    case 4: {
        const int N = layer == 0 ? 4096 : 2304, ld = layer == 0 ? LDP0 : LDP1, uu = 3 * layer + 1;
        run_gemm(lds, H, (const bf16*)(p.ws + W_IN), M_TOK, N, 1024, EpiStoreN{R1, ld, ld, ssb, cvb + (size_t)(uu & 1) * CV_STRIDE, N});
    } break;
    case 5: if (layer == 0) ph_lora_in(p); else ph_mla_prep(p, lds); break;
    case 6:
        if (layer == 0) run_gemm(lds, H, (const bf16*)(p.ws + W_LORA), M_TOK, 2560, 384, EpiLora{(bf16*)(p.ws + WS_R2), p.in[20], p.in[22]});
        else { run_gemm(lds, (const bf16*)(p.ws + WS_CKVA), (const bf16*)(p.ws + W_UKV), M_TOK + 2048, 1024, 256, EpiKV{(bf16*)(p.ws + WS_KV), (bf16*)(p.ws + WS_VT), M_TOK + 2048});
            run_gemm(lds, H, (const bf16*)(p.ws + W_UQ), M_TOK, 768, 384, EpiQ{(bf16*)(p.ws + WS_Q), (const float*)(p.ws + WS_ROPE)}, 32); }
        break;
    case 7: if (layer == 0) ph_scan(p, lds); else ph_attn_hyena(p, lds, dummy); break;
    case 8: if (layer == 0) ph_post_ab(p, dummy); else ph_hy_transpose(p, lds); break;
    default: break;
    }
}

__global__ void __launch_bounds__(NTHREADS, 2) hybrid_fwd(P p) {
    extern __shared__ __attribute__((aligned(16))) unsigned char lds_raw[];
    LAS unsigned char* lds = (LAS unsigned char*)lds_raw;
    cg::grid_group grid = cg::this_grid();
    volatile LAS unsigned* bst = (volatile LAS unsigned*)(lds + LDS_BYTES - 64);
    if (threadIdx.x < 16) bst[threadIdx.x] = 0u;
    __syncthreads();
    XcdBarrier bar = xcd_barrier_post((unsigned*)(p.ws + WS_CTL) + 1024, bst);
#pragma unroll 1
    for (int k = p.ph_lo; k < p.ph_hi; ++k) {
        const int nrep = (DUP_PH >= 0 && k == DUP_PH) ? 2 : 1;
#pragma unroll 1
        for (int rep = 0; rep < nrep; ++rep) { run_phase(p, lds, k, rep + 1 < nrep); if (rep + 1 < nrep) __syncthreads(); }
        if (k + 1 < p.ph_hi) { if (p.ph_hi < 0) grid.sync(); else { xcd_barrier(bar);
        } }
    }
}

extern "C" void kernel_launch(void* const* d_in, const int* in_sizes, int n_in, void* d_out, int out_size, void* d_ws, size_t ws_size, hipStream_t stream) {
    static int grid = 0;
    if (grid == 0) {
        if (n_in != 48 || out_size != 25427968 || ws_size < WS_END) {
            fprintf(stderr, "kernel_launch: expected 48 inputs, 25427968 outputs, >= %zu B workspace; got %d, %d, %zu\n", (size_t)WS_END, n_in, out_size, ws_size);
            grid = -1; return;
        }
        int dev = 0, cus = 0, per_cu = 0;
        hipGetDevice(&dev);
        hipDeviceGetAttribute(&cus, hipDeviceAttributeMultiprocessorCount, dev);
        hipFuncSetAttribute((const void*)hybrid_fwd, hipFuncAttributeMaxDynamicSharedMemorySize, LDS_BYTES);
        hipOccupancyMaxActiveBlocksPerMultiprocessor(&per_cu, (const void*)hybrid_fwd, NTHREADS, LDS_BYTES);
        if (per_cu < 1) { fprintf(stderr, "kernel_launch: occupancy query says %d blocks/CU\n", per_cu); per_cu = 1; }
        (void)hipGetLastError();
        grid = cus;
    }
    if (grid < 0) return;
    (void)hipMemsetAsync((char*)d_ws + WS_CTL, 0, 24 * 1024, stream);
    P prm{};
    for (int i = 0; i < 48; ++i) prm.in[i] = (const float*)d_in[i];
    prm.out = (float*)d_out; prm.ws = (unsigned char*)d_ws;
#ifndef N_SPLIT
    prm.ph_lo = 0; prm.ph_hi = 28;
    void* args[] = {&prm};
    hipError_t e = hipLaunchCooperativeKernel((const void*)hybrid_fwd, dim3(grid), dim3(NTHREADS), args, LDS_BYTES, stream);
    if (e != hipSuccess) fprintf(stderr, "cooperative launch failed: %s (grid %d)\n", hipGetErrorString(e), grid);
#else
    for (int k = 0; k < 28; ++k) {
        prm.ph_lo = k; prm.ph_hi = k + 1;
        void* args[] = {&prm};
        hipError_t e = hipLaunchCooperativeKernel((const void*)hybrid_fwd, dim3(grid), dim3(NTHREADS), args, LDS_BYTES, stream);
        if (e != hipSuccess) { fprintf(stderr, "launch %d failed: %s\n", k, hipGetErrorString(e)); break; }
    }
#endif
}
```

```cpp
#include <hip/hip_runtime.h>
#include <hip/hip_cooperative_groups.h>
#include <cstdio>
#include <cstdint>
namespace cg = cooperative_groups;

#define LAS __attribute__((address_space(3)))
typedef unsigned short bf16;
typedef float f32x2 __attribute__((ext_vector_type(2)));
typedef float f32x4 __attribute__((ext_vector_type(4)));
typedef float f32x16 __attribute__((ext_vector_type(16)));
typedef unsigned u32x2 __attribute__((ext_vector_type(2)));
typedef unsigned u32x4 __attribute__((ext_vector_type(4)));
typedef short s16x8 __attribute__((ext_vector_type(8)));

constexpr int M_TOK = 16384, MP = 8192, DM = 1024, DFF = 2816;
constexpr int LDP0 = 3984, LDP1 = 2304;
constexpr int OUT_YS = 8388608, OUT_SRW = 16777216, OUT_SGD = 18874368, OUT_CKV = 23068672, OUT_KPE = 25165824;

constexpr size_t MiB = 1ull << 20;
constexpr size_t WS_CTL = 0;
constexpr size_t WS_SS = 64 * 1024;
constexpr size_t WS_ROPE = 512 * 1024;
constexpr size_t WS_CV = 2 * 1048576 + 16 * 1048576 + 524288;
constexpr int CV_STRIDE = 9 * 5632;
constexpr size_t WS_MOD = 1 * MiB;
constexpr size_t WS_W = 2 * MiB;
constexpr size_t W_GU = WS_W, W_DOWN = WS_W + 11 * MiB;
constexpr size_t W_IN = WS_W, W_OUT = WS_W + 8 * MiB, W_LORA = WS_W + 10 * MiB, W_UQ = WS_W + 12 * MiB, W_UKV = WS_W + 13 * MiB;
constexpr size_t WS_H = 19 * MiB;
constexpr size_t WS_MIX = 51 * MiB;
constexpr size_t WS_R1 = 83 * MiB;
constexpr size_t R1_BYTES = 130547712;
constexpr size_t WS_HYIN = WS_R1 + 72 * MiB;
constexpr size_t WS_R2 = WS_R1 + R1_BYTES;
constexpr size_t WS_Q = WS_R2, WS_KV = WS_R2 + 24 * MiB, WS_VT = WS_R2 + 42 * MiB, WS_CKVA = WS_R2 + 60 * MiB, WS_KPEA = WS_R2 + 69 * MiB, WS_GFS = WS_R2 + 71 * MiB, WS_GFP = WS_R2 + 75 * MiB;
constexpr size_t WS_XB = WS_R2 + 80 * MiB;
constexpr size_t WS_BON = WS_XB + 32 * MiB;
constexpr size_t WS_END = WS_BON + 1 * MiB;

constexpr int LDS_BYTES = 159744;
constexpr int NTHREADS = 512;

struct P {
    const float* in[48];
    float* out;
    unsigned char* ws;
    int ph_lo, ph_hi;
};

__device__ __forceinline__ float bf2f(unsigned b) { return __uint_as_float(b << 16); }
__device__ __forceinline__ float bflo(unsigned w) { return __uint_as_float(w << 16); }
__device__ __forceinline__ float bfhi(unsigned w) { return __uint_as_float(w & 0xffff0000u); }
typedef __bf16 bf16x2_t __attribute__((ext_vector_type(2)));
__device__ __forceinline__ unsigned pk2(float lo, float hi) { const f32x2 v = {lo, hi}; return __builtin_bit_cast(unsigned, __builtin_convertvector(v, bf16x2_t)); }
__device__ __forceinline__ f32x4 unpk4(u32x2 w) { return (f32x4){bflo(w.x), bfhi(w.x), bflo(w.y), bfhi(w.y)}; }
__device__ __forceinline__ u32x2 pk4(f32x4 v) { return (u32x2){pk2(v.x, v.y), pk2(v.z, v.w)}; }
#define SHFLX(x, o, lane_) __int_as_float(__builtin_amdgcn_ds_bpermute((((lane_) ^ (o)) << 2), __float_as_int(x)))
__device__ __forceinline__ float dpp_f(float x, int) { return x; }
#define DPPF(x, ctrl) __int_as_float(__builtin_amdgcn_update_dpp(0, __float_as_int(x), (ctrl), 0xF, 0xF, true))
__device__ __forceinline__ float red4(float x) { x += DPPF(x, 0xB1); x += DPPF(x, 0x4E); return x; }
__device__ __forceinline__ float red8(float x) { x = red4(x); x += DPPF(x, 0x141); return x; }
__device__ __forceinline__ float red16(float x) { x = red8(x); x += DPPF(x, 0x140); return x; }
__device__ __forceinline__ float sigmoidf_(float x) { return __builtin_amdgcn_rcpf(1.0f + __expf(-x)); }
__device__ __forceinline__ float siluf_(float x) { return x * __builtin_amdgcn_rcpf(1.0f + __expf(-x)); }
__device__ __forceinline__ float rsqrtf_(float x) { return __builtin_amdgcn_rsqf(x); }
__device__ __forceinline__ int cond_of_row(int row) { return row < MP ? 0 : 1 + ((row - MP) >> 10); }
__device__ __forceinline__ int tid_opaque() { int t = threadIdx.x; asm volatile("" : "+v"(t)); return t; }
#define LDS_WAIT() asm volatile("s_waitcnt lgkmcnt(0)" ::: "memory")

namespace pg8 {
#define PG8_LAS __attribute__((address_space(3)))
typedef unsigned short bf16_t;
typedef short bf16x8 __attribute__((ext_vector_type(8)));
typedef float f32x4 __attribute__((ext_vector_type(4)));
typedef unsigned u32x4 __attribute__((ext_vector_type(4)));
constexpr int BM = 256, BK = 64, HALF = 128, HTB = HALF * BK * 2  , STAGE_BYTES = 8 * HTB, NXCD = 8, WGM = 4;

__host__ __device__ __forceinline__ int lds_byte(int r, int c) { const int st = (r >> 4) * 2 + (c >> 5), rr = r & 15, cc = c & 31, ob = rr * 64 + cc * 2; return st * 1024 + (ob ^ (((ob >> 9) & 1) << 5)); }
__host__ __device__ __forceinline__ void stage_rc(int b, int& R, int& C) { const int st = b / 1024, sb = b % 1024, swz = sb ^ (((sb >> 9) & 1) << 5); R = (st >> 1) * 16 + swz / 64; C = (st & 1) * 32 + (swz % 64) / 2; }
__host__ __device__ __forceinline__ int perm32(int rho) { const int n = rho >> 4, i = rho & 15; return 8 * (i >> 2) + 4 * n + (i & 3); }

struct Unit { int pm, pn; };
struct Gemm { const bf16_t* A; const bf16_t* Bt; int M, N, K; int kseg; };

struct StaticOrder {
    int nM, nN, nwg, G, c;
    __host__ __device__ void init(int M, int N, int G_, int c_) { nM = M / BM; nN = N / BM; nwg = nM * nN; G = G_; c = c_; }
    __host__ __device__ bool next(int i, Unit& u) const {
        const long L = (long)i * G + c; if (L >= nwg) return false;
        int wgid = (int)L; { const int q = nwg / NXCD, r = nwg % NXCD, xcd = wgid % NXCD, off = wgid / NXCD; wgid = (xcd < r ? xcd * (q + 1) : r * (q + 1) + (xcd - r) * q) + off; }
        const int nig = WGM * nN, gid = wgid / nig, fm = gid * WGM, gsz = (nM - fm) < WGM ? (nM - fm) : WGM;
        u.pm = fm + ((wgid % nig) % gsz); u.pn = (wgid % nig) / gsz; return true;
    }
    __device__ __forceinline__ void a_ready(const Unit&) const {}
    __device__ __forceinline__ void done(const Unit&) const {}
};
__device__ __forceinline__ unsigned cvt_pk_bf16(float lo, float hi) { unsigned r; asm volatile("v_cvt_pk_bf16_f32 %0, %1, %2" : "=v"(r) : "v"(lo), "v"(hi)); return r; }
typedef float f32x2 __attribute__((ext_vector_type(2)));
template <class Epi, class Sched, bool ALIGN_EPI = false, bool SP2 = false>
__device__ __forceinline__ void gemm_phase(PG8_LAS unsigned char* lds, const Gemm g, const Sched& S, const Epi& E) {
    const int tid = tid_opaque(), wid = __builtin_amdgcn_readfirstlane(tid >> 6), lane = tid & 63, wr = wid >> 2, wc = wid & 3, fr = lane & 15, fq = lane >> 4;
    const int K = g.K; int nt = Epi::KSEG ? 2 : K / BK; asm volatile("" : "+s"(nt));
    unsigned voffA[2], voffB[2];
#pragma unroll
    for (int i = 0; i < 2; ++i) { int R, C; stage_rc(tid * 16 + i * 8192, R, C); const int Rb = Epi::PERM ? ((R & ~31) + perm32(R & 31)) : R;
        voffA[i] = (unsigned)(R * K + C) * 2u; voffB[i] = (unsigned)(Rb * K + C) * 2u; }
    const size_t kstep = (size_t)(BK * 2);
    const size_t hstep = (size_t)HALF * K * 2;
    const size_t tstep = 2 * hstep;
    const unsigned ldsw = (unsigned)wid * 1024u;
    const int aoff = lds_byte(wr * 64 + fr, fq * 8), boff = lds_byte(wc * 32 + fr, fq * 8);
#define PG8_SA(b, h) (((b) * 2 + (h)) * HTB)
#define PG8_SB(b, h) ((4 + (b) * 2 + (h)) * HTB)
#define PG8_STAGE(bufoff, gbase, voff) do { _Pragma("unroll") for (int _i = 0; _i < 2; ++_i) \
        __builtin_amdgcn_global_load_lds((const unsigned*)((const char*)(gbase) + (voff)[_i]), (PG8_LAS unsigned*)(lds + (bufoff) + ldsw + _i * 8192), 16, 0, 0); } while (0)
#define PG8_LDA(dst, b, h) do { _Pragma("unroll") for (int m = 0; m < 4; ++m) _Pragma("unroll") for (int k = 0; k < 2; ++k) dst[m][k] = *(const PG8_LAS bf16x8*)(lds + PG8_SA(b, h) + aoff + m * 2048 + k * 1024); } while (0)
#define PG8_LDB(dst, b, h) do { _Pragma("unroll") for (int n = 0; n < 2; ++n) _Pragma("unroll") for (int k = 0; k < 2; ++k) dst[n][k] = *(const PG8_LAS bf16x8*)(lds + PG8_SB(b, h) + boff + n * 2048 + k * 1024); } while (0)
#define PG8_MMA(ai, bj, At, Bt) do { __builtin_amdgcn_s_setprio(1); _Pragma("unroll") for (int m = 0; m < 4; ++m) _Pragma("unroll") for (int n = 0; n < 2; ++n) _Pragma("unroll") for (int k = 0; k < 2; ++k) \
        acc[ai][bj][m][n] = __builtin_amdgcn_mfma_f32_16x16x32_bf16(Bt[n][k], At[m][k], acc[ai][bj][m][n], 0, 0, 0); __builtin_amdgcn_s_setprio(0); } while (0)
#define PG8_WAIT_V(n) asm volatile("s_waitcnt vmcnt(" #n ")" ::: "memory")
#define PG8_WAIT_L(n) asm volatile("s_waitcnt lgkmcnt(" #n ")" ::: "memory")
#define PG8_BAR __builtin_amdgcn_s_barrier()
#define PG8_SCHED __builtin_amdgcn_sched_barrier(0)
    Unit cur, nxt; int ui = 0;
    if (!S.next(0, cur)) return;
    f32x4 acc[2][2][4][2];
#pragma unroll
    for (int a = 0; a < 2; ++a)
#pragma unroll
        for (int b = 0; b < 2; ++b)
#pragma unroll
            for (int m = 0; m < 4; ++m)
#pragma unroll
                for (int n = 0; n < 2; ++n) acc[a][b][m][n] = (f32x4){0.f, 0.f, 0.f, 0.f};
    bf16x8 At[4][2], B0[2][2], B1[2][2];
    const size_t ko0 = Epi::KSEG ? (size_t)(2 * ((cur.pn >> 2) < 2 ? (cur.pn >> 2) : 2)) * (size_t)(BK * 2) : (size_t)0;
    const char* cA = (const char*)g.A + (size_t)cur.pm * tstep + ko0; const char* cB = (const char*)g.Bt + (size_t)cur.pn * tstep + ko0;
    S.a_ready(cur);
    if constexpr (SP2) {
        PG8_STAGE(PG8_SB(0, 0), cB, voffB); PG8_STAGE(PG8_SB(0, 1), cB + hstep, voffB); PG8_STAGE(PG8_SA(0, 0), cA, voffA); PG8_STAGE(PG8_SA(0, 1), cA + hstep, voffA);
        if (wr == 1) PG8_BAR;
        PG8_WAIT_V(2); PG8_BAR;
        PG8_STAGE(PG8_SB(1, 0), cB + kstep, voffB); PG8_STAGE(PG8_SA(1, 0), cA + kstep, voffA); PG8_STAGE(PG8_SB(1, 1), cB + hstep + kstep, voffB);
        PG8_WAIT_V(6); PG8_BAR;
    } else {
        PG8_STAGE(PG8_SB(0, 0), cB, voffB); PG8_STAGE(PG8_SA(0, 0), cA, voffA); PG8_STAGE(PG8_SB(0, 1), cB + hstep, voffB); PG8_STAGE(PG8_SA(0, 1), cA + hstep, voffA);
        if (wr == 1) PG8_BAR;
        PG8_WAIT_V(4); PG8_BAR;
        PG8_STAGE(PG8_SB(1, 0), cB + kstep, voffB); PG8_STAGE(PG8_SA(1, 0), cA + kstep, voffA); PG8_STAGE(PG8_SB(1, 1), cB + hstep + kstep, voffB);
        PG8_WAIT_V(6); PG8_BAR;
    }
    for (;;) {
        const bool has_next = S.next(ui + 1, nxt);
        const size_t kon = Epi::KSEG ? (size_t)(2 * ((nxt.pn >> 2) < 2 ? (nxt.pn >> 2) : 2)) * (size_t)(BK * 2) : (size_t)0;
        const char* nA = has_next ? (const char*)g.A + (size_t)nxt.pm * tstep + kon : cA; const char* nB = has_next ? (const char*)g.Bt + (size_t)nxt.pn * tstep + kon : cB;
#pragma unroll 1
        for (int t = 0; t < nt; t += 2) {
            const bool last = (t == nt - 2);
            const char* a1 = cA + (size_t)(t + 1) * kstep;
            const char* a2 = last ? nA : cA + (size_t)(t + 2) * kstep; const char* b2 = last ? nB : cB + (size_t)(t + 2) * kstep;
            const char* a3 = a2 + kstep; const char* b3 = b2 + kstep;
            if (last && has_next) S.a_ready(nxt);
            if constexpr (SP2) {
            PG8_LDB(B0, 0, 0); PG8_LDB(B1, 0, 1); PG8_SCHED; PG8_LDA(At, 0, 0); PG8_STAGE(PG8_SA(1, 1), a1 + hstep, voffA);
            PG8_WAIT_V(8); PG8_WAIT_L(0); PG8_BAR; PG8_MMA(0, 0, At, B0); PG8_MMA(0, 1, At, B1); PG8_BAR; PG8_SCHED;
            PG8_LDA(At, 0, 1); PG8_STAGE(PG8_SB(0, 0), b2, voffB); PG8_STAGE(PG8_SB(0, 1), b2 + hstep, voffB); PG8_STAGE(PG8_SA(0, 0), a2, voffA);
            PG8_WAIT_V(8); PG8_WAIT_L(0); PG8_BAR; PG8_MMA(1, 0, At, B0); PG8_MMA(1, 1, At, B1); PG8_BAR; PG8_SCHED;
            PG8_LDB(B0, 1, 0); PG8_LDB(B1, 1, 1); PG8_SCHED; PG8_LDA(At, 1, 0); PG8_STAGE(PG8_SA(0, 1), a2 + hstep, voffA);
            PG8_WAIT_V(8); PG8_WAIT_L(0); PG8_BAR; PG8_MMA(0, 0, At, B0); PG8_MMA(0, 1, At, B1); PG8_BAR; PG8_SCHED;
            PG8_LDA(At, 1, 1); PG8_STAGE(PG8_SB(1, 0), b3, voffB); PG8_STAGE(PG8_SB(1, 1), b3 + hstep, voffB); PG8_STAGE(PG8_SA(1, 0), a3, voffA);
            PG8_WAIT_V(8); PG8_WAIT_L(0); PG8_BAR; PG8_MMA(1, 0, At, B0); PG8_MMA(1, 1, At, B1); PG8_BAR; PG8_SCHED;
            } else {
            PG8_LDB(B0, 0, 0); PG8_SCHED; PG8_LDA(At, 0, 0); PG8_STAGE(PG8_SA(1, 1), a1 + hstep, voffA);
            PG8_WAIT_L(8); PG8_BAR; PG8_WAIT_L(0); PG8_MMA(0, 0, At, B0); PG8_BAR; PG8_SCHED;
            PG8_LDB(B1, 0, 1); PG8_STAGE(PG8_SB(0, 0), b2, voffB);
            PG8_BAR; PG8_WAIT_L(0); PG8_MMA(0, 1, At, B1); PG8_BAR;
            PG8_LDA(At, 0, 1); PG8_STAGE(PG8_SA(0, 0), a2, voffA);
            PG8_BAR; PG8_WAIT_L(0); PG8_MMA(1, 0, At, B0); PG8_BAR; PG8_SCHED;
            PG8_STAGE(PG8_SB(0, 1), b2 + hstep, voffB);
            PG8_WAIT_V(6); PG8_BAR; PG8_MMA(1, 1, At, B1); PG8_BAR;
            PG8_LDB(B0, 1, 0); PG8_SCHED; PG8_LDA(At, 1, 0); PG8_STAGE(PG8_SA(0, 1), a2 + hstep, voffA);
            PG8_WAIT_L(8); PG8_BAR; PG8_WAIT_L(0); PG8_MMA(0, 0, At, B0); PG8_BAR; PG8_SCHED;
            PG8_LDB(B1, 1, 1); PG8_STAGE(PG8_SB(1, 0), b3, voffB);
            PG8_BAR; PG8_WAIT_L(0); PG8_MMA(0, 1, At, B1); PG8_BAR;
            PG8_LDA(At, 1, 1); PG8_STAGE(PG8_SA(1, 0), a3, voffA);
            PG8_BAR; PG8_WAIT_L(0); PG8_MMA(1, 0, At, B0); PG8_BAR; PG8_SCHED;
            PG8_STAGE(PG8_SB(1, 1), b3 + hstep, voffB);
            PG8_WAIT_V(6); PG8_BAR; PG8_MMA(1, 1, At, B1); PG8_BAR;
            }
        }
        if constexpr (ALIGN_EPI) { if (wr == 0) PG8_BAR; }
        if constexpr (!Epi::AFTER_DRAIN) { E(acc, cur, wr, wc, fr, fq); S.done(cur); }
        if (!has_next) break;
#pragma unroll
        for (int a = 0; a < 2; ++a)
#pragma unroll
            for (int b = 0; b < 2; ++b)
#pragma unroll
                for (int m = 0; m < 4; ++m)
#pragma unroll
                    for (int n = 0; n < 2; ++n) acc[a][b][m][n] = (f32x4){0.f, 0.f, 0.f, 0.f};
        cur = nxt; cA = nA; cB = nB; ++ui;
        if constexpr (ALIGN_EPI) { if (wr == 1) PG8_BAR; }
    }
    PG8_WAIT_V(0);
    if constexpr (!ALIGN_EPI) { if (wr == 0) PG8_BAR; }
    PG8_BAR;
    if constexpr (Epi::AFTER_DRAIN) { E.fused(acc, cur, wr, wc, fr, fq, lds, wid, lane); S.done(cur); }
#undef PG8_SA
#undef PG8_SB
#undef PG8_STAGE
#undef PG8_LDA
#undef PG8_LDB
#undef PG8_MMA
#undef PG8_WAIT_V
#undef PG8_WAIT_L
#undef PG8_BAR
#undef PG8_SCHED
}
}

using pg8::Unit;
typedef const f32x4 (&AccRef)[2][2][4][2];
typedef int i32x4 __attribute__((ext_vector_type(4)));
__device__ __forceinline__ f32x4 cvfix4(const float* pcv) { const i32x4 v = *(const i32x4*)pcv; return (f32x4){(float)v.x, (float)v.y, (float)v.z, (float)v.w} * 2.384185791015625e-07f; }

struct EpiSwiglu {
    static constexpr bool PERM = true, AFTER_DRAIN = false, KSEG = false;
    bf16* O;
    __device__ __forceinline__ void operator()(AccRef acc, const Unit& u, int wr, int wc, int fr, int fq) const {
        const int row0 = u.pm * 256 + wr * 64 + fr, col0 = u.pn * 128 + wc * 32 + 8 * fq;
#pragma unroll
        for (int ai = 0; ai < 2; ++ai)
#pragma unroll
            for (int m = 0; m < 4; ++m) {
                const f32x4 g0 = acc[ai][0][m][0], g1 = acc[ai][0][m][1], u0 = acc[ai][1][m][0], u1 = acc[ai][1][m][1];
                float v[8];
#pragma unroll
                for (int i = 0; i < 4; ++i) { v[i] = g0[i] * __builtin_amdgcn_rcpf(1.0f + __expf(-g0[i])) * u0[i]; v[4 + i] = g1[i] * __builtin_amdgcn_rcpf(1.0f + __expf(-g1[i])) * u1[i]; }
                u32x4 w; w.x = pk2(v[0], v[1]); w.y = pk2(v[2], v[3]); w.z = pk2(v[4], v[5]); w.w = pk2(v[6], v[7]);
                *(u32x4*)(O + (size_t)(row0 + ai * 128 + m * 16) * DFF + col0) = w;
            }
    }
};
struct EpiSwigluN {
    static constexpr bool PERM = true, AFTER_DRAIN = false, KSEG = false;
    bf16* O; const float* ss; const float* cv;
    __device__ __forceinline__ void operator()(AccRef acc, const Unit& u, int wr, int wc, int fr, int fq) const {
        const int cond = u.pm < 32 ? 0 : 1 + ((u.pm - 32) >> 2);
        const int row0 = u.pm * 256 + wr * 64 + fr, col0 = u.pn * 128 + wc * 32 + 8 * fq, gc0 = u.pn * 256 + wc * 32 + 8 * fq;
        const float* cp = cv + (size_t)cond * 5632 + gc0;
        const f32x4 cg0 = cvfix4(cp), cg1 = cvfix4(cp + 4), cu0 = cvfix4(cp + 128), cu1 = cvfix4(cp + 132);
#pragma unroll
        for (int ai = 0; ai < 2; ++ai)
#pragma unroll
            for (int m = 0; m < 4; ++m) {
                const int row = row0 + ai * 128 + m * 16;
                const float rs = ss[row];
                const f32x4 g0 = acc[ai][0][m][0] * rs + cg0, g1 = acc[ai][0][m][1] * rs + cg1, u0 = acc[ai][1][m][0] * rs + cu0, u1 = acc[ai][1][m][1] * rs + cu1;
                float v[8];
#pragma unroll
                for (int i = 0; i < 4; ++i) { v[i] = g0[i] * __builtin_amdgcn_rcpf(1.0f + __expf(-g0[i])) * u0[i]; v[4 + i] = g1[i] * __builtin_amdgcn_rcpf(1.0f + __expf(-g1[i])) * u1[i]; }
                u32x4 w; w.x = pk2(v[0], v[1]); w.y = pk2(v[2], v[3]); w.z = pk2(v[4], v[5]); w.w = pk2(v[6], v[7]);
                *(u32x4*)(O + (size_t)row * DFF + col0) = w;
            }
    }
};
struct EpiStoreN {
    static constexpr bool PERM = true, AFTER_DRAIN = false, KSEG = false;
    bf16* O; int ldc; int ncols; const float* ss; const float* cv; int ncv;
    __device__ __forceinline__ void operator()(AccRef acc, const Unit& u, int wr, int wc, int fr, int fq) const {
        const int cond = u.pm < 32 ? 0 : 1 + ((u.pm - 32) >> 2);
        const int row0 = u.pm * 256 + wr * 64 + fr, col0 = u.pn * 256 + wc * 32 + 8 * fq;
        const float* cp = cv + (size_t)cond * ncv + col0;
        const f32x4 c00 = cvfix4(cp), c01 = cvfix4(cp + 4), c10 = cvfix4(cp + 128), c11 = cvfix4(cp + 132);
#pragma unroll
        for (int ai = 0; ai < 2; ++ai)
#pragma unroll
            for (int m = 0; m < 4; ++m) {
                const int row = row0 + ai * 128 + m * 16;
                const float rs = ss[row];
                bf16* rowp = O + (size_t)row * ldc;
#pragma unroll
                for (int bj = 0; bj < 2; ++bj) { const int col = col0 + bj * 128;
                    const f32x4 v0 = acc[ai][bj][m][0] * rs + (bj ? c10 : c00), v1 = acc[ai][bj][m][1] * rs + (bj ? c11 : c01);
                    u32x4 w; w.x = pk2(v0[0], v0[1]); w.y = pk2(v0[2], v0[3]); w.z = pk2(v1[0], v1[1]); w.w = pk2(v1[2], v1[3]);
                    if (col < ncols) *(u32x4*)(rowp + col) = w; }
            }
    }
};
template <bool IN16>
struct EpiResidN {
    static constexpr bool PERM = true, AFTER_DRAIN = false, KSEG = false;
    const float* xin_p; const float* xin_s; bf16* xb16; const float* gate_base;
    const float* gprev; const float* scp_base; const float* gnext; const float* scn_base; float* ss; float coef;
    __device__ __forceinline__ void operator()(AccRef acc, const Unit& u, int wr, int wc, int fr, int fq) const {
        const int cond = u.pm < 32 ? 0 : 1 + ((u.pm - 32) >> 2);
        const float* gate = gate_base + (size_t)cond * 9216; const float* scn = scn_base + (size_t)cond * 9216; const float* scp = scp_base + (size_t)cond * 9216;
        const int row0 = u.pm * 256 + wr * 64 + fr, col0 = u.pn * 256 + wc * 32 + 8 * fq;
        float sq[2][4];
#pragma unroll
        for (int ai = 0; ai < 2; ++ai)
#pragma unroll
            for (int m = 0; m < 4; ++m) sq[ai][m] = 0.f;
        const float* xb = u.pm < 32 ? xin_p : xin_s - (size_t)MP * DM;
        const unsigned off0 = (unsigned)(row0 * DM + col0);
#pragma unroll
        for (int bj = 0; bj < 2; ++bj) {
            const int col = col0 + bj * 128;
            f32x4 gv[2], G[2], Gi[2];
#pragma unroll
            for (int n = 0; n < 2; ++n) { gv[n] = *(const f32x4*)(gate + col + 4 * n) * coef; G[n] = *(const f32x4*)(gnext + col + 4 * n) * (*(const f32x4*)(scn + col + 4 * n) + 1.0f);
                if constexpr (IN16) { const f32x4 gp = *(const f32x4*)(gprev + col + 4 * n) * (*(const f32x4*)(scp + col + 4 * n) + 1.0f);
                    Gi[n] = (f32x4){__builtin_amdgcn_rcpf(gp.x), __builtin_amdgcn_rcpf(gp.y), __builtin_amdgcn_rcpf(gp.z), __builtin_amdgcn_rcpf(gp.w)}; } }
#pragma unroll
            for (int ai = 0; ai < 2; ++ai) {
                f32x4 xv[4][2];
                if constexpr (IN16) {
                    u32x4 raw[4];
#pragma unroll
                    for (int m = 0; m < 4; ++m) raw[m] = *(const u32x4*)(xb16 + (off0 + (unsigned)((ai * 128 + m * 16) * DM + bj * 128)));
#pragma unroll
                    for (int m = 0; m < 4; ++m) { xv[m][0] = unpk4((u32x2){raw[m].x, raw[m].y}) * Gi[0]; xv[m][1] = unpk4((u32x2){raw[m].z, raw[m].w}) * Gi[1]; }
                } else {
#pragma unroll
                    for (int m = 0; m < 4; ++m)
#pragma unroll
                        for (int n = 0; n < 2; ++n) xv[m][n] = *(const f32x4*)(xb + (off0 + (unsigned)((ai * 128 + m * 16) * DM + bj * 128 + 4 * n)));
                }
                asm volatile("" ::: "memory");
#pragma unroll
                for (int m = 0; m < 4; ++m) {
                    const unsigned off = off0 + (unsigned)((ai * 128 + m * 16) * DM + bj * 128);
                    const f32x4 x0 = xv[m][0] + gv[0] * acc[ai][bj][m][0], x1 = xv[m][1] + gv[1] * acc[ai][bj][m][1];
                    const u32x2 w0 = pk4(x0 * G[0]), w1 = pk4(x1 * G[1]);
                    *(u32x4*)(xb16 + off) = (u32x4){w0.x, w0.y, w1.x, w1.y};
                    sq[ai][m] += x0.x * x0.x + x0.y * x0.y + x0.z * x0.z + x0.w * x0.w + x1.x * x1.x + x1.y * x1.y + x1.z * x1.z + x1.w * x1.w;
                }
                asm volatile("" ::: "memory");
            }
        }
#pragma unroll
        for (int ai = 0; ai < 2; ++ai)
#pragma unroll
            for (int m = 0; m < 4; ++m) {
                float t = sq[ai][m]; t += SHFLX(t, 16, fq * 16 + fr); t += SHFLX(t, 32, fq * 16 + fr);
                if (fq == 0) ss[(u.pn * 4 + wc) * M_TOK + row0 + ai * 128 + m * 16] = t;
            }
    }
};
struct EpiResid {
    static constexpr bool PERM = true, AFTER_DRAIN = false, KSEG = false;
    bf16* xb16; const float* gate_base; const float* gprev; const float* scp_base; float coef;
    __device__ __forceinline__ void operator()(AccRef acc, const Unit& u, int wr, int wc, int fr, int fq) const {
        const int cond = u.pm < 32 ? 0 : 1 + ((u.pm - 32) >> 2);
        const float* gate = gate_base + (size_t)cond * 9216; const float* scp = scp_base + (size_t)cond * 9216;
        const int row0 = u.pm * 256 + wr * 64 + fr, col0 = u.pn * 256 + wc * 32 + 8 * fq;
        const unsigned off0 = (unsigned)(row0 * DM + col0);
#pragma unroll
        for (int bj = 0; bj < 2; ++bj) {
            const f32x4 gv0 = *(const f32x4*)(gate + col0 + bj * 128) * coef, gv1 = *(const f32x4*)(gate + col0 + bj * 128 + 4) * coef;
            f32x4 Gi[2];
#pragma unroll
            for (int n = 0; n < 2; ++n) { const f32x4 gp = *(const f32x4*)(gprev + col0 + bj * 128 + 4 * n) * (*(const f32x4*)(scp + col0 + bj * 128 + 4 * n) + 1.0f);
                Gi[n] = (f32x4){__builtin_amdgcn_rcpf(gp.x), __builtin_amdgcn_rcpf(gp.y), __builtin_amdgcn_rcpf(gp.z), __builtin_amdgcn_rcpf(gp.w)}; }
#pragma unroll
            for (int ai = 0; ai < 2; ++ai) {
                f32x4 xv[4][2];
                u32x4 raw[4];
#pragma unroll
                for (int m = 0; m < 4; ++m) raw[m] = *(const u32x4*)(xb16 + (off0 + (unsigned)((ai * 128 + m * 16) * DM + bj * 128)));
#pragma unroll
                for (int m = 0; m < 4; ++m) { xv[m][0] = unpk4((u32x2){raw[m].x, raw[m].y}) * Gi[0]; xv[m][1] = unpk4((u32x2){raw[m].z, raw[m].w}) * Gi[1]; }
                asm volatile("" ::: "memory");
#pragma unroll
                for (int m = 0; m < 4; ++m) {
                    const unsigned off = off0 + (unsigned)((ai * 128 + m * 16) * DM + bj * 128);
                    { const u32x2 r0 = pk4(xv[m][0] + gv0 * acc[ai][bj][m][0]), r1 = pk4(xv[m][1] + gv1 * acc[ai][bj][m][1]); *(u32x4*)(xb16 + off) = (u32x4){r0.x, r0.y, r1.x, r1.y}; }
                }
                asm volatile("" ::: "memory");
            }
        }
    }
};
struct EpiStore {
    static constexpr bool PERM = true, AFTER_DRAIN = false, KSEG = false;
    bf16* O; int ldc; int ncols;
    __device__ __forceinline__ void operator()(AccRef acc, const Unit& u, int wr, int wc, int fr, int fq) const {
        const int row0 = u.pm * 256 + wr * 64 + fr, col0 = u.pn * 256 + wc * 32 + 8 * fq;
#pragma unroll
        for (int ai = 0; ai < 2; ++ai)
#pragma unroll
            for (int m = 0; m < 4; ++m) {
                bf16* rowp = O + (size_t)(row0 + ai * 128 + m * 16) * ldc;
#pragma unroll
                for (int bj = 0; bj < 2; ++bj) { const int col = col0 + bj * 128; const f32x4 v0 = acc[ai][bj][m][0], v1 = acc[ai][bj][m][1];
                    u32x4 w; w.x = pk2(v0[0], v0[1]); w.y = pk2(v0[2], v0[3]); w.z = pk2(v1[0], v1[1]); w.w = pk2(v1[2], v1[3]);
                    if (col < ncols) *(u32x4*)(rowp + col) = w; }
            }
    }
};
struct EpiLora {
    static constexpr bool PERM = true, AFTER_DRAIN = false, KSEG = true;
    bf16* O; const float* w0; const float* a0;
    __device__ __forceinline__ void operator()(AccRef acc, const Unit& u, int wr, int wc, int fr, int fq) const {
        const int seg = u.pn >> 1;
        const float* bias = seg < 2 ? w0 + seg * 512 : a0 + (seg & 1) * 512;
        const int row0 = u.pm * 256 + wr * 64 + fr, ct0 = wc * 32 + 8 * fq;
#pragma unroll
        for (int bj = 0; bj < 2; ++bj) {
            const int cseg = (u.pn & 1) * 256 + ct0 + bj * 128;
            f32x4 b0 = {0.f, 0.f, 0.f, 0.f}, b1 = {0.f, 0.f, 0.f, 0.f};
            if (seg < 4) { b0 = *(const f32x4*)(bias + cseg); b1 = *(const f32x4*)(bias + cseg + 4); }
#pragma unroll
            for (int ai = 0; ai < 2; ++ai)
#pragma unroll
                for (int m = 0; m < 4; ++m) {
                    f32x4 v0 = acc[ai][bj][m][0] + b0, v1 = acc[ai][bj][m][1] + b1;
                    if (seg < 4) {
                        const float sc = seg < 2 ? 0.60653066f : 1.0f;
#pragma unroll
                        for (int i = 0; i < 4; ++i) { v0[i] = sc * sigmoidf_(v0[i]); v1[i] = sc * sigmoidf_(v1[i]); }
                    }
                    u32x4 w; w.x = pk2(v0[0], v0[1]); w.y = pk2(v0[2], v0[3]); w.z = pk2(v1[0], v1[1]); w.w = pk2(v1[2], v1[3]);
                    *(u32x4*)(O + (size_t)(row0 + ai * 128 + m * 16) * 2560 + u.pn * 256 + ct0 + bj * 128) = w;
                    asm volatile("" ::: "memory");
                }
        }
    }
};
struct EpiQ {
    static constexpr bool PERM = true, AFTER_DRAIN = false, KSEG = false;
    bf16* O; const float* rope;
    __device__ __forceinline__ void operator()(AccRef acc, const Unit& u, int wr, int wc, int fr, int fq) const {
        const int row0 = u.pm * 256 + wr * 64 + fr, col0 = u.pn * 256 + wc * 32 + 8 * fq;
        const float qs = 0.10206207261596577f;
#pragma unroll
        for (int bj = 0; bj < 2; ++bj) {
            const int col = col0 + bj * 128, e0 = col % 96;
            const bool is_rope = e0 >= 64;
#pragma unroll
            for (int ai = 0; ai < 2; ++ai)
#pragma unroll
                for (int m = 0; m < 4; ++m) {
                    const int row = row0 + ai * 128 + m * 16;
                    f32x4 v0 = acc[ai][bj][m][0] * qs, v1 = acc[ai][bj][m][1] * qs;
                    if (is_rope && row >= MP) {
                        const int t = (row - MP) & 1023;
                        const float* rt = rope + (size_t)t * 32 + (e0 - 64);
                        const f32x4 c0 = *(const f32x4*)(rt), c1 = *(const f32x4*)(rt + 4);
                        f32x4 r0, r1;
                        r0[0] = v0[0] * c0[0] - v0[1] * c0[1]; r0[1] = v0[0] * c0[1] + v0[1] * c0[0];
                        r0[2] = v0[2] * c0[2] - v0[3] * c0[3]; r0[3] = v0[2] * c0[3] + v0[3] * c0[2];
                        r1[0] = v1[0] * c1[0] - v1[1] * c1[1]; r1[1] = v1[0] * c1[1] + v1[1] * c1[0];
                        r1[2] = v1[2] * c1[2] - v1[3] * c1[3]; r1[3] = v1[2] * c1[3] + v1[3] * c1[2];
                        v0 = r0; v1 = r1;
                    }
                    u32x4 w; w.x = pk2(v0[0], v0[1]); w.y = pk2(v0[2], v0[3]); w.z = pk2(v1[0], v1[1]); w.w = pk2(v1[2], v1[3]);
                    *(u32x4*)(O + (size_t)row * 768 + col) = w;
                    asm volatile("" ::: "memory");
                }
        }
    }
};

struct EpiKV {
    static constexpr bool PERM = true, AFTER_DRAIN = false, KSEG = false;
    bf16* KN; bf16* VT; int nrows;
    __device__ __forceinline__ void operator()(AccRef acc, const Unit& u, int wr, int wc, int fr, int fq) const {
        const int row0 = u.pm * 256 + wr * 64 + fr, col0 = u.pn * 256 + wc * 32 + 8 * fq;
#pragma unroll
        for (int bj = 0; bj < 2; ++bj) {
            const int col = col0 + bj * 128, head = col >> 7, e0 = col & 127;
#pragma unroll
            for (int ai = 0; ai < 2; ++ai)
#pragma unroll
                for (int m = 0; m < 4; ++m) {
                    const int row = row0 + ai * 128 + m * 16;
                    const f32x4 v0 = acc[ai][bj][m][0], v1 = acc[ai][bj][m][1];
                    u32x4 w; w.x = pk2(v0[0], v0[1]); w.y = pk2(v0[2], v0[3]); w.z = pk2(v1[0], v1[1]); w.w = pk2(v1[2], v1[3]);
                    if (e0 < 64) *(u32x4*)(KN + (size_t)row * 512 + head * 64 + e0) = w;
                    else { bf16* vp = VT + (size_t)(head * 64 + e0 - 64) * nrows + row;
#pragma unroll
                        for (int i = 0; i < 4; ++i) { vp[(size_t)(2 * i) * nrows] = (bf16)(w[i] & 0xffffu); vp[(size_t)(2 * i + 1) * nrows] = (bf16)(w[i] >> 16); } }
                }
        }
    }
};

__device__ __forceinline__ void adaln_layer(const P& p, LAS unsigned char* lds, int l, int bfirst) {
    LAS float* scv = (LAS float*)lds;
    LAS float* red = scv + 9 * 1024;
    const int tid = tid_opaque(), tx = tid % 18, ty = tid / 18;
    const float* cc = p.in[6]; const float* cctx = p.in[7];
    float* mod = (float*)(p.ws + WS_MOD);
    if ((int)blockIdx.x < bfirst) return;
    __syncthreads();
    for (int i = tid; i < 9 * 1024; i += NTHREADS) { const int c = i >> 10, k = i & 1023; const float v = c == 0 ? cctx[k] : cc[(c - 1) * 1024 + k]; scv[i] = v / (1.0f + expf(-v)); }
    __syncthreads();
    for (int cgp = blockIdx.x - bfirst; cgp < 128; cgp += gridDim.x - bfirst) {
        const int col0 = cgp * 72 + tx * 4;
        const float* W = p.in[8] + (size_t)l * 1024 * 9216;
        f32x4 acc[9];
#pragma unroll
        for (int c = 0; c < 9; ++c) acc[c] = (f32x4){0.f, 0.f, 0.f, 0.f};
        if (ty < 28) {
#pragma unroll 8
            for (int k = ty; k < 1024; k += 28) {
                const f32x4 w = *(const f32x4*)(W + (size_t)k * 9216 + col0);
#pragma unroll
                for (int c = 0; c < 9; ++c) acc[c] += w * scv[c * 1024 + k];
            }
#pragma unroll
            for (int c = 0; c < 9; ++c) *(LAS f32x4*)(red + ty * 648 + c * 72 + tx * 4) = acc[c];
        }
        __syncthreads();
        for (int o = tid; o < 648; o += NTHREADS) {
            float s = 0.f;
            for (int y = 0; y < 28; ++y) s += red[y * 648 + o];
            const int c = o / 72, j = o % 72;
            mod[(size_t)(l * 9 + c) * 9216 + cgp * 72 + j] = s + p.in[9][l * 9216 + cgp * 72 + j];
        }
        __syncthreads();
    }
}
__device__ __forceinline__ void ph_rope_table(const P& p) {
    const int tid = tid_opaque();
    float* rope = (float*)(p.ws + WS_ROPE);
    for (int idx = blockIdx.x * NTHREADS + tid; idx < 1024 * 16; idx += gridDim.x * NTHREADS) {
        const int t = idx >> 4, i = idx & 15;
        const float pos = (float)(i < 8 ? (t >> 6) : (t & 63));
        const float inv = powf(10000.0f, -(float)(i & 7) / 8.0f);
        const float ang = pos * inv;
        rope[idx * 2] = cosf(ang); rope[idx * 2 + 1] = sinf(ang);
    }
}

__device__ __forceinline__ void norm_rows(const P& p, int layer, int j, const float* gvec, bool from_input) {
    const int tid = tid_opaque(), lane = tid & 63, wave = tid >> 6;
    const float* mod = (const float*)(p.ws + WS_MOD);
    const float* x = p.out;
    bf16* h = (bf16*)(p.ws + WS_H);
    const int nw = gridDim.x * 8;
    for (int row0 = blockIdx.x * 8 + wave; row0 < M_TOK; row0 += 4 * nw) {
        f32x4 v[4][4]; float ss[4];
#pragma unroll
        for (int r = 0; r < 4; ++r) {
            const int row = (row0 + r * nw) < M_TOK ? (row0 + r * nw) : (M_TOK - 1);
            const float* xr = from_input ? (row < MP ? p.in[0] + (size_t)row * DM : p.in[1] + (size_t)(row - MP) * DM) : x + (size_t)row * DM;
#pragma unroll
            for (int q = 0; q < 4; ++q) v[r][q] = *(const f32x4*)(xr + lane * 4 + 256 * q);
        }
#pragma unroll
        for (int r = 0; r < 4; ++r) { float s = 0.f;
#pragma unroll
            for (int q = 0; q < 4; ++q) s += v[r][q].x * v[r][q].x + v[r][q].y * v[r][q].y + v[r][q].z * v[r][q].z + v[r][q].w * v[r][q].w;
            ss[r] = s; }
#pragma unroll
        for (int o = 1; o < 64; o <<= 1) {
#pragma unroll
            for (int r = 0; r < 4; ++r) ss[r] += SHFLX(ss[r], o, lane); }
#pragma unroll
        for (int r = 0; r < 4; ++r) {
            const int row = row0 + r * nw; if (row >= M_TOK) break;
            const float rstd = 1.0f / sqrtf(ss[r] * (1.0f / 1024.0f) + 1e-6f);
            const float* mrow = mod + (size_t)(layer * 9 + cond_of_row(row)) * 9216;
            const float* sh = mrow + (3 * j) * 1024; const float* sc = mrow + (3 * j + 1) * 1024;
#pragma unroll
            for (int q = 0; q < 4; ++q) {
                const int col = lane * 4 + 256 * q;
                const f32x4 g = *(const f32x4*)(gvec + col), s1 = *(const f32x4*)(sc + col), s0 = *(const f32x4*)(sh + col);
                const f32x4 y = (v[r][q] * rstd * g) * (s1 + 1.0f) + s0;
                *(u32x2*)(h + (size_t)row * DM + col) = pk4(y);
            }
        }
    }
}
__device__ __forceinline__ void first_rows(const P& p, const float* gvec, float* ss) {
    const int tid = tid_opaque(), lane = tid & 63, wave = tid >> 6;
    const float* mod = (const float*)(p.ws + WS_MOD);
    bf16* h = (bf16*)(p.ws + WS_XB);
    const int nw = gridDim.x * 8;
    for (int row0 = blockIdx.x * 8 + wave; row0 < M_TOK; row0 += 8 * nw) {
        f32x4 v[8][4]; float sq[8];
#pragma unroll
        for (int r = 0; r < 8; ++r) {
            const int row = (row0 + r * nw) < M_TOK ? (row0 + r * nw) : (M_TOK - 1);
            const float* xr = row < MP ? p.in[0] + (size_t)row * DM : p.in[1] + (size_t)(row - MP) * DM;
#pragma unroll
            for (int q = 0; q < 4; ++q) v[r][q] = *(const f32x4*)(xr + lane * 4 + 256 * q);
        }
#pragma unroll
        for (int r = 0; r < 8; ++r) { float t = 0.f;
#pragma unroll
            for (int q = 0; q < 4; ++q) t += v[r][q].x * v[r][q].x + v[r][q].y * v[r][q].y + v[r][q].z * v[r][q].z + v[r][q].w * v[r][q].w;
            sq[r] = t; }
#pragma unroll
        for (int o = 1; o < 64; o <<= 1) {
#pragma unroll
            for (int r = 0; r < 8; ++r) sq[r] += SHFLX(sq[r], o, lane); }
#pragma unroll
        for (int r = 0; r < 8; ++r) {
            const int row = row0 + r * nw; if (row >= M_TOK) break;
            if (lane == 0) ss[row] = rsqrtf_(sq[r] * (1.0f / 1024.0f) + 1e-6f);
            const float* sc = mod + (size_t)cond_of_row(row) * 9216 + 1024;
#pragma unroll
            for (int q = 0; q < 4; ++q) { const int col = lane * 4 + 256 * q;
                *(u32x2*)(h + (size_t)row * DM + col) = pk4(v[r][q] * (*(const f32x4*)(gvec + col) * (*(const f32x4*)(sc + col) + 1.0f))); }
        }
    }
}
__device__ __forceinline__ void final_norm_rows(const P& p) {
    const int tid = tid_opaque(), lane = tid & 63, wave = tid >> 6;
    float* x = p.out; const float* gvec = p.in[47]; const bf16* xb = (const bf16*)(p.ws + WS_XB);
    const int nw = gridDim.x * 8;
    for (int row0 = blockIdx.x * 8 + wave; row0 < M_TOK; row0 += 4 * nw) {
        f32x4 v[4][4]; float ss[4];
#pragma unroll
        for (int r = 0; r < 4; ++r) { const int row = (row0 + r * nw) < M_TOK ? (row0 + r * nw) : (M_TOK - 1);
#pragma unroll
            for (int q = 0; q < 4; ++q) v[r][q] = unpk4(*(const u32x2*)(xb + (size_t)row * DM + lane * 4 + 256 * q)); }
#pragma unroll
        for (int r = 0; r < 4; ++r) { float s = 0.f;
#pragma unroll
            for (int q = 0; q < 4; ++q) s += v[r][q].x * v[r][q].x + v[r][q].y * v[r][q].y + v[r][q].z * v[r][q].z + v[r][q].w * v[r][q].w;
            ss[r] = s; }
#pragma unroll
        for (int o = 1; o < 64; o <<= 1) {
#pragma unroll
            for (int r = 0; r < 4; ++r) ss[r] += SHFLX(ss[r], o, lane); }
#pragma unroll
        for (int r = 0; r < 4; ++r) { const int row = row0 + r * nw; if (row >= M_TOK) break;
            const float rstd = rsqrtf_(ss[r] * (1.0f / 1024.0f) + 1e-6f);
#pragma unroll
            for (int q = 0; q < 4; ++q) { const int col = lane * 4 + 256 * q; *(f32x4*)(x + (size_t)row * DM + col) = v[r][q] * rstd * *(const f32x4*)(gvec + col); } }
    }
}

template <int MODE>
__device__ __forceinline__ void transpose_w(const float* W, int ldw, int ncols_valid, int K, bf16* WT, int Nt, LAS unsigned char* lds, const float* shift = nullptr, float* cvo = nullptr, int ncv = 0, int rot = 0) {
    const int tid = tid_opaque(), lane = tid & 63, wave = tid >> 6;
    LAS float* scr = (LAS float*)(lds + wave * 16640);
    LAS float* shs = (LAS float*)(lds + 8 * 16640 + wave * 3072);
    const int nblk = Nt / 64, nitems = nblk * (K / 64);
    int vb = ((int)blockIdx.x + (int)gridDim.x - rot % (int)gridDim.x) % (int)gridDim.x;
    for (int it = vb * 8 + wave; it < nitems; it += gridDim.x * 8) {
        const int kb = it / nblk, nb = it % nblk, k0 = kb * 64;
        const int g0 = 2 * nb;
        const int sc0 = MODE == 1 ? (((g0 >> 2) & 1) * DFF + (g0 >> 3) * 128 + (g0 & 3) * 32) : nb * 64;
        const int c4 = (lane & 15) * 4, kr = lane >> 4; const bool ok = (sc0 + c4) < ncols_valid;
        f32x4 t[16];
#pragma unroll
        for (int i = 0; i < 16; ++i) t[i] = ok ? *(const f32x4*)(W + (size_t)(k0 + 4 * i + kr) * ldw + sc0 + c4) : (f32x4){0.f, 0.f, 0.f, 0.f};
#pragma unroll
        for (int i = 0; i < 16; ++i) { LAS float* d = scr + (4 * i + kr) * 65 + c4; d[0] = t[i].x; d[1] = t[i].y; d[2] = t[i].z; d[3] = t[i].w; }
        if (shift) {
#pragma unroll
            for (int cc = 0; cc < 9; ++cc) shs[lane * 12 + cc] = shift[(size_t)cc * 9216 + k0 + lane];
        }
        LDS_WAIT();
        if (shift) {
            float a9[9];
#pragma unroll
            for (int cc = 0; cc < 9; ++cc) a9[cc] = 0.f;
#pragma unroll 4
            for (int k = 0; k < 64; ++k) {
                const float w = scr[k * 65 + lane];
                const f32x4 s0 = *(const LAS f32x4*)(shs + k * 12), s1 = *(const LAS f32x4*)(shs + k * 12 + 4); const float s8 = shs[k * 12 + 8];
                a9[0] += w * s0.x; a9[1] += w * s0.y; a9[2] += w * s0.z; a9[3] += w * s0.w; a9[4] += w * s1.x; a9[5] += w * s1.y; a9[6] += w * s1.z; a9[7] += w * s1.w; a9[8] += w * s8;
            }
#pragma unroll
            for (int cc = 0; cc < 9; ++cc) __hip_atomic_fetch_add((int*)cvo + (size_t)cc * ncv + nb * 64 + lane, (int)rintf(a9[cc] * 4194304.0f), __ATOMIC_RELAXED, __HIP_MEMORY_SCOPE_AGENT);
        }
        const int c = lane & 7;
#pragma unroll
        for (int j = 0; j < 8; ++j) {
            const int nn = (lane >> 3) + 8 * j; const LAS float* sp = scr + (8 * c) * 65 + nn;
            u32x4 o; o.x = pk2(sp[0 * 65], sp[1 * 65]); o.y = pk2(sp[2 * 65], sp[3 * 65]); o.z = pk2(sp[4 * 65], sp[5 * 65]); o.w = pk2(sp[6 * 65], sp[7 * 65]);
            *(u32x4*)(WT + (size_t)(nb * 64 + nn) * K + k0 + 8 * c) = o;
        }
        LDS_WAIT();
    }
}
__device__ __forceinline__ void convert_ffn_weights(const P& p, int layer, int which, LAS unsigned char* lds, const float* shift, float* cvo) {
    const float* wgu = p.in[which == 0 ? 13 : 15] + (size_t)layer * 1024 * 5632;
    const float* wdn = p.in[which == 0 ? 14 : 16] + (size_t)layer * 2816 * 1024;
    transpose_w<1>(wgu, 5632, 5632, 1024, (bf16*)(p.ws + W_GU), 5632, lds, shift, cvo, 5632);
    transpose_w<0>(wdn, 1024, 1024, 2816, (bf16*)(p.ws + W_DOWN), 1024, lds, nullptr, nullptr, 0, 176);
}
__device__ __forceinline__ void build_lora_w(const P& p) {
    bf16* WT = (bf16*)(p.ws + W_LORA);
    const float* w_up = p.in[21]; const float* a_up = p.in[23]; const float* g_up = p.in[24];
    for (int idx = blockIdx.x * NTHREADS + tid_opaque(); idx < 2560 * 384; idx += gridDim.x * NTHREADS) {
        const int n = idx / 384, k = idx % 384, seg = n >> 9, c = n & 511;
        float v = 0.f;
        if (seg == 0) { if (k < 64) v = w_up[(0 * 64 + k) * 512 + c]; }
        else if (seg == 1) { if (k >= 64 && k < 128) v = w_up[(1 * 64 + k - 64) * 512 + c]; }
        else if (seg == 2) { if (k >= 128 && k < 192) v = a_up[(0 * 64 + k - 128) * 512 + c]; }
        else if (seg == 3) { if (k >= 192 && k < 256) v = a_up[(1 * 64 + k - 192) * 512 + c]; }
        else { if (k >= 256) v = g_up[(k - 256) * 512 + c]; }
        WT[(size_t)n * 384 + k] = (bf16)(pk2(v, 0.f) & 0xffffu);
    }
}

__device__ __forceinline__ void ph_lora_in(const P& p) {
    const int tid = tid_opaque(), lane = tid & 63, wave = tid >> 6;
    const bf16* p0 = (const bf16*)(p.ws + WS_R1); bf16* LA = (bf16*)(p.ws + WS_H);
    const float* mu = p.in[19];
    const int nw = gridDim.x * 8;
    float m0[3], m1[3];
#pragma unroll
    for (int ch = 0; ch < 3; ++ch) { m0[ch] = mu[1536 + ch * 128 + lane * 2]; m1[ch] = mu[1536 + ch * 128 + lane * 2 + 1]; }
    for (int row0 = blockIdx.x * 8 + wave; row0 < M_TOK; row0 += 4 * nw) {
        unsigned cur[4][3], prv[4][3], nxt[4][3];
#pragma unroll
        for (int r = 0; r < 4; ++r) {
            const int row = (row0 + r * nw) < M_TOK ? (row0 + r * nw) : (M_TOK - 1);
            const int t = row < MP ? (row & 255) : ((row - MP) & 1023), L = row < MP ? 256 : 1024;
            const bool hp = t > 0, hn = t < L - 1;
#pragma unroll
            for (int ch = 0; ch < 3; ++ch) {
                const bf16* pc = p0 + (size_t)row * LDP0 + 1536 + ch * 128 + lane * 2;
                cur[r][ch] = *(const unsigned*)pc; prv[r][ch] = hp ? *(const unsigned*)(pc - LDP0) : 0u; nxt[r][ch] = hn ? *(const unsigned*)(pc + LDP0) : 0u;
            }
        }
#pragma unroll
        for (int r = 0; r < 4; ++r) {
            const int row = row0 + r * nw; if (row >= M_TOK) break;
#pragma unroll
            for (int ch = 0; ch < 3; ++ch) {
                float a0 = bflo(cur[r][ch]) + m0[ch] * (0.5f * (bflo(prv[r][ch]) + bflo(nxt[r][ch])) - bflo(cur[r][ch]));
                float a1 = bfhi(cur[r][ch]) + m1[ch] * (0.5f * (bfhi(prv[r][ch]) + bfhi(nxt[r][ch])) - bfhi(cur[r][ch]));
                if (ch == 0) { a0 = 1.0f - 2.0f * __builtin_amdgcn_rcpf(__expf(2.0f * a0) + 1.0f); a1 = 1.0f - 2.0f * __builtin_amdgcn_rcpf(__expf(2.0f * a1) + 1.0f); }
                if (ch == 2) { a0 = sigmoidf_(a0); a1 = sigmoidf_(a1); }
                *(unsigned*)(LA + (size_t)row * 384 + ch * 128 + lane * 2) = pk2(a0, a1);
            }
        }
    }
}

__device__ __forceinline__ void rwkv_item(const P& p, LAS unsigned char* lds, int kind, int b, int head, int dir) {
    constexpr int T = 32, NG = 8, GS = 1408;
    LAS float* grp = (LAS float*)lds;
    LAS float* raw = grp + 2 * NG * GS;
    LAS float* ybR = raw + T * 320;
    const int tid = tid_opaque(), lane = tid & 63, wave = tid >> 6, q = lane & 7, vl = lane >> 3, r0 = wave * 8 + vl;
    const int tt = tid >> 4, cgi = tid & 15;
    const int L = kind ? 1024 : 256, nblk = L / T;
    const int rowbase = kind ? MP + b * 1024 : b * 256;
    const bf16* p0 = (const bf16*)(p.ws + WS_R1);
    const bf16* lo = (const bf16*)(p.ws + WS_R2);
    bf16* Y = (bf16*)(p.ws + (dir == 0 ? WS_MIX : WS_H));
    const int colbase = head * 64;
    f32x2 S[4];
#pragma unroll
    for (int i = 0; i < 4; ++i) S[i] = (f32x2){0.f, 0.f};
    if (kind) { const float* s0 = p.in[2] + (((size_t)b * 2 + dir) * 8 + head) * 4096 + q * 8;
        const f32x4 a0 = *(const f32x4*)(s0 + r0 * 64), a1 = *(const f32x4*)(s0 + r0 * 64 + 4);
        S[0] = (f32x2){a0.x, a0.y}; S[1] = (f32x2){a0.z, a0.w}; S[2] = (f32x2){a1.x, a1.y}; S[3] = (f32x2){a1.z, a1.w}; }
    const int C = head * 64 + cgi * 4;
    const f32x4 cA = *(const f32x4*)(p.in[19] + C), cB = *(const f32x4*)(p.in[19] + 512 + C), cC = *(const f32x4*)(p.in[19] + 1024 + C);
    const f32x4 cD = *(const f32x4*)(p.in[25] + C), cE = *(const f32x4*)(p.in[26] + C), cF = *(const f32x4*)(p.in[27] + C);
    float* bonp = (float*)(p.ws + WS_BON);
    u32x2 ra0, ra1, ra2, rb0, rb1, rb2, rc0, rc1, rc2, rd, re;
    const u32x2 z2 = {0u, 0u};
#define RW_LOAD(blk) do { \
        const int n_ = (blk) * T + tt, t_ = dir ? L - 1 - n_ : n_; const size_t row_ = (size_t)(rowbase + t_); \
        const bool hp_ = t_ > 0, hn_ = t_ < L - 1; \
        const bf16* pr_ = p0 + row_ * LDP0 + head * 64 + cgi * 4; \
        ra1 = *(const u32x2*)pr_; ra0 = hp_ ? *(const u32x2*)(pr_ - LDP0) : z2; ra2 = hn_ ? *(const u32x2*)(pr_ + LDP0) : z2; \
        rb1 = *(const u32x2*)(pr_ + 512); rb0 = hp_ ? *(const u32x2*)(pr_ + 512 - LDP0) : z2; rb2 = hn_ ? *(const u32x2*)(pr_ + 512 + LDP0) : z2; \
        rc1 = *(const u32x2*)(pr_ + 1024); rc0 = hp_ ? *(const u32x2*)(pr_ + 1024 - LDP0) : z2; rc2 = hn_ ? *(const u32x2*)(pr_ + 1024 + LDP0) : z2; \
        rd = *(const u32x2*)(lo + row_ * 2560 + dir * 512 + head * 64 + cgi * 4); re = *(const u32x2*)(lo + row_ * 2560 + 1024 + dir * 512 + head * 64 + cgi * 4); \
    } while (0)
#define RW_PREP1(bi, blk_) do { \
        LAS float* rw_ = raw + tt * 320; const int c4_ = cgi * 4; \
        const f32x4 r1_ = unpk4(ra1), k1_ = unpk4(rb1), v1_ = unpk4(rc1); \
        const f32x4 r_ = r1_ + cA * ((unpk4(ra0) + unpk4(ra2)) * 0.5f - r1_); \
        const f32x4 k_ = k1_ + cB * ((unpk4(rb0) + unpk4(rb2)) * 0.5f - k1_); \
        const f32x4 v_ = v1_ + cC * ((unpk4(rc0) + unpk4(rc2)) * 0.5f - v1_); \
        f32x4 kk_ = k_ * cD; \
        const float ss_ = red16(kk_.x * kk_.x + kk_.y * kk_.y + kk_.z * kk_.z + kk_.w * kk_.w); \
        kk_ = kk_ * rsqrtf_(ss_ + 1e-6f); \
        const f32x4 ew_ = unpk4(rd), a_ = unpk4(re); \
        f32x4 w_; w_.x = __expf(-ew_.x); w_.y = __expf(-ew_.y); w_.z = __expf(-ew_.z); w_.w = __expf(-ew_.w); \
        *(LAS f32x4*)(rw_ + c4_) = kk_; *(LAS f32x4*)(rw_ + 64 + c4_) = w_; *(LAS f32x4*)(rw_ + 128 + c4_) = kk_ * a_; \
        const f32x4 kd_ = k_ * ((a_ - 1.0f) * cE + 1.0f); \
        *(LAS f32x4*)(rw_ + 192 + c4_) = kd_; *(LAS f32x4*)(rw_ + 256 + c4_) = r_; \
        { const f32x4 pb_ = r_ * kd_ * cF; const float bs_ = red16(pb_.x + pb_.y + pb_.z + pb_.w);     \
          if (cgi == 0) { const int nb_ = (blk_) * T + tt, tb_ = dir ? L - 1 - nb_ : nb_; bonp[(size_t)(rowbase + tb_) * 16 + head * 2 + dir] = bs_; } } \
        *(LAS f32x4*)(grp + ((bi) * NG + (tt >> 2)) * GS + 1088 + (tt & 3) * 64 + c4_) = v_; \
    } while (0)
#define DOT16(aa_, bb_) red16((aa_)[0] * (bb_)[0] + (aa_)[1] * (bb_)[1] + (aa_)[2] * (bb_)[2] + (aa_)[3] * (bb_)[3])
#define RW_PREP2(bi) do { \
        const int part_ = tid >> 7, gq_ = (tid >> 4) & 7, c4_ = cgi * 4; const LAS float* r4_ = raw + gq_ * 4 * 320 + c4_; LAS float* gi_ = grp + ((bi) * NG + gq_) * GS; \
        const f32x4 kk1 = *(const LAS f32x4*)(r4_), w1 = *(const LAS f32x4*)(r4_ + 64), b1 = *(const LAS f32x4*)(r4_ + 128), d1 = *(const LAS f32x4*)(r4_ + 192), q1 = *(const LAS f32x4*)(r4_ + 256); \
        const f32x4 kk2 = *(const LAS f32x4*)(r4_ + 320), w2 = *(const LAS f32x4*)(r4_ + 384), b2 = *(const LAS f32x4*)(r4_ + 448), d2 = *(const LAS f32x4*)(r4_ + 512), q2 = *(const LAS f32x4*)(r4_ + 576); \
        const f32x4 kk3 = *(const LAS f32x4*)(r4_ + 640), w3 = *(const LAS f32x4*)(r4_ + 704), b3 = *(const LAS f32x4*)(r4_ + 768), d3 = *(const LAS f32x4*)(r4_ + 832), q3 = *(const LAS f32x4*)(r4_ + 896); \
        const f32x4 kk4 = *(const LAS f32x4*)(r4_ + 960), w4 = *(const LAS f32x4*)(r4_ + 1024), b4 = *(const LAS f32x4*)(r4_ + 1088), d4 = *(const LAS f32x4*)(r4_ + 1152), q4 = *(const LAS f32x4*)(r4_ + 1216); \
        const f32x4 W02 = w1 * w2, W03 = W02 * w3, W04 = W03 * w4, W13 = w2 * w3, W14 = W13 * w4, W24 = w3 * w4; \
        float s8_[8]; \
        if (part_ == 0) { \
            *(LAS f32x4*)(gi_ + c4_) = kk1; *(LAS f32x4*)(gi_ + 64 + c4_) = w1 * kk2; *(LAS f32x4*)(gi_ + 128 + c4_) = W02 * kk3; *(LAS f32x4*)(gi_ + 192 + c4_) = W03 * kk4; \
            *(LAS f32x4*)(gi_ + 256 + c4_) = w1 * q1; *(LAS f32x4*)(gi_ + 320 + c4_) = W02 * q2; *(LAS f32x4*)(gi_ + 384 + c4_) = W03 * q3; *(LAS f32x4*)(gi_ + 448 + c4_) = W04 * q4; \
            const f32x4 d1w2 = d1 * w2, d1w13 = d1 * W13, d2w3 = d2 * w3, b1w2 = b1 * w2; \
            s8_[0] = DOT16(d1, kk2); s8_[1] = DOT16(d1w2, kk3); s8_[2] = DOT16(d2, kk3); s8_[3] = DOT16(d1w13, kk4); s8_[4] = DOT16(d2w3, kk4); s8_[5] = DOT16(d3, kk4); s8_[6] = DOT16(b1, kk2); s8_[7] = DOT16(b1w2, kk3); \
        } else if (part_ == 1) { \
            *(LAS f32x4*)(gi_ + 512 + c4_) = d1 * W14; *(LAS f32x4*)(gi_ + 576 + c4_) = d2 * W24; *(LAS f32x4*)(gi_ + 640 + c4_) = d3 * w4; *(LAS f32x4*)(gi_ + 704 + c4_) = d4; \
            const f32x4 b1w13 = b1 * W13, b2w3 = b2 * w3, d1w2 = d1 * w2, d1w13 = d1 * W13; \
            s8_[0] = DOT16(b2, kk3); s8_[1] = DOT16(b1w13, kk4); s8_[2] = DOT16(b2w3, kk4); s8_[3] = DOT16(b3, kk4); s8_[4] = DOT16(d1, q1); s8_[5] = DOT16(d1w2, q2); s8_[6] = DOT16(d2, q2); s8_[7] = DOT16(d1w13, q3); \
        } else if (part_ == 2) { \
            *(LAS f32x4*)(gi_ + 768 + c4_) = b1 * W14; *(LAS f32x4*)(gi_ + 832 + c4_) = b2 * W24; *(LAS f32x4*)(gi_ + 896 + c4_) = b3 * w4; *(LAS f32x4*)(gi_ + 960 + c4_) = b4; \
            *(LAS f32x4*)(gi_ + 1024 + c4_) = W04; \
            const f32x4 d2w3 = d2 * w3, d1w14 = d1 * W14, d2w24 = d2 * W24, d3w4 = d3 * w4, b1w2 = b1 * w2; \
            s8_[0] = DOT16(d2w3, q3); s8_[1] = DOT16(d3, q3); s8_[2] = DOT16(d1w14, q4); s8_[3] = DOT16(d2w24, q4); s8_[4] = DOT16(d3w4, q4); s8_[5] = DOT16(d4, q4); s8_[6] = DOT16(b1, q1); s8_[7] = DOT16(b1w2, q2); \
        } else { \
            const f32x4 b1w13 = b1 * W13, b2w3 = b2 * w3, b1w14 = b1 * W14, b2w24 = b2 * W24, b3w4 = b3 * w4; \
            s8_[0] = DOT16(b2, q2); s8_[1] = DOT16(b1w13, q3); s8_[2] = DOT16(b2w3, q3); s8_[3] = DOT16(b3, q3); s8_[4] = DOT16(b1w14, q4); s8_[5] = DOT16(b2w24, q4); s8_[6] = DOT16(b3w4, q4); s8_[7] = DOT16(b4, q4); \
        } \
        if (cgi == 0) *(LAS f32x4*)(gi_ + 1344 + 8 * part_) = (f32x4){s8_[0], s8_[1], s8_[2], s8_[3]}; \
        if (cgi == 1) *(LAS f32x4*)(gi_ + 1348 + 8 * part_) = (f32x4){s8_[4], s8_[5], s8_[6], s8_[7]}; \
    } while (0)
    __syncthreads();
    RW_LOAD(0); RW_PREP1(0, 0);
    __syncthreads();
    RW_PREP2(0);
    __syncthreads();
#pragma unroll 1
    for (int blk = 0; blk < nblk; ++blk) {
        const int bi = blk & 1;
        if (blk + 1 < nblk) RW_LOAD(blk + 1);
        LAS float* yb = ybR + bi * T * 64;
#pragma unroll 1
        for (int g = 0; g < NG; ++g) {
            const LAS float* gi = grp + (bi * NG + g) * GS;
            float dp[4], du[4];
#pragma unroll
            for (int t = 0; t < 4; ++t) {
                const f32x4 pa = *(const LAS f32x4*)(gi + t * 64 + q * 8), pb = *(const LAS f32x4*)(gi + t * 64 + q * 8 + 4);
                const f32x4 ua = *(const LAS f32x4*)(gi + 256 + t * 64 + q * 8), ub = *(const LAS f32x4*)(gi + 256 + t * 64 + q * 8 + 4);
                const f32x2 a = __builtin_elementwise_fma(S[0], (f32x2){pa.x, pa.y}, S[1] * (f32x2){pa.z, pa.w}) + __builtin_elementwise_fma(S[2], (f32x2){pb.x, pb.y}, S[3] * (f32x2){pb.z, pb.w});
                const f32x2 c = __builtin_elementwise_fma(S[0], (f32x2){ua.x, ua.y}, S[1] * (f32x2){ua.z, ua.w}) + __builtin_elementwise_fma(S[2], (f32x2){ub.x, ub.y}, S[3] * (f32x2){ub.z, ub.w});
                dp[t] = a.x + a.y; du[t] = c.x + c.y;
            }
#pragma unroll
            for (int t = 0; t < 4; ++t) { dp[t] = red8(dp[t]); du[t] = red8(du[t]); }
            const float v1 = gi[1088 + r0], v2 = gi[1152 + r0], v3 = gi[1216 + r0], v4 = gi[1280 + r0];
            const f32x4 A0 = *(const LAS f32x4*)(gi + 1344), A1 = *(const LAS f32x4*)(gi + 1348), B0 = *(const LAS f32x4*)(gi + 1352), E0 = *(const LAS f32x4*)(gi + 1356);
            const f32x4 E1 = *(const LAS f32x4*)(gi + 1360), E2 = *(const LAS f32x4*)(gi + 1364), F0 = *(const LAS f32x4*)(gi + 1368), F1 = *(const LAS f32x4*)(gi + 1372);
            const float g1 = dp[0];
            const float g2 = dp[1] + v1 * A0.x - g1 * A1.z;
            const float g3 = dp[2] + v1 * A0.y + v2 * A0.z - g1 * A1.w - g2 * B0.x;
            const float g4 = dp[3] + v1 * A0.w + v2 * A1.x + v3 * A1.y - g1 * B0.y - g2 * B0.z - g3 * B0.w;
            const float y1 = du[0] + v1 * E0.x - g1 * E2.z;
            const float y2 = du[1] + v1 * E0.y + v2 * E0.z - g1 * E2.w - g2 * F0.x;
            const float y3 = du[2] + v1 * E0.w + v2 * E1.x + v3 * E1.y - g1 * F0.y - g2 * F0.z - g3 * F0.w;
            const float y4 = du[3] + v1 * E1.z + v2 * E1.w + v3 * E2.x + v4 * E2.y - g1 * F1.x - g2 * F1.y - g3 * F1.z - g4 * F1.w;
            if (q == 0) { yb[(4 * g) * 64 + r0] = y1; yb[(4 * g + 1) * 64 + r0] = y2; yb[(4 * g + 2) * 64 + r0] = y3; yb[(4 * g + 3) * 64 + r0] = y4; }
            {
                const f32x4 wa = *(const LAS f32x4*)(gi + 1024 + q * 8), wb = *(const LAS f32x4*)(gi + 1024 + q * 8 + 4);
                f32x2 n0 = S[0] * (f32x2){wa.x, wa.y}, n1 = S[1] * (f32x2){wa.z, wa.w}, n2 = S[2] * (f32x2){wb.x, wb.y}, n3 = S[3] * (f32x2){wb.z, wb.w};
                const float vv[4] = {v1, v2, v3, v4}, gg[4] = {g1, g2, g3, g4};
#pragma unroll
                for (int j = 0; j < 4; ++j) {
                    const f32x4 da = *(const LAS f32x4*)(gi + 512 + j * 64 + q * 8), db = *(const LAS f32x4*)(gi + 512 + j * 64 + q * 8 + 4);
                    const f32x4 ba = *(const LAS f32x4*)(gi + 768 + j * 64 + q * 8), bb = *(const LAS f32x4*)(gi + 768 + j * 64 + q * 8 + 4);
                    const f32x2 vj = {vv[j], vv[j]}, ng = {-gg[j], -gg[j]};
                    n0 = __builtin_elementwise_fma(vj, (f32x2){da.x, da.y}, n0); n1 = __builtin_elementwise_fma(vj, (f32x2){da.z, da.w}, n1);
                    n2 = __builtin_elementwise_fma(vj, (f32x2){db.x, db.y}, n2); n3 = __builtin_elementwise_fma(vj, (f32x2){db.z, db.w}, n3);
                    n0 = __builtin_elementwise_fma(ng, (f32x2){ba.x, ba.y}, n0); n1 = __builtin_elementwise_fma(ng, (f32x2){ba.z, ba.w}, n1);
                    n2 = __builtin_elementwise_fma(ng, (f32x2){bb.x, bb.y}, n2); n3 = __builtin_elementwise_fma(ng, (f32x2){bb.z, bb.w}, n3);
                }
                S[0] = n0; S[1] = n1; S[2] = n2; S[3] = n3;
            }
        }
        if (blk + 1 < nblk) RW_PREP1(bi ^ 1, blk + 1);
        __syncthreads();
        if (blk + 1 < nblk) RW_PREP2(bi ^ 1);
        {
            const int r4 = cgi * 4, n = blk * T + tt, tk = dir ? L - 1 - n : n;
            const f32x4 yv = *(const LAS f32x4*)(yb + tt * 64 + r4);
            *(u32x2*)(Y + (size_t)(rowbase + tk) * 1024 + colbase + r4) = pk4(yv);
        }
        __syncthreads();
    }
#undef RW_LOAD
#undef RW_PREP1
#undef RW_PREP2
#undef DOT16
    if (!kind) { float* so = p.out + OUT_SRW + (((size_t)b * 2 + dir) * 8 + head) * 4096 + q * 8;
        *(f32x4*)(so + r0 * 64) = (f32x4){S[0].x, S[0].y, S[1].x, S[1].y}; *(f32x4*)(so + r0 * 64 + 4) = (f32x4){S[2].x, S[2].y, S[3].x, S[3].y}; }
}

__device__ __forceinline__ void gdn_item(const P& p, LAS unsigned char* lds, int kind, int b, int head, int dir) {
    LAS bf16* Qs = (LAS bf16*)(lds);
    LAS bf16* Ks = (LAS bf16*)(lds + 17408);
    LAS bf16* KT = (LAS bf16*)(lds + 34816);
    LAS bf16* VT = (LAS bf16*)(lds + 53248);
    LAS bf16* ST = (LAS bf16*)(lds + 62464);
    LAS float* Lm = (LAS float*)(lds + 79872);
    LAS bf16* vnT = (LAS bf16*)(lds + 79872);
    LAS bf16* vnsT = (LAS bf16*)(lds + 79872 + 9216);
    LAS float* Tm = (LAS float*)(lds + 98304);
    LAS bf16* Tb = (LAS bf16*)(lds + 115712);
    LAS bf16* QKg = (LAS bf16*)(lds + 124928);
    LAS bf16* rT = (LAS bf16*)(lds + 134144);
    LAS float* gs = (LAS float*)(lds + 143360);
    LAS float* bs = gs + 64;
    LAS float* Gs = gs + 128;
    LAS float* eGs = gs + 192;
    LAS float* eGl = gs + 256;
    LAS float* misc = gs + 320;
    LAS float* CW = (LAS float*)(lds + 144896);
    LAS float* Ysc = (LAS float*)(lds + 149504);
    const int tid = tid_opaque(), lane = tid & 63, wave = tid >> 6, ln = lane & 15, h4 = lane >> 4;
    const int L = kind ? 1024 : 256, nch = L / 64, rowbase = kind ? MP + b * 1024 : b * 256;
    const bf16* p0 = (const bf16*)(p.ws + WS_R1);
    bf16* Y = (bf16*)(p.ws + (dir == 0 ? WS_MIX : WS_H));
    const int colbase = 512 + head * 128;
    const int pi = tid >> 3, c8 = tid & 7;
    const float gA = -expf(p.in[31][dir * 4 + head]), gB = p.in[32][dir * 4 + head];
    __syncthreads();
    for (int e = tid; e < 1152; e += NTHREADS) {
        const int part = e / 384, r = e % 384, tap = r >> 7, d = r & 127;
        CW[e] = p.in[30][tap * 1536 + part * 512 + head * 128 + d];
    }
    for (int e = tid; e < 64 * 72 / 2; e += NTHREADS) { ((LAS unsigned*)Tb)[e] = 0u; ((LAS unsigned*)QKg)[e] = 0u; }
    f32x4 accS[2][4];
#pragma unroll
    for (int hf = 0; hf < 2; ++hf)
#pragma unroll
        for (int vt = 0; vt < 4; ++vt) {
            accS[hf][vt] = (f32x4){0.f, 0.f, 0.f, 0.f};
            if (kind) { const float* s0 = p.in[3] + (((size_t)b * 2 + dir) * 4 + head) * 16384 + (wave * 16 + h4 * 4) * 128 + ln;
#pragma unroll
                for (int r = 0; r < 4; ++r) accS[hf][vt][r] = s0[r * 128 + hf * 64 + vt * 16]; }
        }
#pragma unroll
    for (int vt = 0; vt < 4; ++vt) *(LAS u32x2*)(ST + (vt * 16 + ln) * 136 + wave * 16 + h4 * 4) = pk4(accS[0][vt]);
    u32x4 rq[3][2], rk[3][2], rv[2][3]; unsigned rab = 0u, rbb = 0u;
    const u32x4 z4 = {0u, 0u, 0u, 0u};
#define GD_LOAD(n) do { \
        const int i_ = (n) * 64 + pi, t_ = dir ? L - 1 - i_ : i_; const size_t row_ = (size_t)(rowbase + t_); \
        const bf16* pr_ = p0 + row_ * LDP0 + 1920 + head * 128 + c8 * 16; \
        const bf16* pv_ = p0 + row_ * LDP0 + 1920 + 1024 + head * 128 + c8 * 8; \
        _Pragma("unroll") for (int j_ = 0; j_ < 3; ++j_) { \
            const bool ok_ = (j_ == 1) || (j_ == 0 ? t_ > 0 : t_ < L - 1); const long o_ = (long)(j_ - 1) * LDP0; \
            rq[j_][0] = ok_ ? *(const u32x4*)(pr_ + o_) : z4; rq[j_][1] = ok_ ? *(const u32x4*)(pr_ + o_ + 8) : z4; \
            rk[j_][0] = ok_ ? *(const u32x4*)(pr_ + o_ + 512) : z4; rk[j_][1] = ok_ ? *(const u32x4*)(pr_ + o_ + 520) : z4; \
            rv[0][j_] = ok_ ? *(const u32x4*)(pv_ + o_) : z4; rv[1][j_] = ok_ ? *(const u32x4*)(pv_ + o_ + 64) : z4; } \
        if (wave == 0) { const int iw_ = (n) * 64 + lane, tw_ = dir ? L - 1 - iw_ : iw_; const size_t rw_ = (size_t)(rowbase + tw_); \
            rab = p0[rw_ * LDP0 + 3968 + dir * 8 + head]; rbb = p0[rw_ * LDP0 + 3968 + dir * 8 + 4 + head]; } \
    } while (0)
    GD_LOAD(0);
    __syncthreads();
#pragma unroll 1
    for (int n = 0; n < nch; ++n) {
        int lane_c = lane; asm volatile("" : "+v"(lane_c));
        const int ln = lane_c & 15, h4 = lane_c >> 4;
        const int pis = (((pi >> 3) ^ c8) << 3) | (pi & 7);
        unsigned v1p[4];
        {
            {
                float xq[16]; float sq = 0.f;
#pragma unroll
                for (int e = 0; e < 16; ++e) { const int d = c8 * 16 + e; const int wi = e >> 1, hi = e & 1, vi = wi >> 2, ci = wi & 3;
                    const float q0 = hi ? bfhi(rq[0][vi][ci]) : bflo(rq[0][vi][ci]), q1 = hi ? bfhi(rq[1][vi][ci]) : bflo(rq[1][vi][ci]), q2 = hi ? bfhi(rq[2][vi][ci]) : bflo(rq[2][vi][ci]);
                    const float a = CW[d] * q0 + CW[128 + d] * q1 + CW[256 + d] * q2;
                    xq[e] = siluf_(a); sq += xq[e] * xq[e]; }
                sq = red8(sq);
                const float nq = 0.08838834764831845f * rsqrtf_(sq + 1e-6f);
                u32x4 w0, w1;
                w0.x = pk2(xq[0] * nq, xq[1] * nq); w0.y = pk2(xq[2] * nq, xq[3] * nq); w0.z = pk2(xq[4] * nq, xq[5] * nq); w0.w = pk2(xq[6] * nq, xq[7] * nq);
                w1.x = pk2(xq[8] * nq, xq[9] * nq); w1.y = pk2(xq[10] * nq, xq[11] * nq); w1.z = pk2(xq[12] * nq, xq[13] * nq); w1.w = pk2(xq[14] * nq, xq[15] * nq);
                *(LAS u32x4*)(Qs + pi * 136 + c8 * 16) = w0; *(LAS u32x4*)(Qs + pi * 136 + c8 * 16 + 8) = w1;
            }
            {
                float xk[16]; float sk = 0.f;
#pragma unroll
                for (int e = 0; e < 16; ++e) { const int d = c8 * 16 + e; const int wi = e >> 1, hi = e & 1, vi = wi >> 2, ci = wi & 3;
                    const float k0 = hi ? bfhi(rk[0][vi][ci]) : bflo(rk[0][vi][ci]), k1 = hi ? bfhi(rk[1][vi][ci]) : bflo(rk[1][vi][ci]), k2 = hi ? bfhi(rk[2][vi][ci]) : bflo(rk[2][vi][ci]);
                    const float c = CW[384 + d] * k0 + CW[512 + d] * k1 + CW[640 + d] * k2;
                    xk[e] = siluf_(c); sk += xk[e] * xk[e]; }
                sk = red8(sk);
                const float nk = rsqrtf_(sk + 1e-6f);
                u32x4 w0, w1;
                w0.x = pk2(xk[0] * nk, xk[1] * nk); w0.y = pk2(xk[2] * nk, xk[3] * nk); w0.z = pk2(xk[4] * nk, xk[5] * nk); w0.w = pk2(xk[6] * nk, xk[7] * nk);
                w1.x = pk2(xk[8] * nk, xk[9] * nk); w1.y = pk2(xk[10] * nk, xk[11] * nk); w1.z = pk2(xk[12] * nk, xk[13] * nk); w1.w = pk2(xk[14] * nk, xk[15] * nk);
                *(LAS u32x4*)(Ks + pi * 136 + c8 * 16) = w0; *(LAS u32x4*)(Ks + pi * 136 + c8 * 16 + 8) = w1;
#pragma unroll
                for (int e = 0; e < 4; ++e) {
                    KT[(c8 * 16 + 2 * e) * 72 + pis] = (bf16)(w0[e] & 0xffffu); KT[(c8 * 16 + 2 * e + 1) * 72 + pis] = (bf16)(w0[e] >> 16);
                    KT[(c8 * 16 + 8 + 2 * e) * 72 + pis] = (bf16)(w1[e] & 0xffffu); KT[(c8 * 16 + 8 + 2 * e + 1) * 72 + pis] = (bf16)(w1[e] >> 16); }
            }
#pragma unroll
            for (int hf = 0; hf < 2; ++hf) {
                float xv[8];
#pragma unroll
                for (int e = 0; e < 8; ++e) { const int c = hf * 64 + c8 * 8 + e; const int wi = e >> 1, hi = e & 1;
                    const float v0 = hi ? bfhi(rv[hf][0][wi]) : bflo(rv[hf][0][wi]), v1 = hi ? bfhi(rv[hf][1][wi]) : bflo(rv[hf][1][wi]), v2 = hi ? bfhi(rv[hf][2][wi]) : bflo(rv[hf][2][wi]);
                    xv[e] = siluf_(CW[768 + c] * v0 + CW[896 + c] * v1 + CW[1024 + c] * v2); }
                if (hf == 0) {
#pragma unroll
                    for (int e = 0; e < 8; ++e) VT[(c8 * 8 + e) * 72 + pis] = (bf16)(pk2(xv[e], 0.f) & 0xffffu);
                } else {
#pragma unroll
                    for (int e = 0; e < 4; ++e) v1p[e] = pk2(xv[2 * e], xv[2 * e + 1]);
                }
            }
            if (wave == 0) {
                const float xa = bf2f(rab) + gB; const float sp = xa > 20.f ? xa : __logf(1.0f + __expf(xa));
                float x = gA * sp;
                gs[lane] = x; bs[lane] = sigmoidf_(bf2f(rbb));
                x += DPPF(x, 0x111); x += DPPF(x, 0x112); x += DPPF(x, 0x114); x += DPPF(x, 0x118);
                const int xi = __float_as_int(x);
                const float t0 = __int_as_float(__builtin_amdgcn_readlane(xi, 15)), t1 = __int_as_float(__builtin_amdgcn_readlane(xi, 31)), t2 = __int_as_float(__builtin_amdgcn_readlane(xi, 47));
                x += (lane >= 48) ? (t0 + t1 + t2) : ((lane >= 32) ? (t0 + t1) : ((lane >= 16) ? t0 : 0.f));
                const float Gl = __int_as_float(__builtin_amdgcn_readlane(__float_as_int(x), 63));
                Gs[lane] = x; eGs[lane] = __expf(x); eGl[lane] = __expf(Gl - x); if (lane == 0) misc[0] = __expf(Gl);
            }
        }
        __syncthreads();
#pragma unroll 1
        for (int tix = wave; tix < 20; tix += 8) {
            const int x = tix < 10 ? tix : tix - 10;
            const int it = x >= 6 ? 3 : (x >= 3 ? 2 : (x >= 1 ? 1 : 0)), jt = x - (it * (it + 1)) / 2;
            f32x4 a = {0.f, 0.f, 0.f, 0.f};
            if (tix < 10) {
#pragma unroll
                for (int s = 0; s < 4; ++s) a = __builtin_amdgcn_mfma_f32_16x16x32_bf16(*(const LAS s16x8*)(Ks + (16 * it + ln) * 136 + 32 * s + 8 * h4), *(const LAS s16x8*)(Ks + (16 * jt + ln) * 136 + 32 * s + 8 * h4), a, 0, 0, 0);
                const int j = 16 * jt + ln; const float Gj = Gs[j];
#pragma unroll
                for (int r = 0; r < 4; ++r) { const int i = 16 * it + 4 * h4 + r; Lm[i * 72 + j] = i > j ? bs[i] * a[r] * __expf(Gs[i] - Gj) : 0.f; }
            } else {
#pragma unroll
                for (int s = 0; s < 4; ++s) a = __builtin_amdgcn_mfma_f32_16x16x32_bf16(*(const LAS s16x8*)(Ks + (16 * jt + ln) * 136 + 32 * s + 8 * h4), *(const LAS s16x8*)(Qs + (16 * it + ln) * 136 + 32 * s + 8 * h4), a, 0, 0, 0);
                const int i = 16 * it + ln; const float Gi = Gs[i]; f32x4 o;
#pragma unroll
                for (int r = 0; r < 4; ++r) { const int j = 16 * jt + 4 * h4 + r; o[r] = i >= j ? a[r] * __expf(Gi - Gs[j]) : 0.f; }
                *(LAS u32x2*)(QKg + i * 72 + 16 * jt + 4 * h4) = pk4(o);
            }
        }
        __syncthreads();
        if (wave == 0) {
            const int a = h4; int c = ln; asm volatile("" : "+v"(c)); float xr[16];
#pragma unroll
            for (int r = 0; r < 16; ++r) { float s = (r == c) ? 1.0f : 0.0f;
#pragma unroll
                for (int m = 0; m < r; ++m) s -= Lm[(16 * a + r) * 72 + 16 * a + m] * xr[m];
                xr[r] = s; }
#pragma unroll
            for (int r = 0; r < 16; ++r) { Tm[(16 * a + r) * 68 + 16 * a + c] = xr[r]; Tb[(16 * a + r) * 72 + 16 * a + c] = (bf16)(pk2(xr[r], 0.f) & 0xffffu); }
        } else {
#pragma unroll 1
            for (int tk = wave - 1; tk < 16; tk += 7) {
                const int it = tk >> 2, vt = tk & 3; f32x4 a = {0.f, 0.f, 0.f, 0.f};
#pragma unroll
                for (int s = 0; s < 4; ++s) a = __builtin_amdgcn_mfma_f32_16x16x32_bf16(*(const LAS s16x8*)(Ks + (16 * it + ln) * 136 + 32 * s + 8 * h4), *(const LAS s16x8*)(ST + (16 * vt + ln) * 136 + 32 * s + 8 * h4), a, 0, 0, 0);
                const int v = 16 * vt + ln, i0 = 16 * it + 4 * h4;
                const f32x4 vj = unpk4(*(const LAS u32x2*)(VT + v * 72 + ((((i0 >> 3) ^ (v >> 3)) & 7) << 3) + (i0 & 7))), be = *(const LAS f32x4*)(bs + i0), eg = *(const LAS f32x4*)(eGs + i0);
                *(LAS u32x2*)(rT + v * 72 + i0) = pk4(be * (vj - eg * a));
            }
        }
        __syncthreads();
#pragma unroll 1
        for (int dist = 1; dist < 4; ++dist) {
            if (wave < 4 - dist) {
                const int bb = wave, aa = wave + dist; LAS float* ys = Ysc + wave * 272;
                f32x4 y = {0.f, 0.f, 0.f, 0.f};
                float la[3][4], tb[3][4];
#pragma unroll
                for (int mm = 0; mm < 3; ++mm)
#pragma unroll
                    for (int s = 0; s < 4; ++s) { const int m = bb + (mm < dist ? mm : 0);
                        la[mm][s] = Lm[(16 * aa + ln) * 72 + 16 * m + 4 * s + h4]; tb[mm][s] = Tm[(16 * m + 4 * s + h4) * 68 + 16 * bb + ln]; }
#pragma unroll
                for (int mm = 0; mm < 3; ++mm)
                    if (mm < dist) {
#pragma unroll
                        for (int s = 0; s < 4; ++s) y = __builtin_amdgcn_mfma_f32_16x16x4f32(la[mm][s], tb[mm][s], y, 0, 0, 0); }
#pragma unroll
                for (int r = 0; r < 4; ++r) ys[(4 * h4 + r) * 17 + ln] = y[r];
                f32x4 z = {0.f, 0.f, 0.f, 0.f};
#pragma unroll
                for (int s = 0; s < 4; ++s) z = __builtin_amdgcn_mfma_f32_16x16x4f32(Tm[(16 * aa + ln) * 68 + 16 * aa + 4 * s + h4], ys[(4 * s + h4) * 17 + ln], z, 0, 0, 0);
#pragma unroll
                for (int r = 0; r < 4; ++r) { const int i = 16 * aa + 4 * h4 + r, j = 16 * bb + ln; Tm[i * 68 + j] = -z[r]; Tb[i * 72 + j] = (bf16)(pk2(-z[r], 0.f) & 0xffffu); }
            }
            __syncthreads();
        }
#define GD_P3() do { \
        _Pragma("unroll") for (int u = 0; u < 2; ++u) { \
            const int tile = 2 * wave + u, it = tile >> 2, vt = tile & 3; f32x4 a = {0.f, 0.f, 0.f, 0.f}; \
            a = __builtin_amdgcn_mfma_f32_16x16x32_bf16(*(const LAS s16x8*)(Tb + (16 * it + ln) * 72 + 8 * h4), *(const LAS s16x8*)(rT + (16 * vt + ln) * 72 + 8 * h4), a, 0, 0, 0); \
            if (it >= 2) a = __builtin_amdgcn_mfma_f32_16x16x32_bf16(*(const LAS s16x8*)(Tb + (16 * it + ln) * 72 + 32 + 8 * h4), *(const LAS s16x8*)(rT + (16 * vt + ln) * 72 + 32 + 8 * h4), a, 0, 0, 0); \
            const int v = 16 * vt + ln, i0 = 16 * it + 4 * h4; \
            *(LAS u32x2*)(vnT + v * 72 + i0) = pk4(a); *(LAS u32x2*)(vnsT + v * 72 + i0) = pk4(a * *(const LAS f32x4*)(eGl + i0)); \
        } } while (0)
#define GD_P4(HF) do { \
        _Pragma("unroll") for (int u = 0; u < 2; ++u) { \
            const int tile = 2 * wave + u, vt = tile >> 2, it = tile & 3; f32x4 a = {0.f, 0.f, 0.f, 0.f}; \
            _Pragma("unroll") for (int s = 0; s < 4; ++s) a = __builtin_amdgcn_mfma_f32_16x16x32_bf16(*(const LAS s16x8*)(ST + (16 * vt + ln) * 136 + 32 * s + 8 * h4), *(const LAS s16x8*)(Qs + (16 * it + ln) * 136 + 32 * s + 8 * h4), a, 0, 0, 0); \
            a = a * eGs[16 * it + ln]; \
            a = __builtin_amdgcn_mfma_f32_16x16x32_bf16(*(const LAS s16x8*)(vnT + (16 * vt + ln) * 72 + 8 * h4), *(const LAS s16x8*)(QKg + (16 * it + ln) * 72 + 8 * h4), a, 0, 0, 0); \
            if (it >= 2) a = __builtin_amdgcn_mfma_f32_16x16x32_bf16(*(const LAS s16x8*)(vnT + (16 * vt + ln) * 72 + 32 + 8 * h4), *(const LAS s16x8*)(QKg + (16 * it + ln) * 72 + 32 + 8 * h4), a, 0, 0, 0); \
            const int ic = n * 64 + 16 * it + ln, tk = dir ? L - 1 - ic : ic; \
            *(u32x2*)(Y + (size_t)(rowbase + tk) * 1024 + colbase + (HF) * 64 + 16 * vt + 4 * h4) = pk4(a); \
        } \
        { const float egl = misc[0]; \
            _Pragma("unroll") for (int vt = 0; vt < 4; ++vt) { \
                f32x4 a = accS[HF][vt] * egl; \
                _Pragma("unroll") for (int s = 0; s < 2; ++s) a = __builtin_amdgcn_mfma_f32_16x16x32_bf16(*(const LAS s16x8*)(KT + (16 * wave + ln) * 72 + (((4 * s + h4) ^ wave) << 3)), *(const LAS s16x8*)(vnsT + (16 * vt + ln) * 72 + 32 * s + 8 * h4), a, 0, 0, 0); \
                accS[HF][vt] = a; \
            } } } while (0)
        GD_P3();
        __syncthreads();
        GD_P4(0);
        __syncthreads();
#pragma unroll
        for (int vt = 0; vt < 4; ++vt) *(LAS u32x2*)(ST + (vt * 16 + ln) * 136 + wave * 16 + h4 * 4) = pk4(accS[1][vt]);
#pragma unroll
        for (int e = 0; e < 4; ++e) { VT[(c8 * 8 + 2 * e) * 72 + pis] = (bf16)(v1p[e] & 0xffffu); VT[(c8 * 8 + 2 * e + 1) * 72 + pis] = (bf16)(v1p[e] >> 16); }
        __syncthreads();
#pragma unroll 1
        for (int tk = wave; tk < 16; tk += 8) {
            const int it = tk >> 2, vt = tk & 3; f32x4 a = {0.f, 0.f, 0.f, 0.f};
#pragma unroll
            for (int s = 0; s < 4; ++s) a = __builtin_amdgcn_mfma_f32_16x16x32_bf16(*(const LAS s16x8*)(Ks + (16 * it + ln) * 136 + 32 * s + 8 * h4), *(const LAS s16x8*)(ST + (16 * vt + ln) * 136 + 32 * s + 8 * h4), a, 0, 0, 0);
            const int v = 16 * vt + ln, i0 = 16 * it + 4 * h4;
            const f32x4 vj = unpk4(*(const LAS u32x2*)(VT + v * 72 + ((((i0 >> 3) ^ (v >> 3)) & 7) << 3) + (i0 & 7))), be = *(const LAS f32x4*)(bs + i0), eg = *(const LAS f32x4*)(eGs + i0);
            *(LAS u32x2*)(rT + v * 72 + i0) = pk4(be * (vj - eg * a));
        }
        __syncthreads();
        if (n + 1 < nch) GD_LOAD(n + 1);
        GD_P3();
        __syncthreads();
        GD_P4(1);
        __syncthreads();
#pragma unroll
        for (int vt = 0; vt < 4; ++vt) *(LAS u32x2*)(ST + (vt * 16 + ln) * 136 + wave * 16 + h4 * 4) = pk4(accS[0][vt]);
#undef GD_P3
#undef GD_P4
    }
#undef GD_LOAD
    if (!kind) { float* so = p.out + OUT_SGD + (((size_t)b * 2 + dir) * 4 + head) * 16384;
#pragma unroll
        for (int hf = 0; hf < 2; ++hf)
#pragma unroll
            for (int vt = 0; vt < 4; ++vt)
#pragma unroll
                for (int r = 0; r < 4; ++r) so[(size_t)(wave * 16 + h4 * 4 + r) * 128 + hf * 64 + vt * 16 + ln] = accS[hf][vt][r]; }
}
__device__ __forceinline__ void rwkv_idx(const P& p, LAS unsigned char* lds, int i) {
    const int kind = i < 128 ? 1 : 0, j = i < 128 ? i : i - 128;
    rwkv_item(p, lds, kind, j >> 4, (j >> 1) & 7, j & 1);
}
__device__ __forceinline__ void gdn_idx(const P& p, LAS unsigned char* lds, int i) {
    const int kind = i < 64 ? 1 : 0, j = i < 64 ? i : i - 64;
    gdn_item(p, lds, kind, j >> 3, (j >> 1) & 3, j & 1);
}
__device__ __forceinline__ void ph_scan(const P& p, LAS unsigned char* lds) {
    int B = blockIdx.x; const int G = gridDim.x;
    asm volatile("" : "+s"(B));
#pragma unroll 1
    for (int s = 0; s < 640; ++s) {
        int r = -1, g = -1; bool more = true;
        if (G == 256) {
            if (B < 64) { if (s == 0) r = B; else g = 64 + 2 * B + (s - 1); more = s < 2; }
            else if (B < 128) { if (s == 0) r = B; else if (s == 1) g = 192 + (B - 64); else r = 576 + (B - 64); more = s < 2; }
            else if (B < 192) { if (s == 0) g = B - 128; else r = 128 + 2 * (B - 128) + (s - 1); more = s < 2; }
            else { if (s < 5) r = 256 + 5 * (B - 192) + s; else g = 256 + (B - 192); more = s < 5; }
        } else {
            const int i = B + s * G; if (i < 640) r = i; if (i < 320) g = i; more = i + G < 640;
        }
        if (r >= 0) rwkv_idx(p, lds, r);
        if (g >= 0) gdn_idx(p, lds, g);
        if (!more) break;
    }
}

__device__ __forceinline__ void ph_post_ab(const P& p, bool dummy) {
    const int tid = tid_opaque(), lane = tid & 63, wave = tid >> 6;
    const bf16* p0 = (const bf16*)(p.ws + WS_R1); const bf16* lo = (const bf16*)(p.ws + WS_R2);
    bf16* MX = (bf16*)(p.ws + WS_MIX); const bf16* YB = (const bf16*)(p.ws + WS_H);
    bf16* MO = dummy ? (bf16*)(p.out + OUT_CKV) : MX;
    const int C = lane * 8;
    const float* bonp = (const float*)(p.ws + WS_BON);
    float muv[8], lw[8], lb[8], gn[8];
#pragma unroll
    for (int i = 0; i < 8; ++i) { muv[i] = p.in[19][1024 + C + i];
        lw[i] = p.in[28][C + i]; lb[i] = p.in[29][C + i]; gn[i] = p.in[33][(C + i) & 127]; }
    const int nw = gridDim.x * 8;
    const u32x4 z4 = {0u, 0u, 0u, 0u};
    for (int row0 = blockIdx.x * 8 + wave; row0 < M_TOK; row0 += 2 * nw) {
        u32x4 vc[2], va[2], vn[2], gg[2], yf[2], yb[2], of[2], ob[2], zz[2]; f32x2 bfb[2];
#pragma unroll
        for (int r = 0; r < 2; ++r) {
            const int row = (row0 + r * nw) < M_TOK ? (row0 + r * nw) : (M_TOK - 1);
            const int t = row < MP ? (row & 255) : ((row - MP) & 1023), L = row < MP ? 256 : 1024;
            const bool hp = t > 0, hn = t < L - 1;
            const bf16* pr = p0 + (size_t)row * LDP0 + C;
            vc[r] = *(const u32x4*)(pr + 1024); va[r] = hp ? *(const u32x4*)(pr + 1024 - LDP0) : z4; vn[r] = hn ? *(const u32x4*)(pr + 1024 + LDP0) : z4;
            gg[r] = *(const u32x4*)(lo + (size_t)row * 2560 + 2048 + C);
            bfb[r] = *(const f32x2*)(bonp + (size_t)row * 16 + (lane >> 3) * 2);
            yf[r] = *(const u32x4*)(MX + (size_t)row * 1024 + C); yb[r] = *(const u32x4*)(YB + (size_t)row * 1024 + C);
            of[r] = *(const u32x4*)(MX + (size_t)row * 1024 + 512 + C); ob[r] = *(const u32x4*)(YB + (size_t)row * 1024 + 512 + C);
            zz[r] = *(const u32x4*)(pr + 1920 + 1536);
        }
#pragma unroll
        for (int r = 0; r < 2; ++r) {
            const int row = row0 + r * nw; if (row >= M_TOK) break;
            float v[8];
#pragma unroll
            for (int i = 0; i < 4; ++i) { float c0 = bflo(vc[r][i]), c1 = bfhi(vc[r][i]); v[2 * i] = c0 + muv[2 * i] * (0.5f * (bflo(va[r][i]) + bflo(vn[r][i])) - c0); v[2 * i + 1] = c1 + muv[2 * i + 1] * (0.5f * (bfhi(va[r][i]) + bfhi(vn[r][i])) - c1); }
            float y[8], s = 0.f; const float bon = 0.5f * (bfb[r].x + bfb[r].y);
#pragma unroll
            for (int i = 0; i < 4; ++i) { y[2 * i] = bflo(yf[r][i]) + bflo(yb[r][i]); y[2 * i + 1] = bfhi(yf[r][i]) + bfhi(yb[r][i]); s += y[2 * i] + y[2 * i + 1]; }
            const float mean = red8(s) * (1.0f / 64.0f);
            float q2 = 0.f;
#pragma unroll
            for (int i = 0; i < 8; ++i) { y[i] -= mean; q2 += y[i] * y[i]; }
            const float rstd = rsqrtf_(red8(q2) * (1.0f / 64.0f) + 64e-5f);
            u32x4 o;
#pragma unroll
            for (int i = 0; i < 4; ++i) {
                const float o0 = (y[2 * i] * rstd * lw[2 * i] + lb[2 * i] + bon * v[2 * i]) * bflo(gg[r][i]);
                const float o1 = (y[2 * i + 1] * rstd * lw[2 * i + 1] + lb[2 * i + 1] + bon * v[2 * i + 1]) * bfhi(gg[r][i]);
                o[i] = pk2(o0, o1);
            }
            const size_t orow = dummy ? (size_t)(row & 4095) : (size_t)row;
            *(u32x4*)(MO + orow * 1024 + C) = o;
            float og[8], so = 0.f;
#pragma unroll
            for (int i = 0; i < 4; ++i) { og[2 * i] = bflo(of[r][i]) + bflo(ob[r][i]); og[2 * i + 1] = bfhi(of[r][i]) + bfhi(ob[r][i]); so += og[2 * i] * og[2 * i] + og[2 * i + 1] * og[2 * i + 1]; }
            const float rs = rsqrtf_(red16(so) * (1.0f / 128.0f) + 1e-6f);
            u32x4 o2;
#pragma unroll
            for (int i = 0; i < 4; ++i) { const float z0 = bflo(zz[r][i]), z1 = bfhi(zz[r][i]);
                o2[i] = pk2(og[2 * i] * rs * gn[2 * i] * siluf_(z0), og[2 * i + 1] * rs * gn[2 * i + 1] * siluf_(z1)); }
            *(u32x4*)(MO + orow * 1024 + 512 + C) = o2;
        }
    }
}

__device__ __forceinline__ void ph_hyena_filters(const P& p, LAS unsigned char* lds, int rot) {
    LAS float* f0 = (LAS float*)lds;
    LAS float* h1 = f0 + 32 * 36;
    LAS float* h2 = h1 + 32 * 64;
    LAS bf16* stg = (LAS bf16*)(h2 + 64 * 32);
    LAS float* w1s = h2 + 64 * 32 + 8192;
    LAS float* w2s = w1s + 33 * 64;
    const int tid = tid_opaque();
    const float* b1 = p.in[41]; const float* b2 = p.in[43]; const float* w3 = p.in[44]; const float* fr = p.in[45];
    const int vb = ((int)blockIdx.x + (int)gridDim.x - rot % (int)gridDim.x) % (int)gridDim.x;
    __syncthreads();
    if (vb < 160) {
        for (int e = tid; e < 33 * 64; e += NTHREADS) w1s[e] = p.in[40][e];
        for (int e = tid; e < 64 * 64; e += NTHREADS) w2s[e] = p.in[42][e];
    }
    for (int item4 = vb; item4 < 160; item4 += gridDim.x) {
        const int item = item4 >> 2, oo = item4 & 3;
        const int ls = item < 32 ? 1 : 0;
        const int L = ls ? 1024 : 256, t0 = (ls ? item : item - 32) * 32;
        const int o = tid + oo * 512;
        float wreg[16];
#pragma unroll
        for (int f = 0; f < 16; ++f) wreg[f] = w3[f * 2048 + o];
        __syncthreads();
        for (int e = tid; e < 32 * 33; e += NTHREADS) {
            const int pi = e / 33, f = e % 33; const float t = (float)(t0 + pi);
            float v;
            if (f == 0) v = t / (float)(L - 1);
            else { const int bi = (f - 1) & 15; const float band = 1e-4f + (15.0f - 1e-4f) * ((float)bi / 15.0f); const float ang = (6.283185307179586f / (float)L) * t * band; v = f <= 16 ? __cosf(ang) : -__sinf(ang); }
            f0[pi * 36 + f] = v;
        }
        __syncthreads();
        {
            const int j = tid & 63, pq = tid >> 6; const float bj = b1[j], fj = fr[j];
            float sacc[4] = {bj, bj, bj, bj};
#pragma unroll 3
            for (int f = 0; f < 33; ++f) { const float w = w1s[f * 64 + j];
#pragma unroll
                for (int i = 0; i < 4; ++i) sacc[i] += f0[(pq + 8 * i) * 36 + f] * w; }
#pragma unroll
            for (int i = 0; i < 4; ++i) h1[(pq + 8 * i) * 64 + j] = __sinf(fj * sacc[i]);
        }
        __syncthreads();
        {
            const int j = tid & 63, pq = tid >> 6; const float bj = b2[j], fj = fr[64 + j];
            float sacc[4] = {bj, bj, bj, bj};
#pragma unroll 4
            for (int f = 0; f < 64; ++f) { const float w = w2s[f * 64 + j];
#pragma unroll
                for (int i = 0; i < 4; ++i) sacc[i] += h1[(pq + 8 * i) * 64 + f] * w; }
#pragma unroll
            for (int i = 0; i < 4; ++i) h2[j * 32 + pq + 8 * i] = __sinf(fj * sacc[i]);
        }
        __syncthreads();
        bf16* G = (bf16*)(p.ws + (ls ? WS_GFS : WS_GFP));
        {
            const int c = o & 511;
            f32x4 sv[8];
#pragma unroll
            for (int i = 0; i < 8; ++i) sv[i] = (f32x4){0.f, 0.f, 0.f, 0.f};
#pragma unroll
            for (int fq = 0; fq < 4; ++fq) {
                float wn[16];
                if (fq < 3) {
#pragma unroll
                    for (int f = 0; f < 16; ++f) wn[f] = w3[((fq + 1) * 16 + f) * 2048 + o];
                }
#pragma unroll
                for (int f = 0; f < 16; ++f) { const float w = wreg[f]; const LAS f32x4* hp = (const LAS f32x4*)(h2 + (fq * 16 + f) * 32);
#pragma unroll
                    for (int i = 0; i < 8; ++i) sv[i] += hp[i] * w; }
                if (fq < 3) {
#pragma unroll
                    for (int f = 0; f < 16; ++f) wreg[f] = wn[f];
                }
            }
            const float delta = 3.0701134573253944f + (15.350567286626973f - 3.0701134573253944f) * ((float)c / 511.0f);
            const float inv = 1.0f / (float)(L - 1);
#pragma unroll
            for (int i = 0; i < 8; ++i) {
                const float ta = (float)(t0 + 4 * i) * inv, tb = (float)(t0 + 4 * i + 1) * inv, tc = (float)(t0 + 4 * i + 2) * inv, td = (float)(t0 + 4 * i + 3) * inv;
                *(LAS u32x2*)(stg + tid * 32 + 4 * i) = (u32x2){pk2(sv[i].x * __expf(-ta * delta), sv[i].y * __expf(-tb * delta)), pk2(sv[i].z * __expf(-tc * delta), sv[i].w * __expf(-td * delta))};
            }
            __syncthreads();
            const int lane = tid & 63, wv = tid >> 6, pi = lane & 31;
#pragma unroll 4
            for (int r = 0; r < 32; ++r) {
                const int col = wv * 64 + r * 2 + (lane >> 5);
                const int o2 = col + oo * 512, order2 = o2 >> 10, dr2 = (o2 >> 9) & 1, c2 = o2 & 511, t = t0 + pi;
                const bf16 hv = stg[col * 32 + pi];
                bf16* g = G + ((size_t)order2 * 512 + c2) * (2 * L);
                if (dr2 == 0) g[L - t] = hv;
                else if (t > 0) g[L + t] = hv;
                if (dr2 == 0 && t == 0) g[0] = 0;
            }
        }
    }
}

__device__ __forceinline__ void ph_mla_prep(const P& p, LAS unsigned char* lds) {
    const int tid = tid_opaque(), lane = tid & 63, wave = tid >> 6;
    const bf16* p1 = (const bf16*)(p.ws + WS_R1);
    bf16* qn = (bf16*)(p.ws + WS_H); bf16* ckva = (bf16*)(p.ws + WS_CKVA); bf16* kpea = (bf16*)(p.ws + WS_KPEA);
    const float* rope = (const float*)(p.ws + WS_ROPE);
    const float* qg = p.in[35]; const float* kg = p.in[37];
    const int nw = gridDim.x * 8;
    for (int row0 = blockIdx.x * 8 + wave; row0 < M_TOK; row0 += 4 * nw) {
        unsigned qw[4][3], kw[4]; u32x2 vw[4]; float sq[4], sk[4];
#pragma unroll
        for (int r = 0; r < 4; ++r) {
            const int row = (row0 + r * nw) < M_TOK ? (row0 + r * nw) : (M_TOK - 1);
            const bf16* pr = p1 + (size_t)row * LDP1;
#pragma unroll
            for (int j = 0; j < 3; ++j) qw[r][j] = *(const unsigned*)(pr + j * 128 + lane * 2);
            vw[r] = *(const u32x2*)(pr + 384 + lane * 4);
            kw[r] = lane < 16 ? *(const unsigned*)(pr + 640 + lane * 2) : 0u;
        }
#pragma unroll
        for (int r = 0; r < 4; ++r) {
            float s = 0.f;
#pragma unroll
            for (int j = 0; j < 3; ++j) s += bflo(qw[r][j]) * bflo(qw[r][j]) + bfhi(qw[r][j]) * bfhi(qw[r][j]);
            sq[r] = s;
            const f32x4 kv = unpk4(vw[r]); sk[r] = kv.x * kv.x + kv.y * kv.y + kv.z * kv.z + kv.w * kv.w;
        }
#pragma unroll
        for (int o = 1; o < 64; o <<= 1) {
#pragma unroll
            for (int r = 0; r < 4; ++r) { sq[r] += SHFLX(sq[r], o, lane); sk[r] += SHFLX(sk[r], o, lane); } }
#pragma unroll
        for (int r = 0; r < 4; ++r) {
            const int row = row0 + r * nw; if (row >= M_TOK) break;
            const float rq = rsqrtf_(sq[r] * (1.0f / 384.0f) + 1e-6f), rk = rsqrtf_(sk[r] * (1.0f / 256.0f) + 1e-6f);
#pragma unroll
            for (int j = 0; j < 3; ++j) { const int col = j * 128 + lane * 2; *(unsigned*)(qn + (size_t)row * 384 + col) = pk2(bflo(qw[r][j]) * rq * qg[col], bfhi(qw[r][j]) * rq * qg[col + 1]); }
            const f32x4 ck = unpk4(vw[r]) * rk * *(const f32x4*)(kg + lane * 4);
            *(u32x2*)(ckva + (size_t)row * 256 + lane * 4) = pk4(ck);
            if (row < MP) *(f32x4*)(p.out + OUT_CKV + (size_t)row * 256 + lane * 4) = ck;
            if (lane < 16) {
                float x1 = bflo(kw[r]), x2 = bfhi(kw[r]);
                if (row < MP) { *(f32x2*)(p.out + OUT_KPE + (size_t)row * 32 + lane * 2) = (f32x2){x1, x2}; }
                else { const int tq = (row - MP) & 1023; const f32x2 cs = *(const f32x2*)(rope + (size_t)tq * 32 + lane * 2); const float a = x1 * cs.x - x2 * cs.y, bq = x1 * cs.y + x2 * cs.x; x1 = a; x2 = bq; }
                *(unsigned*)(kpea + (size_t)row * 32 + lane * 2) = pk2(x1, x2);
            }
        }
    }
    for (int r2 = blockIdx.x * 8 + wave; r2 < 2048; r2 += nw) {
        const int row = M_TOK + r2;
        const f32x4 cv = *(const f32x4*)(p.in[4] + (size_t)r2 * 256 + lane * 4);
        *(u32x2*)(ckva + (size_t)row * 256 + lane * 4) = pk4(cv);
        if (lane < 16) { const f32x2 kp = *(const f32x2*)(p.in[5] + (size_t)r2 * 32 + lane * 2); *(unsigned*)(kpea + (size_t)row * 32 + lane * 2) = pk2(kp.x, kp.y); }
    }
    LAS float* tile = (LAS float*)(lds + wave * 8832);
    bf16* HT = (bf16*)(p.ws + WS_HYIN);
    const float* cw = p.in[39];
    for (int it = blockIdx.x * 8 + wave; it < 256 * 48; it += gridDim.x * 8) {
        const int rt = it / 48, cb = it % 48;
        const int r0 = rt * 64, col0 = 672 + cb * 32;
        const int t0 = r0 < MP ? (r0 & 255) : ((r0 - MP) & 1023), L = r0 < MP ? 256 : 1024;
        unsigned wv[17];
#pragma unroll
        for (int i = 0; i < 17; ++i) {
            const int rr = i * 4 + (lane >> 4), tt = t0 - 1 + rr;
            wv[i] = (rr < 66 && tt >= 0 && tt < L) ? *(const unsigned*)(p1 + (size_t)(r0 - 1 + rr) * LDP1 + col0 + (lane & 15) * 2) : 0u;
        }
#pragma unroll
        for (int i = 0; i < 17; ++i) {
            const int rr = i * 4 + (lane >> 4);
            if (rr < 66) { tile[rr * 33 + (lane & 15) * 2] = bflo(wv[i]); tile[rr * 33 + (lane & 15) * 2 + 1] = bfhi(wv[i]); }
        }
        LDS_WAIT();
#pragma unroll 8
        for (int c = 0; c < 32; ++c) {
            const int ch = cb * 32 + c;
            const float v = cw[ch] * tile[lane * 33 + c] + cw[1536 + ch] * tile[(lane + 1) * 33 + c] + cw[3072 + ch] * tile[(lane + 2) * 33 + c];
            HT[(size_t)ch * M_TOK + r0 + lane] = (bf16)(pk2(v, 0.f) & 0xffffu);
        }
        LDS_WAIT();
    }
}

__device__ __forceinline__ void attn_item(const P& p, LAS unsigned char* lds, int kind, int b, int head, int qt) {
    constexpr int KT_H = 128 * 104, VT_H = 64 * 136, TILE_B = (KT_H + VT_H) * 2;
    const int tid = tid_opaque(), lane = tid & 63, wave = tid >> 6, ln = lane & 15, h = lane >> 4;
    const bf16* Q = (const bf16*)(p.ws + WS_Q); const bf16* KN = (const bf16*)(p.ws + WS_KV); const bf16* VT = (const bf16*)(p.ws + WS_VT); const bf16* KPE = (const bf16*)(p.ws + WS_KPEA);
    bf16* MX = (bf16*)(p.ws + WS_MIX);
    const int nkeys = kind ? 1280 : 256, rowbase = kind ? MP + b * 1024 : b * 256, ntiles = nkeys / 128;
    const int qrow = rowbase + qt * 256 + wave * 32 + ln;
    s16x8 qf[2][3];
#pragma unroll
    for (int j = 0; j < 2; ++j)
#pragma unroll
        for (int s = 0; s < 3; ++s) qf[j][s] = *(const s16x8*)(Q + (size_t)(qrow + 16 * j) * 768 + head * 96 + 32 * s + 8 * h);
    f32x4 o[2][4];
#pragma unroll
    for (int j = 0; j < 2; ++j)
#pragma unroll
        for (int i = 0; i < 4; ++i) o[j][i] = (f32x4){0.f, 0.f, 0.f, 0.f};
    float mrun[2] = {-1e30f, -1e30f}, lrun[2] = {0.f, 0.f};
    u32x4 Ak[3], Av[2], Bk[3], Bv[2];
#define ATT_LOAD(X, it) do { const int j0_ = (it) * 128; \
        const int kb_ = kind ? (j0_ < 1024 ? MP + b * 1024 + j0_ : M_TOK + b * 256 + (j0_ - 1024)) : b * 256 + j0_; \
        _Pragma("unroll") for (int i_ = 0; i_ < 3; ++i_) { const int c_ = tid + 512 * i_, key_ = c_ / 12, ch_ = c_ % 12; \
            X##k[i_] = *(const u32x4*)(ch_ < 8 ? KN + (size_t)(kb_ + key_) * 512 + head * 64 + ch_ * 8 : KPE + (size_t)(kb_ + key_) * 32 + (ch_ - 8) * 8); } \
        _Pragma("unroll") for (int i_ = 0; i_ < 2; ++i_) { const int c_ = tid + 512 * i_; \
            X##v[i_] = *(const u32x4*)(VT + (size_t)(head * 64 + (c_ >> 4)) * (M_TOK + 2048) + kb_ + (c_ & 15) * 8); } } while (0)
#define ATT_STORE(X, Kt_, Vt_) do { \
        _Pragma("unroll") for (int i_ = 0; i_ < 3; ++i_) { const int c_ = tid + 512 * i_; *(LAS u32x4*)(Kt_ + (c_ / 12) * 104 + (c_ % 12) * 8) = X##k[i_]; } \
        _Pragma("unroll") for (int i_ = 0; i_ < 2; ++i_) { const int c_ = tid + 512 * i_; *(LAS u32x4*)(Vt_ + (c_ >> 4) * 136 + (c_ & 15) * 8) = X##v[i_]; } } while (0)
    __syncthreads();
    ATT_LOAD(A, 0);
    if (ntiles > 1) ATT_LOAD(B, 1);
#pragma unroll 1
    for (int it = 0; it < ntiles; ++it) {
        LAS bf16* Kt = (LAS bf16*)(lds + (it & 1) * TILE_B);
        LAS bf16* Vt = Kt + KT_H;
        if (it & 1) ATT_STORE(B, Kt, Vt); else ATT_STORE(A, Kt, Vt);
        __syncthreads();
        if (it + 2 < ntiles) { if (it & 1) ATT_LOAD(B, it + 2); else ATT_LOAD(A, it + 2); }
        f32x4 sc[2][8]; float mx[2] = {-1e30f, -1e30f};
#pragma unroll
        for (int kt = 0; kt < 8; ++kt) {
            f32x4 a0 = {0.f, 0.f, 0.f, 0.f}, a1 = a0;
#pragma unroll
            for (int s = 0; s < 3; ++s) { const s16x8 kf = *(const LAS s16x8*)(Kt + (kt * 16 + ln) * 104 + 32 * s + 8 * h);
                a0 = __builtin_amdgcn_mfma_f32_16x16x32_bf16(kf, qf[0][s], a0, 0, 0, 0); a1 = __builtin_amdgcn_mfma_f32_16x16x32_bf16(kf, qf[1][s], a1, 0, 0, 0); }
            sc[0][kt] = a0; mx[0] = fmaxf(mx[0], fmaxf(fmaxf(a0[0], a0[1]), fmaxf(a0[2], a0[3])));
            sc[1][kt] = a1; mx[1] = fmaxf(mx[1], fmaxf(fmaxf(a1[0], a1[1]), fmaxf(a1[2], a1[3])));
        }
        s16x8 pf[2][4];
#pragma unroll
        for (int j = 0; j < 2; ++j) {
            float m = mx[j];
            m = fmaxf(m, SHFLX(m, 16, lane)); m = fmaxf(m, SHFLX(m, 32, lane));
            const float mnew = fmaxf(mrun[j], m), alpha = __expf(mrun[j] - mnew);
            mrun[j] = mnew;
            float ps = 0.f;
#pragma unroll
            for (int kt = 0; kt < 8; ++kt)
#pragma unroll
                for (int r = 0; r < 4; ++r) { sc[j][kt][r] = __expf(sc[j][kt][r] - mnew); ps += sc[j][kt][r]; }
            lrun[j] = lrun[j] * alpha + ps;
#pragma unroll
            for (int i = 0; i < 4; ++i) o[j][i] = o[j][i] * alpha;
#pragma unroll
            for (int s = 0; s < 4; ++s) {
                u32x4 pw; pw.x = pk2(sc[j][2 * s][0], sc[j][2 * s][1]); pw.y = pk2(sc[j][2 * s][2], sc[j][2 * s][3]); pw.z = pk2(sc[j][2 * s + 1][0], sc[j][2 * s + 1][1]); pw.w = pk2(sc[j][2 * s + 1][2], sc[j][2 * s + 1][3]);
                pf[j][s] = __builtin_bit_cast(s16x8, pw);
            }
        }
#pragma unroll
        for (int s = 0; s < 4; ++s) {
#pragma unroll
            for (int vt = 0; vt < 4; ++vt) {
                const LAS bf16* vp = Vt + (vt * 16 + ln) * 136 + 32 * s + 4 * h;
                const u32x2 lo2 = *(const LAS u32x2*)vp, hi2 = *(const LAS u32x2*)(vp + 16);
                const u32x4 vw = {lo2.x, lo2.y, hi2.x, hi2.y};
                o[0][vt] = __builtin_amdgcn_mfma_f32_16x16x32_bf16(__builtin_bit_cast(s16x8, vw), pf[0][s], o[0][vt], 0, 0, 0);
                o[1][vt] = __builtin_amdgcn_mfma_f32_16x16x32_bf16(__builtin_bit_cast(s16x8, vw), pf[1][s], o[1][vt], 0, 0, 0);
            }
        }
    }
#undef ATT_LOAD
#undef ATT_STORE
#pragma unroll
    for (int j = 0; j < 2; ++j) {
        float l = lrun[j]; l += SHFLX(l, 16, lane); l += SHFLX(l, 32, lane);
        const float inv = 1.0f / l;
#pragma unroll
        for (int vt = 0; vt < 4; ++vt) *(u32x2*)(MX + (size_t)(qrow + 16 * j) * 1024 + head * 64 + vt * 16 + 4 * h) = pk4(o[j][vt] * inv);
    }
}

__device__ __forceinline__ void hyena_item(const P& p, LAS unsigned char* lds, int kind, int cgp) {
    const int tid = tid_opaque(), lane = tid & 63, wave = tid >> 6, ci = wave >> 2, qtr = wave & 3;
    const int L = kind ? 1024 : 256, NB = kind ? 8 : 32, base = kind ? MP : 0, c = cgp * 2 + ci;
    const int DMAX = kind ? 31 : 7;
    constexpr int ZCH = 8704;
    LAS bf16* zb = (LAS bf16*)lds;
    LAS bf16* gb = zb + 2 * ZCH;
    LAS bf16* gb1 = gb + 4 * 2048;
    LAS bf16* gl = gb1 + 4 * 2048;
    const bf16* HT = (const bf16*)(p.ws + WS_HYIN);
    const bf16* G = (const bf16*)(p.ws + (kind ? WS_GFS : WS_GFP));
    bf16* HO = (bf16*)(p.ws + WS_H);
    __syncthreads();
    const int Lp = L + 8;
    for (int i = tid; i < 2 * 1024; i += NTHREADS) { const int cc = i >> 10, off = (i & 1023) * 8;
        *(LAS u32x4*)(zb + cc * ZCH + (off / L) * Lp + (off % L)) = *(const u32x4*)(HT + (size_t)(cgp * 2 + cc) * M_TOK + base + off); }
    for (int i = tid; i < 4 * (2 * L / 8); i += NTHREADS) { const int co = i / (2 * L / 8), off = (i % (2 * L / 8)) * 8, cc = co >> 1, od = co & 1;
        *(LAS u32x4*)(gb + (cc * 2 + od) * 2 * L + off) = *(const u32x4*)(G + ((size_t)od * 512 + cgp * 2 + cc) * (2 * L) + off);
        *(LAS u32x4*)(gb1 + (cc * 2 + od) * 2 * L + off) = *(const u32x4*)(G + ((size_t)od * 512 + cgp * 2 + cc) * (2 * L) + off + 1); }
    for (int i = tid; i < 4 * 1024; i += NTHREADS) { const int oc = i >> 10, off = (i & 1023) * 8;
        *(LAS u32x4*)(gl + oc * ZCH + (off / L) * Lp + (off % L)) = *(const u32x4*)(HT + (size_t)(((oc >> 1) + 1) * 512 + cgp * 2 + (oc & 1)) * M_TOK + base + off); }
    __syncthreads();
    const int n = lane & 31, h = lane >> 5;
    const int jl = kind ? (n & 3) : 0, bb = kind ? (n >> 2) : n;
    const LAS bf16* zc = zb + ci * ZCH + bb * Lp;
#pragma unroll 1
    for (int order = 0; order < 2; ++order) {
        const LAS bf16* gr = (n & 1) ? gb1 + (ci * 2 + order) * 2 * L - 1 : gb + (ci * 2 + order) * 2 * L;
        f32x16 acc[2];
#pragma unroll
        for (int g = 0; g < 2; ++g)
#pragma unroll
            for (int r = 0; r < 16; ++r) acc[g][r] = 0.f;
        const int Ilo_w = kind ? 8 * qtr : 2 * qtr, Ihi_w = kind ? 8 * qtr + 7 : 2 * qtr + 1;
        int Dlo = Ilo_w - (L / 32 - 1), Dhi = Ihi_w; if (Dlo < -DMAX) Dlo = -DMAX; if (Dhi > DMAX) Dhi = DMAX;
#define HY_LOAD(DD, A0, A1, B00, B01, B10, B11) do { \
            const volatile LAS unsigned* ap_ = (const volatile LAS unsigned*)(gr + (L - 32 * (DD) + 8 * h - n)); \
            A0.x = ap_[0]; A0.y = ap_[1]; A0.z = ap_[2]; A0.w = ap_[3]; A1.x = ap_[8]; A1.y = ap_[9]; A1.z = ap_[10]; A1.w = ap_[11]; \
            const int J0_ = (kind ? 8 * qtr + jl : 2 * qtr) - (DD), J1_ = (kind ? 8 * qtr + 4 + jl : 2 * qtr + 1) - (DD); \
            const bool k0_ = J0_ >= 0 && J0_ < L / 32, k1_ = J1_ >= 0 && J1_ < L / 32; \
            const LAS bf16* z0_ = zc + 32 * (k0_ ? J0_ : 0) + 8 * h; const LAS bf16* z1_ = zc + 32 * (k1_ ? J1_ : 0) + 8 * h; \
            B00 = *(const LAS u32x4*)z0_; B10 = *(const LAS u32x4*)(z0_ + 16); B01 = *(const LAS u32x4*)z1_; B11 = *(const LAS u32x4*)(z1_ + 16); \
            B00.x = k0_ ? B00.x : 0u; B00.y = k0_ ? B00.y : 0u; B00.z = k0_ ? B00.z : 0u; B00.w = k0_ ? B00.w : 0u; B10.x = k0_ ? B10.x : 0u; B10.y = k0_ ? B10.y : 0u; B10.z = k0_ ? B10.z : 0u; B10.w = k0_ ? B10.w : 0u; \
            B01.x = k1_ ? B01.x : 0u; B01.y = k1_ ? B01.y : 0u; B01.z = k1_ ? B01.z : 0u; B01.w = k1_ ? B01.w : 0u; B11.x = k1_ ? B11.x : 0u; B11.y = k1_ ? B11.y : 0u; B11.z = k1_ ? B11.z : 0u; B11.w = k1_ ? B11.w : 0u; \
        } while (0)
        u32x4 cA0, cA1, cB00, cB01, cB10, cB11;
        HY_LOAD(Dlo, cA0, cA1, cB00, cB01, cB10, cB11);
#pragma unroll 1
        for (int D = Dlo; D <= Dhi; ++D) {
            u32x4 nA0, nA1, nB00, nB01, nB10, nB11;
            HY_LOAD(D + 1, nA0, nA1, nB00, nB01, nB10, nB11);
            acc[0] = __builtin_amdgcn_mfma_f32_32x32x16_bf16(__builtin_bit_cast(s16x8, cA0), __builtin_bit_cast(s16x8, cB00), acc[0], 0, 0, 0);
            acc[1] = __builtin_amdgcn_mfma_f32_32x32x16_bf16(__builtin_bit_cast(s16x8, cA0), __builtin_bit_cast(s16x8, cB01), acc[1], 0, 0, 0);
            acc[0] = __builtin_amdgcn_mfma_f32_32x32x16_bf16(__builtin_bit_cast(s16x8, cA1), __builtin_bit_cast(s16x8, cB10), acc[0], 0, 0, 0);
            acc[1] = __builtin_amdgcn_mfma_f32_32x32x16_bf16(__builtin_bit_cast(s16x8, cA1), __builtin_bit_cast(s16x8, cB11), acc[1], 0, 0, 0);
            cA0 = nA0; cA1 = nA1; cB00 = nB00; cB01 = nB01; cB10 = nB10; cB11 = nB11;
        }
#undef HY_LOAD
        const float bias = p.in[46][order * 512 + c];
        const LAS bf16* gate = gl + (order * 2 + ci) * ZCH + bb * Lp;
        u32x2 zn[2][4];
#pragma unroll
        for (int g = 0; g < 2; ++g) {
            const int og = qtr * 2 + g, I = kind ? 4 * og + jl : og;
#pragma unroll
            for (int rq = 0; rq < 4; ++rq) {
                const int t = 32 * I + 8 * rq + 4 * h;
                const f32x4 zo = unpk4(*(const LAS u32x2*)(zc + t)), gt = unpk4(*(const LAS u32x2*)(gate + t));
                f32x4 y; y.x = acc[g][4 * rq]; y.y = acc[g][4 * rq + 1]; y.z = acc[g][4 * rq + 2]; y.w = acc[g][4 * rq + 3];
                zn[g][rq] = pk4(gt * (y + zo * bias));
            }
        }
        __syncthreads();
#pragma unroll
        for (int g = 0; g < 2; ++g) { const int og = qtr * 2 + g, I = kind ? 4 * og + jl : og;
#pragma unroll
            for (int rq = 0; rq < 4; ++rq) *(LAS u32x2*)(zb + ci * ZCH + bb * Lp + 32 * I + 8 * rq + 4 * h) = zn[g][rq]; }
        __syncthreads();
    }
    for (int i = tid; i < 2 * 1024; i += NTHREADS) { const int cc = i >> 10, off = (i & 1023) * 8;
        *(u32x4*)(HO + (size_t)(cgp * 2 + cc) * M_TOK + base + off) = *(const LAS u32x4*)(zb + cc * ZCH + (off / L) * Lp + (off % L)); }
}
#ifndef DUP_SUB
#define DUP_SUB 3
#endif
__device__ __forceinline__ void ph_attn_hyena(const P& p, LAS unsigned char* lds, bool dummy) {
    const int B = blockIdx.x, G = gridDim.x;
#ifndef T_NO_ATTN
    if (!dummy || (DUP_SUB & 1))
    for (int i = B; i < 512; i += G) { if (i < 256) attn_item(p, lds, 1, i >> 5, (i >> 2) & 7, i & 3); else { const int j = i - 256; attn_item(p, lds, 0, j >> 3, j & 7, 0); } }
#endif
#ifndef T_NO_HY
    if (!dummy || (DUP_SUB & 2))
    for (int i = B; i < 512; i += G) { hyena_item(p, lds, i < 256 ? 1 : 0, i & 255); }
#endif
}

__device__ __forceinline__ void ph_hy_transpose(const P& p, LAS unsigned char* lds) {
    const int tid = tid_opaque(), lane = tid & 63, wave = tid >> 6;
    LAS bf16* tile = (LAS bf16*)(lds + wave * 9216);
    const bf16* HO = (const bf16*)(p.ws + WS_H); bf16* MX = (bf16*)(p.ws + WS_MIX);
    for (int it = blockIdx.x * 8 + wave; it < 2048; it += gridDim.x * 8) {
        const int rt = it >> 3, cb = it & 7, r0 = rt * 64, c0 = cb * 64;
#pragma unroll
        for (int i = 0; i < 8; ++i) { const int id = i * 64 + lane, c = id >> 3, rc = id & 7;
            *(LAS u32x4*)(tile + c * 72 + rc * 8) = *(const u32x4*)(HO + (size_t)(c0 + c) * M_TOK + r0 + rc * 8); }
        LDS_WAIT();
        const int rsub = lane >> 3, ch = lane & 7;
        bf16* dst = MX + (size_t)(r0 + rsub) * 1024 + 512 + c0 + ch * 8;
#pragma unroll
        for (int j = 0; j < 8; ++j) {
            u32x4 w;
#pragma unroll
            for (int i = 0; i < 4; ++i) { const unsigned a = tile[(ch * 8 + 2 * i) * 72 + 8 * j + rsub], bq = tile[(ch * 8 + 2 * i + 1) * 72 + 8 * j + rsub]; w[i] = a | (bq << 16); }
            *(u32x4*)(dst + (size_t)(8 * j) * 1024) = w;
        }
        LDS_WAIT();
    }
}

#define XB_TMO      128
#define XB_XCNT(j)  (256  + 64 * (j))
#define XB_XSUB(j)  (1280 + 64 * (j))
#define XB_XGEN(j)  (2304 + 64 * (j))
#define XB_TOP      3328
#define XB_TOPGEN   3392
#define XCD_BAR_WORDS 3456
#define XB_SPIN_CAP (1u << 18)

__device__ __forceinline__ unsigned xb_ld(unsigned* p)              { return __hip_atomic_load(p, __ATOMIC_RELAXED, __HIP_MEMORY_SCOPE_AGENT); }
__device__ __forceinline__ unsigned xb_add(unsigned* p, unsigned v) { return __hip_atomic_fetch_add(p, v, __ATOMIC_RELAXED, __HIP_MEMORY_SCOPE_AGENT); }
__device__ __forceinline__ unsigned xb_xcc_id() { return (unsigned)__builtin_amdgcn_s_getreg((3 << 11) | 20) & 0xFu; }
#define XB_SPIN(cond, bar) do { unsigned _sp = 0; while (cond) { __builtin_amdgcn_s_sleep(1); \
    if ((++_sp & 255u) == 0u) { if (xb_ld(&(bar)[XB_TMO])) break; if (_sp > XB_SPIN_CAP) { atomicAdd(&(bar)[XB_TMO], 1u); break; } } } } while (0)

struct XcdBarrier {
    unsigned* bar; unsigned x;
    volatile LAS unsigned* st;
};

__device__ __forceinline__ XcdBarrier xcd_barrier_post(unsigned* bar, volatile LAS unsigned* st) {
    XcdBarrier b; b.bar = bar; b.x = xb_xcc_id(); b.st = st;
    if (threadIdx.x == 0) (void)xb_add(&bar[XB_XCNT(b.x)], 1u);
    return b;
}
__device__ __forceinline__ void xcd_barrier_complete(unsigned* bar, unsigned x, unsigned& nloc, unsigned& nx) {
    const unsigned G = gridDim.x * gridDim.y * gridDim.z;
    unsigned sum, cnt, mine, sp = 0u;
    for (;;) {
        sum = 0u; cnt = 0u; mine = 0u;
#pragma unroll
        for (unsigned j = 0; j < 16; ++j) { const unsigned c = xb_ld(&bar[XB_XCNT(j)]); sum += c; cnt += (c > 0u) ? 1u : 0u; mine = (j == x) ? c : mine; }
        if (sum == G) break;
        __builtin_amdgcn_s_sleep(1);
        if ((++sp & 255u) == 0u) { if (xb_ld(&bar[XB_TMO])) break; if (sp > XB_SPIN_CAP) { atomicAdd(&bar[XB_TMO], 1u); break; } }
    }
    nloc = mine > 0u ? mine : 1u; nx = cnt > 0u ? cnt : 1u;
}

__device__ __forceinline__ void xcd_barrier(const XcdBarrier& b) {
    asm volatile("s_waitcnt vmcnt(0)" ::: "memory");
    __syncthreads();
    if (threadIdx.x == 0) {
        unsigned* bar = b.bar;
        __builtin_amdgcn_s_waitcnt(0);
        unsigned nloc = b.st[0], nx = b.st[1];
        if (nloc == 0u) { xcd_barrier_complete(bar, b.x, nloc, nx); b.st[0] = nloc; b.st[1] = nx; }
        const unsigned old = xb_add(&bar[XB_XSUB(b.x)], 1u);
        const unsigned gen = old / nloc;
        if (old + 1u == (gen + 1u) * nloc) {
            __builtin_amdgcn_fence(__ATOMIC_RELEASE, "agent");
            asm volatile("s_waitcnt vmcnt(0)" ::: "memory");
            const unsigned og = xb_add(&bar[XB_TOP], 1u);
            const unsigned tg = og / nx;
            if (og + 1u == (tg + 1u) * nx) xb_add(&bar[XB_TOPGEN], 1u);
            else XB_SPIN(xb_ld(&bar[XB_TOPGEN]) == tg, bar);
            __builtin_amdgcn_fence(__ATOMIC_ACQUIRE, "agent");
            xb_add(&bar[XB_XGEN(b.x)], 1u);
            asm volatile("s_waitcnt vmcnt(0)" ::: "memory");
        } else {
            XB_SPIN(xb_ld(&bar[XB_XGEN(b.x)]) == gen, bar);
            __builtin_amdgcn_fence(__ATOMIC_ACQUIRE, "agent");
            asm volatile("s_waitcnt vmcnt(0)" ::: "memory");
        }
    }
    __syncthreads();
}


template <class Epi>
__device__ __forceinline__ void run_gemm(LAS unsigned char* lds, const bf16* A, const bf16* Bt, int M, int N, int K, const Epi& E, int rot = 0, int kseg = 0) {
    asm volatile("" : "+s"(K));
    pg8::Gemm g{A, Bt, M, N, K, kseg}; pg8::StaticOrder S; S.init(M, N, (int)gridDim.x, (int)((blockIdx.x + gridDim.x - rot) % gridDim.x));
    pg8::gemm_phase<Epi, pg8::StaticOrder, true, true>(lds, g, S, E);
}

#ifndef DUP_PH
#define DUP_PH (-1)
#endif
__device__ __forceinline__ void run_phase(const P& p, LAS unsigned char* lds, int k, bool dummy) {
    if (k == 0) {
        { float* cvz0 = (float*)(p.ws + WS_CV); for (int i = blockIdx.x * NTHREADS + tid_opaque(); i < 2 * CV_STRIDE; i += gridDim.x * NTHREADS) cvz0[i] = 0.f; }
        adaln_layer(p, lds, 0, 0); adaln_layer(p, lds, 1, (int)gridDim.x / 2); ph_rope_table(p); return; }
    if (k == 27) { final_norm_rows(p); return; }
    const int layer = (k - 1) / 13, sub = (k - 1) % 13;
    float* x = p.out;
    const float* mod = (const float*)(p.ws + WS_MOD);
    bf16* H = (bf16*)(p.ws + WS_H); bf16* R1 = (bf16*)(p.ws + WS_R1);
    float* ssb = (float*)(p.ws + WS_SS); float* cvb = (float*)(p.ws + WS_CV); float* ssp = (float*)(p.ws + WS_R2);
    switch (sub) {
    case 0: case 3: case 10: {
        const int jn = sub == 0 ? 0 : (sub == 3 ? 1 : 2), uu = 3 * layer + jn;
        float* cvo = cvb + (size_t)(uu & 1) * CV_STRIDE; float* cvz = cvb + (size_t)((uu + 1) & 1) * CV_STRIDE;
        const float* shift = mod + (size_t)layer * 9 * 9216 + (3 * jn) * 1024;
        for (int i = blockIdx.x * NTHREADS + tid_opaque(); i < CV_STRIDE; i += gridDim.x * NTHREADS) cvz[i] = 0.f;
        if (uu == 0) first_rows(p, p.in[10], ssb);
        else { const int t = tid_opaque();
            for (int row = blockIdx.x * 64 + (t >> 3); row < M_TOK; row += gridDim.x * 64) {
                const float a = red8(ssp[((t & 7) * 2) * M_TOK + row] + ssp[((t & 7) * 2 + 1) * M_TOK + row]);
                if ((t & 7) == 0) ssb[row] = rsqrtf_(a * (1.0f / 1024.0f) + 1e-6f); } }
        if (sub != 3) convert_ffn_weights(p, layer, sub == 0 ? 0 : 1, lds, shift, cvo);
        else {
            transpose_w<0>(p.in[17] + (size_t)layer * 1024 * 1024, 1024, 1024, 1024, (bf16*)(p.ws + W_OUT), 1024, lds, nullptr, nullptr, 0, layer == 0 ? 128 : 72);
            if (layer == 0) { transpose_w<0>(p.in[18], 3984, 3984, 1024, (bf16*)(p.ws + W_IN), 4096, lds, shift, cvo, 4096); build_lora_w(p); }
            else { transpose_w<0>(p.in[34], 2208, 2208, 1024, (bf16*)(p.ws + W_IN), 2304, lds, shift, cvo, 2304, 0);
                transpose_w<0>(p.in[36], 768, 768, 384, (bf16*)(p.ws + W_UQ), 768, lds, nullptr, nullptr, 0, 104);
                transpose_w<0>(p.in[38], 1024, 1024, 256, (bf16*)(p.ws + W_UKV), 1024, lds, nullptr, nullptr, 0, 113); }
        }
    } break;
    case 1: case 11: { const int uu = 3 * layer + (sub == 1 ? 0 : 2);
        run_gemm(lds, (const bf16*)(p.ws + WS_XB), (const bf16*)(p.ws + W_GU), M_TOK, 5632, 1024, EpiSwigluN{R1, ssb, cvb + (size_t)(uu & 1) * CV_STRIDE}); } break;
    case 2: case 12: {
        const bool first = layer == 0 && sub == 2;
        const float* xp = first ? p.in[0] : x; const float* xs = first ? p.in[1] : x + (size_t)MP * DM;
        const float* gate = mod + (size_t)layer * 9 * 9216 + (sub == 2 ? 2 : 8) * 1024;
        bf16* XB = (bf16*)(p.ws + WS_XB);
        if (layer == 1 && sub == 12) { const EpiResid E{XB, gate, p.in[12] + layer * 1024, mod + (size_t)layer * 9 * 9216 + 7 * 1024, 0.5f}; run_gemm(lds, R1, (const bf16*)(p.ws + W_DOWN), M_TOK, 1024, 2816, E); }
        else {
            const int ln = sub == 12 ? layer + 1 : layer, jn = sub == 2 ? 1 : 0, uu = 3 * ln + jn;
            const float* gnx = p.in[jn == 0 ? 10 : 11] + ln * 1024; const float* scx = mod + (size_t)ln * 9 * 9216 + (3 * jn + 1) * 1024;
            const float* gpv = p.in[sub == 2 ? 10 : 12] + layer * 1024; const float* spv = mod + (size_t)layer * 9 * 9216 + (sub == 2 ? 1 : 7) * 1024;
            { const EpiResidN<true> E{xp, xs, XB, gate, gpv, spv, gnx, scx, ssp, 0.5f}; run_gemm(lds, R1, (const bf16*)(p.ws + W_DOWN), M_TOK, 1024, 2816, E); }
        }
    } break;
    case 9: {
        const int uu = 3 * layer + 2;
        bf16* XB = (bf16*)(p.ws + WS_XB);
        const EpiResidN<true> E{x, x + (size_t)MP * DM, XB, mod + (size_t)layer * 9 * 9216 + 5 * 1024, p.in[11] + layer * 1024, mod + (size_t)layer * 9 * 9216 + 4 * 1024, p.in[12] + layer * 1024, mod + (size_t)layer * 9 * 9216 + 7 * 1024, ssp, 1.0f};
        run_gemm(lds, (const bf16*)(p.ws + WS_MIX), (const bf16*)(p.ws + W_OUT), M_TOK, 1024, 1024, E);
    } break;
    case 4: {
        const int N = layer == 0 ? 4096 : 2304, ld = layer == 0 ? LDP0 : LDP1, uu = 3 * layer + 1;
        run_gemm(lds, (const bf16*)(p.ws + WS_XB), (const bf16*)(p.ws + W_IN), M_TOK, N, 1024, EpiStoreN{R1, ld, ld, ssb, cvb + (size_t)(uu & 1) * CV_STRIDE, N});
        if (layer == 1) ph_hyena_filters(p, lds, 96);
    } break;
    case 5: if (layer == 0) ph_lora_in(p); else ph_mla_prep(p, lds); break;
    case 6:
        if (layer == 0) run_gemm(lds, H, (const bf16*)(p.ws + W_LORA), M_TOK, 2560, 384, EpiLora{(bf16*)(p.ws + WS_R2), p.in[20], p.in[22]}, 0, 1);
        else { run_gemm(lds, (const bf16*)(p.ws + WS_CKVA), (const bf16*)(p.ws + W_UKV), M_TOK + 2048, 1024, 256, EpiKV{(bf16*)(p.ws + WS_KV), (bf16*)(p.ws + WS_VT), M_TOK + 2048});
            run_gemm(lds, H, (const bf16*)(p.ws + W_UQ), M_TOK, 768, 384, EpiQ{(bf16*)(p.ws + WS_Q), (const float*)(p.ws + WS_ROPE)}, 32); }
        break;
    case 7: if (layer == 0) ph_scan(p, lds); else ph_attn_hyena(p, lds, dummy); break;
    case 8: if (layer == 0) ph_post_ab(p, dummy); else ph_hy_transpose(p, lds); break;
    default: break;
    }
}

__global__ void __launch_bounds__(NTHREADS, 2) hybrid_fwd(P p) {
    extern __shared__ __attribute__((aligned(16))) unsigned char lds_raw[];
    LAS unsigned char* lds = (LAS unsigned char*)lds_raw;
    cg::grid_group grid = cg::this_grid();
    volatile LAS unsigned* bst = (volatile LAS unsigned*)(lds + LDS_BYTES - 64);
    if (threadIdx.x < 16) bst[threadIdx.x] = 0u;
    __syncthreads();
    XcdBarrier bar = xcd_barrier_post((unsigned*)(p.ws + WS_CTL) + 1024, bst);
#pragma unroll 1
    for (int k = p.ph_lo; k < p.ph_hi; ++k) {
        const int nrep = (DUP_PH >= 0 && k == DUP_PH) ? 2 : 1;
#pragma unroll 1
        for (int rep = 0; rep < nrep; ++rep) { run_phase(p, lds, k, rep + 1 < nrep); if (rep + 1 < nrep) __syncthreads(); }
        if (k + 1 < p.ph_hi) { if (p.ph_hi < 0) grid.sync(); else { xcd_barrier(bar);
        } }
    }
}

extern "C" void kernel_launch(void* const* d_in, const int* in_sizes, int n_in, void* d_out, int out_size, void* d_ws, size_t ws_size, hipStream_t stream) {
    static int grid = 0;
    if (grid == 0) {
        if (n_in != 48 || out_size != 25427968 || ws_size < WS_END) {
            fprintf(stderr, "kernel_launch: expected 48 inputs, 25427968 outputs, >= %zu B workspace; got %d, %d, %zu\n", (size_t)WS_END, n_in, out_size, ws_size);
            grid = -1; return;
        }
        int dev = 0, cus = 0, per_cu = 0;
        hipGetDevice(&dev);
        hipDeviceGetAttribute(&cus, hipDeviceAttributeMultiprocessorCount, dev);
        hipFuncSetAttribute((const void*)hybrid_fwd, hipFuncAttributeMaxDynamicSharedMemorySize, LDS_BYTES);
        hipOccupancyMaxActiveBlocksPerMultiprocessor(&per_cu, (const void*)hybrid_fwd, NTHREADS, LDS_BYTES);
        if (per_cu < 1) { fprintf(stderr, "kernel_launch: occupancy query says %d blocks/CU\n", per_cu); per_cu = 1; }
        (void)hipGetLastError();
        grid = cus;
    }
    if (grid < 0) return;
    (void)hipMemsetAsync((char*)d_ws + WS_CTL, 0, 24 * 1024, stream);
    P prm{};
    for (int i = 0; i < 48; ++i) prm.in[i] = (const float*)d_in[i];
    prm.out = (float*)d_out; prm.ws = (unsigned char*)d_ws;
#ifndef N_SPLIT
    prm.ph_lo = 0; prm.ph_hi = 28;
    void* args[] = {&prm};
    hipError_t e = hipLaunchCooperativeKernel((const void*)hybrid_fwd, dim3(grid), dim3(NTHREADS), args, LDS_BYTES, stream);
    if (e != hipSuccess) fprintf(stderr, "cooperative launch failed: %s (grid %d)\n", hipGetErrorString(e), grid);
#else
    for (int k = 0; k < 28; ++k) {
        prm.ph_lo = k; prm.ph_hi = k + 1;
        void* args[] = {&prm};
        hipError_t e = hipLaunchCooperativeKernel((const void*)hybrid_fwd, dim3(grid), dim3(NTHREADS), args, LDS_BYTES, stream);
        if (e != hipSuccess) { fprintf(stderr, "launch %d failed: %s\n", k, hipGetErrorString(e)); break; }
    }
#endif
}
```
